# Optimizing an MI355X kernel written in HIP

```python
import jax, jax.numpy as jnp
from jax import lax
import numpy as np

D_MODEL = 1024
BATCH = 1
SEQ = 16384
DEPTH = 1

N_HEADS = 8
HEAD_DIM = 64
ATTN_WIDTH = N_HEADS * HEAD_DIM
IDX_HEADS = 4
IDX_DIM = 64
TOPK_MAX = 256
Q_BLOCK = 128
POOL_WINDOWS = (2, 4, 8, 16)
POOL_GROUPS = 4
POOL_GROUP_DIM = 128
POOL_WIDTH = POOL_GROUPS * POOL_GROUP_DIM
D_FF = 2816
CONV_WIDTH = 3
EPS = 1e-6
N_MOD = 6
IN_SIZES = (ATTN_WIDTH, ATTN_WIDTH, ATTN_WIDTH,
            IDX_HEADS * IDX_DIM, IDX_DIM, IDX_HEADS,
            POOL_WIDTH,
            D_MODEL, D_MODEL)
IN_TOTAL = sum(IN_SIZES)

kernel_name = "hybrid_dsa_pool_convffn_block"


def split_cols(a, sizes):
    outs = []
    off = 0
    for s in sizes:
        outs.append(a[..., off:off + s])
        off += s
    return outs


def rms_norm(x, g):
    xf = x.astype(jnp.float32)
    y = xf * lax.rsqrt(jnp.mean(xf * xf, axis=-1, keepdims=True) + EPS)
    return (y * g.astype(jnp.float32)).astype(x.dtype)


def modulate(x, g, shift, scale):
    return rms_norm(x, g) * (1.0 + scale[:, None, :]) + shift[:, None, :]


def alibi_slopes(n_heads):
    return 2.0 ** (-8.0 * jnp.arange(1, n_heads + 1, dtype=jnp.float32) / n_heads)


def dsa_sparse_attention(q, k, v, qi, ki, wi):
    B, S, H, Dh = q.shape
    topk = min(TOPK_MAX, S // 4)
    nb = S // Q_BLOCK
    slopes = alibi_slopes(H)
    key_pos = jnp.arange(S, dtype=jnp.int32)
    scale = HEAD_DIM ** -0.5

    def to_blocks(a):
        return a.reshape((B, nb, Q_BLOCK) + a.shape[2:]).swapaxes(0, 1)

    def block_fn(args):
        qb, qib, wib, bidx = args
        qpos = bidx * Q_BLOCK + jnp.arange(Q_BLOCK, dtype=jnp.int32)
        ilog = jnp.einsum('bqhd,bsd->bqhs', qib, ki).astype(jnp.float32)
        iscore = jnp.einsum('bqhs,bqh->bqs', jax.nn.relu(ilog), wib.astype(jnp.float32))
        causal = key_pos[None, :] <= qpos[:, None]
        iscore = jnp.where(causal[None], iscore, -jnp.inf)
        _, sel = lax.top_k(iscore, topk)
        kg = jax.vmap(lambda kk, ii: kk[ii])(k, sel)
        vg = jax.vmap(lambda vv, ii: vv[ii])(v, sel)
        s = jnp.einsum('bqhd,bqkhd->bhqk', qb, kg).astype(jnp.float32) * scale
        dist = (qpos[None, :, None] - sel).astype(jnp.float32)
        s = s - slopes[None, :, None, None] * dist[:, None]
        valid = sel <= qpos[None, :, None]
        s = jnp.where(valid[:, None], s, -jnp.inf)
        p = jax.nn.softmax(s, axis=-1).astype(vg.dtype)
        return jnp.einsum('bhqk,bqkhd->bqhd', p, vg)

    out = lax.map(block_fn, (to_blocks(q), to_blocks(qi), to_blocks(wi),
                             jnp.arange(nb, dtype=jnp.int32)))
    return out.swapaxes(0, 1).reshape(B, S, H, Dh)


def multiscale_pool(u, w_grp, pool_scale):
    B, S, P = u.shape
    uf = u.astype(jnp.float32)
    cs = jnp.pad(jnp.cumsum(uf, axis=1), ((0, 0), (1, 0), (0, 0)))
    t = jnp.arange(S, dtype=jnp.float32)
    groups = []
    for g, w in enumerate(POOL_WINDOWS):
        c_g = cs[:, :, g * POOL_GROUP_DIM:(g + 1) * POOL_GROUP_DIM]
        upper = c_g[:, 1:]
        lower = jnp.pad(c_g, ((0, 0), (w - 1, 0), (0, 0)))[:, :S]
        count = jnp.minimum(t + 1.0, float(w))[None, :, None]
        mean = (upper - lower) / count
        groups.append(mean - uf[:, :, g * POOL_GROUP_DIM:(g + 1) * POOL_GROUP_DIM])
    pooled = jnp.stack(groups, axis=2).astype(u.dtype)
    mixed = jnp.einsum('bsgc,gcd->bsgd', pooled, w_grp).reshape(B, S, P)
    return mixed * pool_scale


def conv_ffn(h, w_up, conv_w, conv_b, w_down):
    S = h.shape[1]
    up = h @ w_up
    padded = jnp.pad(up, ((0, 0), (CONV_WIDTH - 1, 0), (0, 0)))
    y = conv_b + sum(conv_w[j] * padded[:, j:j + S] for j in range(CONV_WIDTH))
    a, b = jnp.split(y, 2, axis=-1)
    return (jax.nn.silu(a) * b) @ w_down


def setup_inputs(seed: int = 0) -> dict:
    key = jax.random.key(seed)
    ks = jax.random.split(key, 20)
    f = jnp.float32
    D = D_MODEL
    nrm = lambda k, shape, fan: jax.random.normal(k, shape, f) * (fan ** -0.5)
    return {
        "x": jax.random.normal(ks[0], (BATCH, SEQ, D), f),
        "c": jax.random.normal(ks[1], (BATCH, D), f),
        "w_ada": nrm(ks[2], (DEPTH, D, N_MOD * D), D) * 0.5,
        "b_ada": jax.random.normal(ks[3], (DEPTH, N_MOD * D), f) * 0.02,
        "norm1_g": 1.0 + 0.05 * jax.random.normal(ks[4], (DEPTH, D), f),
        "w_in": nrm(ks[5], (DEPTH, D, IN_TOTAL), D),
        "q_norm_g": 1.0 + 0.05 * jax.random.normal(ks[6], (DEPTH, HEAD_DIM), f),
        "k_norm_g": 1.0 + 0.05 * jax.random.normal(ks[7], (DEPTH, HEAD_DIM), f),
        "w_attn_br": nrm(ks[8], (DEPTH, ATTN_WIDTH, D), ATTN_WIDTH),
        "w_pool_grp": nrm(ks[9], (DEPTH, POOL_GROUPS, POOL_GROUP_DIM, POOL_GROUP_DIM), POOL_GROUP_DIM),
        "pool_scale": 1.0 + 0.1 * jax.random.normal(ks[10], (DEPTH, POOL_WIDTH), f),
        "w_pool_br": nrm(ks[11], (DEPTH, POOL_WIDTH, D), POOL_WIDTH),
        "w_out": nrm(ks[12], (DEPTH, D, D), D),
        "norm2_g": 1.0 + 0.05 * jax.random.normal(ks[13], (DEPTH, D), f),
        "w_up": nrm(ks[14], (DEPTH, D, 2 * D_FF), D),
        "conv_w": nrm(ks[15], (DEPTH, CONV_WIDTH, 2 * D_FF), CONV_WIDTH),
        "conv_b": jax.random.normal(ks[16], (DEPTH, 2 * D_FF), f) * 0.02,
        "w_down": nrm(ks[17], (DEPTH, D_FF, D), D_FF),
    }


def reference(x, c, w_ada, b_ada, norm1_g, w_in, q_norm_g, k_norm_g, w_attn_br,
              w_pool_grp, pool_scale, w_pool_br, w_out, norm2_g, w_up, conv_w,
              conv_b, w_down):
    B, S, D = x.shape
    for l in range(DEPTH):
        mod = jax.nn.silu(c) @ w_ada[l] + b_ada[l]
        shift1, scale1, gate1, shift2, scale2, gate2 = jnp.split(mod, N_MOD, axis=-1)

        h = modulate(x, norm1_g[l], shift1, scale1)
        proj = h @ w_in[l]
        q, k, v, qi, ki, wi, u_pool, g_attn, g_pool = split_cols(proj, IN_SIZES)
        q = rms_norm(q.reshape(B, S, N_HEADS, HEAD_DIM), q_norm_g[l])
        k = rms_norm(k.reshape(B, S, N_HEADS, HEAD_DIM), k_norm_g[l])
        v = v.reshape(B, S, N_HEADS, HEAD_DIM)
        qi = qi.reshape(B, S, IDX_HEADS, IDX_DIM) * (IDX_DIM ** -0.5)
        wi = wi * (IDX_HEADS ** -0.5)
        attn = dsa_sparse_attention(q, k, v, qi, ki, wi).reshape(B, S, ATTN_WIDTH)
        y_attn = attn @ w_attn_br[l]
        y_pool = multiscale_pool(u_pool, w_pool_grp[l], pool_scale[l]) @ w_pool_br[l]
        merged = jax.nn.sigmoid(g_attn) * y_attn + jax.nn.sigmoid(g_pool) * y_pool
        x = x + gate1[:, None, :] * (merged @ w_out[l])

        h2 = modulate(x, norm2_g[l], shift2, scale2)
        x = x + gate2[:, None, :] * conv_ffn(h2, w_up[l], conv_w[l], conv_b[l], w_down[l])
    return x
```

```cpp
#include <hip/hip_runtime.h>
#include <cstdio>
#include <cstdint>
namespace pg8 {
#define PG8_LAS __attribute__((address_space(3)))
typedef unsigned short bf16_t;
typedef short bf16x8 __attribute__((ext_vector_type(8)));
typedef float f32x4 __attribute__((ext_vector_type(4)));
typedef unsigned u32x4 __attribute__((ext_vector_type(4)));
constexpr int BM = 256, BK = 64, HALF = 128, HTB = HALF * BK * 2  , STAGE_BYTES = 8 * HTB, NXCD = 8, WGM = 8;

__host__ __device__ __forceinline__ int lds_byte(int r, int c) { const int st = (r >> 4) * 2 + (c >> 5), rr = r & 15, cc = c & 31, ob = rr * 64 + cc * 2; return st * 1024 + (ob ^ (((ob >> 9) & 1) << 5)); }
__host__ __device__ __forceinline__ void stage_rc(int b, int& R, int& C) { const int st = b / 1024, sb = b % 1024, swz = sb ^ (((sb >> 9) & 1) << 5); R = (st >> 1) * 16 + swz / 64; C = (st & 1) * 32 + (swz % 64) / 2; }
__host__ __device__ __forceinline__ int perm32(int rho) { const int n = rho >> 4, i = rho & 15; return 8 * (i >> 2) + 4 * n + (i & 3); }

struct Unit { int pm, pn; };
struct Gemm { const bf16_t* A; const bf16_t* Bt; int M, N, K; };

struct StaticOrder {
    int nM, nN, nwg, G, c;
    __host__ __device__ void init(int M, int N, int G_, int c_) { nM = M / BM; nN = N / BM; nwg = nM * nN; G = G_; c = c_; }
    __host__ __device__ bool next(int i, Unit& u) const {
        const long L = (long)i * G + c; if (L >= nwg) return false;
        int wgid = (int)L; { const int q = nwg / NXCD, r = nwg % NXCD, xcd = wgid % NXCD, off = wgid / NXCD; wgid = (xcd < r ? xcd * (q + 1) : r * (q + 1) + (xcd - r) * q) + off; }
        const int nig = WGM * nN, gid = wgid / nig, fm = gid * WGM, gsz = (nM - fm) < WGM ? (nM - fm) : WGM;
        u.pm = fm + ((wgid % nig) % gsz); u.pn = (wgid % nig) / gsz; return true;
    }
    __device__ __forceinline__ void a_ready(const Unit&) const {}
    __device__ __forceinline__ void done(const Unit&) const {}
};

__device__ __forceinline__ unsigned cvt_pk_bf16(float lo, float hi) { unsigned r; asm volatile("v_cvt_pk_bf16_f32 %0, %1, %2" : "=v"(r) : "v"(lo), "v"(hi)); return r; }
template <class Epi, class Sched, bool ALIGN_EPI = false, bool SP2 = false>
__device__ __forceinline__ void gemm_phase(PG8_LAS unsigned char* lds, const Gemm g, const Sched& S, const Epi& E) {
    const int tid = threadIdx.x, wid = __builtin_amdgcn_readfirstlane(tid >> 6), lane = tid & 63, wr = wid >> 2, wc = wid & 3, fr = lane & 15, fq = lane >> 4;
    const int K = g.K, nt = K / BK;
    unsigned voffA[2], voffB[2];
#pragma unroll
    for (int i = 0; i < 2; ++i) { int R, C; stage_rc(tid * 16 + i * 8192, R, C); const int Rb = Epi::PERM ? ((R & ~31) + perm32(R & 31)) : R;
        voffA[i] = (unsigned)(R * K + C) * 2u; voffB[i] = (unsigned)(Rb * K + C) * 2u; }
    const size_t kstep = (size_t)(BK * 2);
    const size_t hstep = (size_t)HALF * K * 2;
    const size_t tstep = 2 * hstep;
    const unsigned ldsw = (unsigned)wid * 1024u;
    const int aoff = lds_byte(wr * 64 + fr, fq * 8), boff = lds_byte(wc * 32 + fr, fq * 8);
#define PG8_SA(b, h) (((b) * 2 + (h)) * HTB)
#define PG8_SB(b, h) ((4 + (b) * 2 + (h)) * HTB)
#define PG8_STAGE(bufoff, gbase, voff) do { _Pragma("unroll") for (int _i = 0; _i < 2; ++_i) \
        __builtin_amdgcn_global_load_lds((const unsigned*)((const char*)(gbase) + (voff)[_i]), (PG8_LAS unsigned*)(lds + (bufoff) + ldsw + _i * 8192), 16, 0, 0); } while (0)
#define PG8_LDA(dst, b, h) do { _Pragma("unroll") for (int m = 0; m < 4; ++m) _Pragma("unroll") for (int k = 0; k < 2; ++k) dst[m][k] = *(const PG8_LAS bf16x8*)(lds + PG8_SA(b, h) + aoff + m * 2048 + k * 1024); } while (0)
#define PG8_LDB(dst, b, h) do { _Pragma("unroll") for (int n = 0; n < 2; ++n) _Pragma("unroll") for (int k = 0; k < 2; ++k) dst[n][k] = *(const PG8_LAS bf16x8*)(lds + PG8_SB(b, h) + boff + n * 2048 + k * 1024); } while (0)
#define PG8_MMA(ai, bj, At, Bt) do { __builtin_amdgcn_s_setprio(1); _Pragma("unroll") for (int m = 0; m < 4; ++m) _Pragma("unroll") for (int n = 0; n < 2; ++n) _Pragma("unroll") for (int k = 0; k < 2; ++k) \
        acc[ai][bj][m][n] = __builtin_amdgcn_mfma_f32_16x16x32_bf16(Bt[n][k], At[m][k], acc[ai][bj][m][n], 0, 0, 0); __builtin_amdgcn_s_setprio(0); } while (0)
#define PG8_WAIT_V(n) asm volatile("s_waitcnt vmcnt(" #n ")" ::: "memory")
#define PG8_WAIT_L(n) asm volatile("s_waitcnt lgkmcnt(" #n ")" ::: "memory")
#define PG8_BAR __builtin_amdgcn_s_barrier()
#define PG8_SCHED __builtin_amdgcn_sched_barrier(0)
    Unit cur, nxt; int ui = 0;
    if (!S.next(0, cur)) return;
    f32x4 acc[2][2][4][2];
#pragma unroll
    for (int a = 0; a < 2; ++a)
#pragma unroll
        for (int b = 0; b < 2; ++b)
#pragma unroll
            for (int m = 0; m < 4; ++m)
#pragma unroll
                for (int n = 0; n < 2; ++n) acc[a][b][m][n] = (f32x4){0.f, 0.f, 0.f, 0.f};
    bf16x8 At[4][2], B0[2][2], B1[2][2];
    const char* cA = (const char*)g.A + (size_t)cur.pm * tstep; const char* cB = (const char*)g.Bt + (size_t)cur.pn * tstep;
    S.a_ready(cur);
    if constexpr (SP2) {
        PG8_STAGE(PG8_SB(0, 0), cB, voffB); PG8_STAGE(PG8_SB(0, 1), cB + hstep, voffB); PG8_STAGE(PG8_SA(0, 0), cA, voffA); PG8_STAGE(PG8_SA(0, 1), cA + hstep, voffA);
        if (wr == 1) PG8_BAR;
        PG8_WAIT_V(2); PG8_BAR;
        PG8_STAGE(PG8_SB(1, 0), cB + kstep, voffB); PG8_STAGE(PG8_SA(1, 0), cA + kstep, voffA); PG8_STAGE(PG8_SB(1, 1), cB + hstep + kstep, voffB);
        PG8_WAIT_V(6); PG8_BAR;
    } else {
        PG8_STAGE(PG8_SB(0, 0), cB, voffB); PG8_STAGE(PG8_SA(0, 0), cA, voffA); PG8_STAGE(PG8_SB(0, 1), cB + hstep, voffB); PG8_STAGE(PG8_SA(0, 1), cA + hstep, voffA);
        if (wr == 1) PG8_BAR;
        PG8_WAIT_V(4); PG8_BAR;
        PG8_STAGE(PG8_SB(1, 0), cB + kstep, voffB); PG8_STAGE(PG8_SA(1, 0), cA + kstep, voffA); PG8_STAGE(PG8_SB(1, 1), cB + hstep + kstep, voffB);
        PG8_WAIT_V(6); PG8_BAR;
    }
    for (;;) {
        const bool has_next = S.next(ui + 1, nxt);
        const char* nA = has_next ? (const char*)g.A + (size_t)nxt.pm * tstep : cA; const char* nB = has_next ? (const char*)g.Bt + (size_t)nxt.pn * tstep : cB;
        for (int t = 0; t < nt; t += 2) {
            const bool last = (t == nt - 2);
            const char* a1 = cA + (size_t)(t + 1) * kstep;
            const char* a2 = last ? nA : cA + (size_t)(t + 2) * kstep; const char* b2 = last ? nB : cB + (size_t)(t + 2) * kstep;
            const char* a3 = a2 + kstep; const char* b3 = b2 + kstep;
            if (last && has_next) S.a_ready(nxt);
            if constexpr (SP2) {
            PG8_LDB(B0, 0, 0); PG8_LDB(B1, 0, 1); PG8_SCHED; PG8_LDA(At, 0, 0); PG8_STAGE(PG8_SA(1, 1), a1 + hstep, voffA);
            PG8_WAIT_V(8); PG8_WAIT_L(0); PG8_BAR; PG8_MMA(0, 0, At, B0); PG8_MMA(0, 1, At, B1); PG8_BAR; PG8_SCHED;
            PG8_LDA(At, 0, 1); PG8_STAGE(PG8_SB(0, 0), b2, voffB); PG8_STAGE(PG8_SB(0, 1), b2 + hstep, voffB); PG8_STAGE(PG8_SA(0, 0), a2, voffA);
            PG8_WAIT_V(8); PG8_WAIT_L(0); PG8_BAR; PG8_MMA(1, 0, At, B0); PG8_MMA(1, 1, At, B1); PG8_BAR; PG8_SCHED;
            PG8_LDB(B0, 1, 0); PG8_LDB(B1, 1, 1); PG8_SCHED; PG8_LDA(At, 1, 0); PG8_STAGE(PG8_SA(0, 1), a2 + hstep, voffA);
            PG8_WAIT_V(8); PG8_WAIT_L(0); PG8_BAR; PG8_MMA(0, 0, At, B0); PG8_MMA(0, 1, At, B1); PG8_BAR; PG8_SCHED;
            PG8_LDA(At, 1, 1); PG8_STAGE(PG8_SB(1, 0), b3, voffB); PG8_STAGE(PG8_SB(1, 1), b3 + hstep, voffB); PG8_STAGE(PG8_SA(1, 0), a3, voffA);
            PG8_WAIT_V(8); PG8_WAIT_L(0); PG8_BAR; PG8_MMA(1, 0, At, B0); PG8_MMA(1, 1, At, B1); PG8_BAR; PG8_SCHED;
            } else {
            PG8_LDB(B0, 0, 0); PG8_SCHED; PG8_LDA(At, 0, 0); PG8_STAGE(PG8_SA(1, 1), a1 + hstep, voffA);
            PG8_WAIT_L(8); PG8_BAR; PG8_WAIT_L(0); PG8_MMA(0, 0, At, B0); PG8_BAR; PG8_SCHED;
            PG8_LDB(B1, 0, 1); PG8_STAGE(PG8_SB(0, 0), b2, voffB);
            PG8_BAR; PG8_WAIT_L(0); PG8_MMA(0, 1, At, B1); PG8_BAR;
            PG8_LDA(At, 0, 1); PG8_STAGE(PG8_SA(0, 0), a2, voffA);
            PG8_BAR; PG8_WAIT_L(0); PG8_MMA(1, 0, At, B0); PG8_BAR; PG8_SCHED;
            PG8_STAGE(PG8_SB(0, 1), b2 + hstep, voffB);
            PG8_WAIT_V(6); PG8_BAR; PG8_MMA(1, 1, At, B1); PG8_BAR;
            PG8_LDB(B0, 1, 0); PG8_SCHED; PG8_LDA(At, 1, 0); PG8_STAGE(PG8_SA(0, 1), a2 + hstep, voffA);
            PG8_WAIT_L(8); PG8_BAR; PG8_WAIT_L(0); PG8_MMA(0, 0, At, B0); PG8_BAR; PG8_SCHED;
            PG8_LDB(B1, 1, 1); PG8_STAGE(PG8_SB(1, 0), b3, voffB);
            PG8_BAR; PG8_WAIT_L(0); PG8_MMA(0, 1, At, B1); PG8_BAR;
            PG8_LDA(At, 1, 1); PG8_STAGE(PG8_SA(1, 0), a3, voffA);
            PG8_BAR; PG8_WAIT_L(0); PG8_MMA(1, 0, At, B0); PG8_BAR; PG8_SCHED;
            PG8_STAGE(PG8_SB(1, 1), b3 + hstep, voffB);
            PG8_WAIT_V(6); PG8_BAR; PG8_MMA(1, 1, At, B1); PG8_BAR;
            }
        }
        if constexpr (ALIGN_EPI) { if (wr == 0) PG8_BAR; }
        if constexpr (!Epi::AFTER_DRAIN) { E(acc, cur, wr, wc, fr, fq); S.done(cur); }
        if (!has_next) break;
#pragma unroll
        for (int a = 0; a < 2; ++a)
#pragma unroll
            for (int b = 0; b < 2; ++b)
#pragma unroll
                for (int m = 0; m < 4; ++m)
#pragma unroll
                    for (int n = 0; n < 2; ++n) acc[a][b][m][n] = (f32x4){0.f, 0.f, 0.f, 0.f};
        cur = nxt; cA = nA; cB = nB; ++ui;
        if constexpr (ALIGN_EPI) { if (wr == 1) PG8_BAR; }
    }
    PG8_WAIT_V(0);
    if constexpr (!ALIGN_EPI) { if (wr == 0) PG8_BAR; }
    PG8_BAR;
    if constexpr (Epi::AFTER_DRAIN) { E.fused(acc, cur, wr, wc, fr, fq, lds, wid, lane); S.done(cur); }
#undef PG8_SA
#undef PG8_SB
#undef PG8_STAGE
#undef PG8_LDA
#undef PG8_LDB
#undef PG8_MMA
#undef PG8_WAIT_V
#undef PG8_WAIT_L
#undef PG8_BAR
#undef PG8_SCHED
}
}
#define GAS __attribute__((address_space(1)))
#define LAS __attribute__((address_space(3)))
typedef unsigned short bf16;
typedef unsigned v4u __attribute__((ext_vector_type(4)));
typedef float f32x4 __attribute__((ext_vector_type(4)));
typedef short bf16x8 __attribute__((ext_vector_type(8)));
typedef GAS unsigned gu32;
typedef GAS unsigned long long gu64;
#define RLX_AGENT __ATOMIC_RELAXED, __HIP_MEMORY_SCOPE_AGENT
#define LDS_WAIT() asm volatile("s_waitcnt lgkmcnt(0)" ::: "memory")
#define VM_WAIT() asm volatile("s_waitcnt vmcnt(0)" ::: "memory")
__device__ __forceinline__ unsigned long long rt() { return __builtin_amdgcn_s_memrealtime(); }
__device__ __forceinline__ unsigned f2bf(float f) { unsigned u = __builtin_bit_cast(unsigned, f); return (u + 0x7fffu + ((u >> 16) & 1u)) >> 16; }
__device__ __forceinline__ unsigned pk2(float lo, float hi) { return f2bf(lo) | (f2bf(hi) << 16); }

#define XB_TMO      128
#define XB_XCNT(j)  (256  + 64 * (j))
#define XB_XSUB(j)  (1280 + 64 * (j))
#define XB_XGEN(j)  (2304 + 64 * (j))
#define XB_TOP      3328
#define XB_TOPGEN   3392
#define XCD_BAR_WORDS 3456
#define XB_SPIN_CAP (1u << 18)

__device__ __forceinline__ unsigned xb_ld(unsigned* p)              { return __hip_atomic_load(p, __ATOMIC_RELAXED, __HIP_MEMORY_SCOPE_AGENT); }
__device__ __forceinline__ unsigned xb_add(unsigned* p, unsigned v) { return __hip_atomic_fetch_add(p, v, __ATOMIC_RELAXED, __HIP_MEMORY_SCOPE_AGENT); }
__device__ __forceinline__ unsigned xb_xcc_id() { return (unsigned)__builtin_amdgcn_s_getreg((3 << 11) | 20) & 0xFu; }
#define XB_SPIN(cond, bar) do { unsigned _sp = 0; while (cond) { __builtin_amdgcn_s_sleep(1); \
    if ((++_sp & 255u) == 0u) { if (xb_ld(&(bar)[XB_TMO])) break; if (_sp > XB_SPIN_CAP) { atomicAdd(&(bar)[XB_TMO], 1u); break; } } } } while (0)

struct XcdBarrier {
    unsigned* bar; unsigned x;
    volatile LAS unsigned* st;
};

__device__ __forceinline__ XcdBarrier xcd_barrier_post(unsigned* bar, volatile LAS unsigned* st) {
    XcdBarrier b; b.bar = bar; b.x = xb_xcc_id(); b.st = st;
    if (threadIdx.x == 0) (void)xb_add(&bar[XB_XCNT(b.x)], 1u);
    return b;
}
__device__ __forceinline__ void xcd_barrier_complete(unsigned* bar, unsigned x, unsigned& nloc, unsigned& nx) {
    const unsigned G = gridDim.x * gridDim.y * gridDim.z;
    unsigned sum, cnt, mine, sp = 0u;
    for (;;) {
        sum = 0u; cnt = 0u; mine = 0u;
#pragma unroll
        for (unsigned j = 0; j < 16; ++j) { const unsigned c = xb_ld(&bar[XB_XCNT(j)]); sum += c; cnt += (c > 0u) ? 1u : 0u; mine = (j == x) ? c : mine; }
        if (sum == G) break;
        __builtin_amdgcn_s_sleep(1);
        if ((++sp & 255u) == 0u) { if (xb_ld(&bar[XB_TMO])) break; if (sp > XB_SPIN_CAP) { atomicAdd(&bar[XB_TMO], 1u); break; } }
    }
    nloc = mine > 0u ? mine : 1u; nx = cnt > 0u ? cnt : 1u;
}

__device__ __forceinline__ void xcd_barrier(const XcdBarrier& b) {
    asm volatile("s_waitcnt vmcnt(0)" ::: "memory");
    __syncthreads();
    if (threadIdx.x == 0) {
        unsigned* bar = b.bar;
        __builtin_amdgcn_s_waitcnt(0);
        unsigned nloc = b.st[0], nx = b.st[1];
        if (nloc == 0u) { xcd_barrier_complete(bar, b.x, nloc, nx); b.st[0] = nloc; b.st[1] = nx; }
        const unsigned old = xb_add(&bar[XB_XSUB(b.x)], 1u);
        const unsigned gen = old / nloc;
        if (old + 1u == (gen + 1u) * nloc) {
            __builtin_amdgcn_fence(__ATOMIC_RELEASE, "agent");
            asm volatile("s_waitcnt vmcnt(0)" ::: "memory");
            const unsigned og = xb_add(&bar[XB_TOP], 1u);
            const unsigned tg = og / nx;
            if (og + 1u == (tg + 1u) * nx) xb_add(&bar[XB_TOPGEN], 1u);
            else XB_SPIN(xb_ld(&bar[XB_TOPGEN]) == tg, bar);
            __builtin_amdgcn_fence(__ATOMIC_ACQUIRE, "agent");
            xb_add(&bar[XB_XGEN(b.x)], 1u);
            asm volatile("s_waitcnt vmcnt(0)" ::: "memory");
        } else {
            XB_SPIN(xb_ld(&bar[XB_XGEN(b.x)]) == gen, bar);
            __builtin_amdgcn_fence(__ATOMIC_ACQUIRE, "agent");
            asm volatile("s_waitcnt vmcnt(0)" ::: "memory");
        }
    }
    __syncthreads();
}


#ifndef STAGE
#define STAGE 3
#endif
#ifndef N_LAUNCH_MODE
#define N_LAUNCH_MODE 1
#endif
#ifndef DBG_C
#define DBG_C 0.0f
#endif

typedef float f32x16 __attribute__((ext_vector_type(16)));
typedef __attribute__((ext_vector_type(2))) __bf16 bf16x2_t;
using pg8::bf16_t; using pg8::Unit;

constexpr int M = 16384, DM = 1024, NHEAD = 8, HD = 64, AW = 512, PW = 512, FF = 2816, FF2 = 5632, NIN = 4420, NINP = 4608, NMOD = 6144;
constexpr float EPS = 1e-6f;
constexpr int NWAVES = 8, NTHR = 512;

constexpr size_t MiB = 1u << 20;
constexpr size_t WS_CTL = 0, CTL_ZERO_BYTES = 64 * 1024;
constexpr size_t WS_WIN = 1 * MiB, WS_WATTN = 10 * MiB, WS_WGRP = 11 * MiB, WS_WPOOL = 11 * MiB + 512 * 1024, WS_WOUT = 12 * MiB + 512 * 1024,
                 WS_WUP = 14 * MiB + 512 * 1024, WS_WDOWN = 25 * MiB + 512 * 1024;
constexpr size_t WS_MODP = 31 * MiB, WS_MODF = 31 * MiB + 393216, WS_WI = 31 * MiB + 512 * 1024;
constexpr size_t WS_H = 32 * MiB;
constexpr size_t WS_Q = 64 * MiB, WS_K = 80 * MiB, WS_V = 96 * MiB;
constexpr size_t WS_QI = 112 * MiB, WS_KI = 120 * MiB;
constexpr size_t WS_UPOOL = 128 * MiB, WS_POOLED = 144 * MiB, WS_POOLMIX = 160 * MiB, WS_ATTN = 176 * MiB;
constexpr size_t WS_GA = 192 * MiB, WS_GP = 224 * MiB;
constexpr size_t WS_ACT = 64 * MiB;
constexpr size_t WS_RAW = 152 * MiB;
constexpr size_t WS_END = 256 * MiB;
constexpr int CW_BAR = 1024;

constexpr int LDS_BYTES = 163840;
constexpr int HSTRIDE = 1025;
constexpr int LIST_OFF = 135168, ST_OFF = 151552, MISC_OFF = 159744;

#define SYNC() __syncthreads()
__device__ __forceinline__ float wave_sum(float v) {
#pragma unroll
    for (int o = 1; o < 64; o <<= 1) v += __shfl_xor(v, o);
    return v;
}
__device__ __forceinline__ float bf_lo(unsigned w) { return __builtin_bit_cast(float, w << 16); }
__device__ __forceinline__ float bf_hi(unsigned w) { return __builtin_bit_cast(float, w & 0xffff0000u); }
__device__ __forceinline__ float sigmoidf_(float x) { return 1.0f / (1.0f + __expf(-x)); }
__device__ __forceinline__ unsigned pkbf(float lo, float hi) { return pg8::cvt_pk_bf16(lo, hi); }
typedef unsigned u32x2 __attribute__((ext_vector_type(2)));
__device__ __forceinline__ u32x2 pk4(f32x4 v) { u32x2 r; r.x = pkbf(v[0], v[1]); r.y = pkbf(v[2], v[3]); return r; }

__device__ __forceinline__ void tr_item(const float* W, int ldw, int src_col, int nvalid, int k0, bf16_t* WT, int K, int dst_row, LAS float* scr, int lane) {
#pragma unroll 8
    for (int i = 0; i < 32; ++i) { const int kk = 2 * i + (lane >> 5), n = lane & 31;
        float v = 0.f; if (W != nullptr && n < nvalid) v = W[(size_t)(k0 + kk) * ldw + src_col + n];
        scr[kk * 33 + n] = v; }
    LDS_WAIT(); asm volatile("" ::: "memory");
    const int c = lane & 7;
#pragma unroll
    for (int j = 0; j < 4; ++j) { const int n = (lane >> 3) + 8 * j; const LAS float* s = scr + (8 * c) * 33 + n;
        v4u o; o.x = pk2(s[0 * 33], s[1 * 33]); o.y = pk2(s[2 * 33], s[3 * 33]); o.z = pk2(s[4 * 33], s[5 * 33]); o.w = pk2(s[6 * 33], s[7 * 33]);
        *(GAS v4u*)(WT + (size_t)(dst_row + n) * K + k0 + 8 * c) = o; }
    LDS_WAIT(); asm volatile("" ::: "memory");
}

struct P0Ptrs { const float *c, *w_ada, *w_in, *w_attn, *w_grp, *w_pool, *w_out, *w_up, *w_down; bf16_t *WIN, *WATTN, *WGRP, *WPOOL, *WOUT, *WUP, *WDOWN; float* MODP; };
__device__ __forceinline__ void p0_prologue(const P0Ptrs& P, LAS unsigned char* lds, int gw, int NGW, int wave, int lane) {
    LAS float* scr = (LAS float*)(lds + wave * 16384);
    constexpr int I_WIN = 144 * 16, I_WATTN = 32 * 8, I_WGRP = 16 * 8, I_WPOOL = 32 * 8, I_WOUT = 32 * 16, I_WUP = 176 * 16, I_WDOWN = 32 * 44, I_MOD = 96 * 16;
    constexpr int NITEMS = I_WIN + I_WATTN + I_WGRP + I_WPOOL + I_WOUT + I_WUP + I_WDOWN + I_MOD;
    for (int it = gw; it < NITEMS; it += NGW) {
        int r = it;
        if (r < I_MOD) {
            const int cb = r % 96, kc = r / 96, col = cb * 64 + lane; float acc = 0.f;
#pragma unroll 8
            for (int i = 0; i < 64; ++i) { const int k = kc * 64 + i; const float cv = P.c[k]; const float sv = cv / (1.0f + __expf(-cv)); acc = fmaf(sv, P.w_ada[(size_t)k * NMOD + col], acc); }
            P.MODP[kc * NMOD + col] = acc; continue; }
        r -= I_MOD;
        if (r < I_WIN) { const int g = r / 16, kb = r % 16, tile = g >> 3, gi = g & 7; int src = -1, nv = 32;
            const int permgi = gi < 4 ? 64 * gi : 64 * (gi - 4) + 32;
            if (tile < 2) src = tile * 256 + permgi;
            else if (tile < 4) src = 512 + (tile - 2) * 256 + permgi;
            else if (tile < 6) src = 1024 + (tile - 4) * 256 + 32 * gi;
            else if (tile == 6) src = 1536 + 32 * gi;
            else if (tile == 7) { if (gi < 2) src = 1792 + 32 * gi; else if (gi == 2) { src = 1856; nv = 4; } }
            else if (tile < 10) src = 1860 + (tile - 8) * 256 + 32 * gi;
            else if (tile < 14) src = 2372 + (tile - 10) * 256 + 32 * gi;
            else src = 3396 + (tile - 14) * 256 + 32 * gi;
            tr_item(src >= 0 ? P.w_in : nullptr, NIN, src >= 0 ? src : 0, nv, kb * 64, P.WIN, 1024, g * 32, scr, lane); continue; }
        r -= I_WIN;
        if (r < I_WATTN) { tr_item(P.w_attn, 1024, (r / 8) * 32, 32, (r % 8) * 64, P.WATTN, 512, (r / 8) * 32, scr, lane); continue; }
        r -= I_WATTN;
        if (r < I_WGRP) { const int g = r / 8, kb = r % 8, grp = g >> 2;
            const bool nz = (kb >> 1) == grp;
            tr_item(nz ? P.w_grp + (size_t)grp * 128 * 128 : nullptr, 128, (g & 3) * 32, 32, (kb & 1) * 64, P.WGRP + (size_t)(kb >> 1) * 128, 512, g * 32, scr, lane);
            continue; }
        r -= I_WGRP;
        if (r < I_WPOOL) { tr_item(P.w_pool, 1024, (r / 8) * 32, 32, (r % 8) * 64, P.WPOOL, 512, (r / 8) * 32, scr, lane); continue; }
        r -= I_WPOOL;
        if (r < I_WOUT) { tr_item(P.w_out, 1024, (r / 16) * 32, 32, (r % 16) * 64, P.WOUT, 1024, (r / 16) * 32, scr, lane); continue; }
        r -= I_WOUT;
        if (r < I_WUP) { const int g = r / 16, kb = r % 16, tile = g >> 3, gi = g & 7;
            const int src = gi < 4 ? 128 * tile + 32 * gi : FF + 128 * tile + 32 * (gi - 4);
            tr_item(P.w_up, FF2, src, 32, kb * 64, P.WUP, 1024, g * 32, scr, lane); continue; }
        r -= I_WUP;
        { tr_item(P.w_down, 1024, (r / 44) * 32, 32, (r % 44) * 64, P.WDOWN, FF, (r / 44) * 32, scr, lane); }
    }
}

__device__ __forceinline__ void modulate_rows(const float* X, bf16_t* O, const LAS float* mulv, const LAS float* addv, int gw, int NGW, int lane) {
    f32x4 mu[4], ad[4];
#pragma unroll
    for (int j = 0; j < 4; ++j) { mu[j] = *(const LAS f32x4*)(mulv + 4 * lane + 256 * j); ad[j] = *(const LAS f32x4*)(addv + 4 * lane + 256 * j); }
    for (int row = gw; row < M; row += NGW) {
        const GAS f32x4* xr = (const GAS f32x4*)(X + (size_t)row * DM) + lane;
        f32x4 v[4]; float s = 0.f;
#pragma unroll
        for (int j = 0; j < 4; ++j) { v[j] = xr[64 * j]; s += (v[j].x * v[j].x + v[j].y * v[j].y) + (v[j].z * v[j].z + v[j].w * v[j].w); }
        const float rstd = 1.0f / sqrtf(wave_sum(s) * (1.0f / DM) + EPS);
        GAS u32x2* o8 = (GAS u32x2*)(O + (size_t)row * DM) + lane;
#pragma unroll
        for (int j = 0; j < 4; ++j) { const f32x4 y = v[j] * rstd * mu[j] + ad[j]; o8[64 * j] = pk4(y); }
    }
}

struct EpiProj {
    static constexpr bool PERM = false, AFTER_DRAIN = false;
    bf16_t *Q, *Kb, *V, *QI, *KI, *UPOOL, *GA, *GP; float* WI; const float *qg, *kg;
    __device__ __forceinline__ void operator()(const pg8::f32x4 (&acc)[2][2][4][2], const Unit& u, int wr, int wc, int fr, int fq) const {
        const int pn = u.pn, row0 = u.pm * 256 + wr * 64 + fr;
        if (pn < 4) {
            bf16_t* O = pn < 2 ? Q : Kb; const float* g = pn < 2 ? qg : kg; const int head = (pn & 1) * 4 + wc;
            f32x4 gv[2][2];
#pragma unroll
            for (int bj = 0; bj < 2; ++bj)
#pragma unroll
                for (int n = 0; n < 2; ++n) gv[bj][n] = *(const f32x4*)(g + 32 * bj + 16 * n + 4 * fq);
#pragma unroll
            for (int ai = 0; ai < 2; ++ai)
#pragma unroll
                for (int m = 0; m < 4; ++m) {
                    float ss = 0.f;
#pragma unroll
                    for (int bj = 0; bj < 2; ++bj)
#pragma unroll
                        for (int n = 0; n < 2; ++n) { const f32x4 x = acc[ai][bj][m][n]; ss += (x[0] * x[0] + x[1] * x[1]) + (x[2] * x[2] + x[3] * x[3]); }
                    ss += __shfl_xor(ss, 16); ss += __shfl_xor(ss, 32);
                    const float rstd = 1.0f / sqrtf(ss * (1.0f / 64.0f) + EPS);
                    bf16_t* rowp = O + (size_t)(row0 + ai * 128 + m * 16) * AW + head * 64 + 4 * fq;
#pragma unroll
                    for (int bj = 0; bj < 2; ++bj)
#pragma unroll
                        for (int n = 0; n < 2; ++n) { const f32x4 y = acc[ai][bj][m][n] * rstd * gv[bj][n]; *(u32x2*)(rowp + 32 * bj + 16 * n) = pk4(y); }
                }
            return;
        }
        const int colw = wc * 32 + 4 * fq;
        if (pn == 7) {
#pragma unroll
            for (int ai = 0; ai < 2; ++ai)
#pragma unroll
                for (int m = 0; m < 4; ++m) { const int row = row0 + ai * 128 + m * 16;
                    if (wc < 2) {
#pragma unroll
                        for (int n = 0; n < 2; ++n) *(u32x2*)(KI + (size_t)row * 64 + colw + 16 * n) = pk4(acc[ai][0][m][n]);
                    } else if (wc == 2 && fq == 0) { *(f32x4*)(WI + (size_t)row * 4) = acc[ai][0][m][0] * 0.5f; }
                }
            return;
        }
        bf16_t* O; int ldo, ct; float sc = 1.0f; bool sig = false;
        if (pn < 6) { O = V; ldo = AW; ct = (pn - 4) * 256; }
        else if (pn == 6) { O = QI; ldo = 256; ct = 0; sc = 0.125f; }
        else if (pn < 10) { O = UPOOL; ldo = PW; ct = (pn - 8) * 256; }
        else if (pn < 14) { O = GA; ldo = DM; ct = (pn - 10) * 256; sig = true; }
        else { O = GP; ldo = DM; ct = (pn - 14) * 256; sig = true; }
#pragma unroll
        for (int ai = 0; ai < 2; ++ai)
#pragma unroll
            for (int m = 0; m < 4; ++m) { bf16_t* rowp = O + (size_t)(row0 + ai * 128 + m * 16) * ldo + ct + colw;
#pragma unroll
                for (int bj = 0; bj < 2; ++bj)
#pragma unroll
                    for (int n = 0; n < 2; ++n) { f32x4 y = acc[ai][bj][m][n] * sc;
                        if (sig) { y[0] = sigmoidf_(y[0]); y[1] = sigmoidf_(y[1]); y[2] = sigmoidf_(y[2]); y[3] = sigmoidf_(y[3]); }
                        *(u32x2*)(rowp + 128 * bj + 16 * n) = pk4(y); }
            }
    }
};

template <int MODE> struct EpiBf {
    static constexpr bool PERM = false, AFTER_DRAIN = false;
    bf16_t* O; int ldo; const float* colscale; const bf16_t* ADD;
    __device__ __forceinline__ void operator()(const pg8::f32x4 (&acc)[2][2][4][2], const Unit& u, int wr, int wc, int fr, int fq) const {
        const int row0 = u.pm * 256 + wr * 64 + fr, col0 = u.pn * 256 + wc * 32 + 4 * fq;
#pragma unroll
        for (int ai = 0; ai < 2; ++ai)
#pragma unroll
            for (int m = 0; m < 4; ++m) { const size_t ro = (size_t)(row0 + ai * 128 + m * 16) * ldo + col0;
#pragma unroll
                for (int bj = 0; bj < 2; ++bj)
#pragma unroll
                    for (int n = 0; n < 2; ++n) { f32x4 y = acc[ai][bj][m][n]; const size_t off = ro + 128 * bj + 16 * n;
                        if (MODE == 0) { y = y * *(const f32x4*)(colscale + col0 + 128 * bj + 16 * n); }
                        else { const u32x2 gq = *(const u32x2*)(O + off); y[0] *= bf_lo(gq.x); y[1] *= bf_hi(gq.x); y[2] *= bf_lo(gq.y); y[3] *= bf_hi(gq.y);
                            if (MODE == 2) { const u32x2 a = *(const u32x2*)(ADD + off); y[0] += bf_lo(a.x); y[1] += bf_hi(a.x); y[2] += bf_lo(a.y); y[3] += bf_hi(a.y); } }
                        *(u32x2*)(O + off) = pk4(y); }
            }
    }
};

struct EpiRes {
    static constexpr bool PERM = false, AFTER_DRAIN = false;
    const float* BASE; float* OUT; const float* gate; float dbg;
    __device__ __forceinline__ void operator()(const pg8::f32x4 (&acc)[2][2][4][2], const Unit& u, int wr, int wc, int fr, int fq) const {
        const int row0 = u.pm * 256 + wr * 64 + fr, col0 = u.pn * 256 + wc * 32 + 4 * fq;
        f32x4 gv[2][2];
#pragma unroll
        for (int bj = 0; bj < 2; ++bj)
#pragma unroll
            for (int n = 0; n < 2; ++n) gv[bj][n] = *(const f32x4*)(gate + col0 + 128 * bj + 16 * n);
#pragma unroll
        for (int ai = 0; ai < 2; ++ai)
#pragma unroll
            for (int m = 0; m < 4; ++m) { const int row = row0 + ai * 128 + m * 16; const size_t ro = (size_t)row * DM + col0;
#pragma unroll
                for (int bj = 0; bj < 2; ++bj)
#pragma unroll
                    for (int n = 0; n < 2; ++n) { const size_t off = ro + 128 * bj + 16 * n; f32x4 y = *(const f32x4*)(BASE + off) + gv[bj][n] * acc[ai][bj][m][n];
                        if (dbg != 0.f) { const float sg = ((row * 7 + (int)(off >> 2)) & 1) ? dbg : -dbg; y[0] += sg; y[1] -= sg; y[2] += sg; y[3] -= sg; }
                        *(f32x4*)(OUT + off) = y; }
            }
    }
};

template <int CTRL> __device__ __forceinline__ float dppf(float x) { return __builtin_bit_cast(float, __builtin_amdgcn_update_dpp(0, __builtin_bit_cast(int, x), CTRL, 0xf, 0xf, false)); }
__device__ __forceinline__ f32x4 ror1(f32x4 v) { f32x4 r; r[0] = dppf<0x121>(v[0]); r[1] = dppf<0x121>(v[1]); r[2] = dppf<0x121>(v[2]); r[3] = dppf<0x121>(v[3]); return r; }
__device__ __forceinline__ f32x4 ror2(f32x4 v) { f32x4 r; r[0] = dppf<0x122>(v[0]); r[1] = dppf<0x122>(v[1]); r[2] = dppf<0x122>(v[2]); r[3] = dppf<0x122>(v[3]); return r; }
__device__ __forceinline__ f32x4 silu_mul(f32x4 a, f32x4 b) { f32x4 r;
#pragma unroll
    for (int e = 0; e < 4; ++e) r[e] = a[e] / (1.0f + __expf(-a[e])) * b[e];
    return r; }
struct EpiUpAct {
    static constexpr bool PERM = false, AFTER_DRAIN = false;
    bf16_t* ACT; float* RAW; const float* cw; const float* cb;
    __device__ __forceinline__ void operator()(const pg8::f32x4 (&acc)[2][2][4][2], const Unit& u, int wr, int wc, int fr, int fq) const {
#pragma unroll
        for (int n = 0; n < 2; ++n) {
            const int ch = u.pn * 128 + wc * 32 + 4 * fq + 16 * n;
            const f32x4 w0a = *(const f32x4*)(cw + ch), w1a = *(const f32x4*)(cw + FF2 + ch), w2a = *(const f32x4*)(cw + 2 * FF2 + ch), ba = *(const f32x4*)(cb + ch);
            const f32x4 w0b = *(const f32x4*)(cw + FF + ch), w1b = *(const f32x4*)(cw + FF2 + FF + ch), w2b = *(const f32x4*)(cw + 2 * FF2 + FF + ch), bb = *(const f32x4*)(cb + FF + ch);
#pragma unroll
            for (int ai = 0; ai < 2; ++ai) {
                const int blk = u.pm * 4 + ai * 2 + wr;
                if (fr < 2) { *(f32x4*)(RAW + (size_t)(blk * 4 + fr) * FF2 + ch) = acc[ai][0][0][n]; *(f32x4*)(RAW + (size_t)(blk * 4 + fr) * FF2 + FF + ch) = acc[ai][1][0][n]; }
                if (fr >= 14) { *(f32x4*)(RAW + (size_t)(blk * 4 + fr - 12) * FF2 + ch) = acc[ai][0][3][n]; *(f32x4*)(RAW + (size_t)(blk * 4 + fr - 12) * FF2 + FF + ch) = acc[ai][1][3][n]; }
                f32x4 pa1 = {0.f, 0.f, 0.f, 0.f}, pa2 = pa1, pb1 = pa1, pb2 = pa1;
#pragma unroll
                for (int m = 0; m < 4; ++m) {
                    const f32x4 va = acc[ai][0][m][n], vb = acc[ai][1][m][n];
                    const f32x4 ra1 = ror1(va), ra2 = ror2(va), rb1 = ror1(vb), rb2 = ror2(vb);
                    const f32x4 xa1 = fr >= 1 ? ra1 : pa1, xa2 = fr >= 2 ? ra2 : pa2, xb1 = fr >= 1 ? rb1 : pb1, xb2 = fr >= 2 ? rb2 : pb2;
                    pa1 = ra1; pa2 = ra2; pb1 = rb1; pb2 = rb2;
                    const f32x4 ya = ba + w0a * xa2 + w1a * xa1 + w2a * va, yb = bb + w0b * xb2 + w1b * xb1 + w2b * vb;
                    const f32x4 o = silu_mul(ya, yb);
                    if (!(m == 0 && fr < 2)) *(u32x2*)(ACT + (size_t)(blk * 64 + 16 * m + fr) * FF + ch) = pk4(o);
                }
            }
        }
    }
};

__device__ __forceinline__ void fixup_phase(const float* RAW, bf16_t* ACT, const float* cw, const float* cb, int gtid, int nthr) {
    for (int it = gtid; it < 256 * 2 * 704; it += nthr) {
        const int c4 = it % 704, rr = (it / 704) & 1, blk = it / 1408, ch = 4 * c4;
        const float* cur = RAW + (size_t)(blk * 4 + rr) * FF2;
        const float* p1 = rr == 1 ? RAW + (size_t)(blk * 4) * FF2 : (blk > 0 ? RAW + (size_t)((blk - 1) * 4 + 3) * FF2 : nullptr);
        const float* p2 = rr == 1 ? (blk > 0 ? RAW + (size_t)((blk - 1) * 4 + 3) * FF2 : nullptr) : (blk > 0 ? RAW + (size_t)((blk - 1) * 4 + 2) * FF2 : nullptr);
        const f32x4 z = {0.f, 0.f, 0.f, 0.f};
        const f32x4 va = *(const f32x4*)(cur + ch), vb = *(const f32x4*)(cur + FF + ch);
        const f32x4 a1 = p1 ? *(const f32x4*)(p1 + ch) : z, b1 = p1 ? *(const f32x4*)(p1 + FF + ch) : z;
        const f32x4 a2 = p2 ? *(const f32x4*)(p2 + ch) : z, b2 = p2 ? *(const f32x4*)(p2 + FF + ch) : z;
        const f32x4 ya = *(const f32x4*)(cb + ch) + *(const f32x4*)(cw + ch) * a2 + *(const f32x4*)(cw + FF2 + ch) * a1 + *(const f32x4*)(cw + 2 * FF2 + ch) * va;
        const f32x4 yb = *(const f32x4*)(cb + FF + ch) + *(const f32x4*)(cw + FF + ch) * b2 + *(const f32x4*)(cw + FF2 + FF + ch) * b1 + *(const f32x4*)(cw + 2 * FF2 + FF + ch) * vb;
        *(u32x2*)(ACT + (size_t)(blk * 64 + rr) * FF + ch) = pk4(silu_mul(ya, yb));
    }
}

__device__ __forceinline__ void pooled_phase(const bf16_t* UPOOL, bf16_t* POOLED, int gtid, int nthr) {
    for (int it = gtid; it < M * 64; it += nthr) {
        const int t = it >> 6, c8 = it & 63, g = c8 >> 4, w = 2 << g, cntw = (t + 1) < w ? (t + 1) : w;
        float s[8], self[8];
#pragma unroll
        for (int e = 0; e < 8; ++e) s[e] = 0.f;
        for (int j = 0; j < cntw; ++j) { const v4u v = *(const v4u*)(UPOOL + (size_t)(t - j) * PW + 8 * c8);
            const float f[8] = {bf_lo(v.x), bf_hi(v.x), bf_lo(v.y), bf_hi(v.y), bf_lo(v.z), bf_hi(v.z), bf_lo(v.w), bf_hi(v.w)};
#pragma unroll
            for (int e = 0; e < 8; ++e) { s[e] += f[e]; if (j == 0) self[e] = f[e]; } }
        const float inv = 1.0f / (float)cntw; v4u o;
        o.x = pkbf(s[0] * inv - self[0], s[1] * inv - self[1]); o.y = pkbf(s[2] * inv - self[2], s[3] * inv - self[3]);
        o.z = pkbf(s[4] * inv - self[4], s[5] * inv - self[5]); o.w = pkbf(s[6] * inv - self[6], s[7] * inv - self[7]);
        *(v4u*)(POOLED + (size_t)t * PW + 8 * c8) = o;
    }
}

#define MFMA32(a, b, c) __builtin_amdgcn_mfma_f32_32x32x16_bf16((a), (b), (c), 0, 0, 0)
__device__ __forceinline__ unsigned lds_add(LAS unsigned* p, unsigned v) { return __hip_atomic_fetch_add(p, v, __ATOMIC_RELAXED, __HIP_MEMORY_SCOPE_WORKGROUP); }
__device__ __forceinline__ unsigned lds_or(LAS unsigned* p, unsigned v) { return __hip_atomic_fetch_or(p, v, __ATOMIC_RELAXED, __HIP_MEMORY_SCOPE_WORKGROUP); }

template <int LEVEL>
__device__ __forceinline__ void tk_pass(int qb, int wave, int lane, const bf16_t* KI, const pg8::bf16x8 (&qf)[4][4], const float (&wv)[4], LAS unsigned* H, LAS unsigned* SELM, LAS unsigned* TIEM, unsigned pref) {
    const int r = lane & 31, h = lane >> 5;
    for (int T = wave; T <= qb; T += NWAVES) {
        pg8::bf16x8 kf[4];
        const bf16_t* kp = KI + (size_t)(T * 32 + r) * 64 + 8 * h;
#pragma unroll
        for (int s = 0; s < 4; ++s) kf[s] = *(const pg8::bf16x8*)(kp + 16 * s);
        float sc[16];
#pragma unroll
        for (int i = 0; i < 16; ++i) sc[i] = 0.f;
#pragma unroll
        for (int hd = 0; hd < 4; ++hd) { f32x16 a;
#pragma unroll
            for (int i = 0; i < 16; ++i) a[i] = 0.f;
#pragma unroll
            for (int s = 0; s < 4; ++s) a = MFMA32(kf[s], qf[hd][s], a);
#pragma unroll
            for (int i = 0; i < 16; ++i) sc[i] = fmaf(wv[hd], fmaxf(a[i], 0.f), sc[i]); }
        const bool diag = (T == qb);
#pragma unroll
        for (int i = 0; i < 16; ++i) {
            const int kr = (i & 3) + 8 * (i >> 2) + 4 * h;
            bool ok = !diag || (kr <= r);
            unsigned uu = __builtin_bit_cast(unsigned, sc[i]); uu ^= ((unsigned)((int)uu >> 31)) | 0x80000000u;
            if (LEVEL < 3) { unsigned d;
                if (LEVEL == 0) d = uu >> 21;
                else if (LEVEL == 1) { ok = ok && ((uu >> 21) == pref); d = (uu >> 10) & 2047u; }
                else { ok = ok && ((uu >> 10) == pref); d = uu & 1023u; }
                if (ok) lds_add(H + r * HSTRIDE + (d >> 1), 1u << ((d & 1u) * 16u));
            } else {
                const int key = T * 32 + kr;
                if (ok && uu > pref) lds_or(SELM + r * 512 + (key >> 5), 1u << (key & 31));
                else if (ok && uu == pref) lds_or(TIEM + r * 512 + (key >> 5), 1u << (key & 31));
            }
        }
    }
}

__device__ __forceinline__ void tk_scan(const LAS unsigned* Hq, LAS unsigned* pref_p, LAS unsigned* need_p, int bits, int lane) {
    const unsigned need = *need_p;
    unsigned wd[16]; unsigned S = 0;
#pragma unroll
    for (int i = 0; i < 16; ++i) { wd[i] = Hq[16 * lane + i]; S += (wd[i] & 0xffffu) + (wd[i] >> 16); }
    unsigned incl = S;
#pragma unroll
    for (int off = 1; off < 64; off <<= 1) { const unsigned t = __shfl_down(incl, off); if (lane + off < 64) incl += t; }
    const unsigned Tabove = incl - S;
    const bool hit = (Tabove < need) && (need <= Tabove + S);
    unsigned rem = need - Tabove, D = 0, nn = 1; bool found = false;
#pragma unroll
    for (int b = 31; b >= 0; --b) { const unsigned c = (wd[b >> 1] >> (16 * (b & 1))) & 0xffffu;
        if (!found) { if (c >= rem) { found = true; D = 32u * lane + b; nn = rem; } else rem -= c; } }
    const unsigned long long mk = __ballot(hit);
    const int L = mk ? (int)__builtin_ctzll(mk) : 0;
    const unsigned Dsel = __shfl(D, L), nsel = __shfl(nn, L);
    if (lane == 0) { *pref_p = (*pref_p << bits) | Dsel; *need_p = nsel; }
}

template <int CTRL> __device__ __forceinline__ float dppx(float x) { return __builtin_bit_cast(float, __builtin_amdgcn_mov_dpp(__builtin_bit_cast(int, x), CTRL, 0xf, 0xf, true)); }
__device__ __forceinline__ float dot2bf(unsigned k, unsigned q, float acc) { return __builtin_amdgcn_fdot2_f32_bf16(__builtin_bit_cast(bf16x2_t, k), __builtin_bit_cast(bf16x2_t, q), acc, false); }

__device__ __forceinline__ void attn_query(int t, int cnt, const LAS unsigned short* list, const bf16_t* Q, const bf16_t* Kb, const bf16_t* V, bf16_t* ATTN, int lane) {
    constexpr float LOG2E = 1.4426950408889634f;
    const v4u qv = *(const v4u*)(Q + (size_t)t * AW + 8 * lane);
    const float slope2 = exp2f(-(float)((lane >> 3) + 1)) * LOG2E, sc2 = 0.125f * LOG2E;
    float mrun = -INFINITY, lrun = 0.f, o[8];
#pragma unroll
    for (int e = 0; e < 8; ++e) o[e] = 0.f;
    for (int j0 = 0; j0 < cnt; j0 += 8) {
        int key[8]; v4u kf[8], vf[8];
#pragma unroll
        for (int c = 0; c < 8; ++c) { const int jj = (j0 + c) < cnt ? (j0 + c) : (cnt - 1); key[c] = __builtin_amdgcn_readfirstlane((int)list[jj]); }
#pragma unroll
        for (int c = 0; c < 8; ++c) { kf[c] = *(const v4u*)(Kb + (size_t)key[c] * AW + 8 * lane); vf[c] = *(const v4u*)(V + (size_t)key[c] * AW + 8 * lane); }
        float s[8]; float mx = -INFINITY;
#pragma unroll
        for (int c = 0; c < 8; ++c) { float d = dot2bf(kf[c].x, qv.x, 0.f); d = dot2bf(kf[c].y, qv.y, d); d = dot2bf(kf[c].z, qv.z, d); d = dot2bf(kf[c].w, qv.w, d);
            d += dppx<0xB1>(d); d += dppx<0x4E>(d); d += dppx<0x141>(d);
            s[c] = (j0 + c) < cnt ? d * sc2 - slope2 * (float)(t - key[c]) : -INFINITY; mx = fmaxf(mx, s[c]); }
        const float mnew = fmaxf(mrun, mx), scale = exp2f(mrun - mnew);
        lrun *= scale;
#pragma unroll
        for (int e = 0; e < 8; ++e) o[e] *= scale;
#pragma unroll
        for (int c = 0; c < 8; ++c) { const float p = exp2f(s[c] - mnew); lrun += p;
            o[0] = fmaf(p, bf_lo(vf[c].x), o[0]); o[1] = fmaf(p, bf_hi(vf[c].x), o[1]); o[2] = fmaf(p, bf_lo(vf[c].y), o[2]); o[3] = fmaf(p, bf_hi(vf[c].y), o[3]);
            o[4] = fmaf(p, bf_lo(vf[c].z), o[4]); o[5] = fmaf(p, bf_hi(vf[c].z), o[5]); o[6] = fmaf(p, bf_lo(vf[c].w), o[6]); o[7] = fmaf(p, bf_hi(vf[c].w), o[7]); }
        mrun = mnew;
    }
    const float inv = 1.0f / lrun; v4u ov;
    ov.x = pkbf(o[0] * inv, o[1] * inv); ov.y = pkbf(o[2] * inv, o[3] * inv); ov.z = pkbf(o[4] * inv, o[5] * inv); ov.w = pkbf(o[6] * inv, o[7] * inv);
    *(v4u*)(ATTN + (size_t)t * AW + 8 * lane) = ov;
}

struct TkPtrs { const bf16_t *Q, *Kb, *V, *QI, *KI; const float* WI; bf16_t* ATTN; };
__device__ __forceinline__ void topk_attn_block(int qb, const TkPtrs& P, LAS unsigned char* lds, int tid, int wave, int lane) {
    LAS unsigned* H = (LAS unsigned*)lds;
    LAS unsigned* SELM = (LAS unsigned*)lds;
    LAS unsigned* TIEM = (LAS unsigned*)(lds + 65536);
    LAS unsigned short* LIST = (LAS unsigned short*)(lds + LIST_OFF);
    LAS unsigned* STP = (LAS unsigned*)(lds + ST_OFF);
    LAS unsigned* STN = STP + 32;
    const int t0 = qb * 32, r = lane & 31, h = lane >> 5;
    SYNC();
    pg8::bf16x8 qf[4][4]; float wv[4];
    { const bf16_t* qp = P.QI + (size_t)(t0 + r) * 256 + 8 * h;
#pragma unroll
      for (int hd = 0; hd < 4; ++hd)
#pragma unroll
          for (int s = 0; s < 4; ++s) qf[hd][s] = *(const pg8::bf16x8*)(qp + hd * 64 + 16 * s);
      const f32x4 w4 = *(const f32x4*)(P.WI + (size_t)(t0 + r) * 4); wv[0] = w4[0]; wv[1] = w4[1]; wv[2] = w4[2]; wv[3] = w4[3]; }
    if (tid < 32) { STP[tid] = 0u; const int nv = t0 + tid + 1; STN[tid] = nv < 256 ? nv : 256; }
#pragma unroll 1
    for (int level = 0; level < 3; ++level) {
        for (int i = tid; i < 32 * HSTRIDE; i += NTHR) H[i] = 0u;
        SYNC();
        const unsigned pref = STP[r];
        if (level == 0) tk_pass<0>(qb, wave, lane, P.KI, qf, wv, H, SELM, TIEM, pref);
        else if (level == 1) tk_pass<1>(qb, wave, lane, P.KI, qf, wv, H, SELM, TIEM, pref);
        else tk_pass<2>(qb, wave, lane, P.KI, qf, wv, H, SELM, TIEM, pref);
        SYNC();
#pragma unroll 1
        for (int qq = 0; qq < 4; ++qq) { const int rq = 4 * wave + qq; tk_scan(H + rq * HSTRIDE, STP + rq, STN + rq, level == 2 ? 10 : 11, lane); }
        SYNC();
    }
    for (int i = tid; i < 32768; i += NTHR) SELM[i] = 0u;
    SYNC();
    tk_pass<3>(qb, wave, lane, P.KI, qf, wv, H, SELM, TIEM, STP[r]);
    SYNC();
#pragma unroll 1
    for (int qq = 0; qq < 4; ++qq) {
        const int rq = 4 * wave + qq, t = t0 + rq; const int mties = (int)STN[rq];
        unsigned tw[8], fw[8]; int S = 0;
#pragma unroll
        for (int i = 0; i < 8; ++i) { tw[i] = TIEM[rq * 512 + 8 * lane + i]; fw[i] = SELM[rq * 512 + 8 * lane + i]; S += __builtin_popcount(tw[i]); }
        int incl = S;
#pragma unroll
        for (int off = 1; off < 64; off <<= 1) { const int tt = __shfl_up(incl, off); if (lane >= off) incl += tt; }
        int take = mties - (incl - S); take = take < 0 ? 0 : (take > S ? S : take);
        int cl = 0;
#pragma unroll
        for (int i = 0; i < 8; ++i) { unsigned w = tw[i]; const int c = __builtin_popcount(w); unsigned keep;
            if (take >= c) { keep = w; take -= c; } else { keep = 0u; for (int k = 0; k < take; ++k) { const unsigned low = w & (0u - w); keep |= low; w ^= low; } take = 0; }
            fw[i] |= keep; cl += __builtin_popcount(fw[i]); }
        int inc2 = cl;
#pragma unroll
        for (int off = 1; off < 64; off <<= 1) { const int tt = __shfl_up(inc2, off); if (lane >= off) inc2 += tt; }
        int pos = inc2 - cl; const int cnt = __shfl(inc2, 63);
        LAS unsigned short* lp = LIST + rq * 256;
#pragma unroll
        for (int i = 0; i < 8; ++i) { unsigned w = fw[i]; while (w) { const int b = __builtin_ctz(w); if (pos < 256) lp[pos] = (unsigned short)(256 * lane + 32 * i + b); ++pos; w &= w - 1u; } }
        LDS_WAIT(); asm volatile("" ::: "memory");
        attn_query(t, cnt < 256 ? cnt : 256, lp, P.Q, P.Kb, P.V, P.ATTN, lane);
    }
}

struct Args { const float* in[18]; float* out; unsigned char* ws; int ph_lo, ph_hi; };
constexpr int NPH = 12;

__global__ void __launch_bounds__(NTHR, 2) fwd_kernel(Args a) {
    extern __shared__ __attribute__((aligned(16))) unsigned char lds_raw[];
    LAS unsigned char* lds = (LAS unsigned char*)lds_raw;
    volatile LAS unsigned* MISC = (volatile LAS unsigned*)(lds + MISC_OFF);
    const int tid = threadIdx.x, lane = tid & 63, wave = __builtin_amdgcn_readfirstlane(tid >> 6);
    const int G = gridDim.x, bid = blockIdx.x, gw = bid * NWAVES + wave, NGW = G * NWAVES, gtid = bid * NTHR + tid, nthr = G * NTHR;
    unsigned char* ws = a.ws;
    const float *x = a.in[0], *cvec = a.in[1], *w_ada = a.in[2], *b_ada = a.in[3], *norm1_g = a.in[4], *w_in = a.in[5], *q_norm_g = a.in[6], *k_norm_g = a.in[7], *w_attn_br = a.in[8],
                *w_pool_grp = a.in[9], *pool_scale = a.in[10], *w_pool_br = a.in[11], *w_out = a.in[12], *norm2_g = a.in[13], *w_up = a.in[14], *conv_w = a.in[15], *conv_b = a.in[16], *w_down = a.in[17];
    float* out = a.out;
    bf16_t *WIN = (bf16_t*)(ws + WS_WIN), *WATTN = (bf16_t*)(ws + WS_WATTN), *WGRP = (bf16_t*)(ws + WS_WGRP), *WPOOL = (bf16_t*)(ws + WS_WPOOL), *WOUT = (bf16_t*)(ws + WS_WOUT),
           *WUP = (bf16_t*)(ws + WS_WUP), *WDOWN = (bf16_t*)(ws + WS_WDOWN);
    float *MODP = (float*)(ws + WS_MODP), *MODF = (float*)(ws + WS_MODF), *WI = (float*)(ws + WS_WI), *RAW = (float*)(ws + WS_RAW);
    bf16_t *Hb = (bf16_t*)(ws + WS_H), *Qb = (bf16_t*)(ws + WS_Q), *Kb = (bf16_t*)(ws + WS_K), *Vb = (bf16_t*)(ws + WS_V), *QI = (bf16_t*)(ws + WS_QI), *KI = (bf16_t*)(ws + WS_KI),
           *UPOOL = (bf16_t*)(ws + WS_UPOOL), *POOLED = (bf16_t*)(ws + WS_POOLED), *POOLMIX = (bf16_t*)(ws + WS_POOLMIX), *ATTN = (bf16_t*)(ws + WS_ATTN), *GA = (bf16_t*)(ws + WS_GA),
           *GP = (bf16_t*)(ws + WS_GP), *ACT = (bf16_t*)(ws + WS_ACT);

    for (int u = tid; u < (LDS_BYTES - MISC_OFF) / 4; u += NTHR) ((LAS unsigned*)(lds + MISC_OFF))[u] = 0u;
    SYNC();
    const int lo = a.ph_lo, hi = a.ph_hi;
    XcdBarrier bar; bar.bar = (unsigned*)(ws + WS_CTL) + CW_BAR; bar.x = 0; bar.st = nullptr;
    if (hi - lo > 1) bar = xcd_barrier_post((unsigned*)(ws + WS_CTL) + CW_BAR, MISC + 8);
#define IN(k) (lo <= (k) && (k) < hi)
#define SEAM(k) do { if (IN(k) && IN((k) + 1)) xcd_barrier(bar); } while (0)

    if (IN(0)) {
        P0Ptrs P{cvec, w_ada, w_in, w_attn_br, w_pool_grp, w_pool_br, w_out, w_up, w_down, WIN, WATTN, WGRP, WPOOL, WOUT, WUP, WDOWN, MODP};
        p0_prologue(P, lds, gw, NGW, wave, lane);
    }
    SEAM(0);
    if (IN(1)) {
        LAS float* mulv = (LAS float*)lds; LAS float* addv = mulv + 1024;
        for (int i = tid; i < 1024; i += NTHR) { float sh = b_ada[i], scv = b_ada[1024 + i];
#pragma unroll
            for (int kc = 0; kc < 16; ++kc) { sh += MODP[kc * NMOD + i]; scv += MODP[kc * NMOD + 1024 + i]; }
            mulv[i] = norm1_g[i] * (1.0f + scv); addv[i] = sh; }
        if (bid < 24 && tid < 256) { const int i = bid * 256 + tid; float v = b_ada[i];
#pragma unroll
            for (int kc = 0; kc < 16; ++kc) v += MODP[kc * NMOD + i];
            MODF[i] = v; }
        SYNC();
#if STAGE >= 2
        modulate_rows(x, Hb, mulv, addv, gw, NGW, lane);
#endif
        SYNC();
    }
    SEAM(1);
#if STAGE >= 2
    if (IN(2)) {
        pg8::Gemm g{Hb, WIN, M, NINP, DM}; pg8::StaticOrder S; S.init(M, NINP, G, bid);
        EpiProj E{Qb, Kb, Vb, QI, KI, UPOOL, GA, GP, WI, q_norm_g, k_norm_g};
        pg8::gemm_phase<EpiProj, pg8::StaticOrder, true, true>(lds, g, S, E);
    }
    SEAM(2);
    if (IN(3)) {
        pooled_phase(UPOOL, POOLED, gtid, nthr);
#if STAGE >= 3
        TkPtrs T{Qb, Kb, Vb, QI, KI, WI, ATTN};
        for (int b = bid; b < 256; b += G) { topk_attn_block(b, T, lds, tid, wave, lane); topk_attn_block(511 - b, T, lds, tid, wave, lane); }
        SYNC();
#else
        for (int i = gtid; i < M * AW / 8; i += nthr) ((v4u*)ATTN)[i] = (v4u){0u, 0u, 0u, 0u};
#endif
    }
    SEAM(3);
    if (IN(4)) {
        pg8::Gemm g{POOLED, WGRP, M, PW, PW}; pg8::StaticOrder S; S.init(M, PW, G, bid);
        EpiBf<0> E{POOLMIX, PW, pool_scale, nullptr};
        pg8::gemm_phase<EpiBf<0>, pg8::StaticOrder, true, true>(lds, g, S, E);
    }
    SEAM(4);
    if (IN(5)) {
        pg8::Gemm g{POOLMIX, WPOOL, M, DM, PW}; pg8::StaticOrder S; S.init(M, DM, G, bid);
        EpiBf<1> E{GP, DM, nullptr, nullptr};
        pg8::gemm_phase<EpiBf<1>, pg8::StaticOrder, true, true>(lds, g, S, E);
    }
    SEAM(5);
    if (IN(6)) {
        pg8::Gemm g{ATTN, WATTN, M, DM, AW}; pg8::StaticOrder S; S.init(M, DM, G, bid);
        EpiBf<2> E{GA, DM, nullptr, GP};
        pg8::gemm_phase<EpiBf<2>, pg8::StaticOrder, true, true>(lds, g, S, E);
    }
    SEAM(6);
    if (IN(7)) {
        pg8::Gemm g{GA, WOUT, M, DM, DM}; pg8::StaticOrder S; S.init(M, DM, G, bid);
        EpiRes E{x, out, MODF + 2048, 0.f};
        pg8::gemm_phase<EpiRes, pg8::StaticOrder, true, true>(lds, g, S, E);
    }
    SEAM(7);
    const float* x1 = out;
#else
    const float* x1 = x;
#endif
    if (IN(8)) {
        LAS float* mulv = (LAS float*)lds; LAS float* addv = mulv + 1024;
        for (int i = tid; i < 1024; i += NTHR) { mulv[i] = norm2_g[i] * (1.0f + MODF[4096 + i]); addv[i] = MODF[3072 + i]; }
        SYNC();
        modulate_rows(x1, Hb, mulv, addv, gw, NGW, lane);
        SYNC();
    }
    SEAM(8);
    if (IN(9)) {
        pg8::Gemm g{Hb, WUP, M, FF2, DM}; pg8::StaticOrder S; S.init(M, FF2, G, bid);
        EpiUpAct E{ACT, RAW, conv_w, conv_b};
        pg8::gemm_phase<EpiUpAct, pg8::StaticOrder, true, true>(lds, g, S, E);
    }
    SEAM(9);
    if (IN(10)) fixup_phase(RAW, ACT, conv_w, conv_b, gtid, nthr);
    SEAM(10);
    if (IN(11)) {
        pg8::Gemm g{ACT, WDOWN, M, DM, FF}; pg8::StaticOrder S; S.init(M, DM, G, bid);
        EpiRes E{x1, out, MODF + 5120, DBG_C};
        pg8::gemm_phase<EpiRes, pg8::StaticOrder, true, true>(lds, g, S, E);
    }
#undef IN
#undef SEAM
}

extern "C" void kernel_launch(void* const* d_in, const int* in_sizes, int n_in, void* d_out, int out_size, void* d_ws, size_t ws_size, hipStream_t stream) {
    static int grid = 0;
    if (grid == 0) {
        if (n_in != 18 || in_sizes[0] != M * DM || out_size != M * DM || ws_size < WS_END) { fprintf(stderr, "kernel_launch: unexpected shapes (n_in %d, in0 %d, out %d, ws %zu)\n", n_in, n_in > 0 ? in_sizes[0] : -1, out_size, ws_size); grid = -1; return; }
        int dev = 0, cus = 0, per_cu = 0;
        if (hipGetDevice(&dev) != hipSuccess || hipDeviceGetAttribute(&cus, hipDeviceAttributeMultiprocessorCount, dev) != hipSuccess) { grid = -1; return; }
        if (hipFuncSetAttribute((const void*)fwd_kernel, hipFuncAttributeMaxDynamicSharedMemorySize, LDS_BYTES) != hipSuccess) { fprintf(stderr, "kernel_launch: hipFuncSetAttribute failed\n"); grid = -1; return; }
        if (hipOccupancyMaxActiveBlocksPerMultiprocessor(&per_cu, (const void*)fwd_kernel, NTHR, LDS_BYTES) != hipSuccess || per_cu < 1) fprintf(stderr, "kernel_launch: occupancy query says %d\n", per_cu);
        (void)hipGetLastError();
        grid = cus;
    }
    if (grid < 0) return;
    (void)hipMemsetAsync((char*)d_ws + WS_CTL, 0, CTL_ZERO_BYTES, stream);
    Args a{};
    for (int i = 0; i < 18; ++i) a.in[i] = (const float*)d_in[i];
    a.out = (float*)d_out; a.ws = (unsigned char*)d_ws;
#if N_LAUNCH_MODE == 1
    a.ph_lo = 0; a.ph_hi = NPH;
    hipLaunchKernelGGL(fwd_kernel, dim3(grid), dim3(NTHR), LDS_BYTES, stream, a);
#else
    for (int p = 0; p < NPH; ++p) { a.ph_lo = p; a.ph_hi = p + 1; hipLaunchKernelGGL(fwd_kernel, dim3(grid), dim3(NTHR), LDS_BYTES, stream, a); }
#endif
}
```

```cpp
#ifndef REP_TKONLY
#define REP_TKONLY 0
#endif
#ifndef REP_BLK
#define REP_BLK 1
#endif
#include <hip/hip_runtime.h>
#include <cstdio>
#include <cstdint>
namespace pg8 {
#define PG8_LAS __attribute__((address_space(3)))
typedef unsigned short bf16_t;
typedef short bf16x8 __attribute__((ext_vector_type(8)));
typedef float f32x4 __attribute__((ext_vector_type(4)));
typedef unsigned u32x4 __attribute__((ext_vector_type(4)));
constexpr int BM = 256, BK = 64, HALF = 128, HTB = HALF * BK * 2  , STAGE_BYTES = 8 * HTB, NXCD = 8, WGM = 8;

__host__ __device__ __forceinline__ int lds_byte(int r, int c) { const int st = (r >> 4) * 2 + (c >> 5), rr = r & 15, cc = c & 31, ob = rr * 64 + cc * 2; return st * 1024 + (ob ^ (((ob >> 9) & 1) << 5)); }
__host__ __device__ __forceinline__ void stage_rc(int b, int& R, int& C) { const int st = b / 1024, sb = b % 1024, swz = sb ^ (((sb >> 9) & 1) << 5); R = (st >> 1) * 16 + swz / 64; C = (st & 1) * 32 + (swz % 64) / 2; }
__host__ __device__ __forceinline__ int perm32(int rho) { const int n = rho >> 4, i = rho & 15; return 8 * (i >> 2) + 4 * n + (i & 3); }

struct Unit { int pm, pn; };
struct Gemm { const bf16_t* A; const bf16_t* Bt; int M, N, K; };

struct StaticOrder {
    int nM, nN, nwg, G, c;
    __host__ __device__ void init(int M, int N, int G_, int c_) { nM = M / BM; nN = N / BM; nwg = nM * nN; G = G_; c = c_; }
    __host__ __device__ bool next(int i, Unit& u) const {
        const long L = (long)i * G + c; if (L >= nwg) return false;
        int wgid = (int)L; { const int q = nwg / NXCD, r = nwg % NXCD, xcd = wgid % NXCD, off = wgid / NXCD; wgid = (xcd < r ? xcd * (q + 1) : r * (q + 1) + (xcd - r) * q) + off; }
        const int nig = WGM * nN, gid = wgid / nig, fm = gid * WGM, gsz = (nM - fm) < WGM ? (nM - fm) : WGM;
        u.pm = fm + ((wgid % nig) % gsz); u.pn = (wgid % nig) / gsz; return true;
    }
    __device__ __forceinline__ void a_ready(const Unit&) const {}
    __device__ __forceinline__ void done(const Unit&) const {}
};

__device__ __forceinline__ unsigned cvt_pk_bf16(float lo, float hi) { unsigned r; asm volatile("v_cvt_pk_bf16_f32 %0, %1, %2" : "=v"(r) : "v"(lo), "v"(hi)); return r; }
template <class Epi, class Sched, bool ALIGN_EPI = false, bool SP2 = false>
__device__ __forceinline__ void gemm_phase(PG8_LAS unsigned char* lds, const Gemm g, const Sched& S, const Epi& E) {
    int tid_ = threadIdx.x; asm volatile("" : "+v"(tid_));
    const int tid = tid_, wid = __builtin_amdgcn_readfirstlane(tid >> 6), lane = tid & 63, wr = wid >> 2, wc = wid & 3, fr = lane & 15, fq = lane >> 4;
    const int K = g.K, nt = K / BK;
    unsigned voffA[2], voffB[2];
#pragma unroll
    for (int i = 0; i < 2; ++i) { int R, C; stage_rc(tid * 16 + i * 8192, R, C); const int Rb = Epi::PERM ? ((R & ~31) + perm32(R & 31)) : R;
        voffA[i] = (unsigned)(R * K + C) * 2u; voffB[i] = (unsigned)(Rb * K + C) * 2u; }
    const size_t kstep = (size_t)(BK * 2);
    const size_t hstep = (size_t)HALF * K * 2;
    const size_t tstep = 2 * hstep;
    const unsigned ldsw = (unsigned)wid * 1024u;
    const int aoff = lds_byte(wr * 64 + fr, fq * 8), boff = lds_byte(wc * 32 + fr, fq * 8);
#define PG8_SA(b, h) (((b) * 2 + (h)) * HTB)
#define PG8_SB(b, h) ((4 + (b) * 2 + (h)) * HTB)
#define PG8_STAGE(bufoff, gbase, voff) do { _Pragma("unroll") for (int _i = 0; _i < 2; ++_i) \
        __builtin_amdgcn_global_load_lds((const unsigned*)((const char*)(gbase) + (voff)[_i]), (PG8_LAS unsigned*)(lds + (bufoff) + ldsw + _i * 8192), 16, 0, 0); } while (0)
#define PG8_LDA(dst, b, h) do { _Pragma("unroll") for (int m = 0; m < 4; ++m) _Pragma("unroll") for (int k = 0; k < 2; ++k) dst[m][k] = *(const PG8_LAS bf16x8*)(lds + PG8_SA(b, h) + aoff + m * 2048 + k * 1024); } while (0)
#define PG8_LDB(dst, b, h) do { _Pragma("unroll") for (int n = 0; n < 2; ++n) _Pragma("unroll") for (int k = 0; k < 2; ++k) dst[n][k] = *(const PG8_LAS bf16x8*)(lds + PG8_SB(b, h) + boff + n * 2048 + k * 1024); } while (0)
#define PG8_MMA(ai, bj, At, Bt) do { __builtin_amdgcn_s_setprio(1); _Pragma("unroll") for (int m = 0; m < 4; ++m) _Pragma("unroll") for (int n = 0; n < 2; ++n) _Pragma("unroll") for (int k = 0; k < 2; ++k) \
        acc[ai][bj][m][n] = __builtin_amdgcn_mfma_f32_16x16x32_bf16(Bt[n][k], At[m][k], acc[ai][bj][m][n], 0, 0, 0); __builtin_amdgcn_s_setprio(0); } while (0)
#define PG8_WAIT_V(n) asm volatile("s_waitcnt vmcnt(" #n ")" ::: "memory")
#define PG8_WAIT_L(n) asm volatile("s_waitcnt lgkmcnt(" #n ")" ::: "memory")
#define PG8_BAR __builtin_amdgcn_s_barrier()
#define PG8_SCHED __builtin_amdgcn_sched_barrier(0)
    Unit cur, nxt; int ui = 0;
    if (!S.next(0, cur)) return;
    f32x4 acc[2][2][4][2];
#pragma unroll
    for (int a = 0; a < 2; ++a)
#pragma unroll
        for (int b = 0; b < 2; ++b)
#pragma unroll
            for (int m = 0; m < 4; ++m)
#pragma unroll
                for (int n = 0; n < 2; ++n) acc[a][b][m][n] = (f32x4){0.f, 0.f, 0.f, 0.f};
    bf16x8 At[4][2], B0[2][2], B1[2][2];
    const char* cA = (const char*)g.A + (size_t)cur.pm * tstep; const char* cB = (const char*)g.Bt + (size_t)cur.pn * tstep;
    S.a_ready(cur);
    if constexpr (SP2) {
        PG8_STAGE(PG8_SB(0, 0), cB, voffB); PG8_STAGE(PG8_SB(0, 1), cB + hstep, voffB); PG8_STAGE(PG8_SA(0, 0), cA, voffA); PG8_STAGE(PG8_SA(0, 1), cA + hstep, voffA);
        if (wr == 1) PG8_BAR;
        PG8_WAIT_V(2); PG8_BAR;
        PG8_STAGE(PG8_SB(1, 0), cB + kstep, voffB); PG8_STAGE(PG8_SA(1, 0), cA + kstep, voffA); PG8_STAGE(PG8_SB(1, 1), cB + hstep + kstep, voffB);
        PG8_WAIT_V(6); PG8_BAR;
    } else {
        PG8_STAGE(PG8_SB(0, 0), cB, voffB); PG8_STAGE(PG8_SA(0, 0), cA, voffA); PG8_STAGE(PG8_SB(0, 1), cB + hstep, voffB); PG8_STAGE(PG8_SA(0, 1), cA + hstep, voffA);
        if (wr == 1) PG8_BAR;
        PG8_WAIT_V(4); PG8_BAR;
        PG8_STAGE(PG8_SB(1, 0), cB + kstep, voffB); PG8_STAGE(PG8_SA(1, 0), cA + kstep, voffA); PG8_STAGE(PG8_SB(1, 1), cB + hstep + kstep, voffB);
        PG8_WAIT_V(6); PG8_BAR;
    }
    for (;;) {
        const bool has_next = S.next(ui + 1, nxt);
        const char* nA = has_next ? (const char*)g.A + (size_t)nxt.pm * tstep : cA; const char* nB = has_next ? (const char*)g.Bt + (size_t)nxt.pn * tstep : cB;
        for (int t = 0; t < nt; t += 2) {
            const bool last = (t == nt - 2);
            const char* a1 = cA + (size_t)(t + 1) * kstep;
            const char* a2 = last ? nA : cA + (size_t)(t + 2) * kstep; const char* b2 = last ? nB : cB + (size_t)(t + 2) * kstep;
            const char* a3 = a2 + kstep; const char* b3 = b2 + kstep;
            if (last && has_next) S.a_ready(nxt);
            if constexpr (SP2) {
            PG8_LDB(B0, 0, 0); PG8_LDB(B1, 0, 1); PG8_SCHED; PG8_LDA(At, 0, 0); PG8_STAGE(PG8_SA(1, 1), a1 + hstep, voffA);
            PG8_WAIT_V(8); PG8_WAIT_L(0); PG8_BAR; PG8_MMA(0, 0, At, B0); PG8_MMA(0, 1, At, B1); PG8_BAR; PG8_SCHED;
            PG8_LDA(At, 0, 1); PG8_STAGE(PG8_SB(0, 0), b2, voffB); PG8_STAGE(PG8_SB(0, 1), b2 + hstep, voffB); PG8_STAGE(PG8_SA(0, 0), a2, voffA);
            PG8_WAIT_V(8); PG8_WAIT_L(0); PG8_BAR; PG8_MMA(1, 0, At, B0); PG8_MMA(1, 1, At, B1); PG8_BAR; PG8_SCHED;
            PG8_LDB(B0, 1, 0); PG8_LDB(B1, 1, 1); PG8_SCHED; PG8_LDA(At, 1, 0); PG8_STAGE(PG8_SA(0, 1), a2 + hstep, voffA);
            PG8_WAIT_V(8); PG8_WAIT_L(0); PG8_BAR; PG8_MMA(0, 0, At, B0); PG8_MMA(0, 1, At, B1); PG8_BAR; PG8_SCHED;
            PG8_LDA(At, 1, 1); PG8_STAGE(PG8_SB(1, 0), b3, voffB); PG8_STAGE(PG8_SB(1, 1), b3 + hstep, voffB); PG8_STAGE(PG8_SA(1, 0), a3, voffA);
            PG8_WAIT_V(8); PG8_WAIT_L(0); PG8_BAR; PG8_MMA(1, 0, At, B0); PG8_MMA(1, 1, At, B1); PG8_BAR; PG8_SCHED;
            } else {
            PG8_LDB(B0, 0, 0); PG8_SCHED; PG8_LDA(At, 0, 0); PG8_STAGE(PG8_SA(1, 1), a1 + hstep, voffA);
            PG8_WAIT_L(8); PG8_BAR; PG8_WAIT_L(0); PG8_MMA(0, 0, At, B0); PG8_BAR; PG8_SCHED;
            PG8_LDB(B1, 0, 1); PG8_STAGE(PG8_SB(0, 0), b2, voffB);
            PG8_BAR; PG8_WAIT_L(0); PG8_MMA(0, 1, At, B1); PG8_BAR;
            PG8_LDA(At, 0, 1); PG8_STAGE(PG8_SA(0, 0), a2, voffA);
            PG8_BAR; PG8_WAIT_L(0); PG8_MMA(1, 0, At, B0); PG8_BAR; PG8_SCHED;
            PG8_STAGE(PG8_SB(0, 1), b2 + hstep, voffB);
            PG8_WAIT_V(6); PG8_BAR; PG8_MMA(1, 1, At, B1); PG8_BAR;
            PG8_LDB(B0, 1, 0); PG8_SCHED; PG8_LDA(At, 1, 0); PG8_STAGE(PG8_SA(0, 1), a2 + hstep, voffA);
            PG8_WAIT_L(8); PG8_BAR; PG8_WAIT_L(0); PG8_MMA(0, 0, At, B0); PG8_BAR; PG8_SCHED;
            PG8_LDB(B1, 1, 1); PG8_STAGE(PG8_SB(1, 0), b3, voffB);
            PG8_BAR; PG8_WAIT_L(0); PG8_MMA(0, 1, At, B1); PG8_BAR;
            PG8_LDA(At, 1, 1); PG8_STAGE(PG8_SA(1, 0), a3, voffA);
            PG8_BAR; PG8_WAIT_L(0); PG8_MMA(1, 0, At, B0); PG8_BAR; PG8_SCHED;
            PG8_STAGE(PG8_SB(1, 1), b3 + hstep, voffB);
            PG8_WAIT_V(6); PG8_BAR; PG8_MMA(1, 1, At, B1); PG8_BAR;
            }
        }
        if constexpr (ALIGN_EPI) { if (wr == 0) PG8_BAR; }
        if constexpr (!Epi::AFTER_DRAIN) { E(acc, cur, wr, wc, fr, fq); S.done(cur); }
        if (!has_next) break;
#pragma unroll
        for (int a = 0; a < 2; ++a)
#pragma unroll
            for (int b = 0; b < 2; ++b)
#pragma unroll
                for (int m = 0; m < 4; ++m)
#pragma unroll
                    for (int n = 0; n < 2; ++n) acc[a][b][m][n] = (f32x4){0.f, 0.f, 0.f, 0.f};
        cur = nxt; cA = nA; cB = nB; ++ui;
        if constexpr (ALIGN_EPI) { if (wr == 1) PG8_BAR; }
    }
    PG8_WAIT_V(0);
    if constexpr (!ALIGN_EPI) { if (wr == 0) PG8_BAR; }
    PG8_BAR;
    if constexpr (Epi::AFTER_DRAIN) { E.fused(acc, cur, wr, wc, fr, fq, lds, wid, lane); S.done(cur); }
#undef PG8_SA
#undef PG8_SB
#undef PG8_STAGE
#undef PG8_LDA
#undef PG8_LDB
#undef PG8_MMA
#undef PG8_WAIT_V
#undef PG8_WAIT_L
#undef PG8_BAR
#undef PG8_SCHED
}
}
#define GAS __attribute__((address_space(1)))
#define LAS __attribute__((address_space(3)))
typedef unsigned short bf16;
typedef unsigned v4u __attribute__((ext_vector_type(4)));
typedef float f32x4 __attribute__((ext_vector_type(4)));
typedef short bf16x8 __attribute__((ext_vector_type(8)));
typedef GAS unsigned gu32;
typedef GAS unsigned long long gu64;
#define RLX_AGENT __ATOMIC_RELAXED, __HIP_MEMORY_SCOPE_AGENT
#define LDS_WAIT() asm volatile("s_waitcnt lgkmcnt(0)" ::: "memory")
#define VM_WAIT() asm volatile("s_waitcnt vmcnt(0)" ::: "memory")
__device__ __forceinline__ unsigned long long rt() { return __builtin_amdgcn_s_memrealtime(); }
__device__ __forceinline__ unsigned f2bf(float f) { unsigned u = __builtin_bit_cast(unsigned, f); return (u + 0x7fffu + ((u >> 16) & 1u)) >> 16; }
__device__ __forceinline__ unsigned pk2(float lo, float hi) { return f2bf(lo) | (f2bf(hi) << 16); }

#define XB_TMO      128
#define XB_XCNT(j)  (256  + 64 * (j))
#define XB_XSUB(j)  (1280 + 64 * (j))
#define XB_XGEN(j)  (2304 + 64 * (j))
#define XB_TOP      3328
#define XB_TOPGEN   3392
#define XCD_BAR_WORDS 3456
#define XB_SPIN_CAP (1u << 18)

__device__ __forceinline__ unsigned xb_ld(unsigned* p)              { return __hip_atomic_load(p, __ATOMIC_RELAXED, __HIP_MEMORY_SCOPE_AGENT); }
__device__ __forceinline__ unsigned xb_add(unsigned* p, unsigned v) { return __hip_atomic_fetch_add(p, v, __ATOMIC_RELAXED, __HIP_MEMORY_SCOPE_AGENT); }
__device__ __forceinline__ unsigned xb_xcc_id() { return (unsigned)__builtin_amdgcn_s_getreg((3 << 11) | 20) & 0xFu; }
#define XB_SPIN(cond, bar) do { unsigned _sp = 0; while (cond) { __builtin_amdgcn_s_sleep(1); \
    if ((++_sp & 255u) == 0u) { if (xb_ld(&(bar)[XB_TMO])) break; if (_sp > XB_SPIN_CAP) { atomicAdd(&(bar)[XB_TMO], 1u); break; } } } } while (0)

struct XcdBarrier {
    unsigned* bar; unsigned x;
    volatile LAS unsigned* st;
};

__device__ __forceinline__ XcdBarrier xcd_barrier_post(unsigned* bar, volatile LAS unsigned* st) {
    XcdBarrier b; b.bar = bar; b.x = xb_xcc_id(); b.st = st;
    if (threadIdx.x == 0) (void)xb_add(&bar[XB_XCNT(b.x)], 1u);
    return b;
}
__device__ __forceinline__ void xcd_barrier_complete(unsigned* bar, unsigned x, unsigned& nloc, unsigned& nx) {
    const unsigned G = gridDim.x * gridDim.y * gridDim.z;
    unsigned sum, cnt, mine, sp = 0u;
    for (;;) {
        sum = 0u; cnt = 0u; mine = 0u;
#pragma unroll
        for (unsigned j = 0; j < 16; ++j) { const unsigned c = xb_ld(&bar[XB_XCNT(j)]); sum += c; cnt += (c > 0u) ? 1u : 0u; mine = (j == x) ? c : mine; }
        if (sum == G) break;
        __builtin_amdgcn_s_sleep(1);
        if ((++sp & 255u) == 0u) { if (xb_ld(&bar[XB_TMO])) break; if (sp > XB_SPIN_CAP) { atomicAdd(&bar[XB_TMO], 1u); break; } }
    }
    nloc = mine > 0u ? mine : 1u; nx = cnt > 0u ? cnt : 1u;
}

__device__ __forceinline__ void xcd_barrier(const XcdBarrier& b) {
    asm volatile("s_waitcnt vmcnt(0)" ::: "memory");
    __syncthreads();
    if (threadIdx.x == 0) {
        unsigned* bar = b.bar;
        __builtin_amdgcn_s_waitcnt(0);
        unsigned nloc = b.st[0], nx = b.st[1];
        if (nloc == 0u) { xcd_barrier_complete(bar, b.x, nloc, nx); b.st[0] = nloc; b.st[1] = nx; }
        const unsigned old = xb_add(&bar[XB_XSUB(b.x)], 1u);
        const unsigned gen = old / nloc;
        if (old + 1u == (gen + 1u) * nloc) {
            __builtin_amdgcn_fence(__ATOMIC_RELEASE, "agent");
            asm volatile("s_waitcnt vmcnt(0)" ::: "memory");
            const unsigned og = xb_add(&bar[XB_TOP], 1u);
            const unsigned tg = og / nx;
            if (og + 1u == (tg + 1u) * nx) xb_add(&bar[XB_TOPGEN], 1u);
            else XB_SPIN(xb_ld(&bar[XB_TOPGEN]) == tg, bar);
            __builtin_amdgcn_fence(__ATOMIC_ACQUIRE, "agent");
            xb_add(&bar[XB_XGEN(b.x)], 1u);
            asm volatile("s_waitcnt vmcnt(0)" ::: "memory");
        } else {
            XB_SPIN(xb_ld(&bar[XB_XGEN(b.x)]) == gen, bar);
            __builtin_amdgcn_fence(__ATOMIC_ACQUIRE, "agent");
            asm volatile("s_waitcnt vmcnt(0)" ::: "memory");
        }
    }
    __syncthreads();
}


#ifndef STAGE
#define STAGE 3
#endif
#ifndef N_LAUNCH_MODE
#define N_LAUNCH_MODE 1
#endif
#ifndef REP_TK
#define REP_TK 1
#endif
#ifndef REP_AT
#define REP_AT 1
#endif
#ifndef REP_PH
#define REP_PH -1
#endif
#ifndef TK_PREFETCH
#define TK_PREFETCH 1
#endif
#ifndef DBG_C
#define DBG_C 0.0f
#endif

typedef float f32x16 __attribute__((ext_vector_type(16)));
typedef __attribute__((ext_vector_type(2))) __bf16 bf16x2_t;
using pg8::bf16_t; using pg8::Unit;

constexpr int M = 16384, DM = 1024, NHEAD = 8, HD = 64, AW = 512, PW = 512, FF = 2816, FF2 = 5632, NIN = 4420, NINP = 4608, NMOD = 6144;
constexpr float EPS = 1e-6f;
constexpr int NWAVES = 8, NTHR = 512;

constexpr size_t MiB = 1u << 20;
constexpr size_t WS_CTL = 0, CTL_ZERO_BYTES = 64 * 1024;
constexpr size_t WS_WIN = 1 * MiB, WS_WATTN = 10 * MiB, WS_WGRP = 11 * MiB, WS_WPOOL = 11 * MiB + 512 * 1024, WS_WOUT = 12 * MiB + 512 * 1024,
                 WS_WUP = 14 * MiB + 512 * 1024, WS_WDOWN = 25 * MiB + 512 * 1024;
constexpr size_t WS_MODP = 31 * MiB, WS_MODF = 31 * MiB + 393216, WS_WI = 31 * MiB + 512 * 1024;
constexpr size_t WS_H = 32 * MiB;
constexpr size_t WS_Q = 64 * MiB, WS_K = 80 * MiB, WS_V = 96 * MiB;
constexpr size_t WS_SEL = 88 * MiB;
constexpr size_t WS_QI = 112 * MiB, WS_KI = 120 * MiB;
constexpr size_t WS_UPOOL = 128 * MiB, WS_POOLED = 144 * MiB, WS_POOLMIX = 160 * MiB, WS_ATTN = 176 * MiB;
constexpr size_t WS_GA = 192 * MiB, WS_GP = 224 * MiB;
constexpr size_t WS_ACT = 64 * MiB;
constexpr size_t WS_RAW = 152 * MiB;
constexpr size_t WS_END = 256 * MiB;
constexpr int CW_BAR = 1024, CW_QUEUE = 512;

constexpr int LDS_BYTES = 163840;
constexpr int HSTRIDE = 1025;
constexpr int LIST_OFF = 135168, ST_OFF = 151552, MISC_OFF = 159744;

#define SYNC() __syncthreads()
__device__ __forceinline__ float wave_sum(float v) {
#pragma unroll
    for (int o = 1; o < 64; o <<= 1) v += __shfl_xor(v, o);
    return v;
}
__device__ __forceinline__ float bf_lo(unsigned w) { return __builtin_bit_cast(float, w << 16); }
__device__ __forceinline__ float bf_hi(unsigned w) { return __builtin_bit_cast(float, w & 0xffff0000u); }
__device__ __forceinline__ float sigmoidf_(float x) { return 1.0f / (1.0f + __expf(-x)); }
__device__ __forceinline__ unsigned pkbf(float lo, float hi) { return pg8::cvt_pk_bf16(lo, hi); }
typedef unsigned u32x2 __attribute__((ext_vector_type(2)));
__device__ __forceinline__ u32x2 pk4(f32x4 v) { u32x2 r; r.x = pkbf(v[0], v[1]); r.y = pkbf(v[2], v[3]); return r; }
__device__ __forceinline__ unsigned pk4_fp8(f32x4 v) { int w = 0; w = __builtin_amdgcn_cvt_pk_fp8_f32(v[0], v[1], w, false); w = __builtin_amdgcn_cvt_pk_fp8_f32(v[2], v[3], w, true); return (unsigned)w; }

__device__ __forceinline__ void tr_item(const float* W, int ldw, int src_col, int nvalid, int k0, bf16_t* WT, int K, int dst_row, LAS float* scr, int lane) {
#pragma unroll 8
    for (int i = 0; i < 32; ++i) { const int kk = 2 * i + (lane >> 5), n = lane & 31;
        float v = 0.f; if (W != nullptr && n < nvalid) v = W[(size_t)(k0 + kk) * ldw + src_col + n];
        scr[kk * 33 + n] = v; }
    LDS_WAIT(); asm volatile("" ::: "memory");
    const int c = lane & 7;
#pragma unroll
    for (int j = 0; j < 4; ++j) { const int n = (lane >> 3) + 8 * j; const LAS float* s = scr + (8 * c) * 33 + n;
        v4u o; o.x = pk2(s[0 * 33], s[1 * 33]); o.y = pk2(s[2 * 33], s[3 * 33]); o.z = pk2(s[4 * 33], s[5 * 33]); o.w = pk2(s[6 * 33], s[7 * 33]);
        *(GAS v4u*)(WT + (size_t)(dst_row + n) * K + k0 + 8 * c) = o; }
    LDS_WAIT(); asm volatile("" ::: "memory");
}

struct P0Ptrs { const float *c, *w_ada, *w_in, *w_attn, *w_grp, *w_pool, *w_out, *w_up, *w_down; bf16_t *WIN, *WATTN, *WGRP, *WPOOL, *WOUT, *WUP, *WDOWN; float* MODP; };
__device__ __forceinline__ void p0_prologue(const P0Ptrs& P, LAS unsigned char* lds, int gw, int NGW, int wave, int lane) {
    LAS float* scr = (LAS float*)(lds + wave * 16384);
    constexpr int I_WIN = 144 * 16, I_WATTN = 32 * 8, I_WGRP = 16 * 8, I_WPOOL = 32 * 8, I_WOUT = 32 * 16, I_WUP = 176 * 16, I_WDOWN = 32 * 44, I_MOD = 96 * 16;
    constexpr int NITEMS = I_WIN + I_WATTN + I_WGRP + I_WPOOL + I_WOUT + I_WUP + I_WDOWN + I_MOD;
    for (int it = gw; it < NITEMS; it += NGW) {
        int r = it;
        if (r < I_MOD) {
            const int cb = r % 96, kc = r / 96, col = cb * 64 + lane; float acc = 0.f;
#pragma unroll 8
            for (int i = 0; i < 64; ++i) { const int k = kc * 64 + i; const float cv = P.c[k]; const float sv = cv / (1.0f + __expf(-cv)); acc = fmaf(sv, P.w_ada[(size_t)k * NMOD + col], acc); }
            P.MODP[kc * NMOD + col] = acc; continue; }
        r -= I_MOD;
        if (r < I_WIN) { const int g = r / 16, kb = r % 16, tile = g >> 3, gi = g & 7; int src = -1, nv = 32;
            const int permgi = gi < 4 ? 64 * gi : 64 * (gi - 4) + 32;
            if (tile < 2) src = tile * 256 + permgi;
            else if (tile < 4) src = 512 + (tile - 2) * 256 + permgi;
            else if (tile < 6) src = 1024 + (tile - 4) * 256 + 32 * gi;
            else if (tile == 6) src = 1536 + 32 * gi;
            else if (tile == 7) { if (gi < 2) src = 1792 + 32 * gi; else if (gi == 2) { src = 1856; nv = 4; } }
            else if (tile < 10) src = 1860 + (tile - 8) * 256 + 32 * gi;
            else if (tile < 14) src = 2372 + (tile - 10) * 256 + 32 * gi;
            else src = 3396 + (tile - 14) * 256 + 32 * gi;
            tr_item(src >= 0 ? P.w_in : nullptr, NIN, src >= 0 ? src : 0, nv, kb * 64, P.WIN, 1024, g * 32, scr, lane); continue; }
        r -= I_WIN;
        if (r < I_WATTN) { tr_item(P.w_attn, 1024, (r / 8) * 32, 32, (r % 8) * 64, P.WATTN, 512, (r / 8) * 32, scr, lane); continue; }
        r -= I_WATTN;
        if (r < I_WGRP) { const int g = r / 8, kb = r % 8, grp = g >> 2;
            const bool nz = (kb >> 1) == grp;
            tr_item(nz ? P.w_grp + (size_t)grp * 128 * 128 : nullptr, 128, (g & 3) * 32, 32, (kb & 1) * 64, P.WGRP + (size_t)(kb >> 1) * 128, 512, g * 32, scr, lane);
            continue; }
        r -= I_WGRP;
        if (r < I_WPOOL) { tr_item(P.w_pool, 1024, (r / 8) * 32, 32, (r % 8) * 64, P.WPOOL, 512, (r / 8) * 32, scr, lane); continue; }
        r -= I_WPOOL;
        if (r < I_WOUT) { tr_item(P.w_out, 1024, (r / 16) * 32, 32, (r % 16) * 64, P.WOUT, 1024, (r / 16) * 32, scr, lane); continue; }
        r -= I_WOUT;
        if (r < I_WUP) { const int g = r / 16, kb = r % 16, tile = g >> 3, gi = g & 7;
            const int src = gi < 4 ? 128 * tile + 32 * gi : FF + 128 * tile + 32 * (gi - 4);
            tr_item(P.w_up, FF2, src, 32, kb * 64, P.WUP, 1024, g * 32, scr, lane); continue; }
        r -= I_WUP;
        { tr_item(P.w_down, 1024, (r / 44) * 32, 32, (r % 44) * 64, P.WDOWN, FF, (r / 44) * 32, scr, lane); }
    }
}

__device__ __forceinline__ void modulate_rows(const float* X, bf16_t* O, const LAS float* mulv, const LAS float* addv, int gw, int NGW, int lane) {
    f32x4 mu[4], ad[4];
#pragma unroll
    for (int j = 0; j < 4; ++j) { mu[j] = *(const LAS f32x4*)(mulv + 4 * lane + 256 * j); ad[j] = *(const LAS f32x4*)(addv + 4 * lane + 256 * j); }
    for (int row = gw; row < M; row += NGW) {
        const GAS f32x4* xr = (const GAS f32x4*)(X + (size_t)row * DM) + lane;
        f32x4 v[4]; float s = 0.f;
#pragma unroll
        for (int j = 0; j < 4; ++j) { v[j] = xr[64 * j]; s += (v[j].x * v[j].x + v[j].y * v[j].y) + (v[j].z * v[j].z + v[j].w * v[j].w); }
        const float rstd = 1.0f / sqrtf(wave_sum(s) * (1.0f / DM) + EPS);
        GAS u32x2* o8 = (GAS u32x2*)(O + (size_t)row * DM) + lane;
#pragma unroll
        for (int j = 0; j < 4; ++j) { const f32x4 y = v[j] * rstd * mu[j] + ad[j]; o8[64 * j] = pk4(y); }
    }
}

struct EpiProj {
    static constexpr bool PERM = false, AFTER_DRAIN = false;
    bf16_t *Q; unsigned char *K8, *V8; bf16_t *QI, *KI, *UPOOL, *GA, *GP; float* WI; const float *qg, *kg;
    __device__ __forceinline__ void operator()(const pg8::f32x4 (&acc)[2][2][4][2], const Unit& u, int wr, int wc, int fr, int fq) const {
        const int pn = u.pn, row0 = u.pm * 256 + wr * 64 + fr;
        if (pn < 4) {
            const bool isq = pn < 2; const float* g = isq ? qg : kg; const int head = (pn & 1) * 4 + wc;
            f32x4 gv[2][2];
#pragma unroll
            for (int bj = 0; bj < 2; ++bj)
#pragma unroll
                for (int n = 0; n < 2; ++n) gv[bj][n] = *(const f32x4*)(g + 32 * bj + 16 * n + 4 * fq);
#pragma unroll
            for (int ai = 0; ai < 2; ++ai)
#pragma unroll
                for (int m = 0; m < 4; ++m) {
                    float ss = 0.f;
#pragma unroll
                    for (int bj = 0; bj < 2; ++bj)
#pragma unroll
                        for (int n = 0; n < 2; ++n) { const f32x4 x = acc[ai][bj][m][n]; ss += (x[0] * x[0] + x[1] * x[1]) + (x[2] * x[2] + x[3] * x[3]); }
                    ss += __shfl_xor(ss, 16); ss += __shfl_xor(ss, 32);
                    const float rstd = 1.0f / sqrtf(ss * (1.0f / 64.0f) + EPS);
                    const size_t ro = (size_t)(row0 + ai * 128 + m * 16) * AW + head * 64 + 4 * fq;
#pragma unroll
                    for (int bj = 0; bj < 2; ++bj)
#pragma unroll
                        for (int n = 0; n < 2; ++n) { const f32x4 y = acc[ai][bj][m][n] * rstd * gv[bj][n];
                            if (isq) *(u32x2*)(Q + ro + 32 * bj + 16 * n) = pk4(y); else *(unsigned*)(K8 + ((size_t)head * M + (row0 + ai * 128 + m * 16)) * 64 + 4 * fq + 32 * bj + 16 * n) = pk4_fp8(y); }
                }
            return;
        }
        const int colw = wc * 32 + 4 * fq;
        if (pn == 7) {
#pragma unroll
            for (int ai = 0; ai < 2; ++ai)
#pragma unroll
                for (int m = 0; m < 4; ++m) { const int row = row0 + ai * 128 + m * 16;
                    if (wc < 2) {
#pragma unroll
                        for (int n = 0; n < 2; ++n) { const int c = colw + 16 * n; *(u32x2*)(KI + (size_t)(row >> 5) * 2048 + (c >> 4) * 512 + ((((c >> 3) & 1) * 32 + (row & 31)) * 8) + (c & 7)) = pk4(acc[ai][0][m][n]); }
                    } else if (wc == 2 && fq == 0) { *(f32x4*)(WI + (size_t)row * 4) = acc[ai][0][m][0] * 0.5f; }
                }
            return;
        }
        if (pn < 6) {
#pragma unroll
            for (int ai = 0; ai < 2; ++ai)
#pragma unroll
                for (int m = 0; m < 4; ++m) { const int row = row0 + ai * 128 + m * 16;
#pragma unroll
                    for (int bj = 0; bj < 2; ++bj)
#pragma unroll
                        for (int n = 0; n < 2; ++n) { const int col = (pn - 4) * 256 + colw + 128 * bj + 16 * n;
                            *(unsigned*)(V8 + ((size_t)(col >> 6) * M + row) * 64 + (col & 63)) = pk4_fp8(acc[ai][bj][m][n]); } }
            return;
        }
        bf16_t* O; int ldo, ct; float sc = 1.0f; bool sig = false;
        if (pn == 6) { O = QI; ldo = 256; ct = 0; sc = 0.125f; }
        else if (pn < 10) { O = UPOOL; ldo = PW; ct = (pn - 8) * 256; }
        else if (pn < 14) { O = GA; ldo = DM; ct = (pn - 10) * 256; sig = true; }
        else { O = GP; ldo = DM; ct = (pn - 14) * 256; sig = true; }
#pragma unroll
        for (int ai = 0; ai < 2; ++ai)
#pragma unroll
            for (int m = 0; m < 4; ++m) { bf16_t* rowp = O + (size_t)(row0 + ai * 128 + m * 16) * ldo + ct + colw;
#pragma unroll
                for (int bj = 0; bj < 2; ++bj)
#pragma unroll
                    for (int n = 0; n < 2; ++n) { f32x4 y = acc[ai][bj][m][n] * sc;
                        if (sig) { y[0] = sigmoidf_(y[0]); y[1] = sigmoidf_(y[1]); y[2] = sigmoidf_(y[2]); y[3] = sigmoidf_(y[3]); }
                        *(u32x2*)(rowp + 128 * bj + 16 * n) = pk4(y); }
            }
    }
};

template <int MODE> struct EpiBf {
    static constexpr bool PERM = false, AFTER_DRAIN = false;
    bf16_t* O; int ldo; const float* colscale; const bf16_t* ADD;
    __device__ __forceinline__ void operator()(const pg8::f32x4 (&acc)[2][2][4][2], const Unit& u, int wr, int wc, int fr, int fq) const {
        const int row0 = u.pm * 256 + wr * 64 + fr, col0 = u.pn * 256 + wc * 32 + 4 * fq;
#pragma unroll
        for (int ai = 0; ai < 2; ++ai)
#pragma unroll
            for (int m = 0; m < 4; ++m) { const size_t ro = (size_t)(row0 + ai * 128 + m * 16) * ldo + col0;
#pragma unroll
                for (int bj = 0; bj < 2; ++bj)
#pragma unroll
                    for (int n = 0; n < 2; ++n) { f32x4 y = acc[ai][bj][m][n]; const size_t off = ro + 128 * bj + 16 * n;
                        if (MODE == 0) { y = y * *(const f32x4*)(colscale + col0 + 128 * bj + 16 * n); }
                        else { const u32x2 gq = *(const u32x2*)(O + off); y[0] *= bf_lo(gq.x); y[1] *= bf_hi(gq.x); y[2] *= bf_lo(gq.y); y[3] *= bf_hi(gq.y);
                            if (MODE == 2) { const u32x2 a = *(const u32x2*)(ADD + off); y[0] += bf_lo(a.x); y[1] += bf_hi(a.x); y[2] += bf_lo(a.y); y[3] += bf_hi(a.y); } }
                        *(u32x2*)(O + off) = pk4(y); }
            }
    }
};

struct EpiRes {
    static constexpr bool PERM = false, AFTER_DRAIN = false;
    const float* BASE; float* OUT; const float* gate; float dbg;
    __device__ __forceinline__ void operator()(const pg8::f32x4 (&acc)[2][2][4][2], const Unit& u, int wr, int wc, int fr, int fq) const {
        const int row0 = u.pm * 256 + wr * 64 + fr, col0 = u.pn * 256 + wc * 32 + 4 * fq;
        f32x4 gv[2][2];
#pragma unroll
        for (int bj = 0; bj < 2; ++bj)
#pragma unroll
            for (int n = 0; n < 2; ++n) gv[bj][n] = *(const f32x4*)(gate + col0 + 128 * bj + 16 * n);
#pragma unroll
        for (int ai = 0; ai < 2; ++ai)
#pragma unroll
            for (int m = 0; m < 4; ++m) { const int row = row0 + ai * 128 + m * 16; const size_t ro = (size_t)row * DM + col0;
#pragma unroll
                for (int bj = 0; bj < 2; ++bj)
#pragma unroll
                    for (int n = 0; n < 2; ++n) { const size_t off = ro + 128 * bj + 16 * n; f32x4 y = *(const f32x4*)(BASE + off) + gv[bj][n] * acc[ai][bj][m][n];
                        if (dbg != 0.f) { const float sg = ((row * 7 + (int)(off >> 2)) & 1) ? dbg : -dbg; y[0] += sg; y[1] -= sg; y[2] += sg; y[3] -= sg; }
                        *(f32x4*)(OUT + off) = y; }
            }
    }
};

template <int CTRL> __device__ __forceinline__ float dppf(float x) { return __builtin_bit_cast(float, __builtin_amdgcn_update_dpp(0, __builtin_bit_cast(int, x), CTRL, 0xf, 0xf, false)); }
__device__ __forceinline__ f32x4 ror1(f32x4 v) { f32x4 r; r[0] = dppf<0x121>(v[0]); r[1] = dppf<0x121>(v[1]); r[2] = dppf<0x121>(v[2]); r[3] = dppf<0x121>(v[3]); return r; }
__device__ __forceinline__ f32x4 ror2(f32x4 v) { f32x4 r; r[0] = dppf<0x122>(v[0]); r[1] = dppf<0x122>(v[1]); r[2] = dppf<0x122>(v[2]); r[3] = dppf<0x122>(v[3]); return r; }
__device__ __forceinline__ f32x4 silu_mul(f32x4 a, f32x4 b) { f32x4 r;
#pragma unroll
    for (int e = 0; e < 4; ++e) r[e] = a[e] / (1.0f + __expf(-a[e])) * b[e];
    return r; }
struct EpiUpAct {
    static constexpr bool PERM = false, AFTER_DRAIN = false;
    bf16_t* ACT; float* RAW; const float* cw; const float* cb;
    __device__ __forceinline__ void operator()(const pg8::f32x4 (&acc)[2][2][4][2], const Unit& u, int wr, int wc, int fr, int fq) const {
#pragma unroll
        for (int n = 0; n < 2; ++n) {
            const int ch = u.pn * 128 + wc * 32 + 4 * fq + 16 * n;
            const f32x4 w0a = *(const f32x4*)(cw + ch), w1a = *(const f32x4*)(cw + FF2 + ch), w2a = *(const f32x4*)(cw + 2 * FF2 + ch), ba = *(const f32x4*)(cb + ch);
            const f32x4 w0b = *(const f32x4*)(cw + FF + ch), w1b = *(const f32x4*)(cw + FF2 + FF + ch), w2b = *(const f32x4*)(cw + 2 * FF2 + FF + ch), bb = *(const f32x4*)(cb + FF + ch);
#pragma unroll
            for (int ai = 0; ai < 2; ++ai) {
                const int blk = u.pm * 4 + ai * 2 + wr;
                if (fr < 2) { *(f32x4*)(RAW + (size_t)(blk * 4 + fr) * FF2 + ch) = acc[ai][0][0][n]; *(f32x4*)(RAW + (size_t)(blk * 4 + fr) * FF2 + FF + ch) = acc[ai][1][0][n]; }
                if (fr >= 14) { *(f32x4*)(RAW + (size_t)(blk * 4 + fr - 12) * FF2 + ch) = acc[ai][0][3][n]; *(f32x4*)(RAW + (size_t)(blk * 4 + fr - 12) * FF2 + FF + ch) = acc[ai][1][3][n]; }
                f32x4 pa1 = {0.f, 0.f, 0.f, 0.f}, pa2 = pa1, pb1 = pa1, pb2 = pa1;
#pragma unroll
                for (int m = 0; m < 4; ++m) {
                    const f32x4 va = acc[ai][0][m][n], vb = acc[ai][1][m][n];
                    const f32x4 ra1 = ror1(va), ra2 = ror2(va), rb1 = ror1(vb), rb2 = ror2(vb);
                    const f32x4 xa1 = fr >= 1 ? ra1 : pa1, xa2 = fr >= 2 ? ra2 : pa2, xb1 = fr >= 1 ? rb1 : pb1, xb2 = fr >= 2 ? rb2 : pb2;
                    pa1 = ra1; pa2 = ra2; pb1 = rb1; pb2 = rb2;
                    const f32x4 ya = ba + w0a * xa2 + w1a * xa1 + w2a * va, yb = bb + w0b * xb2 + w1b * xb1 + w2b * vb;
                    const f32x4 o = silu_mul(ya, yb);
                    if (!(m == 0 && fr < 2)) *(u32x2*)(ACT + (size_t)(blk * 64 + 16 * m + fr) * FF + ch) = pk4(o);
                }
            }
        }
    }
};

__device__ __forceinline__ void fixup_phase(const float* RAW, bf16_t* ACT, const float* cw, const float* cb, int gtid, int nthr) {
    for (int it = gtid; it < 256 * 2 * 704; it += nthr) {
        const int c4 = it % 704, rr = (it / 704) & 1, blk = it / 1408, ch = 4 * c4;
        const float* cur = RAW + (size_t)(blk * 4 + rr) * FF2;
        const float* p1 = rr == 1 ? RAW + (size_t)(blk * 4) * FF2 : (blk > 0 ? RAW + (size_t)((blk - 1) * 4 + 3) * FF2 : nullptr);
        const float* p2 = rr == 1 ? (blk > 0 ? RAW + (size_t)((blk - 1) * 4 + 3) * FF2 : nullptr) : (blk > 0 ? RAW + (size_t)((blk - 1) * 4 + 2) * FF2 : nullptr);
        const f32x4 z = {0.f, 0.f, 0.f, 0.f};
        const f32x4 va = *(const f32x4*)(cur + ch), vb = *(const f32x4*)(cur + FF + ch);
        const f32x4 a1 = p1 ? *(const f32x4*)(p1 + ch) : z, b1 = p1 ? *(const f32x4*)(p1 + FF + ch) : z;
        const f32x4 a2 = p2 ? *(const f32x4*)(p2 + ch) : z, b2 = p2 ? *(const f32x4*)(p2 + FF + ch) : z;
        const f32x4 ya = *(const f32x4*)(cb + ch) + *(const f32x4*)(cw + ch) * a2 + *(const f32x4*)(cw + FF2 + ch) * a1 + *(const f32x4*)(cw + 2 * FF2 + ch) * va;
        const f32x4 yb = *(const f32x4*)(cb + FF + ch) + *(const f32x4*)(cw + FF + ch) * b2 + *(const f32x4*)(cw + FF2 + FF + ch) * b1 + *(const f32x4*)(cw + 2 * FF2 + FF + ch) * vb;
        *(u32x2*)(ACT + (size_t)(blk * 64 + rr) * FF + ch) = pk4(silu_mul(ya, yb));
    }
}

__device__ __forceinline__ void pooled_phase(const bf16_t* UPOOL, bf16_t* POOLED, int gtid, int nthr) {
    for (int it = gtid; it < M * 64; it += nthr) {
        const int t = it >> 6, c8 = it & 63, g = c8 >> 4, w = 2 << g, cntw = (t + 1) < w ? (t + 1) : w;
        float s[8], self[8];
#pragma unroll
        for (int e = 0; e < 8; ++e) s[e] = 0.f;
        for (int j = 0; j < cntw; ++j) { const v4u v = *(const v4u*)(UPOOL + (size_t)(t - j) * PW + 8 * c8);
            const float f[8] = {bf_lo(v.x), bf_hi(v.x), bf_lo(v.y), bf_hi(v.y), bf_lo(v.z), bf_hi(v.z), bf_lo(v.w), bf_hi(v.w)};
#pragma unroll
            for (int e = 0; e < 8; ++e) { s[e] += f[e]; if (j == 0) self[e] = f[e]; } }
        const float inv = 1.0f / (float)cntw; v4u o;
        o.x = pkbf(s[0] * inv - self[0], s[1] * inv - self[1]); o.y = pkbf(s[2] * inv - self[2], s[3] * inv - self[3]);
        o.z = pkbf(s[4] * inv - self[4], s[5] * inv - self[5]); o.w = pkbf(s[6] * inv - self[6], s[7] * inv - self[7]);
        *(v4u*)(POOLED + (size_t)t * PW + 8 * c8) = o;
    }
}

#define MFMA32(a, b, c) __builtin_amdgcn_mfma_f32_32x32x16_bf16((a), (b), (c), 0, 0, 0)
__device__ __forceinline__ unsigned lds_add(LAS unsigned* p, unsigned v) { return __hip_atomic_fetch_add(p, v, __ATOMIC_RELAXED, __HIP_MEMORY_SCOPE_WORKGROUP); }
__device__ __forceinline__ unsigned lds_or(LAS unsigned* p, unsigned v) { return __hip_atomic_fetch_or(p, v, __ATOMIC_RELAXED, __HIP_MEMORY_SCOPE_WORKGROUP); }

__device__ __forceinline__ float u2f(unsigned u) { return __uint_as_float((u & 0x80000000u) ? (u & 0x7fffffffu) : ~u); }
template <bool EMIT>
__device__ __forceinline__ void tk_pass(int qb, int wave, int lane, const bf16_t* KI, const LAS bf16_t* QF, const float (&wv)[4], LAS unsigned* H, LAS unsigned* SELM, LAS unsigned* TIEM,
                                        int sh, unsigned vlo, bool clampTop, unsigned bmax, int stage, unsigned vmin, float fsel, float ftie) {
    const int r = lane & 31, h = lane >> 5;
    const int gstep = stage == 1 ? 8 : 1, g0 = stage == 1 ? wave : 0;
#define TK_NEXT_G(g) ({ int _g = (g) + gstep; if (stage == 2 && (_g & 7) == wave) ++_g; _g; })
    int gcur = g0; if (stage == 2 && (gcur & 7) == wave) ++gcur;
    pg8::bf16x8 kf[4];
    { const int T0 = (wave + 8 * gcur) <= qb ? (wave + 8 * gcur) : qb; const bf16_t* kp = KI + (size_t)T0 * 2048 + 8 * lane;
#pragma unroll
      for (int s = 0; s < 4; ++s) kf[s] = *(const pg8::bf16x8*)(kp + 512 * s); }
    LAS unsigned* Hq = H + r * HSTRIDE;
#pragma unroll 1
    for (; wave + 8 * gcur <= qb; gcur = TK_NEXT_G(gcur)) {
        const int T = wave + 8 * gcur;
        float sc[16];
#pragma unroll
        for (int i = 0; i < 16; ++i) sc[i] = 0.f;
#pragma unroll
        for (int hd = 0; hd < 4; ++hd) { f32x16 a;
#pragma unroll
            for (int i = 0; i < 16; ++i) a[i] = 0.f;
#pragma unroll
            for (int s = 0; s < 4; ++s) a = MFMA32(kf[s], *(const LAS pg8::bf16x8*)(QF + (hd * 4 + s) * 512 + lane * 8), a);
#pragma unroll
            for (int i = 0; i < 16; ++i) { const float av = a[i]; const int ab = __float_as_int(av); sc[i] = fmaf(wv[hd], __int_as_float(ab > 0 ? ab : 0), sc[i]); } }
        { const int Tnn = wave + 8 * TK_NEXT_G(gcur); const int Tn = Tnn <= qb ? Tnn : T; const bf16_t* kp = KI + (size_t)Tn * 2048 + 8 * lane;
#pragma unroll
          for (int s = 0; s < 4; ++s) kf[s] = *(const pg8::bf16x8*)(kp + 512 * s); }
        const int rlim = (T == qb) ? r : 64;
        if (!EMIT) {
#pragma unroll
            for (int i = 0; i < 16; ++i) {
                const int kr = (i & 3) + 8 * (i >> 2) + 4 * h;
                unsigned uu = __float_as_uint(sc[i]); uu ^= ((unsigned)((int)uu >> 31)) | 0x80000000u;
                const unsigned v = uu >> sh; unsigned b = v - vlo;
                const bool ok = (kr <= rlim) && (v >= vmin) && (clampTop || b <= bmax);
                b = b > 2047u ? 2047u : b;
                lds_add(Hq + (ok ? (b >> 1) : 1024u), 1u << ((b & 1u) * 16u));
            }
        } else {
            unsigned msel = 0u, mtie = 0u;
#pragma unroll
            for (int i = 0; i < 16; ++i) {
                const int kr = (i & 3) + 8 * (i >> 2) + 4 * h;
                const bool okv = kr <= rlim, a = okv && (sc[i] >= fsel), b = okv && (sc[i] >= ftie);
                msel |= a ? (1u << kr) : 0u; mtie |= (b && !a) ? (1u << kr) : 0u;
            }
            const unsigned osel = __shfl_xor(msel, 32), otie = __shfl_xor(mtie, 32);
            if (h == 0) { SELM[T * 32 + r] = msel | osel; TIEM[T * 32 + r] = mtie | otie; }
        }
    }
#undef TK_NEXT_G
}

__device__ __forceinline__ float tk_rescore(const u32x2 q4, float wh, const bf16_t* KI, int key, int lane) {
    const int c = 4 * (lane & 15);
    const u32x2 k4 = *(const u32x2*)(KI + (size_t)(key >> 5) * 2048 + (c >> 4) * 512 + ((((c >> 3) & 1) * 32 + (key & 31)) * 8) + (c & 7));
    float d = bf_lo(q4.x) * bf_lo(k4.x); d = fmaf(bf_hi(q4.x), bf_hi(k4.x), d); d = fmaf(bf_lo(q4.y), bf_lo(k4.y), d); d = fmaf(bf_hi(q4.y), bf_hi(k4.y), d);
    d += __shfl_xor(d, 1); d += __shfl_xor(d, 2); d += __shfl_xor(d, 4); d += __shfl_xor(d, 8);
    float sc = wh * fmaxf(d, 0.f);
    sc += __shfl_xor(sc, 16); sc += __shfl_xor(sc, 32);
    return sc + 0.f;
}

__device__ __forceinline__ void tk_scan(const LAS unsigned* Hq, LAS unsigned* pref_p, LAS unsigned* need_p, LAS unsigned* cnt_p, int bits, int lane) {
    const unsigned need = *need_p;
    unsigned wd[16]; unsigned S = 0;
#pragma unroll
    for (int i = 0; i < 16; ++i) { wd[i] = Hq[16 * lane + i]; S += (wd[i] & 0xffffu) + (wd[i] >> 16); }
    unsigned incl = S;
#pragma unroll
    for (int off = 1; off < 64; off <<= 1) { const unsigned t = __shfl_down(incl, off); if (lane + off < 64) incl += t; }
    const unsigned Tabove = incl - S;
    const bool hit = (Tabove < need) && (need <= Tabove + S);
    unsigned rem = need - Tabove, D = 0, nn = 1, cD = 0; bool found = false;
#pragma unroll
    for (int b = 31; b >= 0; --b) { const unsigned c = (wd[b >> 1] >> (16 * (b & 1))) & 0xffffu;
        if (!found) { if (c >= rem) { found = true; D = 32u * lane + b; nn = rem; cD = c; } else rem -= c; } }
    const unsigned long long mk = __ballot(hit);
    const int L = mk ? (int)__builtin_ctzll(mk) : 0;
    const unsigned Dsel = __shfl(D, L), nsel = __shfl(nn, L), csel = __shfl(cD, L);
    if (lane == 0) { *pref_p = bits ? ((*pref_p << bits) | Dsel) : Dsel; *need_p = nsel; if (cnt_p) *cnt_p = csel; }
}

template <int CTRL> __device__ __forceinline__ float dppx(float x) { return __builtin_bit_cast(float, __builtin_amdgcn_mov_dpp(__builtin_bit_cast(int, x), CTRL, 0xf, 0xf, true)); }
__device__ __forceinline__ float dot2bf(unsigned k, unsigned q, float acc) { return __builtin_amdgcn_fdot2_f32_bf16(__builtin_bit_cast(bf16x2_t, k), __builtin_bit_cast(bf16x2_t, q), acc, false); }

typedef float f32x2_t __attribute__((ext_vector_type(2)));
__device__ __forceinline__ void unpack16(const v4u w, float (&f)[16]) {
#pragma unroll
    for (int i = 0; i < 4; ++i) { const f32x2_t a = __builtin_amdgcn_cvt_pk_f32_fp8((int)w[i], false), b = __builtin_amdgcn_cvt_pk_f32_fp8((int)w[i], true); f[4 * i] = a.x; f[4 * i + 1] = a.y; f[4 * i + 2] = b.x; f[4 * i + 3] = b.y; }
}
__device__ __forceinline__ void attn_item(int t, int hd, const unsigned short* SEL, const bf16_t* Q, const unsigned char* K8, const unsigned char* V8, bf16_t* ATTN, int lane) {
    constexpr float LOG2E = 1.4426950408889634f;
    const int kk = lane >> 2, part = lane & 3, cnt = (t + 1) < 256 ? (t + 1) : 256;
    const float slope2 = exp2f(-(float)(hd + 1)) * LOG2E, sc2 = 0.125f * LOG2E;
    float q[16];
    { const v4u qa = *(const v4u*)(Q + (size_t)t * AW + hd * 64 + part * 16), qb = *(const v4u*)(Q + (size_t)t * AW + hd * 64 + part * 16 + 8);
#pragma unroll
      for (int i = 0; i < 4; ++i) { q[2 * i] = bf_lo(qa[i]) * sc2; q[2 * i + 1] = bf_hi(qa[i]) * sc2; q[8 + 2 * i] = bf_lo(qb[i]) * sc2; q[8 + 2 * i + 1] = bf_hi(qb[i]) * sc2; } }
    const unsigned short* lp = SEL + (size_t)t * 256;
    const unsigned char* kb = K8 + (size_t)hd * M * 64 + part * 16; const unsigned char* vb = V8 + (size_t)hd * M * 64 + part * 16;
    int key[16]; v4u kf[16], vf[16];
#pragma unroll
    for (int r = 0; r < 16; ++r) { const int j = 16 * r + kk; key[r] = j < cnt ? (int)lp[j] : 0; }
#pragma unroll
    for (int r = 0; r < 16; ++r) { kf[r] = *(const v4u*)(kb + (size_t)key[r] * 64); vf[r] = *(const v4u*)(vb + (size_t)key[r] * 64); }
    float sv[16]; float mx = -INFINITY;
#pragma unroll
    for (int r = 0; r < 16; ++r) { float kx[16]; unpack16(kf[r], kx); float d = 0.f;
#pragma unroll
        for (int e = 0; e < 16; ++e) d = fmaf(q[e], kx[e], d);
        d += dppx<0xB1>(d); d += dppx<0x4E>(d);
        sv[r] = (16 * r + kk) < cnt ? d - slope2 * (float)(t - key[r]) : -INFINITY; mx = fmaxf(mx, sv[r]); }
    mx = fmaxf(mx, __shfl_xor(mx, 4)); mx = fmaxf(mx, __shfl_xor(mx, 8)); mx = fmaxf(mx, __shfl_xor(mx, 16)); mx = fmaxf(mx, __shfl_xor(mx, 32));
    float o[16], lsum = 0.f;
#pragma unroll
    for (int e = 0; e < 16; ++e) o[e] = 0.f;
#pragma unroll
    for (int r = 0; r < 16; ++r) { const float p = exp2f(sv[r] - mx); lsum += p; float vx[16]; unpack16(vf[r], vx);
#pragma unroll
        for (int e = 0; e < 16; ++e) o[e] = fmaf(p, vx[e], o[e]); }
    lsum += dppx<0x124>(lsum); lsum += dppx<0x128>(lsum); lsum += __shfl_xor(lsum, 16); lsum += __shfl_xor(lsum, 32);
#pragma unroll
    for (int e = 0; e < 16; ++e) { float v = o[e]; v += dppx<0x124>(v); v += dppx<0x128>(v); v += __shfl_xor(v, 16); v += __shfl_xor(v, 32); o[e] = v; }
    if (lane < 4) { const float inv = 1.0f / lsum; v4u a, b;
        a.x = pkbf(o[0] * inv, o[1] * inv); a.y = pkbf(o[2] * inv, o[3] * inv); a.z = pkbf(o[4] * inv, o[5] * inv); a.w = pkbf(o[6] * inv, o[7] * inv);
        b.x = pkbf(o[8] * inv, o[9] * inv); b.y = pkbf(o[10] * inv, o[11] * inv); b.z = pkbf(o[12] * inv, o[13] * inv); b.w = pkbf(o[14] * inv, o[15] * inv);
        *(v4u*)(ATTN + (size_t)t * AW + hd * 64 + part * 16) = a; *(v4u*)(ATTN + (size_t)t * AW + hd * 64 + part * 16 + 8) = b; }
}

struct TkPtrs { const bf16_t *QI, *KI; const float* WI; unsigned short* SEL; };
__device__ __forceinline__ void topk_attn_block(int qb, const TkPtrs& P, LAS unsigned char* lds, int tid, int wave, int lane, bool do_attn) {
    LAS unsigned* H = (LAS unsigned*)lds;
    LAS unsigned* SELM = (LAS unsigned*)lds;
    LAS unsigned* TIEM = (LAS unsigned*)(lds + 65536);
    LAS unsigned short* LIST = (LAS unsigned short*)(lds + LIST_OFF);
    LAS unsigned* STP = (LAS unsigned*)(lds + ST_OFF);
    LAS unsigned* STN = STP + 32;
    const int t0 = qb * 32, r = lane & 31, h = lane >> 5;
    SYNC();
    float wv[4];
    LAS bf16_t* QF = (LAS bf16_t*)(lds + LIST_OFF);
    { const bf16_t* qp = P.QI + (size_t)(t0 + r) * 256 + 8 * h;
#pragma unroll
      for (int k = 0; k < 2; ++k) { const int f = 2 * wave + k; *(LAS pg8::bf16x8*)(QF + f * 512 + lane * 8) = *(const pg8::bf16x8*)(qp + (f >> 2) * 64 + 16 * (f & 3)); }
      const f32x4 w4 = *(const f32x4*)(P.WI + (size_t)(t0 + r) * 4); wv[0] = w4[0]; wv[1] = w4[1]; wv[2] = w4[2]; wv[3] = w4[3]; }
    LAS unsigned* STC = STP + 64;
    LAS unsigned* STG = STP + 96;
    LAS unsigned* FB = STP + 160;
    LAS unsigned* STS = STP + 192;
    LAS float* FSEL = (LAS float*)(STP + 256);
    LAS float* FTIE = FSEL + 32;
    const bool negw = (wv[0] <= 0.f) && (wv[1] <= 0.f) && (wv[2] <= 0.f) && (wv[3] <= 0.f);
    const unsigned wbase = negw ? 7745u : 22976u;
#pragma unroll 1
    for (int rep_tk = 0; rep_tk < REP_TK; ++rep_tk) {
    if (wave == 0 && lane == 0) *FB = 0u;
#pragma unroll 1
    for (int mode = 0; mode < 2; ++mode) {
        if (mode == 1) { if (*FB == 0u) break; }
        if (wave == 0 && lane < 32) { STP[lane] = 0u; const int nv = t0 + lane + 1; STN[lane] = nv < 256 ? nv : 256; STG[lane] = negw ? 1u : 0u; }
        const int nstep = mode == 0 ? 2 : 3;
#pragma unroll 1
        for (int step = 0; step < nstep; ++step) {
            if (mode == 1 || step == 0) { for (int i = tid; i < 32 * HSTRIDE; i += NTHR) H[i] = 0u; }
            if (mode == 0 && step == 0 && wave == 0 && lane < 32) { STS[lane] = 0u; STS[32 + lane] = 64u; }
            SYNC();
            const int sh = mode == 0 ? 17 : (step == 0 ? 21 : (step == 1 ? 10 : 0));
            const unsigned vlo = mode == 0 ? wbase : (step == 0 ? 0u : (STP[r] << (step == 1 ? 11 : 10)));
            const unsigned vmin = (mode == 0 && step == 1) ? vlo + STS[r] : vlo;
            tk_pass<false>(qb, wave, lane, P.KI, QF, wv, H, SELM, TIEM, sh, vlo, mode == 0, (mode == 1 && step == 2) ? 1023u : 2047u, mode == 0 ? step + 1 : 0, vmin, 0.f, 0.f);
            SYNC();
            const bool samp = (mode == 0 && step == 0);
#pragma unroll 1
            for (int qq = 0; qq < 4; ++qq) { const int rq = 4 * wave + qq;
                tk_scan(H + rq * HSTRIDE, samp ? STS + rq : STP + rq, samp ? STS + 32 + rq : STN + rq, STC + rq, (mode == 1 && step == 2) ? 10 : 11, lane);
                if (mode == 0 && step == 1 && lane == 0) { const unsigned D = STP[rq], nn = STN[rq], c = STC[rq], ng = STG[rq] & 1u;
                    const bool zerobin = ng && D == 2047u, edge = (D == 0u) || (D == 2047u && !ng);
                    const bool wantc = (c > nn) && !zerobin;
                    if (edge || (wantc && c > 64u) || D < STS[rq]) lds_or(FB, 1u);
                    STG[rq] = ng | (wantc ? 2u : 0u);
                    const unsigned wb = ng ? 7745u : 22976u;
                    FTIE[rq] = u2f((wb + D) << 17); FSEL[rq] = zerobin ? INFINITY : u2f((wb + D + 1u) << 17); }
                if (mode == 1 && step == 2 && lane == 0) { const unsigned tau = STP[rq]; FTIE[rq] = u2f(tau); FSEL[rq] = tau == 0xffffffffu ? INFINITY : u2f(tau + 1u); } }
            SYNC();
        }
        if (mode == 0 && *FB != 0u) continue;
        tk_pass<true>(qb, wave, lane, P.KI, QF, wv, H, SELM, TIEM, 0, 0u, false, 0u, 0, 0u, FSEL[r], FTIE[r]);
        SYNC();
        break;
    }
    }
    if (!do_attn) return;
#pragma unroll 1
    for (int qq = 0; qq < 4; ++qq) {
        const int rq = 4 * wave + qq, t = t0 + rq; int mties = (int)STN[rq];
        unsigned tw[8], fw[8]; int S = 0;
#pragma unroll
        for (int i = 0; i < 8; ++i) { const int T = 8 * lane + i; const bool v = T <= qb; tw[i] = v ? TIEM[T * 32 + rq] : 0u; fw[i] = v ? SELM[T * 32 + rq] : 0u; S += __builtin_popcount(tw[i]); }
        int incl = S;
#pragma unroll
        for (int off = 1; off < 64; off <<= 1) { const int tt = __shfl_up(incl, off); if (lane >= off) incl += tt; }
        if (*FB == 0u && (STG[rq] & 2u)) {
            const int c = __shfl(incl, 63), nn = mties;
            LAS unsigned short* cl = LIST + rq * 256;
            { int pos = incl - S;
#pragma unroll
              for (int i = 0; i < 8; ++i) { unsigned w = tw[i]; while (w) { const int b = __builtin_ctz(w); if (pos < 64) cl[pos] = (unsigned short)(256 * lane + 32 * i + b); ++pos; w &= w - 1u; } } }
            LDS_WAIT(); asm volatile("" ::: "memory");
            const u32x2 q4 = *(const u32x2*)(P.QI + (size_t)t * 256 + 4 * lane); const float wh = P.WI[(size_t)t * 4 + (lane >> 4)];
            float mys = 0.f; const int cc = c < 64 ? c : 64;
            for (int j = 0; j < cc; ++j) { const int key = __builtin_amdgcn_readfirstlane((int)cl[j]); const float sj = tk_rescore(q4, wh, P.KI, key, lane); if (lane == j) mys = sj; }
            int rank = 0;
            for (int j = 0; j < cc; ++j) { const float sj = __shfl(mys, j); rank += (sj > mys || (sj == mys && j < lane)) ? 1 : 0; }
            const bool keepme = lane < cc && rank < nn; const int mykey = lane < cc ? (int)cl[lane] : 0;
#pragma unroll 1
            for (int j = 0; j < cc; ++j) { const int kj = __shfl(mykey, j); const int kp = __shfl((int)keepme, j);
                if (kp && (kj >> 8) == lane) {
#pragma unroll
                    for (int i = 0; i < 8; ++i) if (((kj >> 5) & 7) == i) fw[i] |= 1u << (kj & 31); } }
            mties = 0;
        }
        int take = mties - (incl - S); take = take < 0 ? 0 : (take > S ? S : take);
        int cl2 = 0;
#pragma unroll
        for (int i = 0; i < 8; ++i) { unsigned w = tw[i]; const int c = __builtin_popcount(w); unsigned keep;
            if (take >= c) { keep = w; take -= c; } else { keep = 0u; for (int k = 0; k < take; ++k) { const unsigned low = w & (0u - w); keep |= low; w ^= low; } take = 0; }
            fw[i] |= keep; cl2 += __builtin_popcount(fw[i]); }
        int inc2 = cl2;
#pragma unroll
        for (int off = 1; off < 64; off <<= 1) { const int tt = __shfl_up(inc2, off); if (lane >= off) inc2 += tt; }
        int pos = inc2 - cl2; const int cnt = __shfl(inc2, 63);
        LAS unsigned short* lp = LIST + rq * 256;
#pragma unroll
        for (int i = 0; i < 8; ++i) { unsigned w = fw[i]; while (w) { const int b = __builtin_ctz(w); if (pos < 256) lp[pos] = (unsigned short)(256 * lane + 32 * i + b); ++pos; w &= w - 1u; } }
        LDS_WAIT(); asm volatile("" ::: "memory");
        (void)cnt;
        *(u32x2*)(P.SEL + (size_t)t * 256 + 4 * lane) = *(const LAS u32x2*)(lp + 4 * lane);
    }
}

struct Args { const float* in[18]; float* out; unsigned char* ws; int ph_lo, ph_hi; };
constexpr int NPH = 13;

typedef const __attribute__((address_space(4))) unsigned long long* kargp_t;
#define KARGS() kargp_t kargs = (kargp_t)__builtin_amdgcn_kernarg_segment_ptr(); asm volatile("" : "+s"(kargs)); GAS unsigned char* const ws = (GAS unsigned char*)kargs[19]; (void)ws
#define KIN(i) ((const float*)(const GAS float*)kargs[(i)])
#define KOUT() ((float*)(GAS float*)kargs[18])
#define WSP(T, off) ((T*)(GAS T*)(ws + (off)))
__global__ void __launch_bounds__(NTHR, 2) fwd_kernel(Args a) {
    extern __shared__ __attribute__((aligned(16))) unsigned char lds_raw[];
    LAS unsigned char* lds = (LAS unsigned char*)lds_raw;
    const int lo = a.ph_lo, hi = a.ph_hi;
    { int tid0 = threadIdx.x; asm volatile("" : "+v"(tid0)); for (int u = tid0; u < (LDS_BYTES - MISC_OFF) / 4; u += NTHR) ((LAS unsigned*)(lds + MISC_OFF))[u] = 0u; }
    SYNC();
    XcdBarrier bar; bar.bar = nullptr; bar.x = 0; bar.st = nullptr;
    if (hi - lo > 1) { KARGS(); bar = xcd_barrier_post((unsigned*)(GAS unsigned*)(ws + WS_CTL) + CW_BAR, (volatile LAS unsigned*)(lds + MISC_OFF) + 8); }
#define IN(k) (lo <= (k) && (k) < hi)
#define SEAM(k) do { if (IN(k) && IN((k) + 1)) xcd_barrier(bar); } while (0)
#define IDS() const int tid = threadIdx.x, lane = tid & 63, wave = __builtin_amdgcn_readfirstlane(tid >> 6), G = gridDim.x, bid = blockIdx.x; (void)lane; (void)wave; (void)G; (void)bid

    for (int rep_ph = 0; rep_ph < ((REP_PH == 0) ? 2 : 1); ++rep_ph) if (IN(0)) { KARGS(); IDS();
        P0Ptrs P{KIN(1), KIN(2), KIN(5), KIN(8), KIN(9), KIN(11), KIN(12), KIN(14), KIN(17), WSP(bf16_t, WS_WIN), WSP(bf16_t, WS_WATTN), WSP(bf16_t, WS_WGRP), WSP(bf16_t, WS_WPOOL), WSP(bf16_t, WS_WOUT),
                 WSP(bf16_t, WS_WUP), WSP(bf16_t, WS_WDOWN), WSP(float, WS_MODP)};
        p0_prologue(P, lds, bid * NWAVES + wave, G * NWAVES, wave, lane);
    }
    SEAM(0);
    if (IN(1)) { KARGS(); IDS();
        const float *b_ada = KIN(3), *norm1_g = KIN(4); const float* MODP = WSP(float, WS_MODP); float* MODF = WSP(float, WS_MODF);
        LAS float* mulv = (LAS float*)lds; LAS float* addv = mulv + 1024;
        for (int i = tid; i < 1024; i += NTHR) { float sh = b_ada[i], scv = b_ada[1024 + i];
#pragma unroll
            for (int kc = 0; kc < 16; ++kc) { sh += MODP[kc * NMOD + i]; scv += MODP[kc * NMOD + 1024 + i]; }
            mulv[i] = norm1_g[i] * (1.0f + scv); addv[i] = sh; }
        if (bid < 24 && tid < 256) { const int i = bid * 256 + tid; float v = b_ada[i];
#pragma unroll
            for (int kc = 0; kc < 16; ++kc) v += MODP[kc * NMOD + i];
            MODF[i] = v; }
        SYNC();
        modulate_rows(KIN(0), WSP(bf16_t, WS_H), mulv, addv, bid * NWAVES + wave, G * NWAVES, lane);
        SYNC();
    }
    SEAM(1);
    for (int rep_ph = 0; rep_ph < ((REP_PH == 2) ? 2 : 1); ++rep_ph) if (IN(2)) { KARGS(); IDS();
        pg8::Gemm g{WSP(bf16_t, WS_H), WSP(bf16_t, WS_WIN), M, NINP, DM}; pg8::StaticOrder S; S.init(M, NINP, G, bid);
        EpiProj E{WSP(bf16_t, WS_Q), WSP(unsigned char, WS_K), WSP(unsigned char, WS_V), WSP(bf16_t, WS_QI), WSP(bf16_t, WS_KI), WSP(bf16_t, WS_UPOOL), WSP(bf16_t, WS_GA), WSP(bf16_t, WS_GP), WSP(float, WS_WI), KIN(6), KIN(7)};
        pg8::gemm_phase<EpiProj, pg8::StaticOrder, true, true>(lds, g, S, E);
    }
    SEAM(2);
    if (IN(3)) { KARGS(); IDS();
        pooled_phase(WSP(bf16_t, WS_UPOOL), WSP(bf16_t, WS_POOLED), bid * NTHR + tid, G * NTHR);
        TkPtrs T{WSP(bf16_t, WS_QI), WSP(bf16_t, WS_KI), WSP(float, WS_WI), WSP(unsigned short, WS_SEL)};
        unsigned* qctr = (unsigned*)(GAS unsigned*)(ws + WS_CTL) + CW_QUEUE;
        LAS int* qslot = (LAS int*)(lds + ST_OFF + 2040);
#pragma unroll 1
        for (;;) {
            SYNC();
            if (tid == 0) *qslot = (int)__hip_atomic_fetch_add(qctr, 1u, __ATOMIC_RELAXED, __HIP_MEMORY_SCOPE_AGENT);
            SYNC();
            const int qi = *qslot;
            if (qi >= 512 * (1 + REP_TKONLY)) break;
            topk_attn_block(511 - (qi & 511), T, lds, tid, wave, lane, qi >= 512 * REP_TKONLY);
        }
        SYNC();
    }
    SEAM(3);
    if (IN(4)) { KARGS(); IDS();
        const unsigned short* SEL = WSP(unsigned short, WS_SEL); const bf16_t* Qp = WSP(bf16_t, WS_Q); const unsigned char *K8 = WSP(unsigned char, WS_K), *V8 = WSP(unsigned char, WS_V); bf16_t* ATTN = WSP(bf16_t, WS_ATTN);
        if ((G & 7) == 0) { const int hd = bid & 7, wl = (bid >> 3) * NWAVES + wave, NW = (G >> 3) * NWAVES;
#pragma unroll 1
            for (int t = wl; t < M; t += NW) attn_item(t, hd, SEL, Qp, K8, V8, ATTN, lane);
        } else {
#pragma unroll 1
            for (int it = bid * NWAVES + wave; it < 8 * M; it += G * NWAVES) attn_item(it >> 3, it & 7, SEL, Qp, K8, V8, ATTN, lane);
        }
    }
    SEAM(4);
    for (int rep_ph = 0; rep_ph < ((REP_PH == 5) ? 2 : 1); ++rep_ph) if (IN(5)) { KARGS(); IDS();
        pg8::Gemm g{WSP(bf16_t, WS_POOLED), WSP(bf16_t, WS_WGRP), M, PW, PW}; pg8::StaticOrder S; S.init(M, PW, G, bid);
        EpiBf<0> E{WSP(bf16_t, WS_POOLMIX), PW, KIN(10), nullptr};
        pg8::gemm_phase<EpiBf<0>, pg8::StaticOrder, true, true>(lds, g, S, E);
    }
    SEAM(5);
    if (IN(6)) { KARGS(); IDS();
        pg8::Gemm g{WSP(bf16_t, WS_POOLMIX), WSP(bf16_t, WS_WPOOL), M, DM, PW}; pg8::StaticOrder S; S.init(M, DM, G, bid);
        EpiBf<1> E{WSP(bf16_t, WS_GP), DM, nullptr, nullptr};
        pg8::gemm_phase<EpiBf<1>, pg8::StaticOrder, true, true>(lds, g, S, E);
    }
    SEAM(6);
    if (IN(7)) { KARGS(); IDS();
        pg8::Gemm g{WSP(bf16_t, WS_ATTN), WSP(bf16_t, WS_WATTN), M, DM, AW}; pg8::StaticOrder S; S.init(M, DM, G, bid);
        EpiBf<2> E{WSP(bf16_t, WS_GA), DM, nullptr, WSP(bf16_t, WS_GP)};
        pg8::gemm_phase<EpiBf<2>, pg8::StaticOrder, true, true>(lds, g, S, E);
    }
    SEAM(7);
    for (int rep_ph = 0; rep_ph < ((REP_PH == 8) ? 2 : 1); ++rep_ph) if (IN(8)) { KARGS(); IDS();
        pg8::Gemm g{WSP(bf16_t, WS_GA), WSP(bf16_t, WS_WOUT), M, DM, DM}; pg8::StaticOrder S; S.init(M, DM, G, bid);
        EpiRes E{KIN(0), KOUT(), WSP(float, WS_MODF) + 2048, 0.f};
        pg8::gemm_phase<EpiRes, pg8::StaticOrder, true, true>(lds, g, S, E);
    }
    SEAM(8);
    if (IN(9)) { KARGS(); IDS();
        const float* norm2_g = KIN(13); const float* MODF = WSP(float, WS_MODF);
        LAS float* mulv = (LAS float*)lds; LAS float* addv = mulv + 1024;
        for (int i = tid; i < 1024; i += NTHR) { mulv[i] = norm2_g[i] * (1.0f + MODF[4096 + i]); addv[i] = MODF[3072 + i]; }
        SYNC();
        modulate_rows(KOUT(), WSP(bf16_t, WS_H), mulv, addv, bid * NWAVES + wave, G * NWAVES, lane);
        SYNC();
    }
    SEAM(9);
    for (int rep_ph = 0; rep_ph < ((REP_PH == 10) ? 2 : 1); ++rep_ph) if (IN(10)) { KARGS(); IDS();
        pg8::Gemm g{WSP(bf16_t, WS_H), WSP(bf16_t, WS_WUP), M, FF2, DM}; pg8::StaticOrder S; S.init(M, FF2, G, bid);
        EpiUpAct E{WSP(bf16_t, WS_ACT), WSP(float, WS_RAW), KIN(15), KIN(16)};
        pg8::gemm_phase<EpiUpAct, pg8::StaticOrder, true, true>(lds, g, S, E);
    }
    SEAM(10);
    if (IN(11)) { KARGS(); IDS(); fixup_phase(WSP(float, WS_RAW), WSP(bf16_t, WS_ACT), KIN(15), KIN(16), bid * NTHR + tid, G * NTHR); }
    SEAM(11);
    if (IN(12)) { KARGS(); IDS();
        pg8::Gemm g{WSP(bf16_t, WS_ACT), WSP(bf16_t, WS_WDOWN), M, DM, FF}; pg8::StaticOrder S; S.init(M, DM, G, bid);
        EpiRes E{KOUT(), KOUT(), WSP(float, WS_MODF) + 5120, DBG_C};
        pg8::gemm_phase<EpiRes, pg8::StaticOrder, true, true>(lds, g, S, E);
    }
#undef IN
#undef SEAM
}

extern "C" void kernel_launch(void* const* d_in, const int* in_sizes, int n_in, void* d_out, int out_size, void* d_ws, size_t ws_size, hipStream_t stream) {
    static int grid = 0;
    if (grid == 0) {
        if (n_in != 18 || in_sizes[0] != M * DM || out_size != M * DM || ws_size < WS_END) { fprintf(stderr, "kernel_launch: unexpected shapes (n_in %d, in0 %d, out %d, ws %zu)\n", n_in, n_in > 0 ? in_sizes[0] : -1, out_size, ws_size); grid = -1; return; }
        int dev = 0, cus = 0, per_cu = 0;
        if (hipGetDevice(&dev) != hipSuccess || hipDeviceGetAttribute(&cus, hipDeviceAttributeMultiprocessorCount, dev) != hipSuccess) { grid = -1; return; }
        if (hipFuncSetAttribute((const void*)fwd_kernel, hipFuncAttributeMaxDynamicSharedMemorySize, LDS_BYTES) != hipSuccess) { fprintf(stderr, "kernel_launch: hipFuncSetAttribute failed\n"); grid = -1; return; }
        if (hipOccupancyMaxActiveBlocksPerMultiprocessor(&per_cu, (const void*)fwd_kernel, NTHR, LDS_BYTES) != hipSuccess || per_cu < 1) fprintf(stderr, "kernel_launch: occupancy query says %d\n", per_cu);
        (void)hipGetLastError();
        grid = cus;
    }
    if (grid < 0) return;
    (void)hipMemsetAsync((char*)d_ws + WS_CTL, 0, CTL_ZERO_BYTES, stream);
    Args a{};
    for (int i = 0; i < 18; ++i) a.in[i] = (const float*)d_in[i];
    a.out = (float*)d_out; a.ws = (unsigned char*)d_ws;
#if N_LAUNCH_MODE == 1
    a.ph_lo = 0; a.ph_hi = NPH;
    hipLaunchKernelGGL(fwd_kernel, dim3(grid), dim3(NTHR), LDS_BYTES, stream, a);
#else
    for (int p = 0; p < NPH; ++p) { a.ph_lo = p; a.ph_hi = p + 1; hipLaunchKernelGGL(fwd_kernel, dim3(grid), dim3(NTHR), LDS_BYTES, stream, a); }
#endif
}
```

```cpp
#ifndef REP_TKONLY
#define REP_TKONLY 0
#endif
#ifndef REP_BLK
#define REP_BLK 1
#endif
#include <hip/hip_runtime.h>
#include <cstdio>
#include <cstdint>
namespace pg8 {
#define PG8_LAS __attribute__((address_space(3)))
typedef unsigned short bf16_t;
typedef short bf16x8 __attribute__((ext_vector_type(8)));
typedef float f32x4 __attribute__((ext_vector_type(4)));
typedef unsigned u32x4 __attribute__((ext_vector_type(4)));
constexpr int BM = 256, BK = 64, HALF = 128, HTB = HALF * BK * 2  , STAGE_BYTES = 8 * HTB, NXCD = 8, WGM = 8;

__host__ __device__ __forceinline__ int lds_byte(int r, int c) { const int st = (r >> 4) * 2 + (c >> 5), rr = r & 15, cc = c & 31, ob = rr * 64 + cc * 2; return st * 1024 + (ob ^ (((ob >> 9) & 1) << 5)); }
__host__ __device__ __forceinline__ void stage_rc(int b, int& R, int& C) { const int st = b / 1024, sb = b % 1024, swz = sb ^ (((sb >> 9) & 1) << 5); R = (st >> 1) * 16 + swz / 64; C = (st & 1) * 32 + (swz % 64) / 2; }
__host__ __device__ __forceinline__ int perm32(int rho) { const int n = rho >> 4, i = rho & 15; return 8 * (i >> 2) + 4 * n + (i & 3); }

struct Unit { int pm, pn; };
struct Gemm { const bf16_t* A; const bf16_t* Bt; int M, N, K; };

struct StaticOrder {
    int nM, nN, nwg, G, c;
    __host__ __device__ void init(int M, int N, int G_, int c_) { nM = M / BM; nN = N / BM; nwg = nM * nN; G = G_; c = c_; }
    __host__ __device__ bool next(int i, Unit& u) const {
        const long L = (long)i * G + c; if (L >= nwg) return false;
        int wgid = (int)L; { const int q = nwg / NXCD, r = nwg % NXCD, xcd = wgid % NXCD, off = wgid / NXCD; wgid = (xcd < r ? xcd * (q + 1) : r * (q + 1) + (xcd - r) * q) + off; }
        const int nig = WGM * nN, gid = wgid / nig, fm = gid * WGM, gsz = (nM - fm) < WGM ? (nM - fm) : WGM;
        u.pm = fm + ((wgid % nig) % gsz); u.pn = (wgid % nig) / gsz; return true;
    }
    __device__ __forceinline__ void a_ready(const Unit&) const {}
    __device__ __forceinline__ void done(const Unit&) const {}
};

__device__ __forceinline__ unsigned cvt_pk_bf16(float lo, float hi) { unsigned r; asm volatile("v_cvt_pk_bf16_f32 %0, %1, %2" : "=v"(r) : "v"(lo), "v"(hi)); return r; }
template <class Epi, class Sched, bool ALIGN_EPI = false, bool SP2 = false>
__device__ __forceinline__ void gemm_phase(PG8_LAS unsigned char* lds, const Gemm g, const Sched& S, const Epi& E) {
    int tid_ = threadIdx.x; asm volatile("" : "+v"(tid_));
    const int tid = tid_, wid = __builtin_amdgcn_readfirstlane(tid >> 6), lane = tid & 63, wr = wid >> 2, wc = wid & 3, fr = lane & 15, fq = lane >> 4;
    const int K = g.K, nt = K / BK;
    unsigned voffA[2], voffB[2];
#pragma unroll
    for (int i = 0; i < 2; ++i) { int R, C; stage_rc(tid * 16 + i * 8192, R, C); const int Rb = Epi::PERM ? ((R & ~31) + perm32(R & 31)) : R;
        voffA[i] = (unsigned)(R * K + C) * 2u; voffB[i] = (unsigned)(Rb * K + C) * 2u; }
    const size_t kstep = (size_t)(BK * 2);
    const size_t hstep = (size_t)HALF * K * 2;
    const size_t tstep = 2 * hstep;
    const unsigned ldsw = (unsigned)wid * 1024u;
    const int aoff = lds_byte(wr * 64 + fr, fq * 8), boff = lds_byte(wc * 32 + fr, fq * 8);
#define PG8_SA(b, h) (((b) * 2 + (h)) * HTB)
#define PG8_SB(b, h) ((4 + (b) * 2 + (h)) * HTB)
#define PG8_STAGE(bufoff, gbase, voff) do { _Pragma("unroll") for (int _i = 0; _i < 2; ++_i) \
        __builtin_amdgcn_global_load_lds((const unsigned*)((const char*)(gbase) + (voff)[_i]), (PG8_LAS unsigned*)(lds + (bufoff) + ldsw + _i * 8192), 16, 0, 0); } while (0)
#define PG8_LDA(dst, b, h) do { _Pragma("unroll") for (int m = 0; m < 4; ++m) _Pragma("unroll") for (int k = 0; k < 2; ++k) dst[m][k] = *(const PG8_LAS bf16x8*)(lds + PG8_SA(b, h) + aoff + m * 2048 + k * 1024); } while (0)
#define PG8_LDB(dst, b, h) do { _Pragma("unroll") for (int n = 0; n < 2; ++n) _Pragma("unroll") for (int k = 0; k < 2; ++k) dst[n][k] = *(const PG8_LAS bf16x8*)(lds + PG8_SB(b, h) + boff + n * 2048 + k * 1024); } while (0)
#define PG8_MMA(ai, bj, At, Bt) do { __builtin_amdgcn_s_setprio(1); _Pragma("unroll") for (int m = 0; m < 4; ++m) _Pragma("unroll") for (int n = 0; n < 2; ++n) _Pragma("unroll") for (int k = 0; k < 2; ++k) \
        acc[ai][bj][m][n] = __builtin_amdgcn_mfma_f32_16x16x32_bf16(Bt[n][k], At[m][k], acc[ai][bj][m][n], 0, 0, 0); __builtin_amdgcn_s_setprio(0); } while (0)
#define PG8_WAIT_V(n) asm volatile("s_waitcnt vmcnt(" #n ")" ::: "memory")
#define PG8_WAIT_L(n) asm volatile("s_waitcnt lgkmcnt(" #n ")" ::: "memory")
#define PG8_BAR __builtin_amdgcn_s_barrier()
#define PG8_SCHED __builtin_amdgcn_sched_barrier(0)
    Unit cur, nxt; int ui = 0;
    if (!S.next(0, cur)) return;
    f32x4 acc[2][2][4][2];
#pragma unroll
    for (int a = 0; a < 2; ++a)
#pragma unroll
        for (int b = 0; b < 2; ++b)
#pragma unroll
            for (int m = 0; m < 4; ++m)
#pragma unroll
                for (int n = 0; n < 2; ++n) acc[a][b][m][n] = (f32x4){0.f, 0.f, 0.f, 0.f};
    bf16x8 At[4][2], B0[2][2], B1[2][2];
    const char* cA = (const char*)g.A + (size_t)cur.pm * tstep; const char* cB = (const char*)g.Bt + (size_t)cur.pn * tstep;
    S.a_ready(cur);
    if constexpr (SP2) {
        PG8_STAGE(PG8_SB(0, 0), cB, voffB); PG8_STAGE(PG8_SB(0, 1), cB + hstep, voffB); PG8_STAGE(PG8_SA(0, 0), cA, voffA); PG8_STAGE(PG8_SA(0, 1), cA + hstep, voffA);
        if (wr == 1) PG8_BAR;
        PG8_WAIT_V(2); PG8_BAR;
        PG8_STAGE(PG8_SB(1, 0), cB + kstep, voffB); PG8_STAGE(PG8_SA(1, 0), cA + kstep, voffA); PG8_STAGE(PG8_SB(1, 1), cB + hstep + kstep, voffB);
        PG8_WAIT_V(6); PG8_BAR;
    } else {
        PG8_STAGE(PG8_SB(0, 0), cB, voffB); PG8_STAGE(PG8_SA(0, 0), cA, voffA); PG8_STAGE(PG8_SB(0, 1), cB + hstep, voffB); PG8_STAGE(PG8_SA(0, 1), cA + hstep, voffA);
        if (wr == 1) PG8_BAR;
        PG8_WAIT_V(4); PG8_BAR;
        PG8_STAGE(PG8_SB(1, 0), cB + kstep, voffB); PG8_STAGE(PG8_SA(1, 0), cA + kstep, voffA); PG8_STAGE(PG8_SB(1, 1), cB + hstep + kstep, voffB);
        PG8_WAIT_V(6); PG8_BAR;
    }
    for (;;) {
        const bool has_next = S.next(ui + 1, nxt);
        const char* nA = has_next ? (const char*)g.A + (size_t)nxt.pm * tstep : cA; const char* nB = has_next ? (const char*)g.Bt + (size_t)nxt.pn * tstep : cB;
        for (int t = 0; t < nt; t += 2) {
            const bool last = (t == nt - 2);
            const char* a1 = cA + (size_t)(t + 1) * kstep;
            const char* a2 = last ? nA : cA + (size_t)(t + 2) * kstep; const char* b2 = last ? nB : cB + (size_t)(t + 2) * kstep;
            const char* a3 = a2 + kstep; const char* b3 = b2 + kstep;
            if (last && has_next) S.a_ready(nxt);
            if constexpr (SP2) {
            PG8_LDB(B0, 0, 0); PG8_LDB(B1, 0, 1); PG8_SCHED; PG8_LDA(At, 0, 0); PG8_STAGE(PG8_SA(1, 1), a1 + hstep, voffA);
            PG8_WAIT_V(8); PG8_WAIT_L(0); PG8_BAR; PG8_MMA(0, 0, At, B0); PG8_MMA(0, 1, At, B1); PG8_BAR; PG8_SCHED;
            PG8_LDA(At, 0, 1); PG8_STAGE(PG8_SB(0, 0), b2, voffB); PG8_STAGE(PG8_SB(0, 1), b2 + hstep, voffB); PG8_STAGE(PG8_SA(0, 0), a2, voffA);
            PG8_WAIT_V(8); PG8_WAIT_L(0); PG8_BAR; PG8_MMA(1, 0, At, B0); PG8_MMA(1, 1, At, B1); PG8_BAR; PG8_SCHED;
            PG8_LDB(B0, 1, 0); PG8_LDB(B1, 1, 1); PG8_SCHED; PG8_LDA(At, 1, 0); PG8_STAGE(PG8_SA(0, 1), a2 + hstep, voffA);
            PG8_WAIT_V(8); PG8_WAIT_L(0); PG8_BAR; PG8_MMA(0, 0, At, B0); PG8_MMA(0, 1, At, B1); PG8_BAR; PG8_SCHED;
            PG8_LDA(At, 1, 1); PG8_STAGE(PG8_SB(1, 0), b3, voffB); PG8_STAGE(PG8_SB(1, 1), b3 + hstep, voffB); PG8_STAGE(PG8_SA(1, 0), a3, voffA);
            PG8_WAIT_V(8); PG8_WAIT_L(0); PG8_BAR; PG8_MMA(1, 0, At, B0); PG8_MMA(1, 1, At, B1); PG8_BAR; PG8_SCHED;
            } else {
            PG8_LDB(B0, 0, 0); PG8_SCHED; PG8_LDA(At, 0, 0); PG8_STAGE(PG8_SA(1, 1), a1 + hstep, voffA);
            PG8_WAIT_L(8); PG8_BAR; PG8_WAIT_L(0); PG8_MMA(0, 0, At, B0); PG8_BAR; PG8_SCHED;
            PG8_LDB(B1, 0, 1); PG8_STAGE(PG8_SB(0, 0), b2, voffB);
            PG8_BAR; PG8_WAIT_L(0); PG8_MMA(0, 1, At, B1); PG8_BAR;
            PG8_LDA(At, 0, 1); PG8_STAGE(PG8_SA(0, 0), a2, voffA);
            PG8_BAR; PG8_WAIT_L(0); PG8_MMA(1, 0, At, B0); PG8_BAR; PG8_SCHED;
            PG8_STAGE(PG8_SB(0, 1), b2 + hstep, voffB);
            PG8_WAIT_V(6); PG8_BAR; PG8_MMA(1, 1, At, B1); PG8_BAR;
            PG8_LDB(B0, 1, 0); PG8_SCHED; PG8_LDA(At, 1, 0); PG8_STAGE(PG8_SA(0, 1), a2 + hstep, voffA);
            PG8_WAIT_L(8); PG8_BAR; PG8_WAIT_L(0); PG8_MMA(0, 0, At, B0); PG8_BAR; PG8_SCHED;
            PG8_LDB(B1, 1, 1); PG8_STAGE(PG8_SB(1, 0), b3, voffB);
            PG8_BAR; PG8_WAIT_L(0); PG8_MMA(0, 1, At, B1); PG8_BAR;
            PG8_LDA(At, 1, 1); PG8_STAGE(PG8_SA(1, 0), a3, voffA);
            PG8_BAR; PG8_WAIT_L(0); PG8_MMA(1, 0, At, B0); PG8_BAR; PG8_SCHED;
            PG8_STAGE(PG8_SB(1, 1), b3 + hstep, voffB);
            PG8_WAIT_V(6); PG8_BAR; PG8_MMA(1, 1, At, B1); PG8_BAR;
            }
        }
        if constexpr (ALIGN_EPI) { if (wr == 0) PG8_BAR; }
        if constexpr (!Epi::AFTER_DRAIN) { E(acc, cur, wr, wc, fr, fq); S.done(cur); }
        if (!has_next) break;
#pragma unroll
        for (int a = 0; a < 2; ++a)
#pragma unroll
            for (int b = 0; b < 2; ++b)
#pragma unroll
                for (int m = 0; m < 4; ++m)
#pragma unroll
                    for (int n = 0; n < 2; ++n) acc[a][b][m][n] = (f32x4){0.f, 0.f, 0.f, 0.f};
        cur = nxt; cA = nA; cB = nB; ++ui;
        if constexpr (ALIGN_EPI) { if (wr == 1) PG8_BAR; }
    }
    PG8_WAIT_V(0);
    if constexpr (!ALIGN_EPI) { if (wr == 0) PG8_BAR; }
    PG8_BAR;
    if constexpr (Epi::AFTER_DRAIN) { E.fused(acc, cur, wr, wc, fr, fq, lds, wid, lane); S.done(cur); }
#undef PG8_SA
#undef PG8_SB
#undef PG8_STAGE
#undef PG8_LDA
#undef PG8_LDB
#undef PG8_MMA
#undef PG8_WAIT_V
#undef PG8_WAIT_L
#undef PG8_BAR
#undef PG8_SCHED
}
}
#define GAS __attribute__((address_space(1)))
#define LAS __attribute__((address_space(3)))
typedef unsigned short bf16;
typedef unsigned v4u __attribute__((ext_vector_type(4)));
typedef float f32x4 __attribute__((ext_vector_type(4)));
typedef short bf16x8 __attribute__((ext_vector_type(8)));
typedef GAS unsigned gu32;
typedef GAS unsigned long long gu64;
#define RLX_AGENT __ATOMIC_RELAXED, __HIP_MEMORY_SCOPE_AGENT
#define LDS_WAIT() asm volatile("s_waitcnt lgkmcnt(0)" ::: "memory")
#define VM_WAIT() asm volatile("s_waitcnt vmcnt(0)" ::: "memory")
__device__ __forceinline__ unsigned long long rt() { return __builtin_amdgcn_s_memrealtime(); }
__device__ __forceinline__ unsigned f2bf(float f) { unsigned u = __builtin_bit_cast(unsigned, f); return (u + 0x7fffu + ((u >> 16) & 1u)) >> 16; }
__device__ __forceinline__ unsigned pk2(float lo, float hi) { return f2bf(lo) | (f2bf(hi) << 16); }

#define XB_TMO      128
#define XB_XCNT(j)  (256  + 64 * (j))
#define XB_XSUB(j)  (1280 + 64 * (j))
#define XB_XGEN(j)  (2304 + 64 * (j))
#define XB_TOP      3328
#define XB_TOPGEN   3392
#define XCD_BAR_WORDS 3456
#define XB_SPIN_CAP (1u << 18)

__device__ __forceinline__ unsigned xb_ld(unsigned* p)              { return __hip_atomic_load(p, __ATOMIC_RELAXED, __HIP_MEMORY_SCOPE_AGENT); }
__device__ __forceinline__ unsigned xb_add(unsigned* p, unsigned v) { return __hip_atomic_fetch_add(p, v, __ATOMIC_RELAXED, __HIP_MEMORY_SCOPE_AGENT); }
__device__ __forceinline__ unsigned xb_xcc_id() { return (unsigned)__builtin_amdgcn_s_getreg((3 << 11) | 20) & 0xFu; }
#define XB_SPIN(cond, bar) do { unsigned _sp = 0; while (cond) { __builtin_amdgcn_s_sleep(1); \
    if ((++_sp & 255u) == 0u) { if (xb_ld(&(bar)[XB_TMO])) break; if (_sp > XB_SPIN_CAP) { atomicAdd(&(bar)[XB_TMO], 1u); break; } } } } while (0)

struct XcdBarrier {
    unsigned* bar; unsigned x;
    volatile LAS unsigned* st;
};

__device__ __forceinline__ XcdBarrier xcd_barrier_post(unsigned* bar, volatile LAS unsigned* st) {
    XcdBarrier b; b.bar = bar; b.x = xb_xcc_id(); b.st = st;
    if (threadIdx.x == 0) (void)xb_add(&bar[XB_XCNT(b.x)], 1u);
    return b;
}
__device__ __forceinline__ void xcd_barrier_complete(unsigned* bar, unsigned x, unsigned& nloc, unsigned& nx) {
    const unsigned G = gridDim.x * gridDim.y * gridDim.z;
    unsigned sum, cnt, mine, sp = 0u;
    for (;;) {
        sum = 0u; cnt = 0u; mine = 0u;
#pragma unroll
        for (unsigned j = 0; j < 16; ++j) { const unsigned c = xb_ld(&bar[XB_XCNT(j)]); sum += c; cnt += (c > 0u) ? 1u : 0u; mine = (j == x) ? c : mine; }
        if (sum == G) break;
        __builtin_amdgcn_s_sleep(1);
        if ((++sp & 255u) == 0u) { if (xb_ld(&bar[XB_TMO])) break; if (sp > XB_SPIN_CAP) { atomicAdd(&bar[XB_TMO], 1u); break; } }
    }
    nloc = mine > 0u ? mine : 1u; nx = cnt > 0u ? cnt : 1u;
}

__device__ __forceinline__ void xcd_barrier(const XcdBarrier& b) {
    asm volatile("s_waitcnt vmcnt(0)" ::: "memory");
    __syncthreads();
    if (threadIdx.x == 0) {
        unsigned* bar = b.bar;
        __builtin_amdgcn_s_waitcnt(0);
        unsigned nloc = b.st[0], nx = b.st[1];
        if (nloc == 0u) { xcd_barrier_complete(bar, b.x, nloc, nx); b.st[0] = nloc; b.st[1] = nx; }
        const unsigned old = xb_add(&bar[XB_XSUB(b.x)], 1u);
        const unsigned gen = old / nloc;
        if (old + 1u == (gen + 1u) * nloc) {
            __builtin_amdgcn_fence(__ATOMIC_RELEASE, "agent");
            asm volatile("s_waitcnt vmcnt(0)" ::: "memory");
            const unsigned og = xb_add(&bar[XB_TOP], 1u);
            const unsigned tg = og / nx;
            if (og + 1u == (tg + 1u) * nx) xb_add(&bar[XB_TOPGEN], 1u);
            else XB_SPIN(xb_ld(&bar[XB_TOPGEN]) == tg, bar);
            __builtin_amdgcn_fence(__ATOMIC_ACQUIRE, "agent");
            xb_add(&bar[XB_XGEN(b.x)], 1u);
            asm volatile("s_waitcnt vmcnt(0)" ::: "memory");
        } else {
            XB_SPIN(xb_ld(&bar[XB_XGEN(b.x)]) == gen, bar);
            __builtin_amdgcn_fence(__ATOMIC_ACQUIRE, "agent");
            asm volatile("s_waitcnt vmcnt(0)" ::: "memory");
        }
    }
    __syncthreads();
}


#ifndef STAGE
#define STAGE 3
#endif
#ifndef N_LAUNCH_MODE
#define N_LAUNCH_MODE 1
#endif
#ifndef REP_TK
#define REP_TK 1
#endif
#ifndef REP_AT
#define REP_AT 1
#endif
#ifndef REP_PH
#define REP_PH -1
#endif
#ifndef TK_PREFETCH
#define TK_PREFETCH 1
#endif
#ifndef DBG_C
#define DBG_C 0.0f
#endif

typedef float f32x16 __attribute__((ext_vector_type(16)));
typedef __attribute__((ext_vector_type(2))) __bf16 bf16x2_t;
using pg8::bf16_t; using pg8::Unit;

constexpr int M = 16384, DM = 1024, NHEAD = 8, HD = 64, AW = 512, PW = 512, FF = 2816, FF2 = 5632, NIN = 4420, NINP = 4608, NMOD = 6144;
constexpr float EPS = 1e-6f;
constexpr int NWAVES = 8, NTHR = 512;

constexpr size_t MiB = 1u << 20;
constexpr size_t WS_CTL = 0, CTL_ZERO_BYTES = 64 * 1024;
constexpr size_t WS_WIN = 1 * MiB, WS_WATTN = 10 * MiB, WS_WGRP = 11 * MiB, WS_WPOOL = 11 * MiB + 512 * 1024, WS_WOUT = 12 * MiB + 512 * 1024,
                 WS_WUP = 14 * MiB + 512 * 1024, WS_WDOWN = 25 * MiB + 512 * 1024;
constexpr size_t WS_MODP = 31 * MiB, WS_MODF = 31 * MiB + 393216, WS_WI = 31 * MiB + 512 * 1024;
constexpr size_t WS_H = 32 * MiB;
constexpr size_t WS_Q = 64 * MiB, WS_K = 80 * MiB, WS_V = 96 * MiB;
constexpr size_t WS_SEL = 88 * MiB;
constexpr size_t WS_QI = 112 * MiB, WS_KI = 120 * MiB;
constexpr size_t WS_UPOOL = 128 * MiB, WS_POOLED = 144 * MiB, WS_POOLMIX = 160 * MiB, WS_ATTN = 176 * MiB;
constexpr size_t WS_GA = 192 * MiB, WS_GP = 224 * MiB;
constexpr size_t WS_ACT = 64 * MiB;
constexpr size_t WS_RAW = 152 * MiB;
constexpr size_t WS_END = 256 * MiB;
constexpr int CW_BAR = 1024, CW_QUEUE = 512;

constexpr int LDS_BYTES = 163840;
constexpr int HSTRIDE = 1025, MSTRIDE = 513;
constexpr int LIST_OFF = 135168, ST_OFF = 151552, MISC_OFF = 159744;

#define SYNC() __syncthreads()
__device__ __forceinline__ float wave_sum(float v) {
#pragma unroll
    for (int o = 1; o < 64; o <<= 1) v += __shfl_xor(v, o);
    return v;
}
__device__ __forceinline__ float bf_lo(unsigned w) { return __builtin_bit_cast(float, w << 16); }
__device__ __forceinline__ float bf_hi(unsigned w) { return __builtin_bit_cast(float, w & 0xffff0000u); }
__device__ __forceinline__ float sigmoidf_(float x) { return 1.0f / (1.0f + __expf(-x)); }
__device__ __forceinline__ unsigned pkbf(float lo, float hi) { return pg8::cvt_pk_bf16(lo, hi); }
typedef unsigned u32x2 __attribute__((ext_vector_type(2)));
__device__ __forceinline__ u32x2 pk4(f32x4 v) { u32x2 r; r.x = pkbf(v[0], v[1]); r.y = pkbf(v[2], v[3]); return r; }
__device__ __forceinline__ unsigned pk4_fp8(f32x4 v) { int w = 0; w = __builtin_amdgcn_cvt_pk_fp8_f32(v[0], v[1], w, false); w = __builtin_amdgcn_cvt_pk_fp8_f32(v[2], v[3], w, true); return (unsigned)w; }

__device__ __forceinline__ void tr_item(const float* W, int ldw, int src_col, int nvalid, int k0, bf16_t* WT, int K, int dst_row, LAS float* scr, int lane) {
#pragma unroll 8
    for (int i = 0; i < 32; ++i) { const int kk = 2 * i + (lane >> 5), n = lane & 31;
        float v = 0.f; if (W != nullptr && n < nvalid) v = W[(size_t)(k0 + kk) * ldw + src_col + n];
        scr[kk * 33 + n] = v; }
    LDS_WAIT(); asm volatile("" ::: "memory");
    const int c = lane & 7;
#pragma unroll
    for (int j = 0; j < 4; ++j) { const int n = (lane >> 3) + 8 * j; const LAS float* s = scr + (8 * c) * 33 + n;
        v4u o; o.x = pk2(s[0 * 33], s[1 * 33]); o.y = pk2(s[2 * 33], s[3 * 33]); o.z = pk2(s[4 * 33], s[5 * 33]); o.w = pk2(s[6 * 33], s[7 * 33]);
        *(GAS v4u*)(WT + (size_t)(dst_row + n) * K + k0 + 8 * c) = o; }
    LDS_WAIT(); asm volatile("" ::: "memory");
}

struct P0Ptrs { const float *c, *w_ada, *w_in, *w_attn, *w_grp, *w_pool, *w_out, *w_up, *w_down; bf16_t *WIN, *WATTN, *WGRP, *WPOOL, *WOUT, *WUP, *WDOWN; float* MODP; };
__device__ __forceinline__ void p0_prologue(const P0Ptrs& P, LAS unsigned char* lds, int gw, int NGW, int wave, int lane) {
    LAS float* scr = (LAS float*)(lds + wave * 16384);
    constexpr int I_WIN = 144 * 16, I_WATTN = 32 * 8, I_WGRP = 16 * 8, I_WPOOL = 32 * 8, I_WOUT = 32 * 16, I_WUP = 176 * 16, I_WDOWN = 32 * 44, I_MOD = 96 * 16;
    constexpr int NITEMS = I_WIN + I_WATTN + I_WGRP + I_WPOOL + I_WOUT + I_WUP + I_WDOWN + I_MOD;
    for (int it = gw; it < NITEMS; it += NGW) {
        int r = it;
        if (r < I_MOD) {
            const int cb = r % 96, kc = r / 96, col = cb * 64 + lane; float acc = 0.f;
#pragma unroll 8
            for (int i = 0; i < 64; ++i) { const int k = kc * 64 + i; const float cv = P.c[k]; const float sv = cv / (1.0f + __expf(-cv)); acc = fmaf(sv, P.w_ada[(size_t)k * NMOD + col], acc); }
            P.MODP[kc * NMOD + col] = acc; continue; }
        r -= I_MOD;
        if (r < I_WIN) { const int g = r / 16, kb = r % 16, tile = g >> 3, gi = g & 7; int src = -1, nv = 32;
            const int permgi = gi < 4 ? 64 * gi : 64 * (gi - 4) + 32;
            if (tile < 2) src = tile * 256 + permgi;
            else if (tile < 4) src = 512 + (tile - 2) * 256 + permgi;
            else if (tile < 6) src = 1024 + (tile - 4) * 256 + 32 * gi;
            else if (tile == 6) src = 1536 + 32 * gi;
            else if (tile == 7) { if (gi < 2) src = 1792 + 32 * gi; else if (gi == 2) { src = 1856; nv = 4; } }
            else if (tile < 10) src = 1860 + (tile - 8) * 256 + 32 * gi;
            else if (tile < 14) src = 2372 + (tile - 10) * 256 + 32 * gi;
            else src = 3396 + (tile - 14) * 256 + 32 * gi;
            tr_item(src >= 0 ? P.w_in : nullptr, NIN, src >= 0 ? src : 0, nv, kb * 64, P.WIN, 1024, g * 32, scr, lane); continue; }
        r -= I_WIN;
        if (r < I_WATTN) { tr_item(P.w_attn, 1024, (r / 8) * 32, 32, (r % 8) * 64, P.WATTN, 512, (r / 8) * 32, scr, lane); continue; }
        r -= I_WATTN;
        if (r < I_WGRP) { const int g = r / 8, kb = r % 8, grp = g >> 2;
            const bool nz = (kb >> 1) == grp;
            tr_item(nz ? P.w_grp + (size_t)grp * 128 * 128 : nullptr, 128, (g & 3) * 32, 32, (kb & 1) * 64, P.WGRP + (size_t)(kb >> 1) * 128, 512, g * 32, scr, lane);
            continue; }
        r -= I_WGRP;
        if (r < I_WPOOL) { tr_item(P.w_pool, 1024, (r / 8) * 32, 32, (r % 8) * 64, P.WPOOL, 512, (r / 8) * 32, scr, lane); continue; }
        r -= I_WPOOL;
        if (r < I_WOUT) { tr_item(P.w_out, 1024, (r / 16) * 32, 32, (r % 16) * 64, P.WOUT, 1024, (r / 16) * 32, scr, lane); continue; }
        r -= I_WOUT;
        if (r < I_WUP) { const int g = r / 16, kb = r % 16, tile = g >> 3, gi = g & 7;
            const int src = gi < 4 ? 128 * tile + 32 * gi : FF + 128 * tile + 32 * (gi - 4);
            tr_item(P.w_up, FF2, src, 32, kb * 64, P.WUP, 1024, g * 32, scr, lane); continue; }
        r -= I_WUP;
        { tr_item(P.w_down, 1024, (r / 44) * 32, 32, (r % 44) * 64, P.WDOWN, FF, (r / 44) * 32, scr, lane); }
    }
}

__device__ __forceinline__ void modulate_rows(const float* X, bf16_t* O, const LAS float* mulv, const LAS float* addv, int gw, int NGW, int lane) {
    f32x4 mu[4], ad[4];
#pragma unroll
    for (int j = 0; j < 4; ++j) { mu[j] = *(const LAS f32x4*)(mulv + 4 * lane + 256 * j); ad[j] = *(const LAS f32x4*)(addv + 4 * lane + 256 * j); }
    for (int row = gw; row < M; row += NGW) {
        const GAS f32x4* xr = (const GAS f32x4*)(X + (size_t)row * DM) + lane;
        f32x4 v[4]; float s = 0.f;
#pragma unroll
        for (int j = 0; j < 4; ++j) { v[j] = xr[64 * j]; s += (v[j].x * v[j].x + v[j].y * v[j].y) + (v[j].z * v[j].z + v[j].w * v[j].w); }
        const float rstd = 1.0f / sqrtf(wave_sum(s) * (1.0f / DM) + EPS);
        GAS u32x2* o8 = (GAS u32x2*)(O + (size_t)row * DM) + lane;
#pragma unroll
        for (int j = 0; j < 4; ++j) { const f32x4 y = v[j] * rstd * mu[j] + ad[j]; o8[64 * j] = pk4(y); }
    }
}

struct EpiProj {
    static constexpr bool PERM = false, AFTER_DRAIN = false;
    bf16_t *Q; unsigned char *K8, *V8; bf16_t *QI, *KI, *UPOOL, *GA, *GP; float* WI; const float *qg, *kg;
    __device__ __forceinline__ void operator()(const pg8::f32x4 (&acc)[2][2][4][2], const Unit& u, int wr, int wc, int fr, int fq) const {
        const int pn = u.pn, row0 = u.pm * 256 + wr * 64 + fr;
        if (pn < 4) {
            const bool isq = pn < 2; const float* g = isq ? qg : kg; const int head = (pn & 1) * 4 + wc;
            f32x4 gv[2][2];
#pragma unroll
            for (int bj = 0; bj < 2; ++bj)
#pragma unroll
                for (int n = 0; n < 2; ++n) gv[bj][n] = *(const f32x4*)(g + 32 * bj + 16 * n + 4 * fq);
#pragma unroll
            for (int ai = 0; ai < 2; ++ai)
#pragma unroll
                for (int m = 0; m < 4; ++m) {
                    float ss = 0.f;
#pragma unroll
                    for (int bj = 0; bj < 2; ++bj)
#pragma unroll
                        for (int n = 0; n < 2; ++n) { const f32x4 x = acc[ai][bj][m][n]; ss += (x[0] * x[0] + x[1] * x[1]) + (x[2] * x[2] + x[3] * x[3]); }
                    ss += __shfl_xor(ss, 16); ss += __shfl_xor(ss, 32);
                    const float rstd = 1.0f / sqrtf(ss * (1.0f / 64.0f) + EPS);
                    const size_t ro = (size_t)(row0 + ai * 128 + m * 16) * AW + head * 64 + 4 * fq;
#pragma unroll
                    for (int bj = 0; bj < 2; ++bj)
#pragma unroll
                        for (int n = 0; n < 2; ++n) { const f32x4 y = acc[ai][bj][m][n] * rstd * gv[bj][n];
                            if (isq) *(u32x2*)(Q + ro + 32 * bj + 16 * n) = pk4(y); else *(unsigned*)(K8 + ((size_t)head * M + (row0 + ai * 128 + m * 16)) * 64 + 4 * fq + 32 * bj + 16 * n) = pk4_fp8(y); }
                }
            return;
        }
        const int colw = wc * 32 + 4 * fq;
        if (pn == 7) {
#pragma unroll
            for (int ai = 0; ai < 2; ++ai)
#pragma unroll
                for (int m = 0; m < 4; ++m) { const int row = row0 + ai * 128 + m * 16;
                    if (wc < 2) {
#pragma unroll
                        for (int n = 0; n < 2; ++n) { const int c = colw + 16 * n; *(u32x2*)(KI + (size_t)(row >> 5) * 2048 + (c >> 4) * 512 + ((((c >> 3) & 1) * 32 + (row & 31)) * 8) + (c & 7)) = pk4(acc[ai][0][m][n]); }
                    } else if (wc == 2 && fq == 0) { *(f32x4*)(WI + (size_t)row * 4) = acc[ai][0][m][0] * 0.5f; }
                }
            return;
        }
        if (pn < 6) {
#pragma unroll
            for (int ai = 0; ai < 2; ++ai)
#pragma unroll
                for (int m = 0; m < 4; ++m) { const int row = row0 + ai * 128 + m * 16;
#pragma unroll
                    for (int bj = 0; bj < 2; ++bj)
#pragma unroll
                        for (int n = 0; n < 2; ++n) { const int col = (pn - 4) * 256 + colw + 128 * bj + 16 * n;
                            *(unsigned*)(V8 + ((size_t)(col >> 6) * M + row) * 64 + (col & 63)) = pk4_fp8(acc[ai][bj][m][n]); } }
            return;
        }
        bf16_t* O; int ldo, ct; float sc = 1.0f; bool sig = false;
        if (pn == 6) { O = QI; ldo = 256; ct = 0; sc = 0.125f; }
        else if (pn < 10) { O = UPOOL; ldo = PW; ct = (pn - 8) * 256; }
        else if (pn < 14) { O = GA; ldo = DM; ct = (pn - 10) * 256; sig = true; }
        else { O = GP; ldo = DM; ct = (pn - 14) * 256; sig = true; }
#pragma unroll
        for (int ai = 0; ai < 2; ++ai)
#pragma unroll
            for (int m = 0; m < 4; ++m) { bf16_t* rowp = O + (size_t)(row0 + ai * 128 + m * 16) * ldo + ct + colw;
#pragma unroll
                for (int bj = 0; bj < 2; ++bj)
#pragma unroll
                    for (int n = 0; n < 2; ++n) { f32x4 y = acc[ai][bj][m][n] * sc;
                        if (sig) { y[0] = sigmoidf_(y[0]); y[1] = sigmoidf_(y[1]); y[2] = sigmoidf_(y[2]); y[3] = sigmoidf_(y[3]); }
                        *(u32x2*)(rowp + 128 * bj + 16 * n) = pk4(y); }
            }
    }
};

template <int MODE> struct EpiBf {
    static constexpr bool PERM = false, AFTER_DRAIN = false;
    bf16_t* O; int ldo; const float* colscale; const bf16_t* ADD;
    __device__ __forceinline__ void operator()(const pg8::f32x4 (&acc)[2][2][4][2], const Unit& u, int wr, int wc, int fr, int fq) const {
        const int row0 = u.pm * 256 + wr * 64 + fr, col0 = u.pn * 256 + wc * 32 + 4 * fq;
#pragma unroll
        for (int ai = 0; ai < 2; ++ai)
#pragma unroll
            for (int m = 0; m < 4; ++m) { const size_t ro = (size_t)(row0 + ai * 128 + m * 16) * ldo + col0;
#pragma unroll
                for (int bj = 0; bj < 2; ++bj)
#pragma unroll
                    for (int n = 0; n < 2; ++n) { f32x4 y = acc[ai][bj][m][n]; const size_t off = ro + 128 * bj + 16 * n;
                        if (MODE == 0) { y = y * *(const f32x4*)(colscale + col0 + 128 * bj + 16 * n); }
                        else { const u32x2 gq = *(const u32x2*)(O + off); y[0] *= bf_lo(gq.x); y[1] *= bf_hi(gq.x); y[2] *= bf_lo(gq.y); y[3] *= bf_hi(gq.y);
                            if (MODE == 2) { const u32x2 a = *(const u32x2*)(ADD + off); y[0] += bf_lo(a.x); y[1] += bf_hi(a.x); y[2] += bf_lo(a.y); y[3] += bf_hi(a.y); } }
                        *(u32x2*)(O + off) = pk4(y); }
            }
    }
};

struct EpiRes {
    static constexpr bool PERM = false, AFTER_DRAIN = false;
    const float* BASE; float* OUT; const float* gate; float dbg;
    __device__ __forceinline__ void operator()(const pg8::f32x4 (&acc)[2][2][4][2], const Unit& u, int wr, int wc, int fr, int fq) const {
        const int row0 = u.pm * 256 + wr * 64 + fr, col0 = u.pn * 256 + wc * 32 + 4 * fq;
        f32x4 gv[2][2];
#pragma unroll
        for (int bj = 0; bj < 2; ++bj)
#pragma unroll
            for (int n = 0; n < 2; ++n) gv[bj][n] = *(const f32x4*)(gate + col0 + 128 * bj + 16 * n);
#pragma unroll
        for (int ai = 0; ai < 2; ++ai)
#pragma unroll
            for (int m = 0; m < 4; ++m) { const int row = row0 + ai * 128 + m * 16; const size_t ro = (size_t)row * DM + col0;
#pragma unroll
                for (int bj = 0; bj < 2; ++bj)
#pragma unroll
                    for (int n = 0; n < 2; ++n) { const size_t off = ro + 128 * bj + 16 * n; f32x4 y = *(const f32x4*)(BASE + off) + gv[bj][n] * acc[ai][bj][m][n];
                        if (dbg != 0.f) { const float sg = ((row * 7 + (int)(off >> 2)) & 1) ? dbg : -dbg; y[0] += sg; y[1] -= sg; y[2] += sg; y[3] -= sg; }
                        *(f32x4*)(OUT + off) = y; }
            }
    }
};

template <int CTRL> __device__ __forceinline__ float dppf(float x) { return __builtin_bit_cast(float, __builtin_amdgcn_update_dpp(0, __builtin_bit_cast(int, x), CTRL, 0xf, 0xf, false)); }
__device__ __forceinline__ f32x4 ror1(f32x4 v) { f32x4 r; r[0] = dppf<0x121>(v[0]); r[1] = dppf<0x121>(v[1]); r[2] = dppf<0x121>(v[2]); r[3] = dppf<0x121>(v[3]); return r; }
__device__ __forceinline__ f32x4 ror2(f32x4 v) { f32x4 r; r[0] = dppf<0x122>(v[0]); r[1] = dppf<0x122>(v[1]); r[2] = dppf<0x122>(v[2]); r[3] = dppf<0x122>(v[3]); return r; }
__device__ __forceinline__ f32x4 silu_mul(f32x4 a, f32x4 b) { f32x4 r;
#pragma unroll
    for (int e = 0; e < 4; ++e) r[e] = a[e] / (1.0f + __expf(-a[e])) * b[e];
    return r; }
struct EpiUpAct {
    static constexpr bool PERM = false, AFTER_DRAIN = false;
    bf16_t* ACT; float* RAW; const float* cw; const float* cb;
    __device__ __forceinline__ void operator()(const pg8::f32x4 (&acc)[2][2][4][2], const Unit& u, int wr, int wc, int fr, int fq) const {
#pragma unroll
        for (int n = 0; n < 2; ++n) {
            const int ch = u.pn * 128 + wc * 32 + 4 * fq + 16 * n;
            const f32x4 w0a = *(const f32x4*)(cw + ch), w1a = *(const f32x4*)(cw + FF2 + ch), w2a = *(const f32x4*)(cw + 2 * FF2 + ch), ba = *(const f32x4*)(cb + ch);
            const f32x4 w0b = *(const f32x4*)(cw + FF + ch), w1b = *(const f32x4*)(cw + FF2 + FF + ch), w2b = *(const f32x4*)(cw + 2 * FF2 + FF + ch), bb = *(const f32x4*)(cb + FF + ch);
#pragma unroll
            for (int ai = 0; ai < 2; ++ai) {
                const int blk = u.pm * 4 + ai * 2 + wr;
                if (fr < 2) { *(f32x4*)(RAW + (size_t)(blk * 4 + fr) * FF2 + ch) = acc[ai][0][0][n]; *(f32x4*)(RAW + (size_t)(blk * 4 + fr) * FF2 + FF + ch) = acc[ai][1][0][n]; }
                if (fr >= 14) { *(f32x4*)(RAW + (size_t)(blk * 4 + fr - 12) * FF2 + ch) = acc[ai][0][3][n]; *(f32x4*)(RAW + (size_t)(blk * 4 + fr - 12) * FF2 + FF + ch) = acc[ai][1][3][n]; }
                f32x4 pa1 = {0.f, 0.f, 0.f, 0.f}, pa2 = pa1, pb1 = pa1, pb2 = pa1;
#pragma unroll
                for (int m = 0; m < 4; ++m) {
                    const f32x4 va = acc[ai][0][m][n], vb = acc[ai][1][m][n];
                    const f32x4 ra1 = ror1(va), ra2 = ror2(va), rb1 = ror1(vb), rb2 = ror2(vb);
                    const f32x4 xa1 = fr >= 1 ? ra1 : pa1, xa2 = fr >= 2 ? ra2 : pa2, xb1 = fr >= 1 ? rb1 : pb1, xb2 = fr >= 2 ? rb2 : pb2;
                    pa1 = ra1; pa2 = ra2; pb1 = rb1; pb2 = rb2;
                    const f32x4 ya = ba + w0a * xa2 + w1a * xa1 + w2a * va, yb = bb + w0b * xb2 + w1b * xb1 + w2b * vb;
                    const f32x4 o = silu_mul(ya, yb);
                    if (!(m == 0 && fr < 2)) *(u32x2*)(ACT + (size_t)(blk * 64 + 16 * m + fr) * FF + ch) = pk4(o);
                }
            }
        }
    }
};

__device__ __forceinline__ void fixup_phase(const float* RAW, bf16_t* ACT, const float* cw, const float* cb, int gtid, int nthr) {
    for (int it = gtid; it < 256 * 2 * 704; it += nthr) {
        const int c4 = it % 704, rr = (it / 704) & 1, blk = it / 1408, ch = 4 * c4;
        const float* cur = RAW + (size_t)(blk * 4 + rr) * FF2;
        const float* p1 = rr == 1 ? RAW + (size_t)(blk * 4) * FF2 : (blk > 0 ? RAW + (size_t)((blk - 1) * 4 + 3) * FF2 : nullptr);
        const float* p2 = rr == 1 ? (blk > 0 ? RAW + (size_t)((blk - 1) * 4 + 3) * FF2 : nullptr) : (blk > 0 ? RAW + (size_t)((blk - 1) * 4 + 2) * FF2 : nullptr);
        const f32x4 z = {0.f, 0.f, 0.f, 0.f};
        const f32x4 va = *(const f32x4*)(cur + ch), vb = *(const f32x4*)(cur + FF + ch);
        const f32x4 a1 = p1 ? *(const f32x4*)(p1 + ch) : z, b1 = p1 ? *(const f32x4*)(p1 + FF + ch) : z;
        const f32x4 a2 = p2 ? *(const f32x4*)(p2 + ch) : z, b2 = p2 ? *(const f32x4*)(p2 + FF + ch) : z;
        const f32x4 ya = *(const f32x4*)(cb + ch) + *(const f32x4*)(cw + ch) * a2 + *(const f32x4*)(cw + FF2 + ch) * a1 + *(const f32x4*)(cw + 2 * FF2 + ch) * va;
        const f32x4 yb = *(const f32x4*)(cb + FF + ch) + *(const f32x4*)(cw + FF + ch) * b2 + *(const f32x4*)(cw + FF2 + FF + ch) * b1 + *(const f32x4*)(cw + 2 * FF2 + FF + ch) * vb;
        *(u32x2*)(ACT + (size_t)(blk * 64 + rr) * FF + ch) = pk4(silu_mul(ya, yb));
    }
}

__device__ __forceinline__ void pooled_phase(const bf16_t* UPOOL, bf16_t* POOLED, int gtid, int nthr) {
    for (int it = gtid; it < M * 64; it += nthr) {
        const int t = it >> 6, c8 = it & 63, g = c8 >> 4, w = 2 << g, cntw = (t + 1) < w ? (t + 1) : w;
        float s[8], self[8];
#pragma unroll
        for (int e = 0; e < 8; ++e) s[e] = 0.f;
        for (int j = 0; j < cntw; ++j) { const v4u v = *(const v4u*)(UPOOL + (size_t)(t - j) * PW + 8 * c8);
            const float f[8] = {bf_lo(v.x), bf_hi(v.x), bf_lo(v.y), bf_hi(v.y), bf_lo(v.z), bf_hi(v.z), bf_lo(v.w), bf_hi(v.w)};
#pragma unroll
            for (int e = 0; e < 8; ++e) { s[e] += f[e]; if (j == 0) self[e] = f[e]; } }
        const float inv = 1.0f / (float)cntw; v4u o;
        o.x = pkbf(s[0] * inv - self[0], s[1] * inv - self[1]); o.y = pkbf(s[2] * inv - self[2], s[3] * inv - self[3]);
        o.z = pkbf(s[4] * inv - self[4], s[5] * inv - self[5]); o.w = pkbf(s[6] * inv - self[6], s[7] * inv - self[7]);
        *(v4u*)(POOLED + (size_t)t * PW + 8 * c8) = o;
    }
}

#define MFMA32(a, b, c) __builtin_amdgcn_mfma_f32_32x32x16_bf16((a), (b), (c), 0, 0, 0)
__device__ __forceinline__ unsigned lds_add(LAS unsigned* p, unsigned v) { return __hip_atomic_fetch_add(p, v, __ATOMIC_RELAXED, __HIP_MEMORY_SCOPE_WORKGROUP); }
__device__ __forceinline__ unsigned lds_or(LAS unsigned* p, unsigned v) { return __hip_atomic_fetch_or(p, v, __ATOMIC_RELAXED, __HIP_MEMORY_SCOPE_WORKGROUP); }

__device__ __forceinline__ float u2f(unsigned u) { return __uint_as_float((u & 0x80000000u) ? (u & 0x7fffffffu) : ~u); }
template <bool EMIT>
__device__ __forceinline__ void tk_pass(int qb, int wave, int lane, const bf16_t* KI, const LAS bf16_t* QF, const float (&wv)[4], LAS unsigned* H, LAS unsigned* SELM, LAS unsigned* TIEM,
                                        int sh, unsigned vlo, bool clampTop, unsigned bmax, int stage, unsigned vmin, float fsel, float ftie) {
    const int r = lane & 31, h = lane >> 5;
    const int gstep = stage == 1 ? 8 : 1, g0 = stage == 1 ? wave : 0;
#define TK_NEXT_G(g) ({ int _g = (g) + gstep; if (stage == 2 && (_g & 7) == wave) ++_g; _g; })
    int gcur = g0; if (stage == 2 && (gcur & 7) == wave) ++gcur;
    pg8::bf16x8 kf[4];
    { const int T0 = (wave + 8 * gcur) <= qb ? (wave + 8 * gcur) : qb; const bf16_t* kp = KI + (size_t)T0 * 2048 + 8 * lane;
#pragma unroll
      for (int s = 0; s < 4; ++s) kf[s] = *(const pg8::bf16x8*)(kp + 512 * s); }
    LAS unsigned* Hq = H + r * HSTRIDE;
#pragma unroll 1
    for (; wave + 8 * gcur <= qb; gcur = TK_NEXT_G(gcur)) {
        const int T = wave + 8 * gcur;
        float sc[16];
#pragma unroll
        for (int i = 0; i < 16; ++i) sc[i] = 0.f;
#pragma unroll
        for (int hd = 0; hd < 4; ++hd) { f32x16 a;
#pragma unroll
            for (int i = 0; i < 16; ++i) a[i] = 0.f;
#pragma unroll
            for (int s = 0; s < 4; ++s) a = MFMA32(kf[s], *(const LAS pg8::bf16x8*)(QF + (hd * 4 + s) * 512 + lane * 8), a);
#pragma unroll
            for (int i = 0; i < 16; ++i) { const float av = a[i]; const int ab = __float_as_int(av); sc[i] = fmaf(wv[hd], __int_as_float(ab > 0 ? ab : 0), sc[i]); } }
        { const int Tnn = wave + 8 * TK_NEXT_G(gcur); const int Tn = Tnn <= qb ? Tnn : T; const bf16_t* kp = KI + (size_t)Tn * 2048 + 8 * lane;
#pragma unroll
          for (int s = 0; s < 4; ++s) kf[s] = *(const pg8::bf16x8*)(kp + 512 * s); }
        const int rlim = (T == qb) ? r : 64;
        if (!EMIT) {
#pragma unroll
            for (int i = 0; i < 16; ++i) {
                const int kr = (i & 3) + 8 * (i >> 2) + 4 * h;
                unsigned uu = __float_as_uint(sc[i]); uu ^= ((unsigned)((int)uu >> 31)) | 0x80000000u;
                const unsigned v = uu >> sh; unsigned b = v - vlo;
                const bool ok = (kr <= rlim) && (v >= vmin) && (clampTop || b <= bmax);
                b = b > 2047u ? 2047u : b;
                lds_add(Hq + (ok ? (b >> 1) : 1024u), 1u << ((b & 1u) * 16u));
            }
        } else {
            unsigned ms = 0u, mg = 0u;
#pragma unroll
            for (int i = 15; i >= 0; --i) {
                asm("v_cmp_ge_f32_e32 vcc, %1, %2\n\tv_addc_co_u32_e32 %0, vcc, %0, %0, vcc" : "+v"(ms) : "v"(sc[i]), "v"(fsel) : "vcc");
                asm("v_cmp_ge_f32_e32 vcc, %1, %2\n\tv_addc_co_u32_e32 %0, vcc, %0, %0, vcc" : "+v"(mg) : "v"(sc[i]), "v"(ftie) : "vcc");
            }
            const unsigned vrow = rlim >= 31 ? 0xffffffffu : ((2u << rlim) - 1u);
            auto spread = [&](unsigned m) { return (((m & 0xfu) | ((m & 0xf0u) << 4) | ((m & 0xf00u) << 8) | ((m & 0xf000u) << 12)) << (4 * h)) & vrow; };
            const unsigned msel = spread(ms), mtie = spread(mg) & ~msel;
            const unsigned osel = __shfl_xor(msel, 32), otie = __shfl_xor(mtie, 32);
            if (h == 0) { SELM[r * MSTRIDE + T] = msel | osel; TIEM[r * MSTRIDE + T] = mtie | otie; }
        }
    }
#undef TK_NEXT_G
}

template <int CTRL> __device__ __forceinline__ float dppx(float x) { return __builtin_bit_cast(float, __builtin_amdgcn_mov_dpp(__builtin_bit_cast(int, x), CTRL, 0xf, 0xf, true)); }
__device__ __forceinline__ u32x2 tk_rescore_load(const bf16_t* KI, int key, int lane) {
    const int c = 4 * (lane & 15);
    return *(const u32x2*)(KI + (size_t)(key >> 5) * 2048 + (c >> 4) * 512 + ((((c >> 3) & 1) * 32 + (key & 31)) * 8) + (c & 7));
}
__device__ __forceinline__ float tk_rescore(const u32x2 q4, float wh, const u32x2 k4) {
    float d = bf_lo(q4.x) * bf_lo(k4.x); d = fmaf(bf_hi(q4.x), bf_hi(k4.x), d); d = fmaf(bf_lo(q4.y), bf_lo(k4.y), d); d = fmaf(bf_hi(q4.y), bf_hi(k4.y), d);
    d += dppx<0xB1>(d); d += dppx<0x4E>(d); d += dppx<0x141>(d); d += dppx<0x140>(d);
    float sc = wh * fmaxf(d, 0.f);
    sc += __shfl_xor(sc, 16); sc += __shfl_xor(sc, 32);
    return sc + 0.f;
}

__device__ __forceinline__ void tk_scan(const LAS unsigned* Hq, LAS unsigned* pref_p, LAS unsigned* need_p, LAS unsigned* cnt_p, int bits, int lane) {
    const unsigned need = *need_p;
    unsigned wd[16]; unsigned S = 0;
#pragma unroll
    for (int i = 0; i < 16; ++i) { wd[i] = Hq[16 * lane + i]; S += (wd[i] & 0xffffu) + (wd[i] >> 16); }
    unsigned incl = S;
#pragma unroll
    for (int off = 1; off < 64; off <<= 1) { const unsigned t = __shfl_down(incl, off); if (lane + off < 64) incl += t; }
    const unsigned Tabove = incl - S;
    const bool hit = (Tabove < need) && (need <= Tabove + S);
    unsigned rem = need - Tabove, D = 0, nn = 1, cD = 0; bool found = false;
#pragma unroll
    for (int b = 31; b >= 0; --b) { const unsigned c = (wd[b >> 1] >> (16 * (b & 1))) & 0xffffu;
        if (!found) { if (c >= rem) { found = true; D = 32u * lane + b; nn = rem; cD = c; } else rem -= c; } }
    const unsigned long long mk = __ballot(hit);
    const int L = mk ? (int)__builtin_ctzll(mk) : 0;
    const unsigned Dsel = __shfl(D, L), nsel = __shfl(nn, L), csel = __shfl(cD, L);
    if (lane == 0) { *pref_p = bits ? ((*pref_p << bits) | Dsel) : Dsel; *need_p = nsel; if (cnt_p) *cnt_p = csel; }
}

__device__ __forceinline__ float dot2bf(unsigned k, unsigned q, float acc) { return __builtin_amdgcn_fdot2_f32_bf16(__builtin_bit_cast(bf16x2_t, k), __builtin_bit_cast(bf16x2_t, q), acc, false); }

typedef float f32x2_t __attribute__((ext_vector_type(2)));
__device__ __forceinline__ void unpack16(const v4u w, f32x2_t (&f)[8]) {
#pragma unroll
    for (int i = 0; i < 4; ++i) { f[2 * i] = __builtin_amdgcn_cvt_pk_f32_fp8((int)w[i], false); f[2 * i + 1] = __builtin_amdgcn_cvt_pk_f32_fp8((int)w[i], true); }
}
__device__ __forceinline__ void attn_item(int t, int hd, const unsigned short* SEL, const bf16_t* Q, const unsigned char* K8, const unsigned char* V8, bf16_t* ATTN, int lane) {
    constexpr float LOG2E = 1.4426950408889634f;
    const int kk = lane >> 2, part = lane & 3, cnt = (t + 1) < 256 ? (t + 1) : 256;
    const float slope2 = exp2f(-(float)(hd + 1)) * LOG2E, sc2 = 0.125f * LOG2E;
    f32x2_t q[8];
    { const v4u qa = *(const v4u*)(Q + (size_t)t * AW + hd * 64 + part * 16), qb = *(const v4u*)(Q + (size_t)t * AW + hd * 64 + part * 16 + 8);
#pragma unroll
      for (int i = 0; i < 4; ++i) { q[i] = (f32x2_t){bf_lo(qa[i]) * sc2, bf_hi(qa[i]) * sc2}; q[4 + i] = (f32x2_t){bf_lo(qb[i]) * sc2, bf_hi(qb[i]) * sc2}; } }
    const unsigned short* lp = SEL + (size_t)t * 256;
    const unsigned char* kb = K8 + (size_t)hd * M * 64 + part * 16; const unsigned char* vb = V8 + (size_t)hd * M * 64 + part * 16;
    int key[16]; v4u kf[16], vf[16];
#pragma unroll
    for (int r = 0; r < 16; ++r) { const int j = 16 * r + kk; key[r] = j < cnt ? (int)lp[j] : 0; }
#pragma unroll
    for (int r = 0; r < 16; ++r) { kf[r] = *(const v4u*)(kb + (size_t)key[r] * 64); vf[r] = *(const v4u*)(vb + (size_t)key[r] * 64); }
    float sv[16]; float mx = -INFINITY;
#pragma unroll
    for (int r = 0; r < 16; ++r) { f32x2_t kx[8]; unpack16(kf[r], kx); f32x2_t d2 = q[0] * kx[0];
#pragma unroll
        for (int e = 1; e < 8; ++e) d2 = __builtin_elementwise_fma(q[e], kx[e], d2);
        float d = d2.x + d2.y;
        d += dppx<0xB1>(d); d += dppx<0x4E>(d);
        sv[r] = (16 * r + kk) < cnt ? d - slope2 * (float)(t - key[r]) : -INFINITY; mx = fmaxf(mx, sv[r]); }
    mx = fmaxf(mx, __shfl_xor(mx, 4)); mx = fmaxf(mx, __shfl_xor(mx, 8)); mx = fmaxf(mx, __shfl_xor(mx, 16)); mx = fmaxf(mx, __shfl_xor(mx, 32));
    f32x2_t o[8]; float lsum = 0.f;
#pragma unroll
    for (int e = 0; e < 8; ++e) o[e] = (f32x2_t){0.f, 0.f};
#pragma unroll
    for (int r = 0; r < 16; ++r) { const float p = __builtin_amdgcn_exp2f(sv[r] - mx); lsum += p; f32x2_t vx[8]; unpack16(vf[r], vx); const f32x2_t p2 = (f32x2_t){p, p};
#pragma unroll
        for (int e = 0; e < 8; ++e) o[e] = __builtin_elementwise_fma(p2, vx[e], o[e]); }
    lsum += dppx<0x124>(lsum); lsum += dppx<0x128>(lsum); lsum += __shfl_xor(lsum, 16); lsum += __shfl_xor(lsum, 32);
    float of[16];
#pragma unroll
    for (int e = 0; e < 8; ++e) { of[2 * e] = o[e].x; of[2 * e + 1] = o[e].y; }
#pragma unroll
    for (int e = 0; e < 16; ++e) { float v = of[e]; v += dppx<0x124>(v); v += dppx<0x128>(v); v += __shfl_xor(v, 16); v += __shfl_xor(v, 32); of[e] = v; }
    if (lane < 4) { const float inv = 1.0f / lsum; v4u a, b;
        a.x = pkbf(of[0] * inv, of[1] * inv); a.y = pkbf(of[2] * inv, of[3] * inv); a.z = pkbf(of[4] * inv, of[5] * inv); a.w = pkbf(of[6] * inv, of[7] * inv);
        b.x = pkbf(of[8] * inv, of[9] * inv); b.y = pkbf(of[10] * inv, of[11] * inv); b.z = pkbf(of[12] * inv, of[13] * inv); b.w = pkbf(of[14] * inv, of[15] * inv);
        *(v4u*)(ATTN + (size_t)t * AW + hd * 64 + part * 16) = a; *(v4u*)(ATTN + (size_t)t * AW + hd * 64 + part * 16 + 8) = b; }
}

__device__ __forceinline__ int wave_incl_scan(int v) {
    v += __builtin_amdgcn_update_dpp(0, v, 0x111, 0xf, 0xf, true); v += __builtin_amdgcn_update_dpp(0, v, 0x112, 0xf, 0xf, true);
    v += __builtin_amdgcn_update_dpp(0, v, 0x114, 0xf, 0xf, true); v += __builtin_amdgcn_update_dpp(0, v, 0x118, 0xf, 0xf, true);
    v += __builtin_amdgcn_update_dpp(0, v, 0x142, 0xa, 0xf, false); v += __builtin_amdgcn_update_dpp(0, v, 0x143, 0xc, 0xf, false);
    return v;
}
struct TkPtrs { const bf16_t *QI, *KI; const float* WI; unsigned short* SEL; };
__device__ __forceinline__ void topk_attn_block(int qb, const TkPtrs& P, LAS unsigned char* lds, int tid, int wave, int lane, bool do_attn) {
    LAS unsigned* H = (LAS unsigned*)lds;
    LAS unsigned* SELM = (LAS unsigned*)lds;
    LAS unsigned* TIEM = (LAS unsigned*)(lds + 32 * MSTRIDE * 4);
    LAS unsigned short* LIST = (LAS unsigned short*)(lds + LIST_OFF);
    LAS unsigned* STP = (LAS unsigned*)(lds + ST_OFF);
    LAS unsigned* STN = STP + 32;
    const int t0 = qb * 32, r = lane & 31, h = lane >> 5;
    SYNC();
    float wv[4];
    LAS bf16_t* QF = (LAS bf16_t*)(lds + LIST_OFF);
    { const bf16_t* qp = P.QI + (size_t)(t0 + r) * 256 + 8 * h;
#pragma unroll
      for (int k = 0; k < 2; ++k) { const int f = 2 * wave + k; *(LAS pg8::bf16x8*)(QF + f * 512 + lane * 8) = *(const pg8::bf16x8*)(qp + (f >> 2) * 64 + 16 * (f & 3)); }
      const f32x4 w4 = *(const f32x4*)(P.WI + (size_t)(t0 + r) * 4); wv[0] = w4[0]; wv[1] = w4[1]; wv[2] = w4[2]; wv[3] = w4[3]; }
    LAS unsigned* STC = STP + 64;
    LAS unsigned* STG = STP + 96;
    LAS unsigned* FB = STP + 160;
    LAS unsigned* STS = STP + 192;
    LAS float* FSEL = (LAS float*)(STP + 256);
    LAS float* FTIE = FSEL + 32;
    const bool negw = (wv[0] <= 0.f) && (wv[1] <= 0.f) && (wv[2] <= 0.f) && (wv[3] <= 0.f);
    const unsigned wbase = negw ? 7745u : 22976u;
#pragma unroll 1
    for (int rep_tk = 0; rep_tk < REP_TK; ++rep_tk) {
    if (wave == 0 && lane == 0) *FB = 0u;
#pragma unroll 1
    for (int mode = 0; mode < 2; ++mode) {
        if (mode == 1) { if (*FB == 0u) break; }
        if (wave == 0 && lane < 32) { STP[lane] = 0u; const int nv = t0 + lane + 1; STN[lane] = nv < 256 ? nv : 256; STG[lane] = negw ? 1u : 0u; }
        const int nstep = mode == 0 ? 1 : 3;
#pragma unroll 1
        for (int step = 0; step < nstep; ++step) {
            if (mode == 1 || step == 0) { for (int i = tid; i < 32 * HSTRIDE; i += NTHR) H[i] = 0u; }
            SYNC();
            const int sh = mode == 0 ? 17 : (step == 0 ? 21 : (step == 1 ? 10 : 0));
            const unsigned vlo = mode == 0 ? wbase : (step == 0 ? 0u : (STP[r] << (step == 1 ? 11 : 10)));
            const unsigned vmin = vlo;
            tk_pass<false>(qb, wave, lane, P.KI, QF, wv, H, SELM, TIEM, sh, vlo, mode == 0, (mode == 1 && step == 2) ? 1023u : 2047u, 0, vmin, 0.f, 0.f);
            SYNC();
            const bool samp = false;
#pragma unroll 1
            for (int qq = 0; qq < 4; ++qq) { const int rq = 4 * wave + qq;
                tk_scan(H + rq * HSTRIDE, samp ? STS + rq : STP + rq, samp ? STS + 32 + rq : STN + rq, STC + rq, (mode == 1 && step == 2) ? 10 : 11, lane);
                if (mode == 0 && lane == 0) { const unsigned D = STP[rq], nn = STN[rq], c = STC[rq], ng = STG[rq] & 1u;
                    const bool zerobin = ng && D == 2047u, edge = (D == 0u) || (D == 2047u && !ng);
                    const bool wantc = (c > nn) && !zerobin;
                    if (edge || (wantc && c > 64u)) lds_or(FB, 1u);
                    STG[rq] = ng | (wantc ? 2u : 0u);
                    const unsigned wb = ng ? 7745u : 22976u;
                    FTIE[rq] = u2f((wb + D) << 17); FSEL[rq] = zerobin ? INFINITY : u2f((wb + D + 1u) << 17); }
                if (mode == 1 && step == 2 && lane == 0) { const unsigned tau = STP[rq]; FTIE[rq] = u2f(tau); FSEL[rq] = tau == 0xffffffffu ? INFINITY : u2f(tau + 1u); } }
            SYNC();
        }
        if (mode == 0 && *FB != 0u) continue;
        tk_pass<true>(qb, wave, lane, P.KI, QF, wv, H, SELM, TIEM, 0, 0u, false, 0u, 0, 0u, FSEL[r], FTIE[r]);
        SYNC();
        break;
    }
    }
    if (!do_attn) return;
#pragma unroll 1
    for (int qq = 0; qq < 4; ++qq) {
        const int rq = 4 * wave + qq, t = t0 + rq; int mties = (int)STN[rq];
        unsigned tw[8], fw[8]; int S = 0;
#pragma unroll
        for (int i = 0; i < 8; ++i) { const int T = 8 * lane + i; const bool v = T <= qb; tw[i] = v ? TIEM[rq * MSTRIDE + T] : 0u; fw[i] = v ? SELM[rq * MSTRIDE + T] : 0u; S += __builtin_popcount(tw[i]); }
        const int incl = wave_incl_scan(S);
        if (*FB == 0u && (STG[rq] & 2u)) {
            const int c = __builtin_amdgcn_readlane(incl, 63), nn = mties;
            LAS unsigned short* cl = LIST + rq * 256;
            { int pos = incl - S;
#pragma unroll
              for (int i = 0; i < 8; ++i) { unsigned w = tw[i]; while (w) { const int b = __builtin_ctz(w); if (pos < 64) cl[pos] = (unsigned short)(256 * lane + 32 * i + b); ++pos; w &= w - 1u; } } }
            LDS_WAIT(); asm volatile("" ::: "memory");
            const u32x2 q4 = *(const u32x2*)(P.QI + (size_t)t * 256 + 4 * lane); const float wh = P.WI[(size_t)t * 4 + (lane >> 4)];
            float mys = 0.f; const int cc = c < 64 ? c : 64;
#pragma unroll 1
            for (int j0 = 0; j0 < cc; j0 += 8) { u32x2 k4[8];
#pragma unroll
                for (int u = 0; u < 8; ++u) { const int jj = (j0 + u) < cc ? (j0 + u) : (cc - 1); k4[u] = tk_rescore_load(P.KI, __builtin_amdgcn_readfirstlane((int)cl[jj]), lane); }
#pragma unroll
                for (int u = 0; u < 8; ++u) { const float sj = tk_rescore(q4, wh, k4[u]); if (lane == j0 + u) mys = sj; } }
            int rank = 0;
            for (int j = 0; j < cc; ++j) { const float sj = __int_as_float(__builtin_amdgcn_readlane(__float_as_int(mys), j)); rank += (sj > mys || (sj == mys && j < lane)) ? 1 : 0; }
            const bool keepme = lane < cc && rank < nn; const int mykey = lane < cc ? (int)cl[lane] : 0;
#pragma unroll 1
            for (int j = 0; j < cc; ++j) { const int kj = __builtin_amdgcn_readlane(mykey, j); const int kp = __builtin_amdgcn_readlane((int)keepme, j);
                if (kp && (kj >> 8) == lane) {
#pragma unroll
                    for (int i = 0; i < 8; ++i) if (((kj >> 5) & 7) == i) fw[i] |= 1u << (kj & 31); } }
            mties = 0;
        }
        int take = mties - (incl - S); take = take < 0 ? 0 : (take > S ? S : take);
        int cl2 = 0;
#pragma unroll
        for (int i = 0; i < 8; ++i) { unsigned w = tw[i]; const int c = __builtin_popcount(w); unsigned keep;
            if (take >= c) { keep = w; take -= c; } else { keep = 0u; for (int k = 0; k < take; ++k) { const unsigned low = w & (0u - w); keep |= low; w ^= low; } take = 0; }
            fw[i] |= keep; cl2 += __builtin_popcount(fw[i]); }
        const int inc2 = wave_incl_scan(cl2);
        int pos = inc2 - cl2; const int cnt = __builtin_amdgcn_readlane(inc2, 63);
        LAS unsigned short* lp = LIST + rq * 256;
#pragma unroll
        for (int i = 0; i < 8; ++i) { unsigned w = fw[i]; while (w) { const int b = __builtin_ctz(w); if (pos < 256) lp[pos] = (unsigned short)(256 * lane + 32 * i + b); ++pos; w &= w - 1u; } }
        LDS_WAIT(); asm volatile("" ::: "memory");
        (void)cnt;
        *(u32x2*)(P.SEL + (size_t)t * 256 + 4 * lane) = *(const LAS u32x2*)(lp + 4 * lane);
    }
}

struct Args { const float* in[18]; float* out; unsigned char* ws; int ph_lo, ph_hi; };
constexpr int NPH = 13;

typedef const __attribute__((address_space(4))) unsigned long long* kargp_t;
#define KARGS() kargp_t kargs = (kargp_t)__builtin_amdgcn_kernarg_segment_ptr(); asm volatile("" : "+s"(kargs)); GAS unsigned char* const ws = (GAS unsigned char*)kargs[19]; (void)ws
#define KIN(i) ((const float*)(const GAS float*)kargs[(i)])
#define KOUT() ((float*)(GAS float*)kargs[18])
#define WSP(T, off) ((T*)(GAS T*)(ws + (off)))
__global__ void __launch_bounds__(NTHR, 2) fwd_kernel(Args a) {
    extern __shared__ __attribute__((aligned(16))) unsigned char lds_raw[];
    LAS unsigned char* lds = (LAS unsigned char*)lds_raw;
    const int lo = a.ph_lo, hi = a.ph_hi;
    { int tid0 = threadIdx.x; asm volatile("" : "+v"(tid0)); for (int u = tid0; u < (LDS_BYTES - MISC_OFF) / 4; u += NTHR) ((LAS unsigned*)(lds + MISC_OFF))[u] = 0u; }
    SYNC();
    XcdBarrier bar; bar.bar = nullptr; bar.x = 0; bar.st = nullptr;
    if (hi - lo > 1) { KARGS(); bar = xcd_barrier_post((unsigned*)(GAS unsigned*)(ws + WS_CTL) + CW_BAR, (volatile LAS unsigned*)(lds + MISC_OFF) + 8); }
#define IN(k) (lo <= (k) && (k) < hi)
#define SEAM(k) do { if (IN(k) && IN((k) + 1)) xcd_barrier(bar); } while (0)
#define IDS() const int tid = threadIdx.x, lane = tid & 63, wave = __builtin_amdgcn_readfirstlane(tid >> 6), G = gridDim.x, bid = blockIdx.x; (void)lane; (void)wave; (void)G; (void)bid

    for (int rep_ph = 0; rep_ph < ((REP_PH == 0) ? 2 : 1); ++rep_ph) if (IN(0)) { KARGS(); IDS();
        P0Ptrs P{KIN(1), KIN(2), KIN(5), KIN(8), KIN(9), KIN(11), KIN(12), KIN(14), KIN(17), WSP(bf16_t, WS_WIN), WSP(bf16_t, WS_WATTN), WSP(bf16_t, WS_WGRP), WSP(bf16_t, WS_WPOOL), WSP(bf16_t, WS_WOUT),
                 WSP(bf16_t, WS_WUP), WSP(bf16_t, WS_WDOWN), WSP(float, WS_MODP)};
        p0_prologue(P, lds, bid * NWAVES + wave, G * NWAVES, wave, lane);
    }
    SEAM(0);
    if (IN(1)) { KARGS(); IDS();
        const float *b_ada = KIN(3), *norm1_g = KIN(4); const float* MODP = WSP(float, WS_MODP); float* MODF = WSP(float, WS_MODF);
        LAS float* mulv = (LAS float*)lds; LAS float* addv = mulv + 1024;
        for (int i = tid; i < 1024; i += NTHR) { float sh = b_ada[i], scv = b_ada[1024 + i];
#pragma unroll
            for (int kc = 0; kc < 16; ++kc) { sh += MODP[kc * NMOD + i]; scv += MODP[kc * NMOD + 1024 + i]; }
            mulv[i] = norm1_g[i] * (1.0f + scv); addv[i] = sh; }
        if (bid < 24 && tid < 256) { const int i = bid * 256 + tid; float v = b_ada[i];
#pragma unroll
            for (int kc = 0; kc < 16; ++kc) v += MODP[kc * NMOD + i];
            MODF[i] = v; }
        SYNC();
        modulate_rows(KIN(0), WSP(bf16_t, WS_H), mulv, addv, bid * NWAVES + wave, G * NWAVES, lane);
        SYNC();
    }
    SEAM(1);
    for (int rep_ph = 0; rep_ph < ((REP_PH == 2) ? 2 : 1); ++rep_ph) if (IN(2)) { KARGS(); IDS();
        pg8::Gemm g{WSP(bf16_t, WS_H), WSP(bf16_t, WS_WIN), M, NINP, DM}; pg8::StaticOrder S; S.init(M, NINP, G, bid);
        EpiProj E{WSP(bf16_t, WS_Q), WSP(unsigned char, WS_K), WSP(unsigned char, WS_V), WSP(bf16_t, WS_QI), WSP(bf16_t, WS_KI), WSP(bf16_t, WS_UPOOL), WSP(bf16_t, WS_GA), WSP(bf16_t, WS_GP), WSP(float, WS_WI), KIN(6), KIN(7)};
        pg8::gemm_phase<EpiProj, pg8::StaticOrder, true, true>(lds, g, S, E);
    }
    SEAM(2);
    if (IN(3)) { KARGS(); IDS();
        pooled_phase(WSP(bf16_t, WS_UPOOL), WSP(bf16_t, WS_POOLED), bid * NTHR + tid, G * NTHR);
        TkPtrs T{WSP(bf16_t, WS_QI), WSP(bf16_t, WS_KI), WSP(float, WS_WI), WSP(unsigned short, WS_SEL)};
        unsigned* qctr = (unsigned*)(GAS unsigned*)(ws + WS_CTL) + CW_QUEUE;
        LAS int* qslot = (LAS int*)(lds + ST_OFF + 2040);
#pragma unroll 1
        for (;;) {
            SYNC();
            if (tid == 0) *qslot = (int)__hip_atomic_fetch_add(qctr, 1u, __ATOMIC_RELAXED, __HIP_MEMORY_SCOPE_AGENT);
            SYNC();
            const int qi = *qslot;
            if (qi >= 512 * (1 + REP_TKONLY)) break;
            topk_attn_block(511 - (qi & 511), T, lds, tid, wave, lane, qi >= 512 * REP_TKONLY);
        }
        SYNC();
    }
    SEAM(3);
    if (IN(4)) { KARGS(); IDS();
        const unsigned short* SEL = WSP(unsigned short, WS_SEL); const bf16_t* Qp = WSP(bf16_t, WS_Q); const unsigned char *K8 = WSP(unsigned char, WS_K), *V8 = WSP(unsigned char, WS_V); bf16_t* ATTN = WSP(bf16_t, WS_ATTN);
        const bool aff = (G & 7) == 0; const int nitem = 8 * M, step = aff ? (G >> 3) * NWAVES : G * NWAVES;
#pragma unroll 1
        for (int it = aff ? (bid >> 3) * NWAVES + wave : bid * NWAVES + wave; it < (aff ? M : nitem); it += step) attn_item(aff ? it : (it >> 3), aff ? (bid & 7) : (it & 7), SEL, Qp, K8, V8, ATTN, lane);
    }
    SEAM(4);
    for (int rep_ph = 0; rep_ph < ((REP_PH == 5) ? 2 : 1); ++rep_ph) if (IN(5)) { KARGS(); IDS();
        pg8::Gemm g{WSP(bf16_t, WS_POOLED), WSP(bf16_t, WS_WGRP), M, PW, PW}; pg8::StaticOrder S; S.init(M, PW, G, bid);
        EpiBf<0> E{WSP(bf16_t, WS_POOLMIX), PW, KIN(10), nullptr};
        pg8::gemm_phase<EpiBf<0>, pg8::StaticOrder, true, true>(lds, g, S, E);
    }
    SEAM(5);
    if (IN(6)) { KARGS(); IDS();
        pg8::Gemm g{WSP(bf16_t, WS_POOLMIX), WSP(bf16_t, WS_WPOOL), M, DM, PW}; pg8::StaticOrder S; S.init(M, DM, G, bid);
        EpiBf<1> E{WSP(bf16_t, WS_GP), DM, nullptr, nullptr};
        pg8::gemm_phase<EpiBf<1>, pg8::StaticOrder, true, true>(lds, g, S, E);
    }
    SEAM(6);
    if (IN(7)) { KARGS(); IDS();
        pg8::Gemm g{WSP(bf16_t, WS_ATTN), WSP(bf16_t, WS_WATTN), M, DM, AW}; pg8::StaticOrder S; S.init(M, DM, G, bid);
        EpiBf<2> E{WSP(bf16_t, WS_GA), DM, nullptr, WSP(bf16_t, WS_GP)};
        pg8::gemm_phase<EpiBf<2>, pg8::StaticOrder, true, true>(lds, g, S, E);
    }
    SEAM(7);
    for (int rep_ph = 0; rep_ph < ((REP_PH == 8) ? 2 : 1); ++rep_ph) if (IN(8)) { KARGS(); IDS();
        pg8::Gemm g{WSP(bf16_t, WS_GA), WSP(bf16_t, WS_WOUT), M, DM, DM}; pg8::StaticOrder S; S.init(M, DM, G, bid);
        EpiRes E{KIN(0), KOUT(), WSP(float, WS_MODF) + 2048, 0.f};
        pg8::gemm_phase<EpiRes, pg8::StaticOrder, true, true>(lds, g, S, E);
    }
    SEAM(8);
    if (IN(9)) { KARGS(); IDS();
        const float* norm2_g = KIN(13); const float* MODF = WSP(float, WS_MODF);
        LAS float* mulv = (LAS float*)lds; LAS float* addv = mulv + 1024;
        for (int i = tid; i < 1024; i += NTHR) { mulv[i] = norm2_g[i] * (1.0f + MODF[4096 + i]); addv[i] = MODF[3072 + i]; }
        SYNC();
        modulate_rows(KOUT(), WSP(bf16_t, WS_H), mulv, addv, bid * NWAVES + wave, G * NWAVES, lane);
        SYNC();
    }
    SEAM(9);
    for (int rep_ph = 0; rep_ph < ((REP_PH == 10) ? 2 : 1); ++rep_ph) if (IN(10)) { KARGS(); IDS();
        pg8::Gemm g{WSP(bf16_t, WS_H), WSP(bf16_t, WS_WUP), M, FF2, DM}; pg8::StaticOrder S; S.init(M, FF2, G, bid);
        EpiUpAct E{WSP(bf16_t, WS_ACT), WSP(float, WS_RAW), KIN(15), KIN(16)};
        pg8::gemm_phase<EpiUpAct, pg8::StaticOrder, true, true>(lds, g, S, E);
    }
    SEAM(10);
    if (IN(11)) { KARGS(); IDS(); fixup_phase(WSP(float, WS_RAW), WSP(bf16_t, WS_ACT), KIN(15), KIN(16), bid * NTHR + tid, G * NTHR); }
    SEAM(11);
    if (IN(12)) { KARGS(); IDS();
        pg8::Gemm g{WSP(bf16_t, WS_ACT), WSP(bf16_t, WS_WDOWN), M, DM, FF}; pg8::StaticOrder S; S.init(M, DM, G, bid);
        EpiRes E{KOUT(), KOUT(), WSP(float, WS_MODF) + 5120, DBG_C};
        pg8::gemm_phase<EpiRes, pg8::StaticOrder, true, true>(lds, g, S, E);
    }
#undef IN
#undef SEAM
}

extern "C" void kernel_launch(void* const* d_in, const int* in_sizes, int n_in, void* d_out, int out_size, void* d_ws, size_t ws_size, hipStream_t stream) {
    static int grid = 0;
    if (grid == 0) {
        if (n_in != 18 || in_sizes[0] != M * DM || out_size != M * DM || ws_size < WS_END) { fprintf(stderr, "kernel_launch: unexpected shapes (n_in %d, in0 %d, out %d, ws %zu)\n", n_in, n_in > 0 ? in_sizes[0] : -1, out_size, ws_size); grid = -1; return; }
        int dev = 0, cus = 0, per_cu = 0;
        if (hipGetDevice(&dev) != hipSuccess || hipDeviceGetAttribute(&cus, hipDeviceAttributeMultiprocessorCount, dev) != hipSuccess) { grid = -1; return; }
        if (hipFuncSetAttribute((const void*)fwd_kernel, hipFuncAttributeMaxDynamicSharedMemorySize, LDS_BYTES) != hipSuccess) { fprintf(stderr, "kernel_launch: hipFuncSetAttribute failed\n"); grid = -1; return; }
        if (hipOccupancyMaxActiveBlocksPerMultiprocessor(&per_cu, (const void*)fwd_kernel, NTHR, LDS_BYTES) != hipSuccess || per_cu < 1) fprintf(stderr, "kernel_launch: occupancy query says %d\n", per_cu);
        (void)hipGetLastError();
        grid = cus;
    }
    if (grid < 0) return;
    (void)hipMemsetAsync((char*)d_ws + WS_CTL, 0, CTL_ZERO_BYTES, stream);
    Args a{};
    for (int i = 0; i < 18; ++i) a.in[i] = (const float*)d_in[i];
    a.out = (float*)d_out; a.ws = (unsigned char*)d_ws;
#if N_LAUNCH_MODE == 1
    a.ph_lo = 0; a.ph_hi = NPH;
    hipLaunchKernelGGL(fwd_kernel, dim3(grid), dim3(NTHR), LDS_BYTES, stream, a);
#else
    for (int p = 0; p < NPH; ++p) { a.ph_lo = p; a.ph_hi = p + 1; hipLaunchKernelGGL(fwd_kernel, dim3(grid), dim3(NTHR), LDS_BYTES, stream, a); }
#endif
}
```

```cpp
#ifndef REP_TKONLY
#define REP_TKONLY 0
#endif
#ifndef REP_BLK
#define REP_BLK 1
#endif
#include <hip/hip_runtime.h>
#include <cstdio>
#include <cstdint>
namespace pg8 {
#define PG8_LAS __attribute__((address_space(3)))
typedef unsigned short bf16_t;
typedef short bf16x8 __attribute__((ext_vector_type(8)));
typedef float f32x4 __attribute__((ext_vector_type(4)));
typedef unsigned u32x4 __attribute__((ext_vector_type(4)));
constexpr int BM = 256, BK = 64, HALF = 128, HTB = HALF * BK * 2  , STAGE_BYTES = 8 * HTB, NXCD = 8, WGM = 8;

__host__ __device__ __forceinline__ int lds_byte(int r, int c) { const int st = (r >> 4) * 2 + (c >> 5), rr = r & 15, cc = c & 31, ob = rr * 64 + cc * 2; return st * 1024 + (ob ^ (((ob >> 9) & 1) << 5)); }
__host__ __device__ __forceinline__ void stage_rc(int b, int& R, int& C) { const int st = b / 1024, sb = b % 1024, swz = sb ^ (((sb >> 9) & 1) << 5); R = (st >> 1) * 16 + swz / 64; C = (st & 1) * 32 + (swz % 64) / 2; }
__host__ __device__ __forceinline__ int perm32(int rho) { const int n = rho >> 4, i = rho & 15; return 8 * (i >> 2) + 4 * n + (i & 3); }

struct Unit { int pm, pn; };
struct Gemm { const bf16_t* A; const bf16_t* Bt; int M, N, K; };

struct StaticOrder {
    int nM, nN, nwg, G, c;
    __host__ __device__ void init(int M, int N, int G_, int c_) { nM = M / BM; nN = N / BM; nwg = nM * nN; G = G_; c = c_; }
    __host__ __device__ bool next(int i, Unit& u) const {
        const long L = (long)i * G + c; if (L >= nwg) return false;
        int wgid = (int)L; { const int q = nwg / NXCD, r = nwg % NXCD, xcd = wgid % NXCD, off = wgid / NXCD; wgid = (xcd < r ? xcd * (q + 1) : r * (q + 1) + (xcd - r) * q) + off; }
        const int nig = WGM * nN, gid = wgid / nig, fm = gid * WGM, gsz = (nM - fm) < WGM ? (nM - fm) : WGM;
        u.pm = fm + ((wgid % nig) % gsz); u.pn = (wgid % nig) / gsz; return true;
    }
    __device__ __forceinline__ void a_ready(const Unit&) const {}
    __device__ __forceinline__ void done(const Unit&) const {}
};

__device__ __forceinline__ unsigned cvt_pk_bf16(float lo, float hi) { unsigned r; asm volatile("v_cvt_pk_bf16_f32 %0, %1, %2" : "=v"(r) : "v"(lo), "v"(hi)); return r; }
template <class Epi, class Sched, bool ALIGN_EPI = false, bool SP2 = false>
__device__ __forceinline__ void gemm_phase(PG8_LAS unsigned char* lds, const Gemm g, const Sched& S, const Epi& E) {
    int tid_ = threadIdx.x; asm volatile("" : "+v"(tid_));
    const int tid = tid_, wid = __builtin_amdgcn_readfirstlane(tid >> 6), lane = tid & 63, wr = wid >> 2, wc = wid & 3, fr = lane & 15, fq = lane >> 4;
    const int K = g.K, nt = K / BK;
    unsigned voffA[2], voffB[2];
#pragma unroll
    for (int i = 0; i < 2; ++i) { int R, C; stage_rc(tid * 16 + i * 8192, R, C); const int Rb = Epi::PERM ? ((R & ~31) + perm32(R & 31)) : R;
        voffA[i] = (unsigned)(R * K + C) * 2u; voffB[i] = (unsigned)(Rb * K + C) * 2u; }
    const size_t kstep = (size_t)(BK * 2);
    const size_t hstep = (size_t)HALF * K * 2;
    const size_t tstep = 2 * hstep;
    const unsigned ldsw = (unsigned)wid * 1024u;
    const int aoff = lds_byte(wr * 64 + fr, fq * 8), boff = lds_byte(wc * 32 + fr, fq * 8);
#define PG8_SA(b, h) (((b) * 2 + (h)) * HTB)
#define PG8_SB(b, h) ((4 + (b) * 2 + (h)) * HTB)
#define PG8_STAGE(bufoff, gbase, voff) do { _Pragma("unroll") for (int _i = 0; _i < 2; ++_i) \
        __builtin_amdgcn_global_load_lds((const unsigned*)((const char*)(gbase) + (voff)[_i]), (PG8_LAS unsigned*)(lds + (bufoff) + ldsw + _i * 8192), 16, 0, 0); } while (0)
#define PG8_LDA(dst, b, h) do { _Pragma("unroll") for (int m = 0; m < 4; ++m) _Pragma("unroll") for (int k = 0; k < 2; ++k) dst[m][k] = *(const PG8_LAS bf16x8*)(lds + PG8_SA(b, h) + aoff + m * 2048 + k * 1024); } while (0)
#define PG8_LDB(dst, b, h) do { _Pragma("unroll") for (int n = 0; n < 2; ++n) _Pragma("unroll") for (int k = 0; k < 2; ++k) dst[n][k] = *(const PG8_LAS bf16x8*)(lds + PG8_SB(b, h) + boff + n * 2048 + k * 1024); } while (0)
#define PG8_MMA(ai, bj, At, Bt) do { __builtin_amdgcn_s_setprio(1); _Pragma("unroll") for (int m = 0; m < 4; ++m) _Pragma("unroll") for (int n = 0; n < 2; ++n) _Pragma("unroll") for (int k = 0; k < 2; ++k) \
        acc[ai][bj][m][n] = __builtin_amdgcn_mfma_f32_16x16x32_bf16(Bt[n][k], At[m][k], acc[ai][bj][m][n], 0, 0, 0); __builtin_amdgcn_s_setprio(0); } while (0)
#define PG8_WAIT_V(n) asm volatile("s_waitcnt vmcnt(" #n ")" ::: "memory")
#define PG8_WAIT_L(n) asm volatile("s_waitcnt lgkmcnt(" #n ")" ::: "memory")
#define PG8_BAR __builtin_amdgcn_s_barrier()
#define PG8_SCHED __builtin_amdgcn_sched_barrier(0)
    Unit cur, nxt; int ui = 0;
    if (!S.next(0, cur)) return;
    f32x4 acc[2][2][4][2];
#pragma unroll
    for (int a = 0; a < 2; ++a)
#pragma unroll
        for (int b = 0; b < 2; ++b)
#pragma unroll
            for (int m = 0; m < 4; ++m)
#pragma unroll
                for (int n = 0; n < 2; ++n) acc[a][b][m][n] = (f32x4){0.f, 0.f, 0.f, 0.f};
    bf16x8 At[4][2], B0[2][2], B1[2][2];
    const char* cA = (const char*)g.A + (size_t)cur.pm * tstep; const char* cB = (const char*)g.Bt + (size_t)cur.pn * tstep;
    S.a_ready(cur);
    if constexpr (SP2) {
        PG8_STAGE(PG8_SB(0, 0), cB, voffB); PG8_STAGE(PG8_SB(0, 1), cB + hstep, voffB); PG8_STAGE(PG8_SA(0, 0), cA, voffA); PG8_STAGE(PG8_SA(0, 1), cA + hstep, voffA);
        if (wr == 1) PG8_BAR;
        PG8_WAIT_V(2); PG8_BAR;
        PG8_STAGE(PG8_SB(1, 0), cB + kstep, voffB); PG8_STAGE(PG8_SA(1, 0), cA + kstep, voffA); PG8_STAGE(PG8_SB(1, 1), cB + hstep + kstep, voffB);
        PG8_WAIT_V(6); PG8_BAR;
    } else {
        PG8_STAGE(PG8_SB(0, 0), cB, voffB); PG8_STAGE(PG8_SA(0, 0), cA, voffA); PG8_STAGE(PG8_SB(0, 1), cB + hstep, voffB); PG8_STAGE(PG8_SA(0, 1), cA + hstep, voffA);
        if (wr == 1) PG8_BAR;
        PG8_WAIT_V(4); PG8_BAR;
        PG8_STAGE(PG8_SB(1, 0), cB + kstep, voffB); PG8_STAGE(PG8_SA(1, 0), cA + kstep, voffA); PG8_STAGE(PG8_SB(1, 1), cB + hstep + kstep, voffB);
        PG8_WAIT_V(6); PG8_BAR;
    }
    for (;;) {
        const bool has_next = S.next(ui + 1, nxt);
        const char* nA = has_next ? (const char*)g.A + (size_t)nxt.pm * tstep : cA; const char* nB = has_next ? (const char*)g.Bt + (size_t)nxt.pn * tstep : cB;
        for (int t = 0; t < nt; t += 2) {
            const bool last = (t == nt - 2);
            const char* a1 = cA + (size_t)(t + 1) * kstep;
            const char* a2 = last ? nA : cA + (size_t)(t + 2) * kstep; const char* b2 = last ? nB : cB + (size_t)(t + 2) * kstep;
            const char* a3 = a2 + kstep; const char* b3 = b2 + kstep;
            if (last && has_next) S.a_ready(nxt);
            if constexpr (SP2) {
            PG8_LDB(B0, 0, 0); PG8_LDB(B1, 0, 1); PG8_SCHED; PG8_LDA(At, 0, 0); PG8_STAGE(PG8_SA(1, 1), a1 + hstep, voffA);
            PG8_WAIT_V(8); PG8_WAIT_L(0); PG8_BAR; PG8_MMA(0, 0, At, B0); PG8_MMA(0, 1, At, B1); PG8_BAR; PG8_SCHED;
            PG8_LDA(At, 0, 1); PG8_STAGE(PG8_SB(0, 0), b2, voffB); PG8_STAGE(PG8_SB(0, 1), b2 + hstep, voffB); PG8_STAGE(PG8_SA(0, 0), a2, voffA);
            PG8_WAIT_V(8); PG8_WAIT_L(0); PG8_BAR; PG8_MMA(1, 0, At, B0); PG8_MMA(1, 1, At, B1); PG8_BAR; PG8_SCHED;
            PG8_LDB(B0, 1, 0); PG8_LDB(B1, 1, 1); PG8_SCHED; PG8_LDA(At, 1, 0); PG8_STAGE(PG8_SA(0, 1), a2 + hstep, voffA);
            PG8_WAIT_V(8); PG8_WAIT_L(0); PG8_BAR; PG8_MMA(0, 0, At, B0); PG8_MMA(0, 1, At, B1); PG8_BAR; PG8_SCHED;
            PG8_LDA(At, 1, 1); PG8_STAGE(PG8_SB(1, 0), b3, voffB); PG8_STAGE(PG8_SB(1, 1), b3 + hstep, voffB); PG8_STAGE(PG8_SA(1, 0), a3, voffA);
            PG8_WAIT_V(8); PG8_WAIT_L(0); PG8_BAR; PG8_MMA(1, 0, At, B0); PG8_MMA(1, 1, At, B1); PG8_BAR; PG8_SCHED;
            } else {
            PG8_LDB(B0, 0, 0); PG8_SCHED; PG8_LDA(At, 0, 0); PG8_STAGE(PG8_SA(1, 1), a1 + hstep, voffA);
            PG8_WAIT_L(8); PG8_BAR; PG8_WAIT_L(0); PG8_MMA(0, 0, At, B0); PG8_BAR; PG8_SCHED;
            PG8_LDB(B1, 0, 1); PG8_STAGE(PG8_SB(0, 0), b2, voffB);
            PG8_BAR; PG8_WAIT_L(0); PG8_MMA(0, 1, At, B1); PG8_BAR;
            PG8_LDA(At, 0, 1); PG8_STAGE(PG8_SA(0, 0), a2, voffA);
            PG8_BAR; PG8_WAIT_L(0); PG8_MMA(1, 0, At, B0); PG8_BAR; PG8_SCHED;
            PG8_STAGE(PG8_SB(0, 1), b2 + hstep, voffB);
            PG8_WAIT_V(6); PG8_BAR; PG8_MMA(1, 1, At, B1); PG8_BAR;
            PG8_LDB(B0, 1, 0); PG8_SCHED; PG8_LDA(At, 1, 0); PG8_STAGE(PG8_SA(0, 1), a2 + hstep, voffA);
            PG8_WAIT_L(8); PG8_BAR; PG8_WAIT_L(0); PG8_MMA(0, 0, At, B0); PG8_BAR; PG8_SCHED;
            PG8_LDB(B1, 1, 1); PG8_STAGE(PG8_SB(1, 0), b3, voffB);
            PG8_BAR; PG8_WAIT_L(0); PG8_MMA(0, 1, At, B1); PG8_BAR;
            PG8_LDA(At, 1, 1); PG8_STAGE(PG8_SA(1, 0), a3, voffA);
            PG8_BAR; PG8_WAIT_L(0); PG8_MMA(1, 0, At, B0); PG8_BAR; PG8_SCHED;
            PG8_STAGE(PG8_SB(1, 1), b3 + hstep, voffB);
            PG8_WAIT_V(6); PG8_BAR; PG8_MMA(1, 1, At, B1); PG8_BAR;
            }
        }
        if constexpr (ALIGN_EPI) { if (wr == 0) PG8_BAR; }
        if constexpr (!Epi::AFTER_DRAIN) { E(acc, cur, wr, wc, fr, fq); S.done(cur); }
        if (!has_next) break;
#pragma unroll
        for (int a = 0; a < 2; ++a)
#pragma unroll
            for (int b = 0; b < 2; ++b)
#pragma unroll
                for (int m = 0; m < 4; ++m)
#pragma unroll
                    for (int n = 0; n < 2; ++n) acc[a][b][m][n] = (f32x4){0.f, 0.f, 0.f, 0.f};
        cur = nxt; cA = nA; cB = nB; ++ui;
        if constexpr (ALIGN_EPI) { if (wr == 1) PG8_BAR; }
    }
    PG8_WAIT_V(0);
    if constexpr (!ALIGN_EPI) { if (wr == 0) PG8_BAR; }
    PG8_BAR;
    if constexpr (Epi::AFTER_DRAIN) { E.fused(acc, cur, wr, wc, fr, fq, lds, wid, lane); S.done(cur); }
#undef PG8_SA
#undef PG8_SB
#undef PG8_STAGE
#undef PG8_LDA
#undef PG8_LDB
#undef PG8_MMA
#undef PG8_WAIT_V
#undef PG8_WAIT_L
#undef PG8_BAR
#undef PG8_SCHED
}
}
#define GAS __attribute__((address_space(1)))
#define LAS __attribute__((address_space(3)))
typedef unsigned short bf16;
typedef unsigned v4u __attribute__((ext_vector_type(4)));
typedef float f32x4 __attribute__((ext_vector_type(4)));
typedef short bf16x8 __attribute__((ext_vector_type(8)));
typedef GAS unsigned gu32;
typedef GAS unsigned long long gu64;
#define RLX_AGENT __ATOMIC_RELAXED, __HIP_MEMORY_SCOPE_AGENT
#define LDS_WAIT() asm volatile("s_waitcnt lgkmcnt(0)" ::: "memory")
#define VM_WAIT() asm volatile("s_waitcnt vmcnt(0)" ::: "memory")
__device__ __forceinline__ unsigned long long rt() { return __builtin_amdgcn_s_memrealtime(); }
__device__ __forceinline__ unsigned f2bf(float f) { unsigned u = __builtin_bit_cast(unsigned, f); return (u + 0x7fffu + ((u >> 16) & 1u)) >> 16; }
__device__ __forceinline__ unsigned pk2(float lo, float hi) { return f2bf(lo) | (f2bf(hi) << 16); }

#define XB_TMO      128
#define XB_XCNT(j)  (256  + 64 * (j))
#define XB_XSUB(j)  (1280 + 64 * (j))
#define XB_XGEN(j)  (2304 + 64 * (j))
#define XB_TOP      3328
#define XB_TOPGEN   3392
#define XCD_BAR_WORDS 3456
#define XB_SPIN_CAP (1u << 18)

__device__ __forceinline__ unsigned xb_ld(unsigned* p)              { return __hip_atomic_load(p, __ATOMIC_RELAXED, __HIP_MEMORY_SCOPE_AGENT); }
__device__ __forceinline__ unsigned xb_add(unsigned* p, unsigned v) { return __hip_atomic_fetch_add(p, v, __ATOMIC_RELAXED, __HIP_MEMORY_SCOPE_AGENT); }
__device__ __forceinline__ unsigned xb_xcc_id() { return (unsigned)__builtin_amdgcn_s_getreg((3 << 11) | 20) & 0xFu; }
#define XB_SPIN(cond, bar) do { unsigned _sp = 0; while (cond) { __builtin_amdgcn_s_sleep(1); \
    if ((++_sp & 255u) == 0u) { if (xb_ld(&(bar)[XB_TMO])) break; if (_sp > XB_SPIN_CAP) { atomicAdd(&(bar)[XB_TMO], 1u); break; } } } } while (0)

struct XcdBarrier {
    unsigned* bar; unsigned x;
    volatile LAS unsigned* st;
};

__device__ __forceinline__ XcdBarrier xcd_barrier_post(unsigned* bar, volatile LAS unsigned* st) {
    XcdBarrier b; b.bar = bar; b.x = xb_xcc_id(); b.st = st;
    if (threadIdx.x == 0) (void)xb_add(&bar[XB_XCNT(b.x)], 1u);
    return b;
}
__device__ __forceinline__ void xcd_barrier_complete(unsigned* bar, unsigned x, unsigned& nloc, unsigned& nx) {
    const unsigned G = gridDim.x * gridDim.y * gridDim.z;
    unsigned sum, cnt, mine, sp = 0u;
    for (;;) {
        sum = 0u; cnt = 0u; mine = 0u;
#pragma unroll
        for (unsigned j = 0; j < 16; ++j) { const unsigned c = xb_ld(&bar[XB_XCNT(j)]); sum += c; cnt += (c > 0u) ? 1u : 0u; mine = (j == x) ? c : mine; }
        if (sum == G) break;
        __builtin_amdgcn_s_sleep(1);
        if ((++sp & 255u) == 0u) { if (xb_ld(&bar[XB_TMO])) break; if (sp > XB_SPIN_CAP) { atomicAdd(&bar[XB_TMO], 1u); break; } }
    }
    nloc = mine > 0u ? mine : 1u; nx = cnt > 0u ? cnt : 1u;
}

__device__ __forceinline__ void xcd_barrier(const XcdBarrier& b) {
    asm volatile("s_waitcnt vmcnt(0)" ::: "memory");
    __syncthreads();
    if (threadIdx.x == 0) {
        unsigned* bar = b.bar;
        __builtin_amdgcn_s_waitcnt(0);
        unsigned nloc = b.st[0], nx = b.st[1];
        if (nloc == 0u) { xcd_barrier_complete(bar, b.x, nloc, nx); b.st[0] = nloc; b.st[1] = nx; }
        const unsigned old = xb_add(&bar[XB_XSUB(b.x)], 1u);
        const unsigned gen = old / nloc;
        if (old + 1u == (gen + 1u) * nloc) {
            __builtin_amdgcn_fence(__ATOMIC_RELEASE, "agent");
            asm volatile("s_waitcnt vmcnt(0)" ::: "memory");
            const unsigned og = xb_add(&bar[XB_TOP], 1u);
            const unsigned tg = og / nx;
            if (og + 1u == (tg + 1u) * nx) xb_add(&bar[XB_TOPGEN], 1u);
            else XB_SPIN(xb_ld(&bar[XB_TOPGEN]) == tg, bar);
            __builtin_amdgcn_fence(__ATOMIC_ACQUIRE, "agent");
            xb_add(&bar[XB_XGEN(b.x)], 1u);
            asm volatile("s_waitcnt vmcnt(0)" ::: "memory");
        } else {
            XB_SPIN(xb_ld(&bar[XB_XGEN(b.x)]) == gen, bar);
            __builtin_amdgcn_fence(__ATOMIC_ACQUIRE, "agent");
            asm volatile("s_waitcnt vmcnt(0)" ::: "memory");
        }
    }
    __syncthreads();
}


#ifndef STAGE
#define STAGE 3
#endif
#ifndef N_LAUNCH_MODE
#define N_LAUNCH_MODE 1
#endif
#ifndef REP_TK
#define REP_TK 1
#endif
#ifndef REP_AT
#define REP_AT 1
#endif
#ifndef REP_PH
#define REP_PH -1
#endif
#ifndef TK_PREFETCH
#define TK_PREFETCH 1
#endif
#ifndef DBG_C
#define DBG_C 0.0f
#endif

typedef float f32x16 __attribute__((ext_vector_type(16)));
typedef __attribute__((ext_vector_type(2))) __bf16 bf16x2_t;
using pg8::bf16_t; using pg8::Unit;

constexpr int M = 16384, DM = 1024, NHEAD = 8, HD = 64, AW = 512, PW = 512, FF = 2816, FF2 = 5632, NIN = 4420, NINP = 4608, NMOD = 6144;
constexpr float EPS = 1e-6f;
constexpr int NWAVES = 8, NTHR = 512;

constexpr size_t MiB = 1u << 20;
constexpr size_t WS_CTL = 0, CTL_ZERO_BYTES = 64 * 1024;
constexpr size_t WS_WIN = 1 * MiB, WS_WATTN = 10 * MiB, WS_WGRP = 11 * MiB, WS_WPOOL = 11 * MiB + 512 * 1024, WS_WOUT = 12 * MiB + 512 * 1024,
                 WS_WUP = 14 * MiB + 512 * 1024, WS_WDOWN = 25 * MiB + 512 * 1024;
constexpr size_t WS_MODP = 31 * MiB, WS_MODF = 31 * MiB + 393216, WS_WI = 31 * MiB + 512 * 1024;
constexpr size_t WS_H = 32 * MiB;
constexpr size_t WS_Q = 64 * MiB, WS_K = 80 * MiB, WS_V = 96 * MiB;
constexpr size_t WS_SEL = 88 * MiB;
constexpr size_t WS_QI = 112 * MiB, WS_KI = 120 * MiB;
constexpr size_t WS_UPOOL = 128 * MiB, WS_POOLED = 144 * MiB, WS_POOLMIX = 160 * MiB, WS_ATTN = 176 * MiB;
constexpr size_t WS_GA = 192 * MiB, WS_GP = 224 * MiB;
constexpr size_t WS_ACT = 64 * MiB;
constexpr size_t WS_RAW = 152 * MiB;
constexpr size_t WS_END = 256 * MiB;
constexpr int CW_BAR = 1024, CW_QUEUE = 512;

constexpr int LDS_BYTES = 163840;
constexpr int HSTRIDE = 1025, MSTRIDE = 513;
constexpr int LIST_OFF = 135168, ST_OFF = 151552, MISC_OFF = 159744;

#define SYNC() __syncthreads()
__device__ __forceinline__ float wave_sum(float v) {
#pragma unroll
    for (int o = 1; o < 64; o <<= 1) v += __shfl_xor(v, o);
    return v;
}
__device__ __forceinline__ float bf_lo(unsigned w) { return __builtin_bit_cast(float, w << 16); }
__device__ __forceinline__ float bf_hi(unsigned w) { return __builtin_bit_cast(float, w & 0xffff0000u); }
__device__ __forceinline__ float sigmoidf_(float x) { return 1.0f / (1.0f + __expf(-x)); }
__device__ __forceinline__ unsigned pkbf(float lo, float hi) { return pg8::cvt_pk_bf16(lo, hi); }
typedef unsigned u32x2 __attribute__((ext_vector_type(2)));
__device__ __forceinline__ u32x2 pk4(f32x4 v) { u32x2 r; r.x = pkbf(v[0], v[1]); r.y = pkbf(v[2], v[3]); return r; }
__device__ __forceinline__ unsigned pk4_fp8(f32x4 v) { int w = 0; w = __builtin_amdgcn_cvt_pk_fp8_f32(v[0], v[1], w, false); w = __builtin_amdgcn_cvt_pk_fp8_f32(v[2], v[3], w, true); return (unsigned)w; }

__device__ __forceinline__ void tr_item(const float* W, int ldw, int src_col, int nvalid, int k0, bf16_t* WT, int K, int dst_row, LAS float* scr, int lane) {
    f32x4 v[8];
#pragma unroll
    for (int i = 0; i < 8; ++i) { const int kk = 8 * i + (lane >> 3), n4 = 4 * (lane & 7);
        v[i] = (f32x4){0.f, 0.f, 0.f, 0.f}; if (W != nullptr && n4 < nvalid) v[i] = *(const f32x4*)(W + (size_t)(k0 + kk) * ldw + src_col + n4); }
#pragma unroll
    for (int i = 0; i < 8; ++i) { const int kk = 8 * i + (lane >> 3), n4 = 4 * (lane & 7); LAS float* p = scr + kk * 33 + n4; p[0] = v[i][0]; p[1] = v[i][1]; p[2] = v[i][2]; p[3] = v[i][3]; }
    LDS_WAIT(); asm volatile("" ::: "memory");
    const int c = lane & 7;
#pragma unroll
    for (int j = 0; j < 4; ++j) { const int n = (lane >> 3) + 8 * j; const LAS float* s = scr + (8 * c) * 33 + n;
        v4u o; o.x = pk2(s[0 * 33], s[1 * 33]); o.y = pk2(s[2 * 33], s[3 * 33]); o.z = pk2(s[4 * 33], s[5 * 33]); o.w = pk2(s[6 * 33], s[7 * 33]);
        *(GAS v4u*)(WT + (size_t)(dst_row + n) * K + k0 + 8 * c) = o; }
    LDS_WAIT(); asm volatile("" ::: "memory");
}

struct P0Ptrs { const float *c, *w_ada, *w_in, *w_attn, *w_grp, *w_pool, *w_out, *w_up, *w_down; bf16_t *WIN, *WATTN, *WGRP, *WPOOL, *WOUT, *WUP, *WDOWN; float* MODP; };
__device__ __forceinline__ void p0_prologue(const P0Ptrs& P, LAS unsigned char* lds, int gw, int NGW, int wave, int lane) {
    LAS float* scr = (LAS float*)(lds + wave * 16384);
    LAS float* sil = (LAS float*)(lds + 131072);
    for (int i = threadIdx.x; i < 1024; i += NTHR) { const float cv = P.c[i]; sil[i] = cv / (1.0f + __expf(-cv)); }
    SYNC();
    constexpr int I_WIN = 144 * 16, I_WATTN = 32 * 8, I_WGRP = 16 * 8, I_WPOOL = 32 * 8, I_WOUT = 32 * 16, I_WUP = 176 * 16, I_WDOWN = 32 * 44, I_MOD = 96 * 16;
    constexpr int NITEMS = I_WIN + I_WATTN + I_WGRP + I_WPOOL + I_WOUT + I_WUP + I_WDOWN + I_MOD;
    for (int it = gw; it < NITEMS; it += NGW) {
        int r = it;
        if (r < I_MOD) {
            const int cb = r % 96, kc = r / 96, col = cb * 64 + lane; float acc = 0.f;
#pragma unroll 8
            for (int i = 0; i < 64; ++i) { const int k = kc * 64 + i; acc = fmaf(sil[k], P.w_ada[(size_t)k * NMOD + col], acc); }
            P.MODP[kc * NMOD + col] = acc; continue; }
        r -= I_MOD;
        if (r < I_WIN) { const int g = r / 16, kb = r % 16, tile = g >> 3, gi = g & 7; int src = -1, nv = 32;
            const int permgi = gi < 4 ? 64 * gi : 64 * (gi - 4) + 32;
            if (tile < 2) src = tile * 256 + permgi;
            else if (tile < 4) src = 512 + (tile - 2) * 256 + permgi;
            else if (tile < 6) src = 1024 + (tile - 4) * 256 + 32 * gi;
            else if (tile == 6) src = 1536 + 32 * gi;
            else if (tile == 7) { if (gi < 2) src = 1792 + 32 * gi; else if (gi == 2) { src = 1856; nv = 4; } }
            else if (tile < 10) src = 1860 + (tile - 8) * 256 + 32 * gi;
            else if (tile < 14) src = 2372 + (tile - 10) * 256 + 32 * gi;
            else src = 3396 + (tile - 14) * 256 + 32 * gi;
            tr_item(src >= 0 ? P.w_in : nullptr, NIN, src >= 0 ? src : 0, nv, kb * 64, P.WIN, 1024, g * 32, scr, lane); continue; }
        r -= I_WIN;
        if (r < I_WATTN) { tr_item(P.w_attn, 1024, (r / 8) * 32, 32, (r % 8) * 64, P.WATTN, 512, (r / 8) * 32, scr, lane); continue; }
        r -= I_WATTN;
        if (r < I_WGRP) { const int g = r / 8, kb = r % 8, grp = g >> 2;
            const bool nz = (kb >> 1) == grp;
            tr_item(nz ? P.w_grp + (size_t)grp * 128 * 128 : nullptr, 128, (g & 3) * 32, 32, (kb & 1) * 64, P.WGRP + (size_t)(kb >> 1) * 128, 512, g * 32, scr, lane);
            continue; }
        r -= I_WGRP;
        if (r < I_WPOOL) { tr_item(P.w_pool, 1024, (r / 8) * 32, 32, (r % 8) * 64, P.WPOOL, 512, (r / 8) * 32, scr, lane); continue; }
        r -= I_WPOOL;
        if (r < I_WOUT) { tr_item(P.w_out, 1024, (r / 16) * 32, 32, (r % 16) * 64, P.WOUT, 1024, (r / 16) * 32, scr, lane); continue; }
        r -= I_WOUT;
        if (r < I_WUP) { const int g = r / 16, kb = r % 16, tile = g >> 3, gi = g & 7;
            const int src = gi < 4 ? 128 * tile + 32 * gi : FF + 128 * tile + 32 * (gi - 4);
            tr_item(P.w_up, FF2, src, 32, kb * 64, P.WUP, 1024, g * 32, scr, lane); continue; }
        r -= I_WUP;
        { tr_item(P.w_down, 1024, (r / 44) * 32, 32, (r % 44) * 64, P.WDOWN, FF, (r / 44) * 32, scr, lane); }
    }
}

__device__ __forceinline__ void modulate_rows(const float* X, bf16_t* O, const LAS float* mulv, const LAS float* addv, int gw, int NGW, int lane) {
    f32x4 mu[4], ad[4];
#pragma unroll
    for (int j = 0; j < 4; ++j) { mu[j] = *(const LAS f32x4*)(mulv + 4 * lane + 256 * j); ad[j] = *(const LAS f32x4*)(addv + 4 * lane + 256 * j); }
    for (int row = gw; row < M; row += NGW) {
        const GAS f32x4* xr = (const GAS f32x4*)(X + (size_t)row * DM) + lane;
        f32x4 v[4]; float s = 0.f;
#pragma unroll
        for (int j = 0; j < 4; ++j) { v[j] = xr[64 * j]; s += (v[j].x * v[j].x + v[j].y * v[j].y) + (v[j].z * v[j].z + v[j].w * v[j].w); }
        const float rstd = 1.0f / sqrtf(wave_sum(s) * (1.0f / DM) + EPS);
        GAS u32x2* o8 = (GAS u32x2*)(O + (size_t)row * DM) + lane;
#pragma unroll
        for (int j = 0; j < 4; ++j) { const f32x4 y = v[j] * rstd * mu[j] + ad[j]; o8[64 * j] = pk4(y); }
    }
}

struct EpiProj {
    static constexpr bool PERM = false, AFTER_DRAIN = false;
    bf16_t *Q; unsigned char *K8, *V8; bf16_t *QI, *KI, *UPOOL, *GA, *GP; float* WI; const float *qg, *kg;
    __device__ __forceinline__ void operator()(const pg8::f32x4 (&acc)[2][2][4][2], const Unit& u, int wr, int wc, int fr, int fq) const {
        const int pn = u.pn, row0 = u.pm * 256 + wr * 64 + fr;
        if (pn < 4) {
            const bool isq = pn < 2; const float* g = isq ? qg : kg; const int head = (pn & 1) * 4 + wc;
            f32x4 gv[2][2];
#pragma unroll
            for (int bj = 0; bj < 2; ++bj)
#pragma unroll
                for (int n = 0; n < 2; ++n) gv[bj][n] = *(const f32x4*)(g + 32 * bj + 16 * n + 4 * fq);
#pragma unroll
            for (int ai = 0; ai < 2; ++ai)
#pragma unroll
                for (int m = 0; m < 4; ++m) {
                    float ss = 0.f;
#pragma unroll
                    for (int bj = 0; bj < 2; ++bj)
#pragma unroll
                        for (int n = 0; n < 2; ++n) { const f32x4 x = acc[ai][bj][m][n]; ss += (x[0] * x[0] + x[1] * x[1]) + (x[2] * x[2] + x[3] * x[3]); }
                    ss += __shfl_xor(ss, 16); ss += __shfl_xor(ss, 32);
                    const float rstd = 1.0f / sqrtf(ss * (1.0f / 64.0f) + EPS);
                    const size_t ro = (size_t)(row0 + ai * 128 + m * 16) * AW + head * 64 + 4 * fq;
#pragma unroll
                    for (int bj = 0; bj < 2; ++bj)
#pragma unroll
                        for (int n = 0; n < 2; ++n) { const f32x4 y = acc[ai][bj][m][n] * rstd * gv[bj][n];
                            if (isq) *(u32x2*)(Q + ro + 32 * bj + 16 * n) = pk4(y); else *(unsigned*)(K8 + ((size_t)head * M + (row0 + ai * 128 + m * 16)) * 64 + 4 * fq + 32 * bj + 16 * n) = pk4_fp8(y); }
                }
            return;
        }
        const int colw = wc * 32 + 4 * fq;
        if (pn == 7) {
#pragma unroll
            for (int ai = 0; ai < 2; ++ai)
#pragma unroll
                for (int m = 0; m < 4; ++m) { const int row = row0 + ai * 128 + m * 16;
                    if (wc < 2) {
#pragma unroll
                        for (int n = 0; n < 2; ++n) { const int c = colw + 16 * n; *(u32x2*)(KI + (size_t)(row >> 5) * 2048 + (c >> 4) * 512 + ((((c >> 3) & 1) * 32 + (row & 31)) * 8) + (c & 7)) = pk4(acc[ai][0][m][n]); }
                    } else if (wc == 2 && fq == 0) { *(f32x4*)(WI + (size_t)row * 4) = acc[ai][0][m][0] * 0.5f; }
                }
            return;
        }
        if (pn < 6) {
#pragma unroll
            for (int ai = 0; ai < 2; ++ai)
#pragma unroll
                for (int m = 0; m < 4; ++m) { const int row = row0 + ai * 128 + m * 16;
#pragma unroll
                    for (int bj = 0; bj < 2; ++bj)
#pragma unroll
                        for (int n = 0; n < 2; ++n) { const int col = (pn - 4) * 256 + colw + 128 * bj + 16 * n;
                            *(unsigned*)(V8 + ((size_t)(col >> 6) * M + row) * 64 + (col & 63)) = pk4_fp8(acc[ai][bj][m][n]); } }
            return;
        }
        bf16_t* O; int ldo, ct; float sc = 1.0f; bool sig = false;
        if (pn == 6) { O = QI; ldo = 256; ct = 0; sc = 0.125f; }
        else if (pn < 10) { O = UPOOL; ldo = PW; ct = (pn - 8) * 256; }
        else if (pn < 14) { O = GA; ldo = DM; ct = (pn - 10) * 256; sig = true; }
        else { O = GP; ldo = DM; ct = (pn - 14) * 256; sig = true; }
#pragma unroll
        for (int ai = 0; ai < 2; ++ai)
#pragma unroll
            for (int m = 0; m < 4; ++m) { bf16_t* rowp = O + (size_t)(row0 + ai * 128 + m * 16) * ldo + ct + colw;
#pragma unroll
                for (int bj = 0; bj < 2; ++bj)
#pragma unroll
                    for (int n = 0; n < 2; ++n) { f32x4 y = acc[ai][bj][m][n] * sc;
                        if (sig) { y[0] = sigmoidf_(y[0]); y[1] = sigmoidf_(y[1]); y[2] = sigmoidf_(y[2]); y[3] = sigmoidf_(y[3]); }
                        *(u32x2*)(rowp + 128 * bj + 16 * n) = pk4(y); }
            }
    }
};

template <int MODE> struct EpiBf {
    static constexpr bool PERM = false, AFTER_DRAIN = false;
    bf16_t* O; int ldo; const float* colscale; const bf16_t* ADD;
    __device__ __forceinline__ void operator()(const pg8::f32x4 (&acc)[2][2][4][2], const Unit& u, int wr, int wc, int fr, int fq) const {
        const int row0 = u.pm * 256 + wr * 64 + fr, col0 = u.pn * 256 + wc * 32 + 4 * fq;
#pragma unroll
        for (int ai = 0; ai < 2; ++ai)
#pragma unroll
            for (int m = 0; m < 4; ++m) { const size_t ro = (size_t)(row0 + ai * 128 + m * 16) * ldo + col0;
#pragma unroll
                for (int bj = 0; bj < 2; ++bj)
#pragma unroll
                    for (int n = 0; n < 2; ++n) { f32x4 y = acc[ai][bj][m][n]; const size_t off = ro + 128 * bj + 16 * n;
                        if (MODE == 0) { y = y * *(const f32x4*)(colscale + col0 + 128 * bj + 16 * n); }
                        else { const u32x2 gq = *(const u32x2*)(O + off); y[0] *= bf_lo(gq.x); y[1] *= bf_hi(gq.x); y[2] *= bf_lo(gq.y); y[3] *= bf_hi(gq.y);
                            if (MODE == 2) { const u32x2 a = *(const u32x2*)(ADD + off); y[0] += bf_lo(a.x); y[1] += bf_hi(a.x); y[2] += bf_lo(a.y); y[3] += bf_hi(a.y); } }
                        *(u32x2*)(O + off) = pk4(y); }
            }
    }
};

struct EpiRes {
    static constexpr bool PERM = false, AFTER_DRAIN = false;
    const float* BASE; float* OUT; const float* gate; float dbg;
    __device__ __forceinline__ void operator()(const pg8::f32x4 (&acc)[2][2][4][2], const Unit& u, int wr, int wc, int fr, int fq) const {
        const int row0 = u.pm * 256 + wr * 64 + fr, col0 = u.pn * 256 + wc * 32 + 4 * fq;
        f32x4 gv[2][2];
#pragma unroll
        for (int bj = 0; bj < 2; ++bj)
#pragma unroll
            for (int n = 0; n < 2; ++n) gv[bj][n] = *(const f32x4*)(gate + col0 + 128 * bj + 16 * n);
#pragma unroll
        for (int ai = 0; ai < 2; ++ai)
#pragma unroll
            for (int m = 0; m < 4; ++m) { const int row = row0 + ai * 128 + m * 16; const size_t ro = (size_t)row * DM + col0;
#pragma unroll
                for (int bj = 0; bj < 2; ++bj)
#pragma unroll
                    for (int n = 0; n < 2; ++n) { const size_t off = ro + 128 * bj + 16 * n; f32x4 y = *(const f32x4*)(BASE + off) + gv[bj][n] * acc[ai][bj][m][n];
                        if (dbg != 0.f) { const float sg = ((row * 7 + (int)(off >> 2)) & 1) ? dbg : -dbg; y[0] += sg; y[1] -= sg; y[2] += sg; y[3] -= sg; }
                        *(f32x4*)(OUT + off) = y; }
            }
    }
};

template <int CTRL> __device__ __forceinline__ float dppf(float x) { return __builtin_bit_cast(float, __builtin_amdgcn_update_dpp(0, __builtin_bit_cast(int, x), CTRL, 0xf, 0xf, false)); }
__device__ __forceinline__ f32x4 ror1(f32x4 v) { f32x4 r; r[0] = dppf<0x121>(v[0]); r[1] = dppf<0x121>(v[1]); r[2] = dppf<0x121>(v[2]); r[3] = dppf<0x121>(v[3]); return r; }
__device__ __forceinline__ f32x4 ror2(f32x4 v) { f32x4 r; r[0] = dppf<0x122>(v[0]); r[1] = dppf<0x122>(v[1]); r[2] = dppf<0x122>(v[2]); r[3] = dppf<0x122>(v[3]); return r; }
__device__ __forceinline__ f32x4 silu_mul(f32x4 a, f32x4 b) { f32x4 r;
#pragma unroll
    for (int e = 0; e < 4; ++e) r[e] = a[e] / (1.0f + __expf(-a[e])) * b[e];
    return r; }
struct EpiUpAct {
    static constexpr bool PERM = false, AFTER_DRAIN = false;
    bf16_t* ACT; float* RAW; const float* cw; const float* cb;
    __device__ __forceinline__ void operator()(const pg8::f32x4 (&acc)[2][2][4][2], const Unit& u, int wr, int wc, int fr, int fq) const {
#pragma unroll
        for (int n = 0; n < 2; ++n) {
            const int ch = u.pn * 128 + wc * 32 + 4 * fq + 16 * n;
            const f32x4 w0a = *(const f32x4*)(cw + ch), w1a = *(const f32x4*)(cw + FF2 + ch), w2a = *(const f32x4*)(cw + 2 * FF2 + ch), ba = *(const f32x4*)(cb + ch);
            const f32x4 w0b = *(const f32x4*)(cw + FF + ch), w1b = *(const f32x4*)(cw + FF2 + FF + ch), w2b = *(const f32x4*)(cw + 2 * FF2 + FF + ch), bb = *(const f32x4*)(cb + FF + ch);
#pragma unroll
            for (int ai = 0; ai < 2; ++ai) {
                const int blk = u.pm * 4 + ai * 2 + wr;
                if (fr < 2) { *(f32x4*)(RAW + (size_t)(blk * 4 + fr) * FF2 + ch) = acc[ai][0][0][n]; *(f32x4*)(RAW + (size_t)(blk * 4 + fr) * FF2 + FF + ch) = acc[ai][1][0][n]; }
                if (fr >= 14) { *(f32x4*)(RAW + (size_t)(blk * 4 + fr - 12) * FF2 + ch) = acc[ai][0][3][n]; *(f32x4*)(RAW + (size_t)(blk * 4 + fr - 12) * FF2 + FF + ch) = acc[ai][1][3][n]; }
                f32x4 pa1 = {0.f, 0.f, 0.f, 0.f}, pa2 = pa1, pb1 = pa1, pb2 = pa1;
#pragma unroll
                for (int m = 0; m < 4; ++m) {
                    const f32x4 va = acc[ai][0][m][n], vb = acc[ai][1][m][n];
                    const f32x4 ra1 = ror1(va), ra2 = ror2(va), rb1 = ror1(vb), rb2 = ror2(vb);
                    const f32x4 xa1 = fr >= 1 ? ra1 : pa1, xa2 = fr >= 2 ? ra2 : pa2, xb1 = fr >= 1 ? rb1 : pb1, xb2 = fr >= 2 ? rb2 : pb2;
                    pa1 = ra1; pa2 = ra2; pb1 = rb1; pb2 = rb2;
                    const f32x4 ya = ba + w0a * xa2 + w1a * xa1 + w2a * va, yb = bb + w0b * xb2 + w1b * xb1 + w2b * vb;
                    const f32x4 o = silu_mul(ya, yb);
                    if (!(m == 0 && fr < 2)) *(u32x2*)(ACT + (size_t)(blk * 64 + 16 * m + fr) * FF + ch) = pk4(o);
                }
            }
        }
    }
};

__device__ __forceinline__ void fixup_phase(const float* RAW, bf16_t* ACT, const float* cw, const float* cb, int gtid, int nthr) {
    for (int it = gtid; it < 256 * 2 * 704; it += nthr) {
        const int c4 = it % 704, rr = (it / 704) & 1, blk = it / 1408, ch = 4 * c4;
        const float* cur = RAW + (size_t)(blk * 4 + rr) * FF2;
        const float* p1 = rr == 1 ? RAW + (size_t)(blk * 4) * FF2 : (blk > 0 ? RAW + (size_t)((blk - 1) * 4 + 3) * FF2 : nullptr);
        const float* p2 = rr == 1 ? (blk > 0 ? RAW + (size_t)((blk - 1) * 4 + 3) * FF2 : nullptr) : (blk > 0 ? RAW + (size_t)((blk - 1) * 4 + 2) * FF2 : nullptr);
        const f32x4 z = {0.f, 0.f, 0.f, 0.f};
        const f32x4 va = *(const f32x4*)(cur + ch), vb = *(const f32x4*)(cur + FF + ch);
        const f32x4 a1 = p1 ? *(const f32x4*)(p1 + ch) : z, b1 = p1 ? *(const f32x4*)(p1 + FF + ch) : z;
        const f32x4 a2 = p2 ? *(const f32x4*)(p2 + ch) : z, b2 = p2 ? *(const f32x4*)(p2 + FF + ch) : z;
        const f32x4 ya = *(const f32x4*)(cb + ch) + *(const f32x4*)(cw + ch) * a2 + *(const f32x4*)(cw + FF2 + ch) * a1 + *(const f32x4*)(cw + 2 * FF2 + ch) * va;
        const f32x4 yb = *(const f32x4*)(cb + FF + ch) + *(const f32x4*)(cw + FF + ch) * b2 + *(const f32x4*)(cw + FF2 + FF + ch) * b1 + *(const f32x4*)(cw + 2 * FF2 + FF + ch) * vb;
        *(u32x2*)(ACT + (size_t)(blk * 64 + rr) * FF + ch) = pk4(silu_mul(ya, yb));
    }
}

template <int W> __device__ __forceinline__ void pooled_item(const bf16_t* UPOOL, bf16_t* POOLED, int t, int c8) {
    v4u v[W];
#pragma unroll
    for (int j = 0; j < W; ++j) { const int tj = (t - j) >= 0 ? (t - j) : 0; v[j] = *(const v4u*)(UPOOL + (size_t)tj * PW + 8 * c8); }
    float s[8];
#pragma unroll
    for (int e = 0; e < 8; ++e) s[e] = 0.f;
#pragma unroll
    for (int j = 0; j < W; ++j) { const float m = (t - j) >= 0 ? 1.f : 0.f;
        s[0] = fmaf(m, bf_lo(v[j].x), s[0]); s[1] = fmaf(m, bf_hi(v[j].x), s[1]); s[2] = fmaf(m, bf_lo(v[j].y), s[2]); s[3] = fmaf(m, bf_hi(v[j].y), s[3]);
        s[4] = fmaf(m, bf_lo(v[j].z), s[4]); s[5] = fmaf(m, bf_hi(v[j].z), s[5]); s[6] = fmaf(m, bf_lo(v[j].w), s[6]); s[7] = fmaf(m, bf_hi(v[j].w), s[7]); }
    const int cntw = (t + 1) < W ? (t + 1) : W; const float inv = 1.0f / (float)cntw; v4u o;
    o.x = pkbf(s[0] * inv - bf_lo(v[0].x), s[1] * inv - bf_hi(v[0].x)); o.y = pkbf(s[2] * inv - bf_lo(v[0].y), s[3] * inv - bf_hi(v[0].y));
    o.z = pkbf(s[4] * inv - bf_lo(v[0].z), s[5] * inv - bf_hi(v[0].z)); o.w = pkbf(s[6] * inv - bf_lo(v[0].w), s[7] * inv - bf_hi(v[0].w));
    *(v4u*)(POOLED + (size_t)t * PW + 8 * c8) = o;
}
__device__ __forceinline__ void pooled_phase(const bf16_t* UPOOL, bf16_t* POOLED, int gtid, int nthr) {
    for (int it = gtid; it < M * 64; it += nthr) {
        const int wv = it >> 6, l = it & 63, g = wv & 3, t = (wv >> 2) * 4 + (l >> 4), c8 = g * 16 + (l & 15);
        if (g == 0) pooled_item<2>(UPOOL, POOLED, t, c8); else if (g == 1) pooled_item<4>(UPOOL, POOLED, t, c8); else if (g == 2) pooled_item<8>(UPOOL, POOLED, t, c8); else pooled_item<16>(UPOOL, POOLED, t, c8);
    }
}

#define MFMA32(a, b, c) __builtin_amdgcn_mfma_f32_32x32x16_bf16((a), (b), (c), 0, 0, 0)
__device__ __forceinline__ unsigned lds_add(LAS unsigned* p, unsigned v) { return __hip_atomic_fetch_add(p, v, __ATOMIC_RELAXED, __HIP_MEMORY_SCOPE_WORKGROUP); }
__device__ __forceinline__ unsigned lds_or(LAS unsigned* p, unsigned v) { return __hip_atomic_fetch_or(p, v, __ATOMIC_RELAXED, __HIP_MEMORY_SCOPE_WORKGROUP); }

__device__ __forceinline__ float u2f(unsigned u) { return __uint_as_float((u & 0x80000000u) ? (u & 0x7fffffffu) : ~u); }
template <bool EMIT>
__device__ __forceinline__ void tk_pass(int qb, int wave, int lane, const bf16_t* KI, const LAS bf16_t* QF, const float (&wv)[4], LAS unsigned* H, LAS unsigned* SELM, LAS unsigned* TIEM,
                                        int sh, unsigned vlo, bool clampTop, unsigned bmax, int stage, unsigned vmin, float fsel, float ftie) {
    const int r = lane & 31, h = lane >> 5;
    const int gstep = stage == 1 ? 8 : 1, g0 = stage == 1 ? wave : 0;
#define TK_NEXT_G(g) ({ int _g = (g) + gstep; if (stage == 2 && (_g & 7) == wave) ++_g; _g; })
    int gcur = g0; if (stage == 2 && (gcur & 7) == wave) ++gcur;
    pg8::bf16x8 kf[4];
    { const int T0 = (wave + 8 * gcur) <= qb ? (wave + 8 * gcur) : qb; const bf16_t* kp = KI + (size_t)T0 * 2048 + 8 * lane;
#pragma unroll
      for (int s = 0; s < 4; ++s) kf[s] = *(const pg8::bf16x8*)(kp + 512 * s); }
    LAS unsigned* Hq = H + r * HSTRIDE;
#pragma unroll 1
    for (; wave + 8 * gcur <= qb; gcur = TK_NEXT_G(gcur)) {
        const int T = wave + 8 * gcur;
        float sc[16];
#pragma unroll
        for (int i = 0; i < 16; ++i) sc[i] = 0.f;
#pragma unroll
        for (int hd = 0; hd < 4; ++hd) { f32x16 a;
#pragma unroll
            for (int i = 0; i < 16; ++i) a[i] = 0.f;
#pragma unroll
            for (int s = 0; s < 4; ++s) a = MFMA32(kf[s], *(const LAS pg8::bf16x8*)(QF + (hd * 4 + s) * 512 + lane * 8), a);
#pragma unroll
            for (int i = 0; i < 16; ++i) { const float av = a[i]; const int ab = __float_as_int(av); sc[i] = fmaf(wv[hd], __int_as_float(ab > 0 ? ab : 0), sc[i]); } }
        { const int Tnn = wave + 8 * TK_NEXT_G(gcur); const int Tn = Tnn <= qb ? Tnn : T; const bf16_t* kp = KI + (size_t)Tn * 2048 + 8 * lane;
#pragma unroll
          for (int s = 0; s < 4; ++s) kf[s] = *(const pg8::bf16x8*)(kp + 512 * s); }
        const int rlim = (T == qb) ? r : 64;
        if (!EMIT) {
#pragma unroll
            for (int i = 0; i < 16; ++i) {
                const int kr = (i & 3) + 8 * (i >> 2) + 4 * h;
                unsigned uu = __float_as_uint(sc[i]); uu ^= ((unsigned)((int)uu >> 31)) | 0x80000000u;
                const unsigned v = uu >> sh; unsigned b = v - vlo;
                const bool ok = (kr <= rlim) && (v >= vmin) && (clampTop || b <= bmax);
                b = b > 2047u ? 2047u : b;
                lds_add(Hq + (ok ? (b >> 1) : 1024u), 1u << ((b & 1u) * 16u));
            }
        } else {
            unsigned ms = 0u, mg = 0u;
#pragma unroll
            for (int i = 15; i >= 0; --i) {
                asm("v_cmp_ge_f32_e32 vcc, %1, %2\n\tv_addc_co_u32_e32 %0, vcc, %0, %0, vcc" : "+v"(ms) : "v"(sc[i]), "v"(fsel) : "vcc");
                asm("v_cmp_ge_f32_e32 vcc, %1, %2\n\tv_addc_co_u32_e32 %0, vcc, %0, %0, vcc" : "+v"(mg) : "v"(sc[i]), "v"(ftie) : "vcc");
            }
            const unsigned vrow = rlim >= 31 ? 0xffffffffu : ((2u << rlim) - 1u);
            auto spread = [&](unsigned m) { return (((m & 0xfu) | ((m & 0xf0u) << 4) | ((m & 0xf00u) << 8) | ((m & 0xf000u) << 12)) << (4 * h)) & vrow; };
            const unsigned msel = spread(ms), mtie = spread(mg) & ~msel;
            const unsigned osel = __shfl_xor(msel, 32), otie = __shfl_xor(mtie, 32);
            if (h == 0) { SELM[r * MSTRIDE + T] = msel | osel; TIEM[r * MSTRIDE + T] = mtie | otie; }
        }
    }
#undef TK_NEXT_G
}

template <int CTRL> __device__ __forceinline__ float dppx(float x) { return __builtin_bit_cast(float, __builtin_amdgcn_mov_dpp(__builtin_bit_cast(int, x), CTRL, 0xf, 0xf, true)); }
__device__ __forceinline__ u32x2 tk_rescore_load(const bf16_t* KI, int key, int lane) {
    const int c = 4 * (lane & 15);
    return *(const u32x2*)(KI + (size_t)(key >> 5) * 2048 + (c >> 4) * 512 + ((((c >> 3) & 1) * 32 + (key & 31)) * 8) + (c & 7));
}
__device__ __forceinline__ float tk_rescore(const u32x2 q4, float wh, const u32x2 k4) {
    float d = bf_lo(q4.x) * bf_lo(k4.x); d = fmaf(bf_hi(q4.x), bf_hi(k4.x), d); d = fmaf(bf_lo(q4.y), bf_lo(k4.y), d); d = fmaf(bf_hi(q4.y), bf_hi(k4.y), d);
    d += dppx<0xB1>(d); d += dppx<0x4E>(d); d += dppx<0x141>(d); d += dppx<0x140>(d);
    float sc = wh * fmaxf(d, 0.f);
    sc += __shfl_xor(sc, 16); sc += __shfl_xor(sc, 32);
    return sc + 0.f;
}

__device__ __forceinline__ int wave_incl_scan(int v) {
    v += __builtin_amdgcn_update_dpp(0, v, 0x111, 0xf, 0xf, true); v += __builtin_amdgcn_update_dpp(0, v, 0x112, 0xf, 0xf, true);
    v += __builtin_amdgcn_update_dpp(0, v, 0x114, 0xf, 0xf, true); v += __builtin_amdgcn_update_dpp(0, v, 0x118, 0xf, 0xf, true);
    v += __builtin_amdgcn_update_dpp(0, v, 0x142, 0xa, 0xf, false); v += __builtin_amdgcn_update_dpp(0, v, 0x143, 0xc, 0xf, false);
    return v;
}
__device__ __forceinline__ void tk_scan(const LAS unsigned* Hq, LAS unsigned* pref_p, LAS unsigned* need_p, LAS unsigned* cnt_p, int bits, int lane) {
    const int need = (int)*need_p;
    int S = 0;
#pragma unroll
    for (int i = 0; i < 16; ++i) { const unsigned w = Hq[16 * lane + ((i + lane) & 15)]; S += (int)((w & 0xffffu) + (w >> 16)); }
    const int incl = wave_incl_scan(S), total = __builtin_amdgcn_readlane(incl, 63), Tabove = total - incl;
    const bool hit = (Tabove < need) && (need <= Tabove + S);
    const unsigned long long mk = __ballot(hit);
    const int L = mk ? (int)__builtin_ctzll(mk) : 0;
    const int remL = need - __builtin_amdgcn_readlane(Tabove, L);
    const unsigned w2 = Hq[16 * L + ((lane & 31) >> 1)];
    const int c = lane < 32 ? (int)((w2 >> (16 * (lane & 1))) & 0xffffu) : 0;
    const int incl2 = wave_incl_scan(c), tot2 = __builtin_amdgcn_readlane(incl2, 63), above2 = tot2 - incl2;
    const bool hit2 = (lane < 32) && (above2 < remL) && (remL <= above2 + c);
    const unsigned long long mk2 = __ballot(hit2);
    const int J = mk2 ? (int)__builtin_ctzll(mk2) : 0;
    const unsigned Dsel = (unsigned)(32 * L + J), nsel = mk2 ? (unsigned)(remL - __builtin_amdgcn_readlane(above2, J)) : 1u, csel = (unsigned)__builtin_amdgcn_readlane(c, J);
    if (lane == 0) { *pref_p = bits ? ((*pref_p << bits) | Dsel) : Dsel; *need_p = nsel; if (cnt_p) *cnt_p = csel; }
}

typedef float f32x2_t __attribute__((ext_vector_type(2)));
__device__ __forceinline__ void unpack16(const v4u w, f32x2_t (&f)[8]) {
#pragma unroll
    for (int i = 0; i < 4; ++i) { f[2 * i] = __builtin_amdgcn_cvt_pk_f32_fp8((int)w[i], false); f[2 * i + 1] = __builtin_amdgcn_cvt_pk_f32_fp8((int)w[i], true); }
}
__device__ __forceinline__ void attn_item(int t, int hd, const unsigned short* SEL, const bf16_t* Q, const unsigned char* K8, const unsigned char* V8, bf16_t* ATTN, int lane) {
    constexpr float LOG2E = 1.4426950408889634f;
    const int kk = lane >> 2, part = lane & 3, cnt = (t + 1) < 256 ? (t + 1) : 256;
    const float slope2 = exp2f(-(float)(hd + 1)) * LOG2E, sc2 = 0.125f * LOG2E;
    f32x2_t q[8];
    { const v4u qa = *(const v4u*)(Q + (size_t)t * AW + hd * 64 + part * 16), qb = *(const v4u*)(Q + (size_t)t * AW + hd * 64 + part * 16 + 8);
#pragma unroll
      for (int i = 0; i < 4; ++i) { q[i] = (f32x2_t){bf_lo(qa[i]) * sc2, bf_hi(qa[i]) * sc2}; q[4 + i] = (f32x2_t){bf_lo(qb[i]) * sc2, bf_hi(qb[i]) * sc2}; } }
    const unsigned short* lp = SEL + (size_t)t * 256;
    const unsigned char* kb = K8 + (size_t)hd * M * 64 + part * 16; const unsigned char* vb = V8 + (size_t)hd * M * 64 + part * 16;
    int key[16]; v4u kf[16], vf[16];
#pragma unroll
    for (int r = 0; r < 16; ++r) { const int j = 16 * r + kk; key[r] = j < cnt ? (int)lp[j] : 0; }
#pragma unroll
    for (int r = 0; r < 16; ++r) { kf[r] = *(const v4u*)(kb + (size_t)key[r] * 64); vf[r] = *(const v4u*)(vb + (size_t)key[r] * 64); }
    float sv[16]; float mx = -INFINITY;
#pragma unroll
    for (int r = 0; r < 16; ++r) { f32x2_t kx[8]; unpack16(kf[r], kx); f32x2_t d2 = q[0] * kx[0];
#pragma unroll
        for (int e = 1; e < 8; ++e) d2 = __builtin_elementwise_fma(q[e], kx[e], d2);
        float d = d2.x + d2.y;
        d += dppx<0xB1>(d); d += dppx<0x4E>(d);
        sv[r] = (16 * r + kk) < cnt ? d - slope2 * (float)(t - key[r]) : -INFINITY; mx = fmaxf(mx, sv[r]); }
    mx = fmaxf(mx, __shfl_xor(mx, 4)); mx = fmaxf(mx, __shfl_xor(mx, 8)); mx = fmaxf(mx, __shfl_xor(mx, 16)); mx = fmaxf(mx, __shfl_xor(mx, 32));
    f32x2_t o[8]; float lsum = 0.f;
#pragma unroll
    for (int e = 0; e < 8; ++e) o[e] = (f32x2_t){0.f, 0.f};
#pragma unroll
    for (int r = 0; r < 16; ++r) { const float p = __builtin_amdgcn_exp2f(sv[r] - mx); lsum += p; f32x2_t vx[8]; unpack16(vf[r], vx); const f32x2_t p2 = (f32x2_t){p, p};
#pragma unroll
        for (int e = 0; e < 8; ++e) o[e] = __builtin_elementwise_fma(p2, vx[e], o[e]); }
    lsum += dppx<0x124>(lsum); lsum += dppx<0x128>(lsum); lsum += __shfl_xor(lsum, 16); lsum += __shfl_xor(lsum, 32);
    float of[16];
#pragma unroll
    for (int e = 0; e < 8; ++e) { of[2 * e] = o[e].x; of[2 * e + 1] = o[e].y; }
#pragma unroll
    for (int e = 0; e < 16; ++e) { float v = of[e]; v += dppx<0x124>(v); v += dppx<0x128>(v); v += __shfl_xor(v, 16); v += __shfl_xor(v, 32); of[e] = v; }
    if (lane < 4) { const float inv = 1.0f / lsum; v4u a, b;
        a.x = pkbf(of[0] * inv, of[1] * inv); a.y = pkbf(of[2] * inv, of[3] * inv); a.z = pkbf(of[4] * inv, of[5] * inv); a.w = pkbf(of[6] * inv, of[7] * inv);
        b.x = pkbf(of[8] * inv, of[9] * inv); b.y = pkbf(of[10] * inv, of[11] * inv); b.z = pkbf(of[12] * inv, of[13] * inv); b.w = pkbf(of[14] * inv, of[15] * inv);
        *(v4u*)(ATTN + (size_t)t * AW + hd * 64 + part * 16) = a; *(v4u*)(ATTN + (size_t)t * AW + hd * 64 + part * 16 + 8) = b; }
}

struct TkPtrs { const bf16_t *QI, *KI; const float* WI; unsigned short* SEL; };
__device__ __forceinline__ void topk_attn_block(int qb, const TkPtrs& P, LAS unsigned char* lds, int tid, int wave, int lane, bool do_attn) {
    LAS unsigned* H = (LAS unsigned*)lds;
    LAS unsigned* SELM = (LAS unsigned*)lds;
    LAS unsigned* TIEM = (LAS unsigned*)(lds + 32 * MSTRIDE * 4);
    LAS unsigned short* LIST = (LAS unsigned short*)(lds + LIST_OFF);
    LAS unsigned* STP = (LAS unsigned*)(lds + ST_OFF);
    LAS unsigned* STN = STP + 32;
    const int t0 = qb * 32, r = lane & 31, h = lane >> 5;
    SYNC();
    float wv[4];
    LAS bf16_t* QF = (LAS bf16_t*)(lds + LIST_OFF);
    { const bf16_t* qp = P.QI + (size_t)(t0 + r) * 256 + 8 * h;
#pragma unroll
      for (int k = 0; k < 2; ++k) { const int f = 2 * wave + k; *(LAS pg8::bf16x8*)(QF + f * 512 + lane * 8) = *(const pg8::bf16x8*)(qp + (f >> 2) * 64 + 16 * (f & 3)); }
      const f32x4 w4 = *(const f32x4*)(P.WI + (size_t)(t0 + r) * 4); wv[0] = w4[0]; wv[1] = w4[1]; wv[2] = w4[2]; wv[3] = w4[3]; }
    LAS unsigned* STC = STP + 64;
    LAS unsigned* STG = STP + 96;
    LAS unsigned* FB = STP + 160;
    LAS unsigned* STS = STP + 192;
    LAS float* FSEL = (LAS float*)(STP + 256);
    LAS float* FTIE = FSEL + 32;
    const bool negw = (wv[0] <= 0.f) && (wv[1] <= 0.f) && (wv[2] <= 0.f) && (wv[3] <= 0.f);
    const unsigned wbase = negw ? 7745u : 22976u;
#pragma unroll 1
    for (int rep_tk = 0; rep_tk < REP_TK; ++rep_tk) {
    if (wave == 0 && lane == 0) *FB = 0u;
#pragma unroll 1
    for (int mode = 0; mode < 2; ++mode) {
        if (mode == 1) { if (*FB == 0u) break; }
        if (wave == 0 && lane < 32) { STP[lane] = 0u; const int nv = t0 + lane + 1; STN[lane] = nv < 256 ? nv : 256; STG[lane] = negw ? 1u : 0u; }
        const int nstep = mode == 0 ? 1 : 3;
#pragma unroll 1
        for (int step = 0; step < nstep; ++step) {
            if (mode == 1 || step == 0) { for (int i = tid; i < 32 * HSTRIDE; i += NTHR) H[i] = 0u; }
            SYNC();
            const int sh = mode == 0 ? 17 : (step == 0 ? 21 : (step == 1 ? 10 : 0));
            const unsigned vlo = mode == 0 ? wbase : (step == 0 ? 0u : (STP[r] << (step == 1 ? 11 : 10)));
            const unsigned vmin = vlo;
            tk_pass<false>(qb, wave, lane, P.KI, QF, wv, H, SELM, TIEM, sh, vlo, mode == 0, (mode == 1 && step == 2) ? 1023u : 2047u, 0, vmin, 0.f, 0.f);
            SYNC();
            const bool samp = false;
#pragma unroll 1
            for (int qq = 0; qq < 4; ++qq) { const int rq = 4 * wave + qq;
                tk_scan(H + rq * HSTRIDE, samp ? STS + rq : STP + rq, samp ? STS + 32 + rq : STN + rq, STC + rq, (mode == 1 && step == 2) ? 10 : 11, lane);
                if (mode == 0 && lane == 0) { const unsigned D = STP[rq], nn = STN[rq], c = STC[rq], ng = STG[rq] & 1u;
                    const bool zerobin = ng && D == 2047u, edge = (D == 0u) || (D == 2047u && !ng);
                    const bool wantc = (c > nn) && !zerobin;
                    if (edge || (wantc && c > 64u)) lds_or(FB, 1u);
                    STG[rq] = ng | (wantc ? 2u : 0u);
                    const unsigned wb = ng ? 7745u : 22976u;
                    FTIE[rq] = u2f((wb + D) << 17); FSEL[rq] = zerobin ? INFINITY : u2f((wb + D + 1u) << 17); }
                if (mode == 1 && step == 2 && lane == 0) { const unsigned tau = STP[rq]; FTIE[rq] = u2f(tau); FSEL[rq] = tau == 0xffffffffu ? INFINITY : u2f(tau + 1u); } }
            SYNC();
        }
        if (mode == 0 && *FB != 0u) continue;
        tk_pass<true>(qb, wave, lane, P.KI, QF, wv, H, SELM, TIEM, 0, 0u, false, 0u, 0, 0u, FSEL[r], FTIE[r]);
        SYNC();
        break;
    }
    }
    if (!do_attn) return;
#pragma unroll 1
    for (int qq = 0; qq < 4; ++qq) {
        const int rq = 4 * wave + qq, t = t0 + rq; int mties = (int)STN[rq];
        unsigned tw[8], fw[8]; int S = 0;
#pragma unroll
        for (int i = 0; i < 8; ++i) { const int T = 8 * lane + i; const bool v = T <= qb; tw[i] = v ? TIEM[rq * MSTRIDE + T] : 0u; fw[i] = v ? SELM[rq * MSTRIDE + T] : 0u; S += __builtin_popcount(tw[i]); }
        const int incl = wave_incl_scan(S);
        if (*FB == 0u && (STG[rq] & 2u)) {
            const int c = __builtin_amdgcn_readlane(incl, 63), nn = mties;
            LAS unsigned short* cl = LIST + rq * 256;
            { int pos = incl - S;
#pragma unroll
              for (int i = 0; i < 8; ++i) { unsigned w = tw[i]; while (w) { const int b = __builtin_ctz(w); if (pos < 64) cl[pos] = (unsigned short)(256 * lane + 32 * i + b); ++pos; w &= w - 1u; } } }
            LDS_WAIT(); asm volatile("" ::: "memory");
            const u32x2 q4 = *(const u32x2*)(P.QI + (size_t)t * 256 + 4 * lane); const float wh = P.WI[(size_t)t * 4 + (lane >> 4)];
            float mys = 0.f; const int cc = c < 64 ? c : 64;
#pragma unroll 1
            for (int j0 = 0; j0 < cc; j0 += 8) { u32x2 k4[8];
#pragma unroll
                for (int u = 0; u < 8; ++u) { const int jj = (j0 + u) < cc ? (j0 + u) : (cc - 1); k4[u] = tk_rescore_load(P.KI, __builtin_amdgcn_readfirstlane((int)cl[jj]), lane); }
#pragma unroll
                for (int u = 0; u < 8; ++u) { const float sj = tk_rescore(q4, wh, k4[u]); if (lane == j0 + u) mys = sj; } }
            int rank = 0;
            for (int j = 0; j < cc; ++j) { const float sj = __int_as_float(__builtin_amdgcn_readlane(__float_as_int(mys), j)); rank += (sj > mys || (sj == mys && j < lane)) ? 1 : 0; }
            const bool keepme = lane < cc && rank < nn; const int mykey = lane < cc ? (int)cl[lane] : 0;
#pragma unroll 1
            for (int j = 0; j < cc; ++j) { const int kj = __builtin_amdgcn_readlane(mykey, j); const int kp = __builtin_amdgcn_readlane((int)keepme, j);
                if (kp && (kj >> 8) == lane) {
#pragma unroll
                    for (int i = 0; i < 8; ++i) if (((kj >> 5) & 7) == i) fw[i] |= 1u << (kj & 31); } }
            mties = 0;
        }
        int take = mties - (incl - S); take = take < 0 ? 0 : (take > S ? S : take);
        int cl2 = 0;
#pragma unroll
        for (int i = 0; i < 8; ++i) { unsigned w = tw[i]; const int c = __builtin_popcount(w); unsigned keep;
            if (take >= c) { keep = w; take -= c; } else { keep = 0u; for (int k = 0; k < take; ++k) { const unsigned low = w & (0u - w); keep |= low; w ^= low; } take = 0; }
            fw[i] |= keep; cl2 += __builtin_popcount(fw[i]); }
        const int inc2 = wave_incl_scan(cl2);
        int pos = inc2 - cl2; const int cnt = __builtin_amdgcn_readlane(inc2, 63);
        LAS unsigned short* lp = LIST + rq * 256;
#pragma unroll
        for (int i = 0; i < 8; ++i) { unsigned w = fw[i]; while (w) { const int b = __builtin_ctz(w); if (pos < 256) lp[pos] = (unsigned short)(256 * lane + 32 * i + b); ++pos; w &= w - 1u; } }
        LDS_WAIT(); asm volatile("" ::: "memory");
        (void)cnt;
        *(u32x2*)(P.SEL + (size_t)t * 256 + 4 * lane) = *(const LAS u32x2*)(lp + 4 * lane);
    }
}

struct Args { const float* in[18]; float* out; unsigned char* ws; int ph_lo, ph_hi; };
constexpr int NPH = 13;

typedef const __attribute__((address_space(4))) unsigned long long* kargp_t;
#define KARGS() kargp_t kargs = (kargp_t)__builtin_amdgcn_kernarg_segment_ptr(); asm volatile("" : "+s"(kargs)); GAS unsigned char* const ws = (GAS unsigned char*)kargs[19]; (void)ws
#define KIN(i) ((const float*)(const GAS float*)kargs[(i)])
#define KOUT() ((float*)(GAS float*)kargs[18])
#define WSP(T, off) ((T*)(GAS T*)(ws + (off)))
__global__ void __launch_bounds__(NTHR, 2) fwd_kernel(Args a) {
    extern __shared__ __attribute__((aligned(16))) unsigned char lds_raw[];
    LAS unsigned char* lds = (LAS unsigned char*)lds_raw;
    const int lo = a.ph_lo, hi = a.ph_hi;
    { int tid0 = threadIdx.x; asm volatile("" : "+v"(tid0)); for (int u = tid0; u < (LDS_BYTES - MISC_OFF) / 4; u += NTHR) ((LAS unsigned*)(lds + MISC_OFF))[u] = 0u; }
    SYNC();
    XcdBarrier bar; bar.bar = nullptr; bar.x = 0; bar.st = nullptr;
    if (hi - lo > 1) { KARGS(); bar = xcd_barrier_post((unsigned*)(GAS unsigned*)(ws + WS_CTL) + CW_BAR, (volatile LAS unsigned*)(lds + MISC_OFF) + 8); }
#define IN(k) (lo <= (k) && (k) < hi)
#define SEAM(k) do { if (IN(k) && IN((k) + 1)) xcd_barrier(bar); } while (0)
#define IDS() const int tid = threadIdx.x, lane = tid & 63, wave = __builtin_amdgcn_readfirstlane(tid >> 6), G = gridDim.x, bid = blockIdx.x; (void)lane; (void)wave; (void)G; (void)bid

    for (int rep_ph = 0; rep_ph < ((REP_PH == 0) ? 2 : 1); ++rep_ph) if (IN(0)) { KARGS(); IDS();
        P0Ptrs P{KIN(1), KIN(2), KIN(5), KIN(8), KIN(9), KIN(11), KIN(12), KIN(14), KIN(17), WSP(bf16_t, WS_WIN), WSP(bf16_t, WS_WATTN), WSP(bf16_t, WS_WGRP), WSP(bf16_t, WS_WPOOL), WSP(bf16_t, WS_WOUT),
                 WSP(bf16_t, WS_WUP), WSP(bf16_t, WS_WDOWN), WSP(float, WS_MODP)};
        p0_prologue(P, lds, bid * NWAVES + wave, G * NWAVES, wave, lane);
    }
    SEAM(0);
    if (IN(1)) { KARGS(); IDS();
        const float *b_ada = KIN(3), *norm1_g = KIN(4); const float* MODP = WSP(float, WS_MODP); float* MODF = WSP(float, WS_MODF);
        LAS float* mulv = (LAS float*)lds; LAS float* addv = mulv + 1024;
        for (int i = tid; i < 1024; i += NTHR) { float sh = b_ada[i], scv = b_ada[1024 + i];
#pragma unroll
            for (int kc = 0; kc < 16; ++kc) { sh += MODP[kc * NMOD + i]; scv += MODP[kc * NMOD + 1024 + i]; }
            mulv[i] = norm1_g[i] * (1.0f + scv); addv[i] = sh; }
        if (bid < 24 && tid < 256) { const int i = bid * 256 + tid; float v = b_ada[i];
#pragma unroll
            for (int kc = 0; kc < 16; ++kc) v += MODP[kc * NMOD + i];
            MODF[i] = v; }
        SYNC();
        modulate_rows(KIN(0), WSP(bf16_t, WS_H), mulv, addv, bid * NWAVES + wave, G * NWAVES, lane);
        SYNC();
    }
    SEAM(1);
    for (int rep_ph = 0; rep_ph < ((REP_PH == 2) ? 2 : 1); ++rep_ph) if (IN(2)) { KARGS(); IDS();
        pg8::Gemm g{WSP(bf16_t, WS_H), WSP(bf16_t, WS_WIN), M, NINP, DM}; pg8::StaticOrder S; S.init(M, NINP, G, bid);
        EpiProj E{WSP(bf16_t, WS_Q), WSP(unsigned char, WS_K), WSP(unsigned char, WS_V), WSP(bf16_t, WS_QI), WSP(bf16_t, WS_KI), WSP(bf16_t, WS_UPOOL), WSP(bf16_t, WS_GA), WSP(bf16_t, WS_GP), WSP(float, WS_WI), KIN(6), KIN(7)};
        pg8::gemm_phase<EpiProj, pg8::StaticOrder, true, true>(lds, g, S, E);
    }
    SEAM(2);
    if (IN(3)) { KARGS(); IDS();
        pooled_phase(WSP(bf16_t, WS_UPOOL), WSP(bf16_t, WS_POOLED), bid * NTHR + tid, G * NTHR);
        TkPtrs T{WSP(bf16_t, WS_QI), WSP(bf16_t, WS_KI), WSP(float, WS_WI), WSP(unsigned short, WS_SEL)};
        unsigned* qctr = (unsigned*)(GAS unsigned*)(ws + WS_CTL) + CW_QUEUE;
        LAS int* qslot = (LAS int*)(lds + ST_OFF + 2040);
#pragma unroll 1
        for (;;) {
            SYNC();
            if (tid == 0) *qslot = (int)__hip_atomic_fetch_add(qctr, 1u, __ATOMIC_RELAXED, __HIP_MEMORY_SCOPE_AGENT);
            SYNC();
            const int qi = *qslot;
            if (qi >= 512 * (1 + REP_TKONLY)) break;
            topk_attn_block(511 - (qi & 511), T, lds, tid, wave, lane, qi >= 512 * REP_TKONLY);
        }
        SYNC();
    }
    SEAM(3);
    if (IN(4)) { KARGS(); IDS();
        const unsigned short* SEL = WSP(unsigned short, WS_SEL); const bf16_t* Qp = WSP(bf16_t, WS_Q); const unsigned char *K8 = WSP(unsigned char, WS_K), *V8 = WSP(unsigned char, WS_V); bf16_t* ATTN = WSP(bf16_t, WS_ATTN);
        const bool aff = (G & 7) == 0; const int nitem = 8 * M, step = aff ? (G >> 3) * NWAVES : G * NWAVES;
#pragma unroll 1
        for (int it = aff ? (bid >> 3) * NWAVES + wave : bid * NWAVES + wave; it < (aff ? M : nitem); it += step) attn_item(aff ? it : (it >> 3), aff ? (bid & 7) : (it & 7), SEL, Qp, K8, V8, ATTN, lane);
    }
    SEAM(4);
    for (int rep_ph = 0; rep_ph < ((REP_PH == 5) ? 2 : 1); ++rep_ph) if (IN(5)) { KARGS(); IDS();
        pg8::Gemm g{WSP(bf16_t, WS_POOLED), WSP(bf16_t, WS_WGRP), M, PW, PW}; pg8::StaticOrder S; S.init(M, PW, G, bid);
        EpiBf<0> E{WSP(bf16_t, WS_POOLMIX), PW, KIN(10), nullptr};
        pg8::gemm_phase<EpiBf<0>, pg8::StaticOrder, true, true>(lds, g, S, E);
    }
    SEAM(5);
    if (IN(6)) { KARGS(); IDS();
        pg8::Gemm g{WSP(bf16_t, WS_POOLMIX), WSP(bf16_t, WS_WPOOL), M, DM, PW}; pg8::StaticOrder S; S.init(M, DM, G, bid);
        EpiBf<1> E{WSP(bf16_t, WS_GP), DM, nullptr, nullptr};
        pg8::gemm_phase<EpiBf<1>, pg8::StaticOrder, true, true>(lds, g, S, E);
    }
    SEAM(6);
    if (IN(7)) { KARGS(); IDS();
        pg8::Gemm g{WSP(bf16_t, WS_ATTN), WSP(bf16_t, WS_WATTN), M, DM, AW}; pg8::StaticOrder S; S.init(M, DM, G, bid);
        EpiBf<2> E{WSP(bf16_t, WS_GA), DM, nullptr, WSP(bf16_t, WS_GP)};
        pg8::gemm_phase<EpiBf<2>, pg8::StaticOrder, true, true>(lds, g, S, E);
    }
    SEAM(7);
    for (int rep_ph = 0; rep_ph < ((REP_PH == 8) ? 2 : 1); ++rep_ph) if (IN(8)) { KARGS(); IDS();
        pg8::Gemm g{WSP(bf16_t, WS_GA), WSP(bf16_t, WS_WOUT), M, DM, DM}; pg8::StaticOrder S; S.init(M, DM, G, bid);
        EpiRes E{KIN(0), KOUT(), WSP(float, WS_MODF) + 2048, 0.f};
        pg8::gemm_phase<EpiRes, pg8::StaticOrder, true, true>(lds, g, S, E);
    }
    SEAM(8);
    if (IN(9)) { KARGS(); IDS();
        const float* norm2_g = KIN(13); const float* MODF = WSP(float, WS_MODF);
        LAS float* mulv = (LAS float*)lds; LAS float* addv = mulv + 1024;
        for (int i = tid; i < 1024; i += NTHR) { mulv[i] = norm2_g[i] * (1.0f + MODF[4096 + i]); addv[i] = MODF[3072 + i]; }
        SYNC();
        modulate_rows(KOUT(), WSP(bf16_t, WS_H), mulv, addv, bid * NWAVES + wave, G * NWAVES, lane);
        SYNC();
    }
    SEAM(9);
    for (int rep_ph = 0; rep_ph < ((REP_PH == 10) ? 2 : 1); ++rep_ph) if (IN(10)) { KARGS(); IDS();
        pg8::Gemm g{WSP(bf16_t, WS_H), WSP(bf16_t, WS_WUP), M, FF2, DM}; pg8::StaticOrder S; S.init(M, FF2, G, bid);
        EpiUpAct E{WSP(bf16_t, WS_ACT), WSP(float, WS_RAW), KIN(15), KIN(16)};
        pg8::gemm_phase<EpiUpAct, pg8::StaticOrder, true, true>(lds, g, S, E);
    }
    SEAM(10);
    if (IN(11)) { KARGS(); IDS(); fixup_phase(WSP(float, WS_RAW), WSP(bf16_t, WS_ACT), KIN(15), KIN(16), bid * NTHR + tid, G * NTHR); }
    SEAM(11);
    if (IN(12)) { KARGS(); IDS();
        pg8::Gemm g{WSP(bf16_t, WS_ACT), WSP(bf16_t, WS_WDOWN), M, DM, FF}; pg8::StaticOrder S; S.init(M, DM, G, bid);
        EpiRes E{KOUT(), KOUT(), WSP(float, WS_MODF) + 5120, DBG_C};
        pg8::gemm_phase<EpiRes, pg8::StaticOrder, true, true>(lds, g, S, E);
    }
#undef IN
#undef SEAM
}

extern "C" void kernel_launch(void* const* d_in, const int* in_sizes, int n_in, void* d_out, int out_size, void* d_ws, size_t ws_size, hipStream_t stream) {
    static int grid = 0;
    if (grid == 0) {
        if (n_in != 18 || in_sizes[0] != M * DM || out_size != M * DM || ws_size < WS_END) { fprintf(stderr, "kernel_launch: unexpected shapes (n_in %d, in0 %d, out %d, ws %zu)\n", n_in, n_in > 0 ? in_sizes[0] : -1, out_size, ws_size); grid = -1; return; }
        int dev = 0, cus = 0, per_cu = 0;
        if (hipGetDevice(&dev) != hipSuccess || hipDeviceGetAttribute(&cus, hipDeviceAttributeMultiprocessorCount, dev) != hipSuccess) { grid = -1; return; }
        if (hipFuncSetAttribute((const void*)fwd_kernel, hipFuncAttributeMaxDynamicSharedMemorySize, LDS_BYTES) != hipSuccess) { fprintf(stderr, "kernel_launch: hipFuncSetAttribute failed\n"); grid = -1; return; }
        if (hipOccupancyMaxActiveBlocksPerMultiprocessor(&per_cu, (const void*)fwd_kernel, NTHR, LDS_BYTES) != hipSuccess || per_cu < 1) fprintf(stderr, "kernel_launch: occupancy query says %d\n", per_cu);
        (void)hipGetLastError();
        grid = cus;
    }
    if (grid < 0) return;
    (void)hipMemsetAsync((char*)d_ws + WS_CTL, 0, CTL_ZERO_BYTES, stream);
    Args a{};
    for (int i = 0; i < 18; ++i) a.in[i] = (const float*)d_in[i];
    a.out = (float*)d_out; a.ws = (unsigned char*)d_ws;
#if N_LAUNCH_MODE == 1
    a.ph_lo = 0; a.ph_hi = NPH;
    hipLaunchKernelGGL(fwd_kernel, dim3(grid), dim3(NTHR), LDS_BYTES, stream, a);
#else
    for (int p = 0; p < NPH; ++p) { a.ph_lo = p; a.ph_hi = p + 1; hipLaunchKernelGGL(fwd_kernel, dim3(grid), dim3(NTHR), LDS_BYTES, stream, a); }
#endif
}
```

```cpp
#ifndef REP_TKONLY
#define REP_TKONLY 0
#endif
#ifndef REP_BLK
#define REP_BLK 1
#endif
#include <hip/hip_runtime.h>
#include <cstdio>
#include <cstdint>
namespace pg8 {
#define PG8_LAS __attribute__((address_space(3)))
typedef unsigned short bf16_t;
typedef short bf16x8 __attribute__((ext_vector_type(8)));
typedef float f32x4 __attribute__((ext_vector_type(4)));
typedef unsigned u32x4 __attribute__((ext_vector_type(4)));
constexpr int BM = 256, BK = 64, HALF = 128, HTB = HALF * BK * 2  , STAGE_BYTES = 8 * HTB, NXCD = 8, WGM = 8;

__host__ __device__ __forceinline__ int lds_byte(int r, int c) { const int st = (r >> 4) * 2 + (c >> 5), rr = r & 15, cc = c & 31, ob = rr * 64 + cc * 2; return st * 1024 + (ob ^ (((ob >> 9) & 1) << 5)); }
__host__ __device__ __forceinline__ void stage_rc(int b, int& R, int& C) { const int st = b / 1024, sb = b % 1024, swz = sb ^ (((sb >> 9) & 1) << 5); R = (st >> 1) * 16 + swz / 64; C = (st & 1) * 32 + (swz % 64) / 2; }
__host__ __device__ __forceinline__ int perm32(int rho) { const int n = rho >> 4, i = rho & 15; return 8 * (i >> 2) + 4 * n + (i & 3); }

struct Unit { int pm, pn; };
struct Gemm { const bf16_t* A; const bf16_t* Bt; int M, N, K; };

struct StaticOrder {
    int nM, nN, nwg, G, c;
    __host__ __device__ void init(int M, int N, int G_, int c_) { nM = M / BM; nN = N / BM; nwg = nM * nN; G = G_; c = c_; }
    __host__ __device__ bool next(int i, Unit& u) const {
        const long L = (long)i * G + c; if (L >= nwg) return false;
        int wgid = (int)L; { const int q = nwg / NXCD, r = nwg % NXCD, xcd = wgid % NXCD, off = wgid / NXCD; wgid = (xcd < r ? xcd * (q + 1) : r * (q + 1) + (xcd - r) * q) + off; }
        const int nig = WGM * nN, gid = wgid / nig, fm = gid * WGM, gsz = (nM - fm) < WGM ? (nM - fm) : WGM;
        u.pm = fm + ((wgid % nig) % gsz); u.pn = (wgid % nig) / gsz; return true;
    }
    __device__ __forceinline__ void a_ready(const Unit&) const {}
    __device__ __forceinline__ void done(const Unit&) const {}
};

__device__ __forceinline__ unsigned cvt_pk_bf16(float lo, float hi) { unsigned r; asm volatile("v_cvt_pk_bf16_f32 %0, %1, %2" : "=v"(r) : "v"(lo), "v"(hi)); return r; }
template <class Epi, class Sched, bool ALIGN_EPI = false, bool SP2 = false>
__device__ __forceinline__ void gemm_phase(PG8_LAS unsigned char* lds, const Gemm g, const Sched& S, const Epi& E) {
    int tid_ = threadIdx.x; asm volatile("" : "+v"(tid_));
    const int tid = tid_, wid = __builtin_amdgcn_readfirstlane(tid >> 6), lane = tid & 63, wr = wid >> 2, wc = wid & 3, fr = lane & 15, fq = lane >> 4;
    const int K = g.K, nt = K / BK;
    unsigned voffA[2], voffB[2];
#pragma unroll
    for (int i = 0; i < 2; ++i) { int R, C; stage_rc(tid * 16 + i * 8192, R, C); const int Rb = Epi::PERM ? ((R & ~31) + perm32(R & 31)) : R;
        voffA[i] = (unsigned)(R * K + C) * 2u; voffB[i] = (unsigned)(Rb * K + C) * 2u; }
    const size_t kstep = (size_t)(BK * 2);
    const size_t hstep = (size_t)HALF * K * 2;
    const size_t tstep = 2 * hstep;
    const unsigned ldsw = (unsigned)wid * 1024u;
    const int aoff = lds_byte(wr * 64 + fr, fq * 8), boff = lds_byte(wc * 32 + fr, fq * 8);
#define PG8_SA(b, h) (((b) * 2 + (h)) * HTB)
#define PG8_SB(b, h) ((4 + (b) * 2 + (h)) * HTB)
#define PG8_STAGE(bufoff, gbase, voff) do { _Pragma("unroll") for (int _i = 0; _i < 2; ++_i) \
        __builtin_amdgcn_global_load_lds((const unsigned*)((const char*)(gbase) + (voff)[_i]), (PG8_LAS unsigned*)(lds + (bufoff) + ldsw + _i * 8192), 16, 0, 0); } while (0)
#define PG8_LDA(dst, b, h) do { _Pragma("unroll") for (int m = 0; m < 4; ++m) _Pragma("unroll") for (int k = 0; k < 2; ++k) dst[m][k] = *(const PG8_LAS bf16x8*)(lds + PG8_SA(b, h) + aoff + m * 2048 + k * 1024); } while (0)
#define PG8_LDB(dst, b, h) do { _Pragma("unroll") for (int n = 0; n < 2; ++n) _Pragma("unroll") for (int k = 0; k < 2; ++k) dst[n][k] = *(const PG8_LAS bf16x8*)(lds + PG8_SB(b, h) + boff + n * 2048 + k * 1024); } while (0)
#define PG8_MMA(ai, bj, At, Bt) do { __builtin_amdgcn_s_setprio(1); _Pragma("unroll") for (int m = 0; m < 4; ++m) _Pragma("unroll") for (int n = 0; n < 2; ++n) _Pragma("unroll") for (int k = 0; k < 2; ++k) \
        acc[ai][bj][m][n] = __builtin_amdgcn_mfma_f32_16x16x32_bf16(Bt[n][k], At[m][k], acc[ai][bj][m][n], 0, 0, 0); __builtin_amdgcn_s_setprio(0); } while (0)
#define PG8_WAIT_V(n) asm volatile("s_waitcnt vmcnt(" #n ")" ::: "memory")
#define PG8_WAIT_L(n) asm volatile("s_waitcnt lgkmcnt(" #n ")" ::: "memory")
#define PG8_BAR __builtin_amdgcn_s_barrier()
#define PG8_SCHED __builtin_amdgcn_sched_barrier(0)
    Unit cur, nxt; int ui = 0;
    if (!S.next(0, cur)) return;
    f32x4 acc[2][2][4][2];
#pragma unroll
    for (int a = 0; a < 2; ++a)
#pragma unroll
        for (int b = 0; b < 2; ++b)
#pragma unroll
            for (int m = 0; m < 4; ++m)
#pragma unroll
                for (int n = 0; n < 2; ++n) acc[a][b][m][n] = (f32x4){0.f, 0.f, 0.f, 0.f};
    bf16x8 At[4][2], B0[2][2], B1[2][2];
    const char* cA = (const char*)g.A + (size_t)cur.pm * tstep; const char* cB = (const char*)g.Bt + (size_t)cur.pn * tstep;
    S.a_ready(cur);
    if constexpr (SP2) {
        PG8_STAGE(PG8_SB(0, 0), cB, voffB); PG8_STAGE(PG8_SB(0, 1), cB + hstep, voffB); PG8_STAGE(PG8_SA(0, 0), cA, voffA); PG8_STAGE(PG8_SA(0, 1), cA + hstep, voffA);
        if (wr == 1) PG8_BAR;
        PG8_WAIT_V(2); PG8_BAR;
        PG8_STAGE(PG8_SB(1, 0), cB + kstep, voffB); PG8_STAGE(PG8_SA(1, 0), cA + kstep, voffA); PG8_STAGE(PG8_SB(1, 1), cB + hstep + kstep, voffB);
        PG8_WAIT_V(6); PG8_BAR;
    } else {
        PG8_STAGE(PG8_SB(0, 0), cB, voffB); PG8_STAGE(PG8_SA(0, 0), cA, voffA); PG8_STAGE(PG8_SB(0, 1), cB + hstep, voffB); PG8_STAGE(PG8_SA(0, 1), cA + hstep, voffA);
        if (wr == 1) PG8_BAR;
        PG8_WAIT_V(4); PG8_BAR;
        PG8_STAGE(PG8_SB(1, 0), cB + kstep, voffB); PG8_STAGE(PG8_SA(1, 0), cA + kstep, voffA); PG8_STAGE(PG8_SB(1, 1), cB + hstep + kstep, voffB);
        PG8_WAIT_V(6); PG8_BAR;
    }
    for (;;) {
        const bool has_next = S.next(ui + 1, nxt);
        const char* nA = has_next ? (const char*)g.A + (size_t)nxt.pm * tstep : cA; const char* nB = has_next ? (const char*)g.Bt + (size_t)nxt.pn * tstep : cB;
        for (int t = 0; t < nt; t += 2) {
            const bool last = (t == nt - 2);
            const char* a1 = cA + (size_t)(t + 1) * kstep;
            const char* a2 = last ? nA : cA + (size_t)(t + 2) * kstep; const char* b2 = last ? nB : cB + (size_t)(t + 2) * kstep;
            const char* a3 = a2 + kstep; const char* b3 = b2 + kstep;
            if (last && has_next) S.a_ready(nxt);
            if constexpr (SP2) {
            PG8_LDB(B0, 0, 0); PG8_LDB(B1, 0, 1); PG8_SCHED; PG8_LDA(At, 0, 0); PG8_STAGE(PG8_SA(1, 1), a1 + hstep, voffA);
            PG8_WAIT_V(8); PG8_WAIT_L(0); PG8_BAR; PG8_MMA(0, 0, At, B0); PG8_MMA(0, 1, At, B1); PG8_BAR; PG8_SCHED;
            PG8_LDA(At, 0, 1); PG8_STAGE(PG8_SB(0, 0), b2, voffB); PG8_STAGE(PG8_SB(0, 1), b2 + hstep, voffB); PG8_STAGE(PG8_SA(0, 0), a2, voffA);
            PG8_WAIT_V(8); PG8_WAIT_L(0); PG8_BAR; PG8_MMA(1, 0, At, B0); PG8_MMA(1, 1, At, B1); PG8_BAR; PG8_SCHED;
            PG8_LDB(B0, 1, 0); PG8_LDB(B1, 1, 1); PG8_SCHED; PG8_LDA(At, 1, 0); PG8_STAGE(PG8_SA(0, 1), a2 + hstep, voffA);
            PG8_WAIT_V(8); PG8_WAIT_L(0); PG8_BAR; PG8_MMA(0, 0, At, B0); PG8_MMA(0, 1, At, B1); PG8_BAR; PG8_SCHED;
            PG8_LDA(At, 1, 1); PG8_STAGE(PG8_SB(1, 0), b3, voffB); PG8_STAGE(PG8_SB(1, 1), b3 + hstep, voffB); PG8_STAGE(PG8_SA(1, 0), a3, voffA);
            PG8_WAIT_V(8); PG8_WAIT_L(0); PG8_BAR; PG8_MMA(1, 0, At, B0); PG8_MMA(1, 1, At, B1); PG8_BAR; PG8_SCHED;
            } else {
            PG8_LDB(B0, 0, 0); PG8_SCHED; PG8_LDA(At, 0, 0); PG8_STAGE(PG8_SA(1, 1), a1 + hstep, voffA);
            PG8_WAIT_L(8); PG8_BAR; PG8_WAIT_L(0); PG8_MMA(0, 0, At, B0); PG8_BAR; PG8_SCHED;
            PG8_LDB(B1, 0, 1); PG8_STAGE(PG8_SB(0, 0), b2, voffB);
            PG8_BAR; PG8_WAIT_L(0); PG8_MMA(0, 1, At, B1); PG8_BAR;
            PG8_LDA(At, 0, 1); PG8_STAGE(PG8_SA(0, 0), a2, voffA);
            PG8_BAR; PG8_WAIT_L(0); PG8_MMA(1, 0, At, B0); PG8_BAR; PG8_SCHED;
            PG8_STAGE(PG8_SB(0, 1), b2 + hstep, voffB);
            PG8_WAIT_V(6); PG8_BAR; PG8_MMA(1, 1, At, B1); PG8_BAR;
            PG8_LDB(B0, 1, 0); PG8_SCHED; PG8_LDA(At, 1, 0); PG8_STAGE(PG8_SA(0, 1), a2 + hstep, voffA);
            PG8_WAIT_L(8); PG8_BAR; PG8_WAIT_L(0); PG8_MMA(0, 0, At, B0); PG8_BAR; PG8_SCHED;
            PG8_LDB(B1, 1, 1); PG8_STAGE(PG8_SB(1, 0), b3, voffB);
            PG8_BAR; PG8_WAIT_L(0); PG8_MMA(0, 1, At, B1); PG8_BAR;
            PG8_LDA(At, 1, 1); PG8_STAGE(PG8_SA(1, 0), a3, voffA);
            PG8_BAR; PG8_WAIT_L(0); PG8_MMA(1, 0, At, B0); PG8_BAR; PG8_SCHED;
            PG8_STAGE(PG8_SB(1, 1), b3 + hstep, voffB);
            PG8_WAIT_V(6); PG8_BAR; PG8_MMA(1, 1, At, B1); PG8_BAR;
            }
        }
        if constexpr (ALIGN_EPI) { if (wr == 0) PG8_BAR; }
        if constexpr (!Epi::AFTER_DRAIN) { E(acc, cur, wr, wc, fr, fq); S.done(cur); }
        if (!has_next) break;
#pragma unroll
        for (int a = 0; a < 2; ++a)
#pragma unroll
            for (int b = 0; b < 2; ++b)
#pragma unroll
                for (int m = 0; m < 4; ++m)
#pragma unroll
                    for (int n = 0; n < 2; ++n) acc[a][b][m][n] = (f32x4){0.f, 0.f, 0.f, 0.f};
        cur = nxt; cA = nA; cB = nB; ++ui;
        if constexpr (ALIGN_EPI) { if (wr == 1) PG8_BAR; }
    }
    PG8_WAIT_V(0);
    if constexpr (!ALIGN_EPI) { if (wr == 0) PG8_BAR; }
    PG8_BAR;
    if constexpr (Epi::AFTER_DRAIN) { E.fused(acc, cur, wr, wc, fr, fq, lds, wid, lane); S.done(cur); }
#undef PG8_SA
#undef PG8_SB
#undef PG8_STAGE
#undef PG8_LDA
#undef PG8_LDB
#undef PG8_MMA
#undef PG8_WAIT_V
#undef PG8_WAIT_L
#undef PG8_BAR
#undef PG8_SCHED
}
}
#define GAS __attribute__((address_space(1)))
#define LAS __attribute__((address_space(3)))
typedef unsigned short bf16;
typedef unsigned v4u __attribute__((ext_vector_type(4)));
typedef float f32x4 __attribute__((ext_vector_type(4)));
typedef short bf16x8 __attribute__((ext_vector_type(8)));
typedef GAS unsigned gu32;
typedef GAS unsigned long long gu64;
#define RLX_AGENT __ATOMIC_RELAXED, __HIP_MEMORY_SCOPE_AGENT
#define LDS_WAIT() asm volatile("s_waitcnt lgkmcnt(0)" ::: "memory")
#define VM_WAIT() asm volatile("s_waitcnt vmcnt(0)" ::: "memory")
__device__ __forceinline__ unsigned long long rt() { return __builtin_amdgcn_s_memrealtime(); }
__device__ __forceinline__ unsigned f2bf(float f) { unsigned u = __builtin_bit_cast(unsigned, f); return (u + 0x7fffu + ((u >> 16) & 1u)) >> 16; }
__device__ __forceinline__ unsigned pk2(float lo, float hi) { return f2bf(lo) | (f2bf(hi) << 16); }

#define XB_TMO      128
#define XB_XCNT(j)  (256  + 64 * (j))
#define XB_XSUB(j)  (1280 + 64 * (j))
#define XB_XGEN(j)  (2304 + 64 * (j))
#define XB_TOP      3328
#define XB_TOPGEN   3392
#define XCD_BAR_WORDS 3456
#define XB_SPIN_CAP (1u << 18)

__device__ __forceinline__ unsigned xb_ld(unsigned* p)              { return __hip_atomic_load(p, __ATOMIC_RELAXED, __HIP_MEMORY_SCOPE_AGENT); }
__device__ __forceinline__ unsigned xb_add(unsigned* p, unsigned v) { return __hip_atomic_fetch_add(p, v, __ATOMIC_RELAXED, __HIP_MEMORY_SCOPE_AGENT); }
__device__ __forceinline__ unsigned xb_xcc_id() { return (unsigned)__builtin_amdgcn_s_getreg((3 << 11) | 20) & 0xFu; }
#define XB_SPIN(cond, bar) do { unsigned _sp = 0; while (cond) { __builtin_amdgcn_s_sleep(1); \
    if ((++_sp & 255u) == 0u) { if (xb_ld(&(bar)[XB_TMO])) break; if (_sp > XB_SPIN_CAP) { atomicAdd(&(bar)[XB_TMO], 1u); break; } } } } while (0)

struct XcdBarrier {
    unsigned* bar; unsigned x;
    volatile LAS unsigned* st;
};

__device__ __forceinline__ XcdBarrier xcd_barrier_post(unsigned* bar, volatile LAS unsigned* st) {
    XcdBarrier b; b.bar = bar; b.x = xb_xcc_id(); b.st = st;
    if (threadIdx.x == 0) (void)xb_add(&bar[XB_XCNT(b.x)], 1u);
    return b;
}
__device__ __forceinline__ void xcd_barrier_complete(unsigned* bar, unsigned x, unsigned& nloc, unsigned& nx) {
    const unsigned G = gridDim.x * gridDim.y * gridDim.z;
    unsigned sum, cnt, mine, sp = 0u;
    for (;;) {
        sum = 0u; cnt = 0u; mine = 0u;
#pragma unroll
        for (unsigned j = 0; j < 16; ++j) { const unsigned c = xb_ld(&bar[XB_XCNT(j)]); sum += c; cnt += (c > 0u) ? 1u : 0u; mine = (j == x) ? c : mine; }
        if (sum == G) break;
        __builtin_amdgcn_s_sleep(1);
        if ((++sp & 255u) == 0u) { if (xb_ld(&bar[XB_TMO])) break; if (sp > XB_SPIN_CAP) { atomicAdd(&bar[XB_TMO], 1u); break; } }
    }
    nloc = mine > 0u ? mine : 1u; nx = cnt > 0u ? cnt : 1u;
}

__device__ __forceinline__ void xcd_barrier(const XcdBarrier& b) {
    asm volatile("s_waitcnt vmcnt(0)" ::: "memory");
    __syncthreads();
    if (threadIdx.x == 0) {
        unsigned* bar = b.bar;
        __builtin_amdgcn_s_waitcnt(0);
        unsigned nloc = b.st[0], nx = b.st[1];
        if (nloc == 0u) { xcd_barrier_complete(bar, b.x, nloc, nx); b.st[0] = nloc; b.st[1] = nx; }
        const unsigned old = xb_add(&bar[XB_XSUB(b.x)], 1u);
        const unsigned gen = old / nloc;
        if (old + 1u == (gen + 1u) * nloc) {
            __builtin_amdgcn_fence(__ATOMIC_RELEASE, "agent");
            asm volatile("s_waitcnt vmcnt(0)" ::: "memory");
            const unsigned og = xb_add(&bar[XB_TOP], 1u);
            const unsigned tg = og / nx;
            if (og + 1u == (tg + 1u) * nx) xb_add(&bar[XB_TOPGEN], 1u);
            else XB_SPIN(xb_ld(&bar[XB_TOPGEN]) == tg, bar);
            __builtin_amdgcn_fence(__ATOMIC_ACQUIRE, "agent");
            xb_add(&bar[XB_XGEN(b.x)], 1u);
            asm volatile("s_waitcnt vmcnt(0)" ::: "memory");
        } else {
            XB_SPIN(xb_ld(&bar[XB_XGEN(b.x)]) == gen, bar);
            __builtin_amdgcn_fence(__ATOMIC_ACQUIRE, "agent");
            asm volatile("s_waitcnt vmcnt(0)" ::: "memory");
        }
    }
    __syncthreads();
}


#ifndef STAGE
#define STAGE 3
#endif
#ifndef N_LAUNCH_MODE
#define N_LAUNCH_MODE 1
#endif
#ifndef REP_TK
#define REP_TK 1
#endif
#ifndef REP_AT
#define REP_AT 1
#endif
#ifndef REP_PH
#define REP_PH -1
#endif
#ifndef TK_PREFETCH
#define TK_PREFETCH 1
#endif
#ifndef DBG_C
#define DBG_C 0.0f
#endif

typedef float f32x16 __attribute__((ext_vector_type(16)));
typedef __attribute__((ext_vector_type(2))) __bf16 bf16x2_t;
using pg8::bf16_t; using pg8::Unit;

constexpr int M = 16384, DM = 1024, NHEAD = 8, HD = 64, AW = 512, PW = 512, FF = 2816, FF2 = 5632, NIN = 4420, NINP = 4608, NMOD = 6144;
constexpr float EPS = 1e-6f;
constexpr int NWAVES = 8, NTHR = 512;

constexpr size_t MiB = 1u << 20;
constexpr size_t WS_CTL = 0, CTL_ZERO_BYTES = 64 * 1024;
constexpr size_t WS_WIN = 1 * MiB, WS_WATTN = 10 * MiB, WS_WGRP = 11 * MiB, WS_WPOOL = 11 * MiB + 512 * 1024, WS_WOUT = 12 * MiB + 512 * 1024,
                 WS_WUP = 14 * MiB + 512 * 1024, WS_WDOWN = 25 * MiB + 512 * 1024;
constexpr size_t WS_MODP = 31 * MiB, WS_MODF = 31 * MiB + 393216, WS_WI = 31 * MiB + 512 * 1024;
constexpr size_t WS_H = 32 * MiB;
constexpr size_t WS_Q = 64 * MiB, WS_K = 80 * MiB, WS_V = 96 * MiB;
constexpr size_t WS_SEL = 88 * MiB;
constexpr size_t WS_QI = 112 * MiB, WS_KI = 120 * MiB;
constexpr size_t WS_UPOOL = 128 * MiB, WS_POOLED = 144 * MiB, WS_POOLMIX = 160 * MiB, WS_ATTN = 176 * MiB;
constexpr size_t WS_GA = 192 * MiB, WS_GP = 224 * MiB;
constexpr size_t WS_ACT = 64 * MiB;
constexpr size_t WS_RAW = 152 * MiB;
constexpr size_t WS_END = 256 * MiB;
constexpr int CW_BAR = 1024, CW_QUEUE = 512;

constexpr int LDS_BYTES = 163840;
constexpr int HSTRIDE = 1025, MSTRIDE = 513;
constexpr int LIST_OFF = 135168, ST_OFF = 151552, MISC_OFF = 159744;

#define SYNC() __syncthreads()
__device__ __forceinline__ float wave_sum(float v) {
#pragma unroll
    for (int o = 1; o < 64; o <<= 1) v += __shfl_xor(v, o);
    return v;
}
__device__ __forceinline__ float bf_lo(unsigned w) { return __builtin_bit_cast(float, w << 16); }
__device__ __forceinline__ float bf_hi(unsigned w) { return __builtin_bit_cast(float, w & 0xffff0000u); }
__device__ __forceinline__ float sigmoidf_(float x) { return 1.0f / (1.0f + __expf(-x)); }
__device__ __forceinline__ unsigned pkbf(float lo, float hi) { return pg8::cvt_pk_bf16(lo, hi); }
typedef unsigned u32x2 __attribute__((ext_vector_type(2)));
__device__ __forceinline__ u32x2 pk4(f32x4 v) { u32x2 r; r.x = pkbf(v[0], v[1]); r.y = pkbf(v[2], v[3]); return r; }
__device__ __forceinline__ unsigned pk4_fp8(f32x4 v) { int w = 0; w = __builtin_amdgcn_cvt_pk_fp8_f32(v[0], v[1], w, false); w = __builtin_amdgcn_cvt_pk_fp8_f32(v[2], v[3], w, true); return (unsigned)w; }

__device__ __forceinline__ void tr_item(const float* W, int ldw, int src_col, int nvalid, int k0, bf16_t* WT, int K, int dst_row, LAS float* scr, int lane) {
    f32x4 v[8];
#pragma unroll
    for (int i = 0; i < 8; ++i) { const int kk = 8 * i + (lane >> 3), n4 = 4 * (lane & 7);
        v[i] = (f32x4){0.f, 0.f, 0.f, 0.f}; if (W != nullptr && n4 < nvalid) v[i] = *(const f32x4*)(W + (size_t)(k0 + kk) * ldw + src_col + n4); }
#pragma unroll
    for (int i = 0; i < 8; ++i) { const int kk = 8 * i + (lane >> 3), n4 = 4 * (lane & 7); LAS float* p = scr + kk * 33 + n4; p[0] = v[i][0]; p[1] = v[i][1]; p[2] = v[i][2]; p[3] = v[i][3]; }
    LDS_WAIT(); asm volatile("" ::: "memory");
    const int c = lane & 7;
#pragma unroll
    for (int j = 0; j < 4; ++j) { const int n = (lane >> 3) + 8 * j; const LAS float* s = scr + (8 * c) * 33 + n;
        v4u o; o.x = pk2(s[0 * 33], s[1 * 33]); o.y = pk2(s[2 * 33], s[3 * 33]); o.z = pk2(s[4 * 33], s[5 * 33]); o.w = pk2(s[6 * 33], s[7 * 33]);
        *(GAS v4u*)(WT + (size_t)(dst_row + n) * K + k0 + 8 * c) = o; }
    LDS_WAIT(); asm volatile("" ::: "memory");
}

struct P0Ptrs { const float *c, *w_ada, *w_in, *w_attn, *w_grp, *w_pool, *w_out, *w_up, *w_down, *pscale; bf16_t *WIN, *WATTN, *WGRP, *WPOOL, *WOUT, *WUP, *WDOWN; float* MODP; };
__device__ __forceinline__ void p0_prologue(const P0Ptrs& P, LAS unsigned char* lds, int gw, int NGW, int wave, int lane) {
    LAS float* scr = (LAS float*)(lds + wave * 16384);
    LAS float* sil = (LAS float*)(lds + 131072);
    for (int i = threadIdx.x; i < 1024; i += NTHR) { const float cv = P.c[i]; sil[i] = cv / (1.0f + __expf(-cv)); }
    SYNC();
    constexpr int I_WIN = 144 * 16, I_WATTN = 32 * 8, I_WGRP = 128, I_WPOOL = 32 * 8, I_WOUT = 32 * 16, I_WUP = 176 * 16, I_WDOWN = 32 * 44, I_MOD = 96 * 16;
    constexpr int NITEMS = I_WIN + I_WATTN + I_WGRP + I_WPOOL + I_WOUT + I_WUP + I_WDOWN + I_MOD;
    for (int it = gw; it < NITEMS; it += NGW) {
        int r = it;
        if (r < I_MOD) {
            const int cb = r % 96, kc = r / 96, col = cb * 64 + lane; float acc = 0.f;
#pragma unroll 8
            for (int i = 0; i < 64; ++i) { const int k = kc * 64 + i; acc = fmaf(sil[k], P.w_ada[(size_t)k * NMOD + col], acc); }
            P.MODP[kc * NMOD + col] = acc; continue; }
        r -= I_MOD;
        if (r < I_WIN) { const int g = r / 16, kb = r % 16, tile = g >> 3, gi = g & 7; int src = -1, nv = 32;
            const int permgi = gi < 4 ? 64 * gi : 64 * (gi - 4) + 32;
            if (tile < 2) src = tile * 256 + permgi;
            else if (tile < 4) src = 512 + (tile - 2) * 256 + permgi;
            else if (tile < 6) src = 1024 + (tile - 4) * 256 + 32 * gi;
            else if (tile == 6) src = 1536 + 32 * gi;
            else if (tile == 7) { if (gi < 2) src = 1792 + 32 * gi; else if (gi == 2) { src = 1856; nv = 4; } }
            else if (tile < 10) src = 1860 + (tile - 8) * 256 + 32 * gi;
            else if (tile < 14) src = 2372 + (tile - 10) * 256 + 32 * gi;
            else src = 3396 + (tile - 14) * 256 + 32 * gi;
            tr_item(src >= 0 ? P.w_in : nullptr, NIN, src >= 0 ? src : 0, nv, kb * 64, P.WIN, 1024, g * 32, scr, lane); continue; }
        r -= I_WIN;
        if (r < I_WATTN) { tr_item(P.w_attn, 1024, (r / 8) * 32, 32, (r % 8) * 64, P.WATTN, 512, (r / 8) * 32, scr, lane); continue; }
        r -= I_WATTN;
        if (r < I_WGRP) {
            const int row = 4 * r + (lane >> 4), g = row >> 7; const float* src = P.w_grp + (size_t)g * 16384 + (size_t)(row & 127) * 128;
#pragma unroll
            for (int q = 0; q < 4; ++q) { const int d0 = 32 * (lane & 15) + 8 * q; v4u o = (v4u){0u, 0u, 0u, 0u};
                if ((d0 >> 7) == g) { const f32x4 a = *(const f32x4*)(src + (d0 & 127)) * *(const f32x4*)(P.pscale + d0), b = *(const f32x4*)(src + (d0 & 127) + 4) * *(const f32x4*)(P.pscale + d0 + 4);
                    o.x = pk2(a[0], a[1]); o.y = pk2(a[2], a[3]); o.z = pk2(b[0], b[1]); o.w = pk2(b[2], b[3]); }
                *(GAS v4u*)(P.WGRP + (size_t)row * 512 + d0) = o; }
            continue; }
        r -= I_WGRP;
        if (r < I_WPOOL) { tr_item(P.w_pool, 1024, (r / 8) * 32, 32, (r % 8) * 64, P.WPOOL, 512, (r / 8) * 32, scr, lane); continue; }
        r -= I_WPOOL;
        if (r < I_WOUT) { tr_item(P.w_out, 1024, (r / 16) * 32, 32, (r % 16) * 64, P.WOUT, 1024, (r / 16) * 32, scr, lane); continue; }
        r -= I_WOUT;
        if (r < I_WUP) { const int g = r / 16, kb = r % 16, tile = g >> 3, gi = g & 7;
            const int src = gi < 4 ? 128 * tile + 32 * gi : FF + 128 * tile + 32 * (gi - 4);
            tr_item(P.w_up, FF2, src, 32, kb * 64, P.WUP, 1024, g * 32, scr, lane); continue; }
        r -= I_WUP;
        { tr_item(P.w_down, 1024, (r / 44) * 32, 32, (r % 44) * 64, P.WDOWN, FF, (r / 44) * 32, scr, lane); }
    }
}

__device__ __forceinline__ void modulate_rows(const float* X, bf16_t* O, const LAS float* mulv, const LAS float* addv, int gw, int NGW, int lane) {
    f32x4 mu[4], ad[4];
#pragma unroll
    for (int j = 0; j < 4; ++j) { mu[j] = *(const LAS f32x4*)(mulv + 4 * lane + 256 * j); ad[j] = *(const LAS f32x4*)(addv + 4 * lane + 256 * j); }
    for (int row = gw; row < M; row += NGW) {
        const GAS f32x4* xr = (const GAS f32x4*)(X + (size_t)row * DM) + lane;
        f32x4 v[4]; float s = 0.f;
#pragma unroll
        for (int j = 0; j < 4; ++j) { v[j] = xr[64 * j]; s += (v[j].x * v[j].x + v[j].y * v[j].y) + (v[j].z * v[j].z + v[j].w * v[j].w); }
        const float rstd = 1.0f / sqrtf(wave_sum(s) * (1.0f / DM) + EPS);
        GAS u32x2* o8 = (GAS u32x2*)(O + (size_t)row * DM) + lane;
#pragma unroll
        for (int j = 0; j < 4; ++j) { const f32x4 y = v[j] * rstd * mu[j] + ad[j]; o8[64 * j] = pk4(y); }
    }
}

struct EpiProj {
    static constexpr bool PERM = false, AFTER_DRAIN = false;
    bf16_t *Q; unsigned char *K8, *V8; bf16_t *QI, *KI, *UPOOL, *GA, *GP; float* WI; const float *qg, *kg;
    __device__ __forceinline__ void operator()(const pg8::f32x4 (&acc)[2][2][4][2], const Unit& u, int wr, int wc, int fr, int fq) const {
        const int pn = u.pn, row0 = u.pm * 256 + wr * 64 + fr;
        if (pn < 4) {
            const bool isq = pn < 2; const float* g = isq ? qg : kg; const int head = (pn & 1) * 4 + wc;
            f32x4 gv[2][2];
#pragma unroll
            for (int bj = 0; bj < 2; ++bj)
#pragma unroll
                for (int n = 0; n < 2; ++n) gv[bj][n] = *(const f32x4*)(g + 32 * bj + 16 * n + 4 * fq);
#pragma unroll
            for (int ai = 0; ai < 2; ++ai)
#pragma unroll
                for (int m = 0; m < 4; ++m) {
                    float ss = 0.f;
#pragma unroll
                    for (int bj = 0; bj < 2; ++bj)
#pragma unroll
                        for (int n = 0; n < 2; ++n) { const f32x4 x = acc[ai][bj][m][n]; ss += (x[0] * x[0] + x[1] * x[1]) + (x[2] * x[2] + x[3] * x[3]); }
                    ss += __shfl_xor(ss, 16); ss += __shfl_xor(ss, 32);
                    const float rstd = 1.0f / sqrtf(ss * (1.0f / 64.0f) + EPS);
                    const size_t ro = (size_t)(row0 + ai * 128 + m * 16) * AW + head * 64 + 4 * fq;
#pragma unroll
                    for (int bj = 0; bj < 2; ++bj)
#pragma unroll
                        for (int n = 0; n < 2; ++n) { const f32x4 y = acc[ai][bj][m][n] * rstd * gv[bj][n];
                            if (isq) *(u32x2*)(Q + ro + 32 * bj + 16 * n) = pk4(y); else *(unsigned*)(K8 + ((size_t)head * M + (row0 + ai * 128 + m * 16)) * 128 + 4 * fq + 32 * bj + 16 * n) = pk4_fp8(y); }
                }
            return;
        }
        const int colw = wc * 32 + 4 * fq;
        if (pn == 7) {
#pragma unroll
            for (int ai = 0; ai < 2; ++ai)
#pragma unroll
                for (int m = 0; m < 4; ++m) { const int row = row0 + ai * 128 + m * 16;
                    if (wc < 2) {
#pragma unroll
                        for (int n = 0; n < 2; ++n) { const int c = colw + 16 * n; *(u32x2*)(KI + (size_t)(row >> 5) * 2048 + (c >> 4) * 512 + ((((c >> 3) & 1) * 32 + (row & 31)) * 8) + (c & 7)) = pk4(acc[ai][0][m][n]); }
                    } else if (wc == 2 && fq == 0) { *(f32x4*)(WI + (size_t)row * 4) = acc[ai][0][m][0] * 0.5f; }
                }
            return;
        }
        if (pn < 6) {
#pragma unroll
            for (int ai = 0; ai < 2; ++ai)
#pragma unroll
                for (int m = 0; m < 4; ++m) { const int row = row0 + ai * 128 + m * 16;
#pragma unroll
                    for (int bj = 0; bj < 2; ++bj)
#pragma unroll
                        for (int n = 0; n < 2; ++n) { const int col = (pn - 4) * 256 + colw + 128 * bj + 16 * n;
                            *(unsigned*)(V8 + ((size_t)(col >> 6) * M + row) * 128 + 64 + (col & 63)) = pk4_fp8(acc[ai][bj][m][n]); } }
            return;
        }
        bf16_t* O; int ldo, ct; float sc = 1.0f; bool sig = false;
        if (pn == 6) { O = QI; ldo = 256; ct = 0; sc = 0.125f; }
        else if (pn < 10) { O = UPOOL; ldo = PW; ct = (pn - 8) * 256; }
        else if (pn < 14) { O = GA; ldo = DM; ct = (pn - 10) * 256; sig = true; }
        else { O = GP; ldo = DM; ct = (pn - 14) * 256; sig = true; }
#pragma unroll
        for (int ai = 0; ai < 2; ++ai)
#pragma unroll
            for (int m = 0; m < 4; ++m) { bf16_t* rowp = O + (size_t)(row0 + ai * 128 + m * 16) * ldo + ct + colw;
#pragma unroll
                for (int bj = 0; bj < 2; ++bj)
#pragma unroll
                    for (int n = 0; n < 2; ++n) { f32x4 y = acc[ai][bj][m][n] * sc;
                        if (sig) { y[0] = sigmoidf_(y[0]); y[1] = sigmoidf_(y[1]); y[2] = sigmoidf_(y[2]); y[3] = sigmoidf_(y[3]); }
                        *(u32x2*)(rowp + 128 * bj + 16 * n) = pk4(y); }
            }
    }
};

template <int MODE> struct EpiBf {
    static constexpr bool PERM = false, AFTER_DRAIN = false;
    bf16_t* O; int ldo; const float* colscale; const bf16_t* ADD;
    __device__ __forceinline__ void operator()(const pg8::f32x4 (&acc)[2][2][4][2], const Unit& u, int wr, int wc, int fr, int fq) const {
        const int row0 = u.pm * 256 + wr * 64 + fr, col0 = u.pn * 256 + wc * 32 + 4 * fq;
#pragma unroll
        for (int ai = 0; ai < 2; ++ai)
#pragma unroll
            for (int m = 0; m < 4; ++m) { const size_t ro = (size_t)(row0 + ai * 128 + m * 16) * ldo + col0;
#pragma unroll
                for (int bj = 0; bj < 2; ++bj)
#pragma unroll
                    for (int n = 0; n < 2; ++n) { f32x4 y = acc[ai][bj][m][n]; const size_t off = ro + 128 * bj + 16 * n;
                        if (MODE == 3) { }
                        else if (MODE == 0) { y = y * *(const f32x4*)(colscale + col0 + 128 * bj + 16 * n); }
                        else { const u32x2 gq = *(const u32x2*)(O + off); y[0] *= bf_lo(gq.x); y[1] *= bf_hi(gq.x); y[2] *= bf_lo(gq.y); y[3] *= bf_hi(gq.y);
                            if (MODE == 2) { const u32x2 a = *(const u32x2*)(ADD + off); y[0] += bf_lo(a.x); y[1] += bf_hi(a.x); y[2] += bf_lo(a.y); y[3] += bf_hi(a.y); } }
                        *(u32x2*)(O + off) = pk4(y); }
            }
    }
};

struct EpiRes {
    static constexpr bool PERM = false, AFTER_DRAIN = false;
    const float* BASE; float* OUT; const float* gate; float dbg;
    __device__ __forceinline__ void operator()(const pg8::f32x4 (&acc)[2][2][4][2], const Unit& u, int wr, int wc, int fr, int fq) const {
        const int row0 = u.pm * 256 + wr * 64 + fr, col0 = u.pn * 256 + wc * 32 + 4 * fq;
        f32x4 gv[2][2];
#pragma unroll
        for (int bj = 0; bj < 2; ++bj)
#pragma unroll
            for (int n = 0; n < 2; ++n) gv[bj][n] = *(const f32x4*)(gate + col0 + 128 * bj + 16 * n);
#pragma unroll
        for (int ai = 0; ai < 2; ++ai)
#pragma unroll
            for (int m = 0; m < 4; ++m) { const int row = row0 + ai * 128 + m * 16; const size_t ro = (size_t)row * DM + col0;
#pragma unroll
                for (int bj = 0; bj < 2; ++bj)
#pragma unroll
                    for (int n = 0; n < 2; ++n) { const size_t off = ro + 128 * bj + 16 * n; f32x4 y = *(const f32x4*)(BASE + off) + gv[bj][n] * acc[ai][bj][m][n];
                        if (dbg != 0.f) { const float sg = ((row * 7 + (int)(off >> 2)) & 1) ? dbg : -dbg; y[0] += sg; y[1] -= sg; y[2] += sg; y[3] -= sg; }
                        *(f32x4*)(OUT + off) = y; }
            }
    }
};

template <int CTRL> __device__ __forceinline__ float dppf(float x) { return __builtin_bit_cast(float, __builtin_amdgcn_update_dpp(0, __builtin_bit_cast(int, x), CTRL, 0xf, 0xf, false)); }
__device__ __forceinline__ f32x4 ror1(f32x4 v) { f32x4 r; r[0] = dppf<0x121>(v[0]); r[1] = dppf<0x121>(v[1]); r[2] = dppf<0x121>(v[2]); r[3] = dppf<0x121>(v[3]); return r; }
__device__ __forceinline__ f32x4 ror2(f32x4 v) { f32x4 r; r[0] = dppf<0x122>(v[0]); r[1] = dppf<0x122>(v[1]); r[2] = dppf<0x122>(v[2]); r[3] = dppf<0x122>(v[3]); return r; }
__device__ __forceinline__ f32x4 silu_mul(f32x4 a, f32x4 b) { f32x4 r;
#pragma unroll
    for (int e = 0; e < 4; ++e) r[e] = a[e] / (1.0f + __expf(-a[e])) * b[e];
    return r; }
struct EpiUpAct {
    static constexpr bool PERM = false, AFTER_DRAIN = false;
    bf16_t* ACT; float* RAW; const float* cw; const float* cb;
    __device__ __forceinline__ void operator()(const pg8::f32x4 (&acc)[2][2][4][2], const Unit& u, int wr, int wc, int fr, int fq) const {
#pragma unroll
        for (int n = 0; n < 2; ++n) {
            const int ch = u.pn * 128 + wc * 32 + 4 * fq + 16 * n;
            const f32x4 w0a = *(const f32x4*)(cw + ch), w1a = *(const f32x4*)(cw + FF2 + ch), w2a = *(const f32x4*)(cw + 2 * FF2 + ch), ba = *(const f32x4*)(cb + ch);
            const f32x4 w0b = *(const f32x4*)(cw + FF + ch), w1b = *(const f32x4*)(cw + FF2 + FF + ch), w2b = *(const f32x4*)(cw + 2 * FF2 + FF + ch), bb = *(const f32x4*)(cb + FF + ch);
#pragma unroll
            for (int ai = 0; ai < 2; ++ai) {
                const int blk = u.pm * 4 + ai * 2 + wr;
                if (fr < 2) { *(f32x4*)(RAW + (size_t)(blk * 4 + fr) * FF2 + ch) = acc[ai][0][0][n]; *(f32x4*)(RAW + (size_t)(blk * 4 + fr) * FF2 + FF + ch) = acc[ai][1][0][n]; }
                if (fr >= 14) { *(f32x4*)(RAW + (size_t)(blk * 4 + fr - 12) * FF2 + ch) = acc[ai][0][3][n]; *(f32x4*)(RAW + (size_t)(blk * 4 + fr - 12) * FF2 + FF + ch) = acc[ai][1][3][n]; }
                f32x4 pa1 = {0.f, 0.f, 0.f, 0.f}, pa2 = pa1, pb1 = pa1, pb2 = pa1;
#pragma unroll
                for (int m = 0; m < 4; ++m) {
                    const f32x4 va = acc[ai][0][m][n], vb = acc[ai][1][m][n];
                    const f32x4 ra1 = ror1(va), ra2 = ror2(va), rb1 = ror1(vb), rb2 = ror2(vb);
                    const f32x4 xa1 = fr >= 1 ? ra1 : pa1, xa2 = fr >= 2 ? ra2 : pa2, xb1 = fr >= 1 ? rb1 : pb1, xb2 = fr >= 2 ? rb2 : pb2;
                    pa1 = ra1; pa2 = ra2; pb1 = rb1; pb2 = rb2;
                    const f32x4 ya = ba + w0a * xa2 + w1a * xa1 + w2a * va, yb = bb + w0b * xb2 + w1b * xb1 + w2b * vb;
                    const f32x4 o = silu_mul(ya, yb);
                    if (!(m == 0 && fr < 2)) *(u32x2*)(ACT + (size_t)(blk * 64 + 16 * m + fr) * FF + ch) = pk4(o);
                }
            }
        }
    }
};

__device__ __forceinline__ void fixup_phase(const float* RAW, bf16_t* ACT, const float* cw, const float* cb, int gtid, int nthr) {
    for (int it = gtid; it < 256 * 2 * 704; it += nthr) {
        const int c4 = it % 704, rr = (it / 704) & 1, blk = it / 1408, ch = 4 * c4;
        const float* cur = RAW + (size_t)(blk * 4 + rr) * FF2;
        const float* p1 = rr == 1 ? RAW + (size_t)(blk * 4) * FF2 : (blk > 0 ? RAW + (size_t)((blk - 1) * 4 + 3) * FF2 : nullptr);
        const float* p2 = rr == 1 ? (blk > 0 ? RAW + (size_t)((blk - 1) * 4 + 3) * FF2 : nullptr) : (blk > 0 ? RAW + (size_t)((blk - 1) * 4 + 2) * FF2 : nullptr);
        const f32x4 z = {0.f, 0.f, 0.f, 0.f};
        const f32x4 va = *(const f32x4*)(cur + ch), vb = *(const f32x4*)(cur + FF + ch);
        const f32x4 a1 = p1 ? *(const f32x4*)(p1 + ch) : z, b1 = p1 ? *(const f32x4*)(p1 + FF + ch) : z;
        const f32x4 a2 = p2 ? *(const f32x4*)(p2 + ch) : z, b2 = p2 ? *(const f32x4*)(p2 + FF + ch) : z;
        const f32x4 ya = *(const f32x4*)(cb + ch) + *(const f32x4*)(cw + ch) * a2 + *(const f32x4*)(cw + FF2 + ch) * a1 + *(const f32x4*)(cw + 2 * FF2 + ch) * va;
        const f32x4 yb = *(const f32x4*)(cb + FF + ch) + *(const f32x4*)(cw + FF + ch) * b2 + *(const f32x4*)(cw + FF2 + FF + ch) * b1 + *(const f32x4*)(cw + 2 * FF2 + FF + ch) * vb;
        *(u32x2*)(ACT + (size_t)(blk * 64 + rr) * FF + ch) = pk4(silu_mul(ya, yb));
    }
}

template <int W> __device__ __forceinline__ void pooled_item(const bf16_t* UPOOL, bf16_t* POOLED, int t, int c8) {
    v4u v[W];
#pragma unroll
    for (int j = 0; j < W; ++j) { const int tj = (t - j) >= 0 ? (t - j) : 0; v[j] = *(const v4u*)(UPOOL + (size_t)tj * PW + 8 * c8); }
    float s[8];
#pragma unroll
    for (int e = 0; e < 8; ++e) s[e] = 0.f;
#pragma unroll
    for (int j = 0; j < W; ++j) { const float m = (t - j) >= 0 ? 1.f : 0.f;
        s[0] = fmaf(m, bf_lo(v[j].x), s[0]); s[1] = fmaf(m, bf_hi(v[j].x), s[1]); s[2] = fmaf(m, bf_lo(v[j].y), s[2]); s[3] = fmaf(m, bf_hi(v[j].y), s[3]);
        s[4] = fmaf(m, bf_lo(v[j].z), s[4]); s[5] = fmaf(m, bf_hi(v[j].z), s[5]); s[6] = fmaf(m, bf_lo(v[j].w), s[6]); s[7] = fmaf(m, bf_hi(v[j].w), s[7]); }
    const int cntw = (t + 1) < W ? (t + 1) : W; const float inv = 1.0f / (float)cntw; v4u o;
    o.x = pkbf(s[0] * inv - bf_lo(v[0].x), s[1] * inv - bf_hi(v[0].x)); o.y = pkbf(s[2] * inv - bf_lo(v[0].y), s[3] * inv - bf_hi(v[0].y));
    o.z = pkbf(s[4] * inv - bf_lo(v[0].z), s[5] * inv - bf_hi(v[0].z)); o.w = pkbf(s[6] * inv - bf_lo(v[0].w), s[7] * inv - bf_hi(v[0].w));
    *(v4u*)(POOLED + (size_t)t * PW + 8 * c8) = o;
}
__device__ __forceinline__ void pooled_phase(const bf16_t* UPOOL, bf16_t* POOLED, int gtid, int nthr) {
    for (int it = gtid; it < M * 64; it += nthr) {
        const int wv = it >> 6, l = it & 63, g = wv & 3, t = (wv >> 2) * 4 + (l >> 4), c8 = g * 16 + (l & 15);
        if (g == 0) pooled_item<2>(UPOOL, POOLED, t, c8); else if (g == 1) pooled_item<4>(UPOOL, POOLED, t, c8); else if (g == 2) pooled_item<8>(UPOOL, POOLED, t, c8); else pooled_item<16>(UPOOL, POOLED, t, c8);
    }
}

#define MFMA32(a, b, c) __builtin_amdgcn_mfma_f32_32x32x16_bf16((a), (b), (c), 0, 0, 0)
__device__ __forceinline__ unsigned lds_add(LAS unsigned* p, unsigned v) { return __hip_atomic_fetch_add(p, v, __ATOMIC_RELAXED, __HIP_MEMORY_SCOPE_WORKGROUP); }
__device__ __forceinline__ unsigned lds_or(LAS unsigned* p, unsigned v) { return __hip_atomic_fetch_or(p, v, __ATOMIC_RELAXED, __HIP_MEMORY_SCOPE_WORKGROUP); }

__device__ __forceinline__ float u2f(unsigned u) { return __uint_as_float((u & 0x80000000u) ? (u & 0x7fffffffu) : ~u); }
template <bool EMIT>
__device__ __forceinline__ void tk_pass(int qb, int wave, int lane, const bf16_t* KI, const LAS bf16_t* QF, const float (&wv)[4], LAS unsigned* H, LAS unsigned* SELM, LAS unsigned* TIEM,
                                        int sh, unsigned vlo, bool clampTop, unsigned bmax, int stage, unsigned vmin, float fsel, float ftie) {
    const int r = lane & 31, h = lane >> 5;
    const int gstep = stage == 1 ? 8 : 1, g0 = stage == 1 ? wave : 0;
#define TK_NEXT_G(g) ({ int _g = (g) + gstep; if (stage == 2 && (_g & 7) == wave) ++_g; _g; })
    int gcur = g0; if (stage == 2 && (gcur & 7) == wave) ++gcur;
    pg8::bf16x8 kf[4];
    { const int T0 = (wave + 8 * gcur) <= qb ? (wave + 8 * gcur) : qb; const bf16_t* kp = KI + (size_t)T0 * 2048 + 8 * lane;
#pragma unroll
      for (int s = 0; s < 4; ++s) kf[s] = *(const pg8::bf16x8*)(kp + 512 * s); }
    LAS unsigned* Hq = H + r * HSTRIDE;
#pragma unroll 1
    for (; wave + 8 * gcur <= qb; gcur = TK_NEXT_G(gcur)) {
        const int T = wave + 8 * gcur;
        float sc[16];
#pragma unroll
        for (int i = 0; i < 16; ++i) sc[i] = 0.f;
#pragma unroll
        for (int hd = 0; hd < 4; ++hd) { f32x16 a;
#pragma unroll
            for (int i = 0; i < 16; ++i) a[i] = 0.f;
#pragma unroll
            for (int s = 0; s < 4; ++s) a = MFMA32(kf[s], *(const LAS pg8::bf16x8*)(QF + (hd * 4 + s) * 512 + lane * 8), a);
#pragma unroll
            for (int i = 0; i < 16; ++i) { const float av = a[i]; const int ab = __float_as_int(av); sc[i] = fmaf(wv[hd], __int_as_float(ab > 0 ? ab : 0), sc[i]); } }
        { const int Tnn = wave + 8 * TK_NEXT_G(gcur); const int Tn = Tnn <= qb ? Tnn : T; const bf16_t* kp = KI + (size_t)Tn * 2048 + 8 * lane;
#pragma unroll
          for (int s = 0; s < 4; ++s) kf[s] = *(const pg8::bf16x8*)(kp + 512 * s); }
        const int rlim = (T == qb) ? r : 64;
        if (!EMIT) {
#pragma unroll
            for (int i = 0; i < 16; ++i) {
                const int kr = (i & 3) + 8 * (i >> 2) + 4 * h;
                unsigned uu = __float_as_uint(sc[i]); uu ^= ((unsigned)((int)uu >> 31)) | 0x80000000u;
                const unsigned v = uu >> sh; unsigned b = v - vlo;
                const bool ok = (kr <= rlim) && (v >= vmin) && (clampTop || b <= bmax);
                b = b > 2047u ? 2047u : b;
                lds_add(Hq + (ok ? (b >> 1) : 1024u), 1u << ((b & 1u) * 16u));
            }
        } else {
            unsigned ms = 0u, mg = 0u;
#pragma unroll
            for (int i = 15; i >= 0; --i) {
                asm("v_cmp_ge_f32_e32 vcc, %1, %2\n\tv_addc_co_u32_e32 %0, vcc, %0, %0, vcc" : "+v"(ms) : "v"(sc[i]), "v"(fsel) : "vcc");
                asm("v_cmp_ge_f32_e32 vcc, %1, %2\n\tv_addc_co_u32_e32 %0, vcc, %0, %0, vcc" : "+v"(mg) : "v"(sc[i]), "v"(ftie) : "vcc");
            }
            const unsigned vrow = rlim >= 31 ? 0xffffffffu : ((2u << rlim) - 1u);
            auto spread = [&](unsigned m) { return (((m & 0xfu) | ((m & 0xf0u) << 4) | ((m & 0xf00u) << 8) | ((m & 0xf000u) << 12)) << (4 * h)) & vrow; };
            const unsigned msel = spread(ms), mtie = spread(mg) & ~msel;
            const unsigned osel = __shfl_xor(msel, 32), otie = __shfl_xor(mtie, 32);
            if (h == 0) { SELM[r * MSTRIDE + T] = msel | osel; TIEM[r * MSTRIDE + T] = mtie | otie; }
        }
    }
#undef TK_NEXT_G
}

template <int CTRL> __device__ __forceinline__ float dppx(float x) { return __builtin_bit_cast(float, __builtin_amdgcn_mov_dpp(__builtin_bit_cast(int, x), CTRL, 0xf, 0xf, true)); }
__device__ __forceinline__ u32x2 tk_rescore_load(const bf16_t* KI, int key, int lane) {
    const int c = 4 * (lane & 15);
    return *(const u32x2*)(KI + (size_t)(key >> 5) * 2048 + (c >> 4) * 512 + ((((c >> 3) & 1) * 32 + (key & 31)) * 8) + (c & 7));
}
__device__ __forceinline__ float tk_rescore(const u32x2 q4, float wh, const u32x2 k4) {
    float d = bf_lo(q4.x) * bf_lo(k4.x); d = fmaf(bf_hi(q4.x), bf_hi(k4.x), d); d = fmaf(bf_lo(q4.y), bf_lo(k4.y), d); d = fmaf(bf_hi(q4.y), bf_hi(k4.y), d);
    d += dppx<0xB1>(d); d += dppx<0x4E>(d); d += dppx<0x141>(d); d += dppx<0x140>(d);
    float sc = wh * fmaxf(d, 0.f);
    sc += __shfl_xor(sc, 16); sc += __shfl_xor(sc, 32);
    return sc + 0.f;
}

__device__ __forceinline__ int wave_incl_scan(int v) {
    v += __builtin_amdgcn_update_dpp(0, v, 0x111, 0xf, 0xf, true); v += __builtin_amdgcn_update_dpp(0, v, 0x112, 0xf, 0xf, true);
    v += __builtin_amdgcn_update_dpp(0, v, 0x114, 0xf, 0xf, true); v += __builtin_amdgcn_update_dpp(0, v, 0x118, 0xf, 0xf, true);
    v += __builtin_amdgcn_update_dpp(0, v, 0x142, 0xa, 0xf, false); v += __builtin_amdgcn_update_dpp(0, v, 0x143, 0xc, 0xf, false);
    return v;
}
__device__ __forceinline__ void tk_scan(const LAS unsigned* Hq, LAS unsigned* pref_p, LAS unsigned* need_p, LAS unsigned* cnt_p, int bits, int lane) {
    const int need = (int)*need_p;
    int S = 0;
#pragma unroll
    for (int i = 0; i < 16; ++i) { const unsigned w = Hq[16 * lane + ((i + lane) & 15)]; S += (int)((w & 0xffffu) + (w >> 16)); }
    const int incl = wave_incl_scan(S), total = __builtin_amdgcn_readlane(incl, 63), Tabove = total - incl;
    const bool hit = (Tabove < need) && (need <= Tabove + S);
    const unsigned long long mk = __ballot(hit);
    const int L = mk ? (int)__builtin_ctzll(mk) : 0;
    const int remL = need - __builtin_amdgcn_readlane(Tabove, L);
    const unsigned w2 = Hq[16 * L + ((lane & 31) >> 1)];
    const int c = lane < 32 ? (int)((w2 >> (16 * (lane & 1))) & 0xffffu) : 0;
    const int incl2 = wave_incl_scan(c), tot2 = __builtin_amdgcn_readlane(incl2, 63), above2 = tot2 - incl2;
    const bool hit2 = (lane < 32) && (above2 < remL) && (remL <= above2 + c);
    const unsigned long long mk2 = __ballot(hit2);
    const int J = mk2 ? (int)__builtin_ctzll(mk2) : 0;
    const unsigned Dsel = (unsigned)(32 * L + J), nsel = mk2 ? (unsigned)(remL - __builtin_amdgcn_readlane(above2, J)) : 1u, csel = (unsigned)__builtin_amdgcn_readlane(c, J);
    if (lane == 0) { *pref_p = bits ? ((*pref_p << bits) | Dsel) : Dsel; *need_p = nsel; if (cnt_p) *cnt_p = csel; }
}

typedef float f32x2_t __attribute__((ext_vector_type(2)));
__device__ __forceinline__ void unpack16(const v4u w, f32x2_t (&f)[8]) {
#pragma unroll
    for (int i = 0; i < 4; ++i) { f[2 * i] = __builtin_amdgcn_cvt_pk_f32_fp8((int)w[i], false); f[2 * i + 1] = __builtin_amdgcn_cvt_pk_f32_fp8((int)w[i], true); }
}
__device__ __forceinline__ void attn_item(int t, int hd, const unsigned short* SEL, const bf16_t* Q, const unsigned char* K8, const unsigned char* V8, bf16_t* ATTN, int lane) {
    constexpr float LOG2E = 1.4426950408889634f;
    const int kk = lane >> 2, part = lane & 3, cnt = (t + 1) < 256 ? (t + 1) : 256;
    const float slope2 = exp2f(-(float)(hd + 1)) * LOG2E, sc2 = 0.125f * LOG2E;
    f32x2_t q[8];
    { const v4u qa = *(const v4u*)(Q + (size_t)t * AW + hd * 64 + part * 16), qb = *(const v4u*)(Q + (size_t)t * AW + hd * 64 + part * 16 + 8);
#pragma unroll
      for (int i = 0; i < 4; ++i) { q[i] = (f32x2_t){bf_lo(qa[i]) * sc2, bf_hi(qa[i]) * sc2}; q[4 + i] = (f32x2_t){bf_lo(qb[i]) * sc2, bf_hi(qb[i]) * sc2}; } }
    const unsigned short* lp = SEL + (size_t)t * 256;
    const unsigned char* kb = K8 + (size_t)hd * M * 128 + part * 16; const unsigned char* vb = kb + 64; (void)V8;
    int key[16]; v4u kf[16], vf[16];
#pragma unroll
    for (int r = 0; r < 16; ++r) { const int j = 16 * r + kk; key[r] = j < cnt ? (int)lp[j] : 0; }
#pragma unroll
    for (int r = 0; r < 16; ++r) { kf[r] = *(const v4u*)(kb + (size_t)key[r] * 128); vf[r] = *(const v4u*)(vb + (size_t)key[r] * 128); }
    float sv[16]; float mx = -INFINITY;
#pragma unroll
    for (int r = 0; r < 16; ++r) { f32x2_t kx[8]; unpack16(kf[r], kx); f32x2_t d2 = q[0] * kx[0];
#pragma unroll
        for (int e = 1; e < 8; ++e) d2 = __builtin_elementwise_fma(q[e], kx[e], d2);
        float d = d2.x + d2.y;
        d += dppx<0xB1>(d); d += dppx<0x4E>(d);
        sv[r] = (16 * r + kk) < cnt ? d - slope2 * (float)(t - key[r]) : -INFINITY; mx = fmaxf(mx, sv[r]); }
    mx = fmaxf(mx, __shfl_xor(mx, 4)); mx = fmaxf(mx, __shfl_xor(mx, 8)); mx = fmaxf(mx, __shfl_xor(mx, 16)); mx = fmaxf(mx, __shfl_xor(mx, 32));
    f32x2_t o[8]; float lsum = 0.f;
#pragma unroll
    for (int e = 0; e < 8; ++e) o[e] = (f32x2_t){0.f, 0.f};
#pragma unroll
    for (int r = 0; r < 16; ++r) { const float p = __builtin_amdgcn_exp2f(sv[r] - mx); lsum += p; f32x2_t vx[8]; unpack16(vf[r], vx); const f32x2_t p2 = (f32x2_t){p, p};
#pragma unroll
        for (int e = 0; e < 8; ++e) o[e] = __builtin_elementwise_fma(p2, vx[e], o[e]); }
    lsum += dppx<0x124>(lsum); lsum += dppx<0x128>(lsum); lsum += __shfl_xor(lsum, 16); lsum += __shfl_xor(lsum, 32);
    float of[16];
#pragma unroll
    for (int e = 0; e < 8; ++e) { of[2 * e] = o[e].x; of[2 * e + 1] = o[e].y; }
#pragma unroll
    for (int e = 0; e < 16; ++e) { float v = of[e]; v += dppx<0x124>(v); v += dppx<0x128>(v); v += __shfl_xor(v, 16); v += __shfl_xor(v, 32); of[e] = v; }
    if (lane < 4) { const float inv = 1.0f / lsum; v4u a, b;
        a.x = pkbf(of[0] * inv, of[1] * inv); a.y = pkbf(of[2] * inv, of[3] * inv); a.z = pkbf(of[4] * inv, of[5] * inv); a.w = pkbf(of[6] * inv, of[7] * inv);
        b.x = pkbf(of[8] * inv, of[9] * inv); b.y = pkbf(of[10] * inv, of[11] * inv); b.z = pkbf(of[12] * inv, of[13] * inv); b.w = pkbf(of[14] * inv, of[15] * inv);
        *(v4u*)(ATTN + (size_t)t * AW + hd * 64 + part * 16) = a; *(v4u*)(ATTN + (size_t)t * AW + hd * 64 + part * 16 + 8) = b; }
}

struct TkPtrs { const bf16_t *QI, *KI; const float* WI; unsigned short* SEL; };
__device__ __forceinline__ void topk_attn_block(int qb, const TkPtrs& P, LAS unsigned char* lds, int tid, int wave, int lane, bool do_attn) {
    LAS unsigned* H = (LAS unsigned*)lds;
    LAS unsigned* SELM = (LAS unsigned*)lds;
    LAS unsigned* TIEM = (LAS unsigned*)(lds + 32 * MSTRIDE * 4);
    LAS unsigned short* LIST = (LAS unsigned short*)(lds + LIST_OFF);
    LAS unsigned* STP = (LAS unsigned*)(lds + ST_OFF);
    LAS unsigned* STN = STP + 32;
    const int t0 = qb * 32, r = lane & 31, h = lane >> 5;
    SYNC();
    float wv[4];
    LAS bf16_t* QF = (LAS bf16_t*)(lds + LIST_OFF);
    { const bf16_t* qp = P.QI + (size_t)(t0 + r) * 256 + 8 * h;
#pragma unroll
      for (int k = 0; k < 2; ++k) { const int f = 2 * wave + k; *(LAS pg8::bf16x8*)(QF + f * 512 + lane * 8) = *(const pg8::bf16x8*)(qp + (f >> 2) * 64 + 16 * (f & 3)); }
      const f32x4 w4 = *(const f32x4*)(P.WI + (size_t)(t0 + r) * 4); wv[0] = w4[0]; wv[1] = w4[1]; wv[2] = w4[2]; wv[3] = w4[3]; }
    LAS unsigned* STC = STP + 64;
    LAS unsigned* STG = STP + 96;
    LAS unsigned* FB = STP + 160;
    LAS unsigned* STS = STP + 192;
    LAS float* FSEL = (LAS float*)(STP + 256);
    LAS float* FTIE = FSEL + 32;
    const bool negw = (wv[0] <= 0.f) && (wv[1] <= 0.f) && (wv[2] <= 0.f) && (wv[3] <= 0.f);
    const unsigned wbase = negw ? 7745u : 22976u;
#pragma unroll 1
    for (int rep_tk = 0; rep_tk < REP_TK; ++rep_tk) {
    if (wave == 0 && lane == 0) *FB = 0u;
#pragma unroll 1
    for (int mode = 0; mode < 2; ++mode) {
        if (mode == 1) { if (*FB == 0u) break; }
        if (wave == 0 && lane < 32) { STP[lane] = 0u; const int nv = t0 + lane + 1; STN[lane] = nv < 256 ? nv : 256; STG[lane] = negw ? 1u : 0u; }
        const int nstep = mode == 0 ? 1 : 3;
#pragma unroll 1
        for (int step = 0; step < nstep; ++step) {
            if (mode == 1 || step == 0) { for (int i = tid; i < 32 * HSTRIDE; i += NTHR) H[i] = 0u; }
            SYNC();
            const int sh = mode == 0 ? 17 : (step == 0 ? 21 : (step == 1 ? 10 : 0));
            const unsigned vlo = mode == 0 ? wbase : (step == 0 ? 0u : (STP[r] << (step == 1 ? 11 : 10)));
            const unsigned vmin = vlo;
            tk_pass<false>(qb, wave, lane, P.KI, QF, wv, H, SELM, TIEM, sh, vlo, mode == 0, (mode == 1 && step == 2) ? 1023u : 2047u, 0, vmin, 0.f, 0.f);
            SYNC();
            const bool samp = false;
#pragma unroll 1
            for (int qq = 0; qq < 4; ++qq) { const int rq = 4 * wave + qq;
                tk_scan(H + rq * HSTRIDE, samp ? STS + rq : STP + rq, samp ? STS + 32 + rq : STN + rq, STC + rq, (mode == 1 && step == 2) ? 10 : 11, lane);
                if (mode == 0 && lane == 0) { const unsigned D = STP[rq], nn = STN[rq], c = STC[rq], ng = STG[rq] & 1u;
                    const bool zerobin = ng && D == 2047u, edge = (D == 0u) || (D == 2047u && !ng);
                    const bool wantc = (c > nn) && !zerobin;
                    if (edge || (wantc && c > 64u)) lds_or(FB, 1u);
                    STG[rq] = ng | (wantc ? 2u : 0u);
                    const unsigned wb = ng ? 7745u : 22976u;
                    FTIE[rq] = u2f((wb + D) << 17); FSEL[rq] = zerobin ? INFINITY : u2f((wb + D + 1u) << 17); }
                if (mode == 1 && step == 2 && lane == 0) { const unsigned tau = STP[rq]; FTIE[rq] = u2f(tau); FSEL[rq] = tau == 0xffffffffu ? INFINITY : u2f(tau + 1u); } }
            SYNC();
        }
        if (mode == 0 && *FB != 0u) continue;
        tk_pass<true>(qb, wave, lane, P.KI, QF, wv, H, SELM, TIEM, 0, 0u, false, 0u, 0, 0u, FSEL[r], FTIE[r]);
        SYNC();
        break;
    }
    }
    if (!do_attn) return;
#pragma unroll 1
    for (int qq = 0; qq < 4; ++qq) {
        const int rq = 4 * wave + qq, t = t0 + rq; int mties = (int)STN[rq];
        unsigned tw[8], fw[8]; int S = 0;
#pragma unroll
        for (int i = 0; i < 8; ++i) { const int T = 8 * lane + i; const bool v = T <= qb; tw[i] = v ? TIEM[rq * MSTRIDE + T] : 0u; fw[i] = v ? SELM[rq * MSTRIDE + T] : 0u; S += __builtin_popcount(tw[i]); }
        const int incl = wave_incl_scan(S);
        if (*FB == 0u && (STG[rq] & 2u)) {
            const int c = __builtin_amdgcn_readlane(incl, 63), nn = mties;
            LAS unsigned short* cl = LIST + rq * 256;
            { int pos = incl - S;
#pragma unroll
              for (int i = 0; i < 8; ++i) { unsigned w = tw[i]; while (w) { const int b = __builtin_ctz(w); if (pos < 64) cl[pos] = (unsigned short)(256 * lane + 32 * i + b); ++pos; w &= w - 1u; } } }
            LDS_WAIT(); asm volatile("" ::: "memory");
            const u32x2 q4 = *(const u32x2*)(P.QI + (size_t)t * 256 + 4 * lane); const float wh = P.WI[(size_t)t * 4 + (lane >> 4)];
            float mys = 0.f; const int cc = c < 64 ? c : 64;
#pragma unroll 1
            for (int j0 = 0; j0 < cc; j0 += 8) { u32x2 k4[8];
#pragma unroll
                for (int u = 0; u < 8; ++u) { const int jj = (j0 + u) < cc ? (j0 + u) : (cc - 1); k4[u] = tk_rescore_load(P.KI, __builtin_amdgcn_readfirstlane((int)cl[jj]), lane); }
#pragma unroll
                for (int u = 0; u < 8; ++u) { const float sj = tk_rescore(q4, wh, k4[u]); if (lane == j0 + u) mys = sj; } }
            int rank = 0;
            for (int j = 0; j < cc; ++j) { const float sj = __int_as_float(__builtin_amdgcn_readlane(__float_as_int(mys), j)); rank += (sj > mys || (sj == mys && j < lane)) ? 1 : 0; }
            const bool keepme = lane < cc && rank < nn; const int mykey = lane < cc ? (int)cl[lane] : 0;
#pragma unroll 1
            for (int j = 0; j < cc; ++j) { const int kj = __builtin_amdgcn_readlane(mykey, j); const int kp = __builtin_amdgcn_readlane((int)keepme, j);
                if (kp && (kj >> 8) == lane) {
#pragma unroll
                    for (int i = 0; i < 8; ++i) if (((kj >> 5) & 7) == i) fw[i] |= 1u << (kj & 31); } }
            mties = 0;
        }
        int take = mties - (incl - S); take = take < 0 ? 0 : (take > S ? S : take);
        int cl2 = 0;
#pragma unroll
        for (int i = 0; i < 8; ++i) { unsigned w = tw[i]; const int c = __builtin_popcount(w); unsigned keep;
            if (take >= c) { keep = w; take -= c; } else { keep = 0u; for (int k = 0; k < take; ++k) { const unsigned low = w & (0u - w); keep |= low; w ^= low; } take = 0; }
            fw[i] |= keep; cl2 += __builtin_popcount(fw[i]); }
        const int inc2 = wave_incl_scan(cl2);
        int pos = inc2 - cl2; const int cnt = __builtin_amdgcn_readlane(inc2, 63);
        LAS unsigned short* lp = LIST + rq * 256;
#pragma unroll
        for (int i = 0; i < 8; ++i) { unsigned w = fw[i]; while (w) { const int b = __builtin_ctz(w); if (pos < 256) lp[pos] = (unsigned short)(256 * lane + 32 * i + b); ++pos; w &= w - 1u; } }
        LDS_WAIT(); asm volatile("" ::: "memory");
        (void)cnt;
        *(u32x2*)(P.SEL + (size_t)t * 256 + 4 * lane) = *(const LAS u32x2*)(lp + 4 * lane);
    }
}

struct Args { const float* in[18]; float* out; unsigned char* ws; int ph_lo, ph_hi; };
constexpr int NPH = 13;

typedef const __attribute__((address_space(4))) unsigned long long* kargp_t;
#define KARGS() kargp_t kargs = (kargp_t)__builtin_amdgcn_kernarg_segment_ptr(); asm volatile("" : "+s"(kargs)); GAS unsigned char* const ws = (GAS unsigned char*)kargs[19]; (void)ws
#define KIN(i) ((const float*)(const GAS float*)kargs[(i)])
#define KOUT() ((float*)(GAS float*)kargs[18])
#define WSP(T, off) ((T*)(GAS T*)(ws + (off)))
__global__ void __launch_bounds__(NTHR, 2) fwd_kernel(Args a) {
    extern __shared__ __attribute__((aligned(16))) unsigned char lds_raw[];
    LAS unsigned char* lds = (LAS unsigned char*)lds_raw;
    const int lo = a.ph_lo, hi = a.ph_hi;
    { int tid0 = threadIdx.x; asm volatile("" : "+v"(tid0)); for (int u = tid0; u < (LDS_BYTES - MISC_OFF) / 4; u += NTHR) ((LAS unsigned*)(lds + MISC_OFF))[u] = 0u; }
    SYNC();
    XcdBarrier bar; bar.bar = nullptr; bar.x = 0; bar.st = nullptr;
    if (hi - lo > 1) { KARGS(); bar = xcd_barrier_post((unsigned*)(GAS unsigned*)(ws + WS_CTL) + CW_BAR, (volatile LAS unsigned*)(lds + MISC_OFF) + 8); }
#define IN(k) (lo <= (k) && (k) < hi)
#define SEAM(k) do { if (IN(k) && IN((k) + 1)) xcd_barrier(bar); } while (0)
#define IDS() const int tid = threadIdx.x, lane = tid & 63, wave = __builtin_amdgcn_readfirstlane(tid >> 6), G = gridDim.x, bid = blockIdx.x; (void)lane; (void)wave; (void)G; (void)bid

    for (int rep_ph = 0; rep_ph < ((REP_PH == 0) ? 2 : 1); ++rep_ph) if (IN(0)) { KARGS(); IDS();
        P0Ptrs P{KIN(1), KIN(2), KIN(5), KIN(8), KIN(9), KIN(11), KIN(12), KIN(14), KIN(17), KIN(10), WSP(bf16_t, WS_WIN), WSP(bf16_t, WS_WATTN), WSP(bf16_t, WS_WGRP), WSP(bf16_t, WS_WPOOL), WSP(bf16_t, WS_WOUT),
                 WSP(bf16_t, WS_WUP), WSP(bf16_t, WS_WDOWN), WSP(float, WS_MODP)};
        p0_prologue(P, lds, bid * NWAVES + wave, G * NWAVES, wave, lane);
    }
    SEAM(0);
    if (IN(1)) { KARGS(); IDS();
        const float *b_ada = KIN(3), *norm1_g = KIN(4); const float* MODP = WSP(float, WS_MODP); float* MODF = WSP(float, WS_MODF);
        {
            pg8::Gemm g{WSP(bf16_t, WS_WPOOL), WSP(bf16_t, WS_WGRP), 1024, PW, PW}; pg8::StaticOrder S; S.init(1024, PW, G, bid);
            EpiBf<3> E{WSP(bf16_t, WS_POOLMIX), PW, nullptr, nullptr};
            pg8::gemm_phase<EpiBf<3>, pg8::StaticOrder, true, true>(lds, g, S, E);
            SYNC();
        }
        LAS float* mulv = (LAS float*)lds; LAS float* addv = mulv + 1024;
        for (int i = tid; i < 1024; i += NTHR) { float sh = b_ada[i], scv = b_ada[1024 + i];
#pragma unroll
            for (int kc = 0; kc < 16; ++kc) { sh += MODP[kc * NMOD + i]; scv += MODP[kc * NMOD + 1024 + i]; }
            mulv[i] = norm1_g[i] * (1.0f + scv); addv[i] = sh; }
        if (bid < 24 && tid < 256) { const int i = bid * 256 + tid; float v = b_ada[i];
#pragma unroll
            for (int kc = 0; kc < 16; ++kc) v += MODP[kc * NMOD + i];
            MODF[i] = v; }
        SYNC();
        modulate_rows(KIN(0), WSP(bf16_t, WS_H), mulv, addv, bid * NWAVES + wave, G * NWAVES, lane);
        SYNC();
    }
    SEAM(1);
    for (int rep_ph = 0; rep_ph < ((REP_PH == 2) ? 2 : 1); ++rep_ph) if (IN(2)) { KARGS(); IDS();
        pg8::Gemm g{WSP(bf16_t, WS_H), WSP(bf16_t, WS_WIN), M, NINP, DM}; pg8::StaticOrder S; S.init(M, NINP, G, bid);
        EpiProj E{WSP(bf16_t, WS_Q), WSP(unsigned char, WS_K), WSP(unsigned char, WS_K), WSP(bf16_t, WS_QI), WSP(bf16_t, WS_KI), WSP(bf16_t, WS_UPOOL), WSP(bf16_t, WS_GA), WSP(bf16_t, WS_GP), WSP(float, WS_WI), KIN(6), KIN(7)};
        pg8::gemm_phase<EpiProj, pg8::StaticOrder, true, true>(lds, g, S, E);
    }
    SEAM(2);
    if (IN(3)) { KARGS(); IDS();
        pooled_phase(WSP(bf16_t, WS_UPOOL), WSP(bf16_t, WS_POOLED), bid * NTHR + tid, G * NTHR);
        TkPtrs T{WSP(bf16_t, WS_QI), WSP(bf16_t, WS_KI), WSP(float, WS_WI), (unsigned short*)KOUT()};
        unsigned* qctr = (unsigned*)(GAS unsigned*)(ws + WS_CTL) + CW_QUEUE;
        LAS int* qslot = (LAS int*)(lds + ST_OFF + 2040);
#pragma unroll 1
        for (;;) {
            SYNC();
            if (tid == 0) *qslot = (int)__hip_atomic_fetch_add(qctr, 1u, __ATOMIC_RELAXED, __HIP_MEMORY_SCOPE_AGENT);
            SYNC();
            const int qi = *qslot;
            if (qi >= 512 * (1 + REP_TKONLY)) break;
            topk_attn_block(511 - (qi & 511), T, lds, tid, wave, lane, qi >= 512 * REP_TKONLY);
        }
        SYNC();
    }
    SEAM(3);
    if (IN(4)) { KARGS(); IDS();
        const unsigned short* SEL = (const unsigned short*)KOUT(); const bf16_t* Qp = WSP(bf16_t, WS_Q); const unsigned char *K8 = WSP(unsigned char, WS_K), *V8 = WSP(unsigned char, WS_K); bf16_t* ATTN = WSP(bf16_t, WS_ATTN);
        const bool aff = (G & 7) == 0; const int nitem = 8 * M, step = aff ? (G >> 3) * NWAVES : G * NWAVES;
#pragma unroll 1
        for (int it = aff ? (bid >> 3) * NWAVES + wave : bid * NWAVES + wave; it < (aff ? M : nitem); it += step) attn_item(aff ? it : (it >> 3), aff ? (bid & 7) : (it & 7), SEL, Qp, K8, V8, ATTN, lane);
    }
    SEAM(4);
    if (IN(6)) { KARGS(); IDS();
        pg8::Gemm g{WSP(bf16_t, WS_POOLED), WSP(bf16_t, WS_POOLMIX), M, DM, PW}; pg8::StaticOrder S; S.init(M, DM, G, bid);
        EpiBf<1> E{WSP(bf16_t, WS_GP), DM, nullptr, nullptr};
        pg8::gemm_phase<EpiBf<1>, pg8::StaticOrder, true, true>(lds, g, S, E);
    }
    SEAM(6);
    if (IN(7)) { KARGS(); IDS();
        pg8::Gemm g{WSP(bf16_t, WS_ATTN), WSP(bf16_t, WS_WATTN), M, DM, AW}; pg8::StaticOrder S; S.init(M, DM, G, bid);
        EpiBf<2> E{WSP(bf16_t, WS_GA), DM, nullptr, WSP(bf16_t, WS_GP)};
        pg8::gemm_phase<EpiBf<2>, pg8::StaticOrder, true, true>(lds, g, S, E);
    }
    SEAM(7);
    for (int rep_ph = 0; rep_ph < ((REP_PH == 8) ? 2 : 1); ++rep_ph) if (IN(8)) { KARGS(); IDS();
        pg8::Gemm g{WSP(bf16_t, WS_GA), WSP(bf16_t, WS_WOUT), M, DM, DM}; pg8::StaticOrder S; S.init(M, DM, G, bid);
        EpiRes E{KIN(0), KOUT(), WSP(float, WS_MODF) + 2048, 0.f};
        pg8::gemm_phase<EpiRes, pg8::StaticOrder, true, true>(lds, g, S, E);
    }
    SEAM(8);
    if (IN(9)) { KARGS(); IDS();
        const float* norm2_g = KIN(13); const float* MODF = WSP(float, WS_MODF);
        LAS float* mulv = (LAS float*)lds; LAS float* addv = mulv + 1024;
        for (int i = tid; i < 1024; i += NTHR) { mulv[i] = norm2_g[i] * (1.0f + MODF[4096 + i]); addv[i] = MODF[3072 + i]; }
        SYNC();
        modulate_rows(KOUT(), WSP(bf16_t, WS_H), mulv, addv, bid * NWAVES + wave, G * NWAVES, lane);
        SYNC();
    }
    SEAM(9);
    for (int rep_ph = 0; rep_ph < ((REP_PH == 10) ? 2 : 1); ++rep_ph) if (IN(10)) { KARGS(); IDS();
        pg8::Gemm g{WSP(bf16_t, WS_H), WSP(bf16_t, WS_WUP), M, FF2, DM}; pg8::StaticOrder S; S.init(M, FF2, G, bid);
        EpiUpAct E{WSP(bf16_t, WS_ACT), WSP(float, WS_RAW), KIN(15), KIN(16)};
        pg8::gemm_phase<EpiUpAct, pg8::StaticOrder, true, true>(lds, g, S, E);
    }
    SEAM(10);
    if (IN(11)) { KARGS(); IDS(); fixup_phase(WSP(float, WS_RAW), WSP(bf16_t, WS_ACT), KIN(15), KIN(16), bid * NTHR + tid, G * NTHR); }
    SEAM(11);
    if (IN(12)) { KARGS(); IDS();
        pg8::Gemm g{WSP(bf16_t, WS_ACT), WSP(bf16_t, WS_WDOWN), M, DM, FF}; pg8::StaticOrder S; S.init(M, DM, G, bid);
        EpiRes E{KOUT(), KOUT(), WSP(float, WS_MODF) + 5120, DBG_C};
        pg8::gemm_phase<EpiRes, pg8::StaticOrder, true, true>(lds, g, S, E);
    }
#undef IN
#undef SEAM
}

extern "C" void kernel_launch(void* const* d_in, const int* in_sizes, int n_in, void* d_out, int out_size, void* d_ws, size_t ws_size, hipStream_t stream) {
    static int grid = 0;
    if (grid == 0) {
        if (n_in != 18 || in_sizes[0] != M * DM || out_size != M * DM || ws_size < WS_END) { fprintf(stderr, "kernel_launch: unexpected shapes (n_in %d, in0 %d, out %d, ws %zu)\n", n_in, n_in > 0 ? in_sizes[0] : -1, out_size, ws_size); grid = -1; return; }
        int dev = 0, cus = 0, per_cu = 0;
        if (hipGetDevice(&dev) != hipSuccess || hipDeviceGetAttribute(&cus, hipDeviceAttributeMultiprocessorCount, dev) != hipSuccess) { grid = -1; return; }
        if (hipFuncSetAttribute((const void*)fwd_kernel, hipFuncAttributeMaxDynamicSharedMemorySize, LDS_BYTES) != hipSuccess) { fprintf(stderr, "kernel_launch: hipFuncSetAttribute failed\n"); grid = -1; return; }
        if (hipOccupancyMaxActiveBlocksPerMultiprocessor(&per_cu, (const void*)fwd_kernel, NTHR, LDS_BYTES) != hipSuccess || per_cu < 1) fprintf(stderr, "kernel_launch: occupancy query says %d\n", per_cu);
        (void)hipGetLastError();
        grid = cus;
    }
    if (grid < 0) return;
    (void)hipMemsetAsync((char*)d_ws + WS_CTL, 0, CTL_ZERO_BYTES, stream);
    Args a{};
    for (int i = 0; i < 18; ++i) a.in[i] = (const float*)d_in[i];
    a.out = (float*)d_out; a.ws = (unsigned char*)d_ws;
#if N_LAUNCH_MODE == 1
    a.ph_lo = 0; a.ph_hi = NPH;
    hipLaunchKernelGGL(fwd_kernel, dim3(grid), dim3(NTHR), LDS_BYTES, stream, a);
#else
    for (int p = 0; p < NPH; ++p) { a.ph_lo = p; a.ph_hi = p + 1; hipLaunchKernelGGL(fwd_kernel, dim3(grid), dim3(NTHR), LDS_BYTES, stream, a); }
#endif
}
```

```cpp
#ifndef REP_TKONLY
#define REP_TKONLY 0
#endif
#ifndef REP_BLK
#define REP_BLK 1
#endif
#include <hip/hip_runtime.h>
#include <cstdio>
#include <cstdint>
namespace pg8 {
#define PG8_LAS __attribute__((address_space(3)))
typedef unsigned short bf16_t;
typedef short bf16x8 __attribute__((ext_vector_type(8)));
typedef float f32x4 __attribute__((ext_vector_type(4)));
typedef unsigned u32x4 __attribute__((ext_vector_type(4)));
constexpr int BM = 256, BK = 64, HALF = 128, HTB = HALF * BK * 2  , STAGE_BYTES = 8 * HTB, NXCD = 8, WGM = 8;

__host__ __device__ __forceinline__ int lds_byte(int r, int c) { const int st = (r >> 4) * 2 + (c >> 5), rr = r & 15, cc = c & 31, ob = rr * 64 + cc * 2; return st * 1024 + (ob ^ (((ob >> 9) & 1) << 5)); }
__host__ __device__ __forceinline__ void stage_rc(int b, int& R, int& C) { const int st = b / 1024, sb = b % 1024, swz = sb ^ (((sb >> 9) & 1) << 5); R = (st >> 1) * 16 + swz / 64; C = (st & 1) * 32 + (swz % 64) / 2; }
__host__ __device__ __forceinline__ int perm32(int rho) { const int n = rho >> 4, i = rho & 15; return 8 * (i >> 2) + 4 * n + (i & 3); }

struct Unit { int pm, pn; };
struct Gemm { const bf16_t* A; const bf16_t* Bt; int M, N, K; };

struct StaticOrder {
    int nM, nN, nwg, G, c;
    __host__ __device__ void init(int M, int N, int G_, int c_) { nM = M / BM; nN = N / BM; nwg = nM * nN; G = G_; c = c_; }
    __host__ __device__ bool next(int i, Unit& u) const {
        const long L = (long)i * G + c; if (L >= nwg) return false;
        int wgid = (int)L; { const int q = nwg / NXCD, r = nwg % NXCD, xcd = wgid % NXCD, off = wgid / NXCD; wgid = (xcd < r ? xcd * (q + 1) : r * (q + 1) + (xcd - r) * q) + off; }
        const int nig = WGM * nN, gid = wgid / nig, fm = gid * WGM, gsz = (nM - fm) < WGM ? (nM - fm) : WGM;
        u.pm = fm + ((wgid % nig) % gsz); u.pn = (wgid % nig) / gsz; return true;
    }
    __device__ __forceinline__ void a_ready(const Unit&) const {}
    __device__ __forceinline__ void done(const Unit&) const {}
};

__device__ __forceinline__ unsigned cvt_pk_bf16(float lo, float hi) { unsigned r; asm volatile("v_cvt_pk_bf16_f32 %0, %1, %2" : "=v"(r) : "v"(lo), "v"(hi)); return r; }
template <class Epi, class Sched, bool ALIGN_EPI = false, bool SP2 = false>
__device__ __forceinline__ void gemm_phase(PG8_LAS unsigned char* lds, const Gemm g, const Sched& S, const Epi& E) {
    int tid_ = threadIdx.x; asm volatile("" : "+v"(tid_));
    const int tid = tid_, wid = __builtin_amdgcn_readfirstlane(tid >> 6), lane = tid & 63, wr = wid >> 2, wc = wid & 3, fr = lane & 15, fq = lane >> 4;
    const int K = g.K, nt = K / BK;
    unsigned voffA[2], voffB[2];
#pragma unroll
    for (int i = 0; i < 2; ++i) { int R, C; stage_rc(tid * 16 + i * 8192, R, C); const int Rb = Epi::PERM ? ((R & ~31) + perm32(R & 31)) : R;
        voffA[i] = (unsigned)(R * K + C) * 2u; voffB[i] = (unsigned)(Rb * K + C) * 2u; }
    const size_t kstep = (size_t)(BK * 2);
    const size_t hstep = (size_t)HALF * K * 2;
    const size_t tstep = 2 * hstep;
    const unsigned ldsw = (unsigned)wid * 1024u;
    const int aoff = lds_byte(wr * 64 + fr, fq * 8), boff = lds_byte(wc * 32 + fr, fq * 8);
#define PG8_SA(b, h) (((b) * 2 + (h)) * HTB)
#define PG8_SB(b, h) ((4 + (b) * 2 + (h)) * HTB)
#define PG8_STAGE(bufoff, gbase, voff) do { _Pragma("unroll") for (int _i = 0; _i < 2; ++_i) \
        __builtin_amdgcn_global_load_lds((const unsigned*)((const char*)(gbase) + (voff)[_i]), (PG8_LAS unsigned*)(lds + (bufoff) + ldsw + _i * 8192), 16, 0, 0); } while (0)
#define PG8_LDA(dst, b, h) do { _Pragma("unroll") for (int m = 0; m < 4; ++m) _Pragma("unroll") for (int k = 0; k < 2; ++k) dst[m][k] = *(const PG8_LAS bf16x8*)(lds + PG8_SA(b, h) + aoff + m * 2048 + k * 1024); } while (0)
#define PG8_LDB(dst, b, h) do { _Pragma("unroll") for (int n = 0; n < 2; ++n) _Pragma("unroll") for (int k = 0; k < 2; ++k) dst[n][k] = *(const PG8_LAS bf16x8*)(lds + PG8_SB(b, h) + boff + n * 2048 + k * 1024); } while (0)
#define PG8_MMA(ai, bj, At, Bt) do { __builtin_amdgcn_s_setprio(1); _Pragma("unroll") for (int m = 0; m < 4; ++m) _Pragma("unroll") for (int n = 0; n < 2; ++n) _Pragma("unroll") for (int k = 0; k < 2; ++k) \
        acc[ai][bj][m][n] = __builtin_amdgcn_mfma_f32_16x16x32_bf16(Bt[n][k], At[m][k], acc[ai][bj][m][n], 0, 0, 0); __builtin_amdgcn_s_setprio(0); } while (0)
#define PG8_WAIT_V(n) asm volatile("s_waitcnt vmcnt(" #n ")" ::: "memory")
#define PG8_WAIT_L(n) asm volatile("s_waitcnt lgkmcnt(" #n ")" ::: "memory")
#define PG8_BAR __builtin_amdgcn_s_barrier()
#define PG8_SCHED __builtin_amdgcn_sched_barrier(0)
    Unit cur, nxt; int ui = 0;
    if (!S.next(0, cur)) return;
    f32x4 acc[2][2][4][2];
#pragma unroll
    for (int a = 0; a < 2; ++a)
#pragma unroll
        for (int b = 0; b < 2; ++b)
#pragma unroll
            for (int m = 0; m < 4; ++m)
#pragma unroll
                for (int n = 0; n < 2; ++n) acc[a][b][m][n] = (f32x4){0.f, 0.f, 0.f, 0.f};
    bf16x8 At[4][2], B0[2][2], B1[2][2];
    const char* cA = (const char*)g.A + (size_t)cur.pm * tstep; const char* cB = (const char*)g.Bt + (size_t)cur.pn * tstep;
    S.a_ready(cur);
    if constexpr (SP2) {
        PG8_STAGE(PG8_SB(0, 0), cB, voffB); PG8_STAGE(PG8_SB(0, 1), cB + hstep, voffB); PG8_STAGE(PG8_SA(0, 0), cA, voffA); PG8_STAGE(PG8_SA(0, 1), cA + hstep, voffA);
        if (wr == 1) PG8_BAR;
        PG8_WAIT_V(2); PG8_BAR;
        PG8_STAGE(PG8_SB(1, 0), cB + kstep, voffB); PG8_STAGE(PG8_SA(1, 0), cA + kstep, voffA); PG8_STAGE(PG8_SB(1, 1), cB + hstep + kstep, voffB);
        PG8_WAIT_V(6); PG8_BAR;
    } else {
        PG8_STAGE(PG8_SB(0, 0), cB, voffB); PG8_STAGE(PG8_SA(0, 0), cA, voffA); PG8_STAGE(PG8_SB(0, 1), cB + hstep, voffB); PG8_STAGE(PG8_SA(0, 1), cA + hstep, voffA);
        if (wr == 1) PG8_BAR;
        PG8_WAIT_V(4); PG8_BAR;
        PG8_STAGE(PG8_SB(1, 0), cB + kstep, voffB); PG8_STAGE(PG8_SA(1, 0), cA + kstep, voffA); PG8_STAGE(PG8_SB(1, 1), cB + hstep + kstep, voffB);
        PG8_WAIT_V(6); PG8_BAR;
    }
    for (;;) {
        const bool has_next = S.next(ui + 1, nxt);
        const char* nA = has_next ? (const char*)g.A + (size_t)nxt.pm * tstep : cA; const char* nB = has_next ? (const char*)g.Bt + (size_t)nxt.pn * tstep : cB;
        for (int t = 0; t < nt; t += 2) {
            const bool last = (t == nt - 2);
            const char* a1 = cA + (size_t)(t + 1) * kstep;
            const char* a2 = last ? nA : cA + (size_t)(t + 2) * kstep; const char* b2 = last ? nB : cB + (size_t)(t + 2) * kstep;
            const char* a3 = a2 + kstep; const char* b3 = b2 + kstep;
            if (last && has_next) S.a_ready(nxt);
            if constexpr (SP2) {
            PG8_LDB(B0, 0, 0); PG8_LDB(B1, 0, 1); PG8_SCHED; PG8_LDA(At, 0, 0); PG8_STAGE(PG8_SA(1, 1), a1 + hstep, voffA);
            PG8_WAIT_V(8); PG8_WAIT_L(0); PG8_BAR; PG8_MMA(0, 0, At, B0); PG8_MMA(0, 1, At, B1); PG8_BAR; PG8_SCHED;
            PG8_LDA(At, 0, 1); PG8_STAGE(PG8_SB(0, 0), b2, voffB); PG8_STAGE(PG8_SB(0, 1), b2 + hstep, voffB); PG8_STAGE(PG8_SA(0, 0), a2, voffA);
            PG8_WAIT_V(8); PG8_WAIT_L(0); PG8_BAR; PG8_MMA(1, 0, At, B0); PG8_MMA(1, 1, At, B1); PG8_BAR; PG8_SCHED;
            PG8_LDB(B0, 1, 0); PG8_LDB(B1, 1, 1); PG8_SCHED; PG8_LDA(At, 1, 0); PG8_STAGE(PG8_SA(0, 1), a2 + hstep, voffA);
            PG8_WAIT_V(8); PG8_WAIT_L(0); PG8_BAR; PG8_MMA(0, 0, At, B0); PG8_MMA(0, 1, At, B1); PG8_BAR; PG8_SCHED;
            PG8_LDA(At, 1, 1); PG8_STAGE(PG8_SB(1, 0), b3, voffB); PG8_STAGE(PG8_SB(1, 1), b3 + hstep, voffB); PG8_STAGE(PG8_SA(1, 0), a3, voffA);
            PG8_WAIT_V(8); PG8_WAIT_L(0); PG8_BAR; PG8_MMA(1, 0, At, B0); PG8_MMA(1, 1, At, B1); PG8_BAR; PG8_SCHED;
            } else {
            PG8_LDB(B0, 0, 0); PG8_SCHED; PG8_LDA(At, 0, 0); PG8_STAGE(PG8_SA(1, 1), a1 + hstep, voffA);
            PG8_WAIT_L(8); PG8_BAR; PG8_WAIT_L(0); PG8_MMA(0, 0, At, B0); PG8_BAR; PG8_SCHED;
            PG8_LDB(B1, 0, 1); PG8_STAGE(PG8_SB(0, 0), b2, voffB);
            PG8_BAR; PG8_WAIT_L(0); PG8_MMA(0, 1, At, B1); PG8_BAR;
            PG8_LDA(At, 0, 1); PG8_STAGE(PG8_SA(0, 0), a2, voffA);
            PG8_BAR; PG8_WAIT_L(0); PG8_MMA(1, 0, At, B0); PG8_BAR; PG8_SCHED;
            PG8_STAGE(PG8_SB(0, 1), b2 + hstep, voffB);
            PG8_WAIT_V(6); PG8_BAR; PG8_MMA(1, 1, At, B1); PG8_BAR;
            PG8_LDB(B0, 1, 0); PG8_SCHED; PG8_LDA(At, 1, 0); PG8_STAGE(PG8_SA(0, 1), a2 + hstep, voffA);
            PG8_WAIT_L(8); PG8_BAR; PG8_WAIT_L(0); PG8_MMA(0, 0, At, B0); PG8_BAR; PG8_SCHED;
            PG8_LDB(B1, 1, 1); PG8_STAGE(PG8_SB(1, 0), b3, voffB);
            PG8_BAR; PG8_WAIT_L(0); PG8_MMA(0, 1, At, B1); PG8_BAR;
            PG8_LDA(At, 1, 1); PG8_STAGE(PG8_SA(1, 0), a3, voffA);
            PG8_BAR; PG8_WAIT_L(0); PG8_MMA(1, 0, At, B0); PG8_BAR; PG8_SCHED;
            PG8_STAGE(PG8_SB(1, 1), b3 + hstep, voffB);
            PG8_WAIT_V(6); PG8_BAR; PG8_MMA(1, 1, At, B1); PG8_BAR;
            }
        }
        if constexpr (ALIGN_EPI) { if (wr == 0) PG8_BAR; }
        if constexpr (!Epi::AFTER_DRAIN) { E(acc, cur, wr, wc, fr, fq); S.done(cur); }
        if (!has_next) break;
#pragma unroll
        for (int a = 0; a < 2; ++a)
#pragma unroll
            for (int b = 0; b < 2; ++b)
#pragma unroll
                for (int m = 0; m < 4; ++m)
#pragma unroll
                    for (int n = 0; n < 2; ++n) acc[a][b][m][n] = (f32x4){0.f, 0.f, 0.f, 0.f};
        cur = nxt; cA = nA; cB = nB; ++ui;
        if constexpr (ALIGN_EPI) { if (wr == 1) PG8_BAR; }
    }
    PG8_WAIT_V(0);
    if constexpr (!ALIGN_EPI) { if (wr == 0) PG8_BAR; }
    PG8_BAR;
    if constexpr (Epi::AFTER_DRAIN) { E.fused(acc, cur, wr, wc, fr, fq, lds, wid, lane); S.done(cur); }
#undef PG8_SA
#undef PG8_SB
#undef PG8_STAGE
#undef PG8_LDA
#undef PG8_LDB
#undef PG8_MMA
#undef PG8_WAIT_V
#undef PG8_WAIT_L
#undef PG8_BAR
#undef PG8_SCHED
}
}
#define GAS __attribute__((address_space(1)))
#define LAS __attribute__((address_space(3)))
typedef unsigned short bf16;
typedef unsigned v4u __attribute__((ext_vector_type(4)));
typedef float f32x4 __attribute__((ext_vector_type(4)));
typedef short bf16x8 __attribute__((ext_vector_type(8)));
typedef GAS unsigned gu32;
typedef GAS unsigned long long gu64;
#define RLX_AGENT __ATOMIC_RELAXED, __HIP_MEMORY_SCOPE_AGENT
#define LDS_WAIT() asm volatile("s_waitcnt lgkmcnt(0)" ::: "memory")
#define VM_WAIT() asm volatile("s_waitcnt vmcnt(0)" ::: "memory")
__device__ __forceinline__ unsigned long long rt() { return __builtin_amdgcn_s_memrealtime(); }
__device__ __forceinline__ unsigned f2bf(float f) { unsigned u = __builtin_bit_cast(unsigned, f); return (u + 0x7fffu + ((u >> 16) & 1u)) >> 16; }
__device__ __forceinline__ unsigned pk2(float lo, float hi) { return f2bf(lo) | (f2bf(hi) << 16); }

#define XB_TMO      128
#define XB_XCNT(j)  (256  + 64 * (j))
#define XB_XSUB(j)  (1280 + 64 * (j))
#define XB_XGEN(j)  (2304 + 64 * (j))
#define XB_TOP      3328
#define XB_TOPGEN   3392
#define XCD_BAR_WORDS 3456
#define XB_SPIN_CAP (1u << 18)

__device__ __forceinline__ unsigned xb_ld(unsigned* p)              { return __hip_atomic_load(p, __ATOMIC_RELAXED, __HIP_MEMORY_SCOPE_AGENT); }
__device__ __forceinline__ unsigned xb_add(unsigned* p, unsigned v) { return __hip_atomic_fetch_add(p, v, __ATOMIC_RELAXED, __HIP_MEMORY_SCOPE_AGENT); }
__device__ __forceinline__ unsigned xb_xcc_id() { return (unsigned)__builtin_amdgcn_s_getreg((3 << 11) | 20) & 0xFu; }
#define XB_SPIN(cond, bar) do { unsigned _sp = 0; while (cond) { __builtin_amdgcn_s_sleep(1); \
    if ((++_sp & 255u) == 0u) { if (xb_ld(&(bar)[XB_TMO])) break; if (_sp > XB_SPIN_CAP) { atomicAdd(&(bar)[XB_TMO], 1u); break; } } } } while (0)

struct XcdBarrier {
    unsigned* bar; unsigned x;
    volatile LAS unsigned* st;
};

__device__ __forceinline__ XcdBarrier xcd_barrier_post(unsigned* bar, volatile LAS unsigned* st) {
    XcdBarrier b; b.bar = bar; b.x = xb_xcc_id(); b.st = st;
    if (threadIdx.x == 0) (void)xb_add(&bar[XB_XCNT(b.x)], 1u);
    return b;
}
__device__ __forceinline__ void xcd_barrier_complete(unsigned* bar, unsigned x, unsigned& nloc, unsigned& nx) {
    const unsigned G = gridDim.x * gridDim.y * gridDim.z;
    unsigned sum, cnt, mine, sp = 0u;
    for (;;) {
        sum = 0u; cnt = 0u; mine = 0u;
#pragma unroll
        for (unsigned j = 0; j < 16; ++j) { const unsigned c = xb_ld(&bar[XB_XCNT(j)]); sum += c; cnt += (c > 0u) ? 1u : 0u; mine = (j == x) ? c : mine; }
        if (sum == G) break;
        __builtin_amdgcn_s_sleep(1);
        if ((++sp & 255u) == 0u) { if (xb_ld(&bar[XB_TMO])) break; if (sp > XB_SPIN_CAP) { atomicAdd(&bar[XB_TMO], 1u); break; } }
    }
    nloc = mine > 0u ? mine : 1u; nx = cnt > 0u ? cnt : 1u;
}

__device__ __forceinline__ void xcd_barrier(const XcdBarrier& b) {
    asm volatile("s_waitcnt vmcnt(0)" ::: "memory");
    __syncthreads();
    if (threadIdx.x == 0) {
        unsigned* bar = b.bar;
        __builtin_amdgcn_s_waitcnt(0);
        unsigned nloc = b.st[0], nx = b.st[1];
        if (nloc == 0u) { xcd_barrier_complete(bar, b.x, nloc, nx); b.st[0] = nloc; b.st[1] = nx; }
        const unsigned old = xb_add(&bar[XB_XSUB(b.x)], 1u);
        const unsigned gen = old / nloc;
        if (old + 1u == (gen + 1u) * nloc) {
            __builtin_amdgcn_fence(__ATOMIC_RELEASE, "agent");
            asm volatile("s_waitcnt vmcnt(0)" ::: "memory");
            const unsigned og = xb_add(&bar[XB_TOP], 1u);
            const unsigned tg = og / nx;
            if (og + 1u == (tg + 1u) * nx) xb_add(&bar[XB_TOPGEN], 1u);
            else XB_SPIN(xb_ld(&bar[XB_TOPGEN]) == tg, bar);
            __builtin_amdgcn_fence(__ATOMIC_ACQUIRE, "agent");
            xb_add(&bar[XB_XGEN(b.x)], 1u);
            asm volatile("s_waitcnt vmcnt(0)" ::: "memory");
        } else {
            XB_SPIN(xb_ld(&bar[XB_XGEN(b.x)]) == gen, bar);
            __builtin_amdgcn_fence(__ATOMIC_ACQUIRE, "agent");
            asm volatile("s_waitcnt vmcnt(0)" ::: "memory");
        }
    }
    __syncthreads();
}


#ifndef STAGE
#define STAGE 3
#endif
#ifndef N_LAUNCH_MODE
#define N_LAUNCH_MODE 1
#endif
#ifndef REP_TK
#define REP_TK 1
#endif
#ifndef REP_AT
#define REP_AT 1
#endif
#ifndef REP_PH
#define REP_PH -1
#endif
#ifndef TK_PREFETCH
#define TK_PREFETCH 1
#endif
#ifndef DBG_C
#define DBG_C 0.0f
#endif

typedef float f32x16 __attribute__((ext_vector_type(16)));
typedef __attribute__((ext_vector_type(2))) __bf16 bf16x2_t;
using pg8::bf16_t; using pg8::Unit;

constexpr int M = 16384, DM = 1024, NHEAD = 8, HD = 64, AW = 512, PW = 512, FF = 2816, FF2 = 5632, NIN = 4420, NINP = 4608, NMOD = 6144;
constexpr float EPS = 1e-6f;
constexpr int NWAVES = 8, NTHR = 512;

constexpr size_t MiB = 1u << 20;
constexpr size_t WS_CTL = 0, CTL_ZERO_BYTES = 64 * 1024;
constexpr size_t WS_WIN = 1 * MiB, WS_WATTN = 10 * MiB, WS_WGRP = 11 * MiB, WS_WPOOL = 11 * MiB + 512 * 1024, WS_WOUT = 12 * MiB + 512 * 1024,
                 WS_WUP = 14 * MiB + 512 * 1024, WS_WDOWN = 25 * MiB + 512 * 1024;
constexpr size_t WS_MODP = 31 * MiB, WS_MODF = 31 * MiB + 393216, WS_WI = 31 * MiB + 512 * 1024;
constexpr size_t WS_H = 32 * MiB;
constexpr size_t WS_Q = 64 * MiB, WS_K = 80 * MiB, WS_V = 96 * MiB;
constexpr size_t WS_SEL = 88 * MiB;
constexpr size_t WS_QI = 112 * MiB, WS_KI = 120 * MiB;
constexpr size_t WS_UPOOL = 128 * MiB, WS_POOLED = 144 * MiB, WS_POOLMIX = 160 * MiB, WS_ATTN = 176 * MiB;
constexpr size_t WS_GA = 192 * MiB, WS_GP = 224 * MiB;
constexpr size_t WS_ACT = 64 * MiB;
constexpr size_t WS_RAW = 152 * MiB;
constexpr size_t WS_END = 256 * MiB;
constexpr int CW_BAR = 1024, CW_QUEUE = 512;

constexpr int LDS_BYTES = 163840;
constexpr int HSTRIDE = 1025, MSTRIDE = 513;
constexpr int LIST_OFF = 135168, ST_OFF = 151552, MISC_OFF = 159744;

#define SYNC() __syncthreads()
__device__ __forceinline__ float wave_sum(float v) {
#pragma unroll
    for (int o = 1; o < 64; o <<= 1) v += __shfl_xor(v, o);
    return v;
}
__device__ __forceinline__ float bf_lo(unsigned w) { return __builtin_bit_cast(float, w << 16); }
__device__ __forceinline__ float bf_hi(unsigned w) { return __builtin_bit_cast(float, w & 0xffff0000u); }
__device__ __forceinline__ float sigmoidf_(float x) { return __builtin_amdgcn_rcpf(1.0f + __expf(-x)); }
__device__ __forceinline__ unsigned pkbf(float lo, float hi) { return pg8::cvt_pk_bf16(lo, hi); }
typedef unsigned u32x2 __attribute__((ext_vector_type(2)));
__device__ __forceinline__ u32x2 pk4(f32x4 v) { u32x2 r; r.x = pkbf(v[0], v[1]); r.y = pkbf(v[2], v[3]); return r; }
__device__ __forceinline__ unsigned pk4_fp8(f32x4 v) { int w = 0; w = __builtin_amdgcn_cvt_pk_fp8_f32(v[0], v[1], w, false); w = __builtin_amdgcn_cvt_pk_fp8_f32(v[2], v[3], w, true); return (unsigned)w; }

__device__ __forceinline__ void tr_item(const float* W, int ldw, int src_col, int nvalid, int k0, bf16_t* WT, int K, int dst_row, LAS float* scr, int lane) {
    f32x4 v[8];
#pragma unroll
    for (int i = 0; i < 8; ++i) { const int kk = 8 * i + (lane >> 3), n4 = 4 * (lane & 7);
        v[i] = (f32x4){0.f, 0.f, 0.f, 0.f}; if (W != nullptr && n4 < nvalid) v[i] = *(const f32x4*)(W + (size_t)(k0 + kk) * ldw + src_col + n4); }
#pragma unroll
    for (int i = 0; i < 8; ++i) { const int kk = 8 * i + (lane >> 3), n4 = 4 * (lane & 7); LAS float* p = scr + kk * 33 + n4; p[0] = v[i][0]; p[1] = v[i][1]; p[2] = v[i][2]; p[3] = v[i][3]; }
    LDS_WAIT(); asm volatile("" ::: "memory");
    const int c = lane & 7;
#pragma unroll
    for (int j = 0; j < 4; ++j) { const int n = (lane >> 3) + 8 * j; const LAS float* s = scr + (8 * c) * 33 + n;
        v4u o; o.x = pk2(s[0 * 33], s[1 * 33]); o.y = pk2(s[2 * 33], s[3 * 33]); o.z = pk2(s[4 * 33], s[5 * 33]); o.w = pk2(s[6 * 33], s[7 * 33]);
        *(GAS v4u*)(WT + (size_t)(dst_row + n) * K + k0 + 8 * c) = o; }
    LDS_WAIT(); asm volatile("" ::: "memory");
}

struct P0Ptrs { const float *c, *w_ada, *w_in, *w_attn, *w_grp, *w_pool, *w_out, *w_up, *w_down, *pscale; bf16_t *WIN, *WATTN, *WGRP, *WPOOL, *WOUT, *WUP, *WDOWN; float* MODP; };
__device__ __forceinline__ void p0_prologue(const P0Ptrs& P, LAS unsigned char* lds, int gw, int NGW, int wave, int lane) {
    LAS float* scr = (LAS float*)(lds + wave * 16384);
    LAS float* sil = (LAS float*)(lds + 131072);
    for (int i = threadIdx.x; i < 1024; i += NTHR) { const float cv = P.c[i]; sil[i] = cv / (1.0f + __expf(-cv)); }
    SYNC();
    constexpr int I_WIN = 144 * 16, I_WATTN = 32 * 8, I_WGRP = 128, I_WPOOL = 32 * 8, I_WOUT = 32 * 16, I_WUP = 176 * 16, I_WDOWN = 32 * 44, I_MOD = 96 * 16;
    constexpr int NITEMS = I_WIN + I_WATTN + I_WGRP + I_WPOOL + I_WOUT + I_WUP + I_WDOWN + I_MOD;
    for (int it = gw; it < NITEMS; it += NGW) {
        int r = it;
        if (r < I_MOD) {
            const int cb = r % 96, kc = r / 96, col = cb * 64 + lane; float acc = 0.f;
#pragma unroll 8
            for (int i = 0; i < 64; ++i) { const int k = kc * 64 + i; acc = fmaf(sil[k], P.w_ada[(size_t)k * NMOD + col], acc); }
            P.MODP[kc * NMOD + col] = acc; continue; }
        r -= I_MOD;
        if (r < I_WIN) { const int g = r / 16, kb = r % 16, tile = g >> 3, gi = g & 7; int src = -1, nv = 32;
            const int permgi = gi < 4 ? 64 * gi : 64 * (gi - 4) + 32;
            if (tile < 2) src = tile * 256 + permgi;
            else if (tile < 4) src = 512 + (tile - 2) * 256 + permgi;
            else if (tile < 6) src = 1024 + (tile - 4) * 256 + 32 * gi;
            else if (tile == 6) src = 1536 + 32 * gi;
            else if (tile == 7) { if (gi < 2) src = 1792 + 32 * gi; else if (gi == 2) { src = 1856; nv = 4; } }
            else if (tile < 10) src = 1860 + (tile - 8) * 256 + 32 * gi;
            else if (tile < 14) src = 2372 + (tile - 10) * 256 + 32 * gi;
            else src = 3396 + (tile - 14) * 256 + 32 * gi;
            tr_item(src >= 0 ? P.w_in : nullptr, NIN, src >= 0 ? src : 0, nv, kb * 64, P.WIN, 1024, g * 32, scr, lane); continue; }
        r -= I_WIN;
        if (r < I_WATTN) { tr_item(P.w_attn, 1024, (r / 8) * 32, 32, (r % 8) * 64, P.WATTN, 512, (r / 8) * 32, scr, lane); continue; }
        r -= I_WATTN;
        if (r < I_WGRP) {
            const int row = 4 * r + (lane >> 4), g = row >> 7; const float* src = P.w_grp + (size_t)g * 16384 + (size_t)(row & 127) * 128;
#pragma unroll
            for (int q = 0; q < 4; ++q) { const int d0 = 32 * (lane & 15) + 8 * q; v4u o = (v4u){0u, 0u, 0u, 0u};
                if ((d0 >> 7) == g) { const f32x4 a = *(const f32x4*)(src + (d0 & 127)) * *(const f32x4*)(P.pscale + d0), b = *(const f32x4*)(src + (d0 & 127) + 4) * *(const f32x4*)(P.pscale + d0 + 4);
                    o.x = pk2(a[0], a[1]); o.y = pk2(a[2], a[3]); o.z = pk2(b[0], b[1]); o.w = pk2(b[2], b[3]); }
                *(GAS v4u*)(P.WGRP + (size_t)row * 512 + d0) = o; }
            continue; }
        r -= I_WGRP;
        if (r < I_WPOOL) { tr_item(P.w_pool, 1024, (r / 8) * 32, 32, (r % 8) * 64, P.WPOOL, 512, (r / 8) * 32, scr, lane); continue; }
        r -= I_WPOOL;
        if (r < I_WOUT) { tr_item(P.w_out, 1024, (r / 16) * 32, 32, (r % 16) * 64, P.WOUT, 1024, (r / 16) * 32, scr, lane); continue; }
        r -= I_WOUT;
        if (r < I_WUP) { const int g = r / 16, kb = r % 16, tile = g >> 3, gi = g & 7;
            const int src = gi < 4 ? 128 * tile + 32 * gi : FF + 128 * tile + 32 * (gi - 4);
            tr_item(P.w_up, FF2, src, 32, kb * 64, P.WUP, 1024, g * 32, scr, lane); continue; }
        r -= I_WUP;
        { tr_item(P.w_down, 1024, (r / 44) * 32, 32, (r % 44) * 64, P.WDOWN, FF, (r / 44) * 32, scr, lane); }
    }
}

__device__ __forceinline__ void modulate_rows(const float* X, bf16_t* O, const LAS float* mulv, const LAS float* addv, int gw, int NGW, int lane) {
    f32x4 mu[4], ad[4];
#pragma unroll
    for (int j = 0; j < 4; ++j) { mu[j] = *(const LAS f32x4*)(mulv + 4 * lane + 256 * j); ad[j] = *(const LAS f32x4*)(addv + 4 * lane + 256 * j); }
    for (int row = gw; row < M; row += NGW) {
        const GAS f32x4* xr = (const GAS f32x4*)(X + (size_t)row * DM) + lane;
        f32x4 v[4]; float s = 0.f;
#pragma unroll
        for (int j = 0; j < 4; ++j) { v[j] = xr[64 * j]; s += (v[j].x * v[j].x + v[j].y * v[j].y) + (v[j].z * v[j].z + v[j].w * v[j].w); }
        const float rstd = 1.0f / sqrtf(wave_sum(s) * (1.0f / DM) + EPS);
        GAS u32x2* o8 = (GAS u32x2*)(O + (size_t)row * DM) + lane;
#pragma unroll
        for (int j = 0; j < 4; ++j) { const f32x4 y = v[j] * rstd * mu[j] + ad[j]; o8[64 * j] = pk4(y); }
    }
}

struct EpiProj {
    static constexpr bool PERM = false, AFTER_DRAIN = false;
    bf16_t *Q; unsigned char *K8, *V8; bf16_t *QI, *KI, *UPOOL, *GA, *GP; float* WI; const float *qg, *kg;
    __device__ __forceinline__ void operator()(const pg8::f32x4 (&acc)[2][2][4][2], const Unit& u, int wr, int wc, int fr, int fq) const {
        const int pn = u.pn, row0 = u.pm * 256 + wr * 64 + fr;
        if (pn < 4) {
            const bool isq = pn < 2; const float* g = isq ? qg : kg; const int head = (pn & 1) * 4 + wc;
            f32x4 gv[2][2];
#pragma unroll
            for (int bj = 0; bj < 2; ++bj)
#pragma unroll
                for (int n = 0; n < 2; ++n) gv[bj][n] = *(const f32x4*)(g + 32 * bj + 16 * n + 4 * fq);
#pragma unroll
            for (int ai = 0; ai < 2; ++ai)
#pragma unroll
                for (int m = 0; m < 4; ++m) {
                    float ss = 0.f;
#pragma unroll
                    for (int bj = 0; bj < 2; ++bj)
#pragma unroll
                        for (int n = 0; n < 2; ++n) { const f32x4 x = acc[ai][bj][m][n]; ss += (x[0] * x[0] + x[1] * x[1]) + (x[2] * x[2] + x[3] * x[3]); }
                    ss += __shfl_xor(ss, 16); ss += __shfl_xor(ss, 32);
                    const float rstd = 1.0f / sqrtf(ss * (1.0f / 64.0f) + EPS);
                    const size_t ro = (size_t)(row0 + ai * 128 + m * 16) * AW + head * 64 + 4 * fq;
#pragma unroll
                    for (int bj = 0; bj < 2; ++bj)
#pragma unroll
                        for (int n = 0; n < 2; ++n) { const f32x4 y = acc[ai][bj][m][n] * rstd * gv[bj][n];
                            if (isq) *(u32x2*)(Q + ro + 32 * bj + 16 * n) = pk4(y); else *(unsigned*)(K8 + ((size_t)head * M + (row0 + ai * 128 + m * 16)) * 128 + 4 * fq + 32 * bj + 16 * n) = pk4_fp8(y); }
                }
            return;
        }
        const int colw = wc * 32 + 4 * fq;
        if (pn == 7) {
#pragma unroll
            for (int ai = 0; ai < 2; ++ai)
#pragma unroll
                for (int m = 0; m < 4; ++m) { const int row = row0 + ai * 128 + m * 16;
                    if (wc < 2) {
#pragma unroll
                        for (int n = 0; n < 2; ++n) { const int c = colw + 16 * n; *(u32x2*)(KI + (size_t)(row >> 5) * 2048 + (c >> 4) * 512 + ((((c >> 3) & 1) * 32 + (row & 31)) * 8) + (c & 7)) = pk4(acc[ai][0][m][n]); }
                    } else if (wc == 2 && fq == 0) { *(f32x4*)(WI + (size_t)row * 4) = acc[ai][0][m][0] * 0.5f; }
                }
            return;
        }
        if (pn < 6) {
#pragma unroll
            for (int ai = 0; ai < 2; ++ai)
#pragma unroll
                for (int m = 0; m < 4; ++m) { const int row = row0 + ai * 128 + m * 16;
#pragma unroll
                    for (int bj = 0; bj < 2; ++bj)
#pragma unroll
                        for (int n = 0; n < 2; ++n) { const int col = (pn - 4) * 256 + colw + 128 * bj + 16 * n;
                            *(unsigned*)(V8 + ((size_t)(col >> 6) * M + row) * 128 + 64 + (col & 63)) = pk4_fp8(acc[ai][bj][m][n]); } }
            return;
        }
        bf16_t* O; int ldo, ct; float sc = 1.0f; bool sig = false;
        if (pn == 6) { O = QI; ldo = 256; ct = 0; sc = 0.125f; }
        else if (pn < 10) { O = UPOOL; ldo = PW; ct = (pn - 8) * 256; }
        else if (pn < 14) { O = GA; ldo = DM; ct = (pn - 10) * 256; sig = true; }
        else { O = GP; ldo = DM; ct = (pn - 14) * 256; sig = true; }
#pragma unroll
        for (int ai = 0; ai < 2; ++ai)
#pragma unroll
            for (int m = 0; m < 4; ++m) { bf16_t* rowp = O + (size_t)(row0 + ai * 128 + m * 16) * ldo + ct + colw;
#pragma unroll
                for (int bj = 0; bj < 2; ++bj)
#pragma unroll
                    for (int n = 0; n < 2; ++n) { f32x4 y = acc[ai][bj][m][n] * sc;
                        if (sig) { y[0] = sigmoidf_(y[0]); y[1] = sigmoidf_(y[1]); y[2] = sigmoidf_(y[2]); y[3] = sigmoidf_(y[3]); }
                        *(u32x2*)(rowp + 128 * bj + 16 * n) = pk4(y); }
            }
    }
};

template <int MODE> struct EpiBf {
    static constexpr bool PERM = false, AFTER_DRAIN = false;
    bf16_t* O; int ldo; const float* colscale; const bf16_t* ADD;
    __device__ __forceinline__ void operator()(const pg8::f32x4 (&acc)[2][2][4][2], const Unit& u, int wr, int wc, int fr, int fq) const {
        const int row0 = u.pm * 256 + wr * 64 + fr, col0 = u.pn * 256 + wc * 32 + 4 * fq;
#pragma unroll
        for (int ai = 0; ai < 2; ++ai)
#pragma unroll
            for (int m = 0; m < 4; ++m) { const size_t ro = (size_t)(row0 + ai * 128 + m * 16) * ldo + col0;
#pragma unroll
                for (int bj = 0; bj < 2; ++bj)
#pragma unroll
                    for (int n = 0; n < 2; ++n) { f32x4 y = acc[ai][bj][m][n]; const size_t off = ro + 128 * bj + 16 * n;
                        if (MODE == 3) { }
                        else if (MODE == 0) { y = y * *(const f32x4*)(colscale + col0 + 128 * bj + 16 * n); }
                        else { const u32x2 gq = *(const u32x2*)(O + off); y[0] *= bf_lo(gq.x); y[1] *= bf_hi(gq.x); y[2] *= bf_lo(gq.y); y[3] *= bf_hi(gq.y);
                            if (MODE == 2) { const u32x2 a = *(const u32x2*)(ADD + off); y[0] += bf_lo(a.x); y[1] += bf_hi(a.x); y[2] += bf_lo(a.y); y[3] += bf_hi(a.y); } }
                        *(u32x2*)(O + off) = pk4(y); }
            }
    }
};

struct EpiRes {
    static constexpr bool PERM = false, AFTER_DRAIN = false;
    const float* BASE; float* OUT; const float* gate; float dbg;
    __device__ __forceinline__ void operator()(const pg8::f32x4 (&acc)[2][2][4][2], const Unit& u, int wr, int wc, int fr, int fq) const {
        const int row0 = u.pm * 256 + wr * 64 + fr, col0 = u.pn * 256 + wc * 32 + 4 * fq;
        f32x4 gv[2][2];
#pragma unroll
        for (int bj = 0; bj < 2; ++bj)
#pragma unroll
            for (int n = 0; n < 2; ++n) gv[bj][n] = *(const f32x4*)(gate + col0 + 128 * bj + 16 * n);
#pragma unroll
        for (int ai = 0; ai < 2; ++ai)
#pragma unroll
            for (int m = 0; m < 4; ++m) { const int row = row0 + ai * 128 + m * 16; const size_t ro = (size_t)row * DM + col0;
#pragma unroll
                for (int bj = 0; bj < 2; ++bj)
#pragma unroll
                    for (int n = 0; n < 2; ++n) { const size_t off = ro + 128 * bj + 16 * n; f32x4 y = *(const f32x4*)(BASE + off) + gv[bj][n] * acc[ai][bj][m][n];
                        if (dbg != 0.f) { const float sg = ((row * 7 + (int)(off >> 2)) & 1) ? dbg : -dbg; y[0] += sg; y[1] -= sg; y[2] += sg; y[3] -= sg; }
                        *(f32x4*)(OUT + off) = y; }
            }
    }
};

template <int CTRL> __device__ __forceinline__ float dppf(float x) { return __builtin_bit_cast(float, __builtin_amdgcn_update_dpp(0, __builtin_bit_cast(int, x), CTRL, 0xf, 0xf, false)); }
__device__ __forceinline__ f32x4 ror1(f32x4 v) { f32x4 r; r[0] = dppf<0x121>(v[0]); r[1] = dppf<0x121>(v[1]); r[2] = dppf<0x121>(v[2]); r[3] = dppf<0x121>(v[3]); return r; }
__device__ __forceinline__ f32x4 ror2(f32x4 v) { f32x4 r; r[0] = dppf<0x122>(v[0]); r[1] = dppf<0x122>(v[1]); r[2] = dppf<0x122>(v[2]); r[3] = dppf<0x122>(v[3]); return r; }
__device__ __forceinline__ f32x4 silu_mul(f32x4 a, f32x4 b) { f32x4 r;
#pragma unroll
    for (int e = 0; e < 4; ++e) r[e] = a[e] * __builtin_amdgcn_rcpf(1.0f + __expf(-a[e])) * b[e];
    return r; }
struct EpiUpAct {
    static constexpr bool PERM = false, AFTER_DRAIN = false;
    bf16_t* ACT; float* RAW; const float* cw; const float* cb;
    __device__ __forceinline__ void operator()(const pg8::f32x4 (&acc)[2][2][4][2], const Unit& u, int wr, int wc, int fr, int fq) const {
#pragma unroll
        for (int n = 0; n < 2; ++n) {
            const int ch = u.pn * 128 + wc * 32 + 4 * fq + 16 * n;
            const f32x4 w0a = *(const f32x4*)(cw + ch), w1a = *(const f32x4*)(cw + FF2 + ch), w2a = *(const f32x4*)(cw + 2 * FF2 + ch), ba = *(const f32x4*)(cb + ch);
            const f32x4 w0b = *(const f32x4*)(cw + FF + ch), w1b = *(const f32x4*)(cw + FF2 + FF + ch), w2b = *(const f32x4*)(cw + 2 * FF2 + FF + ch), bb = *(const f32x4*)(cb + FF + ch);
#pragma unroll
            for (int ai = 0; ai < 2; ++ai) {
                const int blk = u.pm * 4 + ai * 2 + wr;
                if (fr < 2) { *(f32x4*)(RAW + (size_t)(blk * 4 + fr) * FF2 + ch) = acc[ai][0][0][n]; *(f32x4*)(RAW + (size_t)(blk * 4 + fr) * FF2 + FF + ch) = acc[ai][1][0][n]; }
                if (fr >= 14) { *(f32x4*)(RAW + (size_t)(blk * 4 + fr - 12) * FF2 + ch) = acc[ai][0][3][n]; *(f32x4*)(RAW + (size_t)(blk * 4 + fr - 12) * FF2 + FF + ch) = acc[ai][1][3][n]; }
                f32x4 pa1 = {0.f, 0.f, 0.f, 0.f}, pa2 = pa1, pb1 = pa1, pb2 = pa1;
#pragma unroll
                for (int m = 0; m < 4; ++m) {
                    const f32x4 va = acc[ai][0][m][n], vb = acc[ai][1][m][n];
                    const f32x4 ra1 = ror1(va), ra2 = ror2(va), rb1 = ror1(vb), rb2 = ror2(vb);
                    const f32x4 xa1 = fr >= 1 ? ra1 : pa1, xa2 = fr >= 2 ? ra2 : pa2, xb1 = fr >= 1 ? rb1 : pb1, xb2 = fr >= 2 ? rb2 : pb2;
                    pa1 = ra1; pa2 = ra2; pb1 = rb1; pb2 = rb2;
                    const f32x4 ya = ba + w0a * xa2 + w1a * xa1 + w2a * va, yb = bb + w0b * xb2 + w1b * xb1 + w2b * vb;
                    const f32x4 o = silu_mul(ya, yb);
                    if (!(m == 0 && fr < 2)) *(u32x2*)(ACT + (size_t)(blk * 64 + 16 * m + fr) * FF + ch) = pk4(o);
                }
            }
        }
    }
};

__device__ __forceinline__ void fixup_phase(const float* RAW, bf16_t* ACT, const float* cw, const float* cb, int gtid, int nthr) {
    for (int it = gtid; it < 256 * 2 * 704; it += nthr) {
        const int c4 = it % 704, rr = (it / 704) & 1, blk = it / 1408, ch = 4 * c4;
        const float* cur = RAW + (size_t)(blk * 4 + rr) * FF2;
        const float* p1 = rr == 1 ? RAW + (size_t)(blk * 4) * FF2 : (blk > 0 ? RAW + (size_t)((blk - 1) * 4 + 3) * FF2 : nullptr);
        const float* p2 = rr == 1 ? (blk > 0 ? RAW + (size_t)((blk - 1) * 4 + 3) * FF2 : nullptr) : (blk > 0 ? RAW + (size_t)((blk - 1) * 4 + 2) * FF2 : nullptr);
        const f32x4 z = {0.f, 0.f, 0.f, 0.f};
        const f32x4 va = *(const f32x4*)(cur + ch), vb = *(const f32x4*)(cur + FF + ch);
        const f32x4 a1 = p1 ? *(const f32x4*)(p1 + ch) : z, b1 = p1 ? *(const f32x4*)(p1 + FF + ch) : z;
        const f32x4 a2 = p2 ? *(const f32x4*)(p2 + ch) : z, b2 = p2 ? *(const f32x4*)(p2 + FF + ch) : z;
        const f32x4 ya = *(const f32x4*)(cb + ch) + *(const f32x4*)(cw + ch) * a2 + *(const f32x4*)(cw + FF2 + ch) * a1 + *(const f32x4*)(cw + 2 * FF2 + ch) * va;
        const f32x4 yb = *(const f32x4*)(cb + FF + ch) + *(const f32x4*)(cw + FF + ch) * b2 + *(const f32x4*)(cw + FF2 + FF + ch) * b1 + *(const f32x4*)(cw + 2 * FF2 + FF + ch) * vb;
        *(u32x2*)(ACT + (size_t)(blk * 64 + rr) * FF + ch) = pk4(silu_mul(ya, yb));
    }
}

template <int W> __device__ __forceinline__ void pooled_item(const bf16_t* UPOOL, bf16_t* POOLED, int t, int c8) {
    v4u v[W];
#pragma unroll
    for (int j = 0; j < W; ++j) { const int tj = (t - j) >= 0 ? (t - j) : 0; v[j] = *(const v4u*)(UPOOL + (size_t)tj * PW + 8 * c8); }
    float s[8];
#pragma unroll
    for (int e = 0; e < 8; ++e) s[e] = 0.f;
#pragma unroll
    for (int j = 0; j < W; ++j) { const float m = (t - j) >= 0 ? 1.f : 0.f;
        s[0] = fmaf(m, bf_lo(v[j].x), s[0]); s[1] = fmaf(m, bf_hi(v[j].x), s[1]); s[2] = fmaf(m, bf_lo(v[j].y), s[2]); s[3] = fmaf(m, bf_hi(v[j].y), s[3]);
        s[4] = fmaf(m, bf_lo(v[j].z), s[4]); s[5] = fmaf(m, bf_hi(v[j].z), s[5]); s[6] = fmaf(m, bf_lo(v[j].w), s[6]); s[7] = fmaf(m, bf_hi(v[j].w), s[7]); }
    const int cntw = (t + 1) < W ? (t + 1) : W; const float inv = 1.0f / (float)cntw; v4u o;
    o.x = pkbf(s[0] * inv - bf_lo(v[0].x), s[1] * inv - bf_hi(v[0].x)); o.y = pkbf(s[2] * inv - bf_lo(v[0].y), s[3] * inv - bf_hi(v[0].y));
    o.z = pkbf(s[4] * inv - bf_lo(v[0].z), s[5] * inv - bf_hi(v[0].z)); o.w = pkbf(s[6] * inv - bf_lo(v[0].w), s[7] * inv - bf_hi(v[0].w));
    *(v4u*)(POOLED + (size_t)t * PW + 8 * c8) = o;
}
__device__ __forceinline__ void pooled_phase(const bf16_t* UPOOL, bf16_t* POOLED, int gtid, int nthr) {
    for (int it = gtid; it < M * 64; it += nthr) {
        const int wv = it >> 6, l = it & 63, g = wv & 3, t = (wv >> 2) * 4 + (l >> 4), c8 = g * 16 + (l & 15);
        if (g == 0) pooled_item<2>(UPOOL, POOLED, t, c8); else if (g == 1) pooled_item<4>(UPOOL, POOLED, t, c8); else if (g == 2) pooled_item<8>(UPOOL, POOLED, t, c8); else pooled_item<16>(UPOOL, POOLED, t, c8);
    }
}

#define MFMA32(a, b, c) __builtin_amdgcn_mfma_f32_32x32x16_bf16((a), (b), (c), 0, 0, 0)
__device__ __forceinline__ unsigned lds_add(LAS unsigned* p, unsigned v) { return __hip_atomic_fetch_add(p, v, __ATOMIC_RELAXED, __HIP_MEMORY_SCOPE_WORKGROUP); }
__device__ __forceinline__ unsigned lds_or(LAS unsigned* p, unsigned v) { return __hip_atomic_fetch_or(p, v, __ATOMIC_RELAXED, __HIP_MEMORY_SCOPE_WORKGROUP); }

__device__ __forceinline__ float u2f(unsigned u) { return __uint_as_float((u & 0x80000000u) ? (u & 0x7fffffffu) : ~u); }
template <bool EMIT>
__device__ __forceinline__ void tk_pass(int qb, int wave, int lane, const bf16_t* KI, const LAS bf16_t* QF, const float (&wv)[4], LAS unsigned* H, LAS unsigned* SELM, LAS unsigned* TIEM,
                                        int sh, unsigned vlo, bool clampTop, unsigned bmax, int stage, unsigned vmin, float fsel, float ftie) {
    const int r = lane & 31, h = lane >> 5;
    const int gstep = stage == 1 ? 8 : 1, g0 = stage == 1 ? wave : 0;
#define TK_NEXT_G(g) ({ int _g = (g) + gstep; if (stage == 2 && (_g & 7) == wave) ++_g; _g; })
    int gcur = g0; if (stage == 2 && (gcur & 7) == wave) ++gcur;
    pg8::bf16x8 kf[4];
    { const int T0 = (wave + 8 * gcur) <= qb ? (wave + 8 * gcur) : qb; const bf16_t* kp = KI + (size_t)T0 * 2048 + 8 * lane;
#pragma unroll
      for (int s = 0; s < 4; ++s) kf[s] = *(const pg8::bf16x8*)(kp + 512 * s); }
    LAS unsigned* Hq = H + r * HSTRIDE;
#pragma unroll 1
    for (; wave + 8 * gcur <= qb; gcur = TK_NEXT_G(gcur)) {
        const int T = wave + 8 * gcur;
        float sc[16];
#pragma unroll
        for (int i = 0; i < 16; ++i) sc[i] = 0.f;
#pragma unroll
        for (int hd = 0; hd < 4; ++hd) { f32x16 a;
#pragma unroll
            for (int i = 0; i < 16; ++i) a[i] = 0.f;
#pragma unroll
            for (int s = 0; s < 4; ++s) a = MFMA32(kf[s], *(const LAS pg8::bf16x8*)(QF + (hd * 4 + s) * 512 + lane * 8), a);
#pragma unroll
            for (int i = 0; i < 16; ++i) { const float av = a[i]; const int ab = __float_as_int(av); sc[i] = fmaf(wv[hd], __int_as_float(ab > 0 ? ab : 0), sc[i]); } }
        { const int Tnn = wave + 8 * TK_NEXT_G(gcur); const int Tn = Tnn <= qb ? Tnn : T; const bf16_t* kp = KI + (size_t)Tn * 2048 + 8 * lane;
#pragma unroll
          for (int s = 0; s < 4; ++s) kf[s] = *(const pg8::bf16x8*)(kp + 512 * s); }
        const int rlim = (T == qb) ? r : 64;
        if (!EMIT) {
#pragma unroll
            for (int i = 0; i < 16; ++i) {
                const int kr = (i & 3) + 8 * (i >> 2) + 4 * h;
                unsigned uu = __float_as_uint(sc[i]); uu ^= ((unsigned)((int)uu >> 31)) | 0x80000000u;
                const unsigned v = uu >> sh; unsigned b = v - vlo;
                const bool ok = (kr <= rlim) && (v >= vmin) && (clampTop || b <= bmax);
                b = b > 2047u ? 2047u : b;
                lds_add(Hq + (ok ? (b >> 1) : 1024u), 1u << ((b & 1u) * 16u));
            }
        } else {
            unsigned ms = 0u, mg = 0u;
#pragma unroll
            for (int i = 15; i >= 0; --i) {
                asm("v_cmp_ge_f32_e32 vcc, %1, %2\n\tv_addc_co_u32_e32 %0, vcc, %0, %0, vcc" : "+v"(ms) : "v"(sc[i]), "v"(fsel) : "vcc");
                asm("v_cmp_ge_f32_e32 vcc, %1, %2\n\tv_addc_co_u32_e32 %0, vcc, %0, %0, vcc" : "+v"(mg) : "v"(sc[i]), "v"(ftie) : "vcc");
            }
            const unsigned vrow = rlim >= 31 ? 0xffffffffu : ((2u << rlim) - 1u);
            auto spread = [&](unsigned m) { return (((m & 0xfu) | ((m & 0xf0u) << 4) | ((m & 0xf00u) << 8) | ((m & 0xf000u) << 12)) << (4 * h)) & vrow; };
            const unsigned msel = spread(ms), mtie = spread(mg) & ~msel;
            const unsigned osel = __shfl_xor(msel, 32), otie = __shfl_xor(mtie, 32);
            if (h == 0) { SELM[r * MSTRIDE + T] = msel | osel; TIEM[r * MSTRIDE + T] = mtie | otie; }
        }
    }
#undef TK_NEXT_G
}

template <int CTRL> __device__ __forceinline__ float dppx(float x) { return __builtin_bit_cast(float, __builtin_amdgcn_mov_dpp(__builtin_bit_cast(int, x), CTRL, 0xf, 0xf, true)); }
__device__ __forceinline__ u32x2 tk_rescore_load(const bf16_t* KI, int key, int lane) {
    const int c = 4 * (lane & 15);
    return *(const u32x2*)(KI + (size_t)(key >> 5) * 2048 + (c >> 4) * 512 + ((((c >> 3) & 1) * 32 + (key & 31)) * 8) + (c & 7));
}
__device__ __forceinline__ float tk_rescore(const u32x2 q4, float wh, const u32x2 k4) {
    float d = bf_lo(q4.x) * bf_lo(k4.x); d = fmaf(bf_hi(q4.x), bf_hi(k4.x), d); d = fmaf(bf_lo(q4.y), bf_lo(k4.y), d); d = fmaf(bf_hi(q4.y), bf_hi(k4.y), d);
    d += dppx<0xB1>(d); d += dppx<0x4E>(d); d += dppx<0x141>(d); d += dppx<0x140>(d);
    float sc = wh * fmaxf(d, 0.f);
    sc += __shfl_xor(sc, 16); sc += __shfl_xor(sc, 32);
    return sc + 0.f;
}

__device__ __forceinline__ int wave_incl_scan(int v) {
    v += __builtin_amdgcn_update_dpp(0, v, 0x111, 0xf, 0xf, true); v += __builtin_amdgcn_update_dpp(0, v, 0x112, 0xf, 0xf, true);
    v += __builtin_amdgcn_update_dpp(0, v, 0x114, 0xf, 0xf, true); v += __builtin_amdgcn_update_dpp(0, v, 0x118, 0xf, 0xf, true);
    v += __builtin_amdgcn_update_dpp(0, v, 0x142, 0xa, 0xf, false); v += __builtin_amdgcn_update_dpp(0, v, 0x143, 0xc, 0xf, false);
    return v;
}
__device__ __forceinline__ void tk_scan(const LAS unsigned* Hq, LAS unsigned* pref_p, LAS unsigned* need_p, LAS unsigned* cnt_p, int bits, int lane) {
    const int need = (int)*need_p;
    int S = 0;
#pragma unroll
    for (int i = 0; i < 16; ++i) { const unsigned w = Hq[16 * lane + ((i + lane) & 15)]; S += (int)((w & 0xffffu) + (w >> 16)); }
    const int incl = wave_incl_scan(S), total = __builtin_amdgcn_readlane(incl, 63), Tabove = total - incl;
    const bool hit = (Tabove < need) && (need <= Tabove + S);
    const unsigned long long mk = __ballot(hit);
    const int L = mk ? (int)__builtin_ctzll(mk) : 0;
    const int remL = need - __builtin_amdgcn_readlane(Tabove, L);
    const unsigned w2 = Hq[16 * L + ((lane & 31) >> 1)];
    const int c = lane < 32 ? (int)((w2 >> (16 * (lane & 1))) & 0xffffu) : 0;
    const int incl2 = wave_incl_scan(c), tot2 = __builtin_amdgcn_readlane(incl2, 63), above2 = tot2 - incl2;
    const bool hit2 = (lane < 32) && (above2 < remL) && (remL <= above2 + c);
    const unsigned long long mk2 = __ballot(hit2);
    const int J = mk2 ? (int)__builtin_ctzll(mk2) : 0;
    const unsigned Dsel = (unsigned)(32 * L + J), nsel = mk2 ? (unsigned)(remL - __builtin_amdgcn_readlane(above2, J)) : 1u, csel = (unsigned)__builtin_amdgcn_readlane(c, J);
    if (lane == 0) { *pref_p = bits ? ((*pref_p << bits) | Dsel) : Dsel; *need_p = nsel; if (cnt_p) *cnt_p = csel; }
}

typedef float f32x2_t __attribute__((ext_vector_type(2)));
__device__ __forceinline__ void unpack16(const v4u w, f32x2_t (&f)[8]) {
#pragma unroll
    for (int i = 0; i < 4; ++i) { f[2 * i] = __builtin_amdgcn_cvt_pk_f32_fp8((int)w[i], false); f[2 * i + 1] = __builtin_amdgcn_cvt_pk_f32_fp8((int)w[i], true); }
}
__device__ __forceinline__ void attn_item(int t, int hd, const unsigned short* SEL, const bf16_t* Q, const unsigned char* K8, const unsigned char* V8, bf16_t* ATTN, int lane) {
    constexpr float LOG2E = 1.4426950408889634f;
    const int kk = lane >> 2, part = lane & 3, cnt = (t + 1) < 256 ? (t + 1) : 256;
    const float slope2 = __uint_as_float((unsigned)(126 - hd) << 23) * LOG2E, sc2 = 0.125f * LOG2E;
    f32x2_t q[8];
    { const v4u qa = *(const v4u*)(Q + (size_t)t * AW + hd * 64 + part * 16), qb = *(const v4u*)(Q + (size_t)t * AW + hd * 64 + part * 16 + 8);
#pragma unroll
      for (int i = 0; i < 4; ++i) { q[i] = (f32x2_t){bf_lo(qa[i]) * sc2, bf_hi(qa[i]) * sc2}; q[4 + i] = (f32x2_t){bf_lo(qb[i]) * sc2, bf_hi(qb[i]) * sc2}; } }
    const unsigned short* lp = SEL + (size_t)t * 256;
    const unsigned char* kb = K8 + (size_t)hd * M * 128 + part * 16; const unsigned char* vb = kb + 64; (void)V8;
    int key[16]; v4u kf[16], vf[16];
#pragma unroll
    for (int r = 0; r < 16; ++r) { const int j = 16 * r + kk; key[r] = (int)lp[j < cnt ? j : cnt - 1]; }
#pragma unroll
    for (int r = 0; r < 16; ++r) { kf[r] = *(const v4u*)(kb + (size_t)key[r] * 128); vf[r] = *(const v4u*)(vb + (size_t)key[r] * 128); }
    float sv[16]; float mx = -INFINITY;
#pragma unroll
    for (int r = 0; r < 16; ++r) { f32x2_t kx[8]; unpack16(kf[r], kx); f32x2_t d2 = q[0] * kx[0];
#pragma unroll
        for (int e = 1; e < 8; ++e) d2 = __builtin_elementwise_fma(q[e], kx[e], d2);
        float d = d2.x + d2.y;
        d += dppx<0xB1>(d); d += dppx<0x4E>(d);
        sv[r] = (16 * r + kk) < cnt ? d - slope2 * (float)(t - key[r]) : -INFINITY; mx = fmaxf(mx, sv[r]); }
    mx = fmaxf(mx, __shfl_xor(mx, 4)); mx = fmaxf(mx, __shfl_xor(mx, 8)); mx = fmaxf(mx, __shfl_xor(mx, 16)); mx = fmaxf(mx, __shfl_xor(mx, 32));
    f32x2_t o[8]; float lsum = 0.f;
#pragma unroll
    for (int e = 0; e < 8; ++e) o[e] = (f32x2_t){0.f, 0.f};
#pragma unroll
    for (int r = 0; r < 16; ++r) { const float p = __builtin_amdgcn_exp2f(sv[r] - mx); lsum += p; f32x2_t vx[8]; unpack16(vf[r], vx); const f32x2_t p2 = (f32x2_t){p, p};
#pragma unroll
        for (int e = 0; e < 8; ++e) o[e] = __builtin_elementwise_fma(p2, vx[e], o[e]); }
    lsum += dppx<0x124>(lsum); lsum += dppx<0x128>(lsum); lsum += __shfl_xor(lsum, 16); lsum += __shfl_xor(lsum, 32);
    float of[16];
#pragma unroll
    for (int e = 0; e < 8; ++e) { of[2 * e] = o[e].x; of[2 * e + 1] = o[e].y; }
#pragma unroll
    for (int e = 0; e < 16; ++e) { float v = of[e]; v += dppx<0x124>(v); v += dppx<0x128>(v); v += __shfl_xor(v, 16); v += __shfl_xor(v, 32); of[e] = v; }
    if (lane < 4) { const float inv = __builtin_amdgcn_rcpf(lsum); v4u a, b;
        a.x = pkbf(of[0] * inv, of[1] * inv); a.y = pkbf(of[2] * inv, of[3] * inv); a.z = pkbf(of[4] * inv, of[5] * inv); a.w = pkbf(of[6] * inv, of[7] * inv);
        b.x = pkbf(of[8] * inv, of[9] * inv); b.y = pkbf(of[10] * inv, of[11] * inv); b.z = pkbf(of[12] * inv, of[13] * inv); b.w = pkbf(of[14] * inv, of[15] * inv);
        *(v4u*)(ATTN + (size_t)t * AW + hd * 64 + part * 16) = a; *(v4u*)(ATTN + (size_t)t * AW + hd * 64 + part * 16 + 8) = b; }
}

struct TkPtrs { const bf16_t *QI, *KI; const float* WI; unsigned short* SEL; };
__device__ __forceinline__ void topk_attn_block(int qb, const TkPtrs& P, LAS unsigned char* lds, int tid, int wave, int lane, bool do_attn) {
    LAS unsigned* H = (LAS unsigned*)lds;
    LAS unsigned* SELM = (LAS unsigned*)lds;
    LAS unsigned* TIEM = (LAS unsigned*)(lds + 32 * MSTRIDE * 4);
    LAS unsigned short* LIST = (LAS unsigned short*)(lds + LIST_OFF);
    LAS unsigned* STP = (LAS unsigned*)(lds + ST_OFF);
    LAS unsigned* STN = STP + 32;
    const int t0 = qb * 32, r = lane & 31, h = lane >> 5;
    SYNC();
    float wv[4];
    LAS bf16_t* QF = (LAS bf16_t*)(lds + LIST_OFF);
    { const bf16_t* qp = P.QI + (size_t)(t0 + r) * 256 + 8 * h;
#pragma unroll
      for (int k = 0; k < 2; ++k) { const int f = 2 * wave + k; *(LAS pg8::bf16x8*)(QF + f * 512 + lane * 8) = *(const pg8::bf16x8*)(qp + (f >> 2) * 64 + 16 * (f & 3)); }
      const f32x4 w4 = *(const f32x4*)(P.WI + (size_t)(t0 + r) * 4); wv[0] = w4[0]; wv[1] = w4[1]; wv[2] = w4[2]; wv[3] = w4[3]; }
    LAS unsigned* STC = STP + 64;
    LAS unsigned* STG = STP + 96;
    LAS unsigned* FB = STP + 160;
    LAS unsigned* STS = STP + 192;
    LAS float* FSEL = (LAS float*)(STP + 256);
    LAS float* FTIE = FSEL + 32;
    const bool negw = (wv[0] <= 0.f) && (wv[1] <= 0.f) && (wv[2] <= 0.f) && (wv[3] <= 0.f);
    const unsigned wbase = negw ? 7745u : 22976u;
#pragma unroll 1
    for (int rep_tk = 0; rep_tk < REP_TK; ++rep_tk) {
    if (wave == 0 && lane == 0) *FB = 0u;
#pragma unroll 1
    for (int mode = 0; mode < 2; ++mode) {
        if (mode == 1) { if (*FB == 0u) break; }
        if (wave == 0 && lane < 32) { STP[lane] = 0u; const int nv = t0 + lane + 1; STN[lane] = nv < 256 ? nv : 256; STG[lane] = negw ? 1u : 0u; }
        const int nstep = mode == 0 ? 1 : 3;
#pragma unroll 1
        for (int step = 0; step < nstep; ++step) {
            if (mode == 1 || step == 0) { for (int i = tid; i < 32 * HSTRIDE; i += NTHR) H[i] = 0u; }
            SYNC();
            const int sh = mode == 0 ? 17 : (step == 0 ? 21 : (step == 1 ? 10 : 0));
            const unsigned vlo = mode == 0 ? wbase : (step == 0 ? 0u : (STP[r] << (step == 1 ? 11 : 10)));
            const unsigned vmin = vlo;
            tk_pass<false>(qb, wave, lane, P.KI, QF, wv, H, SELM, TIEM, sh, vlo, mode == 0, (mode == 1 && step == 2) ? 1023u : 2047u, 0, vmin, 0.f, 0.f);
            SYNC();
            const bool samp = false;
#pragma unroll 1
            for (int qq = 0; qq < 4; ++qq) { const int rq = 4 * wave + qq;
                tk_scan(H + rq * HSTRIDE, samp ? STS + rq : STP + rq, samp ? STS + 32 + rq : STN + rq, STC + rq, (mode == 1 && step == 2) ? 10 : 11, lane);
                if (mode == 0 && lane == 0) { const unsigned D = STP[rq], nn = STN[rq], c = STC[rq], ng = STG[rq] & 1u;
                    const bool zerobin = ng && D == 2047u, edge = (D == 0u) || (D == 2047u && !ng);
                    const bool wantc = (c > nn) && !zerobin;
                    if (edge || (wantc && c > 64u)) lds_or(FB, 1u);
                    STG[rq] = ng | (wantc ? 2u : 0u);
                    const unsigned wb = ng ? 7745u : 22976u;
                    FTIE[rq] = u2f((wb + D) << 17); FSEL[rq] = zerobin ? INFINITY : u2f((wb + D + 1u) << 17); }
                if (mode == 1 && step == 2 && lane == 0) { const unsigned tau = STP[rq]; FTIE[rq] = u2f(tau); FSEL[rq] = tau == 0xffffffffu ? INFINITY : u2f(tau + 1u); } }
            SYNC();
        }
        if (mode == 0 && *FB != 0u) continue;
        tk_pass<true>(qb, wave, lane, P.KI, QF, wv, H, SELM, TIEM, 0, 0u, false, 0u, 0, 0u, FSEL[r], FTIE[r]);
        SYNC();
        break;
    }
    }
    if (!do_attn) return;
#pragma unroll 1
    for (int qq = 0; qq < 4; ++qq) {
        const int rq = 4 * wave + qq, t = t0 + rq; int mties = (int)STN[rq];
        unsigned tw[8], fw[8]; int S = 0;
#pragma unroll
        for (int i = 0; i < 8; ++i) { const int T = 8 * lane + i; const bool v = T <= qb; tw[i] = v ? TIEM[rq * MSTRIDE + T] : 0u; fw[i] = v ? SELM[rq * MSTRIDE + T] : 0u; S += __builtin_popcount(tw[i]); }
        const int incl = wave_incl_scan(S);
        if (*FB == 0u && (STG[rq] & 2u)) {
            const int c = __builtin_amdgcn_readlane(incl, 63), nn = mties;
            LAS unsigned short* cl = LIST + rq * 256;
            { int pos = incl - S;
#pragma unroll
              for (int i = 0; i < 8; ++i) { unsigned w = tw[i]; while (w) { const int b = __builtin_ctz(w); if (pos < 64) cl[pos] = (unsigned short)(256 * lane + 32 * i + b); ++pos; w &= w - 1u; } } }
            LDS_WAIT(); asm volatile("" ::: "memory");
            const u32x2 q4 = *(const u32x2*)(P.QI + (size_t)t * 256 + 4 * lane); const float wh = P.WI[(size_t)t * 4 + (lane >> 4)];
            float mys = 0.f; const int cc = c < 64 ? c : 64;
#pragma unroll 1
            for (int j0 = 0; j0 < cc; j0 += 8) { u32x2 k4[8];
#pragma unroll
                for (int u = 0; u < 8; ++u) { const int jj = (j0 + u) < cc ? (j0 + u) : (cc - 1); k4[u] = tk_rescore_load(P.KI, __builtin_amdgcn_readfirstlane((int)cl[jj]), lane); }
#pragma unroll
                for (int u = 0; u < 8; ++u) { const float sj = tk_rescore(q4, wh, k4[u]); if (lane == j0 + u) mys = sj; } }
            int rank = 0;
            for (int j = 0; j < cc; ++j) { const float sj = __int_as_float(__builtin_amdgcn_readlane(__float_as_int(mys), j)); rank += (sj > mys || (sj == mys && j < lane)) ? 1 : 0; }
            const bool keepme = lane < cc && rank < nn; const int mykey = lane < cc ? (int)cl[lane] : 0;
#pragma unroll 1
            for (int j = 0; j < cc; ++j) { const int kj = __builtin_amdgcn_readlane(mykey, j); const int kp = __builtin_amdgcn_readlane((int)keepme, j);
                if (kp && (kj >> 8) == lane) {
#pragma unroll
                    for (int i = 0; i < 8; ++i) if (((kj >> 5) & 7) == i) fw[i] |= 1u << (kj & 31); } }
            mties = 0;
        }
        int take = mties - (incl - S); take = take < 0 ? 0 : (take > S ? S : take);
        int cl2 = 0;
#pragma unroll
        for (int i = 0; i < 8; ++i) { unsigned w = tw[i]; const int c = __builtin_popcount(w); unsigned keep;
            if (take >= c) { keep = w; take -= c; } else { keep = 0u; for (int k = 0; k < take; ++k) { const unsigned low = w & (0u - w); keep |= low; w ^= low; } take = 0; }
            fw[i] |= keep; cl2 += __builtin_popcount(fw[i]); }
        const int inc2 = wave_incl_scan(cl2);
        int pos = inc2 - cl2; const int cnt = __builtin_amdgcn_readlane(inc2, 63);
        LAS unsigned short* lp = LIST + rq * 256;
#pragma unroll
        for (int i = 0; i < 8; ++i) { unsigned w = fw[i]; while (w) { const int b = __builtin_ctz(w); if (pos < 256) lp[pos] = (unsigned short)(256 * lane + 32 * i + b); ++pos; w &= w - 1u; } }
        LDS_WAIT(); asm volatile("" ::: "memory");
        (void)cnt;
        *(u32x2*)(P.SEL + (size_t)t * 256 + 4 * lane) = *(const LAS u32x2*)(lp + 4 * lane);
    }
}

struct OneUnit { int pm, pn;
    __device__ __forceinline__ bool next(int i, pg8::Unit& u) const { if (i != 0) return false; u.pm = pm; u.pn = pn; return true; }
    __device__ __forceinline__ void a_ready(const pg8::Unit&) const {}
    __device__ __forceinline__ void done(const pg8::Unit&) const {}
};
struct Args { const float* in[18]; float* out; unsigned char* ws; int ph_lo, ph_hi; };
constexpr int NPH = 13;

typedef const __attribute__((address_space(4))) unsigned long long* kargp_t;
#define KARGS() kargp_t kargs = (kargp_t)__builtin_amdgcn_kernarg_segment_ptr(); asm volatile("" : "+s"(kargs)); GAS unsigned char* const ws = (GAS unsigned char*)kargs[19]; (void)ws
#define KIN(i) ((const float*)(const GAS float*)kargs[(i)])
#define KOUT() ((float*)(GAS float*)kargs[18])
#define WSP(T, off) ((T*)(GAS T*)(ws + (off)))
__global__ void __launch_bounds__(NTHR, 2) fwd_kernel(Args a) {
    extern __shared__ __attribute__((aligned(16))) unsigned char lds_raw[];
    LAS unsigned char* lds = (LAS unsigned char*)lds_raw;
    const int lo = a.ph_lo, hi = a.ph_hi;
    { int tid0 = threadIdx.x; asm volatile("" : "+v"(tid0)); for (int u = tid0; u < (LDS_BYTES - MISC_OFF) / 4; u += NTHR) ((LAS unsigned*)(lds + MISC_OFF))[u] = 0u; }
    SYNC();
    XcdBarrier bar; bar.bar = nullptr; bar.x = 0; bar.st = nullptr;
    if (hi - lo > 1) { KARGS(); bar = xcd_barrier_post((unsigned*)(GAS unsigned*)(ws + WS_CTL) + CW_BAR, (volatile LAS unsigned*)(lds + MISC_OFF) + 8); }
#define IN(k) (lo <= (k) && (k) < hi)
#define SEAM(k) do { if (IN(k) && IN((k) + 1)) xcd_barrier(bar); } while (0)
#define IDS() const int tid = threadIdx.x, lane = tid & 63, wave = __builtin_amdgcn_readfirstlane(tid >> 6), G = gridDim.x, bid = blockIdx.x; (void)lane; (void)wave; (void)G; (void)bid

    for (int rep_ph = 0; rep_ph < ((REP_PH == 0) ? 2 : 1); ++rep_ph) if (IN(0)) { KARGS(); IDS();
        P0Ptrs P{KIN(1), KIN(2), KIN(5), KIN(8), KIN(9), KIN(11), KIN(12), KIN(14), KIN(17), KIN(10), WSP(bf16_t, WS_WIN), WSP(bf16_t, WS_WATTN), WSP(bf16_t, WS_WGRP), WSP(bf16_t, WS_WPOOL), WSP(bf16_t, WS_WOUT),
                 WSP(bf16_t, WS_WUP), WSP(bf16_t, WS_WDOWN), WSP(float, WS_MODP)};
        p0_prologue(P, lds, bid * NWAVES + wave, G * NWAVES, wave, lane);
    }
    SEAM(0);
    if (IN(1)) { KARGS(); IDS();
        const float *b_ada = KIN(3), *norm1_g = KIN(4); const float* MODP = WSP(float, WS_MODP); float* MODF = WSP(float, WS_MODF);
        LAS float* mulv = (LAS float*)lds; LAS float* addv = mulv + 1024;
        for (int i = tid; i < 1024; i += NTHR) { float sh = b_ada[i], scv = b_ada[1024 + i];
#pragma unroll
            for (int kc = 0; kc < 16; ++kc) { sh += MODP[kc * NMOD + i]; scv += MODP[kc * NMOD + 1024 + i]; }
            mulv[i] = norm1_g[i] * (1.0f + scv); addv[i] = sh; }
        if (bid < 24 && tid < 256) { const int i = bid * 256 + tid; float v = b_ada[i];
#pragma unroll
            for (int kc = 0; kc < 16; ++kc) v += MODP[kc * NMOD + i];
            MODF[i] = v; }
        SYNC();
        modulate_rows(KIN(0), WSP(bf16_t, WS_H), mulv, addv, bid * NWAVES + wave, G * NWAVES, lane);
        SYNC();
    }
    SEAM(1);
    for (int rep_ph = 0; rep_ph < ((REP_PH == 2) ? 2 : 1); ++rep_ph) if (IN(2)) { KARGS(); IDS();
        pg8::Gemm g{WSP(bf16_t, WS_H), WSP(bf16_t, WS_WIN), M, NINP, DM}; pg8::StaticOrder S; S.init(M, NINP, G, bid);
        EpiProj E{WSP(bf16_t, WS_Q), WSP(unsigned char, WS_K), WSP(unsigned char, WS_K), WSP(bf16_t, WS_QI), WSP(bf16_t, WS_KI), WSP(bf16_t, WS_UPOOL), WSP(bf16_t, WS_GA), WSP(bf16_t, WS_GP), WSP(float, WS_WI), KIN(6), KIN(7)};
        pg8::gemm_phase<EpiProj, pg8::StaticOrder, true, true>(lds, g, S, E);
    }
    SEAM(2);
    if (IN(3)) { KARGS(); IDS();
        if (bid < 8) {
            pg8::Gemm g{WSP(bf16_t, WS_WPOOL), WSP(bf16_t, WS_WGRP), 1024, PW, PW}; OneUnit S{bid >> 1, bid & 1};
            EpiBf<3> E{WSP(bf16_t, WS_POOLMIX), PW, nullptr, nullptr};
            pg8::gemm_phase<EpiBf<3>, OneUnit, true, true>(lds, g, S, E);
            SYNC();
        }
        pooled_phase(WSP(bf16_t, WS_UPOOL), WSP(bf16_t, WS_POOLED), bid * NTHR + tid, G * NTHR);
        TkPtrs T{WSP(bf16_t, WS_QI), WSP(bf16_t, WS_KI), WSP(float, WS_WI), (unsigned short*)KOUT()};
        unsigned* qctr = (unsigned*)(GAS unsigned*)(ws + WS_CTL) + CW_QUEUE;
        LAS int* qslot = (LAS int*)(lds + ST_OFF + 2040);
#pragma unroll 1
        for (;;) {
            SYNC();
            if (tid == 0) *qslot = (int)__hip_atomic_fetch_add(qctr, 1u, __ATOMIC_RELAXED, __HIP_MEMORY_SCOPE_AGENT);
            SYNC();
            const int qi0 = *qslot;
            const int qi = qi0;
            if (qi >= 512 * (1 + REP_TKONLY)) break;
            topk_attn_block(511 - (qi & 511), T, lds, tid, wave, lane, qi >= 512 * REP_TKONLY);
        }
        SYNC();
    }
    SEAM(3);
    if (IN(4)) { KARGS(); IDS();
        const unsigned short* SEL = (const unsigned short*)KOUT(); const bf16_t* Qp = WSP(bf16_t, WS_Q); const unsigned char *K8 = WSP(unsigned char, WS_K), *V8 = WSP(unsigned char, WS_K); bf16_t* ATTN = WSP(bf16_t, WS_ATTN);
        const bool aff = (G & 7) == 0; const int nitem = 8 * M, step = aff ? (G >> 3) * NWAVES : G * NWAVES;
#pragma unroll 1
        for (int it = aff ? (bid >> 3) * NWAVES + wave : bid * NWAVES + wave; it < (aff ? M : nitem); it += step) attn_item(aff ? it : (it >> 3), aff ? (bid & 7) : (it & 7), SEL, Qp, K8, V8, ATTN, lane);
    }
    SEAM(4);
    if (IN(6)) { KARGS(); IDS();
        pg8::Gemm g{WSP(bf16_t, WS_POOLED), WSP(bf16_t, WS_POOLMIX), M, DM, PW}; pg8::StaticOrder S; S.init(M, DM, G, bid);
        EpiBf<1> E{WSP(bf16_t, WS_GP), DM, nullptr, nullptr};
        pg8::gemm_phase<EpiBf<1>, pg8::StaticOrder, true, true>(lds, g, S, E);
    }
    SEAM(6);
    if (IN(7)) { KARGS(); IDS();
        pg8::Gemm g{WSP(bf16_t, WS_ATTN), WSP(bf16_t, WS_WATTN), M, DM, AW}; pg8::StaticOrder S; S.init(M, DM, G, bid);
        EpiBf<2> E{WSP(bf16_t, WS_GA), DM, nullptr, WSP(bf16_t, WS_GP)};
        pg8::gemm_phase<EpiBf<2>, pg8::StaticOrder, true, true>(lds, g, S, E);
    }
    SEAM(7);
    for (int rep_ph = 0; rep_ph < ((REP_PH == 8) ? 2 : 1); ++rep_ph) if (IN(8)) { KARGS(); IDS();
        pg8::Gemm g{WSP(bf16_t, WS_GA), WSP(bf16_t, WS_WOUT), M, DM, DM}; pg8::StaticOrder S; S.init(M, DM, G, bid);
        EpiRes E{KIN(0), KOUT(), WSP(float, WS_MODF) + 2048, 0.f};
        pg8::gemm_phase<EpiRes, pg8::StaticOrder, true, true>(lds, g, S, E);
    }
    SEAM(8);
    if (IN(9)) { KARGS(); IDS();
        const float* norm2_g = KIN(13); const float* MODF = WSP(float, WS_MODF);
        LAS float* mulv = (LAS float*)lds; LAS float* addv = mulv + 1024;
        for (int i = tid; i < 1024; i += NTHR) { mulv[i] = norm2_g[i] * (1.0f + MODF[4096 + i]); addv[i] = MODF[3072 + i]; }
        SYNC();
        modulate_rows(KOUT(), WSP(bf16_t, WS_H), mulv, addv, bid * NWAVES + wave, G * NWAVES, lane);
        SYNC();
    }
    SEAM(9);
    for (int rep_ph = 0; rep_ph < ((REP_PH == 10) ? 2 : 1); ++rep_ph) if (IN(10)) { KARGS(); IDS();
        pg8::Gemm g{WSP(bf16_t, WS_H), WSP(bf16_t, WS_WUP), M, FF2, DM}; pg8::StaticOrder S; S.init(M, FF2, G, bid);
        EpiUpAct E{WSP(bf16_t, WS_ACT), WSP(float, WS_RAW), KIN(15), KIN(16)};
        pg8::gemm_phase<EpiUpAct, pg8::StaticOrder, true, true>(lds, g, S, E);
    }
    SEAM(10);
    if (IN(11)) { KARGS(); IDS(); fixup_phase(WSP(float, WS_RAW), WSP(bf16_t, WS_ACT), KIN(15), KIN(16), bid * NTHR + tid, G * NTHR); }
    SEAM(11);
    if (IN(12)) { KARGS(); IDS();
        pg8::Gemm g{WSP(bf16_t, WS_ACT), WSP(bf16_t, WS_WDOWN), M, DM, FF}; pg8::StaticOrder S; S.init(M, DM, G, bid);
        EpiRes E{KOUT(), KOUT(), WSP(float, WS_MODF) + 5120, DBG_C};
        pg8::gemm_phase<EpiRes, pg8::StaticOrder, true, true>(lds, g, S, E);
    }
#undef IN
#undef SEAM
}

extern "C" void kernel_launch(void* const* d_in, const int* in_sizes, int n_in, void* d_out, int out_size, void* d_ws, size_t ws_size, hipStream_t stream) {
    static int grid = 0;
    if (grid == 0) {
        if (n_in != 18 || in_sizes[0] != M * DM || out_size != M * DM || ws_size < WS_END) { fprintf(stderr, "kernel_launch: unexpected shapes (n_in %d, in0 %d, out %d, ws %zu)\n", n_in, n_in > 0 ? in_sizes[0] : -1, out_size, ws_size); grid = -1; return; }
        int dev = 0, cus = 0, per_cu = 0;
        if (hipGetDevice(&dev) != hipSuccess || hipDeviceGetAttribute(&cus, hipDeviceAttributeMultiprocessorCount, dev) != hipSuccess) { grid = -1; return; }
        if (hipFuncSetAttribute((const void*)fwd_kernel, hipFuncAttributeMaxDynamicSharedMemorySize, LDS_BYTES) != hipSuccess) { fprintf(stderr, "kernel_launch: hipFuncSetAttribute failed\n"); grid = -1; return; }
        if (hipOccupancyMaxActiveBlocksPerMultiprocessor(&per_cu, (const void*)fwd_kernel, NTHR, LDS_BYTES) != hipSuccess || per_cu < 1) fprintf(stderr, "kernel_launch: occupancy query says %d\n", per_cu);
        (void)hipGetLastError();
        grid = cus;
    }
    if (grid < 0) return;
    (void)hipMemsetAsync((char*)d_ws + WS_CTL, 0, CTL_ZERO_BYTES, stream);
    Args a{};
    for (int i = 0; i < 18; ++i) a.in[i] = (const float*)d_in[i];
    a.out = (float*)d_out; a.ws = (unsigned char*)d_ws;
#if N_LAUNCH_MODE == 1
    a.ph_lo = 0; a.ph_hi = NPH;
    hipLaunchKernelGGL(fwd_kernel, dim3(grid), dim3(NTHR), LDS_BYTES, stream, a);
#else
    for (int p = 0; p < NPH; ++p) { a.ph_lo = p; a.ph_hi = p + 1; hipLaunchKernelGGL(fwd_kernel, dim3(grid), dim3(NTHR), LDS_BYTES, stream, a); }
#endif
}
```

```cpp
#include <hip/hip_runtime.h>
#include <cstdio>
#include <cstdint>
#ifndef REP_TKONLY
#define REP_TKONLY 0
#endif
#ifndef REP_BLK
#define REP_BLK 1
#endif
namespace pg8 {
#define PG8_LAS __attribute__((address_space(3)))
typedef unsigned short bf16_t;
typedef short bf16x8 __attribute__((ext_vector_type(8)));
typedef float f32x4 __attribute__((ext_vector_type(4)));
typedef unsigned u32x4 __attribute__((ext_vector_type(4)));
constexpr int BM = 256, BK = 64, HALF = 128, HTB = HALF * BK * 2  , STAGE_BYTES = 8 * HTB, NXCD = 8, WGM = 8;

__host__ __device__ __forceinline__ int lds_byte(int r, int c) { const int st = (r >> 4) * 2 + (c >> 5), rr = r & 15, cc = c & 31, ob = rr * 64 + cc * 2; return st * 1024 + (ob ^ (((ob >> 9) & 1) << 5)); }
__host__ __device__ __forceinline__ void stage_rc(int b, int& R, int& C) { const int st = b / 1024, sb = b % 1024, swz = sb ^ (((sb >> 9) & 1) << 5); R = (st >> 1) * 16 + swz / 64; C = (st & 1) * 32 + (swz % 64) / 2; }
__host__ __device__ __forceinline__ int perm32(int rho) { const int n = rho >> 4, i = rho & 15; return 8 * (i >> 2) + 4 * n + (i & 3); }

struct Unit { int pm, pn; };
struct Gemm { const bf16_t* A; const bf16_t* Bt; int M, N, K; };

struct StaticOrder {
    int nM, nN, nwg, G, c;
    __host__ __device__ void init(int M, int N, int G_, int c_) { nM = M / BM; nN = N / BM; nwg = nM * nN; G = G_; c = c_; }
    __host__ __device__ bool next(int i, Unit& u) const {
        const long L = (long)i * G + c; if (L >= nwg) return false;
        int wgid = (int)L; { const int q = nwg / NXCD, r = nwg % NXCD, xcd = wgid % NXCD, off = wgid / NXCD; wgid = (xcd < r ? xcd * (q + 1) : r * (q + 1) + (xcd - r) * q) + off; }
        const int nig = WGM * nN, gid = wgid / nig, fm = gid * WGM, gsz = (nM - fm) < WGM ? (nM - fm) : WGM;
        u.pm = fm + ((wgid % nig) % gsz); u.pn = (wgid % nig) / gsz; return true;
    }
    __device__ __forceinline__ void a_ready(const Unit&) const {}
    __device__ __forceinline__ void done(const Unit&) const {}
};

__device__ __forceinline__ unsigned cvt_pk_bf16(float lo, float hi) { unsigned r; asm volatile("v_cvt_pk_bf16_f32 %0, %1, %2" : "=v"(r) : "v"(lo), "v"(hi)); return r; }
template <class Epi, class Sched, bool ALIGN_EPI = false, bool SP2 = false>
__device__ __forceinline__ void gemm_phase(PG8_LAS unsigned char* lds, const Gemm g, const Sched& S, const Epi& E) {
    int tid_ = threadIdx.x; asm volatile("" : "+v"(tid_));
    const int tid = tid_, wid = __builtin_amdgcn_readfirstlane(tid >> 6), lane = tid & 63, wr = wid >> 2, wc = wid & 3, fr = lane & 15, fq = lane >> 4;
    const int K = g.K, nt = K / BK;
    unsigned voffA[2], voffB[2];
#pragma unroll
    for (int i = 0; i < 2; ++i) { int R, C; stage_rc(tid * 16 + i * 8192, R, C); const int Rb = Epi::PERM ? ((R & ~31) + perm32(R & 31)) : R;
        voffA[i] = (unsigned)(R * K + C) * 2u; voffB[i] = (unsigned)(Rb * K + C) * 2u; }
    const size_t kstep = (size_t)(BK * 2);
    const size_t hstep = (size_t)HALF * K * 2;
    const size_t tstep = 2 * hstep;
    const unsigned ldsw = (unsigned)wid * 1024u;
    const int aoff = lds_byte(wr * 64 + fr, fq * 8), boff = lds_byte(wc * 32 + fr, fq * 8);
#define PG8_SA(b, h) (((b) * 2 + (h)) * HTB)
#define PG8_SB(b, h) ((4 + (b) * 2 + (h)) * HTB)
#define PG8_STAGE(bufoff, gbase, voff) do { _Pragma("unroll") for (int _i = 0; _i < 2; ++_i) \
        __builtin_amdgcn_global_load_lds((const unsigned*)((const char*)(gbase) + (voff)[_i]), (PG8_LAS unsigned*)(lds + (bufoff) + ldsw + _i * 8192), 16, 0, 0); } while (0)
#define PG8_LDA(dst, b, h) do { _Pragma("unroll") for (int m = 0; m < 4; ++m) _Pragma("unroll") for (int k = 0; k < 2; ++k) dst[m][k] = *(const PG8_LAS bf16x8*)(lds + PG8_SA(b, h) + aoff + m * 2048 + k * 1024); } while (0)
#define PG8_LDB(dst, b, h) do { _Pragma("unroll") for (int n = 0; n < 2; ++n) _Pragma("unroll") for (int k = 0; k < 2; ++k) dst[n][k] = *(const PG8_LAS bf16x8*)(lds + PG8_SB(b, h) + boff + n * 2048 + k * 1024); } while (0)
#define PG8_MMA(ai, bj, At, Bt) do { __builtin_amdgcn_s_setprio(1); _Pragma("unroll") for (int m = 0; m < 4; ++m) _Pragma("unroll") for (int n = 0; n < 2; ++n) _Pragma("unroll") for (int k = 0; k < 2; ++k) \
        acc[ai][bj][m][n] = __builtin_amdgcn_mfma_f32_16x16x32_bf16(Bt[n][k], At[m][k], acc[ai][bj][m][n], 0, 0, 0); __builtin_amdgcn_s_setprio(0); } while (0)
#define PG8_WAIT_V(n) asm volatile("s_waitcnt vmcnt(" #n ")" ::: "memory")
#define PG8_WAIT_L(n) asm volatile("s_waitcnt lgkmcnt(" #n ")" ::: "memory")
#define PG8_BAR __builtin_amdgcn_s_barrier()
#define PG8_SCHED __builtin_amdgcn_sched_barrier(0)
    Unit cur, nxt; int ui = 0;
    if (!S.next(0, cur)) return;
    f32x4 acc[2][2][4][2];
#pragma unroll
    for (int a = 0; a < 2; ++a)
#pragma unroll
        for (int b = 0; b < 2; ++b)
#pragma unroll
            for (int m = 0; m < 4; ++m)
#pragma unroll
                for (int n = 0; n < 2; ++n) acc[a][b][m][n] = (f32x4){0.f, 0.f, 0.f, 0.f};
    bf16x8 At[4][2], B0[2][2], B1[2][2];
    const char* cA = (const char*)g.A + (size_t)cur.pm * tstep; const char* cB = (const char*)g.Bt + (size_t)cur.pn * tstep;
    S.a_ready(cur);
    if constexpr (SP2) {
        PG8_STAGE(PG8_SB(0, 0), cB, voffB); PG8_STAGE(PG8_SB(0, 1), cB + hstep, voffB); PG8_STAGE(PG8_SA(0, 0), cA, voffA); PG8_STAGE(PG8_SA(0, 1), cA + hstep, voffA);
        if (wr == 1) PG8_BAR;
        PG8_WAIT_V(2); PG8_BAR;
        PG8_STAGE(PG8_SB(1, 0), cB + kstep, voffB); PG8_STAGE(PG8_SA(1, 0), cA + kstep, voffA); PG8_STAGE(PG8_SB(1, 1), cB + hstep + kstep, voffB);
        PG8_WAIT_V(6); PG8_BAR;
    } else {
        PG8_STAGE(PG8_SB(0, 0), cB, voffB); PG8_STAGE(PG8_SA(0, 0), cA, voffA); PG8_STAGE(PG8_SB(0, 1), cB + hstep, voffB); PG8_STAGE(PG8_SA(0, 1), cA + hstep, voffA);
        if (wr == 1) PG8_BAR;
        PG8_WAIT_V(4); PG8_BAR;
        PG8_STAGE(PG8_SB(1, 0), cB + kstep, voffB); PG8_STAGE(PG8_SA(1, 0), cA + kstep, voffA); PG8_STAGE(PG8_SB(1, 1), cB + hstep + kstep, voffB);
        PG8_WAIT_V(6); PG8_BAR;
    }
    for (;;) {
        const bool has_next = S.next(ui + 1, nxt);
        const char* nA = has_next ? (const char*)g.A + (size_t)nxt.pm * tstep : cA; const char* nB = has_next ? (const char*)g.Bt + (size_t)nxt.pn * tstep : cB;
        for (int t = 0; t < nt; t += 2) {
            const bool last = (t == nt - 2);
            const char* a1 = cA + (size_t)(t + 1) * kstep;
            const char* a2 = last ? nA : cA + (size_t)(t + 2) * kstep; const char* b2 = last ? nB : cB + (size_t)(t + 2) * kstep;
            const char* a3 = a2 + kstep; const char* b3 = b2 + kstep;
            if (last && has_next) S.a_ready(nxt);
            if constexpr (SP2) {
            PG8_LDB(B0, 0, 0); PG8_LDB(B1, 0, 1); PG8_SCHED; PG8_LDA(At, 0, 0); PG8_STAGE(PG8_SA(1, 1), a1 + hstep, voffA);
            PG8_WAIT_V(8); PG8_WAIT_L(0); PG8_BAR; PG8_MMA(0, 0, At, B0); PG8_MMA(0, 1, At, B1); PG8_BAR; PG8_SCHED;
            PG8_LDA(At, 0, 1); PG8_STAGE(PG8_SB(0, 0), b2, voffB); PG8_STAGE(PG8_SB(0, 1), b2 + hstep, voffB); PG8_STAGE(PG8_SA(0, 0), a2, voffA);
            PG8_WAIT_V(8); PG8_WAIT_L(0); PG8_BAR; PG8_MMA(1, 0, At, B0); PG8_MMA(1, 1, At, B1); PG8_BAR; PG8_SCHED;
            PG8_LDB(B0, 1, 0); PG8_LDB(B1, 1, 1); PG8_SCHED; PG8_LDA(At, 1, 0); PG8_STAGE(PG8_SA(0, 1), a2 + hstep, voffA);
            PG8_WAIT_V(8); PG8_WAIT_L(0); PG8_BAR; PG8_MMA(0, 0, At, B0); PG8_MMA(0, 1, At, B1); PG8_BAR; PG8_SCHED;
            PG8_LDA(At, 1, 1); PG8_STAGE(PG8_SB(1, 0), b3, voffB); PG8_STAGE(PG8_SB(1, 1), b3 + hstep, voffB); PG8_STAGE(PG8_SA(1, 0), a3, voffA);
            PG8_WAIT_V(8); PG8_WAIT_L(0); PG8_BAR; PG8_MMA(1, 0, At, B0); PG8_MMA(1, 1, At, B1); PG8_BAR; PG8_SCHED;
            } else {
            PG8_LDB(B0, 0, 0); PG8_SCHED; PG8_LDA(At, 0, 0); PG8_STAGE(PG8_SA(1, 1), a1 + hstep, voffA);
            PG8_WAIT_L(8); PG8_BAR; PG8_WAIT_L(0); PG8_MMA(0, 0, At, B0); PG8_BAR; PG8_SCHED;
            PG8_LDB(B1, 0, 1); PG8_STAGE(PG8_SB(0, 0), b2, voffB);
            PG8_BAR; PG8_WAIT_L(0); PG8_MMA(0, 1, At, B1); PG8_BAR;
            PG8_LDA(At, 0, 1); PG8_STAGE(PG8_SA(0, 0), a2, voffA);
            PG8_BAR; PG8_WAIT_L(0); PG8_MMA(1, 0, At, B0); PG8_BAR; PG8_SCHED;
            PG8_STAGE(PG8_SB(0, 1), b2 + hstep, voffB);
            PG8_WAIT_V(6); PG8_BAR; PG8_MMA(1, 1, At, B1); PG8_BAR;
            PG8_LDB(B0, 1, 0); PG8_SCHED; PG8_LDA(At, 1, 0); PG8_STAGE(PG8_SA(0, 1), a2 + hstep, voffA);
            PG8_WAIT_L(8); PG8_BAR; PG8_WAIT_L(0); PG8_MMA(0, 0, At, B0); PG8_BAR; PG8_SCHED;
            PG8_LDB(B1, 1, 1); PG8_STAGE(PG8_SB(1, 0), b3, voffB);
            PG8_BAR; PG8_WAIT_L(0); PG8_MMA(0, 1, At, B1); PG8_BAR;
            PG8_LDA(At, 1, 1); PG8_STAGE(PG8_SA(1, 0), a3, voffA);
            PG8_BAR; PG8_WAIT_L(0); PG8_MMA(1, 0, At, B0); PG8_BAR; PG8_SCHED;
            PG8_STAGE(PG8_SB(1, 1), b3 + hstep, voffB);
            PG8_WAIT_V(6); PG8_BAR; PG8_MMA(1, 1, At, B1); PG8_BAR;
            }
        }
        if constexpr (ALIGN_EPI) { if (wr == 0) PG8_BAR; }
        if constexpr (!Epi::AFTER_DRAIN) { E(acc, cur, wr, wc, fr, fq); S.done(cur); }
        if (!has_next) break;
#pragma unroll
        for (int a = 0; a < 2; ++a)
#pragma unroll
            for (int b = 0; b < 2; ++b)
#pragma unroll
                for (int m = 0; m < 4; ++m)
#pragma unroll
                    for (int n = 0; n < 2; ++n) acc[a][b][m][n] = (f32x4){0.f, 0.f, 0.f, 0.f};
        cur = nxt; cA = nA; cB = nB; ++ui;
        if constexpr (ALIGN_EPI) { if (wr == 1) PG8_BAR; }
    }
    PG8_WAIT_V(0);
    if constexpr (!ALIGN_EPI) { if (wr == 0) PG8_BAR; }
    PG8_BAR;
    if constexpr (Epi::AFTER_DRAIN) { E.fused(acc, cur, wr, wc, fr, fq, lds, wid, lane); S.done(cur); }
#undef PG8_SA
#undef PG8_SB
#undef PG8_STAGE
#undef PG8_LDA
#undef PG8_LDB
#undef PG8_MMA
#undef PG8_WAIT_V
#undef PG8_WAIT_L
#undef PG8_BAR
#undef PG8_SCHED
}
}
#define GAS __attribute__((address_space(1)))
#define LAS __attribute__((address_space(3)))
typedef unsigned short bf16;
typedef unsigned v4u __attribute__((ext_vector_type(4)));
typedef float f32x4 __attribute__((ext_vector_type(4)));
typedef short bf16x8 __attribute__((ext_vector_type(8)));
typedef GAS unsigned gu32;
typedef GAS unsigned long long gu64;
#define RLX_AGENT __ATOMIC_RELAXED, __HIP_MEMORY_SCOPE_AGENT
#define LDS_WAIT() asm volatile("s_waitcnt lgkmcnt(0)" ::: "memory")
#define VM_WAIT() asm volatile("s_waitcnt vmcnt(0)" ::: "memory")
__device__ __forceinline__ unsigned long long rt() { return __builtin_amdgcn_s_memrealtime(); }
__device__ __forceinline__ unsigned f2bf(float f) { unsigned u = __builtin_bit_cast(unsigned, f); return (u + 0x7fffu + ((u >> 16) & 1u)) >> 16; }
__device__ __forceinline__ unsigned pk2(float lo, float hi) { return f2bf(lo) | (f2bf(hi) << 16); }

#define XB_TMO      128
#define XB_XCNT(j)  (256  + 64 * (j))
#define XB_XSUB(j)  (1280 + 64 * (j))
#define XB_XGEN(j)  (2304 + 64 * (j))
#define XB_TOP      3328
#define XB_TOPGEN   3392
#define XCD_BAR_WORDS 3456
#define XB_SPIN_CAP (1u << 18)

__device__ __forceinline__ unsigned xb_ld(unsigned* p)              { return __hip_atomic_load(p, __ATOMIC_RELAXED, __HIP_MEMORY_SCOPE_AGENT); }
__device__ __forceinline__ unsigned xb_add(unsigned* p, unsigned v) { return __hip_atomic_fetch_add(p, v, __ATOMIC_RELAXED, __HIP_MEMORY_SCOPE_AGENT); }
__device__ __forceinline__ unsigned xb_xcc_id() { return (unsigned)__builtin_amdgcn_s_getreg((3 << 11) | 20) & 0xFu; }
#define XB_SPIN(cond, bar) do { unsigned _sp = 0; while (cond) { __builtin_amdgcn_s_sleep(1); \
    if ((++_sp & 255u) == 0u) { if (xb_ld(&(bar)[XB_TMO])) break; if (_sp > XB_SPIN_CAP) { atomicAdd(&(bar)[XB_TMO], 1u); break; } } } } while (0)

struct XcdBarrier {
    unsigned* bar; unsigned x;
    volatile LAS unsigned* st;
};

__device__ __forceinline__ XcdBarrier xcd_barrier_post(unsigned* bar, volatile LAS unsigned* st) {
    XcdBarrier b; b.bar = bar; b.x = xb_xcc_id(); b.st = st;
    if (threadIdx.x == 0) (void)xb_add(&bar[XB_XCNT(b.x)], 1u);
    return b;
}
__device__ __forceinline__ void xcd_barrier_complete(unsigned* bar, unsigned x, unsigned& nloc, unsigned& nx) {
    const unsigned G = gridDim.x * gridDim.y * gridDim.z;
    unsigned sum, cnt, mine, sp = 0u;
    for (;;) {
        sum = 0u; cnt = 0u; mine = 0u;
#pragma unroll
        for (unsigned j = 0; j < 16; ++j) { const unsigned c = xb_ld(&bar[XB_XCNT(j)]); sum += c; cnt += (c > 0u) ? 1u : 0u; mine = (j == x) ? c : mine; }
        if (sum == G) break;
        __builtin_amdgcn_s_sleep(1);
        if ((++sp & 255u) == 0u) { if (xb_ld(&bar[XB_TMO])) break; if (sp > XB_SPIN_CAP) { atomicAdd(&bar[XB_TMO], 1u); break; } }
    }
    nloc = mine > 0u ? mine : 1u; nx = cnt > 0u ? cnt : 1u;
}

__device__ __forceinline__ void xcd_barrier(const XcdBarrier& b) {
    asm volatile("s_waitcnt vmcnt(0)" ::: "memory");
    __syncthreads();
    if (threadIdx.x == 0) {
        unsigned* bar = b.bar;
        __builtin_amdgcn_s_waitcnt(0);
        unsigned nloc = b.st[0], nx = b.st[1];
        if (nloc == 0u) { xcd_barrier_complete(bar, b.x, nloc, nx); b.st[0] = nloc; b.st[1] = nx; }
        const unsigned old = xb_add(&bar[XB_XSUB(b.x)], 1u);
        const unsigned gen = old / nloc;
        if (old + 1u == (gen + 1u) * nloc) {
            __builtin_amdgcn_fence(__ATOMIC_RELEASE, "agent");
            asm volatile("s_waitcnt vmcnt(0)" ::: "memory");
            const unsigned og = xb_add(&bar[XB_TOP], 1u);
            const unsigned tg = og / nx;
            if (og + 1u == (tg + 1u) * nx) xb_add(&bar[XB_TOPGEN], 1u);
            else XB_SPIN(xb_ld(&bar[XB_TOPGEN]) == tg, bar);
            __builtin_amdgcn_fence(__ATOMIC_ACQUIRE, "agent");
            xb_add(&bar[XB_XGEN(b.x)], 1u);
            asm volatile("s_waitcnt vmcnt(0)" ::: "memory");
        } else {
            XB_SPIN(xb_ld(&bar[XB_XGEN(b.x)]) == gen, bar);
            __builtin_amdgcn_fence(__ATOMIC_ACQUIRE, "agent");
            asm volatile("s_waitcnt vmcnt(0)" ::: "memory");
        }
    }
    __syncthreads();
}


#ifndef STAGE
#define STAGE 3
#endif
#ifndef N_LAUNCH_MODE
#define N_LAUNCH_MODE 1
#endif
#ifndef REP_TK
#define REP_TK 1
#endif
#ifndef REP_AT
#define REP_AT 1
#endif
#ifndef REP_PH
#define REP_PH -1
#endif
#ifndef TK_PREFETCH
#define TK_PREFETCH 1
#endif
#ifndef DBG_C
#define DBG_C 0.0f
#endif

typedef float f32x16 __attribute__((ext_vector_type(16)));
typedef __attribute__((ext_vector_type(2))) __bf16 bf16x2_t;
using pg8::bf16_t; using pg8::Unit;

constexpr int M = 16384, DM = 1024, NHEAD = 8, HD = 64, AW = 512, PW = 512, FF = 2816, FF2 = 5632, NIN = 4420, NINP = 4608, NMOD = 6144;
constexpr float EPS = 1e-6f;
constexpr int NWAVES = 8, NTHR = 512;

constexpr size_t MiB = 1u << 20;
constexpr size_t WS_CTL = 0, CTL_ZERO_BYTES = 64 * 1024;
constexpr size_t WS_WIN = 1 * MiB, WS_WATTN = 10 * MiB, WS_WGRP = 11 * MiB, WS_WPOOL = 11 * MiB + 512 * 1024, WS_WOUT = 12 * MiB + 512 * 1024,
                 WS_WUP = 14 * MiB + 512 * 1024, WS_WDOWN = 25 * MiB + 512 * 1024;
constexpr size_t WS_MODP = 31 * MiB, WS_MODF = 31 * MiB + 393216, WS_WI = 31 * MiB + 512 * 1024;
constexpr size_t WS_H = 32 * MiB;
constexpr size_t WS_Q = 64 * MiB, WS_K = 80 * MiB, WS_V = 96 * MiB;
constexpr size_t WS_SEL = 88 * MiB;
constexpr size_t WS_QI = 112 * MiB, WS_KI = 120 * MiB;
constexpr size_t WS_UPOOL = 128 * MiB, WS_POOLED = 144 * MiB, WS_POOLMIX = 160 * MiB, WS_ATTN = 176 * MiB;
constexpr size_t WS_GA = 192 * MiB, WS_GP = 224 * MiB;
constexpr size_t WS_ACT = 64 * MiB;
constexpr size_t WS_RAW = 152 * MiB;
constexpr size_t WS_END = 256 * MiB;
constexpr int CW_BAR = 1024, CW_QUEUE = 512;

constexpr int LDS_BYTES = 163840;
constexpr int HSTRIDE = 1025, MSTRIDE = 513;
constexpr int LIST_OFF = 135168, ST_OFF = 151552, MISC_OFF = 159744;

#define SYNC() __syncthreads()
__device__ __forceinline__ float wave_sum(float v) {
#pragma unroll
    for (int o = 1; o < 64; o <<= 1) v += __shfl_xor(v, o);
    return v;
}
__device__ __forceinline__ float bf_lo(unsigned w) { return __builtin_bit_cast(float, w << 16); }
__device__ __forceinline__ float bf_hi(unsigned w) { return __builtin_bit_cast(float, w & 0xffff0000u); }
__device__ __forceinline__ float sigmoidf_(float x) { return __builtin_amdgcn_rcpf(1.0f + __expf(-x)); }
__device__ __forceinline__ unsigned pkbf(float lo, float hi) { return pg8::cvt_pk_bf16(lo, hi); }
typedef unsigned u32x2 __attribute__((ext_vector_type(2)));
__device__ __forceinline__ u32x2 pk4(f32x4 v) { u32x2 r; r.x = pkbf(v[0], v[1]); r.y = pkbf(v[2], v[3]); return r; }
__device__ __forceinline__ unsigned pk4_fp8(f32x4 v) { int w = 0; w = __builtin_amdgcn_cvt_pk_fp8_f32(v[0], v[1], w, false); w = __builtin_amdgcn_cvt_pk_fp8_f32(v[2], v[3], w, true); return (unsigned)w; }

__device__ __forceinline__ void tr_item(const float* W, int ldw, int src_col, int nvalid, int k0, bf16_t* WT, int K, int dst_row, LAS float* scr, int lane) {
    f32x4 v[8];
#pragma unroll
    for (int i = 0; i < 8; ++i) { const int kk = 8 * i + (lane >> 3), n4 = 4 * (lane & 7);
        v[i] = (f32x4){0.f, 0.f, 0.f, 0.f}; if (W != nullptr && n4 < nvalid) v[i] = *(const f32x4*)(W + (size_t)(k0 + kk) * ldw + src_col + n4); }
#pragma unroll
    for (int i = 0; i < 8; ++i) { const int kk = 8 * i + (lane >> 3), n4 = 4 * (lane & 7); LAS float* p = scr + kk * 33 + n4; p[0] = v[i][0]; p[1] = v[i][1]; p[2] = v[i][2]; p[3] = v[i][3]; }
    LDS_WAIT(); asm volatile("" ::: "memory");
    const int c = lane & 7;
#pragma unroll
    for (int j = 0; j < 4; ++j) { const int n = (lane >> 3) + 8 * j; const LAS float* s = scr + (8 * c) * 33 + n;
        v4u o; o.x = pk2(s[0 * 33], s[1 * 33]); o.y = pk2(s[2 * 33], s[3 * 33]); o.z = pk2(s[4 * 33], s[5 * 33]); o.w = pk2(s[6 * 33], s[7 * 33]);
        *(GAS v4u*)(WT + (size_t)(dst_row + n) * K + k0 + 8 * c) = o; }
    LDS_WAIT(); asm volatile("" ::: "memory");
}

struct P0Ptrs { const float *c, *w_ada, *w_in, *w_attn, *w_grp, *w_pool, *w_out, *w_up, *w_down, *pscale; bf16_t *WIN, *WATTN, *WGRP, *WPOOL, *WOUT, *WUP, *WDOWN; float* MODP; };
__device__ __forceinline__ void p0_prologue(const P0Ptrs& P, LAS unsigned char* lds, int gw, int NGW, int wave, int lane) {
    LAS float* scr = (LAS float*)(lds + wave * 16384);
    LAS float* sil = (LAS float*)(lds + 131072);
    for (int i = threadIdx.x; i < 1024; i += NTHR) { const float cv = P.c[i]; sil[i] = cv / (1.0f + __expf(-cv)); }
    SYNC();
    constexpr int I_WIN = 144 * 16, I_WATTN = 32 * 8, I_WGRP = 128, I_WPOOL = 32 * 8, I_WOUT = 32 * 16, I_WUP = 176 * 16, I_WDOWN = 32 * 44, I_MOD = 96 * 16;
    constexpr int NITEMS = I_WIN + I_WATTN + I_WGRP + I_WPOOL + I_WOUT + I_WUP + I_WDOWN + I_MOD;
    for (int it = gw; it < NITEMS; it += NGW) {
        int r = it;
        if (r < I_MOD) {
            const int cb = r % 96, kc = r / 96, col = cb * 64 + lane; float acc = 0.f;
#pragma unroll 8
            for (int i = 0; i < 64; ++i) { const int k = kc * 64 + i; acc = fmaf(sil[k], P.w_ada[(size_t)k * NMOD + col], acc); }
            P.MODP[kc * NMOD + col] = acc; continue; }
        r -= I_MOD;
        if (r < I_WIN) { const int g = r / 16, kb = r % 16, tile = g >> 3, gi = g & 7; int src = -1, nv = 32;
            const int permgi = gi < 4 ? 64 * gi : 64 * (gi - 4) + 32;
            if (tile < 2) src = tile * 256 + permgi;
            else if (tile < 4) src = 512 + (tile - 2) * 256 + permgi;
            else if (tile < 6) src = 1024 + (tile - 4) * 256 + 32 * gi;
            else if (tile == 6) src = 1536 + 32 * gi;
            else if (tile == 7) { if (gi < 2) src = 1792 + 32 * gi; else if (gi == 2) { src = 1856; nv = 4; } }
            else if (tile < 10) src = 1860 + (tile - 8) * 256 + 32 * gi;
            else if (tile < 14) src = 2372 + (tile - 10) * 256 + 32 * gi;
            else src = 3396 + (tile - 14) * 256 + 32 * gi;
            tr_item(src >= 0 ? P.w_in : nullptr, NIN, src >= 0 ? src : 0, nv, kb * 64, P.WIN, 1024, g * 32, scr, lane); continue; }
        r -= I_WIN;
        if (r < I_WATTN) { tr_item(P.w_attn, 1024, (r / 8) * 32, 32, (r % 8) * 64, P.WATTN, 512, (r / 8) * 32, scr, lane); continue; }
        r -= I_WATTN;
        if (r < I_WGRP) {
            const int row = 4 * r + (lane >> 4), g = row >> 7; const float* src = P.w_grp + (size_t)g * 16384 + (size_t)(row & 127) * 128;
#pragma unroll
            for (int q = 0; q < 4; ++q) { const int d0 = 32 * (lane & 15) + 8 * q; v4u o = (v4u){0u, 0u, 0u, 0u};
                if ((d0 >> 7) == g) { const f32x4 a = *(const f32x4*)(src + (d0 & 127)) * *(const f32x4*)(P.pscale + d0), b = *(const f32x4*)(src + (d0 & 127) + 4) * *(const f32x4*)(P.pscale + d0 + 4);
                    o.x = pk2(a[0], a[1]); o.y = pk2(a[2], a[3]); o.z = pk2(b[0], b[1]); o.w = pk2(b[2], b[3]); }
                *(GAS v4u*)(P.WGRP + (size_t)row * 512 + d0) = o; }
            continue; }
        r -= I_WGRP;
        if (r < I_WPOOL) { tr_item(P.w_pool, 1024, (r / 8) * 32, 32, (r % 8) * 64, P.WPOOL, 512, (r / 8) * 32, scr, lane); continue; }
        r -= I_WPOOL;
        if (r < I_WOUT) { tr_item(P.w_out, 1024, (r / 16) * 32, 32, (r % 16) * 64, P.WOUT, 1024, (r / 16) * 32, scr, lane); continue; }
        r -= I_WOUT;
        if (r < I_WUP) { const int g = r / 16, kb = r % 16, tile = g >> 3, gi = g & 7;
            const int src = gi < 4 ? 128 * tile + 32 * gi : FF + 128 * tile + 32 * (gi - 4);
            tr_item(P.w_up, FF2, src, 32, kb * 64, P.WUP, 1024, g * 32, scr, lane); continue; }
        r -= I_WUP;
        { tr_item(P.w_down, 1024, (r / 44) * 32, 32, (r % 44) * 64, P.WDOWN, FF, (r / 44) * 32, scr, lane); }
    }
}

__device__ __forceinline__ void modulate_rows(const float* X, bf16_t* O, const LAS float* mulv, const LAS float* addv, int gw, int NGW, int lane) {
    f32x4 mu[4], ad[4];
#pragma unroll
    for (int j = 0; j < 4; ++j) { mu[j] = *(const LAS f32x4*)(mulv + 4 * lane + 256 * j); ad[j] = *(const LAS f32x4*)(addv + 4 * lane + 256 * j); }
    for (int row = gw; row < M; row += NGW) {
        const GAS f32x4* xr = (const GAS f32x4*)(X + (size_t)row * DM) + lane;
        f32x4 v[4]; float s = 0.f;
#pragma unroll
        for (int j = 0; j < 4; ++j) { v[j] = xr[64 * j]; s += (v[j].x * v[j].x + v[j].y * v[j].y) + (v[j].z * v[j].z + v[j].w * v[j].w); }
        const float rstd = 1.0f / sqrtf(wave_sum(s) * (1.0f / DM) + EPS);
        GAS u32x2* o8 = (GAS u32x2*)(O + (size_t)row * DM) + lane;
#pragma unroll
        for (int j = 0; j < 4; ++j) { const f32x4 y = v[j] * rstd * mu[j] + ad[j]; o8[64 * j] = pk4(y); }
    }
}

struct EpiProj {
    static constexpr bool PERM = false, AFTER_DRAIN = false;
    bf16_t *Q; unsigned char *K8, *V8; bf16_t *QI, *KI, *UPOOL, *GA, *GP; float* WI; const float *qg, *kg;
    __device__ __forceinline__ void operator()(const pg8::f32x4 (&acc)[2][2][4][2], const Unit& u, int wr, int wc, int fr, int fq) const {
        const int pn = u.pn, row0 = u.pm * 256 + wr * 64 + fr;
        if (pn < 4) {
            const bool isq = pn < 2; const float* g = isq ? qg : kg; const int head = (pn & 1) * 4 + wc;
            f32x4 gv[2][2];
#pragma unroll
            for (int bj = 0; bj < 2; ++bj)
#pragma unroll
                for (int n = 0; n < 2; ++n) gv[bj][n] = *(const f32x4*)(g + 32 * bj + 16 * n + 4 * fq);
#pragma unroll
            for (int ai = 0; ai < 2; ++ai)
#pragma unroll
                for (int m = 0; m < 4; ++m) {
                    float ss = 0.f;
#pragma unroll
                    for (int bj = 0; bj < 2; ++bj)
#pragma unroll
                        for (int n = 0; n < 2; ++n) { const f32x4 x = acc[ai][bj][m][n]; ss += (x[0] * x[0] + x[1] * x[1]) + (x[2] * x[2] + x[3] * x[3]); }
                    ss += __shfl_xor(ss, 16); ss += __shfl_xor(ss, 32);
                    const float rstd = 1.0f / sqrtf(ss * (1.0f / 64.0f) + EPS);
                    const size_t ro = (size_t)(row0 + ai * 128 + m * 16) * AW + head * 64 + 4 * fq;
#pragma unroll
                    for (int bj = 0; bj < 2; ++bj)
#pragma unroll
                        for (int n = 0; n < 2; ++n) { const f32x4 y = acc[ai][bj][m][n] * rstd * gv[bj][n];
                            if (isq) *(u32x2*)(Q + ro + 32 * bj + 16 * n) = pk4(y); else *(unsigned*)(K8 + ((size_t)head * M + (row0 + ai * 128 + m * 16)) * 128 + 4 * fq + 32 * bj + 16 * n) = pk4_fp8(y); }
                }
            return;
        }
        const int colw = wc * 32 + 4 * fq;
        if (pn == 7) {
#pragma unroll
            for (int ai = 0; ai < 2; ++ai)
#pragma unroll
                for (int m = 0; m < 4; ++m) { const int row = row0 + ai * 128 + m * 16;
                    if (wc < 2) {
#pragma unroll
                        for (int n = 0; n < 2; ++n) { const int c = colw + 16 * n; *(u32x2*)(KI + (size_t)(row >> 5) * 2048 + (c >> 4) * 512 + ((((c >> 3) & 1) * 32 + (row & 31)) * 8) + (c & 7)) = pk4(acc[ai][0][m][n]); }
                    } else if (wc == 2 && fq == 0) { *(f32x4*)(WI + (size_t)row * 4) = acc[ai][0][m][0] * 0.5f; }
                }
            return;
        }
        if (pn < 6) {
#pragma unroll
            for (int ai = 0; ai < 2; ++ai)
#pragma unroll
                for (int m = 0; m < 4; ++m) { const int row = row0 + ai * 128 + m * 16;
#pragma unroll
                    for (int bj = 0; bj < 2; ++bj)
#pragma unroll
                        for (int n = 0; n < 2; ++n) { const int col = (pn - 4) * 256 + colw + 128 * bj + 16 * n;
                            *(unsigned*)(V8 + ((size_t)(col >> 6) * M + row) * 128 + 64 + (col & 63)) = pk4_fp8(acc[ai][bj][m][n]); } }
            return;
        }
        bf16_t* O; int ldo, ct; float sc = 1.0f; bool sig = false;
        if (pn == 6) { O = QI; ldo = 256; ct = 0; sc = 0.125f; }
        else if (pn < 10) { O = UPOOL; ldo = PW; ct = (pn - 8) * 256; }
        else if (pn < 14) { O = GA; ldo = DM; ct = (pn - 10) * 256; sig = true; }
        else { O = GP; ldo = DM; ct = (pn - 14) * 256; sig = true; }
#pragma unroll
        for (int ai = 0; ai < 2; ++ai)
#pragma unroll
            for (int m = 0; m < 4; ++m) { bf16_t* rowp = O + (size_t)(row0 + ai * 128 + m * 16) * ldo + ct + colw;
#pragma unroll
                for (int bj = 0; bj < 2; ++bj)
#pragma unroll
                    for (int n = 0; n < 2; ++n) { f32x4 y = acc[ai][bj][m][n] * sc;
                        if (sig) { y[0] = sigmoidf_(y[0]); y[1] = sigmoidf_(y[1]); y[2] = sigmoidf_(y[2]); y[3] = sigmoidf_(y[3]); }
                        *(u32x2*)(rowp + 128 * bj + 16 * n) = pk4(y); }
            }
    }
};

template <int MODE> struct EpiBf {
    static constexpr bool PERM = false, AFTER_DRAIN = false;
    bf16_t* O; int ldo; const float* colscale; const bf16_t* ADD;
    __device__ __forceinline__ void operator()(const pg8::f32x4 (&acc)[2][2][4][2], const Unit& u, int wr, int wc, int fr, int fq) const {
        const int row0 = u.pm * 256 + wr * 64 + fr, col0 = u.pn * 256 + wc * 32 + 4 * fq;
#pragma unroll
        for (int ai = 0; ai < 2; ++ai)
#pragma unroll
            for (int m = 0; m < 4; ++m) { const size_t ro = (size_t)(row0 + ai * 128 + m * 16) * ldo + col0;
#pragma unroll
                for (int bj = 0; bj < 2; ++bj)
#pragma unroll
                    for (int n = 0; n < 2; ++n) { f32x4 y = acc[ai][bj][m][n]; const size_t off = ro + 128 * bj + 16 * n;
                        if (MODE == 3) { }
                        else if (MODE == 0) { y = y * *(const f32x4*)(colscale + col0 + 128 * bj + 16 * n); }
                        else { const u32x2 gq = *(const u32x2*)(O + off); y[0] *= bf_lo(gq.x); y[1] *= bf_hi(gq.x); y[2] *= bf_lo(gq.y); y[3] *= bf_hi(gq.y);
                            if (MODE == 2) { const u32x2 a = *(const u32x2*)(ADD + off); y[0] += bf_lo(a.x); y[1] += bf_hi(a.x); y[2] += bf_lo(a.y); y[3] += bf_hi(a.y); } }
                        *(u32x2*)(O + off) = pk4(y); }
            }
    }
};

struct EpiRes {
    static constexpr bool PERM = false, AFTER_DRAIN = false;
    const float* BASE; float* OUT; const float* gate; float dbg;
    __device__ __forceinline__ void operator()(const pg8::f32x4 (&acc)[2][2][4][2], const Unit& u, int wr, int wc, int fr, int fq) const {
        const int row0 = u.pm * 256 + wr * 64 + fr, col0 = u.pn * 256 + wc * 32 + 4 * fq;
        f32x4 gv[2][2];
#pragma unroll
        for (int bj = 0; bj < 2; ++bj)
#pragma unroll
            for (int n = 0; n < 2; ++n) gv[bj][n] = *(const f32x4*)(gate + col0 + 128 * bj + 16 * n);
#pragma unroll
        for (int ai = 0; ai < 2; ++ai)
#pragma unroll
            for (int m = 0; m < 4; ++m) { const int row = row0 + ai * 128 + m * 16; const size_t ro = (size_t)row * DM + col0;
#pragma unroll
                for (int bj = 0; bj < 2; ++bj)
#pragma unroll
                    for (int n = 0; n < 2; ++n) { const size_t off = ro + 128 * bj + 16 * n; f32x4 y = *(const f32x4*)(BASE + off) + gv[bj][n] * acc[ai][bj][m][n];
                        if (dbg != 0.f) { const float sg = ((row * 7 + (int)(off >> 2)) & 1) ? dbg : -dbg; y[0] += sg; y[1] -= sg; y[2] += sg; y[3] -= sg; }
                        *(f32x4*)(OUT + off) = y; }
            }
    }
};

template <int CTRL> __device__ __forceinline__ float dppf(float x) { return __builtin_bit_cast(float, __builtin_amdgcn_update_dpp(0, __builtin_bit_cast(int, x), CTRL, 0xf, 0xf, false)); }
__device__ __forceinline__ f32x4 ror1(f32x4 v) { f32x4 r; r[0] = dppf<0x121>(v[0]); r[1] = dppf<0x121>(v[1]); r[2] = dppf<0x121>(v[2]); r[3] = dppf<0x121>(v[3]); return r; }
__device__ __forceinline__ f32x4 ror2(f32x4 v) { f32x4 r; r[0] = dppf<0x122>(v[0]); r[1] = dppf<0x122>(v[1]); r[2] = dppf<0x122>(v[2]); r[3] = dppf<0x122>(v[3]); return r; }
__device__ __forceinline__ f32x4 silu_mul(f32x4 a, f32x4 b) { f32x4 r;
#pragma unroll
    for (int e = 0; e < 4; ++e) r[e] = a[e] * __builtin_amdgcn_rcpf(1.0f + __expf(-a[e])) * b[e];
    return r; }
struct EpiUpAct {
    static constexpr bool PERM = false, AFTER_DRAIN = false;
    bf16_t* ACT; float* RAW; const float* cw; const float* cb;
    __device__ __forceinline__ void operator()(const pg8::f32x4 (&acc)[2][2][4][2], const Unit& u, int wr, int wc, int fr, int fq) const {
#pragma unroll
        for (int n = 0; n < 2; ++n) {
            const int ch = u.pn * 128 + wc * 32 + 4 * fq + 16 * n;
            const f32x4 w0a = *(const f32x4*)(cw + ch), w1a = *(const f32x4*)(cw + FF2 + ch), w2a = *(const f32x4*)(cw + 2 * FF2 + ch), ba = *(const f32x4*)(cb + ch);
            const f32x4 w0b = *(const f32x4*)(cw + FF + ch), w1b = *(const f32x4*)(cw + FF2 + FF + ch), w2b = *(const f32x4*)(cw + 2 * FF2 + FF + ch), bb = *(const f32x4*)(cb + FF + ch);
#pragma unroll
            for (int ai = 0; ai < 2; ++ai) {
                const int blk = u.pm * 4 + ai * 2 + wr;
                if (fr < 2) { *(f32x4*)(RAW + (size_t)(blk * 4 + fr) * FF2 + ch) = acc[ai][0][0][n]; *(f32x4*)(RAW + (size_t)(blk * 4 + fr) * FF2 + FF + ch) = acc[ai][1][0][n]; }
                if (fr >= 14) { *(f32x4*)(RAW + (size_t)(blk * 4 + fr - 12) * FF2 + ch) = acc[ai][0][3][n]; *(f32x4*)(RAW + (size_t)(blk * 4 + fr - 12) * FF2 + FF + ch) = acc[ai][1][3][n]; }
                f32x4 pa1 = {0.f, 0.f, 0.f, 0.f}, pa2 = pa1, pb1 = pa1, pb2 = pa1;
#pragma unroll
                for (int m = 0; m < 4; ++m) {
                    const f32x4 va = acc[ai][0][m][n], vb = acc[ai][1][m][n];
                    const f32x4 ra1 = ror1(va), ra2 = ror2(va), rb1 = ror1(vb), rb2 = ror2(vb);
                    const f32x4 xa1 = fr >= 1 ? ra1 : pa1, xa2 = fr >= 2 ? ra2 : pa2, xb1 = fr >= 1 ? rb1 : pb1, xb2 = fr >= 2 ? rb2 : pb2;
                    pa1 = ra1; pa2 = ra2; pb1 = rb1; pb2 = rb2;
                    const f32x4 ya = ba + w0a * xa2 + w1a * xa1 + w2a * va, yb = bb + w0b * xb2 + w1b * xb1 + w2b * vb;
                    const f32x4 o = silu_mul(ya, yb);
                    if (!(m == 0 && fr < 2)) *(u32x2*)(ACT + (size_t)(blk * 64 + 16 * m + fr) * FF + ch) = pk4(o);
                }
            }
        }
    }
};

__device__ __forceinline__ void fixup_phase(const float* RAW, bf16_t* ACT, const float* cw, const float* cb, int gtid, int nthr) {
    for (int it = gtid; it < 256 * 2 * 704; it += nthr) {
        const int c4 = it % 704, rr = (it / 704) & 1, blk = it / 1408, ch = 4 * c4;
        const float* cur = RAW + (size_t)(blk * 4 + rr) * FF2;
        const float* p1 = rr == 1 ? RAW + (size_t)(blk * 4) * FF2 : (blk > 0 ? RAW + (size_t)((blk - 1) * 4 + 3) * FF2 : nullptr);
        const float* p2 = rr == 1 ? (blk > 0 ? RAW + (size_t)((blk - 1) * 4 + 3) * FF2 : nullptr) : (blk > 0 ? RAW + (size_t)((blk - 1) * 4 + 2) * FF2 : nullptr);
        const f32x4 z = {0.f, 0.f, 0.f, 0.f};
        const f32x4 va = *(const f32x4*)(cur + ch), vb = *(const f32x4*)(cur + FF + ch);
        const f32x4 a1 = p1 ? *(const f32x4*)(p1 + ch) : z, b1 = p1 ? *(const f32x4*)(p1 + FF + ch) : z;
        const f32x4 a2 = p2 ? *(const f32x4*)(p2 + ch) : z, b2 = p2 ? *(const f32x4*)(p2 + FF + ch) : z;
        const f32x4 ya = *(const f32x4*)(cb + ch) + *(const f32x4*)(cw + ch) * a2 + *(const f32x4*)(cw + FF2 + ch) * a1 + *(const f32x4*)(cw + 2 * FF2 + ch) * va;
        const f32x4 yb = *(const f32x4*)(cb + FF + ch) + *(const f32x4*)(cw + FF + ch) * b2 + *(const f32x4*)(cw + FF2 + FF + ch) * b1 + *(const f32x4*)(cw + 2 * FF2 + FF + ch) * vb;
        *(u32x2*)(ACT + (size_t)(blk * 64 + rr) * FF + ch) = pk4(silu_mul(ya, yb));
    }
}

template <int W> __device__ __forceinline__ void pooled_item(const bf16_t* UPOOL, bf16_t* POOLED, int t, int c8) {
    v4u v[W];
#pragma unroll
    for (int j = 0; j < W; ++j) { const int tj = (t - j) >= 0 ? (t - j) : 0; v[j] = *(const v4u*)(UPOOL + (size_t)tj * PW + 8 * c8); }
    float s[8];
#pragma unroll
    for (int e = 0; e < 8; ++e) s[e] = 0.f;
#pragma unroll
    for (int j = 0; j < W; ++j) { const float m = (t - j) >= 0 ? 1.f : 0.f;
        s[0] = fmaf(m, bf_lo(v[j].x), s[0]); s[1] = fmaf(m, bf_hi(v[j].x), s[1]); s[2] = fmaf(m, bf_lo(v[j].y), s[2]); s[3] = fmaf(m, bf_hi(v[j].y), s[3]);
        s[4] = fmaf(m, bf_lo(v[j].z), s[4]); s[5] = fmaf(m, bf_hi(v[j].z), s[5]); s[6] = fmaf(m, bf_lo(v[j].w), s[6]); s[7] = fmaf(m, bf_hi(v[j].w), s[7]); }
    const int cntw = (t + 1) < W ? (t + 1) : W; const float inv = 1.0f / (float)cntw; v4u o;
    o.x = pkbf(s[0] * inv - bf_lo(v[0].x), s[1] * inv - bf_hi(v[0].x)); o.y = pkbf(s[2] * inv - bf_lo(v[0].y), s[3] * inv - bf_hi(v[0].y));
    o.z = pkbf(s[4] * inv - bf_lo(v[0].z), s[5] * inv - bf_hi(v[0].z)); o.w = pkbf(s[6] * inv - bf_lo(v[0].w), s[7] * inv - bf_hi(v[0].w));
    *(v4u*)(POOLED + (size_t)t * PW + 8 * c8) = o;
}
__device__ __forceinline__ void pooled_phase(const bf16_t* UPOOL, bf16_t* POOLED, int gtid, int nthr) {
    for (int it = gtid; it < M * 64; it += nthr) {
        const int wv = it >> 6, l = it & 63, g = wv & 3, t = (wv >> 2) * 4 + (l >> 4), c8 = g * 16 + (l & 15);
        if (g == 0) pooled_item<2>(UPOOL, POOLED, t, c8); else if (g == 1) pooled_item<4>(UPOOL, POOLED, t, c8); else if (g == 2) pooled_item<8>(UPOOL, POOLED, t, c8); else pooled_item<16>(UPOOL, POOLED, t, c8);
    }
}

#define MFMA32(a, b, c) __builtin_amdgcn_mfma_f32_32x32x16_bf16((a), (b), (c), 0, 0, 0)
__device__ __forceinline__ unsigned lds_add(LAS unsigned* p, unsigned v) { return __hip_atomic_fetch_add(p, v, __ATOMIC_RELAXED, __HIP_MEMORY_SCOPE_WORKGROUP); }
__device__ __forceinline__ unsigned lds_or(LAS unsigned* p, unsigned v) { return __hip_atomic_fetch_or(p, v, __ATOMIC_RELAXED, __HIP_MEMORY_SCOPE_WORKGROUP); }

__device__ __forceinline__ float u2f(unsigned u) { return __uint_as_float((u & 0x80000000u) ? (u & 0x7fffffffu) : ~u); }
template <bool EMIT>
__device__ __forceinline__ void tk_pass(int qb, int wave, int lane, const bf16_t* KI, const LAS bf16_t* QF, const float (&wv)[4], LAS unsigned* H, LAS unsigned* SELM, LAS unsigned* TIEM,
                                        int sh, unsigned vlo, bool clampTop, unsigned bmax, int stage, unsigned vmin, float fsel, float ftie) {
    const int r = lane & 31, h = lane >> 5;
    const int gstep = stage == 1 ? 8 : 1, g0 = stage == 1 ? wave : 0;
#define TK_NEXT_G(g) ({ int _g = (g) + gstep; if (stage == 2 && (_g & 7) == wave) ++_g; _g; })
    int gcur = g0; if (stage == 2 && (gcur & 7) == wave) ++gcur;
    pg8::bf16x8 kf[4];
    { const int T0 = (wave + 8 * gcur) <= qb ? (wave + 8 * gcur) : qb; const bf16_t* kp = KI + (size_t)T0 * 2048 + 8 * lane;
#pragma unroll
      for (int s = 0; s < 4; ++s) kf[s] = *(const pg8::bf16x8*)(kp + 512 * s); }
    LAS unsigned* Hq = H + r * HSTRIDE;
#pragma unroll 1
    for (; wave + 8 * gcur <= qb; gcur = TK_NEXT_G(gcur)) {
        const int T = wave + 8 * gcur;
        float sc[16];
#pragma unroll
        for (int i = 0; i < 16; ++i) sc[i] = 0.f;
#pragma unroll
        for (int hd = 0; hd < 4; ++hd) { f32x16 a;
#pragma unroll
            for (int i = 0; i < 16; ++i) a[i] = 0.f;
#pragma unroll
            for (int s = 0; s < 4; ++s) a = MFMA32(kf[s], *(const LAS pg8::bf16x8*)(QF + (hd * 4 + s) * 512 + lane * 8), a);
#pragma unroll
            for (int i = 0; i < 16; ++i) { const float av = a[i]; const int ab = __float_as_int(av); sc[i] = fmaf(wv[hd], __int_as_float(ab > 0 ? ab : 0), sc[i]); } }
        { const int Tnn = wave + 8 * TK_NEXT_G(gcur); const int Tn = Tnn <= qb ? Tnn : T; const bf16_t* kp = KI + (size_t)Tn * 2048 + 8 * lane;
#pragma unroll
          for (int s = 0; s < 4; ++s) kf[s] = *(const pg8::bf16x8*)(kp + 512 * s); }
        const int rlim = (T == qb) ? r : 64;
        if (!EMIT) {
#pragma unroll
            for (int i = 0; i < 16; ++i) {
                const int kr = (i & 3) + 8 * (i >> 2) + 4 * h;
                unsigned uu = __float_as_uint(sc[i]); uu ^= ((unsigned)((int)uu >> 31)) | 0x80000000u;
                const unsigned v = uu >> sh; unsigned b = v - vlo;
                const bool ok = (kr <= rlim) && (v >= vmin) && (clampTop || b <= bmax);
                b = b > 2047u ? 2047u : b;
                lds_add(Hq + (ok ? (b >> 1) : 1024u), 1u << ((b & 1u) * 16u));
            }
        } else {
            unsigned ms = 0u, mg = 0u;
#pragma unroll
            for (int i = 15; i >= 0; --i) {
                asm("v_cmp_ge_f32_e32 vcc, %1, %2\n\tv_addc_co_u32_e32 %0, vcc, %0, %0, vcc" : "+v"(ms) : "v"(sc[i]), "v"(fsel) : "vcc");
                asm("v_cmp_ge_f32_e32 vcc, %1, %2\n\tv_addc_co_u32_e32 %0, vcc, %0, %0, vcc" : "+v"(mg) : "v"(sc[i]), "v"(ftie) : "vcc");
            }
            const unsigned vrow = rlim >= 31 ? 0xffffffffu : ((2u << rlim) - 1u);
            auto spread = [&](unsigned m) { return (((m & 0xfu) | ((m & 0xf0u) << 4) | ((m & 0xf00u) << 8) | ((m & 0xf000u) << 12)) << (4 * h)) & vrow; };
            const unsigned msel = spread(ms), mtie = spread(mg) & ~msel;
            const unsigned osel = __shfl_xor(msel, 32), otie = __shfl_xor(mtie, 32);
            if (h == 0) { SELM[r * MSTRIDE + T] = msel | osel; TIEM[r * MSTRIDE + T] = mtie | otie; }
        }
    }
#undef TK_NEXT_G
}

template <int CTRL> __device__ __forceinline__ float dppx(float x) { return __builtin_bit_cast(float, __builtin_amdgcn_mov_dpp(__builtin_bit_cast(int, x), CTRL, 0xf, 0xf, true)); }
__device__ __forceinline__ u32x2 tk_rescore_load(const bf16_t* KI, int key, int lane) {
    const int c = 4 * (lane & 15);
    return *(const u32x2*)(KI + (size_t)(key >> 5) * 2048 + (c >> 4) * 512 + ((((c >> 3) & 1) * 32 + (key & 31)) * 8) + (c & 7));
}
__device__ __forceinline__ float tk_rescore(const u32x2 q4, float wh, const u32x2 k4) {
    float d = bf_lo(q4.x) * bf_lo(k4.x); d = fmaf(bf_hi(q4.x), bf_hi(k4.x), d); d = fmaf(bf_lo(q4.y), bf_lo(k4.y), d); d = fmaf(bf_hi(q4.y), bf_hi(k4.y), d);
    d += dppx<0xB1>(d); d += dppx<0x4E>(d); d += dppx<0x141>(d); d += dppx<0x140>(d);
    float sc = wh * fmaxf(d, 0.f);
    sc += __shfl_xor(sc, 16); sc += __shfl_xor(sc, 32);
    return sc + 0.f;
}

__device__ __forceinline__ int wave_incl_scan(int v) {
    v += __builtin_amdgcn_update_dpp(0, v, 0x111, 0xf, 0xf, true); v += __builtin_amdgcn_update_dpp(0, v, 0x112, 0xf, 0xf, true);
    v += __builtin_amdgcn_update_dpp(0, v, 0x114, 0xf, 0xf, true); v += __builtin_amdgcn_update_dpp(0, v, 0x118, 0xf, 0xf, true);
    v += __builtin_amdgcn_update_dpp(0, v, 0x142, 0xa, 0xf, false); v += __builtin_amdgcn_update_dpp(0, v, 0x143, 0xc, 0xf, false);
    return v;
}
__device__ __forceinline__ void tk_scan(const LAS unsigned* Hq, LAS unsigned* pref_p, LAS unsigned* need_p, LAS unsigned* cnt_p, int bits, int lane) {
    const int need = (int)*need_p;
    int S = 0;
#pragma unroll
    for (int i = 0; i < 16; ++i) { const unsigned w = Hq[16 * lane + ((i + lane) & 15)]; S += (int)((w & 0xffffu) + (w >> 16)); }
    const int incl = wave_incl_scan(S), total = __builtin_amdgcn_readlane(incl, 63), Tabove = total - incl;
    const bool hit = (Tabove < need) && (need <= Tabove + S);
    const unsigned long long mk = __ballot(hit);
    const int L = mk ? (int)__builtin_ctzll(mk) : 0;
    const int remL = need - __builtin_amdgcn_readlane(Tabove, L);
    const unsigned w2 = Hq[16 * L + ((lane & 31) >> 1)];
    const int c = lane < 32 ? (int)((w2 >> (16 * (lane & 1))) & 0xffffu) : 0;
    const int incl2 = wave_incl_scan(c), tot2 = __builtin_amdgcn_readlane(incl2, 63), above2 = tot2 - incl2;
    const bool hit2 = (lane < 32) && (above2 < remL) && (remL <= above2 + c);
    const unsigned long long mk2 = __ballot(hit2);
    const int J = mk2 ? (int)__builtin_ctzll(mk2) : 0;
    const unsigned Dsel = (unsigned)(32 * L + J), nsel = mk2 ? (unsigned)(remL - __builtin_amdgcn_readlane(above2, J)) : 1u, csel = (unsigned)__builtin_amdgcn_readlane(c, J);
    if (lane == 0) { *pref_p = bits ? ((*pref_p << bits) | Dsel) : Dsel; *need_p = nsel; if (cnt_p) *cnt_p = csel; }
}

typedef float f32x2_t __attribute__((ext_vector_type(2)));
__device__ __forceinline__ void unpack16(const v4u w, f32x2_t (&f)[8]) {
#pragma unroll
    for (int i = 0; i < 4; ++i) { f[2 * i] = __builtin_amdgcn_cvt_pk_f32_fp8((int)w[i], false); f[2 * i + 1] = __builtin_amdgcn_cvt_pk_f32_fp8((int)w[i], true); }
}
__device__ __forceinline__ void attn_item(int t, int hd, const unsigned short* SEL, const bf16_t* Q, const unsigned char* K8, const unsigned char* V8, bf16_t* ATTN, int lane) {
    constexpr float LOG2E = 1.4426950408889634f;
    const int kk = lane >> 2, part = lane & 3, cnt = (t + 1) < 256 ? (t + 1) : 256;
    const float slope2 = __uint_as_float((unsigned)(126 - hd) << 23) * LOG2E, sc2 = 0.125f * LOG2E;
    f32x2_t q[8];
    { const v4u qa = *(const v4u*)(Q + (size_t)t * AW + hd * 64 + part * 16), qb = *(const v4u*)(Q + (size_t)t * AW + hd * 64 + part * 16 + 8);
#pragma unroll
      for (int i = 0; i < 4; ++i) { q[i] = (f32x2_t){bf_lo(qa[i]) * sc2, bf_hi(qa[i]) * sc2}; q[4 + i] = (f32x2_t){bf_lo(qb[i]) * sc2, bf_hi(qb[i]) * sc2}; } }
    const unsigned short* lp = SEL + (size_t)t * 256;
    const unsigned char* kb = K8 + (size_t)hd * M * 128 + part * 16; const unsigned char* vb = kb + 64; (void)V8;
    int key[16]; v4u kf[16], vf[16];
#pragma unroll
    for (int r = 0; r < 16; ++r) { const int j = 16 * r + kk; key[r] = (int)lp[j < cnt ? j : cnt - 1]; }
#pragma unroll
    for (int r = 0; r < 16; ++r) { kf[r] = *(const v4u*)(kb + (size_t)key[r] * 128); vf[r] = *(const v4u*)(vb + (size_t)key[r] * 128); }
    float sv[16]; float mx = -INFINITY;
#pragma unroll
    for (int r = 0; r < 16; ++r) { f32x2_t kx[8]; unpack16(kf[r], kx); f32x2_t d2 = q[0] * kx[0];
#pragma unroll
        for (int e = 1; e < 8; ++e) d2 = __builtin_elementwise_fma(q[e], kx[e], d2);
        sv[r] = d2.x + d2.y; }
#pragma unroll
    for (int r = 0; r < 16; ++r) sv[r] += dppx<0xB1>(sv[r]);
#pragma unroll
    for (int r = 0; r < 16; ++r) sv[r] += dppx<0x4E>(sv[r]);
#pragma unroll
    for (int r = 0; r < 16; ++r) { sv[r] = (16 * r + kk) < cnt ? sv[r] - slope2 * (float)(t - key[r]) : -INFINITY; mx = fmaxf(mx, sv[r]); }
    mx = fmaxf(mx, __shfl_xor(mx, 4)); mx = fmaxf(mx, __shfl_xor(mx, 8)); mx = fmaxf(mx, __shfl_xor(mx, 16)); mx = fmaxf(mx, __shfl_xor(mx, 32));
    f32x2_t o[8]; float lsum = 0.f;
#pragma unroll
    for (int e = 0; e < 8; ++e) o[e] = (f32x2_t){0.f, 0.f};
#pragma unroll
    for (int r = 0; r < 16; ++r) { const float p = __builtin_amdgcn_exp2f(sv[r] - mx); lsum += p; f32x2_t vx[8]; unpack16(vf[r], vx); const f32x2_t p2 = (f32x2_t){p, p};
#pragma unroll
        for (int e = 0; e < 8; ++e) o[e] = __builtin_elementwise_fma(p2, vx[e], o[e]); }
    lsum += dppx<0x124>(lsum); lsum += dppx<0x128>(lsum); lsum += __shfl_xor(lsum, 16); lsum += __shfl_xor(lsum, 32);
    float of[16];
#pragma unroll
    for (int e = 0; e < 8; ++e) { of[2 * e] = o[e].x; of[2 * e + 1] = o[e].y; }
#pragma unroll
    for (int e = 0; e < 16; ++e) of[e] += dppx<0x124>(of[e]);
#pragma unroll
    for (int e = 0; e < 16; ++e) of[e] += dppx<0x128>(of[e]);
#pragma unroll
    for (int e = 0; e < 16; ++e) of[e] += __shfl_xor(of[e], 16);
#pragma unroll
    for (int e = 0; e < 16; ++e) of[e] += __shfl_xor(of[e], 32);
    if (lane < 4) { const float inv = __builtin_amdgcn_rcpf(lsum); v4u a, b;
        a.x = pkbf(of[0] * inv, of[1] * inv); a.y = pkbf(of[2] * inv, of[3] * inv); a.z = pkbf(of[4] * inv, of[5] * inv); a.w = pkbf(of[6] * inv, of[7] * inv);
        b.x = pkbf(of[8] * inv, of[9] * inv); b.y = pkbf(of[10] * inv, of[11] * inv); b.z = pkbf(of[12] * inv, of[13] * inv); b.w = pkbf(of[14] * inv, of[15] * inv);
        *(v4u*)(ATTN + (size_t)t * AW + hd * 64 + part * 16) = a; *(v4u*)(ATTN + (size_t)t * AW + hd * 64 + part * 16 + 8) = b; }
}

struct TkPtrs { const bf16_t *QI, *KI; const float* WI; unsigned short* SEL; };
__device__ __forceinline__ void topk_attn_block(int qb, const TkPtrs& P, LAS unsigned char* lds, int tid, int wave, int lane, bool do_attn) {
    LAS unsigned* H = (LAS unsigned*)lds;
    LAS unsigned* SELM = (LAS unsigned*)lds;
    LAS unsigned* TIEM = (LAS unsigned*)(lds + 32 * MSTRIDE * 4);
    LAS unsigned short* LIST = (LAS unsigned short*)(lds + LIST_OFF);
    LAS unsigned* STP = (LAS unsigned*)(lds + ST_OFF);
    LAS unsigned* STN = STP + 32;
    const int t0 = qb * 32, r = lane & 31, h = lane >> 5;
    SYNC();
    float wv[4];
    LAS bf16_t* QF = (LAS bf16_t*)(lds + LIST_OFF);
    { const bf16_t* qp = P.QI + (size_t)(t0 + r) * 256 + 8 * h;
#pragma unroll
      for (int k = 0; k < 2; ++k) { const int f = 2 * wave + k; *(LAS pg8::bf16x8*)(QF + f * 512 + lane * 8) = *(const pg8::bf16x8*)(qp + (f >> 2) * 64 + 16 * (f & 3)); }
      const f32x4 w4 = *(const f32x4*)(P.WI + (size_t)(t0 + r) * 4); wv[0] = w4[0]; wv[1] = w4[1]; wv[2] = w4[2]; wv[3] = w4[3]; }
    LAS unsigned* STC = STP + 64;
    LAS unsigned* STG = STP + 96;
    LAS unsigned* FB = STP + 160;
    LAS unsigned* STS = STP + 192;
    LAS float* FSEL = (LAS float*)(STP + 256);
    LAS float* FTIE = FSEL + 32;
    const bool negw = (wv[0] <= 0.f) && (wv[1] <= 0.f) && (wv[2] <= 0.f) && (wv[3] <= 0.f);
    const unsigned wbase = negw ? 7745u : 22976u;
#pragma unroll 1
    for (int rep_tk = 0; rep_tk < REP_TK; ++rep_tk) {
    if (wave == 0 && lane == 0) *FB = 0u;
#pragma unroll 1
    for (int mode = 0; mode < 2; ++mode) {
        if (mode == 1) { if (*FB == 0u) break; }
        if (wave == 0 && lane < 32) { STP[lane] = 0u; const int nv = t0 + lane + 1; STN[lane] = nv < 256 ? nv : 256; STG[lane] = negw ? 1u : 0u; }
        const int nstep = mode == 0 ? 1 : 3;
#pragma unroll 1
        for (int step = 0; step < nstep; ++step) {
            if (mode == 1 || step == 0) { for (int i = tid; i < 32 * HSTRIDE; i += NTHR) H[i] = 0u; }
            SYNC();
            const int sh = mode == 0 ? 17 : (step == 0 ? 21 : (step == 1 ? 10 : 0));
            const unsigned vlo = mode == 0 ? wbase : (step == 0 ? 0u : (STP[r] << (step == 1 ? 11 : 10)));
            const unsigned vmin = vlo;
            tk_pass<false>(qb, wave, lane, P.KI, QF, wv, H, SELM, TIEM, sh, vlo, mode == 0, (mode == 1 && step == 2) ? 1023u : 2047u, 0, vmin, 0.f, 0.f);
            SYNC();
            const bool samp = false;
#pragma unroll 1
            for (int qq = 0; qq < 4; ++qq) { const int rq = 4 * wave + qq;
                tk_scan(H + rq * HSTRIDE, samp ? STS + rq : STP + rq, samp ? STS + 32 + rq : STN + rq, STC + rq, (mode == 1 && step == 2) ? 10 : 11, lane);
                if (mode == 0 && lane == 0) { const unsigned D = STP[rq], nn = STN[rq], c = STC[rq], ng = STG[rq] & 1u;
                    const bool zerobin = ng && D == 2047u, edge = (D == 0u) || (D == 2047u && !ng);
                    const bool wantc = (c > nn) && !zerobin;
                    if (edge || (wantc && c > 64u)) lds_or(FB, 1u);
                    STG[rq] = ng | (wantc ? 2u : 0u);
                    const unsigned wb = ng ? 7745u : 22976u;
                    FTIE[rq] = u2f((wb + D) << 17); FSEL[rq] = zerobin ? INFINITY : u2f((wb + D + 1u) << 17); }
                if (mode == 1 && step == 2 && lane == 0) { const unsigned tau = STP[rq]; FTIE[rq] = u2f(tau); FSEL[rq] = tau == 0xffffffffu ? INFINITY : u2f(tau + 1u); } }
            SYNC();
        }
        if (mode == 0 && *FB != 0u) continue;
        tk_pass<true>(qb, wave, lane, P.KI, QF, wv, H, SELM, TIEM, 0, 0u, false, 0u, 0, 0u, FSEL[r], FTIE[r]);
        SYNC();
        break;
    }
    }
    if (!do_attn) return;
#pragma unroll 1
    for (int qq = 0; qq < 4; ++qq) {
        const int rq = 4 * wave + qq, t = t0 + rq; int mties = (int)STN[rq];
        unsigned tw[8], fw[8]; int S = 0;
#pragma unroll
        for (int i = 0; i < 8; ++i) { const int T = 8 * lane + i; const bool v = T <= qb; tw[i] = v ? TIEM[rq * MSTRIDE + T] : 0u; fw[i] = v ? SELM[rq * MSTRIDE + T] : 0u; S += __builtin_popcount(tw[i]); }
        const int incl = wave_incl_scan(S);
        if (*FB == 0u && (STG[rq] & 2u)) {
            const int c = __builtin_amdgcn_readlane(incl, 63), nn = mties;
            LAS unsigned short* cl = LIST + rq * 256;
            { int pos = incl - S;
#pragma unroll
              for (int i = 0; i < 8; ++i) { unsigned w = tw[i]; while (w) { const int b = __builtin_ctz(w); if (pos < 64) cl[pos] = (unsigned short)(256 * lane + 32 * i + b); ++pos; w &= w - 1u; } } }
            LDS_WAIT(); asm volatile("" ::: "memory");
            const u32x2 q4 = *(const u32x2*)(P.QI + (size_t)t * 256 + 4 * lane); const float wh = P.WI[(size_t)t * 4 + (lane >> 4)];
            float mys = 0.f; const int cc = c < 64 ? c : 64;
#pragma unroll 1
            for (int j0 = 0; j0 < cc; j0 += 8) { u32x2 k4[8];
#pragma unroll
                for (int u = 0; u < 8; ++u) { const int jj = (j0 + u) < cc ? (j0 + u) : (cc - 1); k4[u] = tk_rescore_load(P.KI, __builtin_amdgcn_readfirstlane((int)cl[jj]), lane); }
#pragma unroll
                for (int u = 0; u < 8; ++u) { const float sj = tk_rescore(q4, wh, k4[u]); if (lane == j0 + u) mys = sj; } }
            int rank = 0;
            for (int j = 0; j < cc; ++j) { const float sj = __int_as_float(__builtin_amdgcn_readlane(__float_as_int(mys), j)); rank += (sj > mys || (sj == mys && j < lane)) ? 1 : 0; }
            const bool keepme = lane < cc && rank < nn; const int mykey = lane < cc ? (int)cl[lane] : 0;
#pragma unroll 1
            for (int j = 0; j < cc; ++j) { const int kj = __builtin_amdgcn_readlane(mykey, j); const int kp = __builtin_amdgcn_readlane((int)keepme, j);
                if (kp && (kj >> 8) == lane) {
#pragma unroll
                    for (int i = 0; i < 8; ++i) if (((kj >> 5) & 7) == i) fw[i] |= 1u << (kj & 31); } }
            mties = 0;
        }
        int take = mties - (incl - S); take = take < 0 ? 0 : (take > S ? S : take);
        int cl2 = 0;
#pragma unroll
        for (int i = 0; i < 8; ++i) { unsigned w = tw[i]; const int c = __builtin_popcount(w); unsigned keep;
            if (take >= c) { keep = w; take -= c; } else { keep = 0u; for (int k = 0; k < take; ++k) { const unsigned low = w & (0u - w); keep |= low; w ^= low; } take = 0; }
            fw[i] |= keep; cl2 += __builtin_popcount(fw[i]); }
        const int inc2 = wave_incl_scan(cl2);
        int pos = inc2 - cl2; const int cnt = __builtin_amdgcn_readlane(inc2, 63);
        LAS unsigned short* lp = LIST + rq * 256;
#pragma unroll
        for (int i = 0; i < 8; ++i) { unsigned w = fw[i]; while (w) { const int b = __builtin_ctz(w); if (pos < 256) lp[pos] = (unsigned short)(256 * lane + 32 * i + b); ++pos; w &= w - 1u; } }
        LDS_WAIT(); asm volatile("" ::: "memory");
        (void)cnt;
        *(u32x2*)(P.SEL + (size_t)t * 256 + 4 * lane) = *(const LAS u32x2*)(lp + 4 * lane);
    }
}

struct OneUnit { int pm, pn;
    __device__ __forceinline__ bool next(int i, pg8::Unit& u) const { if (i != 0) return false; u.pm = pm; u.pn = pn; return true; }
    __device__ __forceinline__ void a_ready(const pg8::Unit&) const {}
    __device__ __forceinline__ void done(const pg8::Unit&) const {}
};
struct Args { const float* in[18]; float* out; unsigned char* ws; int ph_lo, ph_hi; };
constexpr int NPH = 13;

typedef const __attribute__((address_space(4))) unsigned long long* kargp_t;
#define KARGS() kargp_t kargs = (kargp_t)__builtin_amdgcn_kernarg_segment_ptr(); asm volatile("" : "+s"(kargs)); GAS unsigned char* const ws = (GAS unsigned char*)kargs[19]; (void)ws
#define KIN(i) ((const float*)(const GAS float*)kargs[(i)])
#define KOUT() ((float*)(GAS float*)kargs[18])
#define WSP(T, off) ((T*)(GAS T*)(ws + (off)))
__global__ void __launch_bounds__(NTHR, 2) fwd_kernel(Args a) {
    extern __shared__ __attribute__((aligned(16))) unsigned char lds_raw[];
    LAS unsigned char* lds = (LAS unsigned char*)lds_raw;
    const int lo = a.ph_lo, hi = a.ph_hi;
    { int tid0 = threadIdx.x; asm volatile("" : "+v"(tid0)); for (int u = tid0; u < (LDS_BYTES - MISC_OFF) / 4; u += NTHR) ((LAS unsigned*)(lds + MISC_OFF))[u] = 0u; }
    SYNC();
    XcdBarrier bar; bar.bar = nullptr; bar.x = 0; bar.st = nullptr;
    if (hi - lo > 1) { KARGS(); bar = xcd_barrier_post((unsigned*)(GAS unsigned*)(ws + WS_CTL) + CW_BAR, (volatile LAS unsigned*)(lds + MISC_OFF) + 8); }
#define IN(k) (lo <= (k) && (k) < hi)
#define SEAM(k) do { if (IN(k) && IN((k) + 1)) xcd_barrier(bar); } while (0)
#define IDS() const int tid = threadIdx.x, lane = tid & 63, wave = __builtin_amdgcn_readfirstlane(tid >> 6), G = gridDim.x, bid = blockIdx.x; (void)lane; (void)wave; (void)G; (void)bid

    for (int rep_ph = 0; rep_ph < ((REP_PH == 0) ? 2 : 1); ++rep_ph) if (IN(0)) { KARGS(); IDS();
        P0Ptrs P{KIN(1), KIN(2), KIN(5), KIN(8), KIN(9), KIN(11), KIN(12), KIN(14), KIN(17), KIN(10), WSP(bf16_t, WS_WIN), WSP(bf16_t, WS_WATTN), WSP(bf16_t, WS_WGRP), WSP(bf16_t, WS_WPOOL), WSP(bf16_t, WS_WOUT),
                 WSP(bf16_t, WS_WUP), WSP(bf16_t, WS_WDOWN), WSP(float, WS_MODP)};
        p0_prologue(P, lds, bid * NWAVES + wave, G * NWAVES, wave, lane);
    }
    SEAM(0);
    if (IN(1)) { KARGS(); IDS();
        const float *b_ada = KIN(3), *norm1_g = KIN(4); const float* MODP = WSP(float, WS_MODP); float* MODF = WSP(float, WS_MODF);
        LAS float* mulv = (LAS float*)lds; LAS float* addv = mulv + 1024;
        for (int i = tid; i < 1024; i += NTHR) { float sh = b_ada[i], scv = b_ada[1024 + i];
#pragma unroll
            for (int kc = 0; kc < 16; ++kc) { sh += MODP[kc * NMOD + i]; scv += MODP[kc * NMOD + 1024 + i]; }
            mulv[i] = norm1_g[i] * (1.0f + scv); addv[i] = sh; }
        if (bid < 24 && tid < 256) { const int i = bid * 256 + tid; float v = b_ada[i];
#pragma unroll
            for (int kc = 0; kc < 16; ++kc) v += MODP[kc * NMOD + i];
            MODF[i] = v; }
        SYNC();
        modulate_rows(KIN(0), WSP(bf16_t, WS_H), mulv, addv, bid * NWAVES + wave, G * NWAVES, lane);
        SYNC();
    }
    SEAM(1);
    for (int rep_ph = 0; rep_ph < ((REP_PH == 2) ? 2 : 1); ++rep_ph) if (IN(2)) { KARGS(); IDS();
        pg8::Gemm g{WSP(bf16_t, WS_H), WSP(bf16_t, WS_WIN), M, NINP, DM}; pg8::StaticOrder S; S.init(M, NINP, G, bid);
        EpiProj E{WSP(bf16_t, WS_Q), WSP(unsigned char, WS_K), WSP(unsigned char, WS_K), WSP(bf16_t, WS_QI), WSP(bf16_t, WS_KI), WSP(bf16_t, WS_UPOOL), WSP(bf16_t, WS_GA), WSP(bf16_t, WS_GP), WSP(float, WS_WI), KIN(6), KIN(7)};
        pg8::gemm_phase<EpiProj, pg8::StaticOrder, true, true>(lds, g, S, E);
    }
    SEAM(2);
    if (IN(3)) { KARGS(); IDS();
        if (bid < 8) {
            pg8::Gemm g{WSP(bf16_t, WS_WPOOL), WSP(bf16_t, WS_WGRP), 1024, PW, PW}; OneUnit S{bid >> 1, bid & 1};
            EpiBf<3> E{WSP(bf16_t, WS_POOLMIX), PW, nullptr, nullptr};
            pg8::gemm_phase<EpiBf<3>, OneUnit, true, true>(lds, g, S, E);
            SYNC();
        }
        pooled_phase(WSP(bf16_t, WS_UPOOL), WSP(bf16_t, WS_POOLED), bid * NTHR + tid, G * NTHR);
        TkPtrs T{WSP(bf16_t, WS_QI), WSP(bf16_t, WS_KI), WSP(float, WS_WI), (unsigned short*)KOUT()};
        unsigned* qctr = (unsigned*)(GAS unsigned*)(ws + WS_CTL) + CW_QUEUE;
        LAS int* qslot = (LAS int*)(lds + ST_OFF + 2040);
#pragma unroll 1
        for (;;) {
            SYNC();
            if (tid == 0) *qslot = (int)__hip_atomic_fetch_add(qctr, 1u, __ATOMIC_RELAXED, __HIP_MEMORY_SCOPE_AGENT);
            SYNC();
            const int qi0 = *qslot;
            const int qi = qi0;
            if (qi >= 512 * (1 + REP_TKONLY)) break;
            topk_attn_block(511 - (qi & 511), T, lds, tid, wave, lane, qi >= 512 * REP_TKONLY);
        }
        SYNC();
    }
    SEAM(3);
    if (IN(4)) { KARGS(); IDS();
        const unsigned short* SEL = (const unsigned short*)KOUT(); const bf16_t* Qp = WSP(bf16_t, WS_Q); const unsigned char *K8 = WSP(unsigned char, WS_K), *V8 = WSP(unsigned char, WS_K); bf16_t* ATTN = WSP(bf16_t, WS_ATTN);
        const bool aff = (G & 7) == 0; const int nitem = 8 * M, step = aff ? (G >> 3) * NWAVES : G * NWAVES;
#pragma unroll 1
        for (int it = aff ? (bid >> 3) * NWAVES + wave : bid * NWAVES + wave; it < (aff ? M : nitem); it += step) attn_item(aff ? it : (it >> 3), aff ? (bid & 7) : (it & 7), SEL, Qp, K8, V8, ATTN, lane);
    }
    SEAM(4);
    if (IN(6)) { KARGS(); IDS();
        pg8::Gemm g{WSP(bf16_t, WS_POOLED), WSP(bf16_t, WS_POOLMIX), M, DM, PW}; pg8::StaticOrder S; S.init(M, DM, G, bid);
        EpiBf<1> E{WSP(bf16_t, WS_GP), DM, nullptr, nullptr};
        pg8::gemm_phase<EpiBf<1>, pg8::StaticOrder, true, true>(lds, g, S, E);
    }
    SEAM(6);
    if (IN(7)) { KARGS(); IDS();
        pg8::Gemm g{WSP(bf16_t, WS_ATTN), WSP(bf16_t, WS_WATTN), M, DM, AW}; pg8::StaticOrder S; S.init(M, DM, G, bid);
        EpiBf<2> E{WSP(bf16_t, WS_GA), DM, nullptr, WSP(bf16_t, WS_GP)};
        pg8::gemm_phase<EpiBf<2>, pg8::StaticOrder, true, true>(lds, g, S, E);
    }
    SEAM(7);
    for (int rep_ph = 0; rep_ph < ((REP_PH == 8) ? 2 : 1); ++rep_ph) if (IN(8)) { KARGS(); IDS();
        pg8::Gemm g{WSP(bf16_t, WS_GA), WSP(bf16_t, WS_WOUT), M, DM, DM}; pg8::StaticOrder S; S.init(M, DM, G, bid);
        EpiRes E{KIN(0), KOUT(), WSP(float, WS_MODF) + 2048, 0.f};
        pg8::gemm_phase<EpiRes, pg8::StaticOrder, true, true>(lds, g, S, E);
    }
    SEAM(8);
    if (IN(9)) { KARGS(); IDS();
        const float* norm2_g = KIN(13); const float* MODF = WSP(float, WS_MODF);
        LAS float* mulv = (LAS float*)lds; LAS float* addv = mulv + 1024;
        for (int i = tid; i < 1024; i += NTHR) { mulv[i] = norm2_g[i] * (1.0f + MODF[4096 + i]); addv[i] = MODF[3072 + i]; }
        SYNC();
        modulate_rows(KOUT(), WSP(bf16_t, WS_H), mulv, addv, bid * NWAVES + wave, G * NWAVES, lane);
        SYNC();
    }
    SEAM(9);
    for (int rep_ph = 0; rep_ph < ((REP_PH == 10) ? 2 : 1); ++rep_ph) if (IN(10)) { KARGS(); IDS();
        pg8::Gemm g{WSP(bf16_t, WS_H), WSP(bf16_t, WS_WUP), M, FF2, DM}; pg8::StaticOrder S; S.init(M, FF2, G, bid);
        EpiUpAct E{WSP(bf16_t, WS_ACT), WSP(float, WS_RAW), KIN(15), KIN(16)};
        pg8::gemm_phase<EpiUpAct, pg8::StaticOrder, true, true>(lds, g, S, E);
    }
    SEAM(10);
    if (IN(11)) { KARGS(); IDS(); fixup_phase(WSP(float, WS_RAW), WSP(bf16_t, WS_ACT), KIN(15), KIN(16), bid * NTHR + tid, G * NTHR); }
    SEAM(11);
    if (IN(12)) { KARGS(); IDS();
        pg8::Gemm g{WSP(bf16_t, WS_ACT), WSP(bf16_t, WS_WDOWN), M, DM, FF}; pg8::StaticOrder S; S.init(M, DM, G, bid);
        EpiRes E{KOUT(), KOUT(), WSP(float, WS_MODF) + 5120, DBG_C};
        pg8::gemm_phase<EpiRes, pg8::StaticOrder, true, true>(lds, g, S, E);
    }
#undef IN
#undef SEAM
}

extern "C" void kernel_launch(void* const* d_in, const int* in_sizes, int n_in, void* d_out, int out_size, void* d_ws, size_t ws_size, hipStream_t stream) {
    static int grid = 0;
    if (grid == 0) {
        if (n_in != 18 || in_sizes[0] != M * DM || out_size != M * DM || ws_size < WS_END) { fprintf(stderr, "kernel_launch: unexpected shapes (n_in %d, in0 %d, out %d, ws %zu)\n", n_in, n_in > 0 ? in_sizes[0] : -1, out_size, ws_size); grid = -1; return; }
        int dev = 0, cus = 0, per_cu = 0;
        if (hipGetDevice(&dev) != hipSuccess || hipDeviceGetAttribute(&cus, hipDeviceAttributeMultiprocessorCount, dev) != hipSuccess) { grid = -1; return; }
        if (hipFuncSetAttribute((const void*)fwd_kernel, hipFuncAttributeMaxDynamicSharedMemorySize, LDS_BYTES) != hipSuccess) { fprintf(stderr, "kernel_launch: hipFuncSetAttribute failed\n"); grid = -1; return; }
        if (hipOccupancyMaxActiveBlocksPerMultiprocessor(&per_cu, (const void*)fwd_kernel, NTHR, LDS_BYTES) != hipSuccess || per_cu < 1) fprintf(stderr, "kernel_launch: occupancy query says %d\n", per_cu);
        (void)hipGetLastError();
        grid = cus;
    }
    if (grid < 0) return;
    (void)hipMemsetAsync((char*)d_ws + WS_CTL, 0, CTL_ZERO_BYTES, stream);
    Args a{};
    for (int i = 0; i < 18; ++i) a.in[i] = (const float*)d_in[i];
    a.out = (float*)d_out; a.ws = (unsigned char*)d_ws;
#if N_LAUNCH_MODE == 1
    a.ph_lo = 0; a.ph_hi = NPH;
    hipLaunchKernelGGL(fwd_kernel, dim3(grid), dim3(NTHR), LDS_BYTES, stream, a);
#else
    for (int p = 0; p < NPH; ++p) { a.ph_lo = p; a.ph_hi = p + 1; hipLaunchKernelGGL(fwd_kernel, dim3(grid), dim3(NTHR), LDS_BYTES, stream, a); }
#endif
}
```

```cpp
#include <hip/hip_runtime.h>
#include <cstdio>
#include <cstdint>
#ifndef REP_TKONLY
#define REP_TKONLY 0
#endif
#ifndef REP_BLK
#define REP_BLK 1
#endif
namespace pg8 {
#define PG8_LAS __attribute__((address_space(3)))
typedef unsigned short bf16_t;
typedef short bf16x8 __attribute__((ext_vector_type(8)));
typedef float f32x4 __attribute__((ext_vector_type(4)));
typedef unsigned u32x4 __attribute__((ext_vector_type(4)));
constexpr int BM = 256, BK = 64, HALF = 128, HTB = HALF * BK * 2  , STAGE_BYTES = 8 * HTB, NXCD = 8, WGM = 8;

__host__ __device__ __forceinline__ int lds_byte(int r, int c) { const int st = (r >> 4) * 2 + (c >> 5), rr = r & 15, cc = c & 31, ob = rr * 64 + cc * 2; return st * 1024 + (ob ^ (((ob >> 9) & 1) << 5)); }
__host__ __device__ __forceinline__ void stage_rc(int b, int& R, int& C) { const int st = b / 1024, sb = b % 1024, swz = sb ^ (((sb >> 9) & 1) << 5); R = (st >> 1) * 16 + swz / 64; C = (st & 1) * 32 + (swz % 64) / 2; }
__host__ __device__ __forceinline__ int perm32(int rho) { const int n = rho >> 4, i = rho & 15; return 8 * (i >> 2) + 4 * n + (i & 3); }

struct Unit { int pm, pn; };
struct Gemm { const bf16_t* A; const bf16_t* Bt; int M, N, K; };

struct StaticOrder {
    int nM, nN, nwg, G, c;
    __host__ __device__ void init(int M, int N, int G_, int c_) { nM = M / BM; nN = N / BM; nwg = nM * nN; G = G_; c = c_; }
    __host__ __device__ bool next(int i, Unit& u) const {
        const long L = (long)i * G + c; if (L >= nwg) return false;
        int wgid = (int)L; { const int q = nwg / NXCD, r = nwg % NXCD, xcd = wgid % NXCD, off = wgid / NXCD; wgid = (xcd < r ? xcd * (q + 1) : r * (q + 1) + (xcd - r) * q) + off; }
        const int nig = WGM * nN, gid = wgid / nig, fm = gid * WGM, gsz = (nM - fm) < WGM ? (nM - fm) : WGM;
        u.pm = fm + ((wgid % nig) % gsz); u.pn = (wgid % nig) / gsz; return true;
    }
    __device__ __forceinline__ void a_ready(const Unit&) const {}
    __device__ __forceinline__ void done(const Unit&) const {}
};

__device__ __forceinline__ unsigned cvt_pk_bf16(float lo, float hi) { unsigned r; asm volatile("v_cvt_pk_bf16_f32 %0, %1, %2" : "=v"(r) : "v"(lo), "v"(hi)); return r; }
template <class Epi, class Sched, bool ALIGN_EPI = false, bool SP2 = false>
__device__ __forceinline__ void gemm_phase(PG8_LAS unsigned char* lds, const Gemm g, const Sched& S, const Epi& E) {
    int tid_ = threadIdx.x; asm volatile("" : "+v"(tid_));
    const int tid = tid_, wid = __builtin_amdgcn_readfirstlane(tid >> 6), lane = tid & 63, wr = wid >> 2, wc = wid & 3, fr = lane & 15, fq = lane >> 4;
    const int K = g.K, nt = K / BK;
    unsigned voffA[2], voffB[2];
#pragma unroll
    for (int i = 0; i < 2; ++i) { int R, C; stage_rc(tid * 16 + i * 8192, R, C); const int Rb = Epi::PERM ? ((R & ~31) + perm32(R & 31)) : R;
        voffA[i] = (unsigned)(R * K + C) * 2u; voffB[i] = (unsigned)(Rb * K + C) * 2u; }
    const size_t kstep = (size_t)(BK * 2);
    const size_t hstep = (size_t)HALF * K * 2;
    const size_t tstep = 2 * hstep;
    const unsigned ldsw = (unsigned)wid * 1024u;
    const int aoff = lds_byte(wr * 64 + fr, fq * 8), boff = lds_byte(wc * 32 + fr, fq * 8);
#define PG8_SA(b, h) (((b) * 2 + (h)) * HTB)
#define PG8_SB(b, h) ((4 + (b) * 2 + (h)) * HTB)
#define PG8_STAGE(bufoff, gbase, voff) do { _Pragma("unroll") for (int _i = 0; _i < 2; ++_i) \
        __builtin_amdgcn_global_load_lds((const unsigned*)((const char*)(gbase) + (voff)[_i]), (PG8_LAS unsigned*)(lds + (bufoff) + ldsw + _i * 8192), 16, 0, 0); } while (0)
#define PG8_LDA(dst, b, h) do { _Pragma("unroll") for (int m = 0; m < 4; ++m) _Pragma("unroll") for (int k = 0; k < 2; ++k) dst[m][k] = *(const PG8_LAS bf16x8*)(lds + PG8_SA(b, h) + aoff + m * 2048 + k * 1024); } while (0)
#define PG8_LDB(dst, b, h) do { _Pragma("unroll") for (int n = 0; n < 2; ++n) _Pragma("unroll") for (int k = 0; k < 2; ++k) dst[n][k] = *(const PG8_LAS bf16x8*)(lds + PG8_SB(b, h) + boff + n * 2048 + k * 1024); } while (0)
#define PG8_MMA(ai, bj, At, Bt) do { __builtin_amdgcn_s_setprio(1); _Pragma("unroll") for (int m = 0; m < 4; ++m) _Pragma("unroll") for (int n = 0; n < 2; ++n) _Pragma("unroll") for (int k = 0; k < 2; ++k) \
        acc[ai][bj][m][n] = __builtin_amdgcn_mfma_f32_16x16x32_bf16(Bt[n][k], At[m][k], acc[ai][bj][m][n], 0, 0, 0); __builtin_amdgcn_s_setprio(0); } while (0)
#define PG8_WAIT_V(n) asm volatile("s_waitcnt vmcnt(" #n ")" ::: "memory")
#define PG8_WAIT_L(n) asm volatile("s_waitcnt lgkmcnt(" #n ")" ::: "memory")
#define PG8_BAR __builtin_amdgcn_s_barrier()
#define PG8_SCHED __builtin_amdgcn_sched_barrier(0)
    Unit cur, nxt; int ui = 0;
    if (!S.next(0, cur)) return;
    f32x4 acc[2][2][4][2];
#pragma unroll
    for (int a = 0; a < 2; ++a)
#pragma unroll
        for (int b = 0; b < 2; ++b)
#pragma unroll
            for (int m = 0; m < 4; ++m)
#pragma unroll
                for (int n = 0; n < 2; ++n) acc[a][b][m][n] = (f32x4){0.f, 0.f, 0.f, 0.f};
    bf16x8 At[4][2], B0[2][2], B1[2][2];
    const char* cA = (const char*)g.A + (size_t)cur.pm * tstep; const char* cB = (const char*)g.Bt + (size_t)cur.pn * tstep;
    S.a_ready(cur);
    if constexpr (SP2) {
        PG8_STAGE(PG8_SB(0, 0), cB, voffB); PG8_STAGE(PG8_SB(0, 1), cB + hstep, voffB); PG8_STAGE(PG8_SA(0, 0), cA, voffA); PG8_STAGE(PG8_SA(0, 1), cA + hstep, voffA);
        if (wr == 1) PG8_BAR;
        PG8_WAIT_V(2); PG8_BAR;
        PG8_STAGE(PG8_SB(1, 0), cB + kstep, voffB); PG8_STAGE(PG8_SA(1, 0), cA + kstep, voffA); PG8_STAGE(PG8_SB(1, 1), cB + hstep + kstep, voffB);
        PG8_WAIT_V(6); PG8_BAR;
    } else {
        PG8_STAGE(PG8_SB(0, 0), cB, voffB); PG8_STAGE(PG8_SA(0, 0), cA, voffA); PG8_STAGE(PG8_SB(0, 1), cB + hstep, voffB); PG8_STAGE(PG8_SA(0, 1), cA + hstep, voffA);
        if (wr == 1) PG8_BAR;
        PG8_WAIT_V(4); PG8_BAR;
        PG8_STAGE(PG8_SB(1, 0), cB + kstep, voffB); PG8_STAGE(PG8_SA(1, 0), cA + kstep, voffA); PG8_STAGE(PG8_SB(1, 1), cB + hstep + kstep, voffB);
        PG8_WAIT_V(6); PG8_BAR;
    }
    for (;;) {
        const bool has_next = S.next(ui + 1, nxt);
        const char* nA = has_next ? (const char*)g.A + (size_t)nxt.pm * tstep : cA; const char* nB = has_next ? (const char*)g.Bt + (size_t)nxt.pn * tstep : cB;
        for (int t = 0; t < nt; t += 2) {
            const bool last = (t == nt - 2);
            const char* a1 = cA + (size_t)(t + 1) * kstep;
            const char* a2 = last ? nA : cA + (size_t)(t + 2) * kstep; const char* b2 = last ? nB : cB + (size_t)(t + 2) * kstep;
            const char* a3 = a2 + kstep; const char* b3 = b2 + kstep;
            if (last && has_next) S.a_ready(nxt);
            if constexpr (SP2) {
            PG8_LDB(B0, 0, 0); PG8_LDB(B1, 0, 1); PG8_SCHED; PG8_LDA(At, 0, 0); PG8_STAGE(PG8_SA(1, 1), a1 + hstep, voffA);
            PG8_WAIT_V(8); PG8_WAIT_L(0); PG8_BAR; PG8_MMA(0, 0, At, B0); PG8_MMA(0, 1, At, B1); PG8_BAR; PG8_SCHED;
            PG8_LDA(At, 0, 1); PG8_STAGE(PG8_SB(0, 0), b2, voffB); PG8_STAGE(PG8_SB(0, 1), b2 + hstep, voffB); PG8_STAGE(PG8_SA(0, 0), a2, voffA);
            PG8_WAIT_V(8); PG8_WAIT_L(0); PG8_BAR; PG8_MMA(1, 0, At, B0); PG8_MMA(1, 1, At, B1); PG8_BAR; PG8_SCHED;
            PG8_LDB(B0, 1, 0); PG8_LDB(B1, 1, 1); PG8_SCHED; PG8_LDA(At, 1, 0); PG8_STAGE(PG8_SA(0, 1), a2 + hstep, voffA);
            PG8_WAIT_V(8); PG8_WAIT_L(0); PG8_BAR; PG8_MMA(0, 0, At, B0); PG8_MMA(0, 1, At, B1); PG8_BAR; PG8_SCHED;
            PG8_LDA(At, 1, 1); PG8_STAGE(PG8_SB(1, 0), b3, voffB); PG8_STAGE(PG8_SB(1, 1), b3 + hstep, voffB); PG8_STAGE(PG8_SA(1, 0), a3, voffA);
            PG8_WAIT_V(8); PG8_WAIT_L(0); PG8_BAR; PG8_MMA(1, 0, At, B0); PG8_MMA(1, 1, At, B1); PG8_BAR; PG8_SCHED;
            } else {
            PG8_LDB(B0, 0, 0); PG8_SCHED; PG8_LDA(At, 0, 0); PG8_STAGE(PG8_SA(1, 1), a1 + hstep, voffA);
            PG8_WAIT_L(8); PG8_BAR; PG8_WAIT_L(0); PG8_MMA(0, 0, At, B0); PG8_BAR; PG8_SCHED;
            PG8_LDB(B1, 0, 1); PG8_STAGE(PG8_SB(0, 0), b2, voffB);
            PG8_BAR; PG8_WAIT_L(0); PG8_MMA(0, 1, At, B1); PG8_BAR;
            PG8_LDA(At, 0, 1); PG8_STAGE(PG8_SA(0, 0), a2, voffA);
            PG8_BAR; PG8_WAIT_L(0); PG8_MMA(1, 0, At, B0); PG8_BAR; PG8_SCHED;
            PG8_STAGE(PG8_SB(0, 1), b2 + hstep, voffB);
            PG8_WAIT_V(6); PG8_BAR; PG8_MMA(1, 1, At, B1); PG8_BAR;
            PG8_LDB(B0, 1, 0); PG8_SCHED; PG8_LDA(At, 1, 0); PG8_STAGE(PG8_SA(0, 1), a2 + hstep, voffA);
            PG8_WAIT_L(8); PG8_BAR; PG8_WAIT_L(0); PG8_MMA(0, 0, At, B0); PG8_BAR; PG8_SCHED;
            PG8_LDB(B1, 1, 1); PG8_STAGE(PG8_SB(1, 0), b3, voffB);
            PG8_BAR; PG8_WAIT_L(0); PG8_MMA(0, 1, At, B1); PG8_BAR;
            PG8_LDA(At, 1, 1); PG8_STAGE(PG8_SA(1, 0), a3, voffA);
            PG8_BAR; PG8_WAIT_L(0); PG8_MMA(1, 0, At, B0); PG8_BAR; PG8_SCHED;
            PG8_STAGE(PG8_SB(1, 1), b3 + hstep, voffB);
            PG8_WAIT_V(6); PG8_BAR; PG8_MMA(1, 1, At, B1); PG8_BAR;
            }
        }
        if constexpr (ALIGN_EPI) { if (wr == 0) PG8_BAR; }
        if constexpr (!Epi::AFTER_DRAIN) { E(acc, cur, wr, wc, fr, fq); S.done(cur); }
        if (!has_next) break;
#pragma unroll
        for (int a = 0; a < 2; ++a)
#pragma unroll
            for (int b = 0; b < 2; ++b)
#pragma unroll
                for (int m = 0; m < 4; ++m)
#pragma unroll
                    for (int n = 0; n < 2; ++n) acc[a][b][m][n] = (f32x4){0.f, 0.f, 0.f, 0.f};
        cur = nxt; cA = nA; cB = nB; ++ui;
        if constexpr (ALIGN_EPI) { if (wr == 1) PG8_BAR; }
    }
    PG8_WAIT_V(0);
    if constexpr (!ALIGN_EPI) { if (wr == 0) PG8_BAR; }
    PG8_BAR;
    if constexpr (Epi::AFTER_DRAIN) { E.fused(acc, cur, wr, wc, fr, fq, lds, wid, lane); S.done(cur); }
#undef PG8_SA
#undef PG8_SB
#undef PG8_STAGE
#undef PG8_LDA
#undef PG8_LDB
#undef PG8_MMA
#undef PG8_WAIT_V
#undef PG8_WAIT_L
#undef PG8_BAR
#undef PG8_SCHED
}
}
#define GAS __attribute__((address_space(1)))
#define LAS __attribute__((address_space(3)))
typedef unsigned short bf16;
typedef unsigned v4u __attribute__((ext_vector_type(4)));
typedef float f32x4 __attribute__((ext_vector_type(4)));
typedef short bf16x8 __attribute__((ext_vector_type(8)));
typedef GAS unsigned gu32;
typedef GAS unsigned long long gu64;
#define RLX_AGENT __ATOMIC_RELAXED, __HIP_MEMORY_SCOPE_AGENT
#define LDS_WAIT() asm volatile("s_waitcnt lgkmcnt(0)" ::: "memory")
#define VM_WAIT() asm volatile("s_waitcnt vmcnt(0)" ::: "memory")
__device__ __forceinline__ unsigned long long rt() { return __builtin_amdgcn_s_memrealtime(); }
__device__ __forceinline__ unsigned f2bf(float f) { unsigned u = __builtin_bit_cast(unsigned, f); return (u + 0x7fffu + ((u >> 16) & 1u)) >> 16; }
__device__ __forceinline__ unsigned pk2(float lo, float hi) { return f2bf(lo) | (f2bf(hi) << 16); }

#define XB_TMO      128
#define XB_XCNT(j)  (256  + 64 * (j))
#define XB_XSUB(j)  (1280 + 64 * (j))
#define XB_XGEN(j)  (2304 + 64 * (j))
#define XB_TOP      3328
#define XB_TOPGEN   3392
#define XCD_BAR_WORDS 3456
#define XB_SPIN_CAP (1u << 18)

__device__ __forceinline__ unsigned xb_ld(unsigned* p)              { return __hip_atomic_load(p, __ATOMIC_RELAXED, __HIP_MEMORY_SCOPE_AGENT); }
__device__ __forceinline__ unsigned xb_add(unsigned* p, unsigned v) { return __hip_atomic_fetch_add(p, v, __ATOMIC_RELAXED, __HIP_MEMORY_SCOPE_AGENT); }
__device__ __forceinline__ unsigned xb_xcc_id() { return (unsigned)__builtin_amdgcn_s_getreg((3 << 11) | 20) & 0xFu; }
#define XB_SPIN(cond, bar) do { unsigned _sp = 0; while (cond) { __builtin_amdgcn_s_sleep(1); \
    if ((++_sp & 255u) == 0u) { if (xb_ld(&(bar)[XB_TMO])) break; if (_sp > XB_SPIN_CAP) { atomicAdd(&(bar)[XB_TMO], 1u); break; } } } } while (0)

struct XcdBarrier {
    unsigned* bar; unsigned x;
    volatile LAS unsigned* st;
};

__device__ __forceinline__ XcdBarrier xcd_barrier_post(unsigned* bar, volatile LAS unsigned* st) {
    XcdBarrier b; b.bar = bar; b.x = xb_xcc_id(); b.st = st;
    if (threadIdx.x == 0) (void)xb_add(&bar[XB_XCNT(b.x)], 1u);
    return b;
}
__device__ __forceinline__ void xcd_barrier_complete(unsigned* bar, unsigned x, unsigned& nloc, unsigned& nx) {
    const unsigned G = gridDim.x * gridDim.y * gridDim.z;
    unsigned sum, cnt, mine, sp = 0u;
    for (;;) {
        sum = 0u; cnt = 0u; mine = 0u;
#pragma unroll
        for (unsigned j = 0; j < 16; ++j) { const unsigned c = xb_ld(&bar[XB_XCNT(j)]); sum += c; cnt += (c > 0u) ? 1u : 0u; mine = (j == x) ? c : mine; }
        if (sum == G) break;
        __builtin_amdgcn_s_sleep(1);
        if ((++sp & 255u) == 0u) { if (xb_ld(&bar[XB_TMO])) break; if (sp > XB_SPIN_CAP) { atomicAdd(&bar[XB_TMO], 1u); break; } }
    }
    nloc = mine > 0u ? mine : 1u; nx = cnt > 0u ? cnt : 1u;
}

__device__ __forceinline__ void xcd_barrier(const XcdBarrier& b) {
    asm volatile("s_waitcnt vmcnt(0)" ::: "memory");
    __syncthreads();
    if (threadIdx.x == 0) {
        unsigned* bar = b.bar;
        __builtin_amdgcn_s_waitcnt(0);
        unsigned nloc = b.st[0], nx = b.st[1];
        if (nloc == 0u) { xcd_barrier_complete(bar, b.x, nloc, nx); b.st[0] = nloc; b.st[1] = nx; }
        const unsigned old = xb_add(&bar[XB_XSUB(b.x)], 1u);
        const unsigned gen = old / nloc;
        if (old + 1u == (gen + 1u) * nloc) {
            __builtin_amdgcn_fence(__ATOMIC_RELEASE, "agent");
            asm volatile("s_waitcnt vmcnt(0)" ::: "memory");
            const unsigned og = xb_add(&bar[XB_TOP], 1u);
            const unsigned tg = og / nx;
            if (og + 1u == (tg + 1u) * nx) xb_add(&bar[XB_TOPGEN], 1u);
            else XB_SPIN(xb_ld(&bar[XB_TOPGEN]) == tg, bar);
            __builtin_amdgcn_fence(__ATOMIC_ACQUIRE, "agent");
            xb_add(&bar[XB_XGEN(b.x)], 1u);
            asm volatile("s_waitcnt vmcnt(0)" ::: "memory");
        } else {
            XB_SPIN(xb_ld(&bar[XB_XGEN(b.x)]) == gen, bar);
            __builtin_amdgcn_fence(__ATOMIC_ACQUIRE, "agent");
            asm volatile("s_waitcnt vmcnt(0)" ::: "memory");
        }
    }
    __syncthreads();
}


#ifndef STAGE
#define STAGE 3
#endif
#ifndef N_LAUNCH_MODE
#define N_LAUNCH_MODE 1
#endif
#ifndef REP_TK
#define REP_TK 1
#endif
#ifndef REP_AT
#define REP_AT 1
#endif
#ifndef REP_PH
#define REP_PH -1
#endif
#ifndef TK_PREFETCH
#define TK_PREFETCH 1
#endif
#ifndef DBG_C
#define DBG_C 0.0f
#endif

typedef float f32x16 __attribute__((ext_vector_type(16)));
typedef __attribute__((ext_vector_type(2))) __bf16 bf16x2_t;
using pg8::bf16_t; using pg8::Unit;

constexpr int M = 16384, DM = 1024, NHEAD = 8, HD = 64, AW = 512, PW = 512, FF = 2816, FF2 = 5632, NIN = 4420, NINP = 4608, NMOD = 6144;
constexpr float EPS = 1e-6f;
constexpr int NWAVES = 8, NTHR = 512;

constexpr size_t MiB = 1u << 20;
constexpr size_t WS_CTL = 0, CTL_ZERO_BYTES = 64 * 1024;
constexpr size_t WS_WIN = 1 * MiB, WS_WATTN = 10 * MiB, WS_WGRP = 11 * MiB, WS_WPOOL = 11 * MiB + 512 * 1024, WS_WOUT = 12 * MiB + 512 * 1024,
                 WS_WUP = 14 * MiB + 512 * 1024, WS_WDOWN = 25 * MiB + 512 * 1024;
constexpr size_t WS_MODP = 31 * MiB, WS_MODF = 31 * MiB + 393216, WS_WI = 31 * MiB + 512 * 1024;
constexpr size_t WS_H = 32 * MiB;
constexpr size_t WS_Q = 64 * MiB, WS_K = 80 * MiB, WS_V = 96 * MiB;
constexpr size_t WS_SEL = 88 * MiB;
constexpr size_t WS_QI = 112 * MiB, WS_KI = 120 * MiB;
constexpr size_t WS_UPOOL = 128 * MiB, WS_POOLED = 144 * MiB, WS_POOLMIX = 160 * MiB, WS_ATTN = 176 * MiB;
constexpr size_t WS_GA = 192 * MiB, WS_GP = 224 * MiB;
constexpr size_t WS_ACT = 64 * MiB;
constexpr size_t WS_RAW = 152 * MiB;
constexpr size_t WS_END = 256 * MiB;
constexpr int CW_BAR = 1024, CW_QUEUE = 512;

constexpr int LDS_BYTES = 163840;
constexpr int HSTRIDE = 1025, MSTRIDE = 513;
constexpr int LIST_OFF = 135168, ST_OFF = 151552, MISC_OFF = 159744;

#define SYNC() __syncthreads()
__device__ __forceinline__ float wave_sum(float v) {
#pragma unroll
    for (int o = 1; o < 64; o <<= 1) v += __shfl_xor(v, o);
    return v;
}
__device__ __forceinline__ float bf_lo(unsigned w) { return __builtin_bit_cast(float, w << 16); }
__device__ __forceinline__ float bf_hi(unsigned w) { return __builtin_bit_cast(float, w & 0xffff0000u); }
__device__ __forceinline__ float sigmoidf_(float x) { return __builtin_amdgcn_rcpf(1.0f + __expf(-x)); }
__device__ __forceinline__ unsigned pkbf(float lo, float hi) { return pg8::cvt_pk_bf16(lo, hi); }
typedef unsigned u32x2 __attribute__((ext_vector_type(2)));
__device__ __forceinline__ u32x2 pk4(f32x4 v) { u32x2 r; r.x = pkbf(v[0], v[1]); r.y = pkbf(v[2], v[3]); return r; }
__device__ __forceinline__ unsigned pk4_fp8(f32x4 v) { int w = 0; w = __builtin_amdgcn_cvt_pk_fp8_f32(v[0], v[1], w, false); w = __builtin_amdgcn_cvt_pk_fp8_f32(v[2], v[3], w, true); return (unsigned)w; }

__device__ __forceinline__ void tr_item(const float* W, int ldw, int src_col, int nvalid, int k0, bf16_t* WT, int K, int dst_row, LAS float* scr, int lane) {
    f32x4 v[8];
#pragma unroll
    for (int i = 0; i < 8; ++i) { const int kk = 8 * i + (lane >> 3), n4 = 4 * (lane & 7);
        v[i] = (f32x4){0.f, 0.f, 0.f, 0.f}; if (W != nullptr && n4 < nvalid) v[i] = *(const f32x4*)(W + (size_t)(k0 + kk) * ldw + src_col + n4); }
#pragma unroll
    for (int i = 0; i < 8; ++i) { const int kk = 8 * i + (lane >> 3), n4 = 4 * (lane & 7); LAS float* p = scr + kk * 33 + n4; p[0] = v[i][0]; p[1] = v[i][1]; p[2] = v[i][2]; p[3] = v[i][3]; }
    LDS_WAIT(); asm volatile("" ::: "memory");
    const int c = lane & 7;
#pragma unroll
    for (int j = 0; j < 4; ++j) { const int n = (lane >> 3) + 8 * j; const LAS float* s = scr + (8 * c) * 33 + n;
        v4u o; o.x = pk2(s[0 * 33], s[1 * 33]); o.y = pk2(s[2 * 33], s[3 * 33]); o.z = pk2(s[4 * 33], s[5 * 33]); o.w = pk2(s[6 * 33], s[7 * 33]);
        *(GAS v4u*)(WT + (size_t)(dst_row + n) * K + k0 + 8 * c) = o; }
    LDS_WAIT(); asm volatile("" ::: "memory");
}

struct P0Ptrs { const float *c, *w_ada, *w_in, *w_attn, *w_grp, *w_pool, *w_out, *w_up, *w_down, *pscale; bf16_t *WIN, *WATTN, *WGRP, *WPOOL, *WOUT, *WUP, *WDOWN; float* MODP; };
__device__ __forceinline__ void p0_prologue(const P0Ptrs& P, LAS unsigned char* lds, int gw, int NGW, int wave, int lane) {
    LAS float* scr = (LAS float*)(lds + wave * 16384);
    LAS float* sil = (LAS float*)(lds + 131072);
    for (int i = threadIdx.x; i < 1024; i += NTHR) { const float cv = P.c[i]; sil[i] = cv / (1.0f + __expf(-cv)); }
    SYNC();
    constexpr int I_WIN = 144 * 16, I_WATTN = 32 * 8, I_WGRP = 128, I_WPOOL = 32 * 8, I_WOUT = 32 * 16, I_WUP = 176 * 16, I_WDOWN = 32 * 44, I_MOD = 96 * 16;
    constexpr int NITEMS = I_WIN + I_WATTN + I_WGRP + I_WPOOL + I_WOUT + I_WUP + I_WDOWN + I_MOD;
    for (int it = gw; it < NITEMS; it += NGW) {
        int r = it;
        if (r < I_MOD) {
            const int cb = r % 96, kc = r / 96, col = cb * 64 + lane; float acc = 0.f;
#pragma unroll 8
            for (int i = 0; i < 64; ++i) { const int k = kc * 64 + i; acc = fmaf(sil[k], P.w_ada[(size_t)k * NMOD + col], acc); }
            P.MODP[kc * NMOD + col] = acc; continue; }
        r -= I_MOD;
        if (r < I_WIN) { const int g = r / 16, kb = r % 16, tile = g >> 3, gi = g & 7; int src = -1, nv = 32;
            const int permgi = gi < 4 ? 64 * gi : 64 * (gi - 4) + 32;
            if (tile < 2) src = tile * 256 + permgi;
            else if (tile < 4) src = 512 + (tile - 2) * 256 + permgi;
            else if (tile < 6) src = 1024 + (tile - 4) * 256 + 32 * gi;
            else if (tile == 6) src = 1536 + 32 * gi;
            else if (tile == 7) { if (gi < 2) src = 1792 + 32 * gi; else if (gi == 2) { src = 1856; nv = 4; } }
            else if (tile < 10) src = 1860 + (tile - 8) * 256 + 32 * gi;
            else if (tile < 14) src = 2372 + (tile - 10) * 256 + 32 * gi;
            else src = 3396 + (tile - 14) * 256 + 32 * gi;
            tr_item(src >= 0 ? P.w_in : nullptr, NIN, src >= 0 ? src : 0, nv, kb * 64, P.WIN, 1024, g * 32, scr, lane); continue; }
        r -= I_WIN;
        if (r < I_WATTN) { tr_item(P.w_attn, 1024, (r / 8) * 32, 32, (r % 8) * 64, P.WATTN, 512, (r / 8) * 32, scr, lane); continue; }
        r -= I_WATTN;
        if (r < I_WGRP) {
            const int row = 4 * r + (lane >> 4), g = row >> 7; const float* src = P.w_grp + (size_t)g * 16384 + (size_t)(row & 127) * 128;
#pragma unroll
            for (int q = 0; q < 4; ++q) { const int d0 = 32 * (lane & 15) + 8 * q; v4u o = (v4u){0u, 0u, 0u, 0u};
                if ((d0 >> 7) == g) { const f32x4 a = *(const f32x4*)(src + (d0 & 127)) * *(const f32x4*)(P.pscale + d0), b = *(const f32x4*)(src + (d0 & 127) + 4) * *(const f32x4*)(P.pscale + d0 + 4);
                    o.x = pk2(a[0], a[1]); o.y = pk2(a[2], a[3]); o.z = pk2(b[0], b[1]); o.w = pk2(b[2], b[3]); }
                *(GAS v4u*)(P.WGRP + (size_t)row * 512 + d0) = o; }
            continue; }
        r -= I_WGRP;
        if (r < I_WPOOL) { tr_item(P.w_pool, 1024, (r / 8) * 32, 32, (r % 8) * 64, P.WPOOL, 512, (r / 8) * 32, scr, lane); continue; }
        r -= I_WPOOL;
        if (r < I_WOUT) { tr_item(P.w_out, 1024, (r / 16) * 32, 32, (r % 16) * 64, P.WOUT, 1024, (r / 16) * 32, scr, lane); continue; }
        r -= I_WOUT;
        if (r < I_WUP) { const int g = r / 16, kb = r % 16, tile = g >> 3, gi = g & 7;
            const int src = gi < 4 ? 128 * tile + 32 * gi : FF + 128 * tile + 32 * (gi - 4);
            tr_item(P.w_up, FF2, src, 32, kb * 64, P.WUP, 1024, g * 32, scr, lane); continue; }
        r -= I_WUP;
        { tr_item(P.w_down, 1024, (r / 44) * 32, 32, (r % 44) * 64, P.WDOWN, FF, (r / 44) * 32, scr, lane); }
    }
}

__device__ __forceinline__ void modulate_rows(const float* X, bf16_t* O, const LAS float* mulv, const LAS float* addv, int gw, int NGW, int lane) {
    f32x4 mu[4], ad[4];
#pragma unroll
    for (int j = 0; j < 4; ++j) { mu[j] = *(const LAS f32x4*)(mulv + 4 * lane + 256 * j); ad[j] = *(const LAS f32x4*)(addv + 4 * lane + 256 * j); }
    for (int row = gw; row < M; row += NGW) {
        const GAS f32x4* xr = (const GAS f32x4*)(X + (size_t)row * DM) + lane;
        f32x4 v[4]; float s = 0.f;
#pragma unroll
        for (int j = 0; j < 4; ++j) { v[j] = xr[64 * j]; s += (v[j].x * v[j].x + v[j].y * v[j].y) + (v[j].z * v[j].z + v[j].w * v[j].w); }
        const float rstd = 1.0f / sqrtf(wave_sum(s) * (1.0f / DM) + EPS);
        GAS u32x2* o8 = (GAS u32x2*)(O + (size_t)row * DM) + lane;
#pragma unroll
        for (int j = 0; j < 4; ++j) { const f32x4 y = v[j] * rstd * mu[j] + ad[j]; o8[64 * j] = pk4(y); }
    }
}

struct EpiProj {
    static constexpr bool PERM = false, AFTER_DRAIN = false;
    bf16_t *Q; unsigned char *K8, *V8; bf16_t *QI, *KI, *UPOOL, *GA, *GP; float* WI; const float *qg, *kg;
    __device__ __forceinline__ void operator()(const pg8::f32x4 (&acc)[2][2][4][2], const Unit& u, int wr, int wc, int fr, int fq) const {
        const int pn = u.pn, row0 = u.pm * 256 + wr * 64 + fr;
        if (pn < 4) {
            const bool isq = pn < 2; const float* g = isq ? qg : kg; const int head = (pn & 1) * 4 + wc;
            f32x4 gv[2][2];
#pragma unroll
            for (int bj = 0; bj < 2; ++bj)
#pragma unroll
                for (int n = 0; n < 2; ++n) gv[bj][n] = *(const f32x4*)(g + 32 * bj + 16 * n + 4 * fq);
#pragma unroll
            for (int ai = 0; ai < 2; ++ai)
#pragma unroll
                for (int m = 0; m < 4; ++m) {
                    float ss = 0.f;
#pragma unroll
                    for (int bj = 0; bj < 2; ++bj)
#pragma unroll
                        for (int n = 0; n < 2; ++n) { const f32x4 x = acc[ai][bj][m][n]; ss += (x[0] * x[0] + x[1] * x[1]) + (x[2] * x[2] + x[3] * x[3]); }
                    ss += __shfl_xor(ss, 16); ss += __shfl_xor(ss, 32);
                    const float rstd = 1.0f / sqrtf(ss * (1.0f / 64.0f) + EPS);
                    const size_t ro = (size_t)(row0 + ai * 128 + m * 16) * AW + head * 64 + 4 * fq;
#pragma unroll
                    for (int bj = 0; bj < 2; ++bj)
#pragma unroll
                        for (int n = 0; n < 2; ++n) { const f32x4 y = acc[ai][bj][m][n] * rstd * gv[bj][n];
                            if (isq) *(u32x2*)(Q + ro + 32 * bj + 16 * n) = pk4(y); else *(unsigned*)(K8 + ((size_t)head * M + (row0 + ai * 128 + m * 16)) * 128 + 4 * fq + 32 * bj + 16 * n) = pk4_fp8(y); }
                }
            return;
        }
        const int colw = wc * 32 + 4 * fq;
        if (pn == 7) {
#pragma unroll
            for (int ai = 0; ai < 2; ++ai)
#pragma unroll
                for (int m = 0; m < 4; ++m) { const int row = row0 + ai * 128 + m * 16;
                    if (wc < 2) {
#pragma unroll
                        for (int n = 0; n < 2; ++n) { const int c = colw + 16 * n; *(u32x2*)(KI + (size_t)(row >> 5) * 2048 + (c >> 4) * 512 + ((((c >> 3) & 1) * 32 + (row & 31)) * 8) + (c & 7)) = pk4(acc[ai][0][m][n]); }
                    } else if (wc == 2 && fq == 0) { *(f32x4*)(WI + (size_t)row * 4) = acc[ai][0][m][0] * 0.5f; }
                }
            return;
        }
        if (pn < 6) {
#pragma unroll
            for (int ai = 0; ai < 2; ++ai)
#pragma unroll
                for (int m = 0; m < 4; ++m) { const int row = row0 + ai * 128 + m * 16;
#pragma unroll
                    for (int bj = 0; bj < 2; ++bj)
#pragma unroll
                        for (int n = 0; n < 2; ++n) { const int col = (pn - 4) * 256 + colw + 128 * bj + 16 * n;
                            *(unsigned*)(V8 + ((size_t)(col >> 6) * M + row) * 128 + 64 + (col & 63)) = pk4_fp8(acc[ai][bj][m][n]); } }
            return;
        }
        bf16_t* O; int ldo, ct; float sc = 1.0f; bool sig = false;
        if (pn == 6) { O = QI; ldo = 256; ct = 0; sc = 0.125f; }
        else if (pn < 10) { O = UPOOL; ldo = PW; ct = (pn - 8) * 256; }
        else if (pn < 14) { O = GA; ldo = DM; ct = (pn - 10) * 256; sig = true; }
        else { O = GP; ldo = DM; ct = (pn - 14) * 256; sig = true; }
#pragma unroll
        for (int ai = 0; ai < 2; ++ai)
#pragma unroll
            for (int m = 0; m < 4; ++m) { bf16_t* rowp = O + (size_t)(row0 + ai * 128 + m * 16) * ldo + ct + colw;
#pragma unroll
                for (int bj = 0; bj < 2; ++bj)
#pragma unroll
                    for (int n = 0; n < 2; ++n) { f32x4 y = acc[ai][bj][m][n] * sc;
                        if (sig) { y[0] = sigmoidf_(y[0]); y[1] = sigmoidf_(y[1]); y[2] = sigmoidf_(y[2]); y[3] = sigmoidf_(y[3]); }
                        *(u32x2*)(rowp + 128 * bj + 16 * n) = pk4(y); }
            }
    }
};

template <int MODE> struct EpiBf {
    static constexpr bool PERM = false, AFTER_DRAIN = false;
    bf16_t* O; int ldo; const float* colscale; const bf16_t* ADD;
    __device__ __forceinline__ void operator()(const pg8::f32x4 (&acc)[2][2][4][2], const Unit& u, int wr, int wc, int fr, int fq) const {
        const int row0 = u.pm * 256 + wr * 64 + fr, col0 = u.pn * 256 + wc * 32 + 4 * fq;
#pragma unroll
        for (int ai = 0; ai < 2; ++ai)
#pragma unroll
            for (int m = 0; m < 4; ++m) { const size_t ro = (size_t)(row0 + ai * 128 + m * 16) * ldo + col0;
#pragma unroll
                for (int bj = 0; bj < 2; ++bj)
#pragma unroll
                    for (int n = 0; n < 2; ++n) { f32x4 y = acc[ai][bj][m][n]; const size_t off = ro + 128 * bj + 16 * n;
                        if (MODE == 3) { }
                        else if (MODE == 0) { y = y * *(const f32x4*)(colscale + col0 + 128 * bj + 16 * n); }
                        else { const u32x2 gq = *(const u32x2*)(O + off); y[0] *= bf_lo(gq.x); y[1] *= bf_hi(gq.x); y[2] *= bf_lo(gq.y); y[3] *= bf_hi(gq.y);
                            if (MODE == 2) { const u32x2 a = *(const u32x2*)(ADD + off); y[0] += bf_lo(a.x); y[1] += bf_hi(a.x); y[2] += bf_lo(a.y); y[3] += bf_hi(a.y); } }
                        *(u32x2*)(O + off) = pk4(y); }
            }
    }
};

struct EpiRes {
    static constexpr bool PERM = false, AFTER_DRAIN = false;
    const float* BASE; float* OUT; const float* gate; float dbg;
    __device__ __forceinline__ void operator()(const pg8::f32x4 (&acc)[2][2][4][2], const Unit& u, int wr, int wc, int fr, int fq) const {
        const int row0 = u.pm * 256 + wr * 64 + fr, col0 = u.pn * 256 + wc * 32 + 4 * fq;
        f32x4 gv[2][2];
#pragma unroll
        for (int bj = 0; bj < 2; ++bj)
#pragma unroll
            for (int n = 0; n < 2; ++n) gv[bj][n] = *(const f32x4*)(gate + col0 + 128 * bj + 16 * n);
#pragma unroll
        for (int ai = 0; ai < 2; ++ai)
#pragma unroll
            for (int m = 0; m < 4; ++m) { const int row = row0 + ai * 128 + m * 16; const size_t ro = (size_t)row * DM + col0;
#pragma unroll
                for (int bj = 0; bj < 2; ++bj)
#pragma unroll
                    for (int n = 0; n < 2; ++n) { const size_t off = ro + 128 * bj + 16 * n; f32x4 y = *(const f32x4*)(BASE + off) + gv[bj][n] * acc[ai][bj][m][n];
                        if (dbg != 0.f) { const float sg = ((row * 7 + (int)(off >> 2)) & 1) ? dbg : -dbg; y[0] += sg; y[1] -= sg; y[2] += sg; y[3] -= sg; }
                        *(f32x4*)(OUT + off) = y; }
            }
    }
};

template <int CTRL> __device__ __forceinline__ float dppf(float x) { return __builtin_bit_cast(float, __builtin_amdgcn_update_dpp(0, __builtin_bit_cast(int, x), CTRL, 0xf, 0xf, false)); }
__device__ __forceinline__ f32x4 ror1(f32x4 v) { f32x4 r; r[0] = dppf<0x121>(v[0]); r[1] = dppf<0x121>(v[1]); r[2] = dppf<0x121>(v[2]); r[3] = dppf<0x121>(v[3]); return r; }
__device__ __forceinline__ f32x4 ror2(f32x4 v) { f32x4 r; r[0] = dppf<0x122>(v[0]); r[1] = dppf<0x122>(v[1]); r[2] = dppf<0x122>(v[2]); r[3] = dppf<0x122>(v[3]); return r; }
__device__ __forceinline__ f32x4 silu_mul(f32x4 a, f32x4 b) { f32x4 r;
#pragma unroll
    for (int e = 0; e < 4; ++e) r[e] = a[e] * __builtin_amdgcn_rcpf(1.0f + __expf(-a[e])) * b[e];
    return r; }
struct EpiUpAct {
    static constexpr bool PERM = false, AFTER_DRAIN = false;
    bf16_t* ACT; float* RAW; const float* cw; const float* cb;
    __device__ __forceinline__ void operator()(const pg8::f32x4 (&acc)[2][2][4][2], const Unit& u, int wr, int wc, int fr, int fq) const {
#pragma unroll
        for (int n = 0; n < 2; ++n) {
            const int ch = u.pn * 128 + wc * 32 + 4 * fq + 16 * n;
            const f32x4 w0a = *(const f32x4*)(cw + ch), w1a = *(const f32x4*)(cw + FF2 + ch), w2a = *(const f32x4*)(cw + 2 * FF2 + ch), ba = *(const f32x4*)(cb + ch);
            const f32x4 w0b = *(const f32x4*)(cw + FF + ch), w1b = *(const f32x4*)(cw + FF2 + FF + ch), w2b = *(const f32x4*)(cw + 2 * FF2 + FF + ch), bb = *(const f32x4*)(cb + FF + ch);
#pragma unroll
            for (int ai = 0; ai < 2; ++ai) {
                const int blk = u.pm * 4 + ai * 2 + wr;
                if (fr < 2) { *(f32x4*)(RAW + (size_t)(blk * 4 + fr) * FF2 + ch) = acc[ai][0][0][n]; *(f32x4*)(RAW + (size_t)(blk * 4 + fr) * FF2 + FF + ch) = acc[ai][1][0][n]; }
                if (fr >= 14) { *(f32x4*)(RAW + (size_t)(blk * 4 + fr - 12) * FF2 + ch) = acc[ai][0][3][n]; *(f32x4*)(RAW + (size_t)(blk * 4 + fr - 12) * FF2 + FF + ch) = acc[ai][1][3][n]; }
                f32x4 pa1 = {0.f, 0.f, 0.f, 0.f}, pa2 = pa1, pb1 = pa1, pb2 = pa1;
#pragma unroll
                for (int m = 0; m < 4; ++m) {
                    const f32x4 va = acc[ai][0][m][n], vb = acc[ai][1][m][n];
                    const f32x4 ra1 = ror1(va), ra2 = ror2(va), rb1 = ror1(vb), rb2 = ror2(vb);
                    const f32x4 xa1 = fr >= 1 ? ra1 : pa1, xa2 = fr >= 2 ? ra2 : pa2, xb1 = fr >= 1 ? rb1 : pb1, xb2 = fr >= 2 ? rb2 : pb2;
                    pa1 = ra1; pa2 = ra2; pb1 = rb1; pb2 = rb2;
                    const f32x4 ya = ba + w0a * xa2 + w1a * xa1 + w2a * va, yb = bb + w0b * xb2 + w1b * xb1 + w2b * vb;
                    const f32x4 o = silu_mul(ya, yb);
                    if (!(m == 0 && fr < 2)) *(u32x2*)(ACT + (size_t)(blk * 64 + 16 * m + fr) * FF + ch) = pk4(o);
                }
            }
        }
    }
};

__device__ __forceinline__ void fixup_phase(const float* RAW, bf16_t* ACT, const float* cw, const float* cb, int gtid, int nthr) {
    for (int it = gtid; it < 256 * 2 * 704; it += nthr) {
        const int c4 = it % 704, rr = (it / 704) & 1, blk = it / 1408, ch = 4 * c4;
        const float* cur = RAW + (size_t)(blk * 4 + rr) * FF2;
        const float* p1 = rr == 1 ? RAW + (size_t)(blk * 4) * FF2 : (blk > 0 ? RAW + (size_t)((blk - 1) * 4 + 3) * FF2 : nullptr);
        const float* p2 = rr == 1 ? (blk > 0 ? RAW + (size_t)((blk - 1) * 4 + 3) * FF2 : nullptr) : (blk > 0 ? RAW + (size_t)((blk - 1) * 4 + 2) * FF2 : nullptr);
        const f32x4 z = {0.f, 0.f, 0.f, 0.f};
        const f32x4 va = *(const f32x4*)(cur + ch), vb = *(const f32x4*)(cur + FF + ch);
        const f32x4 a1 = p1 ? *(const f32x4*)(p1 + ch) : z, b1 = p1 ? *(const f32x4*)(p1 + FF + ch) : z;
        const f32x4 a2 = p2 ? *(const f32x4*)(p2 + ch) : z, b2 = p2 ? *(const f32x4*)(p2 + FF + ch) : z;
        const f32x4 ya = *(const f32x4*)(cb + ch) + *(const f32x4*)(cw + ch) * a2 + *(const f32x4*)(cw + FF2 + ch) * a1 + *(const f32x4*)(cw + 2 * FF2 + ch) * va;
        const f32x4 yb = *(const f32x4*)(cb + FF + ch) + *(const f32x4*)(cw + FF + ch) * b2 + *(const f32x4*)(cw + FF2 + FF + ch) * b1 + *(const f32x4*)(cw + 2 * FF2 + FF + ch) * vb;
        *(u32x2*)(ACT + (size_t)(blk * 64 + rr) * FF + ch) = pk4(silu_mul(ya, yb));
    }
}

template <int W> __device__ __forceinline__ void pooled_item(const bf16_t* UPOOL, bf16_t* POOLED, int t, int c8) {
    v4u v[W];
#pragma unroll
    for (int j = 0; j < W; ++j) { const int tj = (t - j) >= 0 ? (t - j) : 0; v[j] = *(const v4u*)(UPOOL + (size_t)tj * PW + 8 * c8); }
    float s[8];
#pragma unroll
    for (int e = 0; e < 8; ++e) s[e] = 0.f;
#pragma unroll
    for (int j = 0; j < W; ++j) { const float m = (t - j) >= 0 ? 1.f : 0.f;
        s[0] = fmaf(m, bf_lo(v[j].x), s[0]); s[1] = fmaf(m, bf_hi(v[j].x), s[1]); s[2] = fmaf(m, bf_lo(v[j].y), s[2]); s[3] = fmaf(m, bf_hi(v[j].y), s[3]);
        s[4] = fmaf(m, bf_lo(v[j].z), s[4]); s[5] = fmaf(m, bf_hi(v[j].z), s[5]); s[6] = fmaf(m, bf_lo(v[j].w), s[6]); s[7] = fmaf(m, bf_hi(v[j].w), s[7]); }
    const int cntw = (t + 1) < W ? (t + 1) : W; const float inv = 1.0f / (float)cntw; v4u o;
    o.x = pkbf(s[0] * inv - bf_lo(v[0].x), s[1] * inv - bf_hi(v[0].x)); o.y = pkbf(s[2] * inv - bf_lo(v[0].y), s[3] * inv - bf_hi(v[0].y));
    o.z = pkbf(s[4] * inv - bf_lo(v[0].z), s[5] * inv - bf_hi(v[0].z)); o.w = pkbf(s[6] * inv - bf_lo(v[0].w), s[7] * inv - bf_hi(v[0].w));
    *(v4u*)(POOLED + (size_t)t * PW + 8 * c8) = o;
}
__device__ __forceinline__ void pooled_phase(const bf16_t* UPOOL, bf16_t* POOLED, int gtid, int nthr) {
    for (int it = gtid; it < M * 64; it += nthr) {
        const int wv = it >> 6, l = it & 63, g = wv & 3, t = (wv >> 2) * 4 + (l >> 4), c8 = g * 16 + (l & 15);
        if (g == 0) pooled_item<2>(UPOOL, POOLED, t, c8); else if (g == 1) pooled_item<4>(UPOOL, POOLED, t, c8); else if (g == 2) pooled_item<8>(UPOOL, POOLED, t, c8); else pooled_item<16>(UPOOL, POOLED, t, c8);
    }
}

#define MFMA32(a, b, c) __builtin_amdgcn_mfma_f32_32x32x16_bf16((a), (b), (c), 0, 0, 0)
__device__ __forceinline__ unsigned lds_add(LAS unsigned* p, unsigned v) { return __hip_atomic_fetch_add(p, v, __ATOMIC_RELAXED, __HIP_MEMORY_SCOPE_WORKGROUP); }
__device__ __forceinline__ unsigned lds_or(LAS unsigned* p, unsigned v) { return __hip_atomic_fetch_or(p, v, __ATOMIC_RELAXED, __HIP_MEMORY_SCOPE_WORKGROUP); }

__device__ __forceinline__ float u2f(unsigned u) { return __uint_as_float((u & 0x80000000u) ? (u & 0x7fffffffu) : ~u); }
template <bool EMIT>
__device__ __forceinline__ void tk_pass(int qb, int wave, int lane, const bf16_t* KI, const LAS bf16_t* QF, const float (&wv)[4], LAS unsigned* H, LAS unsigned* SELM, LAS unsigned* TIEM,
                                        int sh, unsigned vlo, bool clampTop, unsigned bmax, int stage, unsigned vmin, float fsel, float ftie) {
    const int r = lane & 31, h = lane >> 5;
    const int gstep = stage == 1 ? 8 : 1, g0 = stage == 1 ? wave : 0;
#define TK_NEXT_G(g) ({ int _g = (g) + gstep; if (stage == 2 && (_g & 7) == wave) ++_g; _g; })
    int gcur = g0; if (stage == 2 && (gcur & 7) == wave) ++gcur;
    pg8::bf16x8 kf[4];
    { const int T0 = (wave + 8 * gcur) <= qb ? (wave + 8 * gcur) : qb; const bf16_t* kp = KI + (size_t)T0 * 2048 + 8 * lane;
#pragma unroll
      for (int s = 0; s < 4; ++s) kf[s] = *(const pg8::bf16x8*)(kp + 512 * s); }
    LAS unsigned* Hq = H + r * HSTRIDE;
#pragma unroll 1
    for (; wave + 8 * gcur <= qb; gcur = TK_NEXT_G(gcur)) {
        const int T = wave + 8 * gcur;
        float sc[16];
#pragma unroll
        for (int i = 0; i < 16; ++i) sc[i] = 0.f;
#pragma unroll
        for (int hd = 0; hd < 4; ++hd) { f32x16 a;
#pragma unroll
            for (int i = 0; i < 16; ++i) a[i] = 0.f;
#pragma unroll
            for (int s = 0; s < 4; ++s) a = MFMA32(kf[s], *(const LAS pg8::bf16x8*)(QF + (hd * 4 + s) * 512 + lane * 8), a);
#pragma unroll
            for (int i = 0; i < 16; ++i) { const float av = a[i]; const int ab = __float_as_int(av); sc[i] = fmaf(wv[hd], __int_as_float(ab > 0 ? ab : 0), sc[i]); } }
        { const int Tnn = wave + 8 * TK_NEXT_G(gcur); const int Tn = Tnn <= qb ? Tnn : T; const bf16_t* kp = KI + (size_t)Tn * 2048 + 8 * lane;
#pragma unroll
          for (int s = 0; s < 4; ++s) kf[s] = *(const pg8::bf16x8*)(kp + 512 * s); }
        const int rlim = (T == qb) ? r : 64;
        if (!EMIT) {
#pragma unroll
            for (int i = 0; i < 16; ++i) {
                const int kr = (i & 3) + 8 * (i >> 2) + 4 * h;
                unsigned uu = __float_as_uint(sc[i]); uu ^= ((unsigned)((int)uu >> 31)) | 0x80000000u;
                const unsigned v = uu >> sh; unsigned b = v - vlo;
                const bool ok = (kr <= rlim) && (v >= vmin) && (clampTop || b <= bmax);
                b = b > 2047u ? 2047u : b;
                lds_add(Hq + (ok ? (b >> 1) : 1024u), 1u << ((b & 1u) * 16u));
            }
        } else {
            unsigned ms = 0u, mg = 0u;
#pragma unroll
            for (int i = 15; i >= 0; --i) {
                asm("v_cmp_ge_f32_e32 vcc, %1, %2\n\tv_addc_co_u32_e32 %0, vcc, %0, %0, vcc" : "+v"(ms) : "v"(sc[i]), "v"(fsel) : "vcc");
                asm("v_cmp_ge_f32_e32 vcc, %1, %2\n\tv_addc_co_u32_e32 %0, vcc, %0, %0, vcc" : "+v"(mg) : "v"(sc[i]), "v"(ftie) : "vcc");
            }
            const unsigned vrow = rlim >= 31 ? 0xffffffffu : ((2u << rlim) - 1u);
            auto spread = [&](unsigned m) { return (((m & 0xfu) | ((m & 0xf0u) << 4) | ((m & 0xf00u) << 8) | ((m & 0xf000u) << 12)) << (4 * h)) & vrow; };
            const unsigned msel = spread(ms), mtie = spread(mg) & ~msel;
            const unsigned osel = __shfl_xor(msel, 32), otie = __shfl_xor(mtie, 32);
            if (h == 0) { SELM[r * MSTRIDE + T] = msel | osel; TIEM[r * MSTRIDE + T] = mtie | otie; }
        }
    }
#undef TK_NEXT_G
}

template <int CTRL> __device__ __forceinline__ float dppx(float x) { return __builtin_bit_cast(float, __builtin_amdgcn_mov_dpp(__builtin_bit_cast(int, x), CTRL, 0xf, 0xf, true)); }
__device__ __forceinline__ u32x2 tk_rescore_load(const bf16_t* KI, int key, int lane) {
    const int c = 4 * (lane & 15);
    return *(const u32x2*)(KI + (size_t)(key >> 5) * 2048 + (c >> 4) * 512 + ((((c >> 3) & 1) * 32 + (key & 31)) * 8) + (c & 7));
}
__device__ __forceinline__ float tk_rescore(const u32x2 q4, float wh, const u32x2 k4) {
    float d = bf_lo(q4.x) * bf_lo(k4.x); d = fmaf(bf_hi(q4.x), bf_hi(k4.x), d); d = fmaf(bf_lo(q4.y), bf_lo(k4.y), d); d = fmaf(bf_hi(q4.y), bf_hi(k4.y), d);
    d += dppx<0xB1>(d); d += dppx<0x4E>(d); d += dppx<0x141>(d); d += dppx<0x140>(d);
    float sc = wh * fmaxf(d, 0.f);
    sc += __shfl_xor(sc, 16); sc += __shfl_xor(sc, 32);
    return sc + 0.f;
}

__device__ __forceinline__ int wave_incl_scan(int v) {
    v += __builtin_amdgcn_update_dpp(0, v, 0x111, 0xf, 0xf, true); v += __builtin_amdgcn_update_dpp(0, v, 0x112, 0xf, 0xf, true);
    v += __builtin_amdgcn_update_dpp(0, v, 0x114, 0xf, 0xf, true); v += __builtin_amdgcn_update_dpp(0, v, 0x118, 0xf, 0xf, true);
    v += __builtin_amdgcn_update_dpp(0, v, 0x142, 0xa, 0xf, false); v += __builtin_amdgcn_update_dpp(0, v, 0x143, 0xc, 0xf, false);
    return v;
}
__device__ __forceinline__ void tk_scan(const LAS unsigned* Hq, LAS unsigned* pref_p, LAS unsigned* need_p, LAS unsigned* cnt_p, int bits, int lane) {
    const int need = (int)*need_p;
    int S = 0;
#pragma unroll
    for (int i = 0; i < 16; ++i) { const unsigned w = Hq[16 * lane + ((i + lane) & 15)]; S += (int)((w & 0xffffu) + (w >> 16)); }
    const int incl = wave_incl_scan(S), total = __builtin_amdgcn_readlane(incl, 63), Tabove = total - incl;
    const bool hit = (Tabove < need) && (need <= Tabove + S);
    const unsigned long long mk = __ballot(hit);
    const int L = mk ? (int)__builtin_ctzll(mk) : 0;
    const int remL = need - __builtin_amdgcn_readlane(Tabove, L);
    const unsigned w2 = Hq[16 * L + ((lane & 31) >> 1)];
    const int c = lane < 32 ? (int)((w2 >> (16 * (lane & 1))) & 0xffffu) : 0;
    const int incl2 = wave_incl_scan(c), tot2 = __builtin_amdgcn_readlane(incl2, 63), above2 = tot2 - incl2;
    const bool hit2 = (lane < 32) && (above2 < remL) && (remL <= above2 + c);
    const unsigned long long mk2 = __ballot(hit2);
    const int J = mk2 ? (int)__builtin_ctzll(mk2) : 0;
    const unsigned Dsel = (unsigned)(32 * L + J), nsel = mk2 ? (unsigned)(remL - __builtin_amdgcn_readlane(above2, J)) : 1u, csel = (unsigned)__builtin_amdgcn_readlane(c, J);
    if (lane == 0) { *pref_p = bits ? ((*pref_p << bits) | Dsel) : Dsel; *need_p = nsel; if (cnt_p) *cnt_p = csel; }
}

typedef float f32x2_t __attribute__((ext_vector_type(2)));
__device__ __forceinline__ void unpack16(const v4u w, f32x2_t (&f)[8]) {
#pragma unroll
    for (int i = 0; i < 4; ++i) { f[2 * i] = __builtin_amdgcn_cvt_pk_f32_fp8((int)w[i], false); f[2 * i + 1] = __builtin_amdgcn_cvt_pk_f32_fp8((int)w[i], true); }
}
__device__ __forceinline__ void attn_item(int t, int hd, const unsigned short* SEL, const bf16_t* Q, const unsigned char* K8, const unsigned char* V8, bf16_t* ATTN, int lane) {
    constexpr float LOG2E = 1.4426950408889634f;
    const int kk = lane >> 2, part = lane & 3, cnt = (t + 1) < 256 ? (t + 1) : 256;
    const float slope2 = __uint_as_float((unsigned)(126 - hd) << 23) * LOG2E, sc2 = 0.125f * LOG2E;
    f32x2_t q[8];
    { const v4u qa = *(const v4u*)(Q + (size_t)t * AW + hd * 64 + part * 16), qb = *(const v4u*)(Q + (size_t)t * AW + hd * 64 + part * 16 + 8);
#pragma unroll
      for (int i = 0; i < 4; ++i) { q[i] = (f32x2_t){bf_lo(qa[i]) * sc2, bf_hi(qa[i]) * sc2}; q[4 + i] = (f32x2_t){bf_lo(qb[i]) * sc2, bf_hi(qb[i]) * sc2}; } }
    const unsigned short* lp = SEL + (size_t)t * 256;
    const unsigned char* kb = K8 + (size_t)hd * M * 128 + part * 16; const unsigned char* vb = kb + 64; (void)V8;
    int key[16]; v4u kf[16], vf[16];
#pragma unroll
    for (int r = 0; r < 16; ++r) { const int j = 16 * r + kk; key[r] = (int)lp[j < cnt ? j : cnt - 1]; }
#pragma unroll
    for (int r = 0; r < 16; ++r) { kf[r] = *(const v4u*)(kb + (size_t)key[r] * 128); vf[r] = *(const v4u*)(vb + (size_t)key[r] * 128); }
    float sv[16]; float mx = -INFINITY;
#pragma unroll
    for (int r = 0; r < 16; ++r) { f32x2_t kx[8]; unpack16(kf[r], kx); f32x2_t d2 = q[0] * kx[0];
#pragma unroll
        for (int e = 1; e < 8; ++e) d2 = __builtin_elementwise_fma(q[e], kx[e], d2);
        sv[r] = d2.x + d2.y; }
#pragma unroll
    for (int r = 0; r < 16; ++r) sv[r] += dppx<0xB1>(sv[r]);
#pragma unroll
    for (int r = 0; r < 16; ++r) sv[r] += dppx<0x4E>(sv[r]);
#pragma unroll
    for (int r = 0; r < 16; ++r) { sv[r] = (16 * r + kk) < cnt ? sv[r] - slope2 * (float)(t - key[r]) : -INFINITY; mx = fmaxf(mx, sv[r]); }
    mx = fmaxf(mx, __shfl_xor(mx, 4)); mx = fmaxf(mx, __shfl_xor(mx, 8)); mx = fmaxf(mx, __shfl_xor(mx, 16)); mx = fmaxf(mx, __shfl_xor(mx, 32));
    f32x2_t o[8]; float lsum = 0.f;
#pragma unroll
    for (int e = 0; e < 8; ++e) o[e] = (f32x2_t){0.f, 0.f};
#pragma unroll
    for (int r = 0; r < 16; ++r) { const float p = __builtin_amdgcn_exp2f(sv[r] - mx); lsum += p; f32x2_t vx[8]; unpack16(vf[r], vx); const f32x2_t p2 = (f32x2_t){p, p};
#pragma unroll
        for (int e = 0; e < 8; ++e) o[e] = __builtin_elementwise_fma(p2, vx[e], o[e]); }
    lsum += dppx<0x124>(lsum); lsum += dppx<0x128>(lsum); lsum += __shfl_xor(lsum, 16); lsum += __shfl_xor(lsum, 32);
    float of[16];
#pragma unroll
    for (int e = 0; e < 8; ++e) { of[2 * e] = o[e].x; of[2 * e + 1] = o[e].y; }
#pragma unroll
    for (int e = 0; e < 16; ++e) of[e] += dppx<0x124>(of[e]);
#pragma unroll
    for (int e = 0; e < 16; ++e) of[e] += dppx<0x128>(of[e]);
#pragma unroll
    for (int e = 0; e < 16; ++e) of[e] += __shfl_xor(of[e], 16);
#pragma unroll
    for (int e = 0; e < 16; ++e) of[e] += __shfl_xor(of[e], 32);
    if (lane < 4) { const float inv = __builtin_amdgcn_rcpf(lsum); v4u a, b;
        a.x = pkbf(of[0] * inv, of[1] * inv); a.y = pkbf(of[2] * inv, of[3] * inv); a.z = pkbf(of[4] * inv, of[5] * inv); a.w = pkbf(of[6] * inv, of[7] * inv);
        b.x = pkbf(of[8] * inv, of[9] * inv); b.y = pkbf(of[10] * inv, of[11] * inv); b.z = pkbf(of[12] * inv, of[13] * inv); b.w = pkbf(of[14] * inv, of[15] * inv);
        *(v4u*)(ATTN + (size_t)t * AW + hd * 64 + part * 16) = a; *(v4u*)(ATTN + (size_t)t * AW + hd * 64 + part * 16 + 8) = b; }
}

struct TkPtrs { const bf16_t *QI, *KI; const float* WI; unsigned short* SEL; };
__device__ __forceinline__ void topk_attn_block(int qb, const TkPtrs& P, LAS unsigned char* lds, int tid, int wave, int lane, bool do_attn) {
    LAS unsigned* H = (LAS unsigned*)lds;
    LAS unsigned* SELM = (LAS unsigned*)lds;
    LAS unsigned* TIEM = (LAS unsigned*)(lds + 32 * MSTRIDE * 4);
    LAS unsigned short* LIST = (LAS unsigned short*)(lds + LIST_OFF);
    LAS unsigned* STP = (LAS unsigned*)(lds + ST_OFF);
    LAS unsigned* STN = STP + 32;
    const int t0 = qb * 32, r = lane & 31, h = lane >> 5;
    SYNC();
    float wv[4];
    LAS bf16_t* QF = (LAS bf16_t*)(lds + LIST_OFF);
    { const bf16_t* qp = P.QI + (size_t)(t0 + r) * 256 + 8 * h;
#pragma unroll
      for (int k = 0; k < 2; ++k) { const int f = 2 * wave + k; *(LAS pg8::bf16x8*)(QF + f * 512 + lane * 8) = *(const pg8::bf16x8*)(qp + (f >> 2) * 64 + 16 * (f & 3)); }
      const f32x4 w4 = *(const f32x4*)(P.WI + (size_t)(t0 + r) * 4); wv[0] = w4[0]; wv[1] = w4[1]; wv[2] = w4[2]; wv[3] = w4[3]; }
    LAS unsigned* STC = STP + 64;
    LAS unsigned* STG = STP + 96;
    LAS unsigned* FB = STP + 160;
    LAS unsigned* STS = STP + 192;
    LAS float* FSEL = (LAS float*)(STP + 256);
    LAS float* FTIE = FSEL + 32;
    const bool negw = (wv[0] <= 0.f) && (wv[1] <= 0.f) && (wv[2] <= 0.f) && (wv[3] <= 0.f);
    const unsigned wbase = negw ? 7745u : 22976u;
#pragma unroll 1
    for (int rep_tk = 0; rep_tk < REP_TK; ++rep_tk) {
    if (wave == 0 && lane == 0) *FB = 0u;
#pragma unroll 1
    for (int mode = 0; mode < 2; ++mode) {
        if (mode == 1) { if (*FB == 0u) break; }
        if (wave == 0 && lane < 32) { STP[lane] = 0u; const int nv = t0 + lane + 1; STN[lane] = nv < 256 ? nv : 256; STG[lane] = negw ? 1u : 0u; }
        const int nstep = mode == 0 ? 1 : 3;
#pragma unroll 1
        for (int step = 0; step < nstep; ++step) {
            if (mode == 1 || step == 0) { for (int i = tid; i < 32 * HSTRIDE; i += NTHR) H[i] = 0u; }
            SYNC();
            const int sh = mode == 0 ? 17 : (step == 0 ? 21 : (step == 1 ? 10 : 0));
            const unsigned vlo = mode == 0 ? wbase : (step == 0 ? 0u : (STP[r] << (step == 1 ? 11 : 10)));
            const unsigned vmin = vlo;
            tk_pass<false>(qb, wave, lane, P.KI, QF, wv, H, SELM, TIEM, sh, vlo, mode == 0, (mode == 1 && step == 2) ? 1023u : 2047u, 0, vmin, 0.f, 0.f);
            SYNC();
            const bool samp = false;
#pragma unroll 1
            for (int qq = 0; qq < 4; ++qq) { const int rq = 4 * wave + qq;
                tk_scan(H + rq * HSTRIDE, samp ? STS + rq : STP + rq, samp ? STS + 32 + rq : STN + rq, STC + rq, (mode == 1 && step == 2) ? 10 : 11, lane);
                if (mode == 0 && lane == 0) { const unsigned D = STP[rq], nn = STN[rq], c = STC[rq], ng = STG[rq] & 1u;
                    const bool zerobin = ng && D == 2047u, edge = (D == 0u) || (D == 2047u && !ng);
                    const bool wantc = (c > nn) && !zerobin;
                    if (edge || (wantc && c > 64u)) lds_or(FB, 1u);
                    STG[rq] = ng | (wantc ? 2u : 0u);
                    const unsigned wb = ng ? 7745u : 22976u;
                    FTIE[rq] = u2f((wb + D) << 17); FSEL[rq] = zerobin ? INFINITY : u2f((wb + D + 1u) << 17); }
                if (mode == 1 && step == 2 && lane == 0) { const unsigned tau = STP[rq]; FTIE[rq] = u2f(tau); FSEL[rq] = tau == 0xffffffffu ? INFINITY : u2f(tau + 1u); } }
            SYNC();
        }
        if (mode == 0 && *FB != 0u) continue;
        tk_pass<true>(qb, wave, lane, P.KI, QF, wv, H, SELM, TIEM, 0, 0u, false, 0u, 0, 0u, FSEL[r], FTIE[r]);
        SYNC();
        break;
    }
    }
    if (!do_attn) return;
#pragma unroll 1
    for (int qq = 0; qq < 4; ++qq) {
        const int rq = 4 * wave + qq, t = t0 + rq; int mties = (int)STN[rq];
        unsigned tw[8], fw[8]; int S = 0;
#pragma unroll
        for (int i = 0; i < 8; ++i) { const int T = 8 * lane + i; const bool v = T <= qb; tw[i] = v ? TIEM[rq * MSTRIDE + T] : 0u; fw[i] = v ? SELM[rq * MSTRIDE + T] : 0u; S += __builtin_popcount(tw[i]); }
        const int incl = wave_incl_scan(S);
        if (*FB == 0u && (STG[rq] & 2u)) {
            const int c = __builtin_amdgcn_readlane(incl, 63), nn = mties;
            LAS unsigned short* cl = LIST + rq * 256;
            { int pos = incl - S;
#pragma unroll
              for (int i = 0; i < 8; ++i) { unsigned w = tw[i]; while (w) { const int b = __builtin_ctz(w); if (pos < 64) cl[pos] = (unsigned short)(256 * lane + 32 * i + b); ++pos; w &= w - 1u; } } }
            LDS_WAIT(); asm volatile("" ::: "memory");
            const u32x2 q4 = *(const u32x2*)(P.QI + (size_t)t * 256 + 4 * lane); const float wh = P.WI[(size_t)t * 4 + (lane >> 4)];
            float mys = 0.f; const int cc = c < 64 ? c : 64;
#pragma unroll 1
            for (int j0 = 0; j0 < cc; j0 += 8) { u32x2 k4[8];
#pragma unroll
                for (int u = 0; u < 8; ++u) { const int jj = (j0 + u) < cc ? (j0 + u) : (cc - 1); k4[u] = tk_rescore_load(P.KI, __builtin_amdgcn_readfirstlane((int)cl[jj]), lane); }
#pragma unroll
                for (int u = 0; u < 8; ++u) { const float sj = tk_rescore(q4, wh, k4[u]); if (lane == j0 + u) mys = sj; } }
            int rank = 0;
            for (int j = 0; j < cc; ++j) { const float sj = __int_as_float(__builtin_amdgcn_readlane(__float_as_int(mys), j)); rank += (sj > mys || (sj == mys && j < lane)) ? 1 : 0; }
            const bool keepme = lane < cc && rank < nn; const int mykey = lane < cc ? (int)cl[lane] : 0;
#pragma unroll 1
            for (int j = 0; j < cc; ++j) { const int kj = __builtin_amdgcn_readlane(mykey, j); const int kp = __builtin_amdgcn_readlane((int)keepme, j);
                if (kp && (kj >> 8) == lane) {
#pragma unroll
                    for (int i = 0; i < 8; ++i) if (((kj >> 5) & 7) == i) fw[i] |= 1u << (kj & 31); } }
            mties = 0;
        }
        int take = mties - (incl - S); take = take < 0 ? 0 : (take > S ? S : take);
        int cl2 = 0;
#pragma unroll
        for (int i = 0; i < 8; ++i) { unsigned w = tw[i]; const int c = __builtin_popcount(w); unsigned keep;
            if (take >= c) { keep = w; take -= c; } else { keep = 0u; for (int k = 0; k < take; ++k) { const unsigned low = w & (0u - w); keep |= low; w ^= low; } take = 0; }
            fw[i] |= keep; cl2 += __builtin_popcount(fw[i]); }
        const int inc2 = wave_incl_scan(cl2);
        int pos = inc2 - cl2; const int cnt = __builtin_amdgcn_readlane(inc2, 63);
        LAS unsigned short* lp = LIST + rq * 256;
#pragma unroll
        for (int i = 0; i < 8; ++i) { unsigned w = fw[i]; while (w) { const int b = __builtin_ctz(w); if (pos < 256) lp[pos] = (unsigned short)(256 * lane + 32 * i + b); ++pos; w &= w - 1u; } }
        LDS_WAIT(); asm volatile("" ::: "memory");
        (void)cnt;
        *(u32x2*)(P.SEL + (size_t)t * 256 + 4 * lane) = *(const LAS u32x2*)(lp + 4 * lane);
    }
}

struct OneUnit { int pm, pn;
    __device__ __forceinline__ bool next(int i, pg8::Unit& u) const { if (i != 0) return false; u.pm = pm; u.pn = pn; return true; }
    __device__ __forceinline__ void a_ready(const pg8::Unit&) const {}
    __device__ __forceinline__ void done(const pg8::Unit&) const {}
};
struct Args { const float* in[18]; float* out; unsigned char* ws; int ph_lo, ph_hi; };
constexpr int NPH = 13;

typedef const __attribute__((address_space(4))) unsigned long long* kargp_t;
#define KARGS() kargp_t kargs = (kargp_t)__builtin_amdgcn_kernarg_segment_ptr(); asm volatile("" : "+s"(kargs)); GAS unsigned char* const ws = (GAS unsigned char*)kargs[19]; (void)ws
#define KIN(i) ((const float*)(const GAS float*)kargs[(i)])
#define KOUT() ((float*)(GAS float*)kargs[18])
#define WSP(T, off) ((T*)(GAS T*)(ws + (off)))
__global__ void __launch_bounds__(NTHR, 2) fwd_kernel(Args a) {
    extern __shared__ __attribute__((aligned(16))) unsigned char lds_raw[];
    LAS unsigned char* lds = (LAS unsigned char*)lds_raw;
    const int lo = a.ph_lo, hi = a.ph_hi;
    { int tid0 = threadIdx.x; asm volatile("" : "+v"(tid0)); for (int u = tid0; u < (LDS_BYTES - MISC_OFF) / 4; u += NTHR) ((LAS unsigned*)(lds + MISC_OFF))[u] = 0u; }
    SYNC();
    XcdBarrier bar; bar.bar = nullptr; bar.x = 0; bar.st = nullptr;
    if (hi - lo > 1) { KARGS(); bar = xcd_barrier_post((unsigned*)(GAS unsigned*)(ws + WS_CTL) + CW_BAR, (volatile LAS unsigned*)(lds + MISC_OFF) + 8); }
#define IN(k) (lo <= (k) && (k) < hi)
#define SEAM(k) do { if (IN(k) && IN((k) + 1)) xcd_barrier(bar); } while (0)
#define IDS() const int tid = threadIdx.x, lane = tid & 63, wave = __builtin_amdgcn_readfirstlane(tid >> 6), G = gridDim.x, bid = blockIdx.x; (void)lane; (void)wave; (void)G; (void)bid

    for (int rep_ph = 0; rep_ph < ((REP_PH == 0) ? 2 : 1); ++rep_ph) if (IN(0)) { KARGS(); IDS();
        P0Ptrs P{KIN(1), KIN(2), KIN(5), KIN(8), KIN(9), KIN(11), KIN(12), KIN(14), KIN(17), KIN(10), WSP(bf16_t, WS_WIN), WSP(bf16_t, WS_WATTN), WSP(bf16_t, WS_WGRP), WSP(bf16_t, WS_WPOOL), WSP(bf16_t, WS_WOUT),
                 WSP(bf16_t, WS_WUP), WSP(bf16_t, WS_WDOWN), WSP(float, WS_MODP)};
        p0_prologue(P, lds, bid * NWAVES + wave, G * NWAVES, wave, lane);
    }
    SEAM(0);
    if (IN(1)) { KARGS(); IDS();
        const float *b_ada = KIN(3), *norm1_g = KIN(4); const float* MODP = WSP(float, WS_MODP); float* MODF = WSP(float, WS_MODF);
        LAS float* mulv = (LAS float*)lds; LAS float* addv = mulv + 1024;
        for (int i = tid; i < 1024; i += NTHR) { float sh = b_ada[i], scv = b_ada[1024 + i];
#pragma unroll
            for (int kc = 0; kc < 16; ++kc) { sh += MODP[kc * NMOD + i]; scv += MODP[kc * NMOD + 1024 + i]; }
            mulv[i] = norm1_g[i] * (1.0f + scv); addv[i] = sh; }
        if (bid < 24 && tid < 256) { const int i = bid * 256 + tid; float v = b_ada[i];
#pragma unroll
            for (int kc = 0; kc < 16; ++kc) v += MODP[kc * NMOD + i];
            MODF[i] = v; }
        SYNC();
        modulate_rows(KIN(0), WSP(bf16_t, WS_H), mulv, addv, bid * NWAVES + wave, G * NWAVES, lane);
        SYNC();
    }
    SEAM(1);
    for (int rep_ph = 0; rep_ph < ((REP_PH == 2) ? 2 : 1); ++rep_ph) if (IN(2)) { KARGS(); IDS();
        pg8::Gemm g{WSP(bf16_t, WS_H), WSP(bf16_t, WS_WIN), M, NINP, DM}; pg8::StaticOrder S; S.init(M, NINP, G, bid);
        EpiProj E{WSP(bf16_t, WS_Q), WSP(unsigned char, WS_K), WSP(unsigned char, WS_K), WSP(bf16_t, WS_QI), WSP(bf16_t, WS_KI), WSP(bf16_t, WS_UPOOL), WSP(bf16_t, WS_GA), WSP(bf16_t, WS_GP), WSP(float, WS_WI), KIN(6), KIN(7)};
        pg8::gemm_phase<EpiProj, pg8::StaticOrder, true, true>(lds, g, S, E);
    }
    SEAM(2);
    if (IN(3)) { KARGS(); IDS();
        if (bid < 8) {
            pg8::Gemm g{WSP(bf16_t, WS_WPOOL), WSP(bf16_t, WS_WGRP), 1024, PW, PW}; OneUnit S{bid >> 1, bid & 1};
            EpiBf<3> E{WSP(bf16_t, WS_POOLMIX), PW, nullptr, nullptr};
            pg8::gemm_phase<EpiBf<3>, OneUnit, true, true>(lds, g, S, E);
            SYNC();
        }
        pooled_phase(WSP(bf16_t, WS_UPOOL), WSP(bf16_t, WS_POOLED), bid * NTHR + tid, G * NTHR);
        TkPtrs T{WSP(bf16_t, WS_QI), WSP(bf16_t, WS_KI), WSP(float, WS_WI), (unsigned short*)KOUT()};
        unsigned* qctr = (unsigned*)(GAS unsigned*)(ws + WS_CTL) + CW_QUEUE;
        LAS int* qslot = (LAS int*)(lds + ST_OFF + 2040);
#pragma unroll 1
        for (;;) {
            SYNC();
            if (tid == 0) *qslot = (int)__hip_atomic_fetch_add(qctr, 1u, __ATOMIC_RELAXED, __HIP_MEMORY_SCOPE_AGENT);
            SYNC();
            const int qi0 = *qslot;
            const int qi = qi0;
            if (qi >= 512 * (1 + REP_TKONLY)) break;
            topk_attn_block(511 - (qi & 511), T, lds, tid, wave, lane, qi >= 512 * REP_TKONLY);
        }
        SYNC();
    }
    SEAM(3);
    if (IN(4)) { KARGS(); IDS();
        {
        pg8::Gemm g{WSP(bf16_t, WS_POOLED), WSP(bf16_t, WS_POOLMIX), M, DM, PW}; pg8::StaticOrder S; S.init(M, DM, G, bid);
        EpiBf<1> E{WSP(bf16_t, WS_GP), DM, nullptr, nullptr};
        pg8::gemm_phase<EpiBf<1>, pg8::StaticOrder, true, true>(lds, g, S, E);
        }
        SYNC();
        const unsigned short* SEL = (const unsigned short*)KOUT(); const bf16_t* Qp = WSP(bf16_t, WS_Q); const unsigned char *K8 = WSP(unsigned char, WS_K), *V8 = WSP(unsigned char, WS_K); bf16_t* ATTN = WSP(bf16_t, WS_ATTN);
        const bool aff = (G & 7) == 0; const int nitem = 8 * M, step = aff ? (G >> 3) * NWAVES : G * NWAVES;
#pragma unroll 1
        for (int it = aff ? (bid >> 3) * NWAVES + wave : bid * NWAVES + wave; it < (aff ? M : nitem); it += step) attn_item(aff ? it : (it >> 3), aff ? (bid & 7) : (it & 7), SEL, Qp, K8, V8, ATTN, lane);
    }
    SEAM(4);
    if (IN(7)) { KARGS(); IDS();
        pg8::Gemm g{WSP(bf16_t, WS_ATTN), WSP(bf16_t, WS_WATTN), M, DM, AW}; pg8::StaticOrder S; S.init(M, DM, G, bid);
        EpiBf<2> E{WSP(bf16_t, WS_GA), DM, nullptr, WSP(bf16_t, WS_GP)};
        pg8::gemm_phase<EpiBf<2>, pg8::StaticOrder, true, true>(lds, g, S, E);
    }
    SEAM(7);
    for (int rep_ph = 0; rep_ph < ((REP_PH == 8) ? 2 : 1); ++rep_ph) if (IN(8)) { KARGS(); IDS();
        pg8::Gemm g{WSP(bf16_t, WS_GA), WSP(bf16_t, WS_WOUT), M, DM, DM}; pg8::StaticOrder S; S.init(M, DM, G, bid);
        EpiRes E{KIN(0), KOUT(), WSP(float, WS_MODF) + 2048, 0.f};
        pg8::gemm_phase<EpiRes, pg8::StaticOrder, true, true>(lds, g, S, E);
    }
    SEAM(8);
    if (IN(9)) { KARGS(); IDS();
        const float* norm2_g = KIN(13); const float* MODF = WSP(float, WS_MODF);
        LAS float* mulv = (LAS float*)lds; LAS float* addv = mulv + 1024;
        for (int i = tid; i < 1024; i += NTHR) { mulv[i] = norm2_g[i] * (1.0f + MODF[4096 + i]); addv[i] = MODF[3072 + i]; }
        SYNC();
        modulate_rows(KOUT(), WSP(bf16_t, WS_H), mulv, addv, bid * NWAVES + wave, G * NWAVES, lane);
        SYNC();
    }
    SEAM(9);
    for (int rep_ph = 0; rep_ph < ((REP_PH == 10) ? 2 : 1); ++rep_ph) if (IN(10)) { KARGS(); IDS();
        pg8::Gemm g{WSP(bf16_t, WS_H), WSP(bf16_t, WS_WUP), M, FF2, DM}; pg8::StaticOrder S; S.init(M, FF2, G, bid);
        EpiUpAct E{WSP(bf16_t, WS_ACT), WSP(float, WS_RAW), KIN(15), KIN(16)};
        pg8::gemm_phase<EpiUpAct, pg8::StaticOrder, true, true>(lds, g, S, E);
    }
    SEAM(10);
    if (IN(11)) { KARGS(); IDS(); fixup_phase(WSP(float, WS_RAW), WSP(bf16_t, WS_ACT), KIN(15), KIN(16), bid * NTHR + tid, G * NTHR); }
    SEAM(11);
    if (IN(12)) { KARGS(); IDS();
        pg8::Gemm g{WSP(bf16_t, WS_ACT), WSP(bf16_t, WS_WDOWN), M, DM, FF}; pg8::StaticOrder S; S.init(M, DM, G, bid);
        EpiRes E{KOUT(), KOUT(), WSP(float, WS_MODF) + 5120, DBG_C};
        pg8::gemm_phase<EpiRes, pg8::StaticOrder, true, true>(lds, g, S, E);
    }
#undef IN
#undef SEAM
}

extern "C" void kernel_launch(void* const* d_in, const int* in_sizes, int n_in, void* d_out, int out_size, void* d_ws, size_t ws_size, hipStream_t stream) {
    static int grid = 0;
    if (grid == 0) {
        if (n_in != 18 || in_sizes[0] != M * DM || out_size != M * DM || ws_size < WS_END) { fprintf(stderr, "kernel_launch: unexpected shapes (n_in %d, in0 %d, out %d, ws %zu)\n", n_in, n_in > 0 ? in_sizes[0] : -1, out_size, ws_size); grid = -1; return; }
        int dev = 0, cus = 0, per_cu = 0;
        if (hipGetDevice(&dev) != hipSuccess || hipDeviceGetAttribute(&cus, hipDeviceAttributeMultiprocessorCount, dev) != hipSuccess) { grid = -1; return; }
        if (hipFuncSetAttribute((const void*)fwd_kernel, hipFuncAttributeMaxDynamicSharedMemorySize, LDS_BYTES) != hipSuccess) { fprintf(stderr, "kernel_launch: hipFuncSetAttribute failed\n"); grid = -1; return; }
        if (hipOccupancyMaxActiveBlocksPerMultiprocessor(&per_cu, (const void*)fwd_kernel, NTHR, LDS_BYTES) != hipSuccess || per_cu < 1) fprintf(stderr, "kernel_launch: occupancy query says %d\n", per_cu);
        (void)hipGetLastError();
        grid = cus;
    }
    if (grid < 0) return;
    (void)hipMemsetAsync((char*)d_ws + WS_CTL, 0, CTL_ZERO_BYTES, stream);
    Args a{};
    for (int i = 0; i < 18; ++i) a.in[i] = (const float*)d_in[i];
    a.out = (float*)d_out; a.ws = (unsigned char*)d_ws;
#if N_LAUNCH_MODE == 1
    a.ph_lo = 0; a.ph_hi = NPH;
    hipLaunchKernelGGL(fwd_kernel, dim3(grid), dim3(NTHR), LDS_BYTES, stream, a);
#else
    for (int p = 0; p < NPH; ++p) { a.ph_lo = p; a.ph_hi = p + 1; hipLaunchKernelGGL(fwd_kernel, dim3(grid), dim3(NTHR), LDS_BYTES, stream, a); }
#endif
}
```

```cpp
#include <hip/hip_runtime.h>
#include <cstdio>
#include <cstdint>
#ifndef REP_TKONLY
#define REP_TKONLY 0
#endif
#ifndef REP_BLK
#define REP_BLK 1
#endif
namespace pg8 {
#define PG8_LAS __attribute__((address_space(3)))
typedef unsigned short bf16_t;
typedef short bf16x8 __attribute__((ext_vector_type(8)));
typedef float f32x4 __attribute__((ext_vector_type(4)));
typedef unsigned u32x4 __attribute__((ext_vector_type(4)));
constexpr int BM = 256, BK = 64, HALF = 128, HTB = HALF * BK * 2  , STAGE_BYTES = 8 * HTB, NXCD = 8, WGM = 8;

__host__ __device__ __forceinline__ int lds_byte(int r, int c) { const int st = (r >> 4) * 2 + (c >> 5), rr = r & 15, cc = c & 31, ob = rr * 64 + cc * 2; return st * 1024 + (ob ^ (((ob >> 9) & 1) << 5)); }
__host__ __device__ __forceinline__ void stage_rc(int b, int& R, int& C) { const int st = b / 1024, sb = b % 1024, swz = sb ^ (((sb >> 9) & 1) << 5); R = (st >> 1) * 16 + swz / 64; C = (st & 1) * 32 + (swz % 64) / 2; }
__host__ __device__ __forceinline__ int perm32(int rho) { const int n = rho >> 4, i = rho & 15; return 8 * (i >> 2) + 4 * n + (i & 3); }

struct Unit { int pm, pn; };
struct Gemm { const bf16_t* A; const bf16_t* Bt; int M, N, K; };

struct StaticOrder {
    int nM, nN, nwg, G, c;
    __host__ __device__ void init(int M, int N, int G_, int c_) { nM = M / BM; nN = N / BM; nwg = nM * nN; G = G_; c = c_; }
    __host__ __device__ bool next(int i, Unit& u) const {
        const long L = (long)i * G + c; if (L >= nwg) return false;
        int wgid = (int)L; { const int q = nwg / NXCD, r = nwg % NXCD, xcd = wgid % NXCD, off = wgid / NXCD; wgid = (xcd < r ? xcd * (q + 1) : r * (q + 1) + (xcd - r) * q) + off; }
        const int nig = WGM * nN, gid = wgid / nig, fm = gid * WGM, gsz = (nM - fm) < WGM ? (nM - fm) : WGM;
        u.pm = fm + ((wgid % nig) % gsz); u.pn = (wgid % nig) / gsz; return true;
    }
    __device__ __forceinline__ void a_ready(const Unit&) const {}
    __device__ __forceinline__ void done(const Unit&) const {}
};

__device__ __forceinline__ unsigned cvt_pk_bf16(float lo, float hi) { unsigned r; asm volatile("v_cvt_pk_bf16_f32 %0, %1, %2" : "=v"(r) : "v"(lo), "v"(hi)); return r; }
template <class Epi, class Sched, bool ALIGN_EPI = false, bool SP2 = false>
__device__ __forceinline__ void gemm_phase(PG8_LAS unsigned char* lds, const Gemm g, const Sched& S, const Epi& E) {
    int tid_ = threadIdx.x; asm volatile("" : "+v"(tid_));
    const int tid = tid_, wid = __builtin_amdgcn_readfirstlane(tid >> 6), lane = tid & 63, wr = wid >> 2, wc = wid & 3, fr = lane & 15, fq = lane >> 4;
    const int K = g.K, nt = K / BK;
    unsigned voffA[2], voffB[2];
#pragma unroll
    for (int i = 0; i < 2; ++i) { int R, C; stage_rc(tid * 16 + i * 8192, R, C); const int Rb = Epi::PERM ? ((R & ~31) + perm32(R & 31)) : R;
        voffA[i] = (unsigned)(R * K + C) * 2u; voffB[i] = (unsigned)(Rb * K + C) * 2u; }
    const size_t kstep = (size_t)(BK * 2);
    const size_t hstep = (size_t)HALF * K * 2;
    const size_t tstep = 2 * hstep;
    const unsigned ldsw = (unsigned)wid * 1024u;
    const int aoff = lds_byte(wr * 64 + fr, fq * 8), boff = lds_byte(wc * 32 + fr, fq * 8);
#define PG8_SA(b, h) (((b) * 2 + (h)) * HTB)
#define PG8_SB(b, h) ((4 + (b) * 2 + (h)) * HTB)
#define PG8_STAGE(bufoff, gbase, voff) do { _Pragma("unroll") for (int _i = 0; _i < 2; ++_i) \
        __builtin_amdgcn_global_load_lds((const unsigned*)((const char*)(gbase) + (voff)[_i]), (PG8_LAS unsigned*)(lds + (bufoff) + ldsw + _i * 8192), 16, 0, 0); } while (0)
#define PG8_LDA(dst, b, h) do { _Pragma("unroll") for (int m = 0; m < 4; ++m) _Pragma("unroll") for (int k = 0; k < 2; ++k) dst[m][k] = *(const PG8_LAS bf16x8*)(lds + PG8_SA(b, h) + aoff + m * 2048 + k * 1024); } while (0)
#define PG8_LDB(dst, b, h) do { _Pragma("unroll") for (int n = 0; n < 2; ++n) _Pragma("unroll") for (int k = 0; k < 2; ++k) dst[n][k] = *(const PG8_LAS bf16x8*)(lds + PG8_SB(b, h) + boff + n * 2048 + k * 1024); } while (0)
#define PG8_MMA(ai, bj, At, Bt) do { __builtin_amdgcn_s_setprio(1); _Pragma("unroll") for (int m = 0; m < 4; ++m) _Pragma("unroll") for (int n = 0; n < 2; ++n) _Pragma("unroll") for (int k = 0; k < 2; ++k) \
        acc[ai][bj][m][n] = __builtin_amdgcn_mfma_f32_16x16x32_bf16(Bt[n][k], At[m][k], acc[ai][bj][m][n], 0, 0, 0); __builtin_amdgcn_s_setprio(0); } while (0)
#define PG8_WAIT_V(n) asm volatile("s_waitcnt vmcnt(" #n ")" ::: "memory")
#define PG8_WAIT_L(n) asm volatile("s_waitcnt lgkmcnt(" #n ")" ::: "memory")
#define PG8_BAR __builtin_amdgcn_s_barrier()
#define PG8_SCHED __builtin_amdgcn_sched_barrier(0)
    Unit cur, nxt; int ui = 0;
    if (!S.next(0, cur)) return;
    f32x4 acc[2][2][4][2];
#pragma unroll
    for (int a = 0; a < 2; ++a)
#pragma unroll
        for (int b = 0; b < 2; ++b)
#pragma unroll
            for (int m = 0; m < 4; ++m)
#pragma unroll
                for (int n = 0; n < 2; ++n) acc[a][b][m][n] = (f32x4){0.f, 0.f, 0.f, 0.f};
    bf16x8 At[4][2], B0[2][2], B1[2][2];
    const char* cA = (const char*)g.A + (size_t)cur.pm * tstep; const char* cB = (const char*)g.Bt + (size_t)cur.pn * tstep;
    S.a_ready(cur);
    if constexpr (SP2) {
        PG8_STAGE(PG8_SB(0, 0), cB, voffB); PG8_STAGE(PG8_SB(0, 1), cB + hstep, voffB); PG8_STAGE(PG8_SA(0, 0), cA, voffA); PG8_STAGE(PG8_SA(0, 1), cA + hstep, voffA);
        if (wr == 1) PG8_BAR;
        PG8_WAIT_V(2); PG8_BAR;
        PG8_STAGE(PG8_SB(1, 0), cB + kstep, voffB); PG8_STAGE(PG8_SA(1, 0), cA + kstep, voffA); PG8_STAGE(PG8_SB(1, 1), cB + hstep + kstep, voffB);
        PG8_WAIT_V(6); PG8_BAR;
    } else {
        PG8_STAGE(PG8_SB(0, 0), cB, voffB); PG8_STAGE(PG8_SA(0, 0), cA, voffA); PG8_STAGE(PG8_SB(0, 1), cB + hstep, voffB); PG8_STAGE(PG8_SA(0, 1), cA + hstep, voffA);
        if (wr == 1) PG8_BAR;
        PG8_WAIT_V(4); PG8_BAR;
        PG8_STAGE(PG8_SB(1, 0), cB + kstep, voffB); PG8_STAGE(PG8_SA(1, 0), cA + kstep, voffA); PG8_STAGE(PG8_SB(1, 1), cB + hstep + kstep, voffB);
        PG8_WAIT_V(6); PG8_BAR;
    }
    for (;;) {
        const bool has_next = S.next(ui + 1, nxt);
        const char* nA = has_next ? (const char*)g.A + (size_t)nxt.pm * tstep : cA; const char* nB = has_next ? (const char*)g.Bt + (size_t)nxt.pn * tstep : cB;
        for (int t = 0; t < nt; t += 2) {
            const bool last = (t == nt - 2);
            const char* a1 = cA + (size_t)(t + 1) * kstep;
            const char* a2 = last ? nA : cA + (size_t)(t + 2) * kstep; const char* b2 = last ? nB : cB + (size_t)(t + 2) * kstep;
            const char* a3 = a2 + kstep; const char* b3 = b2 + kstep;
            if (last && has_next) S.a_ready(nxt);
            if constexpr (SP2) {
            PG8_LDB(B0, 0, 0); PG8_LDB(B1, 0, 1); PG8_SCHED; PG8_LDA(At, 0, 0); PG8_STAGE(PG8_SA(1, 1), a1 + hstep, voffA);
            PG8_WAIT_V(8); PG8_WAIT_L(0); PG8_BAR; PG8_MMA(0, 0, At, B0); PG8_MMA(0, 1, At, B1); PG8_BAR; PG8_SCHED;
            PG8_LDA(At, 0, 1); PG8_STAGE(PG8_SB(0, 0), b2, voffB); PG8_STAGE(PG8_SB(0, 1), b2 + hstep, voffB); PG8_STAGE(PG8_SA(0, 0), a2, voffA);
            PG8_WAIT_V(8); PG8_WAIT_L(0); PG8_BAR; PG8_MMA(1, 0, At, B0); PG8_MMA(1, 1, At, B1); PG8_BAR; PG8_SCHED;
            PG8_LDB(B0, 1, 0); PG8_LDB(B1, 1, 1); PG8_SCHED; PG8_LDA(At, 1, 0); PG8_STAGE(PG8_SA(0, 1), a2 + hstep, voffA);
            PG8_WAIT_V(8); PG8_WAIT_L(0); PG8_BAR; PG8_MMA(0, 0, At, B0); PG8_MMA(0, 1, At, B1); PG8_BAR; PG8_SCHED;
            PG8_LDA(At, 1, 1); PG8_STAGE(PG8_SB(1, 0), b3, voffB); PG8_STAGE(PG8_SB(1, 1), b3 + hstep, voffB); PG8_STAGE(PG8_SA(1, 0), a3, voffA);
            PG8_WAIT_V(8); PG8_WAIT_L(0); PG8_BAR; PG8_MMA(1, 0, At, B0); PG8_MMA(1, 1, At, B1); PG8_BAR; PG8_SCHED;
            } else {
            PG8_LDB(B0, 0, 0); PG8_SCHED; PG8_LDA(At, 0, 0); PG8_STAGE(PG8_SA(1, 1), a1 + hstep, voffA);
            PG8_WAIT_L(8); PG8_BAR; PG8_WAIT_L(0); PG8_MMA(0, 0, At, B0); PG8_BAR; PG8_SCHED;
            PG8_LDB(B1, 0, 1); PG8_STAGE(PG8_SB(0, 0), b2, voffB);
            PG8_BAR; PG8_WAIT_L(0); PG8_MMA(0, 1, At, B1); PG8_BAR;
            PG8_LDA(At, 0, 1); PG8_STAGE(PG8_SA(0, 0), a2, voffA);
            PG8_BAR; PG8_WAIT_L(0); PG8_MMA(1, 0, At, B0); PG8_BAR; PG8_SCHED;
            PG8_STAGE(PG8_SB(0, 1), b2 + hstep, voffB);
            PG8_WAIT_V(6); PG8_BAR; PG8_MMA(1, 1, At, B1); PG8_BAR;
            PG8_LDB(B0, 1, 0); PG8_SCHED; PG8_LDA(At, 1, 0); PG8_STAGE(PG8_SA(0, 1), a2 + hstep, voffA);
            PG8_WAIT_L(8); PG8_BAR; PG8_WAIT_L(0); PG8_MMA(0, 0, At, B0); PG8_BAR; PG8_SCHED;
            PG8_LDB(B1, 1, 1); PG8_STAGE(PG8_SB(1, 0), b3, voffB);
            PG8_BAR; PG8_WAIT_L(0); PG8_MMA(0, 1, At, B1); PG8_BAR;
            PG8_LDA(At, 1, 1); PG8_STAGE(PG8_SA(1, 0), a3, voffA);
            PG8_BAR; PG8_WAIT_L(0); PG8_MMA(1, 0, At, B0); PG8_BAR; PG8_SCHED;
            PG8_STAGE(PG8_SB(1, 1), b3 + hstep, voffB);
            PG8_WAIT_V(6); PG8_BAR; PG8_MMA(1, 1, At, B1); PG8_BAR;
            }
        }
        if constexpr (ALIGN_EPI) { if (wr == 0) PG8_BAR; }
        if constexpr (!Epi::AFTER_DRAIN) { E(acc, cur, wr, wc, fr, fq); S.done(cur); }
        if (!has_next) break;
#pragma unroll
        for (int a = 0; a < 2; ++a)
#pragma unroll
            for (int b = 0; b < 2; ++b)
#pragma unroll
                for (int m = 0; m < 4; ++m)
#pragma unroll
                    for (int n = 0; n < 2; ++n) acc[a][b][m][n] = (f32x4){0.f, 0.f, 0.f, 0.f};
        cur = nxt; cA = nA; cB = nB; ++ui;
        if constexpr (ALIGN_EPI) { if (wr == 1) PG8_BAR; }
    }
    PG8_WAIT_V(0);
    if constexpr (!ALIGN_EPI) { if (wr == 0) PG8_BAR; }
    PG8_BAR;
    if constexpr (Epi::AFTER_DRAIN) { E.fused(acc, cur, wr, wc, fr, fq, lds, wid, lane); S.done(cur); }
#undef PG8_SA
#undef PG8_SB
#undef PG8_STAGE
#undef PG8_LDA
#undef PG8_LDB
#undef PG8_MMA
#undef PG8_WAIT_V
#undef PG8_WAIT_L
#undef PG8_BAR
#undef PG8_SCHED
}
}
#define GAS __attribute__((address_space(1)))
#define LAS __attribute__((address_space(3)))
typedef unsigned short bf16;
typedef unsigned v4u __attribute__((ext_vector_type(4)));
typedef float f32x4 __attribute__((ext_vector_type(4)));
typedef short bf16x8 __attribute__((ext_vector_type(8)));
typedef GAS unsigned gu32;
typedef GAS unsigned long long gu64;
#define RLX_AGENT __ATOMIC_RELAXED, __HIP_MEMORY_SCOPE_AGENT
#define LDS_WAIT() asm volatile("s_waitcnt lgkmcnt(0)" ::: "memory")
#define VM_WAIT() asm volatile("s_waitcnt vmcnt(0)" ::: "memory")
__device__ __forceinline__ unsigned long long rt() { return __builtin_amdgcn_s_memrealtime(); }
__device__ __forceinline__ unsigned f2bf(float f) { unsigned u = __builtin_bit_cast(unsigned, f); return (u + 0x7fffu + ((u >> 16) & 1u)) >> 16; }
__device__ __forceinline__ unsigned pk2(float lo, float hi) { return f2bf(lo) | (f2bf(hi) << 16); }

#define XB_TMO      128
#define XB_XCNT(j)  (256  + 64 * (j))
#define XB_XSUB(j)  (1280 + 64 * (j))
#define XB_XGEN(j)  (2304 + 64 * (j))
#define XB_TOP      3328
#define XB_TOPGEN   3392
#define XCD_BAR_WORDS 3456
#define XB_SPIN_CAP (1u << 18)

__device__ __forceinline__ unsigned xb_ld(unsigned* p)              { return __hip_atomic_load(p, __ATOMIC_RELAXED, __HIP_MEMORY_SCOPE_AGENT); }
__device__ __forceinline__ unsigned xb_add(unsigned* p, unsigned v) { return __hip_atomic_fetch_add(p, v, __ATOMIC_RELAXED, __HIP_MEMORY_SCOPE_AGENT); }
__device__ __forceinline__ unsigned xb_xcc_id() { return (unsigned)__builtin_amdgcn_s_getreg((3 << 11) | 20) & 0xFu; }
#define XB_SPIN(cond, bar) do { unsigned _sp = 0; while (cond) { __builtin_amdgcn_s_sleep(1); \
    if ((++_sp & 255u) == 0u) { if (xb_ld(&(bar)[XB_TMO])) break; if (_sp > XB_SPIN_CAP) { atomicAdd(&(bar)[XB_TMO], 1u); break; } } } } while (0)

struct XcdBarrier {
    unsigned* bar; unsigned x;
    volatile LAS unsigned* st;
};

__device__ __forceinline__ XcdBarrier xcd_barrier_post(unsigned* bar, volatile LAS unsigned* st) {
    XcdBarrier b; b.bar = bar; b.x = xb_xcc_id(); b.st = st;
    if (threadIdx.x == 0) (void)xb_add(&bar[XB_XCNT(b.x)], 1u);
    return b;
}
__device__ __forceinline__ void xcd_barrier_complete(unsigned* bar, unsigned x, unsigned& nloc, unsigned& nx) {
    const unsigned G = gridDim.x * gridDim.y * gridDim.z;
    unsigned sum, cnt, mine, sp = 0u;
    for (;;) {
        sum = 0u; cnt = 0u; mine = 0u;
#pragma unroll
        for (unsigned j = 0; j < 16; ++j) { const unsigned c = xb_ld(&bar[XB_XCNT(j)]); sum += c; cnt += (c > 0u) ? 1u : 0u; mine = (j == x) ? c : mine; }
        if (sum == G) break;
        __builtin_amdgcn_s_sleep(1);
        if ((++sp & 255u) == 0u) { if (xb_ld(&bar[XB_TMO])) break; if (sp > XB_SPIN_CAP) { atomicAdd(&bar[XB_TMO], 1u); break; } }
    }
    nloc = mine > 0u ? mine : 1u; nx = cnt > 0u ? cnt : 1u;
}

__device__ __forceinline__ void xcd_barrier(const XcdBarrier& b) {
    asm volatile("s_waitcnt vmcnt(0)" ::: "memory");
    __syncthreads();
    if (threadIdx.x == 0) {
        unsigned* bar = b.bar;
        __builtin_amdgcn_s_waitcnt(0);
        unsigned nloc = b.st[0], nx = b.st[1];
        if (nloc == 0u) { xcd_barrier_complete(bar, b.x, nloc, nx); b.st[0] = nloc; b.st[1] = nx; }
        const unsigned old = xb_add(&bar[XB_XSUB(b.x)], 1u);
        const unsigned gen = old / nloc;
        if (old + 1u == (gen + 1u) * nloc) {
            __builtin_amdgcn_fence(__ATOMIC_RELEASE, "agent");
            asm volatile("s_waitcnt vmcnt(0)" ::: "memory");
            const unsigned og = xb_add(&bar[XB_TOP], 1u);
            const unsigned tg = og / nx;
            if (og + 1u == (tg + 1u) * nx) xb_add(&bar[XB_TOPGEN], 1u);
            else XB_SPIN(xb_ld(&bar[XB_TOPGEN]) == tg, bar);
            __builtin_amdgcn_fence(__ATOMIC_ACQUIRE, "agent");
            xb_add(&bar[XB_XGEN(b.x)], 1u);
            asm volatile("s_waitcnt vmcnt(0)" ::: "memory");
        } else {
            XB_SPIN(xb_ld(&bar[XB_XGEN(b.x)]) == gen, bar);
            __builtin_amdgcn_fence(__ATOMIC_ACQUIRE, "agent");
            asm volatile("s_waitcnt vmcnt(0)" ::: "memory");
        }
    }
    __syncthreads();
}


#ifndef STAGE
#define STAGE 3
#endif
#ifndef N_LAUNCH_MODE
#define N_LAUNCH_MODE 1
#endif
#ifndef REP_TK
#define REP_TK 1
#endif
#ifndef REP_AT
#define REP_AT 1
#endif
#ifndef REP_PH
#define REP_PH -1
#endif
#ifndef TK_PREFETCH
#define TK_PREFETCH 1
#endif
#ifndef DBG_C
#define DBG_C 0.0f
#endif

typedef float f32x16 __attribute__((ext_vector_type(16)));
typedef __attribute__((ext_vector_type(2))) __bf16 bf16x2_t;
using pg8::bf16_t; using pg8::Unit;

constexpr int M = 16384, DM = 1024, NHEAD = 8, HD = 64, AW = 512, PW = 512, FF = 2816, FF2 = 5632, NIN = 4420, NINP = 4608, NMOD = 6144;
constexpr float EPS = 1e-6f;
constexpr int NWAVES = 8, NTHR = 512;

constexpr size_t MiB = 1u << 20;
constexpr size_t WS_CTL = 0, CTL_ZERO_BYTES = 64 * 1024;
constexpr size_t WS_WIN = 1 * MiB, WS_WATTN = 10 * MiB, WS_WGRP = 11 * MiB, WS_WPOOL = 11 * MiB + 512 * 1024, WS_WOUT = 12 * MiB + 512 * 1024,
                 WS_WUP = 14 * MiB + 512 * 1024, WS_WDOWN = 25 * MiB + 512 * 1024;
constexpr size_t WS_MODP = 31 * MiB, WS_MODF = 31 * MiB + 393216, WS_WI = 31 * MiB + 512 * 1024;
constexpr size_t WS_H = 32 * MiB;
constexpr size_t WS_Q = 64 * MiB, WS_K = 80 * MiB, WS_V = 96 * MiB;
constexpr size_t WS_SEL = 88 * MiB;
constexpr size_t WS_QI = 112 * MiB, WS_KI = 120 * MiB;
constexpr size_t WS_UPOOL = 128 * MiB, WS_POOLED = 144 * MiB, WS_POOLMIX = 160 * MiB, WS_ATTN = 176 * MiB;
constexpr size_t WS_GA = 192 * MiB, WS_GP = 224 * MiB;
constexpr size_t WS_ACT = 64 * MiB;
constexpr size_t WS_RAW = 152 * MiB;
constexpr size_t WS_END = 256 * MiB;
constexpr int CW_BAR = 1024, CW_QUEUE = 512;

constexpr int LDS_BYTES = 163840;
constexpr int HSTRIDE = 1025, MSTRIDE = 513;
constexpr int LIST_OFF = 135168, ST_OFF = 151552, MISC_OFF = 159744;

#define SYNC() __syncthreads()
__device__ __forceinline__ float wave_sum(float v) {
#pragma unroll
    for (int o = 1; o < 64; o <<= 1) v += __shfl_xor(v, o);
    return v;
}
__device__ __forceinline__ float bf_lo(unsigned w) { return __builtin_bit_cast(float, w << 16); }
__device__ __forceinline__ float bf_hi(unsigned w) { return __builtin_bit_cast(float, w & 0xffff0000u); }
__device__ __forceinline__ float sigmoidf_(float x) { return __builtin_amdgcn_rcpf(1.0f + __expf(-x)); }
__device__ __forceinline__ unsigned pkbf(float lo, float hi) { return pg8::cvt_pk_bf16(lo, hi); }
typedef unsigned u32x2 __attribute__((ext_vector_type(2)));
__device__ __forceinline__ u32x2 pk4(f32x4 v) { u32x2 r; r.x = pkbf(v[0], v[1]); r.y = pkbf(v[2], v[3]); return r; }
__device__ __forceinline__ unsigned pk4_fp8(f32x4 v) { int w = 0; w = __builtin_amdgcn_cvt_pk_fp8_f32(v[0], v[1], w, false); w = __builtin_amdgcn_cvt_pk_fp8_f32(v[2], v[3], w, true); return (unsigned)w; }

__device__ __forceinline__ void tr_item(const float* W, int ldw, int src_col, int nvalid, int k0, bf16_t* WT, int K, int dst_row, LAS float* scr, int lane) {
    f32x4 v[8];
#pragma unroll
    for (int i = 0; i < 8; ++i) { const int kk = 8 * i + (lane >> 3), n4 = 4 * (lane & 7);
        v[i] = (f32x4){0.f, 0.f, 0.f, 0.f}; if (W != nullptr && n4 < nvalid) v[i] = *(const f32x4*)(W + (size_t)(k0 + kk) * ldw + src_col + n4); }
#pragma unroll
    for (int i = 0; i < 8; ++i) { const int kk = 8 * i + (lane >> 3), n4 = 4 * (lane & 7); LAS float* p = scr + kk * 33 + n4; p[0] = v[i][0]; p[1] = v[i][1]; p[2] = v[i][2]; p[3] = v[i][3]; }
    LDS_WAIT(); asm volatile("" ::: "memory");
    const int c = lane & 7;
#pragma unroll
    for (int j = 0; j < 4; ++j) { const int n = (lane >> 3) + 8 * j; const LAS float* s = scr + (8 * c) * 33 + n;
        v4u o; o.x = pk2(s[0 * 33], s[1 * 33]); o.y = pk2(s[2 * 33], s[3 * 33]); o.z = pk2(s[4 * 33], s[5 * 33]); o.w = pk2(s[6 * 33], s[7 * 33]);
        *(GAS v4u*)(WT + (size_t)(dst_row + n) * K + k0 + 8 * c) = o; }
    LDS_WAIT(); asm volatile("" ::: "memory");
}

struct P0Ptrs { const float *c, *w_ada, *w_in, *w_attn, *w_grp, *w_pool, *w_out, *w_up, *w_down, *pscale; bf16_t *WIN, *WATTN, *WGRP, *WPOOL, *WOUT, *WUP, *WDOWN; float* MODP; };
__device__ __forceinline__ void p0_prologue(const P0Ptrs& P, LAS unsigned char* lds, int gw, int NGW, int wave, int lane) {
    LAS float* scr = (LAS float*)(lds + wave * 16384);
    LAS float* sil = (LAS float*)(lds + 131072);
    for (int i = threadIdx.x; i < 1024; i += NTHR) { const float cv = P.c[i]; sil[i] = cv / (1.0f + __expf(-cv)); }
    SYNC();
    constexpr int I_WIN = 144 * 16, I_WATTN = 32 * 8, I_WGRP = 128, I_WPOOL = 32 * 8, I_WOUT = 32 * 16, I_WUP = 176 * 16, I_WDOWN = 32 * 44, I_MOD = 96 * 16;
    constexpr int NITEMS = I_WIN + I_WATTN + I_WGRP + I_WPOOL + I_WOUT + I_WUP + I_WDOWN + I_MOD;
    for (int it = gw; it < NITEMS; it += NGW) {
        int r = it;
        if (r < I_MOD) {
            const int cb = r % 96, kc = r / 96, col = cb * 64 + lane; float acc = 0.f;
#pragma unroll 8
            for (int i = 0; i < 64; ++i) { const int k = kc * 64 + i; acc = fmaf(sil[k], P.w_ada[(size_t)k * NMOD + col], acc); }
            P.MODP[kc * NMOD + col] = acc; continue; }
        r -= I_MOD;
        if (r < I_WIN) { const int g = r / 16, kb = r % 16, tile = g >> 3, gi = g & 7; int src = -1, nv = 32;
            const int permgi = gi < 4 ? 64 * gi : 64 * (gi - 4) + 32;
            if (tile < 2) src = tile * 256 + permgi;
            else if (tile < 4) src = 512 + (tile - 2) * 256 + permgi;
            else if (tile < 6) src = 1024 + (tile - 4) * 256 + 32 * gi;
            else if (tile == 6) src = 1536 + 32 * gi;
            else if (tile == 7) { if (gi < 2) src = 1792 + 32 * gi; else if (gi == 2) { src = 1856; nv = 4; } }
            else if (tile < 10) src = 1860 + (tile - 8) * 256 + 32 * gi;
            else if (tile < 14) src = 2372 + (tile - 10) * 256 + 32 * gi;
            else src = 3396 + (tile - 14) * 256 + 32 * gi;
            tr_item(src >= 0 ? P.w_in : nullptr, NIN, src >= 0 ? src : 0, nv, kb * 64, P.WIN, 1024, g * 32, scr, lane); continue; }
        r -= I_WIN;
        if (r < I_WATTN) { tr_item(P.w_attn, 1024, (r / 8) * 32, 32, (r % 8) * 64, P.WATTN, 512, (r / 8) * 32, scr, lane); continue; }
        r -= I_WATTN;
        if (r < I_WGRP) {
            const int row = 4 * r + (lane >> 4), g = row >> 7; const float* src = P.w_grp + (size_t)g * 16384 + (size_t)(row & 127) * 128;
#pragma unroll
            for (int q = 0; q < 4; ++q) { const int d0 = 32 * (lane & 15) + 8 * q; v4u o = (v4u){0u, 0u, 0u, 0u};
                if ((d0 >> 7) == g) { const f32x4 a = *(const f32x4*)(src + (d0 & 127)) * *(const f32x4*)(P.pscale + d0), b = *(const f32x4*)(src + (d0 & 127) + 4) * *(const f32x4*)(P.pscale + d0 + 4);
                    o.x = pk2(a[0], a[1]); o.y = pk2(a[2], a[3]); o.z = pk2(b[0], b[1]); o.w = pk2(b[2], b[3]); }
                *(GAS v4u*)(P.WGRP + (size_t)row * 512 + d0) = o; }
            continue; }
        r -= I_WGRP;
        if (r < I_WPOOL) { tr_item(P.w_pool, 1024, (r / 8) * 32, 32, (r % 8) * 64, P.WPOOL, 512, (r / 8) * 32, scr, lane); continue; }
        r -= I_WPOOL;
        if (r < I_WOUT) { tr_item(P.w_out, 1024, (r / 16) * 32, 32, (r % 16) * 64, P.WOUT, 1024, (r / 16) * 32, scr, lane); continue; }
        r -= I_WOUT;
        if (r < I_WUP) { const int g = r / 16, kb = r % 16, tile = g >> 3, gi = g & 7;
            const int src = gi < 4 ? 128 * tile + 32 * gi : FF + 128 * tile + 32 * (gi - 4);
            tr_item(P.w_up, FF2, src, 32, kb * 64, P.WUP, 1024, g * 32, scr, lane); continue; }
        r -= I_WUP;
        { tr_item(P.w_down, 1024, (r / 44) * 32, 32, (r % 44) * 64, P.WDOWN, FF, (r / 44) * 32, scr, lane); }
    }
}

__device__ __forceinline__ void modulate_rows(const float* X, bf16_t* O, const LAS float* mulv, const LAS float* addv, int gw, int NGW, int lane) {
    f32x4 mu[4], ad[4];
#pragma unroll
    for (int j = 0; j < 4; ++j) { mu[j] = *(const LAS f32x4*)(mulv + 4 * lane + 256 * j); ad[j] = *(const LAS f32x4*)(addv + 4 * lane + 256 * j); }
    for (int row = gw; row < M; row += NGW) {
        const GAS f32x4* xr = (const GAS f32x4*)(X + (size_t)row * DM) + lane;
        f32x4 v[4]; float s = 0.f;
#pragma unroll
        for (int j = 0; j < 4; ++j) { v[j] = xr[64 * j]; s += (v[j].x * v[j].x + v[j].y * v[j].y) + (v[j].z * v[j].z + v[j].w * v[j].w); }
        const float rstd = 1.0f / sqrtf(wave_sum(s) * (1.0f / DM) + EPS);
        GAS u32x2* o8 = (GAS u32x2*)(O + (size_t)row * DM) + lane;
#pragma unroll
        for (int j = 0; j < 4; ++j) { const f32x4 y = v[j] * rstd * mu[j] + ad[j]; o8[64 * j] = pk4(y); }
    }
}

struct EpiProj {
    static constexpr bool PERM = false, AFTER_DRAIN = false;
    bf16_t *Q; unsigned char *K8, *V8; bf16_t *QI, *KI, *UPOOL, *GA, *GP; float* WI; const float *qg, *kg;
    __device__ __forceinline__ void operator()(const pg8::f32x4 (&acc)[2][2][4][2], const Unit& u, int wr, int wc, int fr, int fq) const {
        const int pn = u.pn, row0 = u.pm * 256 + wr * 64 + fr;
        if (pn < 4) {
            const bool isq = pn < 2; const float* g = isq ? qg : kg; const int head = (pn & 1) * 4 + wc;
            f32x4 gv[2][2];
#pragma unroll
            for (int bj = 0; bj < 2; ++bj)
#pragma unroll
                for (int n = 0; n < 2; ++n) gv[bj][n] = *(const f32x4*)(g + 32 * bj + 16 * n + 4 * fq);
#pragma unroll
            for (int ai = 0; ai < 2; ++ai)
#pragma unroll
                for (int m = 0; m < 4; ++m) {
                    float ss = 0.f;
#pragma unroll
                    for (int bj = 0; bj < 2; ++bj)
#pragma unroll
                        for (int n = 0; n < 2; ++n) { const f32x4 x = acc[ai][bj][m][n]; ss += (x[0] * x[0] + x[1] * x[1]) + (x[2] * x[2] + x[3] * x[3]); }
                    ss += __shfl_xor(ss, 16); ss += __shfl_xor(ss, 32);
                    const float rstd = 1.0f / sqrtf(ss * (1.0f / 64.0f) + EPS);
                    const size_t ro = (size_t)(row0 + ai * 128 + m * 16) * AW + head * 64 + 4 * fq;
#pragma unroll
                    for (int bj = 0; bj < 2; ++bj)
#pragma unroll
                        for (int n = 0; n < 2; ++n) { const f32x4 y = acc[ai][bj][m][n] * rstd * gv[bj][n];
                            if (isq) *(u32x2*)(Q + ro + 32 * bj + 16 * n) = pk4(y); else *(unsigned*)(K8 + ((size_t)head * M + (row0 + ai * 128 + m * 16)) * 128 + 4 * fq + 32 * bj + 16 * n) = pk4_fp8(y); }
                }
            return;
        }
        const int colw = wc * 32 + 4 * fq;
        if (pn == 7) {
#pragma unroll
            for (int ai = 0; ai < 2; ++ai)
#pragma unroll
                for (int m = 0; m < 4; ++m) { const int row = row0 + ai * 128 + m * 16;
                    if (wc < 2) {
#pragma unroll
                        for (int n = 0; n < 2; ++n) { const int c = colw + 16 * n; *(u32x2*)(KI + (size_t)(row >> 5) * 2048 + (c >> 4) * 512 + ((((c >> 3) & 1) * 32 + (row & 31)) * 8) + (c & 7)) = pk4(acc[ai][0][m][n]); }
                    } else if (wc == 2 && fq == 0) { *(f32x4*)(WI + (size_t)row * 4) = acc[ai][0][m][0] * 0.5f; }
                }
            return;
        }
        if (pn < 6) {
#pragma unroll
            for (int ai = 0; ai < 2; ++ai)
#pragma unroll
                for (int m = 0; m < 4; ++m) { const int row = row0 + ai * 128 + m * 16;
#pragma unroll
                    for (int bj = 0; bj < 2; ++bj)
#pragma unroll
                        for (int n = 0; n < 2; ++n) { const int col = (pn - 4) * 256 + colw + 128 * bj + 16 * n;
                            *(unsigned*)(V8 + ((size_t)(col >> 6) * M + row) * 128 + 64 + (col & 63)) = pk4_fp8(acc[ai][bj][m][n]); } }
            return;
        }
        bf16_t* O; int ldo, ct; float sc = 1.0f; bool sig = false;
        if (pn == 6) { O = QI; ldo = 256; ct = 0; sc = 0.125f; }
        else if (pn < 10) { O = UPOOL; ldo = PW; ct = (pn - 8) * 256; }
        else if (pn < 14) { O = GA; ldo = DM; ct = (pn - 10) * 256; sig = true; }
        else { O = GP; ldo = DM; ct = (pn - 14) * 256; sig = true; }
#pragma unroll
        for (int ai = 0; ai < 2; ++ai)
#pragma unroll
            for (int m = 0; m < 4; ++m) { bf16_t* rowp = O + (size_t)(row0 + ai * 128 + m * 16) * ldo + ct + colw;
#pragma unroll
                for (int bj = 0; bj < 2; ++bj)
#pragma unroll
                    for (int n = 0; n < 2; ++n) { f32x4 y = acc[ai][bj][m][n] * sc;
                        if (sig) { y[0] = sigmoidf_(y[0]); y[1] = sigmoidf_(y[1]); y[2] = sigmoidf_(y[2]); y[3] = sigmoidf_(y[3]); }
                        *(u32x2*)(rowp + 128 * bj + 16 * n) = pk4(y); }
            }
    }
};

template <int MODE> struct EpiBf {
    static constexpr bool PERM = false, AFTER_DRAIN = false;
    bf16_t* O; int ldo; const float* colscale; const bf16_t* ADD;
    __device__ __forceinline__ void operator()(const pg8::f32x4 (&acc)[2][2][4][2], const Unit& u, int wr, int wc, int fr, int fq) const {
        const int row0 = u.pm * 256 + wr * 64 + fr, col0 = u.pn * 256 + wc * 32 + 4 * fq;
#pragma unroll
        for (int ai = 0; ai < 2; ++ai)
#pragma unroll
            for (int m = 0; m < 4; ++m) { const size_t ro = (size_t)(row0 + ai * 128 + m * 16) * ldo + col0;
#pragma unroll
                for (int bj = 0; bj < 2; ++bj)
#pragma unroll
                    for (int n = 0; n < 2; ++n) { f32x4 y = acc[ai][bj][m][n]; const size_t off = ro + 128 * bj + 16 * n;
                        if (MODE == 3) { }
                        else if (MODE == 0) { y = y * *(const f32x4*)(colscale + col0 + 128 * bj + 16 * n); }
                        else { const u32x2 gq = *(const u32x2*)(O + off); y[0] *= bf_lo(gq.x); y[1] *= bf_hi(gq.x); y[2] *= bf_lo(gq.y); y[3] *= bf_hi(gq.y);
                            if (MODE == 2) { const u32x2 a = *(const u32x2*)(ADD + off); y[0] += bf_lo(a.x); y[1] += bf_hi(a.x); y[2] += bf_lo(a.y); y[3] += bf_hi(a.y); } }
                        *(u32x2*)(O + off) = pk4(y); }
            }
    }
};

struct EpiRes {
    static constexpr bool PERM = false, AFTER_DRAIN = false;
    const float* BASE; float* OUT; const float* gate; float dbg;
    __device__ __forceinline__ void operator()(const pg8::f32x4 (&acc)[2][2][4][2], const Unit& u, int wr, int wc, int fr, int fq) const {
        const int row0 = u.pm * 256 + wr * 64 + fr, col0 = u.pn * 256 + wc * 32 + 4 * fq;
        f32x4 gv[2][2];
#pragma unroll
        for (int bj = 0; bj < 2; ++bj)
#pragma unroll
            for (int n = 0; n < 2; ++n) gv[bj][n] = *(const f32x4*)(gate + col0 + 128 * bj + 16 * n);
#pragma unroll
        for (int ai = 0; ai < 2; ++ai)
#pragma unroll
            for (int m = 0; m < 4; ++m) { const int row = row0 + ai * 128 + m * 16; const size_t ro = (size_t)row * DM + col0;
#pragma unroll
                for (int bj = 0; bj < 2; ++bj)
#pragma unroll
                    for (int n = 0; n < 2; ++n) { const size_t off = ro + 128 * bj + 16 * n; f32x4 y = *(const f32x4*)(BASE + off) + gv[bj][n] * acc[ai][bj][m][n];
                        if (dbg != 0.f) { const float sg = ((row * 7 + (int)(off >> 2)) & 1) ? dbg : -dbg; y[0] += sg; y[1] -= sg; y[2] += sg; y[3] -= sg; }
                        *(f32x4*)(OUT + off) = y; }
            }
    }
};

template <int CTRL> __device__ __forceinline__ float dppf(float x) { return __builtin_bit_cast(float, __builtin_amdgcn_update_dpp(0, __builtin_bit_cast(int, x), CTRL, 0xf, 0xf, false)); }
__device__ __forceinline__ f32x4 ror1(f32x4 v) { f32x4 r; r[0] = dppf<0x121>(v[0]); r[1] = dppf<0x121>(v[1]); r[2] = dppf<0x121>(v[2]); r[3] = dppf<0x121>(v[3]); return r; }
__device__ __forceinline__ f32x4 ror2(f32x4 v) { f32x4 r; r[0] = dppf<0x122>(v[0]); r[1] = dppf<0x122>(v[1]); r[2] = dppf<0x122>(v[2]); r[3] = dppf<0x122>(v[3]); return r; }
__device__ __forceinline__ f32x4 silu_mul(f32x4 a, f32x4 b) { f32x4 r;
#pragma unroll
    for (int e = 0; e < 4; ++e) r[e] = a[e] * __builtin_amdgcn_rcpf(1.0f + __expf(-a[e])) * b[e];
    return r; }
struct EpiUpAct {
    static constexpr bool PERM = false, AFTER_DRAIN = false;
    bf16_t* ACT; float* RAW; const float* cw; const float* cb;
    __device__ __forceinline__ void operator()(const pg8::f32x4 (&acc)[2][2][4][2], const Unit& u, int wr, int wc, int fr, int fq) const {
#pragma unroll
        for (int n = 0; n < 2; ++n) {
            const int ch = u.pn * 128 + wc * 32 + 4 * fq + 16 * n;
            const f32x4 w0a = *(const f32x4*)(cw + ch), w1a = *(const f32x4*)(cw + FF2 + ch), w2a = *(const f32x4*)(cw + 2 * FF2 + ch), ba = *(const f32x4*)(cb + ch);
            const f32x4 w0b = *(const f32x4*)(cw + FF + ch), w1b = *(const f32x4*)(cw + FF2 + FF + ch), w2b = *(const f32x4*)(cw + 2 * FF2 + FF + ch), bb = *(const f32x4*)(cb + FF + ch);
#pragma unroll
            for (int ai = 0; ai < 2; ++ai) {
                const int blk = u.pm * 4 + ai * 2 + wr;
                if (fr < 2) { *(f32x4*)(RAW + (size_t)(blk * 4 + fr) * FF2 + ch) = acc[ai][0][0][n]; *(f32x4*)(RAW + (size_t)(blk * 4 + fr) * FF2 + FF + ch) = acc[ai][1][0][n]; }
                if (fr >= 14) { *(f32x4*)(RAW + (size_t)(blk * 4 + fr - 12) * FF2 + ch) = acc[ai][0][3][n]; *(f32x4*)(RAW + (size_t)(blk * 4 + fr - 12) * FF2 + FF + ch) = acc[ai][1][3][n]; }
                f32x4 pa1 = {0.f, 0.f, 0.f, 0.f}, pa2 = pa1, pb1 = pa1, pb2 = pa1;
#pragma unroll
                for (int m = 0; m < 4; ++m) {
                    const f32x4 va = acc[ai][0][m][n], vb = acc[ai][1][m][n];
                    const f32x4 ra1 = ror1(va), ra2 = ror2(va), rb1 = ror1(vb), rb2 = ror2(vb);
                    const f32x4 xa1 = fr >= 1 ? ra1 : pa1, xa2 = fr >= 2 ? ra2 : pa2, xb1 = fr >= 1 ? rb1 : pb1, xb2 = fr >= 2 ? rb2 : pb2;
                    pa1 = ra1; pa2 = ra2; pb1 = rb1; pb2 = rb2;
                    const f32x4 ya = ba + w0a * xa2 + w1a * xa1 + w2a * va, yb = bb + w0b * xb2 + w1b * xb1 + w2b * vb;
                    const f32x4 o = silu_mul(ya, yb);
                    if (!(m == 0 && fr < 2)) *(u32x2*)(ACT + (size_t)(blk * 64 + 16 * m + fr) * FF + ch) = pk4(o);
                }
            }
        }
    }
};

__device__ __forceinline__ void fixup_phase(const float* RAW, bf16_t* ACT, const float* cw, const float* cb, int gtid, int nthr) {
    for (int it = gtid; it < 256 * 2 * 704; it += nthr) {
        const int c4 = it % 704, rr = (it / 704) & 1, blk = it / 1408, ch = 4 * c4;
        const float* cur = RAW + (size_t)(blk * 4 + rr) * FF2;
        const float* p1 = rr == 1 ? RAW + (size_t)(blk * 4) * FF2 : (blk > 0 ? RAW + (size_t)((blk - 1) * 4 + 3) * FF2 : nullptr);
        const float* p2 = rr == 1 ? (blk > 0 ? RAW + (size_t)((blk - 1) * 4 + 3) * FF2 : nullptr) : (blk > 0 ? RAW + (size_t)((blk - 1) * 4 + 2) * FF2 : nullptr);
        const f32x4 z = {0.f, 0.f, 0.f, 0.f};
        const f32x4 va = *(const f32x4*)(cur + ch), vb = *(const f32x4*)(cur + FF + ch);
        const f32x4 a1 = p1 ? *(const f32x4*)(p1 + ch) : z, b1 = p1 ? *(const f32x4*)(p1 + FF + ch) : z;
        const f32x4 a2 = p2 ? *(const f32x4*)(p2 + ch) : z, b2 = p2 ? *(const f32x4*)(p2 + FF + ch) : z;
        const f32x4 ya = *(const f32x4*)(cb + ch) + *(const f32x4*)(cw + ch) * a2 + *(const f32x4*)(cw + FF2 + ch) * a1 + *(const f32x4*)(cw + 2 * FF2 + ch) * va;
        const f32x4 yb = *(const f32x4*)(cb + FF + ch) + *(const f32x4*)(cw + FF + ch) * b2 + *(const f32x4*)(cw + FF2 + FF + ch) * b1 + *(const f32x4*)(cw + 2 * FF2 + FF + ch) * vb;
        *(u32x2*)(ACT + (size_t)(blk * 64 + rr) * FF + ch) = pk4(silu_mul(ya, yb));
    }
}

template <int W> __device__ __forceinline__ void pooled_item(const bf16_t* UPOOL, bf16_t* POOLED, int t, int c8) {
    v4u v[W];
#pragma unroll
    for (int j = 0; j < W; ++j) { const int tj = (t - j) >= 0 ? (t - j) : 0; v[j] = *(const v4u*)(UPOOL + (size_t)tj * PW + 8 * c8); }
    float s[8];
#pragma unroll
    for (int e = 0; e < 8; ++e) s[e] = 0.f;
#pragma unroll
    for (int j = 0; j < W; ++j) { const float m = (t - j) >= 0 ? 1.f : 0.f;
        s[0] = fmaf(m, bf_lo(v[j].x), s[0]); s[1] = fmaf(m, bf_hi(v[j].x), s[1]); s[2] = fmaf(m, bf_lo(v[j].y), s[2]); s[3] = fmaf(m, bf_hi(v[j].y), s[3]);
        s[4] = fmaf(m, bf_lo(v[j].z), s[4]); s[5] = fmaf(m, bf_hi(v[j].z), s[5]); s[6] = fmaf(m, bf_lo(v[j].w), s[6]); s[7] = fmaf(m, bf_hi(v[j].w), s[7]); }
    const int cntw = (t + 1) < W ? (t + 1) : W; const float inv = 1.0f / (float)cntw; v4u o;
    o.x = pkbf(s[0] * inv - bf_lo(v[0].x), s[1] * inv - bf_hi(v[0].x)); o.y = pkbf(s[2] * inv - bf_lo(v[0].y), s[3] * inv - bf_hi(v[0].y));
    o.z = pkbf(s[4] * inv - bf_lo(v[0].z), s[5] * inv - bf_hi(v[0].z)); o.w = pkbf(s[6] * inv - bf_lo(v[0].w), s[7] * inv - bf_hi(v[0].w));
    *(v4u*)(POOLED + (size_t)t * PW + 8 * c8) = o;
}
__device__ __forceinline__ void pooled_phase(const bf16_t* UPOOL, bf16_t* POOLED, int gtid, int nthr) {
    for (int it = gtid; it < M * 64; it += nthr) {
        const int wv = it >> 6, l = it & 63, g = wv & 3, t = (wv >> 2) * 4 + (l >> 4), c8 = g * 16 + (l & 15);
        if (g == 0) pooled_item<2>(UPOOL, POOLED, t, c8); else if (g == 1) pooled_item<4>(UPOOL, POOLED, t, c8); else if (g == 2) pooled_item<8>(UPOOL, POOLED, t, c8); else pooled_item<16>(UPOOL, POOLED, t, c8);
    }
}

#define MFMA32(a, b, c) __builtin_amdgcn_mfma_f32_32x32x16_bf16((a), (b), (c), 0, 0, 0)
__device__ __forceinline__ unsigned lds_add(LAS unsigned* p, unsigned v) { return __hip_atomic_fetch_add(p, v, __ATOMIC_RELAXED, __HIP_MEMORY_SCOPE_WORKGROUP); }
__device__ __forceinline__ unsigned lds_or(LAS unsigned* p, unsigned v) { return __hip_atomic_fetch_or(p, v, __ATOMIC_RELAXED, __HIP_MEMORY_SCOPE_WORKGROUP); }

__device__ __forceinline__ float u2f(unsigned u) { return __uint_as_float((u & 0x80000000u) ? (u & 0x7fffffffu) : ~u); }
template <bool EMIT>
__device__ __forceinline__ void tk_pass(int qb, int wave, int lane, const bf16_t* KI, const LAS bf16_t* QF, const float (&wv)[4], LAS unsigned* H, LAS unsigned* SELM, LAS unsigned* TIEM,
                                        int sh, unsigned vlo, bool clampTop, unsigned bmax, int stage, unsigned vmin, float fsel, float ftie, unsigned vmax = 0xffffffffu) {
    const int r = lane & 31, h = lane >> 5;
    const int gstep = stage == 1 ? 8 : 1, g0 = stage == 1 ? wave : 0;
#define TK_NEXT_G(g) ({ int _g = (g) + gstep; if (stage == 2 && (_g & 7) == wave) ++_g; _g; })
    int gcur = g0; if (stage == 2 && (gcur & 7) == wave) ++gcur;
    pg8::bf16x8 kf[4];
    { const int T0 = (wave + 8 * gcur) <= qb ? (wave + 8 * gcur) : qb; const bf16_t* kp = KI + (size_t)T0 * 2048 + 8 * lane;
#pragma unroll
      for (int s = 0; s < 4; ++s) kf[s] = *(const pg8::bf16x8*)(kp + 512 * s); }
    LAS unsigned* Hq = H + r * HSTRIDE;
#pragma unroll 1
    for (; wave + 8 * gcur <= qb; gcur = TK_NEXT_G(gcur)) {
        const int T = wave + 8 * gcur;
        float sc[16];
#pragma unroll
        for (int i = 0; i < 16; ++i) sc[i] = 0.f;
#pragma unroll
        for (int hd = 0; hd < 4; ++hd) { f32x16 a;
#pragma unroll
            for (int i = 0; i < 16; ++i) a[i] = 0.f;
#pragma unroll
            for (int s = 0; s < 4; ++s) a = MFMA32(kf[s], *(const LAS pg8::bf16x8*)(QF + (hd * 4 + s) * 512 + lane * 8), a);
#pragma unroll
            for (int i = 0; i < 16; ++i) { const float av = a[i]; const int ab = __float_as_int(av); sc[i] = fmaf(wv[hd], __int_as_float(ab > 0 ? ab : 0), sc[i]); } }
        { const int Tnn = wave + 8 * TK_NEXT_G(gcur); const int Tn = Tnn <= qb ? Tnn : T; const bf16_t* kp = KI + (size_t)Tn * 2048 + 8 * lane;
#pragma unroll
          for (int s = 0; s < 4; ++s) kf[s] = *(const pg8::bf16x8*)(kp + 512 * s); }
        const int rlim = (T == qb) ? r : 64;
        if (!EMIT) {
#pragma unroll
            for (int i = 0; i < 16; ++i) {
                const int kr = (i & 3) + 8 * (i >> 2) + 4 * h;
                unsigned uu = __float_as_uint(sc[i]); uu ^= ((unsigned)((int)uu >> 31)) | 0x80000000u;
                const unsigned v = uu >> sh; unsigned b = v - vlo;
                const bool ok = (kr <= rlim) && (v >= vmin) && (v <= vmax) && (clampTop || b <= bmax);
                b = b > 2047u ? 2047u : b;
                lds_add(Hq + (ok ? (b >> 1) : 1024u), 1u << ((b & 1u) * 16u));
            }
        } else {
            unsigned ms = 0u, mg = 0u;
#pragma unroll
            for (int i = 15; i >= 0; --i) {
                asm("v_cmp_ge_f32_e32 vcc, %1, %2\n\tv_addc_co_u32_e32 %0, vcc, %0, %0, vcc" : "+v"(ms) : "v"(sc[i]), "v"(fsel) : "vcc");
                asm("v_cmp_ge_f32_e32 vcc, %1, %2\n\tv_addc_co_u32_e32 %0, vcc, %0, %0, vcc" : "+v"(mg) : "v"(sc[i]), "v"(ftie) : "vcc");
            }
            const unsigned vrow = rlim >= 31 ? 0xffffffffu : ((2u << rlim) - 1u);
            auto spread = [&](unsigned m) { return (((m & 0xfu) | ((m & 0xf0u) << 4) | ((m & 0xf00u) << 8) | ((m & 0xf000u) << 12)) << (4 * h)) & vrow; };
            const unsigned msel = spread(ms), mtie = spread(mg) & ~msel;
            const unsigned osel = __shfl_xor(msel, 32), otie = __shfl_xor(mtie, 32);
            if (h == 0) { SELM[r * MSTRIDE + T] = msel | osel; TIEM[r * MSTRIDE + T] = mtie | otie; }
        }
    }
#undef TK_NEXT_G
}

template <int CTRL> __device__ __forceinline__ float dppx(float x) { return __builtin_bit_cast(float, __builtin_amdgcn_mov_dpp(__builtin_bit_cast(int, x), CTRL, 0xf, 0xf, true)); }
__device__ __forceinline__ u32x2 tk_rescore_load(const bf16_t* KI, int key, int lane) {
    const int c = 4 * (lane & 15);
    return *(const u32x2*)(KI + (size_t)(key >> 5) * 2048 + (c >> 4) * 512 + ((((c >> 3) & 1) * 32 + (key & 31)) * 8) + (c & 7));
}
__device__ __forceinline__ float tk_rescore(const u32x2 q4, float wh, const u32x2 k4) {
    float d = bf_lo(q4.x) * bf_lo(k4.x); d = fmaf(bf_hi(q4.x), bf_hi(k4.x), d); d = fmaf(bf_lo(q4.y), bf_lo(k4.y), d); d = fmaf(bf_hi(q4.y), bf_hi(k4.y), d);
    d += dppx<0xB1>(d); d += dppx<0x4E>(d); d += dppx<0x141>(d); d += dppx<0x140>(d);
    float sc = wh * fmaxf(d, 0.f);
    sc += __shfl_xor(sc, 16); sc += __shfl_xor(sc, 32);
    return sc + 0.f;
}

__device__ __forceinline__ int wave_incl_scan(int v) {
    v += __builtin_amdgcn_update_dpp(0, v, 0x111, 0xf, 0xf, true); v += __builtin_amdgcn_update_dpp(0, v, 0x112, 0xf, 0xf, true);
    v += __builtin_amdgcn_update_dpp(0, v, 0x114, 0xf, 0xf, true); v += __builtin_amdgcn_update_dpp(0, v, 0x118, 0xf, 0xf, true);
    v += __builtin_amdgcn_update_dpp(0, v, 0x142, 0xa, 0xf, false); v += __builtin_amdgcn_update_dpp(0, v, 0x143, 0xc, 0xf, false);
    return v;
}
__device__ __forceinline__ void tk_scan(const LAS unsigned* Hq, LAS unsigned* pref_p, LAS unsigned* need_p, LAS unsigned* cnt_p, int bits, int lane, LAS unsigned* tot_p = nullptr) {
    const int need = (int)*need_p;
    int S = 0;
#pragma unroll
    for (int i = 0; i < 16; ++i) { const unsigned w = Hq[16 * lane + ((i + lane) & 15)]; S += (int)((w & 0xffffu) + (w >> 16)); }
    const int incl = wave_incl_scan(S), total = __builtin_amdgcn_readlane(incl, 63), Tabove = total - incl;
    const bool hit = (Tabove < need) && (need <= Tabove + S);
    const unsigned long long mk = __ballot(hit);
    const int L = mk ? (int)__builtin_ctzll(mk) : 0;
    const int remL = need - __builtin_amdgcn_readlane(Tabove, L);
    const unsigned w2 = Hq[16 * L + ((lane & 31) >> 1)];
    const int c = lane < 32 ? (int)((w2 >> (16 * (lane & 1))) & 0xffffu) : 0;
    const int incl2 = wave_incl_scan(c), tot2 = __builtin_amdgcn_readlane(incl2, 63), above2 = tot2 - incl2;
    const bool hit2 = (lane < 32) && (above2 < remL) && (remL <= above2 + c);
    const unsigned long long mk2 = __ballot(hit2);
    const int J = mk2 ? (int)__builtin_ctzll(mk2) : 0;
    const unsigned Dsel = mk ? (unsigned)(32 * L + J) : 0xffffu, nsel = mk2 ? (unsigned)(remL - __builtin_amdgcn_readlane(above2, J)) : 1u, csel = (unsigned)__builtin_amdgcn_readlane(c, J);
    if (lane == 0) { *pref_p = bits ? ((*pref_p << bits) | Dsel) : Dsel; *need_p = nsel; if (cnt_p) *cnt_p = csel; if (tot_p) *tot_p = (unsigned)total; }
}

typedef float f32x2_t __attribute__((ext_vector_type(2)));
__device__ __forceinline__ void unpack16(const v4u w, f32x2_t (&f)[8]) {
#pragma unroll
    for (int i = 0; i < 4; ++i) { f[2 * i] = __builtin_amdgcn_cvt_pk_f32_fp8((int)w[i], false); f[2 * i + 1] = __builtin_amdgcn_cvt_pk_f32_fp8((int)w[i], true); }
}
__device__ __forceinline__ void attn_item(int t, int hd, const unsigned short* SEL, const bf16_t* Q, const unsigned char* K8, const unsigned char* V8, bf16_t* ATTN, int lane) {
    constexpr float LOG2E = 1.4426950408889634f;
    const int kk = lane >> 2, part = lane & 3, cnt = (t + 1) < 256 ? (t + 1) : 256;
    const float slope2 = __uint_as_float((unsigned)(126 - hd) << 23) * LOG2E, sc2 = 0.125f * LOG2E;
    f32x2_t q[8];
    { const v4u qa = *(const v4u*)(Q + (size_t)t * AW + hd * 64 + part * 16), qb = *(const v4u*)(Q + (size_t)t * AW + hd * 64 + part * 16 + 8);
#pragma unroll
      for (int i = 0; i < 4; ++i) { q[i] = (f32x2_t){bf_lo(qa[i]) * sc2, bf_hi(qa[i]) * sc2}; q[4 + i] = (f32x2_t){bf_lo(qb[i]) * sc2, bf_hi(qb[i]) * sc2}; } }
    const unsigned short* lp = SEL + (size_t)t * 256;
    const unsigned char* kb = K8 + (size_t)hd * M * 128 + part * 16; const unsigned char* vb = kb + 64; (void)V8;
    int key[16]; v4u kf[16], vf[16];
#pragma unroll
    for (int r = 0; r < 16; ++r) { const int j = 16 * r + kk; key[r] = (int)lp[j < cnt ? j : cnt - 1]; }
#pragma unroll
    for (int r = 0; r < 16; ++r) { kf[r] = *(const v4u*)(kb + (size_t)key[r] * 128); vf[r] = *(const v4u*)(vb + (size_t)key[r] * 128); }
    float sv[16]; float mx = -INFINITY;
#pragma unroll
    for (int r = 0; r < 16; ++r) { f32x2_t kx[8]; unpack16(kf[r], kx); f32x2_t d2 = q[0] * kx[0];
#pragma unroll
        for (int e = 1; e < 8; ++e) d2 = __builtin_elementwise_fma(q[e], kx[e], d2);
        sv[r] = d2.x + d2.y; }
#pragma unroll
    for (int r = 0; r < 16; ++r) sv[r] += dppx<0xB1>(sv[r]);
#pragma unroll
    for (int r = 0; r < 16; ++r) sv[r] += dppx<0x4E>(sv[r]);
#pragma unroll
    for (int r = 0; r < 16; ++r) { sv[r] = (16 * r + kk) < cnt ? sv[r] - slope2 * (float)(t - key[r]) : -INFINITY; mx = fmaxf(mx, sv[r]); }
    mx = fmaxf(mx, __shfl_xor(mx, 4)); mx = fmaxf(mx, __shfl_xor(mx, 8)); mx = fmaxf(mx, __shfl_xor(mx, 16)); mx = fmaxf(mx, __shfl_xor(mx, 32));
    f32x2_t o[8]; float lsum = 0.f;
#pragma unroll
    for (int e = 0; e < 8; ++e) o[e] = (f32x2_t){0.f, 0.f};
#pragma unroll
    for (int r = 0; r < 16; ++r) { const float p = __builtin_amdgcn_exp2f(sv[r] - mx); lsum += p; f32x2_t vx[8]; unpack16(vf[r], vx); const f32x2_t p2 = (f32x2_t){p, p};
#pragma unroll
        for (int e = 0; e < 8; ++e) o[e] = __builtin_elementwise_fma(p2, vx[e], o[e]); }
    lsum += dppx<0x124>(lsum); lsum += dppx<0x128>(lsum); lsum += __shfl_xor(lsum, 16); lsum += __shfl_xor(lsum, 32);
    float of[16];
#pragma unroll
    for (int e = 0; e < 8; ++e) { of[2 * e] = o[e].x; of[2 * e + 1] = o[e].y; }
#pragma unroll
    for (int e = 0; e < 16; ++e) of[e] += dppx<0x124>(of[e]);
#pragma unroll
    for (int e = 0; e < 16; ++e) of[e] += dppx<0x128>(of[e]);
#pragma unroll
    for (int e = 0; e < 16; ++e) of[e] += __shfl_xor(of[e], 16);
#pragma unroll
    for (int e = 0; e < 16; ++e) of[e] += __shfl_xor(of[e], 32);
    if (lane < 4) { const float inv = __builtin_amdgcn_rcpf(lsum); v4u a, b;
        a.x = pkbf(of[0] * inv, of[1] * inv); a.y = pkbf(of[2] * inv, of[3] * inv); a.z = pkbf(of[4] * inv, of[5] * inv); a.w = pkbf(of[6] * inv, of[7] * inv);
        b.x = pkbf(of[8] * inv, of[9] * inv); b.y = pkbf(of[10] * inv, of[11] * inv); b.z = pkbf(of[12] * inv, of[13] * inv); b.w = pkbf(of[14] * inv, of[15] * inv);
        *(v4u*)(ATTN + (size_t)t * AW + hd * 64 + part * 16) = a; *(v4u*)(ATTN + (size_t)t * AW + hd * 64 + part * 16 + 8) = b; }
}

struct TkPtrs { const bf16_t *QI, *KI; const float* WI; unsigned short* SEL; };
__device__ __forceinline__ void topk_attn_block(int qb, const TkPtrs& P, LAS unsigned char* lds, int tid, int wave, int lane, bool do_attn) {
    LAS unsigned* H = (LAS unsigned*)lds;
    LAS unsigned* SELM = (LAS unsigned*)lds;
    LAS unsigned* TIEM = (LAS unsigned*)(lds + 32 * MSTRIDE * 4);
    LAS unsigned short* LIST = (LAS unsigned short*)(lds + LIST_OFF);
    LAS unsigned* STP = (LAS unsigned*)(lds + ST_OFF);
    LAS unsigned* STN = STP + 32;
    const int t0 = qb * 32, r = lane & 31, h = lane >> 5;
    SYNC();
    float wv[4];
    LAS bf16_t* QF = (LAS bf16_t*)(lds + LIST_OFF);
    { const bf16_t* qp = P.QI + (size_t)(t0 + r) * 256 + 8 * h;
#pragma unroll
      for (int k = 0; k < 2; ++k) { const int f = 2 * wave + k; *(LAS pg8::bf16x8*)(QF + f * 512 + lane * 8) = *(const pg8::bf16x8*)(qp + (f >> 2) * 64 + 16 * (f & 3)); }
      const f32x4 w4 = *(const f32x4*)(P.WI + (size_t)(t0 + r) * 4); wv[0] = w4[0]; wv[1] = w4[1]; wv[2] = w4[2]; wv[3] = w4[3]; }
    LAS unsigned* STC = STP + 64;
    LAS unsigned* STG = STP + 96;
    LAS unsigned* FB = STP + 160;
    LAS unsigned* STS = STP + 192;
    LAS float* FSEL = (LAS float*)(STP + 256);
    LAS float* FTIE = FSEL + 32;
    const bool negw = (wv[0] <= 0.f) && (wv[1] <= 0.f) && (wv[2] <= 0.f) && (wv[3] <= 0.f);
    const unsigned wbase = negw ? 7745u : 22976u;
    LAS unsigned* WINOK = STP + 161;
    LAS unsigned* PBN = STP + 320;
    if (wave == 0 && lane == 0) { *FB = 0u; *WINOK = 0u; }
#pragma unroll 1
    for (int mode = 0; mode < 2; ++mode) {
        if (mode == 1) { if ((*FB & 1u) == 0u) break; }
        if (wave == 0 && lane < 32) { STP[lane] = 0u; const int nv = t0 + lane + 1; STN[lane] = nv < 256 ? nv : 256; STG[lane] = negw ? 1u : 0u; }
        const int nstep = mode == 0 ? 1 : 3;
#pragma unroll 1
        for (int step = 0; step < nstep; ++step) {
            for (int i = tid; i < 32 * HSTRIDE; i += NTHR) H[i] = 0u;
            SYNC();
            const int sh = mode == 0 ? 17 : (step == 0 ? 21 : (step == 1 ? 10 : 0));
            const unsigned vlo = mode == 0 ? wbase : (step == 0 ? 0u : (STP[r] << (step == 1 ? 11 : 10)));
            tk_pass<false>(qb, wave, lane, P.KI, QF, wv, H, SELM, TIEM, sh, vlo, mode == 0, (mode == 1 && step == 2) ? 1023u : 2047u, 0, vlo, 0.f, 0.f);
            SYNC();
#pragma unroll 1
            for (int qq = 0; qq < 4; ++qq) { const int rq = 4 * wave + qq;
                tk_scan(H + rq * HSTRIDE, STP + rq, STN + rq, STC + rq, (mode == 1 && step == 2) ? 10 : 11, lane, PBN + rq);
                if (mode == 0 && lane == 0) { const unsigned D = STP[rq], nn = STN[rq], c = STC[rq], ng = STG[rq] & 1u;
                    if (D == 0xffffu) {
                        if (!ng) { const int nv = t0 + rq + 1; const unsigned need0 = nv < 256 ? nv : 256; PBN[rq] = need0 - PBN[rq]; STG[rq] = 4u; lds_or(FB, 2u); }
                        else lds_or(FB, 1u);
                    } else {
                        const bool zerobin = ng && D == 2047u, edge = (D == 0u) || (D == 2047u && !ng);
                        const bool wantc = (c > nn) && !zerobin;
                        if (edge || (wantc && c > 64u)) lds_or(FB, 1u);
                        STG[rq] = ng | (wantc ? 2u : 0u);
                        const unsigned wb = ng ? 7745u : 22976u;
                        FTIE[rq] = u2f((wb + D) << 17); FSEL[rq] = zerobin ? INFINITY : u2f((wb + D + 1u) << 17); } }
                if (mode == 1 && step == 2 && lane == 0) { const unsigned tau = STP[rq]; FTIE[rq] = u2f(tau); FSEL[rq] = tau == 0xffffffffu ? INFINITY : u2f(tau + 1u); } }
            SYNC();
        }
        if (mode == 0 && (*FB & 1u)) continue;
        if (mode == 0 && (*FB & 2u)) {
            for (int i = tid; i < 32 * HSTRIDE; i += NTHR) H[i] = 0u;
            if (wave == 0 && lane < 32 && (STG[lane] & 4u)) { STP[lane] = 0u; STN[lane] = PBN[lane]; }
            SYNC();
            const bool isB = (STG[r] & 4u) != 0u;
            tk_pass<false>(qb, wave, lane, P.KI, QF, wv, H, SELM, TIEM, 17, 7745u, true, 2047u, 0, isB ? 7745u : 0xffffffffu, 0.f, 0.f, 22975u);
            SYNC();
#pragma unroll 1
            for (int qq = 0; qq < 4; ++qq) { const int rq = 4 * wave + qq;
                if (STG[rq] & 4u) { tk_scan(H + rq * HSTRIDE, STP + rq, STN + rq, STC + rq, 11, lane);
                    if (lane == 0) { const unsigned D = STP[rq], nn = STN[rq], c = STC[rq];
                        const bool zerobin = D == 2047u, wantc = (c > nn) && !zerobin;
                        if (D == 0xffffu || D == 0u || (wantc && c > 64u)) lds_or(FB, 1u);
                        STG[rq] = wantc ? 2u : 0u;
                        FTIE[rq] = u2f((7745u + D) << 17); FSEL[rq] = zerobin ? __uint_as_float(1u) : u2f((7745u + D + 1u) << 17); } } }
            SYNC();
            if (*FB & 1u) continue;
        }
        tk_pass<true>(qb, wave, lane, P.KI, QF, wv, H, SELM, TIEM, 0, 0u, false, 0u, 0, 0u, FSEL[r], FTIE[r]);
        if (mode == 0 && wave == 0 && lane == 0) *WINOK = 1u;
        SYNC();
        break;
    }
    if (!do_attn) return;
#pragma unroll 1
    for (int qq = 0; qq < 4; ++qq) {
        const int rq = 4 * wave + qq, t = t0 + rq; int mties = (int)STN[rq];
        unsigned tw[8], fw[8]; int S = 0;
#pragma unroll
        for (int i = 0; i < 8; ++i) { const int T = 8 * lane + i; const bool v = T <= qb; tw[i] = v ? TIEM[rq * MSTRIDE + T] : 0u; fw[i] = v ? SELM[rq * MSTRIDE + T] : 0u; S += __builtin_popcount(tw[i]); }
        const int incl = wave_incl_scan(S);
        if (*WINOK != 0u && (STG[rq] & 2u)) {
            const int c = __builtin_amdgcn_readlane(incl, 63), nn = mties;
            LAS unsigned short* cl = LIST + rq * 256;
            { int pos = incl - S;
#pragma unroll
              for (int i = 0; i < 8; ++i) { unsigned w = tw[i]; while (w) { const int b = __builtin_ctz(w); if (pos < 64) cl[pos] = (unsigned short)(256 * lane + 32 * i + b); ++pos; w &= w - 1u; } } }
            LDS_WAIT(); asm volatile("" ::: "memory");
            const u32x2 q4 = *(const u32x2*)(P.QI + (size_t)t * 256 + 4 * lane); const float wh = P.WI[(size_t)t * 4 + (lane >> 4)];
            float mys = 0.f; const int cc = c < 64 ? c : 64;
#pragma unroll 1
            for (int j0 = 0; j0 < cc; j0 += 8) { u32x2 k4[8];
#pragma unroll
                for (int u = 0; u < 8; ++u) { const int jj = (j0 + u) < cc ? (j0 + u) : (cc - 1); k4[u] = tk_rescore_load(P.KI, __builtin_amdgcn_readfirstlane((int)cl[jj]), lane); }
#pragma unroll
                for (int u = 0; u < 8; ++u) { const float sj = tk_rescore(q4, wh, k4[u]); if (lane == j0 + u) mys = sj; } }
            int rank = 0;
            for (int j = 0; j < cc; ++j) { const float sj = __int_as_float(__builtin_amdgcn_readlane(__float_as_int(mys), j)); rank += (sj > mys || (sj == mys && j < lane)) ? 1 : 0; }
            const bool keepme = lane < cc && rank < nn; const int mykey = lane < cc ? (int)cl[lane] : 0;
#pragma unroll 1
            for (int j = 0; j < cc; ++j) { const int kj = __builtin_amdgcn_readlane(mykey, j); const int kp = __builtin_amdgcn_readlane((int)keepme, j);
                if (kp && (kj >> 8) == lane) {
#pragma unroll
                    for (int i = 0; i < 8; ++i) if (((kj >> 5) & 7) == i) fw[i] |= 1u << (kj & 31); } }
            mties = 0;
        }
        int take = mties - (incl - S); take = take < 0 ? 0 : (take > S ? S : take);
        int cl2 = 0;
#pragma unroll
        for (int i = 0; i < 8; ++i) { unsigned w = tw[i]; const int c = __builtin_popcount(w); unsigned keep;
            if (take >= c) { keep = w; take -= c; } else { keep = 0u; for (int k = 0; k < take; ++k) { const unsigned low = w & (0u - w); keep |= low; w ^= low; } take = 0; }
            fw[i] |= keep; cl2 += __builtin_popcount(fw[i]); }
        const int inc2 = wave_incl_scan(cl2);
        int pos = inc2 - cl2; const int cnt = __builtin_amdgcn_readlane(inc2, 63);
        LAS unsigned short* lp = LIST + rq * 256;
#pragma unroll
        for (int i = 0; i < 8; ++i) { unsigned w = fw[i]; while (w) { const int b = __builtin_ctz(w); if (pos < 256) lp[pos] = (unsigned short)(256 * lane + 32 * i + b); ++pos; w &= w - 1u; } }
        LDS_WAIT(); asm volatile("" ::: "memory");
        (void)cnt;
        *(u32x2*)(P.SEL + (size_t)t * 256 + 4 * lane) = *(const LAS u32x2*)(lp + 4 * lane);
    }
}

struct OneUnit { int pm, pn;
    __device__ __forceinline__ bool next(int i, pg8::Unit& u) const { if (i != 0) return false; u.pm = pm; u.pn = pn; return true; }
    __device__ __forceinline__ void a_ready(const pg8::Unit&) const {}
    __device__ __forceinline__ void done(const pg8::Unit&) const {}
};
struct Args { const float* in[18]; float* out; unsigned char* ws; int ph_lo, ph_hi; };
constexpr int NPH = 13;

typedef const __attribute__((address_space(4))) unsigned long long* kargp_t;
#define KARGS() kargp_t kargs = (kargp_t)__builtin_amdgcn_kernarg_segment_ptr(); asm volatile("" : "+s"(kargs)); GAS unsigned char* const ws = (GAS unsigned char*)kargs[19]; (void)ws
#define KIN(i) ((const float*)(const GAS float*)kargs[(i)])
#define KOUT() ((float*)(GAS float*)kargs[18])
#define WSP(T, off) ((T*)(GAS T*)(ws + (off)))
__global__ void __launch_bounds__(NTHR, 2) fwd_kernel(Args a) {
    extern __shared__ __attribute__((aligned(16))) unsigned char lds_raw[];
    LAS unsigned char* lds = (LAS unsigned char*)lds_raw;
    const int lo = a.ph_lo, hi = a.ph_hi;
    { int tid0 = threadIdx.x; asm volatile("" : "+v"(tid0)); for (int u = tid0; u < (LDS_BYTES - MISC_OFF) / 4; u += NTHR) ((LAS unsigned*)(lds + MISC_OFF))[u] = 0u; }
    SYNC();
    XcdBarrier bar; bar.bar = nullptr; bar.x = 0; bar.st = nullptr;
    if (hi - lo > 1) { KARGS(); bar = xcd_barrier_post((unsigned*)(GAS unsigned*)(ws + WS_CTL) + CW_BAR, (volatile LAS unsigned*)(lds + MISC_OFF) + 8); }
#define IN(k) (lo <= (k) && (k) < hi)
#define SEAM(k) do { if (IN(k) && IN((k) + 1)) xcd_barrier(bar); } while (0)
#define IDS() const int tid = threadIdx.x, lane = tid & 63, wave = __builtin_amdgcn_readfirstlane(tid >> 6), G = gridDim.x, bid = blockIdx.x; (void)lane; (void)wave; (void)G; (void)bid

    for (int rep_ph = 0; rep_ph < ((REP_PH == 0) ? 2 : 1); ++rep_ph) if (IN(0)) { KARGS(); IDS();
        P0Ptrs P{KIN(1), KIN(2), KIN(5), KIN(8), KIN(9), KIN(11), KIN(12), KIN(14), KIN(17), KIN(10), WSP(bf16_t, WS_WIN), WSP(bf16_t, WS_WATTN), WSP(bf16_t, WS_WGRP), WSP(bf16_t, WS_WPOOL), WSP(bf16_t, WS_WOUT),
                 WSP(bf16_t, WS_WUP), WSP(bf16_t, WS_WDOWN), WSP(float, WS_MODP)};
        p0_prologue(P, lds, bid * NWAVES + wave, G * NWAVES, wave, lane);
    }
    SEAM(0);
    if (IN(1)) { KARGS(); IDS();
        const float *b_ada = KIN(3), *norm1_g = KIN(4); const float* MODP = WSP(float, WS_MODP); float* MODF = WSP(float, WS_MODF);
        LAS float* mulv = (LAS float*)lds; LAS float* addv = mulv + 1024;
        for (int i = tid; i < 1024; i += NTHR) { float sh = b_ada[i], scv = b_ada[1024 + i];
#pragma unroll
            for (int kc = 0; kc < 16; ++kc) { sh += MODP[kc * NMOD + i]; scv += MODP[kc * NMOD + 1024 + i]; }
            mulv[i] = norm1_g[i] * (1.0f + scv); addv[i] = sh; }
        if (bid < 24 && tid < 256) { const int i = bid * 256 + tid; float v = b_ada[i];
#pragma unroll
            for (int kc = 0; kc < 16; ++kc) v += MODP[kc * NMOD + i];
            MODF[i] = v; }
        SYNC();
        modulate_rows(KIN(0), WSP(bf16_t, WS_H), mulv, addv, bid * NWAVES + wave, G * NWAVES, lane);
        SYNC();
    }
    SEAM(1);
    for (int rep_ph = 0; rep_ph < ((REP_PH == 2) ? 2 : 1); ++rep_ph) if (IN(2)) { KARGS(); IDS();
        pg8::Gemm g{WSP(bf16_t, WS_H), WSP(bf16_t, WS_WIN), M, NINP, DM}; pg8::StaticOrder S; S.init(M, NINP, G, bid);
        EpiProj E{WSP(bf16_t, WS_Q), WSP(unsigned char, WS_K), WSP(unsigned char, WS_K), WSP(bf16_t, WS_QI), WSP(bf16_t, WS_KI), WSP(bf16_t, WS_UPOOL), WSP(bf16_t, WS_GA), WSP(bf16_t, WS_GP), WSP(float, WS_WI), KIN(6), KIN(7)};
        pg8::gemm_phase<EpiProj, pg8::StaticOrder, true, true>(lds, g, S, E);
    }
    SEAM(2);
    if (IN(3)) { KARGS(); IDS();
        if (bid < 8) {
            pg8::Gemm g{WSP(bf16_t, WS_WPOOL), WSP(bf16_t, WS_WGRP), 1024, PW, PW}; OneUnit S{bid >> 1, bid & 1};
            EpiBf<3> E{WSP(bf16_t, WS_POOLMIX), PW, nullptr, nullptr};
            pg8::gemm_phase<EpiBf<3>, OneUnit, true, true>(lds, g, S, E);
            SYNC();
        }
        pooled_phase(WSP(bf16_t, WS_UPOOL), WSP(bf16_t, WS_POOLED), bid * NTHR + tid, G * NTHR);
        TkPtrs T{WSP(bf16_t, WS_QI), WSP(bf16_t, WS_KI), WSP(float, WS_WI), (unsigned short*)KOUT()};
        unsigned* qctr = (unsigned*)(GAS unsigned*)(ws + WS_CTL) + CW_QUEUE;
        LAS int* qslot = (LAS int*)(lds + ST_OFF + 2040);
#pragma unroll 1
        for (;;) {
            SYNC();
            if (tid == 0) *qslot = (int)__hip_atomic_fetch_add(qctr, 1u, __ATOMIC_RELAXED, __HIP_MEMORY_SCOPE_AGENT);
            SYNC();
            const int qi0 = *qslot;
            const int qi = qi0;
            if (qi >= 512 * (1 + REP_TKONLY)) break;
            topk_attn_block(511 - (qi & 511), T, lds, tid, wave, lane, qi >= 512 * REP_TKONLY);
        }
        SYNC();
    }
    SEAM(3);
    if (IN(4)) { KARGS(); IDS();
        {
        pg8::Gemm g{WSP(bf16_t, WS_POOLED), WSP(bf16_t, WS_POOLMIX), M, DM, PW}; pg8::StaticOrder S; S.init(M, DM, G, bid);
        EpiBf<1> E{WSP(bf16_t, WS_GP), DM, nullptr, nullptr};
        pg8::gemm_phase<EpiBf<1>, pg8::StaticOrder, true, true>(lds, g, S, E);
        }
        SYNC();
        const unsigned short* SEL = (const unsigned short*)KOUT(); const bf16_t* Qp = WSP(bf16_t, WS_Q); const unsigned char *K8 = WSP(unsigned char, WS_K), *V8 = WSP(unsigned char, WS_K); bf16_t* ATTN = WSP(bf16_t, WS_ATTN);
        const bool aff = (G & 7) == 0; const int nitem = 8 * M, step = aff ? (G >> 3) * NWAVES : G * NWAVES;
#pragma unroll 1
        for (int it = aff ? (bid >> 3) * NWAVES + wave : bid * NWAVES + wave; it < (aff ? M : nitem); it += step) attn_item(aff ? it : (it >> 3), aff ? (bid & 7) : (it & 7), SEL, Qp, K8, V8, ATTN, lane);
    }
    SEAM(4);
    if (IN(7)) { KARGS(); IDS();
        pg8::Gemm g{WSP(bf16_t, WS_ATTN), WSP(bf16_t, WS_WATTN), M, DM, AW}; pg8::StaticOrder S; S.init(M, DM, G, bid);
        EpiBf<2> E{WSP(bf16_t, WS_GA), DM, nullptr, WSP(bf16_t, WS_GP)};
        pg8::gemm_phase<EpiBf<2>, pg8::StaticOrder, true, true>(lds, g, S, E);
    }
    SEAM(7);
    for (int rep_ph = 0; rep_ph < ((REP_PH == 8) ? 2 : 1); ++rep_ph) if (IN(8)) { KARGS(); IDS();
        pg8::Gemm g{WSP(bf16_t, WS_GA), WSP(bf16_t, WS_WOUT), M, DM, DM}; pg8::StaticOrder S; S.init(M, DM, G, bid);
        EpiRes E{KIN(0), KOUT(), WSP(float, WS_MODF) + 2048, 0.f};
        pg8::gemm_phase<EpiRes, pg8::StaticOrder, true, true>(lds, g, S, E);
    }
    SEAM(8);
    if (IN(9)) { KARGS(); IDS();
        const float* norm2_g = KIN(13); const float* MODF = WSP(float, WS_MODF);
        LAS float* mulv = (LAS float*)lds; LAS float* addv = mulv + 1024;
        for (int i = tid; i < 1024; i += NTHR) { mulv[i] = norm2_g[i] * (1.0f + MODF[4096 + i]); addv[i] = MODF[3072 + i]; }
        SYNC();
        modulate_rows(KOUT(), WSP(bf16_t, WS_H), mulv, addv, bid * NWAVES + wave, G * NWAVES, lane);
        SYNC();
    }
    SEAM(9);
    for (int rep_ph = 0; rep_ph < ((REP_PH == 10) ? 2 : 1); ++rep_ph) if (IN(10)) { KARGS(); IDS();
        pg8::Gemm g{WSP(bf16_t, WS_H), WSP(bf16_t, WS_WUP), M, FF2, DM}; pg8::StaticOrder S; S.init(M, FF2, G, bid);
        EpiUpAct E{WSP(bf16_t, WS_ACT), WSP(float, WS_RAW), KIN(15), KIN(16)};
        pg8::gemm_phase<EpiUpAct, pg8::StaticOrder, true, true>(lds, g, S, E);
    }
    SEAM(10);
    if (IN(11)) { KARGS(); IDS(); fixup_phase(WSP(float, WS_RAW), WSP(bf16_t, WS_ACT), KIN(15), KIN(16), bid * NTHR + tid, G * NTHR); }
    SEAM(11);
    if (IN(12)) { KARGS(); IDS();
        pg8::Gemm g{WSP(bf16_t, WS_ACT), WSP(bf16_t, WS_WDOWN), M, DM, FF}; pg8::StaticOrder S; S.init(M, DM, G, bid);
        EpiRes E{KOUT(), KOUT(), WSP(float, WS_MODF) + 5120, DBG_C};
        pg8::gemm_phase<EpiRes, pg8::StaticOrder, true, true>(lds, g, S, E);
    }
#undef IN
#undef SEAM
}

extern "C" void kernel_launch(void* const* d_in, const int* in_sizes, int n_in, void* d_out, int out_size, void* d_ws, size_t ws_size, hipStream_t stream) {
    static int grid = 0;
    if (grid == 0) {
        if (n_in != 18 || in_sizes[0] != M * DM || out_size != M * DM || ws_size < WS_END) { fprintf(stderr, "kernel_launch: unexpected shapes (n_in %d, in0 %d, out %d, ws %zu)\n", n_in, n_in > 0 ? in_sizes[0] : -1, out_size, ws_size); grid = -1; return; }
        int dev = 0, cus = 0, per_cu = 0;
        if (hipGetDevice(&dev) != hipSuccess || hipDeviceGetAttribute(&cus, hipDeviceAttributeMultiprocessorCount, dev) != hipSuccess) { grid = -1; return; }
        if (hipFuncSetAttribute((const void*)fwd_kernel, hipFuncAttributeMaxDynamicSharedMemorySize, LDS_BYTES) != hipSuccess) { fprintf(stderr, "kernel_launch: hipFuncSetAttribute failed\n"); grid = -1; return; }
        if (hipOccupancyMaxActiveBlocksPerMultiprocessor(&per_cu, (const void*)fwd_kernel, NTHR, LDS_BYTES) != hipSuccess || per_cu < 1) fprintf(stderr, "kernel_launch: occupancy query says %d\n", per_cu);
        (void)hipGetLastError();
        grid = cus;
    }
    if (grid < 0) return;
    (void)hipMemsetAsync((char*)d_ws + WS_CTL, 0, CTL_ZERO_BYTES, stream);
    Args a{};
    for (int i = 0; i < 18; ++i) a.in[i] = (const float*)d_in[i];
    a.out = (float*)d_out; a.ws = (unsigned char*)d_ws;
#if N_LAUNCH_MODE == 1
    a.ph_lo = 0; a.ph_hi = NPH;
    hipLaunchKernelGGL(fwd_kernel, dim3(grid), dim3(NTHR), LDS_BYTES, stream, a);
#else
    for (int p = 0; p < NPH; ++p) { a.ph_lo = p; a.ph_hi = p + 1; hipLaunchKernelGGL(fwd_kernel, dim3(grid), dim3(NTHR), LDS_BYTES, stream, a); }
#endif
}
```

```cpp
#include <hip/hip_runtime.h>
#include <cstdio>
#include <cstdint>
#ifndef REP_TKONLY
#define REP_TKONLY 0
#endif
#ifndef REP_BLK
#define REP_BLK 1
#endif
namespace pg8 {
#define PG8_LAS __attribute__((address_space(3)))
typedef unsigned short bf16_t;
typedef short bf16x8 __attribute__((ext_vector_type(8)));
typedef float f32x4 __attribute__((ext_vector_type(4)));
typedef unsigned u32x4 __attribute__((ext_vector_type(4)));
constexpr int BM = 256, BK = 64, HALF = 128, HTB = HALF * BK * 2  , STAGE_BYTES = 8 * HTB, NXCD = 8, WGM = 8;

__host__ __device__ __forceinline__ int lds_byte(int r, int c) { const int st = (r >> 4) * 2 + (c >> 5), rr = r & 15, cc = c & 31, ob = rr * 64 + cc * 2; return st * 1024 + (ob ^ (((ob >> 9) & 1) << 5)); }
__host__ __device__ __forceinline__ void stage_rc(int b, int& R, int& C) { const int st = b / 1024, sb = b % 1024, swz = sb ^ (((sb >> 9) & 1) << 5); R = (st >> 1) * 16 + swz / 64; C = (st & 1) * 32 + (swz % 64) / 2; }
__host__ __device__ __forceinline__ int perm32(int rho) { const int n = rho >> 4, i = rho & 15; return 8 * (i >> 2) + 4 * n + (i & 3); }

struct Unit { int pm, pn; };
struct Gemm { const bf16_t* A; const bf16_t* Bt; int M, N, K; };

struct StaticOrder {
    int nM, nN, nwg, G, c;
    __host__ __device__ void init(int M, int N, int G_, int c_) { nM = M / BM; nN = N / BM; nwg = nM * nN; G = G_; c = c_; }
    __host__ __device__ bool next(int i, Unit& u) const {
        const long L = (long)i * G + c; if (L >= nwg) return false;
        int wgid = (int)L; { const int q = nwg / NXCD, r = nwg % NXCD, xcd = wgid % NXCD, off = wgid / NXCD; wgid = (xcd < r ? xcd * (q + 1) : r * (q + 1) + (xcd - r) * q) + off; }
        const int nig = WGM * nN, gid = wgid / nig, fm = gid * WGM, gsz = (nM - fm) < WGM ? (nM - fm) : WGM;
        u.pm = fm + ((wgid % nig) % gsz); u.pn = (wgid % nig) / gsz; return true;
    }
    __device__ __forceinline__ void a_ready(const Unit&) const {}
    __device__ __forceinline__ void done(const Unit&) const {}
};

__device__ __forceinline__ unsigned cvt_pk_bf16(float lo, float hi) { unsigned r; asm volatile("v_cvt_pk_bf16_f32 %0, %1, %2" : "=v"(r) : "v"(lo), "v"(hi)); return r; }
template <class Epi, class Sched, bool ALIGN_EPI = false, bool SP2 = false>
__device__ __forceinline__ void gemm_phase(PG8_LAS unsigned char* lds, const Gemm g, const Sched& S, const Epi& E) {
    int tid_ = threadIdx.x; asm volatile("" : "+v"(tid_));
    const int tid = tid_, wid = __builtin_amdgcn_readfirstlane(tid >> 6), lane = tid & 63, wr = wid >> 2, wc = wid & 3, fr = lane & 15, fq = lane >> 4;
    const int K = g.K, nt = K / BK;
    unsigned voffA[2], voffB[2];
#pragma unroll
    for (int i = 0; i < 2; ++i) { int R, C; stage_rc(tid * 16 + i * 8192, R, C); const int Rb = Epi::PERM ? ((R & ~31) + perm32(R & 31)) : R;
        voffA[i] = (unsigned)(R * K + C) * 2u; voffB[i] = (unsigned)(Rb * K + C) * 2u; }
    const size_t kstep = (size_t)(BK * 2);
    const size_t hstep = (size_t)HALF * K * 2;
    const size_t tstep = 2 * hstep;
    const unsigned ldsw = (unsigned)wid * 1024u;
    const int aoff = lds_byte(wr * 64 + fr, fq * 8), boff = lds_byte(wc * 32 + fr, fq * 8);
#define PG8_SA(b, h) (((b) * 2 + (h)) * HTB)
#define PG8_SB(b, h) ((4 + (b) * 2 + (h)) * HTB)
#define PG8_STAGE(bufoff, gbase, voff) do { _Pragma("unroll") for (int _i = 0; _i < 2; ++_i) \
        __builtin_amdgcn_global_load_lds((const unsigned*)((const char*)(gbase) + (voff)[_i]), (PG8_LAS unsigned*)(lds + (bufoff) + ldsw + _i * 8192), 16, 0, 0); } while (0)
#define PG8_LDA(dst, b, h) do { _Pragma("unroll") for (int m = 0; m < 4; ++m) _Pragma("unroll") for (int k = 0; k < 2; ++k) dst[m][k] = *(const PG8_LAS bf16x8*)(lds + PG8_SA(b, h) + aoff + m * 2048 + k * 1024); } while (0)
#define PG8_LDB(dst, b, h) do { _Pragma("unroll") for (int n = 0; n < 2; ++n) _Pragma("unroll") for (int k = 0; k < 2; ++k) dst[n][k] = *(const PG8_LAS bf16x8*)(lds + PG8_SB(b, h) + boff + n * 2048 + k * 1024); } while (0)
#define PG8_MMA(ai, bj, At, Bt) do { __builtin_amdgcn_s_setprio(1); _Pragma("unroll") for (int m = 0; m < 4; ++m) _Pragma("unroll") for (int n = 0; n < 2; ++n) _Pragma("unroll") for (int k = 0; k < 2; ++k) \
        acc[ai][bj][m][n] = __builtin_amdgcn_mfma_f32_16x16x32_bf16(Bt[n][k], At[m][k], acc[ai][bj][m][n], 0, 0, 0); __builtin_amdgcn_s_setprio(0); } while (0)
#define PG8_WAIT_V(n) asm volatile("s_waitcnt vmcnt(" #n ")" ::: "memory")
#define PG8_WAIT_L(n) asm volatile("s_waitcnt lgkmcnt(" #n ")" ::: "memory")
#define PG8_BAR __builtin_amdgcn_s_barrier()
#define PG8_SCHED __builtin_amdgcn_sched_barrier(0)
    Unit cur, nxt; int ui = 0;
    if (!S.next(0, cur)) return;
    f32x4 acc[2][2][4][2];
#pragma unroll
    for (int a = 0; a < 2; ++a)
#pragma unroll
        for (int b = 0; b < 2; ++b)
#pragma unroll
            for (int m = 0; m < 4; ++m)
#pragma unroll
                for (int n = 0; n < 2; ++n) acc[a][b][m][n] = (f32x4){0.f, 0.f, 0.f, 0.f};
    bf16x8 At[4][2], B0[2][2], B1[2][2];
    const char* cA = (const char*)g.A + (size_t)cur.pm * tstep; const char* cB = (const char*)g.Bt + (size_t)cur.pn * tstep;
    S.a_ready(cur);
    if constexpr (SP2) {
        PG8_STAGE(PG8_SB(0, 0), cB, voffB); PG8_STAGE(PG8_SB(0, 1), cB + hstep, voffB); PG8_STAGE(PG8_SA(0, 0), cA, voffA); PG8_STAGE(PG8_SA(0, 1), cA + hstep, voffA);
        if (wr == 1) PG8_BAR;
        PG8_WAIT_V(2); PG8_BAR;
        PG8_STAGE(PG8_SB(1, 0), cB + kstep, voffB); PG8_STAGE(PG8_SA(1, 0), cA + kstep, voffA); PG8_STAGE(PG8_SB(1, 1), cB + hstep + kstep, voffB);
        PG8_WAIT_V(6); PG8_BAR;
    } else {
        PG8_STAGE(PG8_SB(0, 0), cB, voffB); PG8_STAGE(PG8_SA(0, 0), cA, voffA); PG8_STAGE(PG8_SB(0, 1), cB + hstep, voffB); PG8_STAGE(PG8_SA(0, 1), cA + hstep, voffA);
        if (wr == 1) PG8_BAR;
        PG8_WAIT_V(4); PG8_BAR;
        PG8_STAGE(PG8_SB(1, 0), cB + kstep, voffB); PG8_STAGE(PG8_SA(1, 0), cA + kstep, voffA); PG8_STAGE(PG8_SB(1, 1), cB + hstep + kstep, voffB);
        PG8_WAIT_V(6); PG8_BAR;
    }
    for (;;) {
        const bool has_next = S.next(ui + 1, nxt);
        const char* nA = has_next ? (const char*)g.A + (size_t)nxt.pm * tstep : cA; const char* nB = has_next ? (const char*)g.Bt + (size_t)nxt.pn * tstep : cB;
        for (int t = 0; t < nt; t += 2) {
            const bool last = (t == nt - 2);
            const char* a1 = cA + (size_t)(t + 1) * kstep;
            const char* a2 = last ? nA : cA + (size_t)(t + 2) * kstep; const char* b2 = last ? nB : cB + (size_t)(t + 2) * kstep;
            const char* a3 = a2 + kstep; const char* b3 = b2 + kstep;
            if (last && has_next) S.a_ready(nxt);
            if constexpr (SP2) {
            PG8_LDB(B0, 0, 0); PG8_LDB(B1, 0, 1); PG8_SCHED; PG8_LDA(At, 0, 0); PG8_STAGE(PG8_SA(1, 1), a1 + hstep, voffA);
            PG8_WAIT_V(8); PG8_WAIT_L(0); PG8_BAR; PG8_MMA(0, 0, At, B0); PG8_MMA(0, 1, At, B1); PG8_BAR; PG8_SCHED;
            PG8_LDA(At, 0, 1); PG8_STAGE(PG8_SB(0, 0), b2, voffB); PG8_STAGE(PG8_SB(0, 1), b2 + hstep, voffB); PG8_STAGE(PG8_SA(0, 0), a2, voffA);
            PG8_WAIT_V(8); PG8_WAIT_L(0); PG8_BAR; PG8_MMA(1, 0, At, B0); PG8_MMA(1, 1, At, B1); PG8_BAR; PG8_SCHED;
            PG8_LDB(B0, 1, 0); PG8_LDB(B1, 1, 1); PG8_SCHED; PG8_LDA(At, 1, 0); PG8_STAGE(PG8_SA(0, 1), a2 + hstep, voffA);
            PG8_WAIT_V(8); PG8_WAIT_L(0); PG8_BAR; PG8_MMA(0, 0, At, B0); PG8_MMA(0, 1, At, B1); PG8_BAR; PG8_SCHED;
            PG8_LDA(At, 1, 1); PG8_STAGE(PG8_SB(1, 0), b3, voffB); PG8_STAGE(PG8_SB(1, 1), b3 + hstep, voffB); PG8_STAGE(PG8_SA(1, 0), a3, voffA);
            PG8_WAIT_V(8); PG8_WAIT_L(0); PG8_BAR; PG8_MMA(1, 0, At, B0); PG8_MMA(1, 1, At, B1); PG8_BAR; PG8_SCHED;
            } else {
            PG8_LDB(B0, 0, 0); PG8_SCHED; PG8_LDA(At, 0, 0); PG8_STAGE(PG8_SA(1, 1), a1 + hstep, voffA);
            PG8_WAIT_L(8); PG8_BAR; PG8_WAIT_L(0); PG8_MMA(0, 0, At, B0); PG8_BAR; PG8_SCHED;
            PG8_LDB(B1, 0, 1); PG8_STAGE(PG8_SB(0, 0), b2, voffB);
            PG8_BAR; PG8_WAIT_L(0); PG8_MMA(0, 1, At, B1); PG8_BAR;
            PG8_LDA(At, 0, 1); PG8_STAGE(PG8_SA(0, 0), a2, voffA);
            PG8_BAR; PG8_WAIT_L(0); PG8_MMA(1, 0, At, B0); PG8_BAR; PG8_SCHED;
            PG8_STAGE(PG8_SB(0, 1), b2 + hstep, voffB);
            PG8_WAIT_V(6); PG8_BAR; PG8_MMA(1, 1, At, B1); PG8_BAR;
            PG8_LDB(B0, 1, 0); PG8_SCHED; PG8_LDA(At, 1, 0); PG8_STAGE(PG8_SA(0, 1), a2 + hstep, voffA);
            PG8_WAIT_L(8); PG8_BAR; PG8_WAIT_L(0); PG8_MMA(0, 0, At, B0); PG8_BAR; PG8_SCHED;
            PG8_LDB(B1, 1, 1); PG8_STAGE(PG8_SB(1, 0), b3, voffB);
            PG8_BAR; PG8_WAIT_L(0); PG8_MMA(0, 1, At, B1); PG8_BAR;
            PG8_LDA(At, 1, 1); PG8_STAGE(PG8_SA(1, 0), a3, voffA);
            PG8_BAR; PG8_WAIT_L(0); PG8_MMA(1, 0, At, B0); PG8_BAR; PG8_SCHED;
            PG8_STAGE(PG8_SB(1, 1), b3 + hstep, voffB);
            PG8_WAIT_V(6); PG8_BAR; PG8_MMA(1, 1, At, B1); PG8_BAR;
            }
        }
        if constexpr (ALIGN_EPI) { if (wr == 0) PG8_BAR; }
        if constexpr (!Epi::AFTER_DRAIN) { E(acc, cur, wr, wc, fr, fq); S.done(cur); }
        if (!has_next) break;
#pragma unroll
        for (int a = 0; a < 2; ++a)
#pragma unroll
            for (int b = 0; b < 2; ++b)
#pragma unroll
                for (int m = 0; m < 4; ++m)
#pragma unroll
                    for (int n = 0; n < 2; ++n) acc[a][b][m][n] = (f32x4){0.f, 0.f, 0.f, 0.f};
        cur = nxt; cA = nA; cB = nB; ++ui;
        if constexpr (ALIGN_EPI) { if (wr == 1) PG8_BAR; }
    }
    PG8_WAIT_V(0);
    if constexpr (!ALIGN_EPI) { if (wr == 0) PG8_BAR; }
    PG8_BAR;
    if constexpr (Epi::AFTER_DRAIN) { E.fused(acc, cur, wr, wc, fr, fq, lds, wid, lane); S.done(cur); }
#undef PG8_SA
#undef PG8_SB
#undef PG8_STAGE
#undef PG8_LDA
#undef PG8_LDB
#undef PG8_MMA
#undef PG8_WAIT_V
#undef PG8_WAIT_L
#undef PG8_BAR
#undef PG8_SCHED
}
}
#define GAS __attribute__((address_space(1)))
#define LAS __attribute__((address_space(3)))
typedef unsigned short bf16;
typedef unsigned v4u __attribute__((ext_vector_type(4)));
typedef float f32x4 __attribute__((ext_vector_type(4)));
typedef short bf16x8 __attribute__((ext_vector_type(8)));
typedef GAS unsigned gu32;
typedef GAS unsigned long long gu64;
#define RLX_AGENT __ATOMIC_RELAXED, __HIP_MEMORY_SCOPE_AGENT
#define LDS_WAIT() asm volatile("s_waitcnt lgkmcnt(0)" ::: "memory")
#define VM_WAIT() asm volatile("s_waitcnt vmcnt(0)" ::: "memory")
__device__ __forceinline__ unsigned long long rt() { return __builtin_amdgcn_s_memrealtime(); }
__device__ __forceinline__ unsigned f2bf(float f) { unsigned u = __builtin_bit_cast(unsigned, f); return (u + 0x7fffu + ((u >> 16) & 1u)) >> 16; }
__device__ __forceinline__ unsigned pk2(float lo, float hi) { return f2bf(lo) | (f2bf(hi) << 16); }

#define XB_TMO      128
#define XB_XCNT(j)  (256  + 64 * (j))
#define XB_XSUB(j)  (1280 + 64 * (j))
#define XB_XGEN(j)  (2304 + 64 * (j))
#define XB_TOP      3328
#define XB_TOPGEN   3392
#define XCD_BAR_WORDS 3456
#define XB_SPIN_CAP (1u << 18)

__device__ __forceinline__ unsigned xb_ld(unsigned* p)              { return __hip_atomic_load(p, __ATOMIC_RELAXED, __HIP_MEMORY_SCOPE_AGENT); }
__device__ __forceinline__ unsigned xb_add(unsigned* p, unsigned v) { return __hip_atomic_fetch_add(p, v, __ATOMIC_RELAXED, __HIP_MEMORY_SCOPE_AGENT); }
__device__ __forceinline__ unsigned xb_xcc_id() { return (unsigned)__builtin_amdgcn_s_getreg((3 << 11) | 20) & 0xFu; }
#define XB_SPIN(cond, bar) do { unsigned _sp = 0; while (cond) { __builtin_amdgcn_s_sleep(1); \
    if ((++_sp & 255u) == 0u) { if (xb_ld(&(bar)[XB_TMO])) break; if (_sp > XB_SPIN_CAP) { atomicAdd(&(bar)[XB_TMO], 1u); break; } } } } while (0)

struct XcdBarrier {
    unsigned* bar; unsigned x;
    volatile LAS unsigned* st;
};

__device__ __forceinline__ XcdBarrier xcd_barrier_post(unsigned* bar, volatile LAS unsigned* st) {
    XcdBarrier b; b.bar = bar; b.x = xb_xcc_id(); b.st = st;
    if (threadIdx.x == 0) (void)xb_add(&bar[XB_XCNT(b.x)], 1u);
    return b;
}
__device__ __forceinline__ void xcd_barrier_complete(unsigned* bar, unsigned x, unsigned& nloc, unsigned& nx) {
    const unsigned G = gridDim.x * gridDim.y * gridDim.z;
    unsigned sum, cnt, mine, sp = 0u;
    for (;;) {
        sum = 0u; cnt = 0u; mine = 0u;
#pragma unroll
        for (unsigned j = 0; j < 16; ++j) { const unsigned c = xb_ld(&bar[XB_XCNT(j)]); sum += c; cnt += (c > 0u) ? 1u : 0u; mine = (j == x) ? c : mine; }
        if (sum == G) break;
        __builtin_amdgcn_s_sleep(1);
        if ((++sp & 255u) == 0u) { if (xb_ld(&bar[XB_TMO])) break; if (sp > XB_SPIN_CAP) { atomicAdd(&bar[XB_TMO], 1u); break; } }
    }
    nloc = mine > 0u ? mine : 1u; nx = cnt > 0u ? cnt : 1u;
}

__device__ __forceinline__ void xcd_barrier(const XcdBarrier& b) {
    asm volatile("s_waitcnt vmcnt(0)" ::: "memory");
    __syncthreads();
    if (threadIdx.x == 0) {
        unsigned* bar = b.bar;
        __builtin_amdgcn_s_waitcnt(0);
        unsigned nloc = b.st[0], nx = b.st[1];
        if (nloc == 0u) { xcd_barrier_complete(bar, b.x, nloc, nx); b.st[0] = nloc; b.st[1] = nx; }
        const unsigned old = xb_add(&bar[XB_XSUB(b.x)], 1u);
        const unsigned gen = old / nloc;
        if (old + 1u == (gen + 1u) * nloc) {
            __builtin_amdgcn_fence(__ATOMIC_RELEASE, "agent");
            asm volatile("s_waitcnt vmcnt(0)" ::: "memory");
            const unsigned og = xb_add(&bar[XB_TOP], 1u);
            const unsigned tg = og / nx;
            if (og + 1u == (tg + 1u) * nx) xb_add(&bar[XB_TOPGEN], 1u);
            else XB_SPIN(xb_ld(&bar[XB_TOPGEN]) == tg, bar);
            __builtin_amdgcn_fence(__ATOMIC_ACQUIRE, "agent");
            xb_add(&bar[XB_XGEN(b.x)], 1u);
            asm volatile("s_waitcnt vmcnt(0)" ::: "memory");
        } else {
            XB_SPIN(xb_ld(&bar[XB_XGEN(b.x)]) == gen, bar);
            __builtin_amdgcn_fence(__ATOMIC_ACQUIRE, "agent");
            asm volatile("s_waitcnt vmcnt(0)" ::: "memory");
        }
    }
    __syncthreads();
}


#ifndef STAGE
#define STAGE 3
#endif
#ifndef N_LAUNCH_MODE
#define N_LAUNCH_MODE 1
#endif
#ifndef REP_TK
#define REP_TK 1
#endif
#ifndef REP_AT
#define REP_AT 1
#endif
#ifndef REP_PH
#define REP_PH -1
#endif
#ifndef TK_PREFETCH
#define TK_PREFETCH 1
#endif
#ifndef DBG_C
#define DBG_C 0.0f
#endif

typedef float f32x16 __attribute__((ext_vector_type(16)));
typedef __attribute__((ext_vector_type(2))) __bf16 bf16x2_t;
using pg8::bf16_t; using pg8::Unit;

constexpr int M = 16384, DM = 1024, NHEAD = 8, HD = 64, AW = 512, PW = 512, FF = 2816, FF2 = 5632, NIN = 4420, NINP = 4608, NMOD = 6144;
constexpr float EPS = 1e-6f;
constexpr int NWAVES = 8, NTHR = 512;

constexpr size_t MiB = 1u << 20;
constexpr size_t WS_CTL = 0, CTL_ZERO_BYTES = 64 * 1024;
constexpr size_t WS_WIN = 1 * MiB, WS_WATTN = 10 * MiB, WS_WGRP = 11 * MiB, WS_WPOOL = 11 * MiB + 512 * 1024, WS_WOUT = 12 * MiB + 512 * 1024,
                 WS_WUP = 14 * MiB + 512 * 1024, WS_WDOWN = 25 * MiB + 512 * 1024;
constexpr size_t WS_MODP = 31 * MiB, WS_MODF = 31 * MiB + 393216, WS_WI = 31 * MiB + 512 * 1024;
constexpr size_t WS_H = 32 * MiB;
constexpr size_t WS_Q = 64 * MiB, WS_K = 80 * MiB, WS_V = 96 * MiB;
constexpr size_t WS_SEL = 88 * MiB;
constexpr size_t WS_QI = 112 * MiB, WS_KI = 120 * MiB;
constexpr size_t WS_UPOOL = 128 * MiB, WS_POOLED = 144 * MiB, WS_POOLMIX = 160 * MiB, WS_ATTN = 176 * MiB;
constexpr size_t WS_GA = 192 * MiB, WS_GP = 224 * MiB;
constexpr size_t WS_ACT = 64 * MiB;
constexpr size_t WS_RAW = 152 * MiB;
constexpr size_t WS_END = 256 * MiB;
constexpr int CW_BAR = 1024, CW_QUEUE = 512;

constexpr int LDS_BYTES = 163840;
constexpr int HSTRIDE = 1025, MSTRIDE = 513;
constexpr int LIST_OFF = 135168, ST_OFF = 151552, MISC_OFF = 159744;

#define SYNC() __syncthreads()
__device__ __forceinline__ float wave_sum(float v) {
#pragma unroll
    for (int o = 1; o < 64; o <<= 1) v += __shfl_xor(v, o);
    return v;
}
__device__ __forceinline__ float bf_lo(unsigned w) { return __builtin_bit_cast(float, w << 16); }
__device__ __forceinline__ float bf_hi(unsigned w) { return __builtin_bit_cast(float, w & 0xffff0000u); }
__device__ __forceinline__ float sigmoidf_(float x) { return __builtin_amdgcn_rcpf(1.0f + __expf(-x)); }
__device__ __forceinline__ unsigned pkbf(float lo, float hi) { return pg8::cvt_pk_bf16(lo, hi); }
typedef unsigned u32x2 __attribute__((ext_vector_type(2)));
__device__ __forceinline__ u32x2 pk4(f32x4 v) { u32x2 r; r.x = pkbf(v[0], v[1]); r.y = pkbf(v[2], v[3]); return r; }
__device__ __forceinline__ unsigned pk4_fp8(f32x4 v) { int w = 0; w = __builtin_amdgcn_cvt_pk_fp8_f32(v[0], v[1], w, false); w = __builtin_amdgcn_cvt_pk_fp8_f32(v[2], v[3], w, true); return (unsigned)w; }

__device__ __forceinline__ void tr_item(const float* W, int ldw, int src_col, int nvalid, int k0, bf16_t* WT, int K, int dst_row, LAS float* scr, int lane) {
    f32x4 v[8];
#pragma unroll
    for (int i = 0; i < 8; ++i) { const int kk = 8 * i + (lane >> 3), n4 = 4 * (lane & 7);
        v[i] = (f32x4){0.f, 0.f, 0.f, 0.f}; if (W != nullptr && n4 < nvalid) v[i] = *(const f32x4*)(W + (size_t)(k0 + kk) * ldw + src_col + n4); }
#pragma unroll
    for (int i = 0; i < 8; ++i) { const int kk = 8 * i + (lane >> 3), n4 = 4 * (lane & 7); LAS float* p = scr + kk * 33 + n4; p[0] = v[i][0]; p[1] = v[i][1]; p[2] = v[i][2]; p[3] = v[i][3]; }
    LDS_WAIT(); asm volatile("" ::: "memory");
    const int c = lane & 7;
#pragma unroll
    for (int j = 0; j < 4; ++j) { const int n = (lane >> 3) + 8 * j; const LAS float* s = scr + (8 * c) * 33 + n;
        v4u o; o.x = pk2(s[0 * 33], s[1 * 33]); o.y = pk2(s[2 * 33], s[3 * 33]); o.z = pk2(s[4 * 33], s[5 * 33]); o.w = pk2(s[6 * 33], s[7 * 33]);
        *(GAS v4u*)(WT + (size_t)(dst_row + n) * K + k0 + 8 * c) = o; }
    LDS_WAIT(); asm volatile("" ::: "memory");
}

struct P0Ptrs { const float *c, *w_ada, *w_in, *w_attn, *w_grp, *w_pool, *w_out, *w_up, *w_down, *pscale; bf16_t *WIN, *WATTN, *WGRP, *WPOOL, *WOUT, *WUP, *WDOWN; float* MODP; };
__device__ __forceinline__ void p0_prologue(const P0Ptrs& P, LAS unsigned char* lds, int gw, int NGW, int wave, int lane) {
    LAS float* scr = (LAS float*)(lds + wave * 16384);
    LAS float* sil = (LAS float*)(lds + 131072);
    for (int i = threadIdx.x; i < 1024; i += NTHR) { const float cv = P.c[i]; sil[i] = cv / (1.0f + __expf(-cv)); }
    SYNC();
    constexpr int I_WIN = 144 * 16, I_WATTN = 32 * 8, I_WGRP = 128, I_WPOOL = 32 * 8, I_WOUT = 32 * 16, I_WUP = 176 * 16, I_WDOWN = 32 * 44, I_MOD = 96 * 16;
    constexpr int NITEMS = I_WIN + I_WATTN + I_WGRP + I_WPOOL + I_WOUT + I_WUP + I_WDOWN + I_MOD;
    for (int it = gw; it < NITEMS; it += NGW) {
        int r = it;
        if (r < I_MOD) {
            const int cb = r % 96, kc = r / 96, col = cb * 64 + lane; float acc = 0.f;
#pragma unroll 8
            for (int i = 0; i < 64; ++i) { const int k = kc * 64 + i; acc = fmaf(sil[k], P.w_ada[(size_t)k * NMOD + col], acc); }
            P.MODP[kc * NMOD + col] = acc; continue; }
        r -= I_MOD;
        if (r < I_WIN) { const int g = r / 16, kb = r % 16, tile = g >> 3, gi = g & 7; int src = -1, nv = 32;
            const int permgi = gi < 4 ? 64 * gi : 64 * (gi - 4) + 32;
            if (tile < 2) src = tile * 256 + permgi;
            else if (tile < 4) src = 512 + (tile - 2) * 256 + permgi;
            else if (tile < 6) src = 1024 + (tile - 4) * 256 + 32 * gi;
            else if (tile == 6) src = 1536 + 32 * gi;
            else if (tile == 7) { if (gi < 2) src = 1792 + 32 * gi; else if (gi == 2) { src = 1856; nv = 4; } }
            else if (tile < 10) src = 1860 + (tile - 8) * 256 + 32 * gi;
            else if (tile < 14) src = 2372 + (tile - 10) * 256 + 32 * gi;
            else src = 3396 + (tile - 14) * 256 + 32 * gi;
            tr_item(src >= 0 ? P.w_in : nullptr, NIN, src >= 0 ? src : 0, nv, kb * 64, P.WIN, 1024, g * 32, scr, lane); continue; }
        r -= I_WIN;
        if (r < I_WATTN) { tr_item(P.w_attn, 1024, (r / 8) * 32, 32, (r % 8) * 64, P.WATTN, 512, (r / 8) * 32, scr, lane); continue; }
        r -= I_WATTN;
        if (r < I_WGRP) {
            const int row = 4 * r + (lane >> 4), g = row >> 7; const float* src = P.w_grp + (size_t)g * 16384 + (size_t)(row & 127) * 128;
#pragma unroll
            for (int q = 0; q < 4; ++q) { const int d0 = 32 * (lane & 15) + 8 * q; v4u o = (v4u){0u, 0u, 0u, 0u};
                if ((d0 >> 7) == g) { const f32x4 a = *(const f32x4*)(src + (d0 & 127)) * *(const f32x4*)(P.pscale + d0), b = *(const f32x4*)(src + (d0 & 127) + 4) * *(const f32x4*)(P.pscale + d0 + 4);
                    o.x = pk2(a[0], a[1]); o.y = pk2(a[2], a[3]); o.z = pk2(b[0], b[1]); o.w = pk2(b[2], b[3]); }
                *(GAS v4u*)(P.WGRP + (size_t)row * 512 + d0) = o; }
            continue; }
        r -= I_WGRP;
        if (r < I_WPOOL) { tr_item(P.w_pool, 1024, (r / 8) * 32, 32, (r % 8) * 64, P.WPOOL, 512, (r / 8) * 32, scr, lane); continue; }
        r -= I_WPOOL;
        if (r < I_WOUT) { tr_item(P.w_out, 1024, (r / 16) * 32, 32, (r % 16) * 64, P.WOUT, 1024, (r / 16) * 32, scr, lane); continue; }
        r -= I_WOUT;
        if (r < I_WUP) { const int g = r / 16, kb = r % 16, tile = g >> 3, gi = g & 7;
            const int src = gi < 4 ? 128 * tile + 32 * gi : FF + 128 * tile + 32 * (gi - 4);
            tr_item(P.w_up, FF2, src, 32, kb * 64, P.WUP, 1024, g * 32, scr, lane); continue; }
        r -= I_WUP;
        { tr_item(P.w_down, 1024, (r / 44) * 32, 32, (r % 44) * 64, P.WDOWN, FF, (r / 44) * 32, scr, lane); }
    }
}

__device__ __forceinline__ void modulate_rows(const float* X, bf16_t* O, const LAS float* mulv, const LAS float* addv, int gw, int NGW, int lane) {
    f32x4 mu[4], ad[4];
#pragma unroll
    for (int j = 0; j < 4; ++j) { mu[j] = *(const LAS f32x4*)(mulv + 4 * lane + 256 * j); ad[j] = *(const LAS f32x4*)(addv + 4 * lane + 256 * j); }
    for (int row = gw; row < M; row += NGW) {
        const GAS f32x4* xr = (const GAS f32x4*)(X + (size_t)row * DM) + lane;
        f32x4 v[4]; float s = 0.f;
#pragma unroll
        for (int j = 0; j < 4; ++j) { v[j] = xr[64 * j]; s += (v[j].x * v[j].x + v[j].y * v[j].y) + (v[j].z * v[j].z + v[j].w * v[j].w); }
        const float rstd = 1.0f / sqrtf(wave_sum(s) * (1.0f / DM) + EPS);
        GAS u32x2* o8 = (GAS u32x2*)(O + (size_t)row * DM) + lane;
#pragma unroll
        for (int j = 0; j < 4; ++j) { const f32x4 y = v[j] * rstd * mu[j] + ad[j]; o8[64 * j] = pk4(y); }
    }
}

struct EpiProj {
    static constexpr bool PERM = false, AFTER_DRAIN = false;
    bf16_t *Q; unsigned char *K8, *V8; bf16_t *QI, *KI, *UPOOL, *GA, *GP; float* WI; const float *qg, *kg;
    __device__ __forceinline__ void operator()(const pg8::f32x4 (&acc)[2][2][4][2], const Unit& u, int wr, int wc, int fr, int fq) const {
        const int pn = u.pn, row0 = u.pm * 256 + wr * 64 + fr;
        if (pn < 4) {
            const bool isq = pn < 2; const float* g = isq ? qg : kg; const int head = (pn & 1) * 4 + wc;
            f32x4 gv[2][2];
#pragma unroll
            for (int bj = 0; bj < 2; ++bj)
#pragma unroll
                for (int n = 0; n < 2; ++n) gv[bj][n] = *(const f32x4*)(g + 32 * bj + 16 * n + 4 * fq);
#pragma unroll
            for (int ai = 0; ai < 2; ++ai)
#pragma unroll
                for (int m = 0; m < 4; ++m) {
                    float ss = 0.f;
#pragma unroll
                    for (int bj = 0; bj < 2; ++bj)
#pragma unroll
                        for (int n = 0; n < 2; ++n) { const f32x4 x = acc[ai][bj][m][n]; ss += (x[0] * x[0] + x[1] * x[1]) + (x[2] * x[2] + x[3] * x[3]); }
                    ss += __shfl_xor(ss, 16); ss += __shfl_xor(ss, 32);
                    const float rstd = 1.0f / sqrtf(ss * (1.0f / 64.0f) + EPS);
                    const size_t ro = (size_t)(row0 + ai * 128 + m * 16) * AW + head * 64 + 4 * fq;
#pragma unroll
                    for (int bj = 0; bj < 2; ++bj)
#pragma unroll
                        for (int n = 0; n < 2; ++n) { const f32x4 y = acc[ai][bj][m][n] * rstd * gv[bj][n];
                            if (isq) *(u32x2*)(Q + ro + 32 * bj + 16 * n) = pk4(y); else *(unsigned*)(K8 + ((size_t)head * M + (row0 + ai * 128 + m * 16)) * 128 + 4 * fq + 32 * bj + 16 * n) = pk4_fp8(y); }
                }
            return;
        }
        const int colw = wc * 32 + 4 * fq;
        if (pn == 7) {
#pragma unroll
            for (int ai = 0; ai < 2; ++ai)
#pragma unroll
                for (int m = 0; m < 4; ++m) { const int row = row0 + ai * 128 + m * 16;
                    if (wc < 2) {
#pragma unroll
                        for (int n = 0; n < 2; ++n) { const int c = colw + 16 * n; *(u32x2*)(KI + (size_t)(row >> 5) * 2048 + (c >> 4) * 512 + ((((c >> 3) & 1) * 32 + (row & 31)) * 8) + (c & 7)) = pk4(acc[ai][0][m][n]); }
                    } else if (wc == 2 && fq == 0) { *(f32x4*)(WI + (size_t)row * 4) = acc[ai][0][m][0] * 0.5f; }
                }
            return;
        }
        if (pn < 6) {
#pragma unroll
            for (int ai = 0; ai < 2; ++ai)
#pragma unroll
                for (int m = 0; m < 4; ++m) { const int row = row0 + ai * 128 + m * 16;
#pragma unroll
                    for (int bj = 0; bj < 2; ++bj)
#pragma unroll
                        for (int n = 0; n < 2; ++n) { const int col = (pn - 4) * 256 + colw + 128 * bj + 16 * n;
                            *(unsigned*)(V8 + ((size_t)(col >> 6) * M + row) * 128 + 64 + (col & 63)) = pk4_fp8(acc[ai][bj][m][n]); } }
            return;
        }
        bf16_t* O; int ldo, ct; float sc = 1.0f; bool sig = false;
        if (pn == 6) { O = QI; ldo = 256; ct = 0; sc = 0.125f; }
        else if (pn < 10) { O = UPOOL; ldo = PW; ct = (pn - 8) * 256; }
        else if (pn < 14) { O = GA; ldo = DM; ct = (pn - 10) * 256; sig = true; }
        else { O = GP; ldo = DM; ct = (pn - 14) * 256; sig = true; }
#pragma unroll
        for (int ai = 0; ai < 2; ++ai)
#pragma unroll
            for (int m = 0; m < 4; ++m) { bf16_t* rowp = O + (size_t)(row0 + ai * 128 + m * 16) * ldo + ct + colw;
#pragma unroll
                for (int bj = 0; bj < 2; ++bj)
#pragma unroll
                    for (int n = 0; n < 2; ++n) { f32x4 y = acc[ai][bj][m][n] * sc;
                        if (sig) { y[0] = sigmoidf_(y[0]); y[1] = sigmoidf_(y[1]); y[2] = sigmoidf_(y[2]); y[3] = sigmoidf_(y[3]); }
                        *(u32x2*)(rowp + 128 * bj + 16 * n) = pk4(y); }
            }
    }
};

template <int MODE> struct EpiBf {
    static constexpr bool PERM = false, AFTER_DRAIN = false;
    bf16_t* O; int ldo; const float* colscale; const bf16_t* ADD;
    __device__ __forceinline__ void operator()(const pg8::f32x4 (&acc)[2][2][4][2], const Unit& u, int wr, int wc, int fr, int fq) const {
        const int row0 = u.pm * 256 + wr * 64 + fr, col0 = u.pn * 256 + wc * 32 + 4 * fq;
#pragma unroll
        for (int ai = 0; ai < 2; ++ai)
#pragma unroll
            for (int m = 0; m < 4; ++m) { const size_t ro = (size_t)(row0 + ai * 128 + m * 16) * ldo + col0;
#pragma unroll
                for (int bj = 0; bj < 2; ++bj)
#pragma unroll
                    for (int n = 0; n < 2; ++n) { f32x4 y = acc[ai][bj][m][n]; const size_t off = ro + 128 * bj + 16 * n;
                        if (MODE == 3) { }
                        else if (MODE == 0) { y = y * *(const f32x4*)(colscale + col0 + 128 * bj + 16 * n); }
                        else { const u32x2 gq = *(const u32x2*)(O + off); y[0] *= bf_lo(gq.x); y[1] *= bf_hi(gq.x); y[2] *= bf_lo(gq.y); y[3] *= bf_hi(gq.y);
                            if (MODE == 2) { const u32x2 a = *(const u32x2*)(ADD + off); y[0] += bf_lo(a.x); y[1] += bf_hi(a.x); y[2] += bf_lo(a.y); y[3] += bf_hi(a.y); } }
                        *(u32x2*)(O + off) = pk4(y); }
            }
    }
};

struct EpiRes {
    static constexpr bool PERM = false, AFTER_DRAIN = false;
    const float* BASE; float* OUT; const float* gate; float dbg;
    __device__ __forceinline__ void operator()(const pg8::f32x4 (&acc)[2][2][4][2], const Unit& u, int wr, int wc, int fr, int fq) const {
        const int row0 = u.pm * 256 + wr * 64 + fr, col0 = u.pn * 256 + wc * 32 + 4 * fq;
        f32x4 gv[2][2];
#pragma unroll
        for (int bj = 0; bj < 2; ++bj)
#pragma unroll
            for (int n = 0; n < 2; ++n) gv[bj][n] = *(const f32x4*)(gate + col0 + 128 * bj + 16 * n);
#pragma unroll
        for (int ai = 0; ai < 2; ++ai)
#pragma unroll
            for (int m = 0; m < 4; ++m) { const int row = row0 + ai * 128 + m * 16; const size_t ro = (size_t)row * DM + col0;
#pragma unroll
                for (int bj = 0; bj < 2; ++bj)
#pragma unroll
                    for (int n = 0; n < 2; ++n) { const size_t off = ro + 128 * bj + 16 * n; f32x4 y = *(const f32x4*)(BASE + off) + gv[bj][n] * acc[ai][bj][m][n];
                        if (dbg != 0.f) { const float sg = ((row * 7 + (int)(off >> 2)) & 1) ? dbg : -dbg; y[0] += sg; y[1] -= sg; y[2] += sg; y[3] -= sg; }
                        *(f32x4*)(OUT + off) = y; }
            }
    }
};

template <int CTRL> __device__ __forceinline__ float dppf(float x) { return __builtin_bit_cast(float, __builtin_amdgcn_update_dpp(0, __builtin_bit_cast(int, x), CTRL, 0xf, 0xf, false)); }
__device__ __forceinline__ f32x4 ror1(f32x4 v) { f32x4 r; r[0] = dppf<0x121>(v[0]); r[1] = dppf<0x121>(v[1]); r[2] = dppf<0x121>(v[2]); r[3] = dppf<0x121>(v[3]); return r; }
__device__ __forceinline__ f32x4 ror2(f32x4 v) { f32x4 r; r[0] = dppf<0x122>(v[0]); r[1] = dppf<0x122>(v[1]); r[2] = dppf<0x122>(v[2]); r[3] = dppf<0x122>(v[3]); return r; }
__device__ __forceinline__ f32x4 silu_mul(f32x4 a, f32x4 b) { f32x4 r;
#pragma unroll
    for (int e = 0; e < 4; ++e) r[e] = a[e] * __builtin_amdgcn_rcpf(1.0f + __expf(-a[e])) * b[e];
    return r; }
struct EpiUpAct {
    static constexpr bool PERM = false, AFTER_DRAIN = false;
    bf16_t* ACT; float* RAW; const float* cw; const float* cb;
    __device__ __forceinline__ void operator()(const pg8::f32x4 (&acc)[2][2][4][2], const Unit& u, int wr, int wc, int fr, int fq) const {
#pragma unroll
        for (int n = 0; n < 2; ++n) {
            const int ch = u.pn * 128 + wc * 32 + 4 * fq + 16 * n;
            const f32x4 w0a = *(const f32x4*)(cw + ch), w1a = *(const f32x4*)(cw + FF2 + ch), w2a = *(const f32x4*)(cw + 2 * FF2 + ch), ba = *(const f32x4*)(cb + ch);
            const f32x4 w0b = *(const f32x4*)(cw + FF + ch), w1b = *(const f32x4*)(cw + FF2 + FF + ch), w2b = *(const f32x4*)(cw + 2 * FF2 + FF + ch), bb = *(const f32x4*)(cb + FF + ch);
#pragma unroll
            for (int ai = 0; ai < 2; ++ai) {
                const int blk = u.pm * 4 + ai * 2 + wr;
                if (fr < 2) { *(f32x4*)(RAW + (size_t)(blk * 4 + fr) * FF2 + ch) = acc[ai][0][0][n]; *(f32x4*)(RAW + (size_t)(blk * 4 + fr) * FF2 + FF + ch) = acc[ai][1][0][n]; }
                if (fr >= 14) { *(f32x4*)(RAW + (size_t)(blk * 4 + fr - 12) * FF2 + ch) = acc[ai][0][3][n]; *(f32x4*)(RAW + (size_t)(blk * 4 + fr - 12) * FF2 + FF + ch) = acc[ai][1][3][n]; }
                f32x4 pa1 = {0.f, 0.f, 0.f, 0.f}, pa2 = pa1, pb1 = pa1, pb2 = pa1;
#pragma unroll
                for (int m = 0; m < 4; ++m) {
                    const f32x4 va = acc[ai][0][m][n], vb = acc[ai][1][m][n];
                    const f32x4 ra1 = ror1(va), ra2 = ror2(va), rb1 = ror1(vb), rb2 = ror2(vb);
                    const f32x4 xa1 = fr >= 1 ? ra1 : pa1, xa2 = fr >= 2 ? ra2 : pa2, xb1 = fr >= 1 ? rb1 : pb1, xb2 = fr >= 2 ? rb2 : pb2;
                    pa1 = ra1; pa2 = ra2; pb1 = rb1; pb2 = rb2;
                    const f32x4 ya = ba + w0a * xa2 + w1a * xa1 + w2a * va, yb = bb + w0b * xb2 + w1b * xb1 + w2b * vb;
                    const f32x4 o = silu_mul(ya, yb);
                    if (!(m == 0 && fr < 2)) *(u32x2*)(ACT + (size_t)(blk * 64 + 16 * m + fr) * FF + ch) = pk4(o);
                }
            }
        }
    }
};

__device__ __forceinline__ void fixup_phase(const float* RAW, bf16_t* ACT, const float* cw, const float* cb, int gtid, int nthr) {
    for (int it = gtid; it < 256 * 2 * 704; it += nthr) {
        const int c4 = it % 704, rr = (it / 704) & 1, blk = it / 1408, ch = 4 * c4;
        const float* cur = RAW + (size_t)(blk * 4 + rr) * FF2;
        const float* p1 = rr == 1 ? RAW + (size_t)(blk * 4) * FF2 : (blk > 0 ? RAW + (size_t)((blk - 1) * 4 + 3) * FF2 : nullptr);
        const float* p2 = rr == 1 ? (blk > 0 ? RAW + (size_t)((blk - 1) * 4 + 3) * FF2 : nullptr) : (blk > 0 ? RAW + (size_t)((blk - 1) * 4 + 2) * FF2 : nullptr);
        const f32x4 z = {0.f, 0.f, 0.f, 0.f};
        const f32x4 va = *(const f32x4*)(cur + ch), vb = *(const f32x4*)(cur + FF + ch);
        const f32x4 a1 = p1 ? *(const f32x4*)(p1 + ch) : z, b1 = p1 ? *(const f32x4*)(p1 + FF + ch) : z;
        const f32x4 a2 = p2 ? *(const f32x4*)(p2 + ch) : z, b2 = p2 ? *(const f32x4*)(p2 + FF + ch) : z;
        const f32x4 ya = *(const f32x4*)(cb + ch) + *(const f32x4*)(cw + ch) * a2 + *(const f32x4*)(cw + FF2 + ch) * a1 + *(const f32x4*)(cw + 2 * FF2 + ch) * va;
        const f32x4 yb = *(const f32x4*)(cb + FF + ch) + *(const f32x4*)(cw + FF + ch) * b2 + *(const f32x4*)(cw + FF2 + FF + ch) * b1 + *(const f32x4*)(cw + 2 * FF2 + FF + ch) * vb;
        *(u32x2*)(ACT + (size_t)(blk * 64 + rr) * FF + ch) = pk4(silu_mul(ya, yb));
    }
}

template <int W> __device__ __forceinline__ void pooled_item(const bf16_t* UPOOL, bf16_t* POOLED, int t, int c8) {
    v4u v[W];
#pragma unroll
    for (int j = 0; j < W; ++j) { const int tj = (t - j) >= 0 ? (t - j) : 0; v[j] = *(const v4u*)(UPOOL + (size_t)tj * PW + 8 * c8); }
    float s[8];
#pragma unroll
    for (int e = 0; e < 8; ++e) s[e] = 0.f;
#pragma unroll
    for (int j = 0; j < W; ++j) { const float m = (t - j) >= 0 ? 1.f : 0.f;
        s[0] = fmaf(m, bf_lo(v[j].x), s[0]); s[1] = fmaf(m, bf_hi(v[j].x), s[1]); s[2] = fmaf(m, bf_lo(v[j].y), s[2]); s[3] = fmaf(m, bf_hi(v[j].y), s[3]);
        s[4] = fmaf(m, bf_lo(v[j].z), s[4]); s[5] = fmaf(m, bf_hi(v[j].z), s[5]); s[6] = fmaf(m, bf_lo(v[j].w), s[6]); s[7] = fmaf(m, bf_hi(v[j].w), s[7]); }
    const int cntw = (t + 1) < W ? (t + 1) : W; const float inv = 1.0f / (float)cntw; v4u o;
    o.x = pkbf(s[0] * inv - bf_lo(v[0].x), s[1] * inv - bf_hi(v[0].x)); o.y = pkbf(s[2] * inv - bf_lo(v[0].y), s[3] * inv - bf_hi(v[0].y));
    o.z = pkbf(s[4] * inv - bf_lo(v[0].z), s[5] * inv - bf_hi(v[0].z)); o.w = pkbf(s[6] * inv - bf_lo(v[0].w), s[7] * inv - bf_hi(v[0].w));
    *(v4u*)(POOLED + (size_t)t * PW + 8 * c8) = o;
}
__device__ __forceinline__ void pooled_phase(const bf16_t* UPOOL, bf16_t* POOLED, int gtid, int nthr) {
    for (int it = gtid; it < M * 64; it += nthr) {
        const int wv = it >> 6, l = it & 63, g = wv & 3, t = (wv >> 2) * 4 + (l >> 4), c8 = g * 16 + (l & 15);
        if (g == 0) pooled_item<2>(UPOOL, POOLED, t, c8); else if (g == 1) pooled_item<4>(UPOOL, POOLED, t, c8); else if (g == 2) pooled_item<8>(UPOOL, POOLED, t, c8); else pooled_item<16>(UPOOL, POOLED, t, c8);
    }
}

#ifndef ATT_MFMA
#define ATT_MFMA 1
#endif
#ifndef SP_QB
#define SP_QB 64
#endif
#ifndef SP_Z
#define SP_Z 3.5f
#endif
#ifndef SP_DRY
#define SP_DRY 0
#endif
#define MFMA32(a, b, c) __builtin_amdgcn_mfma_f32_32x32x16_bf16((a), (b), (c), 0, 0, 0)
__device__ __forceinline__ unsigned lds_add(LAS unsigned* p, unsigned v) { return __hip_atomic_fetch_add(p, v, __ATOMIC_RELAXED, __HIP_MEMORY_SCOPE_WORKGROUP); }
__device__ __forceinline__ unsigned lds_or(LAS unsigned* p, unsigned v) { return __hip_atomic_fetch_or(p, v, __ATOMIC_RELAXED, __HIP_MEMORY_SCOPE_WORKGROUP); }

__device__ __forceinline__ unsigned f2sort(float f) { unsigned uu = __float_as_uint(f); return uu ^ (((unsigned)((int)uu >> 31)) | 0x80000000u); }
__device__ __forceinline__ float u2f(unsigned u) { return __uint_as_float((u & 0x80000000u) ? (u & 0x7fffffffu) : ~u); }
constexpr unsigned SP_CAP = 48u, SP_PHYS = 64u;
template <bool EMIT>
__device__ __forceinline__ unsigned tk_pass(int qb, int wave, int lane, const bf16_t* KI, const LAS bf16_t* QF, const float (&wv)[4], LAS unsigned* H, LAS unsigned* SELM, LAS unsigned* TIEM,
                                        int sh, unsigned vlo, bool clampTop, unsigned bmax, int stage, unsigned vmin, float fsel, float ftie, unsigned vmax = 0xffffffffu,
                                        bool append = false, float ftie_a = 0.f, unsigned char* lst = nullptr, unsigned loff0 = 0u) {
    const int r = lane & 31, h = lane >> 5;
    unsigned loff = loff0, lovf = 0u;
    const int gstep = stage == 1 ? 8 : 1, g0 = stage == 1 ? wave : 0;
#define TK_NEXT_G(g) ({ int _g = (g) + gstep; if (stage == 2 && (_g & 7) == wave) ++_g; _g; })
    int gcur = g0; if (stage == 2 && (gcur & 7) == wave) ++gcur;
    pg8::bf16x8 kf[4];
    { const int T0 = (wave + 8 * gcur) <= qb ? (wave + 8 * gcur) : qb; const bf16_t* kp = KI + (size_t)T0 * 2048 + 8 * lane;
#pragma unroll
      for (int s = 0; s < 4; ++s) kf[s] = *(const pg8::bf16x8*)(kp + 512 * s); }
    LAS unsigned* Hq = H + r * HSTRIDE;
#pragma unroll 1
    for (; wave + 8 * gcur <= qb; gcur = TK_NEXT_G(gcur)) {
        const int T = wave + 8 * gcur;
        float sc[16];
#pragma unroll
        for (int i = 0; i < 16; ++i) sc[i] = 0.f;
#pragma unroll
        for (int hd = 0; hd < 4; ++hd) { f32x16 a;
#pragma unroll
            for (int i = 0; i < 16; ++i) a[i] = 0.f;
#pragma unroll
            for (int s = 0; s < 4; ++s) a = MFMA32(kf[s], *(const LAS pg8::bf16x8*)(QF + (hd * 4 + s) * 512 + lane * 8), a);
#pragma unroll
            for (int i = 0; i < 16; ++i) { const float av = a[i]; const int ab = __float_as_int(av); sc[i] = fmaf(wv[hd], __int_as_float(ab > 0 ? ab : 0), sc[i]); } }
        { const int Tnn = wave + 8 * TK_NEXT_G(gcur); const int Tn = Tnn <= qb ? Tnn : T; const bf16_t* kp = KI + (size_t)Tn * 2048 + 8 * lane;
#pragma unroll
          for (int s = 0; s < 4; ++s) kf[s] = *(const pg8::bf16x8*)(kp + 512 * s); }
        const int rlim = (T == qb) ? r : 64;
        if (!EMIT) {
#pragma unroll
            for (int i = 0; i < 16; ++i) {
                const int kr = (i & 3) + 8 * (i >> 2) + 4 * h;
                unsigned uu = __float_as_uint(sc[i]); uu ^= ((unsigned)((int)uu >> 31)) | 0x80000000u;
                const unsigned v = uu >> sh; unsigned b = v - vlo;
                const bool ok = (kr <= rlim) && (v >= vmin) && (v <= vmax) && (clampTop || b <= bmax);
                b = b > 2047u ? 2047u : b;
                lds_add(Hq + (ok ? (b >> 1) : 1024u), 1u << ((b & 1u) * 16u));
            }
        } else {
            unsigned ms = 0u, mg = 0u;
#pragma unroll
            for (int i = 15; i >= 0; --i) {
                asm("v_cmp_ge_f32_e32 vcc, %1, %2\n\tv_addc_co_u32_e32 %0, vcc, %0, %0, vcc" : "+v"(ms) : "v"(sc[i]), "v"(fsel) : "vcc");
                asm("v_cmp_ge_f32_e32 vcc, %1, %2\n\tv_addc_co_u32_e32 %0, vcc, %0, %0, vcc" : "+v"(mg) : "v"(sc[i]), "v"(ftie) : "vcc");
            }
            const unsigned vrow = rlim >= 31 ? 0xffffffffu : ((2u << rlim) - 1u);
            auto spread = [&](unsigned m) { return (((m & 0xfu) | ((m & 0xf0u) << 4) | ((m & 0xf00u) << 8) | ((m & 0xf000u) << 12)) << (4 * h)) & vrow; };
            const unsigned msel = spread(ms), mtie = spread(mg) & ~msel;
            const unsigned osel = __shfl_xor(msel, 32), otie = __shfl_xor(mtie, 32);
            if (h == 0) { SELM[r * MSTRIDE + T] = msel | osel; TIEM[r * MSTRIDE + T] = mtie | otie; }
            if (append) {
#pragma unroll
                for (int i = 0; i < 16; ++i) {
                    const int kr = (i & 3) + 8 * (i >> 2) + 4 * h;
                    if ((sc[i] >= ftie_a) && !(sc[i] >= fsel) && (kr <= rlim)) { *(u32x2*)(lst + loff) = (u32x2){__float_as_uint(sc[i]), (unsigned)(32 * T + kr)}; loff += 4096u; }
                }
                if (loff >= loff0 + (SP_PHYS - 16u) * 4096u) { lovf = 1u; loff = loff0; }
            }
        }
    }
#undef TK_NEXT_G
    return loff | lovf;
}

template <int CTRL> __device__ __forceinline__ float dppx(float x) { return __builtin_bit_cast(float, __builtin_amdgcn_mov_dpp(__builtin_bit_cast(int, x), CTRL, 0xf, 0xf, true)); }
__device__ __forceinline__ u32x2 tk_rescore_load(const bf16_t* KI, int key, int lane) {
    const int c = 4 * (lane & 15);
    return *(const u32x2*)(KI + (size_t)(key >> 5) * 2048 + (c >> 4) * 512 + ((((c >> 3) & 1) * 32 + (key & 31)) * 8) + (c & 7));
}
__device__ __forceinline__ float tk_rescore(const u32x2 q4, float wh, const u32x2 k4) {
    float d = bf_lo(q4.x) * bf_lo(k4.x); d = fmaf(bf_hi(q4.x), bf_hi(k4.x), d); d = fmaf(bf_lo(q4.y), bf_lo(k4.y), d); d = fmaf(bf_hi(q4.y), bf_hi(k4.y), d);
    d += dppx<0xB1>(d); d += dppx<0x4E>(d); d += dppx<0x141>(d); d += dppx<0x140>(d);
    float sc = wh * fmaxf(d, 0.f);
    sc += __shfl_xor(sc, 16); sc += __shfl_xor(sc, 32);
    return sc + 0.f;
}

__device__ __forceinline__ int wave_incl_scan(int v) {
    v += __builtin_amdgcn_update_dpp(0, v, 0x111, 0xf, 0xf, true); v += __builtin_amdgcn_update_dpp(0, v, 0x112, 0xf, 0xf, true);
    v += __builtin_amdgcn_update_dpp(0, v, 0x114, 0xf, 0xf, true); v += __builtin_amdgcn_update_dpp(0, v, 0x118, 0xf, 0xf, true);
    v += __builtin_amdgcn_update_dpp(0, v, 0x142, 0xa, 0xf, false); v += __builtin_amdgcn_update_dpp(0, v, 0x143, 0xc, 0xf, false);
    return v;
}
template <int WPL>
__device__ __forceinline__ void tk_scan_core(const LAS unsigned* Hq, int need, int lane, unsigned& Dsel, unsigned& nsel, unsigned& csel, int& total) {
    constexpr int BPL = 2 * WPL;
    int S = 0;
#pragma unroll
    for (int i = 0; i < WPL; ++i) { const unsigned w = Hq[WPL * lane + ((i + lane) & (WPL - 1))]; S += (int)((w & 0xffffu) + (w >> 16)); }
    const int incl = wave_incl_scan(S); total = __builtin_amdgcn_readlane(incl, 63); const int Tabove = total - incl;
    const bool hit = (Tabove < need) && (need <= Tabove + S);
    const unsigned long long mk = __ballot(hit);
    const int L = mk ? (int)__builtin_ctzll(mk) : 0;
    const int remL = need - __builtin_amdgcn_readlane(Tabove, L);
    const unsigned w2 = Hq[WPL * L + ((lane & (BPL - 1)) >> 1)];
    const int c = lane < BPL ? (int)((w2 >> (16 * (lane & 1))) & 0xffffu) : 0;
    const int incl2 = wave_incl_scan(c), tot2 = __builtin_amdgcn_readlane(incl2, 63), above2 = tot2 - incl2;
    const bool hit2 = (lane < BPL) && (above2 < remL) && (remL <= above2 + c);
    const unsigned long long mk2 = __ballot(hit2);
    const int J = mk2 ? (int)__builtin_ctzll(mk2) : 0;
    Dsel = mk ? (unsigned)(BPL * L + J) : 0xffffu; nsel = mk2 ? (unsigned)(remL - __builtin_amdgcn_readlane(above2, J)) : 1u; csel = (unsigned)__builtin_amdgcn_readlane(c, J);
}
__device__ __forceinline__ void tk_scan(const LAS unsigned* Hq, LAS unsigned* pref_p, LAS unsigned* need_p, LAS unsigned* cnt_p, int bits, int lane, LAS unsigned* tot_p = nullptr) {
    unsigned Dsel, nsel, csel; int total;
    tk_scan_core<16>(Hq, (int)*need_p, lane, Dsel, nsel, csel, total);
    if (lane == 0) { *pref_p = bits ? ((*pref_p << bits) | Dsel) : Dsel; *need_p = nsel; if (cnt_p) *cnt_p = csel; if (tot_p) *tot_p = (unsigned)total; }
}

typedef float f32x2_t __attribute__((ext_vector_type(2)));
__device__ __forceinline__ void unpack16(const v4u w, f32x2_t (&f)[8]) {
#pragma unroll
    for (int i = 0; i < 4; ++i) { f[2 * i] = __builtin_amdgcn_cvt_pk_f32_fp8((int)w[i], false); f[2 * i + 1] = __builtin_amdgcn_cvt_pk_f32_fp8((int)w[i], true); }
}
__device__ __forceinline__ void attn_item(int t, int hd, const unsigned short* SEL, const bf16_t* Q, const unsigned char* K8, const unsigned char* V8, bf16_t* ATTN, int lane) {
    constexpr float LOG2E = 1.4426950408889634f;
    const int kk = lane >> 2, part = lane & 3, cnt = (t + 1) < 256 ? (t + 1) : 256;
    const float slope2 = __uint_as_float((unsigned)(126 - hd) << 23) * LOG2E, sc2 = 0.125f * LOG2E;
#if ATT_MFMA
    const int g4 = lane >> 4, bp = 4 * (4 * (lane & 15) + g4), isel = kk & 3;
    long B1, B2;
    { const v4u qa = *(const v4u*)(Q + (size_t)t * AW + hd * 64 + g4 * 16), qb = *(const v4u*)(Q + (size_t)t * AW + hd * 64 + g4 * 16 + 8);
      int b0 = __builtin_amdgcn_cvt_pk_fp8_f32(bf_lo(qa.x), bf_hi(qa.x), 0, false); b0 = __builtin_amdgcn_cvt_pk_fp8_f32(bf_lo(qa.y), bf_hi(qa.y), b0, true);
      int b1 = __builtin_amdgcn_cvt_pk_fp8_f32(bf_lo(qa.z), bf_hi(qa.z), 0, false); b1 = __builtin_amdgcn_cvt_pk_fp8_f32(bf_lo(qa.w), bf_hi(qa.w), b1, true);
      int b2 = __builtin_amdgcn_cvt_pk_fp8_f32(bf_lo(qb.x), bf_hi(qb.x), 0, false); b2 = __builtin_amdgcn_cvt_pk_fp8_f32(bf_lo(qb.y), bf_hi(qb.y), b2, true);
      int b3 = __builtin_amdgcn_cvt_pk_fp8_f32(bf_lo(qb.z), bf_hi(qb.z), 0, false); b3 = __builtin_amdgcn_cvt_pk_fp8_f32(bf_lo(qb.w), bf_hi(qb.w), b3, true);
      B1 = (long)(((unsigned long long)(unsigned)b1 << 32) | (unsigned)b0); B2 = (long)(((unsigned long long)(unsigned)b3 << 32) | (unsigned)b2); }
#else
    f32x2_t q[8];
    { const v4u qa = *(const v4u*)(Q + (size_t)t * AW + hd * 64 + part * 16), qb = *(const v4u*)(Q + (size_t)t * AW + hd * 64 + part * 16 + 8);
#pragma unroll
      for (int i = 0; i < 4; ++i) { q[i] = (f32x2_t){bf_lo(qa[i]) * sc2, bf_hi(qa[i]) * sc2}; q[4 + i] = (f32x2_t){bf_lo(qb[i]) * sc2, bf_hi(qb[i]) * sc2}; } }
#endif
    const unsigned short* lp = SEL + (size_t)t * 256;
    const unsigned char* kb = K8 + (size_t)hd * M * 128 + part * 16; const unsigned char* vb = kb + 64; (void)V8;
    int key[16]; v4u kf[16], vf[16];
#pragma unroll
    for (int r = 0; r < 16; ++r) { const int j = 16 * r + kk; key[r] = (int)lp[j < cnt ? j : cnt - 1]; }
#pragma unroll
    for (int r = 0; r < 16; ++r) { kf[r] = *(const v4u*)(kb + (size_t)key[r] * 128); vf[r] = *(const v4u*)(vb + (size_t)key[r] * 128); }
    float sv[16]; float mx = -INFINITY;
#if ATT_MFMA
    const bool o1 = (isel & 1) != 0, o2 = (isel & 2) != 0;
#pragma unroll
    for (int r = 0; r < 16; ++r) {
        kf[r].x = (unsigned)__builtin_amdgcn_ds_bpermute(bp, (int)kf[r].x); kf[r].y = (unsigned)__builtin_amdgcn_ds_bpermute(bp, (int)kf[r].y);
        kf[r].z = (unsigned)__builtin_amdgcn_ds_bpermute(bp, (int)kf[r].z); kf[r].w = (unsigned)__builtin_amdgcn_ds_bpermute(bp, (int)kf[r].w); }
#pragma unroll
    for (int r = 0; r < 16; ++r) {
        const long A1 = (long)(((unsigned long long)kf[r].y << 32) | kf[r].x), A2 = (long)(((unsigned long long)kf[r].w << 32) | kf[r].z);
        f32x4 acc = {0.f, 0.f, 0.f, 0.f};
        acc = __builtin_amdgcn_mfma_f32_16x16x32_fp8_fp8(A1, B1, acc, 0, 0, 0); acc = __builtin_amdgcn_mfma_f32_16x16x32_fp8_fp8(A2, B2, acc, 0, 0, 0);
        const float a0 = acc[0], a1 = acc[1], a2 = acc[2], a3 = acc[3];
        const float s01 = o1 ? a1 : a0, s23 = o1 ? a3 : a2;
        sv[r] = o2 ? s23 : s01; }
#pragma unroll
    for (int r = 0; r < 16; ++r) { sv[r] = (16 * r + kk) < cnt ? fmaf(sv[r], sc2, -slope2 * (float)(t - key[r])) : -INFINITY; mx = fmaxf(mx, sv[r]); }
#else
#pragma unroll
    for (int r = 0; r < 16; ++r) { f32x2_t kx[8]; unpack16(kf[r], kx); f32x2_t d2 = q[0] * kx[0];
#pragma unroll
        for (int e = 1; e < 8; ++e) d2 = __builtin_elementwise_fma(q[e], kx[e], d2);
        sv[r] = d2.x + d2.y; }
#pragma unroll
    for (int r = 0; r < 16; ++r) sv[r] += dppx<0xB1>(sv[r]);
#pragma unroll
    for (int r = 0; r < 16; ++r) sv[r] += dppx<0x4E>(sv[r]);
#pragma unroll
    for (int r = 0; r < 16; ++r) { sv[r] = (16 * r + kk) < cnt ? sv[r] - slope2 * (float)(t - key[r]) : -INFINITY; mx = fmaxf(mx, sv[r]); }
#endif
    mx = fmaxf(mx, __shfl_xor(mx, 4)); mx = fmaxf(mx, __shfl_xor(mx, 8)); mx = fmaxf(mx, __shfl_xor(mx, 16)); mx = fmaxf(mx, __shfl_xor(mx, 32));
    f32x2_t o[8]; float lsum = 0.f;
#pragma unroll
    for (int e = 0; e < 8; ++e) o[e] = (f32x2_t){0.f, 0.f};
#pragma unroll
    for (int r = 0; r < 16; ++r) { const float p = __builtin_amdgcn_exp2f(sv[r] - mx); lsum += p; f32x2_t vx[8]; unpack16(vf[r], vx); const f32x2_t p2 = (f32x2_t){p, p};
#pragma unroll
        for (int e = 0; e < 8; ++e) o[e] = __builtin_elementwise_fma(p2, vx[e], o[e]); }
    lsum += dppx<0x124>(lsum); lsum += dppx<0x128>(lsum); lsum += __shfl_xor(lsum, 16); lsum += __shfl_xor(lsum, 32);
    float of[16];
#pragma unroll
    for (int e = 0; e < 8; ++e) { of[2 * e] = o[e].x; of[2 * e + 1] = o[e].y; }
#pragma unroll
    for (int e = 0; e < 16; ++e) of[e] += dppx<0x124>(of[e]);
#pragma unroll
    for (int e = 0; e < 16; ++e) of[e] += dppx<0x128>(of[e]);
#pragma unroll
    for (int e = 0; e < 16; ++e) of[e] += __shfl_xor(of[e], 16);
#pragma unroll
    for (int e = 0; e < 16; ++e) of[e] += __shfl_xor(of[e], 32);
    if (lane < 4) { const float inv = __builtin_amdgcn_rcpf(lsum); v4u a, b;
        a.x = pkbf(of[0] * inv, of[1] * inv); a.y = pkbf(of[2] * inv, of[3] * inv); a.z = pkbf(of[4] * inv, of[5] * inv); a.w = pkbf(of[6] * inv, of[7] * inv);
        b.x = pkbf(of[8] * inv, of[9] * inv); b.y = pkbf(of[10] * inv, of[11] * inv); b.z = pkbf(of[12] * inv, of[13] * inv); b.w = pkbf(of[14] * inv, of[15] * inv);
        *(v4u*)(ATTN + (size_t)t * AW + hd * 64 + part * 16) = a; *(v4u*)(ATTN + (size_t)t * AW + hd * 64 + part * 16 + 8) = b; }
}

struct TkPtrs { const bf16_t *QI, *KI; const float* WI; unsigned short* SEL; unsigned char* LST; };
__device__ __forceinline__ void topk_attn_block(int qb, const TkPtrs& P, LAS unsigned char* lds, int tid, int wave, int lane, bool do_attn) {
    LAS unsigned* H = (LAS unsigned*)lds;
    LAS unsigned* SELM = (LAS unsigned*)lds;
    LAS unsigned* TIEM = (LAS unsigned*)(lds + 32 * MSTRIDE * 4);
    LAS unsigned short* LIST = (LAS unsigned short*)(lds + LIST_OFF);
    LAS unsigned* STP = (LAS unsigned*)(lds + ST_OFF);
    LAS unsigned* STN = STP + 32;
    const int t0 = qb * 32, r = lane & 31, h = lane >> 5;
    SYNC();
    float wv[4];
    LAS bf16_t* QF = (LAS bf16_t*)(lds + LIST_OFF);
    { const bf16_t* qp = P.QI + (size_t)(t0 + r) * 256 + 8 * h;
#pragma unroll
      for (int k = 0; k < 2; ++k) { const int f = 2 * wave + k; *(LAS pg8::bf16x8*)(QF + f * 512 + lane * 8) = *(const pg8::bf16x8*)(qp + (f >> 2) * 64 + 16 * (f & 3)); }
      const f32x4 w4 = *(const f32x4*)(P.WI + (size_t)(t0 + r) * 4); wv[0] = w4[0]; wv[1] = w4[1]; wv[2] = w4[2]; wv[3] = w4[3]; }
    LAS unsigned* STC = STP + 64;
    LAS unsigned* STG = STP + 96;
    LAS unsigned* FB = STP + 160;
    LAS unsigned* STS = STP + 192;
    LAS float* FSEL = (LAS float*)(STP + 256);
    LAS float* FTIE = FSEL + 32;
    const bool negw = (wv[0] <= 0.f) && (wv[1] <= 0.f) && (wv[2] <= 0.f) && (wv[3] <= 0.f);
    const unsigned wbase = negw ? 7745u : 22976u;
    LAS unsigned* WINOK = STP + 161;
    LAS unsigned* PBN = STP + 320;
    LAS unsigned* FBS = STP + 162;
    LAS float* FTA = FSEL + 96;
    LAS unsigned* CNTL = STP + 512;
    if (wave == 0 && lane == 0) { *FB = 0u; *WINOK = 0u; *FBS = 0u; }
#pragma unroll 1
    for (int mode = (qb >= SP_QB && blockIdx.x < 256u) ? -1 : 0; mode < 2; ++mode) {
        if (mode == 1) { if ((*FB & 1u) == 0u) break; }
        if (wave == 0 && lane < 32) { STP[lane] = 0u; const int nv = t0 + lane + 1; STN[lane] = nv < 256 ? nv : 256; STG[lane] = negw ? 1u : 0u; }
        const int nstep = mode <= 0 ? 1 : 3;
#pragma unroll 1
        for (int step = 0; step < nstep; ++step) {
            for (int i = tid; i < 32 * HSTRIDE; i += NTHR) H[i] = 0u;
            SYNC();
            const int sh = mode <= 0 ? 17 : (step == 0 ? 21 : (step == 1 ? 10 : 0));
            const unsigned vlo = mode <= 0 ? wbase : (step == 0 ? 0u : (STP[r] << (step == 1 ? 11 : 10)));
            tk_pass<false>(qb, wave, lane, P.KI, QF, wv, H, SELM, TIEM, sh, vlo, mode <= 0, (mode == 1 && step == 2) ? 1023u : 2047u, mode < 0 ? 1 : 0, vlo, 0.f, 0.f);
            SYNC();
#pragma unroll 1
            for (int qq = 0; qq < 4; ++qq) { const int rq = 4 * wave + qq;
                if (mode < 0) {
                    int ns = 0;
#pragma unroll
                    for (int w = 0; w < 8; ++w) { const int first = 9 * w; if (first <= qb) { const int k = (qb - first) >> 6; ns += 32 * (k + 1); if (first + 64 * k == qb) ns -= 31 - rq; } }
                    const float phi = (float)ns / (float)(t0 + rq + 1), mu = 256.f * phi, sd = sqrtf(mu * (1.f - phi));
                    int rhi = (int)floorf(mu - SP_Z * sd); const int rlo = (int)ceilf(mu + SP_Z * sd); rhi = rhi < 1 ? 1 : rhi;
                    unsigned Dh, Dl, n1, c1; int tot1;
                    tk_scan_core<16>(H + rq * HSTRIDE, rhi, lane, Dh, n1, c1, tot1);
                    tk_scan_core<16>(H + rq * HSTRIDE, rlo, lane, Dl, n1, c1, tot1);
                    if (lane == 0) { const unsigned ng = STG[rq] & 1u;
                        if (Dh == 0xffffu || Dl == 0xffffu) *FBS = 1u;
                        else { const unsigned wb = ng ? 7745u : 22976u; const bool zb = ng && Dl == 2047u;
                            const float ft = u2f((wb + Dl) << 17);
                            FSEL[rq] = Dh == 2047u ? INFINITY : u2f((wb + Dh + 1u) << 17); FTIE[rq] = ft; FTA[rq] = zb ? INFINITY : ft;
                            STG[rq] = ng | (zb ? 0u : 8u); } }
                    continue;
                }
                tk_scan(H + rq * HSTRIDE, STP + rq, STN + rq, STC + rq, (mode == 1 && step == 2) ? 10 : 11, lane, PBN + rq);
                if (mode == 0 && lane == 0) { const unsigned D = STP[rq], nn = STN[rq], c = STC[rq], ng = STG[rq] & 1u;
                    if (D == 0xffffu) {
                        if (!ng) { const int nv = t0 + rq + 1; const unsigned need0 = nv < 256 ? nv : 256; PBN[rq] = need0 - PBN[rq]; STG[rq] = 4u; lds_or(FB, 2u); }
                        else lds_or(FB, 1u);
                    } else {
                        const bool zerobin = ng && D == 2047u, edge = (D == 0u) || (D == 2047u && !ng);
                        const bool wantc = (c > nn) && !zerobin;
                        if (edge || (wantc && c > 64u)) lds_or(FB, 1u);
                        STG[rq] = ng | (wantc ? 2u : 0u);
                        const unsigned wb = ng ? 7745u : 22976u;
                        FTIE[rq] = u2f((wb + D) << 17); FSEL[rq] = zerobin ? INFINITY : u2f((wb + D + 1u) << 17); } }
                if (mode == 1 && step == 2 && lane == 0) { const unsigned tau = STP[rq]; FTIE[rq] = u2f(tau); FSEL[rq] = tau == 0xffffffffu ? INFINITY : u2f(tau + 1u); } }
            SYNC();
        }
        if (mode < 0) {
            if (*FBS) continue;
            const unsigned tid8 = (unsigned)tid * 8u;
            const unsigned lend = tk_pass<true>(qb, wave, lane, P.KI, QF, wv, H, SELM, TIEM, 0, 0u, false, 0u, 0, 0u, FSEL[r], FTIE[r], 0xffffffffu, true, FTA[r], P.LST, tid8);
            CNTL[tid] = (lend & 1u) ? 0xffffu : ((lend - tid8) >> 12);
            SYNC();
#pragma unroll 1
            for (int qq = 0; qq < 4; ++qq) { const int rq = 4 * wave + qq;
                int cs = 0, ct = 0;
#pragma unroll
                for (int i = 0; i < 8; ++i) { const int T = 8 * lane + i; if (T <= qb) { cs += __builtin_popcount(SELM[rq * MSTRIDE + T]); ct += __builtin_popcount(TIEM[rq * MSTRIDE + T]); } }
                cs = __builtin_amdgcn_readlane(wave_incl_scan(cs), 63); ct = __builtin_amdgcn_readlane(wave_incl_scan(ct), 63);
                const unsigned cn = CNTL[64 * ((lane & 15) >> 1) + 32 * (lane & 1) + rq];
                const bool bad = __ballot(cn > SP_CAP) != 0ull;
                if (lane == 0) { if (cs >= 256 || cs + ct < 256 || ((STG[rq] & 8u) && bad)) *FBS = 1u; STN[rq] = (unsigned)(256 - cs); }
            }
            SYNC();
            if (*FBS || SP_DRY) continue;
            break;
        }
        if (mode == 0 && (*FB & 1u)) continue;
        if (mode == 0 && (*FB & 2u)) {
            for (int i = tid; i < 32 * HSTRIDE; i += NTHR) H[i] = 0u;
            if (wave == 0 && lane < 32 && (STG[lane] & 4u)) { STP[lane] = 0u; STN[lane] = PBN[lane]; }
            SYNC();
            const bool isB = (STG[r] & 4u) != 0u;
            tk_pass<false>(qb, wave, lane, P.KI, QF, wv, H, SELM, TIEM, 17, 7745u, true, 2047u, 0, isB ? 7745u : 0xffffffffu, 0.f, 0.f, 22975u);
            SYNC();
#pragma unroll 1
            for (int qq = 0; qq < 4; ++qq) { const int rq = 4 * wave + qq;
                if (STG[rq] & 4u) { tk_scan(H + rq * HSTRIDE, STP + rq, STN + rq, STC + rq, 11, lane);
                    if (lane == 0) { const unsigned D = STP[rq], nn = STN[rq], c = STC[rq];
                        const bool zerobin = D == 2047u, wantc = (c > nn) && !zerobin;
                        if (D == 0xffffu || D == 0u || (wantc && c > 64u)) lds_or(FB, 1u);
                        STG[rq] = wantc ? 2u : 0u;
                        FTIE[rq] = u2f((7745u + D) << 17); FSEL[rq] = zerobin ? __uint_as_float(1u) : u2f((7745u + D + 1u) << 17); } } }
            SYNC();
            if (*FB & 1u) continue;
        }
        tk_pass<true>(qb, wave, lane, P.KI, QF, wv, H, SELM, TIEM, 0, 0u, false, 0u, 0, 0u, FSEL[r], FTIE[r]);
        if (mode == 0 && wave == 0 && lane == 0) *WINOK = 1u;
        SYNC();
        break;
    }
    if (!do_attn) return;
#pragma unroll 1
    for (int qq = 0; qq < 4; ++qq) {
        const int rq = 4 * wave + qq, t = t0 + rq; int mties = (int)STN[rq];
        if (STG[rq] & 8u) {
            const int src = 64 * ((lane & 15) >> 1) + 32 * (lane & 1) + rq; const int cn = (int)CNTL[src];
            const unsigned lo_u = f2sort(FTIE[rq]), span = f2sort(FSEL[rq]) - lo_u;
            unsigned eu[12], ek[12];
#pragma unroll
            for (int m = 0; m < 12; ++m) { const int j = (lane >> 4) + 4 * m; const bool v = j < cn; const u32x2 e = *(const u32x2*)(P.LST + (size_t)((v ? j : 0) * 512 + src) * 8);
                eu[m] = v ? f2sort(__uint_as_float(e.x)) - lo_u : 0xffffffffu; ek[m] = e.y; }
            LAS unsigned* Hr = TIEM + rq * MSTRIDE; LAS unsigned* Sr = SELM + rq * MSTRIDE;
            unsigned lo = 0u, width = span; int sh = 22 - (int)__builtin_clz(span | 1u); sh = sh < 0 ? 0 : sh;
            int needc = mties; unsigned long long thr = 0ull; unsigned tieoff = 0xffffffffu; int mt = 0;
#pragma unroll 1
            for (int round = 0; round < 4; ++round) {
#pragma unroll
                for (int i = 0; i < 8; ++i) Hr[lane + 64 * i] = 0u;
                LDS_WAIT();
#pragma unroll
                for (int m = 0; m < 12; ++m) { const unsigned d = eu[m] - lo; if (d < width) { const unsigned b = d >> sh; lds_add(Hr + (b >> 1), 1u << ((b & 1u) * 16u)); } }
                LDS_WAIT();
                unsigned D, nn, c; int tot;
                tk_scan_core<8>(Hr, needc, lane, D, nn, c, tot);
                if (D == 0xffffu) break;
                if (c == nn) { thr = (unsigned long long)lo + ((unsigned long long)D << sh); break; }
                if (sh == 0) { thr = (unsigned long long)lo + D + 1ull; tieoff = lo + D; mt = (int)nn; break; }
                lo += D << sh; width = 1u << sh; sh = sh > 10 ? sh - 10 : 0; needc = (int)nn;
            }
#pragma unroll
            for (int i = 0; i < 8; ++i) Hr[lane + 64 * i] = 0u;
            LDS_WAIT();
#pragma unroll
            for (int m = 0; m < 12; ++m) { const unsigned bit = 1u << (ek[m] & 31u);
                if (eu[m] != 0xffffffffu && (unsigned long long)eu[m] >= thr) lds_or(Sr + (ek[m] >> 5), bit);
                else if (eu[m] == tieoff && eu[m] != 0xffffffffu) lds_or(Hr + (ek[m] >> 5), bit); }
            LDS_WAIT(); asm volatile("" ::: "memory");
            mties = mt;
        }
        unsigned tw[8], fw[8]; int S = 0;
#pragma unroll
        for (int i = 0; i < 8; ++i) { const int T = 8 * lane + i; const bool v = T <= qb; tw[i] = v ? TIEM[rq * MSTRIDE + T] : 0u; fw[i] = v ? SELM[rq * MSTRIDE + T] : 0u; S += __builtin_popcount(tw[i]); }
        const int incl = wave_incl_scan(S);
        if (*WINOK != 0u && (STG[rq] & 2u)) {
            const int c = __builtin_amdgcn_readlane(incl, 63), nn = mties;
            LAS unsigned short* cl = LIST + rq * 256;
            { int pos = incl - S;
#pragma unroll
              for (int i = 0; i < 8; ++i) { unsigned w = tw[i]; while (w) { const int b = __builtin_ctz(w); if (pos < 64) cl[pos] = (unsigned short)(256 * lane + 32 * i + b); ++pos; w &= w - 1u; } } }
            LDS_WAIT(); asm volatile("" ::: "memory");
            const u32x2 q4 = *(const u32x2*)(P.QI + (size_t)t * 256 + 4 * lane); const float wh = P.WI[(size_t)t * 4 + (lane >> 4)];
            float mys = 0.f; const int cc = c < 64 ? c : 64;
#pragma unroll 1
            for (int j0 = 0; j0 < cc; j0 += 8) { u32x2 k4[8];
#pragma unroll
                for (int u = 0; u < 8; ++u) { const int jj = (j0 + u) < cc ? (j0 + u) : (cc - 1); k4[u] = tk_rescore_load(P.KI, __builtin_amdgcn_readfirstlane((int)cl[jj]), lane); }
#pragma unroll
                for (int u = 0; u < 8; ++u) { const float sj = tk_rescore(q4, wh, k4[u]); if (lane == j0 + u) mys = sj; } }
            int rank = 0;
            for (int j = 0; j < cc; ++j) { const float sj = __int_as_float(__builtin_amdgcn_readlane(__float_as_int(mys), j)); rank += (sj > mys || (sj == mys && j < lane)) ? 1 : 0; }
            const bool keepme = lane < cc && rank < nn; const int mykey = lane < cc ? (int)cl[lane] : 0;
#pragma unroll 1
            for (int j = 0; j < cc; ++j) { const int kj = __builtin_amdgcn_readlane(mykey, j); const int kp = __builtin_amdgcn_readlane((int)keepme, j);
                if (kp && (kj >> 8) == lane) {
#pragma unroll
                    for (int i = 0; i < 8; ++i) if (((kj >> 5) & 7) == i) fw[i] |= 1u << (kj & 31); } }
            mties = 0;
        }
        int take = mties - (incl - S); take = take < 0 ? 0 : (take > S ? S : take);
        int cl2 = 0;
#pragma unroll
        for (int i = 0; i < 8; ++i) { unsigned w = tw[i]; const int c = __builtin_popcount(w); unsigned keep;
            if (take >= c) { keep = w; take -= c; } else { keep = 0u; for (int k = 0; k < take; ++k) { const unsigned low = w & (0u - w); keep |= low; w ^= low; } take = 0; }
            fw[i] |= keep; cl2 += __builtin_popcount(fw[i]); }
        const int inc2 = wave_incl_scan(cl2);
        int pos = inc2 - cl2; const int cnt = __builtin_amdgcn_readlane(inc2, 63);
        LAS unsigned short* lp = LIST + rq * 256;
#pragma unroll
        for (int i = 0; i < 8; ++i) { unsigned w = fw[i]; while (w) { const int b = __builtin_ctz(w); if (pos < 256) lp[pos] = (unsigned short)(256 * lane + 32 * i + b); ++pos; w &= w - 1u; } }
        LDS_WAIT(); asm volatile("" ::: "memory");
        (void)cnt;
        *(u32x2*)(P.SEL + (size_t)t * 256 + 4 * lane) = *(const LAS u32x2*)(lp + 4 * lane);
    }
}

struct OneUnit { int pm, pn;
    __device__ __forceinline__ bool next(int i, pg8::Unit& u) const { if (i != 0) return false; u.pm = pm; u.pn = pn; return true; }
    __device__ __forceinline__ void a_ready(const pg8::Unit&) const {}
    __device__ __forceinline__ void done(const pg8::Unit&) const {}
};
struct Args { const float* in[18]; float* out; unsigned char* ws; int ph_lo, ph_hi; };
constexpr int NPH = 13;

typedef const __attribute__((address_space(4))) unsigned long long* kargp_t;
#define KARGS() kargp_t kargs = (kargp_t)__builtin_amdgcn_kernarg_segment_ptr(); asm volatile("" : "+s"(kargs)); GAS unsigned char* const ws = (GAS unsigned char*)kargs[19]; (void)ws
#define KIN(i) ((const float*)(const GAS float*)kargs[(i)])
#define KOUT() ((float*)(GAS float*)kargs[18])
#define WSP(T, off) ((T*)(GAS T*)(ws + (off)))
__global__ void __launch_bounds__(NTHR, 2) fwd_kernel(Args a) {
    extern __shared__ __attribute__((aligned(16))) unsigned char lds_raw[];
    LAS unsigned char* lds = (LAS unsigned char*)lds_raw;
    const int lo = a.ph_lo, hi = a.ph_hi;
    { int tid0 = threadIdx.x; asm volatile("" : "+v"(tid0)); for (int u = tid0; u < (LDS_BYTES - MISC_OFF) / 4; u += NTHR) ((LAS unsigned*)(lds + MISC_OFF))[u] = 0u; }
    SYNC();
    XcdBarrier bar; bar.bar = nullptr; bar.x = 0; bar.st = nullptr;
    if (hi - lo > 1) { KARGS(); bar = xcd_barrier_post((unsigned*)(GAS unsigned*)(ws + WS_CTL) + CW_BAR, (volatile LAS unsigned*)(lds + MISC_OFF) + 8); }
#define IN(k) (lo <= (k) && (k) < hi)
#define SEAM(k) do { if (IN(k) && IN((k) + 1)) xcd_barrier(bar); } while (0)
#define IDS() const int tid = threadIdx.x, lane = tid & 63, wave = __builtin_amdgcn_readfirstlane(tid >> 6), G = gridDim.x, bid = blockIdx.x; (void)lane; (void)wave; (void)G; (void)bid

    for (int rep_ph = 0; rep_ph < ((REP_PH == 0) ? 2 : 1); ++rep_ph) if (IN(0)) { KARGS(); IDS();
        P0Ptrs P{KIN(1), KIN(2), KIN(5), KIN(8), KIN(9), KIN(11), KIN(12), KIN(14), KIN(17), KIN(10), WSP(bf16_t, WS_WIN), WSP(bf16_t, WS_WATTN), WSP(bf16_t, WS_WGRP), WSP(bf16_t, WS_WPOOL), WSP(bf16_t, WS_WOUT),
                 WSP(bf16_t, WS_WUP), WSP(bf16_t, WS_WDOWN), WSP(float, WS_MODP)};
        p0_prologue(P, lds, bid * NWAVES + wave, G * NWAVES, wave, lane);
    }
    SEAM(0);
    if (IN(1)) { KARGS(); IDS();
        const float *b_ada = KIN(3), *norm1_g = KIN(4); const float* MODP = WSP(float, WS_MODP); float* MODF = WSP(float, WS_MODF);
        LAS float* mulv = (LAS float*)lds; LAS float* addv = mulv + 1024;
        for (int i = tid; i < 1024; i += NTHR) { float sh = b_ada[i], scv = b_ada[1024 + i];
#pragma unroll
            for (int kc = 0; kc < 16; ++kc) { sh += MODP[kc * NMOD + i]; scv += MODP[kc * NMOD + 1024 + i]; }
            mulv[i] = norm1_g[i] * (1.0f + scv); addv[i] = sh; }
        if (bid < 24 && tid < 256) { const int i = bid * 256 + tid; float v = b_ada[i];
#pragma unroll
            for (int kc = 0; kc < 16; ++kc) v += MODP[kc * NMOD + i];
            MODF[i] = v; }
        SYNC();
        modulate_rows(KIN(0), WSP(bf16_t, WS_H), mulv, addv, bid * NWAVES + wave, G * NWAVES, lane);
        SYNC();
    }
    SEAM(1);
    for (int rep_ph = 0; rep_ph < ((REP_PH == 2) ? 2 : 1); ++rep_ph) if (IN(2)) { KARGS(); IDS();
        pg8::Gemm g{WSP(bf16_t, WS_H), WSP(bf16_t, WS_WIN), M, NINP, DM}; pg8::StaticOrder S; S.init(M, NINP, G, bid);
        EpiProj E{WSP(bf16_t, WS_Q), WSP(unsigned char, WS_K), WSP(unsigned char, WS_K), WSP(bf16_t, WS_QI), WSP(bf16_t, WS_KI), WSP(bf16_t, WS_UPOOL), WSP(bf16_t, WS_GA), WSP(bf16_t, WS_GP), WSP(float, WS_WI), KIN(6), KIN(7)};
        pg8::gemm_phase<EpiProj, pg8::StaticOrder, true, true>(lds, g, S, E);
    }
    SEAM(2);
    if (IN(3)) { KARGS(); IDS();
        if (bid < 8) {
            pg8::Gemm g{WSP(bf16_t, WS_WPOOL), WSP(bf16_t, WS_WGRP), 1024, PW, PW}; OneUnit S{bid >> 1, bid & 1};
            EpiBf<3> E{WSP(bf16_t, WS_POOLMIX), PW, nullptr, nullptr};
            pg8::gemm_phase<EpiBf<3>, OneUnit, true, true>(lds, g, S, E);
            SYNC();
        }
        pooled_phase(WSP(bf16_t, WS_UPOOL), WSP(bf16_t, WS_POOLED), bid * NTHR + tid, G * NTHR);
        const int lb = bid & 255; const size_t lsto = (lb < 128 ? WS_H : (lb < 192 ? WS_ATTN - 128u * 262144u : WS_V - 192u * 262144u)) + (size_t)lb * 262144u;
        TkPtrs T{WSP(bf16_t, WS_QI), WSP(bf16_t, WS_KI), WSP(float, WS_WI), (unsigned short*)KOUT(), WSP(unsigned char, lsto)};
        unsigned* qctr = (unsigned*)(GAS unsigned*)(ws + WS_CTL) + CW_QUEUE;
        LAS int* qslot = (LAS int*)(lds + ST_OFF + 2040);
#pragma unroll 1
        for (;;) {
            SYNC();
            if (tid == 0) *qslot = (int)__hip_atomic_fetch_add(qctr, 1u, __ATOMIC_RELAXED, __HIP_MEMORY_SCOPE_AGENT);
            SYNC();
            const int qi0 = *qslot;
            const int qi = qi0;
            if (qi >= 512 * (1 + REP_TKONLY)) break;
            topk_attn_block(511 - (qi & 511), T, lds, tid, wave, lane, qi >= 512 * REP_TKONLY);
        }
        SYNC();
    }
    SEAM(3);
    if (IN(4)) { KARGS(); IDS();
        {
        pg8::Gemm g{WSP(bf16_t, WS_POOLED), WSP(bf16_t, WS_POOLMIX), M, DM, PW}; pg8::StaticOrder S; S.init(M, DM, G, bid);
        EpiBf<1> E{WSP(bf16_t, WS_GP), DM, nullptr, nullptr};
        pg8::gemm_phase<EpiBf<1>, pg8::StaticOrder, true, true>(lds, g, S, E);
        }
        SYNC();
        const unsigned short* SEL = (const unsigned short*)KOUT(); const bf16_t* Qp = WSP(bf16_t, WS_Q); const unsigned char *K8 = WSP(unsigned char, WS_K), *V8 = WSP(unsigned char, WS_K); bf16_t* ATTN = WSP(bf16_t, WS_ATTN);
        const bool aff = (G & 7) == 0; const int nitem = 8 * M, step = aff ? (G >> 3) * NWAVES : G * NWAVES;
#pragma unroll 1
        for (int it = aff ? (bid >> 3) * NWAVES + wave : bid * NWAVES + wave; it < (aff ? M : nitem); it += step) attn_item(aff ? it : (it >> 3), aff ? (bid & 7) : (it & 7), SEL, Qp, K8, V8, ATTN, lane);
    }
    SEAM(4);
    if (IN(7)) { KARGS(); IDS();
        pg8::Gemm g{WSP(bf16_t, WS_ATTN), WSP(bf16_t, WS_WATTN), M, DM, AW}; pg8::StaticOrder S; S.init(M, DM, G, bid);
        EpiBf<2> E{WSP(bf16_t, WS_GA), DM, nullptr, WSP(bf16_t, WS_GP)};
        pg8::gemm_phase<EpiBf<2>, pg8::StaticOrder, true, true>(lds, g, S, E);
    }
    SEAM(7);
    for (int rep_ph = 0; rep_ph < ((REP_PH == 8) ? 2 : 1); ++rep_ph) if (IN(8)) { KARGS(); IDS();
        pg8::Gemm g{WSP(bf16_t, WS_GA), WSP(bf16_t, WS_WOUT), M, DM, DM}; pg8::StaticOrder S; S.init(M, DM, G, bid);
        EpiRes E{KIN(0), KOUT(), WSP(float, WS_MODF) + 2048, 0.f};
        pg8::gemm_phase<EpiRes, pg8::StaticOrder, true, true>(lds, g, S, E);
    }
    SEAM(8);
    if (IN(9)) { KARGS(); IDS();
        const float* norm2_g = KIN(13); const float* MODF = WSP(float, WS_MODF);
        LAS float* mulv = (LAS float*)lds; LAS float* addv = mulv + 1024;
        for (int i = tid; i < 1024; i += NTHR) { mulv[i] = norm2_g[i] * (1.0f + MODF[4096 + i]); addv[i] = MODF[3072 + i]; }
        SYNC();
        modulate_rows(KOUT(), WSP(bf16_t, WS_H), mulv, addv, bid * NWAVES + wave, G * NWAVES, lane);
        SYNC();
    }
    SEAM(9);
    for (int rep_ph = 0; rep_ph < ((REP_PH == 10) ? 2 : 1); ++rep_ph) if (IN(10)) { KARGS(); IDS();
        pg8::Gemm g{WSP(bf16_t, WS_H), WSP(bf16_t, WS_WUP), M, FF2, DM}; pg8::StaticOrder S; S.init(M, FF2, G, bid);
        EpiUpAct E{WSP(bf16_t, WS_ACT), WSP(float, WS_RAW), KIN(15), KIN(16)};
        pg8::gemm_phase<EpiUpAct, pg8::StaticOrder, true, true>(lds, g, S, E);
    }
    SEAM(10);
    if (IN(11)) { KARGS(); IDS(); fixup_phase(WSP(float, WS_RAW), WSP(bf16_t, WS_ACT), KIN(15), KIN(16), bid * NTHR + tid, G * NTHR); }
    SEAM(11);
    if (IN(12)) { KARGS(); IDS();
        pg8::Gemm g{WSP(bf16_t, WS_ACT), WSP(bf16_t, WS_WDOWN), M, DM, FF}; pg8::StaticOrder S; S.init(M, DM, G, bid);
        EpiRes E{KOUT(), KOUT(), WSP(float, WS_MODF) + 5120, DBG_C};
        pg8::gemm_phase<EpiRes, pg8::StaticOrder, true, true>(lds, g, S, E);
    }
#undef IN
#undef SEAM
}

extern "C" void kernel_launch(void* const* d_in, const int* in_sizes, int n_in, void* d_out, int out_size, void* d_ws, size_t ws_size, hipStream_t stream) {
    static int grid = 0;
    if (grid == 0) {
        if (n_in != 18 || in_sizes[0] != M * DM || out_size != M * DM || ws_size < WS_END) { fprintf(stderr, "kernel_launch: unexpected shapes (n_in %d, in0 %d, out %d, ws %zu)\n", n_in, n_in > 0 ? in_sizes[0] : -1, out_size, ws_size); grid = -1; return; }
        int dev = 0, cus = 0, per_cu = 0;
        if (hipGetDevice(&dev) != hipSuccess || hipDeviceGetAttribute(&cus, hipDeviceAttributeMultiprocessorCount, dev) != hipSuccess) { grid = -1; return; }
        if (hipFuncSetAttribute((const void*)fwd_kernel, hipFuncAttributeMaxDynamicSharedMemorySize, LDS_BYTES) != hipSuccess) { fprintf(stderr, "kernel_launch: hipFuncSetAttribute failed\n"); grid = -1; return; }
        if (hipOccupancyMaxActiveBlocksPerMultiprocessor(&per_cu, (const void*)fwd_kernel, NTHR, LDS_BYTES) != hipSuccess || per_cu < 1) fprintf(stderr, "kernel_launch: occupancy query says %d\n", per_cu);
        (void)hipGetLastError();
        grid = cus;
    }
    if (grid < 0) return;
    (void)hipMemsetAsync((char*)d_ws + WS_CTL, 0, CTL_ZERO_BYTES, stream);
    Args a{};
    for (int i = 0; i < 18; ++i) a.in[i] = (const float*)d_in[i];
    a.out = (float*)d_out; a.ws = (unsigned char*)d_ws;
#if N_LAUNCH_MODE == 1
    a.ph_lo = 0; a.ph_hi = NPH;
    hipLaunchKernelGGL(fwd_kernel, dim3(grid), dim3(NTHR), LDS_BYTES, stream, a);
#else
    for (int p = 0; p < NPH; ++p) { a.ph_lo = p; a.ph_hi = p + 1; hipLaunchKernelGGL(fwd_kernel, dim3(grid), dim3(NTHR), LDS_BYTES, stream, a); }
#endif
}
```

```cpp
#include <hip/hip_runtime.h>
#include <cstdio>
#include <cstdint>
#ifndef REP_TKONLY
#define REP_TKONLY 0
#endif
#ifndef REP_BLK
#define REP_BLK 1
#endif
namespace pg8 {
#define PG8_LAS __attribute__((address_space(3)))
typedef unsigned short bf16_t;
typedef short bf16x8 __attribute__((ext_vector_type(8)));
typedef float f32x4 __attribute__((ext_vector_type(4)));
typedef unsigned u32x4 __attribute__((ext_vector_type(4)));
constexpr int BM = 256, BK = 64, HALF = 128, HTB = HALF * BK * 2  , STAGE_BYTES = 8 * HTB, NXCD = 8, WGM = 8;

__host__ __device__ __forceinline__ int lds_byte(int r, int c) { const int st = (r >> 4) * 2 + (c >> 5), rr = r & 15, cc = c & 31, ob = rr * 64 + cc * 2; return st * 1024 + (ob ^ (((ob >> 9) & 1) << 5)); }
__host__ __device__ __forceinline__ void stage_rc(int b, int& R, int& C) { const int st = b / 1024, sb = b % 1024, swz = sb ^ (((sb >> 9) & 1) << 5); R = (st >> 1) * 16 + swz / 64; C = (st & 1) * 32 + (swz % 64) / 2; }
__host__ __device__ __forceinline__ int perm32(int rho) { const int n = rho >> 4, i = rho & 15; return 8 * (i >> 2) + 4 * n + (i & 3); }

struct Unit { int pm, pn; };
struct Gemm { const bf16_t* A; const bf16_t* Bt; int M, N, K; };

struct StaticOrder {
    int nM, nN, nwg, G, c;
    __host__ __device__ void init(int M, int N, int G_, int c_) { nM = M / BM; nN = N / BM; nwg = nM * nN; G = G_; c = c_; }
    __host__ __device__ bool next(int i, Unit& u) const {
        const long L = (long)i * G + c; if (L >= nwg) return false;
        int wgid = (int)L; { const int q = nwg / NXCD, r = nwg % NXCD, xcd = wgid % NXCD, off = wgid / NXCD; wgid = (xcd < r ? xcd * (q + 1) : r * (q + 1) + (xcd - r) * q) + off; }
        const int nig = WGM * nN, gid = wgid / nig, fm = gid * WGM, gsz = (nM - fm) < WGM ? (nM - fm) : WGM;
        u.pm = fm + ((wgid % nig) % gsz); u.pn = (wgid % nig) / gsz; return true;
    }
    __device__ __forceinline__ void a_ready(const Unit&) const {}
    __device__ __forceinline__ void done(const Unit&) const {}
};

__device__ __forceinline__ unsigned cvt_pk_bf16(float lo, float hi) { unsigned r; asm volatile("v_cvt_pk_bf16_f32 %0, %1, %2" : "=v"(r) : "v"(lo), "v"(hi)); return r; }
template <class Epi, class Sched, bool ALIGN_EPI = false, bool SP2 = false>
__device__ __forceinline__ void gemm_phase(PG8_LAS unsigned char* lds, const Gemm g, const Sched& S, const Epi& E) {
    int tid_ = threadIdx.x; asm volatile("" : "+v"(tid_));
    const int tid = tid_, wid = __builtin_amdgcn_readfirstlane(tid >> 6), lane = tid & 63, wr = wid >> 2, wc = wid & 3, fr = lane & 15, fq = lane >> 4;
    const int K = g.K, nt = K / BK;
    unsigned voffA[2], voffB[2];
#pragma unroll
    for (int i = 0; i < 2; ++i) { int R, C; stage_rc(tid * 16 + i * 8192, R, C); const int Rb = Epi::PERM ? ((R & ~31) + perm32(R & 31)) : R;
        voffA[i] = (unsigned)(R * K + C) * 2u; voffB[i] = (unsigned)(Rb * K + C) * 2u; }
    const size_t kstep = (size_t)(BK * 2);
    const size_t hstep = (size_t)HALF * K * 2;
    const size_t tstep = 2 * hstep;
    const unsigned ldsw = (unsigned)wid * 1024u;
    const int aoff = lds_byte(wr * 64 + fr, fq * 8), boff = lds_byte(wc * 32 + fr, fq * 8);
#define PG8_SA(b, h) (((b) * 2 + (h)) * HTB)
#define PG8_SB(b, h) ((4 + (b) * 2 + (h)) * HTB)
#define PG8_STAGE(bufoff, gbase, voff) do { _Pragma("unroll") for (int _i = 0; _i < 2; ++_i) \
        __builtin_amdgcn_global_load_lds((const unsigned*)((const char*)(gbase) + (voff)[_i]), (PG8_LAS unsigned*)(lds + (bufoff) + ldsw + _i * 8192), 16, 0, 0); } while (0)
#define PG8_LDA(dst, b, h) do { _Pragma("unroll") for (int m = 0; m < 4; ++m) _Pragma("unroll") for (int k = 0; k < 2; ++k) dst[m][k] = *(const PG8_LAS bf16x8*)(lds + PG8_SA(b, h) + aoff + m * 2048 + k * 1024); } while (0)
#define PG8_LDB(dst, b, h) do { _Pragma("unroll") for (int n = 0; n < 2; ++n) _Pragma("unroll") for (int k = 0; k < 2; ++k) dst[n][k] = *(const PG8_LAS bf16x8*)(lds + PG8_SB(b, h) + boff + n * 2048 + k * 1024); } while (0)
#define PG8_MMA(ai, bj, At, Bt) do { __builtin_amdgcn_s_setprio(1); _Pragma("unroll") for (int m = 0; m < 4; ++m) _Pragma("unroll") for (int n = 0; n < 2; ++n) _Pragma("unroll") for (int k = 0; k < 2; ++k) \
        acc[ai][bj][m][n] = __builtin_amdgcn_mfma_f32_16x16x32_bf16(Bt[n][k], At[m][k], acc[ai][bj][m][n], 0, 0, 0); __builtin_amdgcn_s_setprio(0); } while (0)
#define PG8_WAIT_V(n) asm volatile("s_waitcnt vmcnt(" #n ")" ::: "memory")
#define PG8_WAIT_L(n) asm volatile("s_waitcnt lgkmcnt(" #n ")" ::: "memory")
#define PG8_BAR __builtin_amdgcn_s_barrier()
#define PG8_SCHED __builtin_amdgcn_sched_barrier(0)
    Unit cur, nxt; int ui = 0;
    if (!S.next(0, cur)) return;
    f32x4 acc[2][2][4][2];
#pragma unroll
    for (int a = 0; a < 2; ++a)
#pragma unroll
        for (int b = 0; b < 2; ++b)
#pragma unroll
            for (int m = 0; m < 4; ++m)
#pragma unroll
                for (int n = 0; n < 2; ++n) acc[a][b][m][n] = (f32x4){0.f, 0.f, 0.f, 0.f};
    bf16x8 At[4][2], B0[2][2], B1[2][2];
    const char* cA = (const char*)g.A + (size_t)cur.pm * tstep; const char* cB = (const char*)g.Bt + (size_t)cur.pn * tstep;
    S.a_ready(cur);
    if constexpr (SP2) {
        PG8_STAGE(PG8_SB(0, 0), cB, voffB); PG8_STAGE(PG8_SB(0, 1), cB + hstep, voffB); PG8_STAGE(PG8_SA(0, 0), cA, voffA); PG8_STAGE(PG8_SA(0, 1), cA + hstep, voffA);
        if (wr == 1) PG8_BAR;
        PG8_WAIT_V(2); PG8_BAR;
        PG8_STAGE(PG8_SB(1, 0), cB + kstep, voffB); PG8_STAGE(PG8_SA(1, 0), cA + kstep, voffA); PG8_STAGE(PG8_SB(1, 1), cB + hstep + kstep, voffB);
        PG8_WAIT_V(6); PG8_BAR;
    } else {
        PG8_STAGE(PG8_SB(0, 0), cB, voffB); PG8_STAGE(PG8_SA(0, 0), cA, voffA); PG8_STAGE(PG8_SB(0, 1), cB + hstep, voffB); PG8_STAGE(PG8_SA(0, 1), cA + hstep, voffA);
        if (wr == 1) PG8_BAR;
        PG8_WAIT_V(4); PG8_BAR;
        PG8_STAGE(PG8_SB(1, 0), cB + kstep, voffB); PG8_STAGE(PG8_SA(1, 0), cA + kstep, voffA); PG8_STAGE(PG8_SB(1, 1), cB + hstep + kstep, voffB);
        PG8_WAIT_V(6); PG8_BAR;
    }
    for (;;) {
        const bool has_next = S.next(ui + 1, nxt);
        const char* nA = has_next ? (const char*)g.A + (size_t)nxt.pm * tstep : cA; const char* nB = has_next ? (const char*)g.Bt + (size_t)nxt.pn * tstep : cB;
        for (int t = 0; t < nt; t += 2) {
            const bool last = (t == nt - 2);
            const char* a1 = cA + (size_t)(t + 1) * kstep;
            const char* a2 = last ? nA : cA + (size_t)(t + 2) * kstep; const char* b2 = last ? nB : cB + (size_t)(t + 2) * kstep;
            const char* a3 = a2 + kstep; const char* b3 = b2 + kstep;
            if (last && has_next) S.a_ready(nxt);
            if constexpr (SP2) {
            PG8_LDB(B0, 0, 0); PG8_LDB(B1, 0, 1); PG8_SCHED; PG8_LDA(At, 0, 0); PG8_STAGE(PG8_SA(1, 1), a1 + hstep, voffA);
            PG8_WAIT_V(8); PG8_WAIT_L(0); PG8_BAR; PG8_MMA(0, 0, At, B0); PG8_MMA(0, 1, At, B1); PG8_BAR; PG8_SCHED;
            PG8_LDA(At, 0, 1); PG8_STAGE(PG8_SB(0, 0), b2, voffB); PG8_STAGE(PG8_SB(0, 1), b2 + hstep, voffB); PG8_STAGE(PG8_SA(0, 0), a2, voffA);
            PG8_WAIT_V(8); PG8_WAIT_L(0); PG8_BAR; PG8_MMA(1, 0, At, B0); PG8_MMA(1, 1, At, B1); PG8_BAR; PG8_SCHED;
            PG8_LDB(B0, 1, 0); PG8_LDB(B1, 1, 1); PG8_SCHED; PG8_LDA(At, 1, 0); PG8_STAGE(PG8_SA(0, 1), a2 + hstep, voffA);
            PG8_WAIT_V(8); PG8_WAIT_L(0); PG8_BAR; PG8_MMA(0, 0, At, B0); PG8_MMA(0, 1, At, B1); PG8_BAR; PG8_SCHED;
            PG8_LDA(At, 1, 1); PG8_STAGE(PG8_SB(1, 0), b3, voffB); PG8_STAGE(PG8_SB(1, 1), b3 + hstep, voffB); PG8_STAGE(PG8_SA(1, 0), a3, voffA);
            PG8_WAIT_V(8); PG8_WAIT_L(0); PG8_BAR; PG8_MMA(1, 0, At, B0); PG8_MMA(1, 1, At, B1); PG8_BAR; PG8_SCHED;
            } else {
            PG8_LDB(B0, 0, 0); PG8_SCHED; PG8_LDA(At, 0, 0); PG8_STAGE(PG8_SA(1, 1), a1 + hstep, voffA);
            PG8_WAIT_L(8); PG8_BAR; PG8_WAIT_L(0); PG8_MMA(0, 0, At, B0); PG8_BAR; PG8_SCHED;
            PG8_LDB(B1, 0, 1); PG8_STAGE(PG8_SB(0, 0), b2, voffB);
            PG8_BAR; PG8_WAIT_L(0); PG8_MMA(0, 1, At, B1); PG8_BAR;
            PG8_LDA(At, 0, 1); PG8_STAGE(PG8_SA(0, 0), a2, voffA);
            PG8_BAR; PG8_WAIT_L(0); PG8_MMA(1, 0, At, B0); PG8_BAR; PG8_SCHED;
            PG8_STAGE(PG8_SB(0, 1), b2 + hstep, voffB);
            PG8_WAIT_V(6); PG8_BAR; PG8_MMA(1, 1, At, B1); PG8_BAR;
            PG8_LDB(B0, 1, 0); PG8_SCHED; PG8_LDA(At, 1, 0); PG8_STAGE(PG8_SA(0, 1), a2 + hstep, voffA);
            PG8_WAIT_L(8); PG8_BAR; PG8_WAIT_L(0); PG8_MMA(0, 0, At, B0); PG8_BAR; PG8_SCHED;
            PG8_LDB(B1, 1, 1); PG8_STAGE(PG8_SB(1, 0), b3, voffB);
            PG8_BAR; PG8_WAIT_L(0); PG8_MMA(0, 1, At, B1); PG8_BAR;
            PG8_LDA(At, 1, 1); PG8_STAGE(PG8_SA(1, 0), a3, voffA);
            PG8_BAR; PG8_WAIT_L(0); PG8_MMA(1, 0, At, B0); PG8_BAR; PG8_SCHED;
            PG8_STAGE(PG8_SB(1, 1), b3 + hstep, voffB);
            PG8_WAIT_V(6); PG8_BAR; PG8_MMA(1, 1, At, B1); PG8_BAR;
            }
        }
        if constexpr (ALIGN_EPI) { if (wr == 0) PG8_BAR; }
        if constexpr (!Epi::AFTER_DRAIN) { E(acc, cur, wr, wc, fr, fq); S.done(cur); }
        if (!has_next) break;
#pragma unroll
        for (int a = 0; a < 2; ++a)
#pragma unroll
            for (int b = 0; b < 2; ++b)
#pragma unroll
                for (int m = 0; m < 4; ++m)
#pragma unroll
                    for (int n = 0; n < 2; ++n) acc[a][b][m][n] = (f32x4){0.f, 0.f, 0.f, 0.f};
        cur = nxt; cA = nA; cB = nB; ++ui;
        if constexpr (ALIGN_EPI) { if (wr == 1) PG8_BAR; }
    }
    PG8_WAIT_V(0);
    if constexpr (!ALIGN_EPI) { if (wr == 0) PG8_BAR; }
    PG8_BAR;
    if constexpr (Epi::AFTER_DRAIN) { E.fused(acc, cur, wr, wc, fr, fq, lds, wid, lane); S.done(cur); }
#undef PG8_SA
#undef PG8_SB
#undef PG8_STAGE
#undef PG8_LDA
#undef PG8_LDB
#undef PG8_MMA
#undef PG8_WAIT_V
#undef PG8_WAIT_L
#undef PG8_BAR
#undef PG8_SCHED
}
}
#define GAS __attribute__((address_space(1)))
#define LAS __attribute__((address_space(3)))
typedef unsigned short bf16;
typedef unsigned v4u __attribute__((ext_vector_type(4)));
typedef float f32x4 __attribute__((ext_vector_type(4)));
typedef short bf16x8 __attribute__((ext_vector_type(8)));
typedef GAS unsigned gu32;
typedef GAS unsigned long long gu64;
#define RLX_AGENT __ATOMIC_RELAXED, __HIP_MEMORY_SCOPE_AGENT
#define LDS_WAIT() asm volatile("s_waitcnt lgkmcnt(0)" ::: "memory")
#define VM_WAIT() asm volatile("s_waitcnt vmcnt(0)" ::: "memory")
__device__ __forceinline__ unsigned long long rt() { return __builtin_amdgcn_s_memrealtime(); }
__device__ __forceinline__ unsigned f2bf(float f) { unsigned u = __builtin_bit_cast(unsigned, f); return (u + 0x7fffu + ((u >> 16) & 1u)) >> 16; }
__device__ __forceinline__ unsigned pk2(float lo, float hi) { return f2bf(lo) | (f2bf(hi) << 16); }

#define XB_TMO      128
#define XB_XCNT(j)  (256  + 64 * (j))
#define XB_XSUB(j)  (1280 + 64 * (j))
#define XB_XGEN(j)  (2304 + 64 * (j))
#define XB_TOP      3328
#define XB_TOPGEN   3392
#define XCD_BAR_WORDS 3456
#define XB_SPIN_CAP (1u << 18)

__device__ __forceinline__ unsigned xb_ld(unsigned* p)              { return __hip_atomic_load(p, __ATOMIC_RELAXED, __HIP_MEMORY_SCOPE_AGENT); }
__device__ __forceinline__ unsigned xb_add(unsigned* p, unsigned v) { return __hip_atomic_fetch_add(p, v, __ATOMIC_RELAXED, __HIP_MEMORY_SCOPE_AGENT); }
__device__ __forceinline__ unsigned xb_xcc_id() { return (unsigned)__builtin_amdgcn_s_getreg((3 << 11) | 20) & 0xFu; }
#define XB_SPIN(cond, bar) do { unsigned _sp = 0; while (cond) { __builtin_amdgcn_s_sleep(1); \
    if ((++_sp & 255u) == 0u) { if (xb_ld(&(bar)[XB_TMO])) break; if (_sp > XB_SPIN_CAP) { atomicAdd(&(bar)[XB_TMO], 1u); break; } } } } while (0)

struct XcdBarrier {
    unsigned* bar; unsigned x;
    volatile LAS unsigned* st;
};

__device__ __forceinline__ XcdBarrier xcd_barrier_post(unsigned* bar, volatile LAS unsigned* st) {
    XcdBarrier b; b.bar = bar; b.x = xb_xcc_id(); b.st = st;
    if (threadIdx.x == 0) (void)xb_add(&bar[XB_XCNT(b.x)], 1u);
    return b;
}
__device__ __forceinline__ void xcd_barrier_complete(unsigned* bar, unsigned x, unsigned& nloc, unsigned& nx) {
    const unsigned G = gridDim.x * gridDim.y * gridDim.z;
    unsigned sum, cnt, mine, sp = 0u;
    for (;;) {
        sum = 0u; cnt = 0u; mine = 0u;
#pragma unroll
        for (unsigned j = 0; j < 16; ++j) { const unsigned c = xb_ld(&bar[XB_XCNT(j)]); sum += c; cnt += (c > 0u) ? 1u : 0u; mine = (j == x) ? c : mine; }
        if (sum == G) break;
        __builtin_amdgcn_s_sleep(1);
        if ((++sp & 255u) == 0u) { if (xb_ld(&bar[XB_TMO])) break; if (sp > XB_SPIN_CAP) { atomicAdd(&bar[XB_TMO], 1u); break; } }
    }
    nloc = mine > 0u ? mine : 1u; nx = cnt > 0u ? cnt : 1u;
}

__device__ __forceinline__ void xcd_barrier(const XcdBarrier& b) {
    asm volatile("s_waitcnt vmcnt(0)" ::: "memory");
    __syncthreads();
    if (threadIdx.x == 0) {
        unsigned* bar = b.bar;
        __builtin_amdgcn_s_waitcnt(0);
        unsigned nloc = b.st[0], nx = b.st[1];
        if (nloc == 0u) { xcd_barrier_complete(bar, b.x, nloc, nx); b.st[0] = nloc; b.st[1] = nx; }
        const unsigned old = xb_add(&bar[XB_XSUB(b.x)], 1u);
        const unsigned gen = old / nloc;
        if (old + 1u == (gen + 1u) * nloc) {
            __builtin_amdgcn_fence(__ATOMIC_RELEASE, "agent");
            asm volatile("s_waitcnt vmcnt(0)" ::: "memory");
            const unsigned og = xb_add(&bar[XB_TOP], 1u);
            const unsigned tg = og / nx;
            if (og + 1u == (tg + 1u) * nx) xb_add(&bar[XB_TOPGEN], 1u);
            else XB_SPIN(xb_ld(&bar[XB_TOPGEN]) == tg, bar);
            __builtin_amdgcn_fence(__ATOMIC_ACQUIRE, "agent");
            xb_add(&bar[XB_XGEN(b.x)], 1u);
            asm volatile("s_waitcnt vmcnt(0)" ::: "memory");
        } else {
            XB_SPIN(xb_ld(&bar[XB_XGEN(b.x)]) == gen, bar);
            __builtin_amdgcn_fence(__ATOMIC_ACQUIRE, "agent");
            asm volatile("s_waitcnt vmcnt(0)" ::: "memory");
        }
    }
    __syncthreads();
}


#ifndef STAGE
#define STAGE 3
#endif
#ifndef N_LAUNCH_MODE
#define N_LAUNCH_MODE 1
#endif
#ifndef REP_TK
#define REP_TK 1
#endif
#ifndef REP_AT
#define REP_AT 1
#endif
#ifndef REP_PH
#define REP_PH -1
#endif
#ifndef TK_PREFETCH
#define TK_PREFETCH 1
#endif
#ifndef DBG_C
#define DBG_C 0.0f
#endif

typedef float f32x16 __attribute__((ext_vector_type(16)));
typedef __attribute__((ext_vector_type(2))) __bf16 bf16x2_t;
using pg8::bf16_t; using pg8::Unit;

constexpr int M = 16384, DM = 1024, NHEAD = 8, HD = 64, AW = 512, PW = 512, FF = 2816, FF2 = 5632, NIN = 4420, NINP = 4608, NMOD = 6144;
constexpr float EPS = 1e-6f;
constexpr int NWAVES = 8, NTHR = 512;

constexpr size_t MiB = 1u << 20;
constexpr size_t WS_CTL = 0, CTL_ZERO_BYTES = 64 * 1024;
constexpr size_t WS_WIN = 1 * MiB, WS_WATTN = 10 * MiB, WS_WGRP = 11 * MiB, WS_WPOOL = 11 * MiB + 512 * 1024, WS_WOUT = 12 * MiB + 512 * 1024,
                 WS_WUP = 14 * MiB + 512 * 1024, WS_WDOWN = 25 * MiB + 512 * 1024;
constexpr size_t WS_MODP = 31 * MiB, WS_MODF = 31 * MiB + 393216, WS_WI = 31 * MiB + 512 * 1024;
constexpr size_t WS_H = 32 * MiB;
constexpr size_t WS_Q = 64 * MiB, WS_K = 80 * MiB, WS_V = 96 * MiB;
constexpr size_t WS_SEL = 88 * MiB;
constexpr size_t WS_QI = 112 * MiB, WS_KI = 120 * MiB;
constexpr size_t WS_UPOOL = 128 * MiB, WS_POOLED = 144 * MiB, WS_POOLMIX = 160 * MiB, WS_ATTN = 176 * MiB;
constexpr size_t WS_GA = 192 * MiB, WS_GP = 224 * MiB;
constexpr size_t WS_ACT = 64 * MiB;
constexpr size_t WS_RAW = 152 * MiB;
constexpr size_t WS_END = 256 * MiB;
constexpr int CW_BAR = 1024, CW_QUEUE = 512;

constexpr int LDS_BYTES = 163840;
constexpr int HSTRIDE = 1025, MSTRIDE = 513;
constexpr int LIST_OFF = 135168, ST_OFF = 151552, MISC_OFF = 159744;

#define SYNC() __syncthreads()
__device__ __forceinline__ float wave_sum(float v) {
#pragma unroll
    for (int o = 1; o < 64; o <<= 1) v += __shfl_xor(v, o);
    return v;
}
__device__ __forceinline__ float bf_lo(unsigned w) { return __builtin_bit_cast(float, w << 16); }
__device__ __forceinline__ float bf_hi(unsigned w) { return __builtin_bit_cast(float, w & 0xffff0000u); }
__device__ __forceinline__ float sigmoidf_(float x) { return __builtin_amdgcn_rcpf(1.0f + __expf(-x)); }
__device__ __forceinline__ unsigned pkbf(float lo, float hi) { return pg8::cvt_pk_bf16(lo, hi); }
typedef unsigned u32x2 __attribute__((ext_vector_type(2)));
__device__ __forceinline__ u32x2 pk4(f32x4 v) { u32x2 r; r.x = pkbf(v[0], v[1]); r.y = pkbf(v[2], v[3]); return r; }
__device__ __forceinline__ unsigned pk4_fp8(f32x4 v) { int w = 0; w = __builtin_amdgcn_cvt_pk_fp8_f32(v[0], v[1], w, false); w = __builtin_amdgcn_cvt_pk_fp8_f32(v[2], v[3], w, true); return (unsigned)w; }

__device__ __forceinline__ void tr_item(const float* W, int ldw, int src_col, int nvalid, int k0, bf16_t* WT, int K, int dst_row, LAS float* scr, int lane) {
    f32x4 v[8];
#pragma unroll
    for (int i = 0; i < 8; ++i) { const int kk = 8 * i + (lane >> 3), n4 = 4 * (lane & 7);
        v[i] = (f32x4){0.f, 0.f, 0.f, 0.f}; if (W != nullptr && n4 < nvalid) v[i] = *(const f32x4*)(W + (size_t)(k0 + kk) * ldw + src_col + n4); }
#pragma unroll
    for (int i = 0; i < 8; ++i) { const int kk = 8 * i + (lane >> 3), n4 = 4 * (lane & 7); LAS float* p = scr + kk * 33 + n4; p[0] = v[i][0]; p[1] = v[i][1]; p[2] = v[i][2]; p[3] = v[i][3]; }
    LDS_WAIT(); asm volatile("" ::: "memory");
    const int c = lane & 7;
#pragma unroll
    for (int j = 0; j < 4; ++j) { const int n = (lane >> 3) + 8 * j; const LAS float* s = scr + (8 * c) * 33 + n;
        v4u o; o.x = pk2(s[0 * 33], s[1 * 33]); o.y = pk2(s[2 * 33], s[3 * 33]); o.z = pk2(s[4 * 33], s[5 * 33]); o.w = pk2(s[6 * 33], s[7 * 33]);
        *(GAS v4u*)(WT + (size_t)(dst_row + n) * K + k0 + 8 * c) = o; }
    LDS_WAIT(); asm volatile("" ::: "memory");
}

struct P0Ptrs { const float *c, *w_ada, *w_in, *w_attn, *w_grp, *w_pool, *w_out, *w_up, *w_down, *pscale; bf16_t *WIN, *WATTN, *WGRP, *WPOOL, *WOUT, *WUP, *WDOWN; float* MODP; };
__device__ __forceinline__ void p0_prologue(const P0Ptrs& P, LAS unsigned char* lds, int gw, int NGW, int wave, int lane) {
    LAS float* scr = (LAS float*)(lds + wave * 16384);
    LAS float* sil = (LAS float*)(lds + 131072);
    for (int i = threadIdx.x; i < 1024; i += NTHR) { const float cv = P.c[i]; sil[i] = cv / (1.0f + __expf(-cv)); }
    SYNC();
    constexpr int I_WIN = 144 * 16, I_WATTN = 32 * 8, I_WGRP = 128, I_WPOOL = 32 * 8, I_WOUT = 32 * 16, I_WUP = 176 * 16, I_WDOWN = 32 * 44, I_MOD = 96 * 16;
    constexpr int NITEMS = I_WIN + I_WATTN + I_WGRP + I_WPOOL + I_WOUT + I_WUP + I_WDOWN + I_MOD;
    for (int it = gw; it < NITEMS; it += NGW) {
        int r = it;
        if (r < I_MOD) {
            const int cb = r % 96, kc = r / 96, col = cb * 64 + lane; float acc = 0.f;
#pragma unroll 8
            for (int i = 0; i < 64; ++i) { const int k = kc * 64 + i; acc = fmaf(sil[k], P.w_ada[(size_t)k * NMOD + col], acc); }
            P.MODP[kc * NMOD + col] = acc; continue; }
        r -= I_MOD;
        if (r < I_WIN) { const int g = r / 16, kb = r % 16, tile = g >> 3, gi = g & 7; int src = -1, nv = 32;
            const int permgi = gi < 4 ? 64 * gi : 64 * (gi - 4) + 32;
            if (tile < 2) src = tile * 256 + permgi;
            else if (tile < 4) src = 512 + (tile - 2) * 256 + permgi;
            else if (tile < 6) src = 1024 + (tile - 4) * 256 + 32 * gi;
            else if (tile == 6) src = 1536 + 32 * gi;
            else if (tile == 7) { if (gi < 2) src = 1792 + 32 * gi; else if (gi == 2) { src = 1856; nv = 4; } }
            else if (tile < 10) src = 1860 + (tile - 8) * 256 + 32 * gi;
            else if (tile < 14) src = 2372 + (tile - 10) * 256 + 32 * gi;
            else src = 3396 + (tile - 14) * 256 + 32 * gi;
            tr_item(src >= 0 ? P.w_in : nullptr, NIN, src >= 0 ? src : 0, nv, kb * 64, P.WIN, 1024, g * 32, scr, lane); continue; }
        r -= I_WIN;
        if (r < I_WATTN) { tr_item(P.w_attn, 1024, (r / 8) * 32, 32, (r % 8) * 64, P.WATTN, 512, (r / 8) * 32, scr, lane); continue; }
        r -= I_WATTN;
        if (r < I_WGRP) {
            const int row = 4 * r + (lane >> 4), g = row >> 7; const float* src = P.w_grp + (size_t)g * 16384 + (size_t)(row & 127) * 128;
#pragma unroll
            for (int q = 0; q < 4; ++q) { const int d0 = 32 * (lane & 15) + 8 * q; v4u o = (v4u){0u, 0u, 0u, 0u};
                if ((d0 >> 7) == g) { const f32x4 a = *(const f32x4*)(src + (d0 & 127)) * *(const f32x4*)(P.pscale + d0), b = *(const f32x4*)(src + (d0 & 127) + 4) * *(const f32x4*)(P.pscale + d0 + 4);
                    o.x = pk2(a[0], a[1]); o.y = pk2(a[2], a[3]); o.z = pk2(b[0], b[1]); o.w = pk2(b[2], b[3]); }
                *(GAS v4u*)(P.WGRP + (size_t)row * 512 + d0) = o; }
            continue; }
        r -= I_WGRP;
        if (r < I_WPOOL) { tr_item(P.w_pool, 1024, (r / 8) * 32, 32, (r % 8) * 64, P.WPOOL, 512, (r / 8) * 32, scr, lane); continue; }
        r -= I_WPOOL;
        if (r < I_WOUT) { tr_item(P.w_out, 1024, (r / 16) * 32, 32, (r % 16) * 64, P.WOUT, 1024, (r / 16) * 32, scr, lane); continue; }
        r -= I_WOUT;
        if (r < I_WUP) { const int g = r / 16, kb = r % 16, tile = g >> 3, gi = g & 7;
            const int src = gi < 4 ? 128 * tile + 32 * gi : FF + 128 * tile + 32 * (gi - 4);
            tr_item(P.w_up, FF2, src, 32, kb * 64, P.WUP, 1024, g * 32, scr, lane); continue; }
        r -= I_WUP;
        { tr_item(P.w_down, 1024, (r / 44) * 32, 32, (r % 44) * 64, P.WDOWN, FF, (r / 44) * 32, scr, lane); }
    }
}

__device__ __forceinline__ void modulate_rows(const float* X, bf16_t* O, const LAS float* mulv, const LAS float* addv, int gw, int NGW, int lane) {
    f32x4 mu[4], ad[4];
#pragma unroll
    for (int j = 0; j < 4; ++j) { mu[j] = *(const LAS f32x4*)(mulv + 4 * lane + 256 * j); ad[j] = *(const LAS f32x4*)(addv + 4 * lane + 256 * j); }
    for (int row = gw; row < M; row += NGW) {
        const GAS f32x4* xr = (const GAS f32x4*)(X + (size_t)row * DM) + lane;
        f32x4 v[4]; float s = 0.f;
#pragma unroll
        for (int j = 0; j < 4; ++j) { v[j] = xr[64 * j]; s += (v[j].x * v[j].x + v[j].y * v[j].y) + (v[j].z * v[j].z + v[j].w * v[j].w); }
        const float rstd = 1.0f / sqrtf(wave_sum(s) * (1.0f / DM) + EPS);
        GAS u32x2* o8 = (GAS u32x2*)(O + (size_t)row * DM) + lane;
#pragma unroll
        for (int j = 0; j < 4; ++j) { const f32x4 y = v[j] * rstd * mu[j] + ad[j]; o8[64 * j] = pk4(y); }
    }
}

struct EpiProj {
    static constexpr bool PERM = false, AFTER_DRAIN = false;
    bf16_t *Q; unsigned char *K8, *V8; bf16_t *QI, *KI, *UPOOL, *GA, *GP; float* WI; const float *qg, *kg;
    __device__ __forceinline__ void operator()(const pg8::f32x4 (&acc)[2][2][4][2], const Unit& u, int wr, int wc, int fr, int fq) const {
        const int pn = u.pn, row0 = u.pm * 256 + wr * 64 + fr;
        if (pn < 4) {
            const bool isq = pn < 2; const float* g = isq ? qg : kg; const int head = (pn & 1) * 4 + wc;
            f32x4 gv[2][2];
#pragma unroll
            for (int bj = 0; bj < 2; ++bj)
#pragma unroll
                for (int n = 0; n < 2; ++n) gv[bj][n] = *(const f32x4*)(g + 32 * bj + 16 * n + 4 * fq);
#pragma unroll
            for (int ai = 0; ai < 2; ++ai)
#pragma unroll
                for (int m = 0; m < 4; ++m) {
                    float ss = 0.f;
#pragma unroll
                    for (int bj = 0; bj < 2; ++bj)
#pragma unroll
                        for (int n = 0; n < 2; ++n) { const f32x4 x = acc[ai][bj][m][n]; ss += (x[0] * x[0] + x[1] * x[1]) + (x[2] * x[2] + x[3] * x[3]); }
                    ss += __shfl_xor(ss, 16); ss += __shfl_xor(ss, 32);
                    const float rstd = 1.0f / sqrtf(ss * (1.0f / 64.0f) + EPS);
                    const size_t ro = (size_t)(row0 + ai * 128 + m * 16) * AW + head * 64 + 4 * fq;
#pragma unroll
                    for (int bj = 0; bj < 2; ++bj)
#pragma unroll
                        for (int n = 0; n < 2; ++n) { const f32x4 y = acc[ai][bj][m][n] * rstd * gv[bj][n];
                            if (isq) *(u32x2*)(Q + ro + 32 * bj + 16 * n) = pk4(y); else *(unsigned*)(K8 + ((size_t)head * M + (row0 + ai * 128 + m * 16)) * 128 + 4 * fq + 32 * bj + 16 * n) = pk4_fp8(y); }
                }
            return;
        }
        const int colw = wc * 32 + 4 * fq;
        if (pn == 7) {
#pragma unroll
            for (int ai = 0; ai < 2; ++ai)
#pragma unroll
                for (int m = 0; m < 4; ++m) { const int row = row0 + ai * 128 + m * 16;
                    if (wc < 2) {
#pragma unroll
                        for (int n = 0; n < 2; ++n) { const int c = colw + 16 * n; *(u32x2*)(KI + (size_t)(row >> 5) * 2048 + (c >> 4) * 512 + ((((c >> 3) & 1) * 32 + (row & 31)) * 8) + (c & 7)) = pk4(acc[ai][0][m][n]); }
                    } else if (wc == 2 && fq == 0) { *(f32x4*)(WI + (size_t)row * 4) = acc[ai][0][m][0] * 0.5f; }
                }
            return;
        }
        if (pn < 6) {
#pragma unroll
            for (int ai = 0; ai < 2; ++ai)
#pragma unroll
                for (int m = 0; m < 4; ++m) { const int row = row0 + ai * 128 + m * 16;
#pragma unroll
                    for (int bj = 0; bj < 2; ++bj)
#pragma unroll
                        for (int n = 0; n < 2; ++n) { const int col = (pn - 4) * 256 + colw + 128 * bj + 16 * n;
                            *(unsigned*)(V8 + ((size_t)(col >> 6) * M + row) * 128 + 64 + (col & 63)) = pk4_fp8(acc[ai][bj][m][n]); } }
            return;
        }
        bf16_t* O; int ldo, ct; float sc = 1.0f; bool sig = false;
        if (pn == 6) { O = QI; ldo = 256; ct = 0; sc = 0.125f; }
        else if (pn < 10) { O = UPOOL; ldo = PW; ct = (pn - 8) * 256; }
        else if (pn < 14) { O = GA; ldo = DM; ct = (pn - 10) * 256; sig = true; }
        else { O = GP; ldo = DM; ct = (pn - 14) * 256; sig = true; }
#pragma unroll
        for (int ai = 0; ai < 2; ++ai)
#pragma unroll
            for (int m = 0; m < 4; ++m) { bf16_t* rowp = O + (size_t)(row0 + ai * 128 + m * 16) * ldo + ct + colw;
#pragma unroll
                for (int bj = 0; bj < 2; ++bj)
#pragma unroll
                    for (int n = 0; n < 2; ++n) { f32x4 y = acc[ai][bj][m][n] * sc;
                        if (sig) { y[0] = sigmoidf_(y[0]); y[1] = sigmoidf_(y[1]); y[2] = sigmoidf_(y[2]); y[3] = sigmoidf_(y[3]); }
                        *(u32x2*)(rowp + 128 * bj + 16 * n) = pk4(y); }
            }
    }
};

template <int MODE> struct EpiBf {
    static constexpr bool PERM = false, AFTER_DRAIN = false;
    bf16_t* O; int ldo; const float* colscale; const bf16_t* ADD;
    __device__ __forceinline__ void operator()(const pg8::f32x4 (&acc)[2][2][4][2], const Unit& u, int wr, int wc, int fr, int fq) const {
        const int row0 = u.pm * 256 + wr * 64 + fr, col0 = u.pn * 256 + wc * 32 + 4 * fq;
#pragma unroll
        for (int ai = 0; ai < 2; ++ai)
#pragma unroll
            for (int m = 0; m < 4; ++m) { const size_t ro = (size_t)(row0 + ai * 128 + m * 16) * ldo + col0;
#pragma unroll
                for (int bj = 0; bj < 2; ++bj)
#pragma unroll
                    for (int n = 0; n < 2; ++n) { f32x4 y = acc[ai][bj][m][n]; const size_t off = ro + 128 * bj + 16 * n;
                        if (MODE == 3) { }
                        else if (MODE == 0) { y = y * *(const f32x4*)(colscale + col0 + 128 * bj + 16 * n); }
                        else { const u32x2 gq = *(const u32x2*)(O + off); y[0] *= bf_lo(gq.x); y[1] *= bf_hi(gq.x); y[2] *= bf_lo(gq.y); y[3] *= bf_hi(gq.y);
                            if (MODE == 2) { const u32x2 a = *(const u32x2*)(ADD + off); y[0] += bf_lo(a.x); y[1] += bf_hi(a.x); y[2] += bf_lo(a.y); y[3] += bf_hi(a.y); } }
                        *(u32x2*)(O + off) = pk4(y); }
            }
    }
};

struct EpiRes {
    static constexpr bool PERM = false, AFTER_DRAIN = false;
    const float* BASE; float* OUT; const float* gate; float dbg;
    __device__ __forceinline__ void operator()(const pg8::f32x4 (&acc)[2][2][4][2], const Unit& u, int wr, int wc, int fr, int fq) const {
        const int row0 = u.pm * 256 + wr * 64 + fr, col0 = u.pn * 256 + wc * 32 + 4 * fq;
        f32x4 gv[2][2];
#pragma unroll
        for (int bj = 0; bj < 2; ++bj)
#pragma unroll
            for (int n = 0; n < 2; ++n) gv[bj][n] = *(const f32x4*)(gate + col0 + 128 * bj + 16 * n);
#pragma unroll
        for (int ai = 0; ai < 2; ++ai)
#pragma unroll
            for (int m = 0; m < 4; ++m) { const int row = row0 + ai * 128 + m * 16; const size_t ro = (size_t)row * DM + col0;
#pragma unroll
                for (int bj = 0; bj < 2; ++bj)
#pragma unroll
                    for (int n = 0; n < 2; ++n) { const size_t off = ro + 128 * bj + 16 * n; f32x4 y = *(const f32x4*)(BASE + off) + gv[bj][n] * acc[ai][bj][m][n];
                        if (dbg != 0.f) { const float sg = ((row * 7 + (int)(off >> 2)) & 1) ? dbg : -dbg; y[0] += sg; y[1] -= sg; y[2] += sg; y[3] -= sg; }
                        *(f32x4*)(OUT + off) = y; }
            }
    }
};

template <int CTRL> __device__ __forceinline__ float dppf(float x) { return __builtin_bit_cast(float, __builtin_amdgcn_update_dpp(0, __builtin_bit_cast(int, x), CTRL, 0xf, 0xf, false)); }
__device__ __forceinline__ f32x4 ror1(f32x4 v) { f32x4 r; r[0] = dppf<0x121>(v[0]); r[1] = dppf<0x121>(v[1]); r[2] = dppf<0x121>(v[2]); r[3] = dppf<0x121>(v[3]); return r; }
__device__ __forceinline__ f32x4 ror2(f32x4 v) { f32x4 r; r[0] = dppf<0x122>(v[0]); r[1] = dppf<0x122>(v[1]); r[2] = dppf<0x122>(v[2]); r[3] = dppf<0x122>(v[3]); return r; }
__device__ __forceinline__ f32x4 silu_mul(f32x4 a, f32x4 b) { f32x4 r;
#pragma unroll
    for (int e = 0; e < 4; ++e) r[e] = a[e] * __builtin_amdgcn_rcpf(1.0f + __expf(-a[e])) * b[e];
    return r; }
struct EpiUpAct {
    static constexpr bool PERM = false, AFTER_DRAIN = false;
    bf16_t* ACT; float* RAW; const float* cw; const float* cb;
    __device__ __forceinline__ void operator()(const pg8::f32x4 (&acc)[2][2][4][2], const Unit& u, int wr, int wc, int fr, int fq) const {
#pragma unroll
        for (int n = 0; n < 2; ++n) {
            const int ch = u.pn * 128 + wc * 32 + 4 * fq + 16 * n;
            const f32x4 w0a = *(const f32x4*)(cw + ch), w1a = *(const f32x4*)(cw + FF2 + ch), w2a = *(const f32x4*)(cw + 2 * FF2 + ch), ba = *(const f32x4*)(cb + ch);
            const f32x4 w0b = *(const f32x4*)(cw + FF + ch), w1b = *(const f32x4*)(cw + FF2 + FF + ch), w2b = *(const f32x4*)(cw + 2 * FF2 + FF + ch), bb = *(const f32x4*)(cb + FF + ch);
#pragma unroll
            for (int ai = 0; ai < 2; ++ai) {
                const int blk = u.pm * 4 + ai * 2 + wr;
                if (fr < 2) { *(f32x4*)(RAW + (size_t)(blk * 4 + fr) * FF2 + ch) = acc[ai][0][0][n]; *(f32x4*)(RAW + (size_t)(blk * 4 + fr) * FF2 + FF + ch) = acc[ai][1][0][n]; }
                if (fr >= 14) { *(f32x4*)(RAW + (size_t)(blk * 4 + fr - 12) * FF2 + ch) = acc[ai][0][3][n]; *(f32x4*)(RAW + (size_t)(blk * 4 + fr - 12) * FF2 + FF + ch) = acc[ai][1][3][n]; }
                f32x4 pa1 = {0.f, 0.f, 0.f, 0.f}, pa2 = pa1, pb1 = pa1, pb2 = pa1;
#pragma unroll
                for (int m = 0; m < 4; ++m) {
                    const f32x4 va = acc[ai][0][m][n], vb = acc[ai][1][m][n];
                    const f32x4 ra1 = ror1(va), ra2 = ror2(va), rb1 = ror1(vb), rb2 = ror2(vb);
                    const f32x4 xa1 = fr >= 1 ? ra1 : pa1, xa2 = fr >= 2 ? ra2 : pa2, xb1 = fr >= 1 ? rb1 : pb1, xb2 = fr >= 2 ? rb2 : pb2;
                    pa1 = ra1; pa2 = ra2; pb1 = rb1; pb2 = rb2;
                    const f32x4 ya = ba + w0a * xa2 + w1a * xa1 + w2a * va, yb = bb + w0b * xb2 + w1b * xb1 + w2b * vb;
                    const f32x4 o = silu_mul(ya, yb);
                    if (!(m == 0 && fr < 2)) *(u32x2*)(ACT + (size_t)(blk * 64 + 16 * m + fr) * FF + ch) = pk4(o);
                }
            }
        }
    }
};

__device__ __forceinline__ void fixup_phase(const float* RAW, bf16_t* ACT, const float* cw, const float* cb, int gtid, int nthr) {
    for (int it = gtid; it < 256 * 2 * 704; it += nthr) {
        const int c4 = it % 704, rr = (it / 704) & 1, blk = it / 1408, ch = 4 * c4;
        const float* cur = RAW + (size_t)(blk * 4 + rr) * FF2;
        const float* p1 = rr == 1 ? RAW + (size_t)(blk * 4) * FF2 : (blk > 0 ? RAW + (size_t)((blk - 1) * 4 + 3) * FF2 : nullptr);
        const float* p2 = rr == 1 ? (blk > 0 ? RAW + (size_t)((blk - 1) * 4 + 3) * FF2 : nullptr) : (blk > 0 ? RAW + (size_t)((blk - 1) * 4 + 2) * FF2 : nullptr);
        const f32x4 z = {0.f, 0.f, 0.f, 0.f};
        const f32x4 va = *(const f32x4*)(cur + ch), vb = *(const f32x4*)(cur + FF + ch);
        const f32x4 a1 = p1 ? *(const f32x4*)(p1 + ch) : z, b1 = p1 ? *(const f32x4*)(p1 + FF + ch) : z;
        const f32x4 a2 = p2 ? *(const f32x4*)(p2 + ch) : z, b2 = p2 ? *(const f32x4*)(p2 + FF + ch) : z;
        const f32x4 ya = *(const f32x4*)(cb + ch) + *(const f32x4*)(cw + ch) * a2 + *(const f32x4*)(cw + FF2 + ch) * a1 + *(const f32x4*)(cw + 2 * FF2 + ch) * va;
        const f32x4 yb = *(const f32x4*)(cb + FF + ch) + *(const f32x4*)(cw + FF + ch) * b2 + *(const f32x4*)(cw + FF2 + FF + ch) * b1 + *(const f32x4*)(cw + 2 * FF2 + FF + ch) * vb;
        *(u32x2*)(ACT + (size_t)(blk * 64 + rr) * FF + ch) = pk4(silu_mul(ya, yb));
    }
}

template <int W> __device__ __forceinline__ void pooled_item(const bf16_t* UPOOL, bf16_t* POOLED, int t, int c8) {
    v4u v[W];
#pragma unroll
    for (int j = 0; j < W; ++j) { const int tj = (t - j) >= 0 ? (t - j) : 0; v[j] = *(const v4u*)(UPOOL + (size_t)tj * PW + 8 * c8); }
    float s[8];
#pragma unroll
    for (int e = 0; e < 8; ++e) s[e] = 0.f;
#pragma unroll
    for (int j = 0; j < W; ++j) { const float m = (t - j) >= 0 ? 1.f : 0.f;
        s[0] = fmaf(m, bf_lo(v[j].x), s[0]); s[1] = fmaf(m, bf_hi(v[j].x), s[1]); s[2] = fmaf(m, bf_lo(v[j].y), s[2]); s[3] = fmaf(m, bf_hi(v[j].y), s[3]);
        s[4] = fmaf(m, bf_lo(v[j].z), s[4]); s[5] = fmaf(m, bf_hi(v[j].z), s[5]); s[6] = fmaf(m, bf_lo(v[j].w), s[6]); s[7] = fmaf(m, bf_hi(v[j].w), s[7]); }
    const int cntw = (t + 1) < W ? (t + 1) : W; const float inv = 1.0f / (float)cntw; v4u o;
    o.x = pkbf(s[0] * inv - bf_lo(v[0].x), s[1] * inv - bf_hi(v[0].x)); o.y = pkbf(s[2] * inv - bf_lo(v[0].y), s[3] * inv - bf_hi(v[0].y));
    o.z = pkbf(s[4] * inv - bf_lo(v[0].z), s[5] * inv - bf_hi(v[0].z)); o.w = pkbf(s[6] * inv - bf_lo(v[0].w), s[7] * inv - bf_hi(v[0].w));
    *(v4u*)(POOLED + (size_t)t * PW + 8 * c8) = o;
}
__device__ __forceinline__ void pooled_phase(const bf16_t* UPOOL, bf16_t* POOLED, int gtid, int nthr) {
    for (int it = gtid; it < M * 64; it += nthr) {
        const int wv = it >> 6, l = it & 63, g = wv & 3, t = (wv >> 2) * 4 + (l >> 4), c8 = g * 16 + (l & 15);
        if (g == 0) pooled_item<2>(UPOOL, POOLED, t, c8); else if (g == 1) pooled_item<4>(UPOOL, POOLED, t, c8); else if (g == 2) pooled_item<8>(UPOOL, POOLED, t, c8); else pooled_item<16>(UPOOL, POOLED, t, c8);
    }
}

#ifndef ATT_MFMA
#define ATT_MFMA 1
#endif
#ifndef SP_QB
#define SP_QB 64
#endif
#ifndef SP_Z
#define SP_Z 3.5f
#endif
#ifndef SP_DRY
#define SP_DRY 0
#endif
#define MFMA32(a, b, c) __builtin_amdgcn_mfma_f32_32x32x16_bf16((a), (b), (c), 0, 0, 0)
__device__ __forceinline__ unsigned lds_add(LAS unsigned* p, unsigned v) { return __hip_atomic_fetch_add(p, v, __ATOMIC_RELAXED, __HIP_MEMORY_SCOPE_WORKGROUP); }
__device__ __forceinline__ unsigned lds_and(LAS unsigned* p, unsigned v) { return __hip_atomic_fetch_and(p, v, __ATOMIC_RELAXED, __HIP_MEMORY_SCOPE_WORKGROUP); }
__device__ __forceinline__ unsigned lds_or(LAS unsigned* p, unsigned v) { return __hip_atomic_fetch_or(p, v, __ATOMIC_RELAXED, __HIP_MEMORY_SCOPE_WORKGROUP); }

__device__ __forceinline__ unsigned f2sort(float f) { unsigned uu = __float_as_uint(f); return uu ^ (((unsigned)((int)uu >> 31)) | 0x80000000u); }
__device__ __forceinline__ float u2f(unsigned u) { return __uint_as_float((u & 0x80000000u) ? (u & 0x7fffffffu) : ~u); }
constexpr unsigned SP_CAP = 48u, SP_PHYS = 64u;
template <bool EMIT>
__device__ __forceinline__ unsigned tk_pass(int qb, int wave, int lane, const bf16_t* KI, const LAS bf16_t* QF, const float (&wv)[4], LAS unsigned* H, LAS unsigned* SELM, LAS unsigned* TIEM,
                                        int sh, unsigned vlo, bool clampTop, unsigned bmax, int stage, unsigned vmin, float fsel, float ftie, unsigned vmax = 0xffffffffu,
                                        bool append = false, float ftie_a = 0.f, unsigned char* lst = nullptr, unsigned loff0 = 0u) {
    const int r = lane & 31, h = lane >> 5;
    unsigned loff = loff0, lovf = 0u;
    const int gstep = stage == 1 ? 8 : 1, g0 = stage == 1 ? wave : 0;
#define TK_NEXT_G(g) ({ int _g = (g) + gstep; if (stage == 2 && (_g & 7) == wave) ++_g; _g; })
    int gcur = g0; if (stage == 2 && (gcur & 7) == wave) ++gcur;
    pg8::bf16x8 kf[4];
    { const int T0 = (wave + 8 * gcur) <= qb ? (wave + 8 * gcur) : qb; const bf16_t* kp = KI + (size_t)T0 * 2048 + 8 * lane;
#pragma unroll
      for (int s = 0; s < 4; ++s) kf[s] = *(const pg8::bf16x8*)(kp + 512 * s); }
    LAS unsigned* Hq = H + r * HSTRIDE;
    pg8::bf16x8 qf[16];
#pragma unroll
    for (int f = 0; f < 16; ++f) qf[f] = *(const LAS pg8::bf16x8*)(QF + f * 512 + lane * 8);
#pragma unroll 1
    for (; wave + 8 * gcur <= qb; gcur = TK_NEXT_G(gcur)) {
        const int T = wave + 8 * gcur;
        float sc[16];
#pragma unroll
        for (int i = 0; i < 16; ++i) sc[i] = 0.f;
        f32x16 acur;
#pragma unroll
        for (int i = 0; i < 16; ++i) acur[i] = 0.f;
#pragma unroll
        for (int s = 0; s < 4; ++s) acur = MFMA32(kf[s], qf[s], acur);
#pragma unroll
        for (int hd = 0; hd < 4; ++hd) { f32x16 an;
#pragma unroll
            for (int i = 0; i < 16; ++i) an[i] = 0.f;
            if (hd < 3) {
#pragma unroll
                for (int s = 0; s < 4; ++s) an = MFMA32(kf[s], qf[(hd + 1) * 4 + s], an); }
#pragma unroll
            for (int i = 0; i < 16; ++i) { const float av = acur[i]; const int ab = __float_as_int(av); sc[i] = fmaf(wv[hd], __int_as_float(ab > 0 ? ab : 0), sc[i]); }
            acur = an; }
        { const int Tnn = wave + 8 * TK_NEXT_G(gcur); const int Tn = Tnn <= qb ? Tnn : T; const bf16_t* kp = KI + (size_t)Tn * 2048 + 8 * lane;
#pragma unroll
          for (int s = 0; s < 4; ++s) kf[s] = *(const pg8::bf16x8*)(kp + 512 * s); }
        const int rlim = (T == qb) ? r : 64;
        if (!EMIT) {
#pragma unroll
            for (int i = 0; i < 16; ++i) {
                const int kr = (i & 3) + 8 * (i >> 2) + 4 * h;
                unsigned uu = __float_as_uint(sc[i]); uu ^= ((unsigned)((int)uu >> 31)) | 0x80000000u;
                const unsigned v = uu >> sh; unsigned b = v - vlo;
                const bool ok = (kr <= rlim) && (v >= vmin) && (v <= vmax) && (clampTop || b <= bmax);
                b = b > 2047u ? 2047u : b;
                lds_add(Hq + (ok ? (b >> 1) : 1024u), 1u << ((b & 1u) * 16u));
            }
        } else {
            unsigned ms = 0u, mg = 0u;
#pragma unroll
            for (int i = 15; i >= 0; --i) {
                asm("v_cmp_ge_f32_e32 vcc, %1, %2\n\tv_addc_co_u32_e32 %0, vcc, %0, %0, vcc" : "+v"(ms) : "v"(sc[i]), "v"(fsel) : "vcc");
                asm("v_cmp_ge_f32_e32 vcc, %1, %2\n\tv_addc_co_u32_e32 %0, vcc, %0, %0, vcc" : "+v"(mg) : "v"(sc[i]), "v"(ftie) : "vcc");
            }
            const unsigned vrow = rlim >= 31 ? 0xffffffffu : ((2u << rlim) - 1u);
            auto spread = [&](unsigned m) { return (((m & 0xfu) | ((m & 0xf0u) << 4) | ((m & 0xf00u) << 8) | ((m & 0xf000u) << 12)) << (4 * h)) & vrow; };
            const unsigned msel = spread(ms), mtie = spread(mg) & ~msel;
            const unsigned osel = __shfl_xor(msel, 32), otie = __shfl_xor(mtie, 32);
            if (h == 0) { SELM[r * MSTRIDE + T] = msel | osel; TIEM[r * MSTRIDE + T] = mtie | otie; }
            if (append) {
#pragma unroll
                for (int i = 0; i < 16; ++i) {
                    const int kr = (i & 3) + 8 * (i >> 2) + 4 * h;
                    if ((sc[i] >= ftie_a) && !(sc[i] >= fsel) && (kr <= rlim)) { *(u32x2*)(lst + loff) = (u32x2){__float_as_uint(sc[i]), (unsigned)(32 * T + kr)}; loff += 8u; }
                }
                if (loff >= loff0 + (SP_PHYS - 16u) * 8u) { lovf = 1u; loff = loff0; }
            }
        }
    }
#undef TK_NEXT_G
    return loff | lovf;
}

template <int CTRL> __device__ __forceinline__ float dppx(float x) { return __builtin_bit_cast(float, __builtin_amdgcn_mov_dpp(__builtin_bit_cast(int, x), CTRL, 0xf, 0xf, true)); }
__device__ __forceinline__ u32x2 tk_rescore_load(const bf16_t* KI, int key, int lane) {
    const int c = 4 * (lane & 15);
    return *(const u32x2*)(KI + (size_t)(key >> 5) * 2048 + (c >> 4) * 512 + ((((c >> 3) & 1) * 32 + (key & 31)) * 8) + (c & 7));
}
__device__ __forceinline__ float tk_rescore(const u32x2 q4, float wh, const u32x2 k4) {
    float d = bf_lo(q4.x) * bf_lo(k4.x); d = fmaf(bf_hi(q4.x), bf_hi(k4.x), d); d = fmaf(bf_lo(q4.y), bf_lo(k4.y), d); d = fmaf(bf_hi(q4.y), bf_hi(k4.y), d);
    d += dppx<0xB1>(d); d += dppx<0x4E>(d); d += dppx<0x141>(d); d += dppx<0x140>(d);
    float sc = wh * fmaxf(d, 0.f);
    sc += __shfl_xor(sc, 16); sc += __shfl_xor(sc, 32);
    return sc + 0.f;
}

__device__ __forceinline__ int wave_incl_scan(int v) {
    v += __builtin_amdgcn_update_dpp(0, v, 0x111, 0xf, 0xf, true); v += __builtin_amdgcn_update_dpp(0, v, 0x112, 0xf, 0xf, true);
    v += __builtin_amdgcn_update_dpp(0, v, 0x114, 0xf, 0xf, true); v += __builtin_amdgcn_update_dpp(0, v, 0x118, 0xf, 0xf, true);
    v += __builtin_amdgcn_update_dpp(0, v, 0x142, 0xa, 0xf, false); v += __builtin_amdgcn_update_dpp(0, v, 0x143, 0xc, 0xf, false);
    return v;
}
template <int WPL>
__device__ __forceinline__ void tk_scan_core(const LAS unsigned* Hq, int need, int lane, unsigned& Dsel, unsigned& nsel, unsigned& csel, int& total) {
    constexpr int BPL = 2 * WPL;
    asm volatile("" : "+v"(lane));
    int S = 0;
#pragma unroll
    for (int i = 0; i < WPL; ++i) { const unsigned w = Hq[WPL * lane + ((i + lane) & (WPL - 1))]; S += (int)((w & 0xffffu) + (w >> 16)); }
    const int incl = wave_incl_scan(S); total = __builtin_amdgcn_readlane(incl, 63); const int Tabove = total - incl;
    const bool hit = (Tabove < need) && (need <= Tabove + S);
    const unsigned long long mk = __ballot(hit);
    const int L = mk ? (int)__builtin_ctzll(mk) : 0;
    const int remL = need - __builtin_amdgcn_readlane(Tabove, L);
    const unsigned w2 = Hq[WPL * L + ((lane & (BPL - 1)) >> 1)];
    const int c = lane < BPL ? (int)((w2 >> (16 * (lane & 1))) & 0xffffu) : 0;
    const int incl2 = wave_incl_scan(c), tot2 = __builtin_amdgcn_readlane(incl2, 63), above2 = tot2 - incl2;
    const bool hit2 = (lane < BPL) && (above2 < remL) && (remL <= above2 + c);
    const unsigned long long mk2 = __ballot(hit2);
    const int J = mk2 ? (int)__builtin_ctzll(mk2) : 0;
    Dsel = mk ? (unsigned)(BPL * L + J) : 0xffffu; nsel = mk2 ? (unsigned)(remL - __builtin_amdgcn_readlane(above2, J)) : 1u; csel = (unsigned)__builtin_amdgcn_readlane(c, J);
}
__device__ __forceinline__ void tk_scan(const LAS unsigned* Hq, LAS unsigned* pref_p, LAS unsigned* need_p, LAS unsigned* cnt_p, int bits, int lane, LAS unsigned* tot_p = nullptr) {
    unsigned Dsel, nsel, csel; int total;
    tk_scan_core<16>(Hq, (int)*need_p, lane, Dsel, nsel, csel, total);
    if (lane == 0) { *pref_p = bits ? ((*pref_p << bits) | Dsel) : Dsel; *need_p = nsel; if (cnt_p) *cnt_p = csel; if (tot_p) *tot_p = (unsigned)total; }
}

typedef float f32x2_t __attribute__((ext_vector_type(2)));
__device__ __forceinline__ void unpack16(const v4u w, f32x2_t (&f)[8]) {
#pragma unroll
    for (int i = 0; i < 4; ++i) { f[2 * i] = __builtin_amdgcn_cvt_pk_f32_fp8((int)w[i], false); f[2 * i + 1] = __builtin_amdgcn_cvt_pk_f32_fp8((int)w[i], true); }
}
__device__ __forceinline__ void attn_item(int t, int hd, const unsigned short* SEL, const bf16_t* Q, const unsigned char* K8, const unsigned char* V8, bf16_t* ATTN, int lane) {
    constexpr float LOG2E = 1.4426950408889634f;
    const int kk = lane >> 2, part = lane & 3, cnt = (t + 1) < 256 ? (t + 1) : 256;
    const float slope2 = __uint_as_float((unsigned)(126 - hd) << 23) * LOG2E, sc2 = 0.125f * LOG2E;
#if ATT_MFMA
    const int g4 = lane >> 4, bp = 4 * (4 * (lane & 15) + g4), isel = kk & 3;
    long B1, B2;
    { const v4u qa = *(const v4u*)(Q + (size_t)t * AW + hd * 64 + g4 * 16), qb = *(const v4u*)(Q + (size_t)t * AW + hd * 64 + g4 * 16 + 8);
      int b0 = __builtin_amdgcn_cvt_pk_fp8_f32(bf_lo(qa.x), bf_hi(qa.x), 0, false); b0 = __builtin_amdgcn_cvt_pk_fp8_f32(bf_lo(qa.y), bf_hi(qa.y), b0, true);
      int b1 = __builtin_amdgcn_cvt_pk_fp8_f32(bf_lo(qa.z), bf_hi(qa.z), 0, false); b1 = __builtin_amdgcn_cvt_pk_fp8_f32(bf_lo(qa.w), bf_hi(qa.w), b1, true);
      int b2 = __builtin_amdgcn_cvt_pk_fp8_f32(bf_lo(qb.x), bf_hi(qb.x), 0, false); b2 = __builtin_amdgcn_cvt_pk_fp8_f32(bf_lo(qb.y), bf_hi(qb.y), b2, true);
      int b3 = __builtin_amdgcn_cvt_pk_fp8_f32(bf_lo(qb.z), bf_hi(qb.z), 0, false); b3 = __builtin_amdgcn_cvt_pk_fp8_f32(bf_lo(qb.w), bf_hi(qb.w), b3, true);
      B1 = (long)(((unsigned long long)(unsigned)b1 << 32) | (unsigned)b0); B2 = (long)(((unsigned long long)(unsigned)b3 << 32) | (unsigned)b2); }
#else
    f32x2_t q[8];
    { const v4u qa = *(const v4u*)(Q + (size_t)t * AW + hd * 64 + part * 16), qb = *(const v4u*)(Q + (size_t)t * AW + hd * 64 + part * 16 + 8);
#pragma unroll
      for (int i = 0; i < 4; ++i) { q[i] = (f32x2_t){bf_lo(qa[i]) * sc2, bf_hi(qa[i]) * sc2}; q[4 + i] = (f32x2_t){bf_lo(qb[i]) * sc2, bf_hi(qb[i]) * sc2}; } }
#endif
    const unsigned short* lp = SEL + (size_t)t * 256;
    const unsigned char* kb = K8 + (size_t)hd * M * 128 + part * 16; const unsigned char* vb = kb + 64; (void)V8;
    int key[16]; v4u kf[16], vf[16];
#pragma unroll
    for (int r = 0; r < 16; ++r) { const int j = 16 * r + kk; key[r] = (int)lp[j < cnt ? j : cnt - 1]; }
#pragma unroll
    for (int r = 0; r < 16; ++r) { kf[r] = *(const v4u*)(kb + (size_t)key[r] * 128); vf[r] = *(const v4u*)(vb + (size_t)key[r] * 128); }
    float sv[16]; float mx = -INFINITY;
#if ATT_MFMA
    const bool o1 = (isel & 1) != 0, o2 = (isel & 2) != 0;
#pragma unroll
    for (int r = 0; r < 16; ++r) {
        kf[r].x = (unsigned)__builtin_amdgcn_ds_bpermute(bp, (int)kf[r].x); kf[r].y = (unsigned)__builtin_amdgcn_ds_bpermute(bp, (int)kf[r].y);
        kf[r].z = (unsigned)__builtin_amdgcn_ds_bpermute(bp, (int)kf[r].z); kf[r].w = (unsigned)__builtin_amdgcn_ds_bpermute(bp, (int)kf[r].w); }
#pragma unroll
    for (int r = 0; r < 16; ++r) {
        const long A1 = (long)(((unsigned long long)kf[r].y << 32) | kf[r].x), A2 = (long)(((unsigned long long)kf[r].w << 32) | kf[r].z);
        f32x4 acc = {0.f, 0.f, 0.f, 0.f};
        acc = __builtin_amdgcn_mfma_f32_16x16x32_fp8_fp8(A1, B1, acc, 0, 0, 0); acc = __builtin_amdgcn_mfma_f32_16x16x32_fp8_fp8(A2, B2, acc, 0, 0, 0);
        const float a0 = acc[0], a1 = acc[1], a2 = acc[2], a3 = acc[3];
        const float s01 = o1 ? a1 : a0, s23 = o1 ? a3 : a2;
        sv[r] = o2 ? s23 : s01; }
#pragma unroll
    for (int r = 0; r < 16; ++r) { sv[r] = (16 * r + kk) < cnt ? fmaf(sv[r], sc2, -slope2 * (float)(t - key[r])) : -INFINITY; mx = fmaxf(mx, sv[r]); }
#else
#pragma unroll
    for (int r = 0; r < 16; ++r) { f32x2_t kx[8]; unpack16(kf[r], kx); f32x2_t d2 = q[0] * kx[0];
#pragma unroll
        for (int e = 1; e < 8; ++e) d2 = __builtin_elementwise_fma(q[e], kx[e], d2);
        sv[r] = d2.x + d2.y; }
#pragma unroll
    for (int r = 0; r < 16; ++r) sv[r] += dppx<0xB1>(sv[r]);
#pragma unroll
    for (int r = 0; r < 16; ++r) sv[r] += dppx<0x4E>(sv[r]);
#pragma unroll
    for (int r = 0; r < 16; ++r) { sv[r] = (16 * r + kk) < cnt ? sv[r] - slope2 * (float)(t - key[r]) : -INFINITY; mx = fmaxf(mx, sv[r]); }
#endif
    mx = fmaxf(mx, __shfl_xor(mx, 4)); mx = fmaxf(mx, __shfl_xor(mx, 8)); mx = fmaxf(mx, __shfl_xor(mx, 16)); mx = fmaxf(mx, __shfl_xor(mx, 32));
    f32x2_t o[8]; float lsum = 0.f;
#pragma unroll
    for (int e = 0; e < 8; ++e) o[e] = (f32x2_t){0.f, 0.f};
#pragma unroll
    for (int r = 0; r < 16; ++r) { const float p = __builtin_amdgcn_exp2f(sv[r] - mx); lsum += p; f32x2_t vx[8]; unpack16(vf[r], vx); const f32x2_t p2 = (f32x2_t){p, p};
#pragma unroll
        for (int e = 0; e < 8; ++e) o[e] = __builtin_elementwise_fma(p2, vx[e], o[e]); }
    lsum += dppx<0x124>(lsum); lsum += dppx<0x128>(lsum); lsum += __shfl_xor(lsum, 16); lsum += __shfl_xor(lsum, 32);
    float of[16];
#pragma unroll
    for (int e = 0; e < 8; ++e) { of[2 * e] = o[e].x; of[2 * e + 1] = o[e].y; }
#pragma unroll
    for (int e = 0; e < 16; ++e) of[e] += dppx<0x124>(of[e]);
#pragma unroll
    for (int e = 0; e < 16; ++e) of[e] += dppx<0x128>(of[e]);
#pragma unroll
    for (int e = 0; e < 16; ++e) of[e] += __shfl_xor(of[e], 16);
#pragma unroll
    for (int e = 0; e < 16; ++e) of[e] += __shfl_xor(of[e], 32);
    if (lane < 4) { const float inv = __builtin_amdgcn_rcpf(lsum); v4u a, b;
        a.x = pkbf(of[0] * inv, of[1] * inv); a.y = pkbf(of[2] * inv, of[3] * inv); a.z = pkbf(of[4] * inv, of[5] * inv); a.w = pkbf(of[6] * inv, of[7] * inv);
        b.x = pkbf(of[8] * inv, of[9] * inv); b.y = pkbf(of[10] * inv, of[11] * inv); b.z = pkbf(of[12] * inv, of[13] * inv); b.w = pkbf(of[14] * inv, of[15] * inv);
        *(v4u*)(ATTN + (size_t)t * AW + hd * 64 + part * 16) = a; *(v4u*)(ATTN + (size_t)t * AW + hd * 64 + part * 16 + 8) = b; }
}

struct TkPtrs { const bf16_t *QI, *KI; const float* WI; unsigned short* SEL; unsigned char* LST; };
__device__ __forceinline__ void topk_attn_block(int qb, const TkPtrs& P, LAS unsigned char* lds, int tid, int wave, int lane, bool do_attn) {
    LAS unsigned* H = (LAS unsigned*)lds;
    LAS unsigned* SELM = (LAS unsigned*)lds;
    LAS unsigned* TIEM = (LAS unsigned*)(lds + 32 * MSTRIDE * 4);
    LAS unsigned short* LIST = (LAS unsigned short*)(lds + LIST_OFF);
    LAS unsigned* STP = (LAS unsigned*)(lds + ST_OFF);
    LAS unsigned* STN = STP + 32;
    const int t0 = qb * 32, r = lane & 31, h = lane >> 5;
    SYNC();
    float wv[4];
    LAS bf16_t* QF = (LAS bf16_t*)(lds + LIST_OFF);
    { const bf16_t* qp = P.QI + (size_t)(t0 + r) * 256 + 8 * h;
#pragma unroll
      for (int k = 0; k < 2; ++k) { const int f = 2 * wave + k; *(LAS pg8::bf16x8*)(QF + f * 512 + lane * 8) = *(const pg8::bf16x8*)(qp + (f >> 2) * 64 + 16 * (f & 3)); }
      const f32x4 w4 = *(const f32x4*)(P.WI + (size_t)(t0 + r) * 4); wv[0] = w4[0]; wv[1] = w4[1]; wv[2] = w4[2]; wv[3] = w4[3]; }
    LAS unsigned* STC = STP + 64;
    LAS unsigned* STG = STP + 96;
    LAS unsigned* FB = STP + 160;
    LAS unsigned* STS = STP + 192;
    LAS float* FSEL = (LAS float*)(STP + 256);
    LAS float* FTIE = FSEL + 32;
    const bool negw = (wv[0] <= 0.f) && (wv[1] <= 0.f) && (wv[2] <= 0.f) && (wv[3] <= 0.f);
    const unsigned wbase = negw ? 7745u : 22976u;
    LAS unsigned* WINOK = STP + 161;
    LAS unsigned* PBN = STP + 320;
    LAS unsigned* FBS = STP + 162;
    LAS float* FTA = FSEL + 96;
    LAS unsigned* CNTL = STP + 512;
    if (wave == 0 && lane == 0) { *FB = 0u; *WINOK = 0u; *FBS = 0u; }
#pragma unroll 1
    for (int mode = (qb >= SP_QB && blockIdx.x < 256u) ? -1 : 0; mode < 2; ++mode) {
        if (mode == 1) { if ((*FB & 1u) == 0u) break; }
        if (wave == 0 && lane < 32) { STP[lane] = 0u; const int nv = t0 + lane + 1; STN[lane] = nv < 256 ? nv : 256; STG[lane] = negw ? 1u : 0u; }
        const int nstep = mode <= 0 ? 1 : 3;
#pragma unroll 1
        for (int step = 0; step < nstep; ++step) {
            for (int i = tid; i < 32 * HSTRIDE; i += NTHR) H[i] = 0u;
            SYNC();
            const int sh = mode <= 0 ? 17 : (step == 0 ? 21 : (step == 1 ? 10 : 0));
            const unsigned vlo = mode <= 0 ? wbase : (step == 0 ? 0u : (STP[r] << (step == 1 ? 11 : 10)));
            tk_pass<false>(qb, wave, lane, P.KI, QF, wv, H, SELM, TIEM, sh, vlo, mode <= 0, (mode == 1 && step == 2) ? 1023u : 2047u, mode < 0 ? 1 : 0, vlo, 0.f, 0.f);
            SYNC();
#pragma unroll 1
            for (int qq = 0; qq < 4; ++qq) { const int rq = 4 * wave + qq;
                if (mode < 0) {
                    int ns = 0;
#pragma unroll
                    for (int w = 0; w < 8; ++w) { const int first = 9 * w; if (first <= qb) { const int k = (qb - first) >> 6; ns += 32 * (k + 1); if (first + 64 * k == qb) ns -= 31 - rq; } }
                    const float phi = (float)ns / (float)(t0 + rq + 1), mu = 256.f * phi, sd = sqrtf(mu * (1.f - phi));
                    int rhi = (int)floorf(mu - SP_Z * sd); const int rlo = (int)ceilf(mu + SP_Z * sd); rhi = rhi < 1 ? 1 : rhi;
                    unsigned Dh, Dl, n1, c1; int tot1;
                    tk_scan_core<16>(H + rq * HSTRIDE, rhi, lane, Dh, n1, c1, tot1);
                    tk_scan_core<16>(H + rq * HSTRIDE, rlo, lane, Dl, n1, c1, tot1);
                    if (lane == 0) { const unsigned ng = STG[rq] & 1u;
                        if (Dl == 0xffffu) {
                            if (ng) *FBS = 1u;
                            else {
                                FSEL[rq] = (Dh == 0xffffu || Dh == 2047u) ? INFINITY : u2f((22976u + Dh + 1u) << 17); FTIE[rq] = 0.f; FTA[rq] = __uint_as_float(1u); STG[rq] = 8u | 16u; }
                        } else { const unsigned wb = ng ? 7745u : 22976u; const bool zb = ng && Dl == 2047u;
                            const float ft = u2f((wb + Dl) << 17);
                            FSEL[rq] = Dh == 2047u ? INFINITY : u2f((wb + Dh + 1u) << 17); FTIE[rq] = ft; FTA[rq] = zb ? INFINITY : ft;
                            STG[rq] = ng | (zb ? 0u : 8u); } }
                    continue;
                }
                tk_scan(H + rq * HSTRIDE, STP + rq, STN + rq, STC + rq, (mode == 1 && step == 2) ? 10 : 11, lane, PBN + rq);
                if (mode == 0 && lane == 0) { const unsigned D = STP[rq], nn = STN[rq], c = STC[rq], ng = STG[rq] & 1u;
                    if (D == 0xffffu) {
                        if (!ng) { const int nv = t0 + rq + 1; const unsigned need0 = nv < 256 ? nv : 256; PBN[rq] = need0 - PBN[rq]; STG[rq] = 4u; lds_or(FB, 2u); }
                        else lds_or(FB, 1u);
                    } else {
                        const bool zerobin = ng && D == 2047u, edge = (D == 0u) || (D == 2047u && !ng);
                        const bool wantc = (c > nn) && !zerobin;
                        if (edge || (wantc && c > 64u)) lds_or(FB, 1u);
                        STG[rq] = ng | (wantc ? 2u : 0u);
                        const unsigned wb = ng ? 7745u : 22976u;
                        FTIE[rq] = u2f((wb + D) << 17); FSEL[rq] = zerobin ? INFINITY : u2f((wb + D + 1u) << 17); } }
                if (mode == 1 && step == 2 && lane == 0) { const unsigned tau = STP[rq]; FTIE[rq] = u2f(tau); FSEL[rq] = tau == 0xffffffffu ? INFINITY : u2f(tau + 1u); } }
            SYNC();
        }
        if (mode < 0) {
            if (*FBS) continue;
            const unsigned tid8 = (unsigned)((r * 16 + 2 * wave + h) * 512);
            const unsigned lend = tk_pass<true>(qb, wave, lane, P.KI, QF, wv, H, SELM, TIEM, 0, 0u, false, 0u, 0, 0u, FSEL[r], FTIE[r], 0xffffffffu, true, FTA[r], P.LST, tid8);
            CNTL[tid] = (lend & 1u) ? 0xffffu : ((lend - tid8) >> 3);
            SYNC();
#pragma unroll 1
            for (int qq = 0; qq < 4; ++qq) { const int rq = 4 * wave + qq;
                int cs = 0, ct = 0;
#pragma unroll
                for (int i = 0; i < 8; ++i) { const int T = 8 * lane + i; if (T <= qb) { cs += __builtin_popcount(SELM[rq * MSTRIDE + T]); ct += __builtin_popcount(TIEM[rq * MSTRIDE + T]); } }
                cs = __builtin_amdgcn_readlane(wave_incl_scan(cs), 63); ct = __builtin_amdgcn_readlane(wave_incl_scan(ct), 63);
                const unsigned cn = CNTL[64 * ((lane & 15) >> 1) + 32 * (lane & 1) + rq];
                const bool bad = __ballot(cn > SP_CAP) != 0ull;
                if (lane == 0) { if (cs >= 256 || cs + ct < 256 || ((STG[rq] & 8u) && bad)) *FBS = 1u; STN[rq] = (unsigned)(256 - cs); }
            }
            SYNC();
            if (*FBS || SP_DRY) continue;
            break;
        }
        if (mode == 0 && (*FB & 1u)) continue;
        if (mode == 0 && (*FB & 2u)) {
            for (int i = tid; i < 32 * HSTRIDE; i += NTHR) H[i] = 0u;
            if (wave == 0 && lane < 32 && (STG[lane] & 4u)) { STP[lane] = 0u; STN[lane] = PBN[lane]; }
            SYNC();
            const bool isB = (STG[r] & 4u) != 0u;
            tk_pass<false>(qb, wave, lane, P.KI, QF, wv, H, SELM, TIEM, 17, 7745u, true, 2047u, 0, isB ? 7745u : 0xffffffffu, 0.f, 0.f, 22975u);
            SYNC();
#pragma unroll 1
            for (int qq = 0; qq < 4; ++qq) { const int rq = 4 * wave + qq;
                if (STG[rq] & 4u) { tk_scan(H + rq * HSTRIDE, STP + rq, STN + rq, STC + rq, 11, lane);
                    if (lane == 0) { const unsigned D = STP[rq], nn = STN[rq], c = STC[rq];
                        const bool zerobin = D == 2047u, wantc = (c > nn) && !zerobin;
                        if (D == 0xffffu || D == 0u || (wantc && c > 64u)) lds_or(FB, 1u);
                        STG[rq] = wantc ? 2u : 0u;
                        FTIE[rq] = u2f((7745u + D) << 17); FSEL[rq] = zerobin ? __uint_as_float(1u) : u2f((7745u + D + 1u) << 17); } } }
            SYNC();
            if (*FB & 1u) continue;
        }
        tk_pass<true>(qb, wave, lane, P.KI, QF, wv, H, SELM, TIEM, 0, 0u, false, 0u, 0, 0u, FSEL[r], FTIE[r]);
        if (mode == 0 && wave == 0 && lane == 0) *WINOK = 1u;
        SYNC();
        break;
    }
    if (!do_attn) return;
    asm volatile("" : "+v"(lane));
#pragma unroll 1
    for (int qq = 0; qq < 4; ++qq) {
        const int rq = 4 * wave + qq, t = t0 + rq; int mties = (int)STN[rq];
        if (STG[rq] & 8u) {
            const int sl = lane >> 2, cn = (int)CNTL[64 * (sl >> 1) + 32 * (sl & 1) + rq];
            const unsigned lo_u = f2sort(FTA[rq]), span = f2sort(FSEL[rq]) - lo_u;
            const int ptot = __builtin_amdgcn_readlane(wave_incl_scan((lane & 3) == 0 ? cn : 0), 63);
            const bool allc = (STG[rq] & 16u) && ptot < mties;
            unsigned eu[12], ek[12];
#pragma unroll
            for (int m = 0; m < 6; ++m) { const int j0 = 2 * (lane & 3) + 8 * m; const v4u e = *(const v4u*)(P.LST + (size_t)(((rq * 16 + sl) * 64 + j0) * 8));
                eu[2 * m] = j0 < cn ? f2sort(__uint_as_float(e.x)) - lo_u : 0xffffffffu; ek[2 * m] = e.y;
                eu[2 * m + 1] = (j0 + 1) < cn ? f2sort(__uint_as_float(e.z)) - lo_u : 0xffffffffu; ek[2 * m + 1] = e.w; }
            LAS unsigned* Hr = TIEM + rq * MSTRIDE; LAS unsigned* Sr = SELM + rq * MSTRIDE;
            unsigned lo = 0u, width = span; int sh = 22 - (int)__builtin_clz(span | 1u); sh = sh < 0 ? 0 : sh;
            int needc = mties; unsigned long long thr = 0ull; unsigned tieoff = 0xffffffffu; int mt = 0;
            if (allc) {
#pragma unroll
                for (int m = 0; m < 12; ++m) if (eu[m] != 0xffffffffu) { const unsigned bit = 1u << (ek[m] & 31u); lds_or(Sr + (ek[m] >> 5), bit); lds_and(Hr + (ek[m] >> 5), ~bit); }
                LDS_WAIT(); asm volatile("" ::: "memory");
                mties -= ptot;
            } else {
#pragma unroll 1
            for (int round = 0; round < 4; ++round) {
#pragma unroll
                for (int i = 0; i < 8; ++i) Hr[lane + 64 * i] = 0u;
                LDS_WAIT();
#pragma unroll
                for (int m = 0; m < 12; ++m) { const unsigned d = eu[m] - lo; if (d < width) { const unsigned b = d >> sh; lds_add(Hr + (b >> 1), 1u << ((b & 1u) * 16u)); } }
                LDS_WAIT();
                unsigned D, nn, c; int tot;
                tk_scan_core<8>(Hr, needc, lane, D, nn, c, tot);
                if (D == 0xffffu) break;
                if (c == nn) { thr = (unsigned long long)lo + ((unsigned long long)D << sh); break; }
                if (sh == 0) { thr = (unsigned long long)lo + D + 1ull; tieoff = lo + D; mt = (int)nn; break; }
                lo += D << sh; width = 1u << sh; sh = sh > 10 ? sh - 10 : 0; needc = (int)nn;
            }
#pragma unroll
            for (int i = 0; i < 8; ++i) Hr[lane + 64 * i] = 0u;
            LDS_WAIT();
#pragma unroll
            for (int m = 0; m < 12; ++m) { const unsigned bit = 1u << (ek[m] & 31u);
                if (eu[m] != 0xffffffffu && (unsigned long long)eu[m] >= thr) lds_or(Sr + (ek[m] >> 5), bit);
                else if (eu[m] == tieoff && eu[m] != 0xffffffffu) lds_or(Hr + (ek[m] >> 5), bit); }
            LDS_WAIT(); asm volatile("" ::: "memory");
            mties = mt;
            }
        }
        unsigned tw[8], fw[8]; int S = 0;
#pragma unroll
        for (int i = 0; i < 8; ++i) { const int T = 8 * lane + i; const bool v = T <= qb; tw[i] = v ? TIEM[rq * MSTRIDE + T] : 0u; fw[i] = v ? SELM[rq * MSTRIDE + T] : 0u; S += __builtin_popcount(tw[i]); }
        const int incl = wave_incl_scan(S);
        if (*WINOK != 0u && (STG[rq] & 2u)) {
            const int c = __builtin_amdgcn_readlane(incl, 63), nn = mties;
            LAS unsigned short* cl = LIST + rq * 256;
            { int pos = incl - S;
#pragma unroll
              for (int i = 0; i < 8; ++i) { unsigned w = tw[i]; while (w) { const int b = __builtin_ctz(w); if (pos < 64) cl[pos] = (unsigned short)(256 * lane + 32 * i + b); ++pos; w &= w - 1u; } } }
            LDS_WAIT(); asm volatile("" ::: "memory");
            const u32x2 q4 = *(const u32x2*)(P.QI + (size_t)t * 256 + 4 * lane); const float wh = P.WI[(size_t)t * 4 + (lane >> 4)];
            float mys = 0.f; const int cc = c < 64 ? c : 64;
#pragma unroll 1
            for (int j0 = 0; j0 < cc; j0 += 8) { u32x2 k4[8];
#pragma unroll
                for (int u = 0; u < 8; ++u) { const int jj = (j0 + u) < cc ? (j0 + u) : (cc - 1); k4[u] = tk_rescore_load(P.KI, __builtin_amdgcn_readfirstlane((int)cl[jj]), lane); }
#pragma unroll
                for (int u = 0; u < 8; ++u) { const float sj = tk_rescore(q4, wh, k4[u]); if (lane == j0 + u) mys = sj; } }
            int rank = 0;
            for (int j = 0; j < cc; ++j) { const float sj = __int_as_float(__builtin_amdgcn_readlane(__float_as_int(mys), j)); rank += (sj > mys || (sj == mys && j < lane)) ? 1 : 0; }
            const bool keepme = lane < cc && rank < nn; const int mykey = lane < cc ? (int)cl[lane] : 0;
#pragma unroll 1
            for (int j = 0; j < cc; ++j) { const int kj = __builtin_amdgcn_readlane(mykey, j); const int kp = __builtin_amdgcn_readlane((int)keepme, j);
                if (kp && (kj >> 8) == lane) {
#pragma unroll
                    for (int i = 0; i < 8; ++i) if (((kj >> 5) & 7) == i) fw[i] |= 1u << (kj & 31); } }
            mties = 0;
        }
        int take = mties - (incl - S); take = take < 0 ? 0 : (take > S ? S : take);
        int cl2 = 0;
#pragma unroll
        for (int i = 0; i < 8; ++i) { unsigned w = tw[i]; const int c = __builtin_popcount(w); unsigned keep;
            if (take >= c) { keep = w; take -= c; } else { keep = 0u; for (int k = 0; k < take; ++k) { const unsigned low = w & (0u - w); keep |= low; w ^= low; } take = 0; }
            fw[i] |= keep; cl2 += __builtin_popcount(fw[i]); }
        const int inc2 = wave_incl_scan(cl2);
        int pos = inc2 - cl2; const int cnt = __builtin_amdgcn_readlane(inc2, 63);
        LAS unsigned short* lp = LIST + rq * 256;
#pragma unroll
        for (int i = 0; i < 8; ++i) { unsigned w = fw[i]; while (w) { const int b = __builtin_ctz(w); if (pos < 256) lp[pos] = (unsigned short)(256 * lane + 32 * i + b); ++pos; w &= w - 1u; } }
        LDS_WAIT(); asm volatile("" ::: "memory");
        (void)cnt;
        *(u32x2*)(P.SEL + (size_t)t * 256 + 4 * lane) = *(const LAS u32x2*)(lp + 4 * lane);
    }
}

struct OneUnit { int pm, pn;
    __device__ __forceinline__ bool next(int i, pg8::Unit& u) const { if (i != 0) return false; u.pm = pm; u.pn = pn; return true; }
    __device__ __forceinline__ void a_ready(const pg8::Unit&) const {}
    __device__ __forceinline__ void done(const pg8::Unit&) const {}
};
struct Args { const float* in[18]; float* out; unsigned char* ws; int ph_lo, ph_hi; };
constexpr int NPH = 13;

typedef const __attribute__((address_space(4))) unsigned long long* kargp_t;
#define KARGS() kargp_t kargs = (kargp_t)__builtin_amdgcn_kernarg_segment_ptr(); asm volatile("" : "+s"(kargs)); GAS unsigned char* const ws = (GAS unsigned char*)kargs[19]; (void)ws
#define KIN(i) ((const float*)(const GAS float*)kargs[(i)])
#define KOUT() ((float*)(GAS float*)kargs[18])
#define WSP(T, off) ((T*)(GAS T*)(ws + (off)))
__global__ void __launch_bounds__(NTHR, 2) fwd_kernel(Args a) {
    extern __shared__ __attribute__((aligned(16))) unsigned char lds_raw[];
    LAS unsigned char* lds = (LAS unsigned char*)lds_raw;
    const int lo = a.ph_lo, hi = a.ph_hi;
    { int tid0 = threadIdx.x; asm volatile("" : "+v"(tid0)); for (int u = tid0; u < (LDS_BYTES - MISC_OFF) / 4; u += NTHR) ((LAS unsigned*)(lds + MISC_OFF))[u] = 0u; }
    SYNC();
    XcdBarrier bar; bar.bar = nullptr; bar.x = 0; bar.st = nullptr;
    if (hi - lo > 1) { KARGS(); bar = xcd_barrier_post((unsigned*)(GAS unsigned*)(ws + WS_CTL) + CW_BAR, (volatile LAS unsigned*)(lds + MISC_OFF) + 8); }
#define IN(k) (lo <= (k) && (k) < hi)
#define SEAM(k) do { if (IN(k) && IN((k) + 1)) xcd_barrier(bar); } while (0)
#define IDS() const int tid = threadIdx.x, lane = tid & 63, wave = __builtin_amdgcn_readfirstlane(tid >> 6), G = gridDim.x, bid = blockIdx.x; (void)lane; (void)wave; (void)G; (void)bid

    for (int rep_ph = 0; rep_ph < ((REP_PH == 0) ? 2 : 1); ++rep_ph) if (IN(0)) { KARGS(); IDS();
        P0Ptrs P{KIN(1), KIN(2), KIN(5), KIN(8), KIN(9), KIN(11), KIN(12), KIN(14), KIN(17), KIN(10), WSP(bf16_t, WS_WIN), WSP(bf16_t, WS_WATTN), WSP(bf16_t, WS_WGRP), WSP(bf16_t, WS_WPOOL), WSP(bf16_t, WS_WOUT),
                 WSP(bf16_t, WS_WUP), WSP(bf16_t, WS_WDOWN), WSP(float, WS_MODP)};
        p0_prologue(P, lds, bid * NWAVES + wave, G * NWAVES, wave, lane);
    }
    SEAM(0);
    if (IN(1)) { KARGS(); IDS();
        const float *b_ada = KIN(3), *norm1_g = KIN(4); const float* MODP = WSP(float, WS_MODP); float* MODF = WSP(float, WS_MODF);
        LAS float* mulv = (LAS float*)lds; LAS float* addv = mulv + 1024;
        for (int i = tid; i < 1024; i += NTHR) { float sh = b_ada[i], scv = b_ada[1024 + i];
#pragma unroll
            for (int kc = 0; kc < 16; ++kc) { sh += MODP[kc * NMOD + i]; scv += MODP[kc * NMOD + 1024 + i]; }
            mulv[i] = norm1_g[i] * (1.0f + scv); addv[i] = sh; }
        if (bid < 24 && tid < 256) { const int i = bid * 256 + tid; float v = b_ada[i];
#pragma unroll
            for (int kc = 0; kc < 16; ++kc) v += MODP[kc * NMOD + i];
            MODF[i] = v; }
        SYNC();
        modulate_rows(KIN(0), WSP(bf16_t, WS_H), mulv, addv, bid * NWAVES + wave, G * NWAVES, lane);
        SYNC();
    }
    SEAM(1);
    for (int rep_ph = 0; rep_ph < ((REP_PH == 2) ? 2 : 1); ++rep_ph) if (IN(2)) { KARGS(); IDS();
        pg8::Gemm g{WSP(bf16_t, WS_H), WSP(bf16_t, WS_WIN), M, NINP, DM}; pg8::StaticOrder S; S.init(M, NINP, G, bid);
        EpiProj E{WSP(bf16_t, WS_Q), WSP(unsigned char, WS_K), WSP(unsigned char, WS_K), WSP(bf16_t, WS_QI), WSP(bf16_t, WS_KI), WSP(bf16_t, WS_UPOOL), WSP(bf16_t, WS_GA), WSP(bf16_t, WS_GP), WSP(float, WS_WI), KIN(6), KIN(7)};
        pg8::gemm_phase<EpiProj, pg8::StaticOrder, true, true>(lds, g, S, E);
    }
    SEAM(2);
    if (IN(3)) { KARGS(); IDS();
        if (bid < 8) {
            pg8::Gemm g{WSP(bf16_t, WS_WPOOL), WSP(bf16_t, WS_WGRP), 1024, PW, PW}; OneUnit S{bid >> 1, bid & 1};
            EpiBf<3> E{WSP(bf16_t, WS_POOLMIX), PW, nullptr, nullptr};
            pg8::gemm_phase<EpiBf<3>, OneUnit, true, true>(lds, g, S, E);
            SYNC();
        }
        pooled_phase(WSP(bf16_t, WS_UPOOL), WSP(bf16_t, WS_POOLED), bid * NTHR + tid, G * NTHR);
        const int lb = bid & 255; const size_t lsto = (lb < 128 ? WS_H : (lb < 192 ? WS_ATTN - 128u * 262144u : WS_V - 192u * 262144u)) + (size_t)lb * 262144u;
        TkPtrs T{WSP(bf16_t, WS_QI), WSP(bf16_t, WS_KI), WSP(float, WS_WI), (unsigned short*)KOUT(), WSP(unsigned char, lsto)};
        unsigned* qctr = (unsigned*)(GAS unsigned*)(ws + WS_CTL) + CW_QUEUE;
        LAS int* qslot = (LAS int*)(lds + ST_OFF + 2040);
#pragma unroll 1
        for (;;) {
            SYNC();
            if (tid == 0) *qslot = (int)__hip_atomic_fetch_add(qctr, 1u, __ATOMIC_RELAXED, __HIP_MEMORY_SCOPE_AGENT);
            SYNC();
            const int qi0 = *qslot;
            const int qi = qi0;
            if (qi >= 512 * (1 + REP_TKONLY)) break;
            topk_attn_block(511 - (qi & 511), T, lds, tid, wave, lane, qi >= 512 * REP_TKONLY);
        }
        SYNC();
    }
    SEAM(3);
    if (IN(4)) { KARGS(); IDS();
        {
        pg8::Gemm g{WSP(bf16_t, WS_POOLED), WSP(bf16_t, WS_POOLMIX), M, DM, PW}; pg8::StaticOrder S; S.init(M, DM, G, bid);
        EpiBf<1> E{WSP(bf16_t, WS_GP), DM, nullptr, nullptr};
        pg8::gemm_phase<EpiBf<1>, pg8::StaticOrder, true, true>(lds, g, S, E);
        }
        SYNC();
        const unsigned short* SEL = (const unsigned short*)KOUT(); const bf16_t* Qp = WSP(bf16_t, WS_Q); const unsigned char *K8 = WSP(unsigned char, WS_K), *V8 = WSP(unsigned char, WS_K); bf16_t* ATTN = WSP(bf16_t, WS_ATTN);
        const bool aff = (G & 7) == 0; const int nitem = 8 * M, step = aff ? (G >> 3) * NWAVES : G * NWAVES;
#pragma unroll 1
        for (int it = aff ? (bid >> 3) * NWAVES + wave : bid * NWAVES + wave; it < (aff ? M : nitem); it += step) attn_item(aff ? it : (it >> 3), aff ? (bid & 7) : (it & 7), SEL, Qp, K8, V8, ATTN, lane);
    }
    SEAM(4);
    if (IN(7)) { KARGS(); IDS();
        pg8::Gemm g{WSP(bf16_t, WS_ATTN), WSP(bf16_t, WS_WATTN), M, DM, AW}; pg8::StaticOrder S; S.init(M, DM, G, bid);
        EpiBf<2> E{WSP(bf16_t, WS_GA), DM, nullptr, WSP(bf16_t, WS_GP)};
        pg8::gemm_phase<EpiBf<2>, pg8::StaticOrder, true, true>(lds, g, S, E);
    }
    SEAM(7);
    for (int rep_ph = 0; rep_ph < ((REP_PH == 8) ? 2 : 1); ++rep_ph) if (IN(8)) { KARGS(); IDS();
        pg8::Gemm g{WSP(bf16_t, WS_GA), WSP(bf16_t, WS_WOUT), M, DM, DM}; pg8::StaticOrder S; S.init(M, DM, G, bid);
        EpiRes E{KIN(0), KOUT(), WSP(float, WS_MODF) + 2048, 0.f};
        pg8::gemm_phase<EpiRes, pg8::StaticOrder, true, true>(lds, g, S, E);
    }
    SEAM(8);
    if (IN(9)) { KARGS(); IDS();
        const float* norm2_g = KIN(13); const float* MODF = WSP(float, WS_MODF);
        LAS float* mulv = (LAS float*)lds; LAS float* addv = mulv + 1024;
        for (int i = tid; i < 1024; i += NTHR) { mulv[i] = norm2_g[i] * (1.0f + MODF[4096 + i]); addv[i] = MODF[3072 + i]; }
        SYNC();
        modulate_rows(KOUT(), WSP(bf16_t, WS_H), mulv, addv, bid * NWAVES + wave, G * NWAVES, lane);
        SYNC();
    }
    SEAM(9);
    for (int rep_ph = 0; rep_ph < ((REP_PH == 10) ? 2 : 1); ++rep_ph) if (IN(10)) { KARGS(); IDS();
        pg8::Gemm g{WSP(bf16_t, WS_H), WSP(bf16_t, WS_WUP), M, FF2, DM}; pg8::StaticOrder S; S.init(M, FF2, G, bid);
        EpiUpAct E{WSP(bf16_t, WS_ACT), WSP(float, WS_RAW), KIN(15), KIN(16)};
        pg8::gemm_phase<EpiUpAct, pg8::StaticOrder, true, true>(lds, g, S, E);
    }
    SEAM(10);
    if (IN(11)) { KARGS(); IDS(); fixup_phase(WSP(float, WS_RAW), WSP(bf16_t, WS_ACT), KIN(15), KIN(16), bid * NTHR + tid, G * NTHR); }
    SEAM(11);
    if (IN(12)) { KARGS(); IDS();
        pg8::Gemm g{WSP(bf16_t, WS_ACT), WSP(bf16_t, WS_WDOWN), M, DM, FF}; pg8::StaticOrder S; S.init(M, DM, G, bid);
        EpiRes E{KOUT(), KOUT(), WSP(float, WS_MODF) + 5120, DBG_C};
        pg8::gemm_phase<EpiRes, pg8::StaticOrder, true, true>(lds, g, S, E);
    }
#undef IN
#undef SEAM
}

extern "C" void kernel_launch(void* const* d_in, const int* in_sizes, int n_in, void* d_out, int out_size, void* d_ws, size_t ws_size, hipStream_t stream) {
    static int grid = 0;
    if (grid == 0) {
        if (n_in != 18 || in_sizes[0] != M * DM || out_size != M * DM || ws_size < WS_END) { fprintf(stderr, "kernel_launch: unexpected shapes (n_in %d, in0 %d, out %d, ws %zu)\n", n_in, n_in > 0 ? in_sizes[0] : -1, out_size, ws_size); grid = -1; return; }
        int dev = 0, cus = 0, per_cu = 0;
        if (hipGetDevice(&dev) != hipSuccess || hipDeviceGetAttribute(&cus, hipDeviceAttributeMultiprocessorCount, dev) != hipSuccess) { grid = -1; return; }
        if (hipFuncSetAttribute((const void*)fwd_kernel, hipFuncAttributeMaxDynamicSharedMemorySize, LDS_BYTES) != hipSuccess) { fprintf(stderr, "kernel_launch: hipFuncSetAttribute failed\n"); grid = -1; return; }
        if (hipOccupancyMaxActiveBlocksPerMultiprocessor(&per_cu, (const void*)fwd_kernel, NTHR, LDS_BYTES) != hipSuccess || per_cu < 1) fprintf(stderr, "kernel_launch: occupancy query says %d\n", per_cu);
        (void)hipGetLastError();
        grid = cus;
    }
    if (grid < 0) return;
    (void)hipMemsetAsync((char*)d_ws + WS_CTL, 0, CTL_ZERO_BYTES, stream);
    Args a{};
    for (int i = 0; i < 18; ++i) a.in[i] = (const float*)d_in[i];
    a.out = (float*)d_out; a.ws = (unsigned char*)d_ws;
#if N_LAUNCH_MODE == 1
    a.ph_lo = 0; a.ph_hi = NPH;
    hipLaunchKernelGGL(fwd_kernel, dim3(grid), dim3(NTHR), LDS_BYTES, stream, a);
#else
    for (int p = 0; p < NPH; ++p) { a.ph_lo = p; a.ph_hi = p + 1; hipLaunchKernelGGL(fwd_kernel, dim3(grid), dim3(NTHR), LDS_BYTES, stream, a); }
#endif
}
```

```cpp
#include <hip/hip_runtime.h>
#include <cstdio>
#include <cstdint>
#ifndef REP_TKONLY
#define REP_TKONLY 0
#endif
#ifndef REP_BLK
#define REP_BLK 1
#endif
namespace pg8 {
#define PG8_LAS __attribute__((address_space(3)))
typedef unsigned short bf16_t;
typedef short bf16x8 __attribute__((ext_vector_type(8)));
typedef float f32x4 __attribute__((ext_vector_type(4)));
typedef unsigned u32x4 __attribute__((ext_vector_type(4)));
constexpr int BM = 256, BK = 64, HALF = 128, HTB = HALF * BK * 2  , STAGE_BYTES = 8 * HTB, NXCD = 8, WGM = 8;

__host__ __device__ __forceinline__ int lds_byte(int r, int c) { const int st = (r >> 4) * 2 + (c >> 5), rr = r & 15, cc = c & 31, ob = rr * 64 + cc * 2; return st * 1024 + (ob ^ (((ob >> 9) & 1) << 5)); }
__host__ __device__ __forceinline__ void stage_rc(int b, int& R, int& C) { const int st = b / 1024, sb = b % 1024, swz = sb ^ (((sb >> 9) & 1) << 5); R = (st >> 1) * 16 + swz / 64; C = (st & 1) * 32 + (swz % 64) / 2; }
__host__ __device__ __forceinline__ int perm32(int rho) { const int n = rho >> 4, i = rho & 15; return 8 * (i >> 2) + 4 * n + (i & 3); }

struct Unit { int pm, pn; };
struct Gemm { const bf16_t* A; const bf16_t* Bt; int M, N, K; };

struct StaticOrder {
    int nM, nN, nwg, G, c;
    __host__ __device__ void init(int M, int N, int G_, int c_) { nM = M / BM; nN = N / BM; nwg = nM * nN; G = G_; c = c_; }
    __host__ __device__ bool next(int i, Unit& u) const {
        const long L = (long)i * G + c; if (L >= nwg) return false;
        int wgid = (int)L; { const int q = nwg / NXCD, r = nwg % NXCD, xcd = wgid % NXCD, off = wgid / NXCD; wgid = (xcd < r ? xcd * (q + 1) : r * (q + 1) + (xcd - r) * q) + off; }
        const int nig = WGM * nN, gid = wgid / nig, fm = gid * WGM, gsz = (nM - fm) < WGM ? (nM - fm) : WGM;
        u.pm = fm + ((wgid % nig) % gsz); u.pn = (wgid % nig) / gsz; return true;
    }
    __device__ __forceinline__ void a_ready(const Unit&) const {}
    __device__ __forceinline__ void done(const Unit&) const {}
};

__device__ __forceinline__ unsigned cvt_pk_bf16(float lo, float hi) { unsigned r; asm volatile("v_cvt_pk_bf16_f32 %0, %1, %2" : "=v"(r) : "v"(lo), "v"(hi)); return r; }
template <class Epi, class Sched, bool ALIGN_EPI = false, bool SP2 = false>
__device__ __forceinline__ void gemm_phase(PG8_LAS unsigned char* lds, const Gemm g, const Sched& S, const Epi& E) {
    int tid_ = threadIdx.x; asm volatile("" : "+v"(tid_));
    const int tid = tid_, wid = __builtin_amdgcn_readfirstlane(tid >> 6), lane = tid & 63, wr = wid >> 2, wc = wid & 3, fr = lane & 15, fq = lane >> 4;
    const int K = g.K, nt = K / BK;
    unsigned voffA[2], voffB[2];
#pragma unroll
    for (int i = 0; i < 2; ++i) { int R, C; stage_rc(tid * 16 + i * 8192, R, C); const int Rb = Epi::PERM ? ((R & ~31) + perm32(R & 31)) : R;
        voffA[i] = (unsigned)(R * K + C) * 2u; voffB[i] = (unsigned)(Rb * K + C) * 2u; }
    const size_t kstep = (size_t)(BK * 2);
    const size_t hstep = (size_t)HALF * K * 2;
    const size_t tstep = 2 * hstep;
    const unsigned ldsw = (unsigned)wid * 1024u;
    const int aoff = lds_byte(wr * 64 + fr, fq * 8), boff = lds_byte(wc * 32 + fr, fq * 8);
#define PG8_SA(b, h) (((b) * 2 + (h)) * HTB)
#define PG8_SB(b, h) ((4 + (b) * 2 + (h)) * HTB)
#define PG8_STAGE(bufoff, gbase, voff) do { _Pragma("unroll") for (int _i = 0; _i < 2; ++_i) \
        __builtin_amdgcn_global_load_lds((const unsigned*)((const char*)(gbase) + (voff)[_i]), (PG8_LAS unsigned*)(lds + (bufoff) + ldsw + _i * 8192), 16, 0, 0); } while (0)
#define PG8_LDA(dst, b, h) do { _Pragma("unroll") for (int m = 0; m < 4; ++m) _Pragma("unroll") for (int k = 0; k < 2; ++k) dst[m][k] = *(const PG8_LAS bf16x8*)(lds + PG8_SA(b, h) + aoff + m * 2048 + k * 1024); } while (0)
#define PG8_LDB(dst, b, h) do { _Pragma("unroll") for (int n = 0; n < 2; ++n) _Pragma("unroll") for (int k = 0; k < 2; ++k) dst[n][k] = *(const PG8_LAS bf16x8*)(lds + PG8_SB(b, h) + boff + n * 2048 + k * 1024); } while (0)
#define PG8_MMA(ai, bj, At, Bt) do { __builtin_amdgcn_s_setprio(1); _Pragma("unroll") for (int m = 0; m < 4; ++m) _Pragma("unroll") for (int n = 0; n < 2; ++n) _Pragma("unroll") for (int k = 0; k < 2; ++k) \
        acc[ai][bj][m][n] = __builtin_amdgcn_mfma_f32_16x16x32_bf16(Bt[n][k], At[m][k], acc[ai][bj][m][n], 0, 0, 0); __builtin_amdgcn_s_setprio(0); } while (0)
#define PG8_WAIT_V(n) asm volatile("s_waitcnt vmcnt(" #n ")" ::: "memory")
#define PG8_WAIT_L(n) asm volatile("s_waitcnt lgkmcnt(" #n ")" ::: "memory")
#define PG8_BAR __builtin_amdgcn_s_barrier()
#define PG8_SCHED __builtin_amdgcn_sched_barrier(0)
    Unit cur, nxt; int ui = 0;
    if (!S.next(0, cur)) return;
    f32x4 acc[2][2][4][2];
#pragma unroll
    for (int a = 0; a < 2; ++a)
#pragma unroll
        for (int b = 0; b < 2; ++b)
#pragma unroll
            for (int m = 0; m < 4; ++m)
#pragma unroll
                for (int n = 0; n < 2; ++n) acc[a][b][m][n] = (f32x4){0.f, 0.f, 0.f, 0.f};
    bf16x8 At[4][2], B0[2][2], B1[2][2];
    const char* cA = (const char*)g.A + (size_t)cur.pm * tstep; const char* cB = (const char*)g.Bt + (size_t)cur.pn * tstep;
    S.a_ready(cur);
    if constexpr (SP2) {
        PG8_STAGE(PG8_SB(0, 0), cB, voffB); PG8_STAGE(PG8_SB(0, 1), cB + hstep, voffB); PG8_STAGE(PG8_SA(0, 0), cA, voffA); PG8_STAGE(PG8_SA(0, 1), cA + hstep, voffA);
        if (wr == 1) PG8_BAR;
        PG8_WAIT_V(2); PG8_BAR;
        PG8_STAGE(PG8_SB(1, 0), cB + kstep, voffB); PG8_STAGE(PG8_SA(1, 0), cA + kstep, voffA); PG8_STAGE(PG8_SB(1, 1), cB + hstep + kstep, voffB);
        PG8_WAIT_V(6); PG8_BAR;
    } else {
        PG8_STAGE(PG8_SB(0, 0), cB, voffB); PG8_STAGE(PG8_SA(0, 0), cA, voffA); PG8_STAGE(PG8_SB(0, 1), cB + hstep, voffB); PG8_STAGE(PG8_SA(0, 1), cA + hstep, voffA);
        if (wr == 1) PG8_BAR;
        PG8_WAIT_V(4); PG8_BAR;
        PG8_STAGE(PG8_SB(1, 0), cB + kstep, voffB); PG8_STAGE(PG8_SA(1, 0), cA + kstep, voffA); PG8_STAGE(PG8_SB(1, 1), cB + hstep + kstep, voffB);
        PG8_WAIT_V(6); PG8_BAR;
    }
    for (;;) {
        const bool has_next = S.next(ui + 1, nxt);
        const char* nA = has_next ? (const char*)g.A + (size_t)nxt.pm * tstep : cA; const char* nB = has_next ? (const char*)g.Bt + (size_t)nxt.pn * tstep : cB;
        for (int t = 0; t < nt; t += 2) {
            const bool last = (t == nt - 2);
            const char* a1 = cA + (size_t)(t + 1) * kstep;
            const char* a2 = last ? nA : cA + (size_t)(t + 2) * kstep; const char* b2 = last ? nB : cB + (size_t)(t + 2) * kstep;
            const char* a3 = a2 + kstep; const char* b3 = b2 + kstep;
            if (last && has_next) S.a_ready(nxt);
            if constexpr (SP2) {
            PG8_LDB(B0, 0, 0); PG8_LDB(B1, 0, 1); PG8_SCHED; PG8_LDA(At, 0, 0); PG8_STAGE(PG8_SA(1, 1), a1 + hstep, voffA);
            PG8_WAIT_V(8); PG8_WAIT_L(0); PG8_BAR; PG8_MMA(0, 0, At, B0); PG8_MMA(0, 1, At, B1); PG8_BAR; PG8_SCHED;
            PG8_LDA(At, 0, 1); PG8_STAGE(PG8_SB(0, 0), b2, voffB); PG8_STAGE(PG8_SB(0, 1), b2 + hstep, voffB); PG8_STAGE(PG8_SA(0, 0), a2, voffA);
            PG8_WAIT_V(8); PG8_WAIT_L(0); PG8_BAR; PG8_MMA(1, 0, At, B0); PG8_MMA(1, 1, At, B1); PG8_BAR; PG8_SCHED;
            PG8_LDB(B0, 1, 0); PG8_LDB(B1, 1, 1); PG8_SCHED; PG8_LDA(At, 1, 0); PG8_STAGE(PG8_SA(0, 1), a2 + hstep, voffA);
            PG8_WAIT_V(8); PG8_WAIT_L(0); PG8_BAR; PG8_MMA(0, 0, At, B0); PG8_MMA(0, 1, At, B1); PG8_BAR; PG8_SCHED;
            PG8_LDA(At, 1, 1); PG8_STAGE(PG8_SB(1, 0), b3, voffB); PG8_STAGE(PG8_SB(1, 1), b3 + hstep, voffB); PG8_STAGE(PG8_SA(1, 0), a3, voffA);
            PG8_WAIT_V(8); PG8_WAIT_L(0); PG8_BAR; PG8_MMA(1, 0, At, B0); PG8_MMA(1, 1, At, B1); PG8_BAR; PG8_SCHED;
            } else {
            PG8_LDB(B0, 0, 0); PG8_SCHED; PG8_LDA(At, 0, 0); PG8_STAGE(PG8_SA(1, 1), a1 + hstep, voffA);
            PG8_WAIT_L(8); PG8_BAR; PG8_WAIT_L(0); PG8_MMA(0, 0, At, B0); PG8_BAR; PG8_SCHED;
            PG8_LDB(B1, 0, 1); PG8_STAGE(PG8_SB(0, 0), b2, voffB);
            PG8_BAR; PG8_WAIT_L(0); PG8_MMA(0, 1, At, B1); PG8_BAR;
            PG8_LDA(At, 0, 1); PG8_STAGE(PG8_SA(0, 0), a2, voffA);
            PG8_BAR; PG8_WAIT_L(0); PG8_MMA(1, 0, At, B0); PG8_BAR; PG8_SCHED;
            PG8_STAGE(PG8_SB(0, 1), b2 + hstep, voffB);
            PG8_WAIT_V(6); PG8_BAR; PG8_MMA(1, 1, At, B1); PG8_BAR;
            PG8_LDB(B0, 1, 0); PG8_SCHED; PG8_LDA(At, 1, 0); PG8_STAGE(PG8_SA(0, 1), a2 + hstep, voffA);
            PG8_WAIT_L(8); PG8_BAR; PG8_WAIT_L(0); PG8_MMA(0, 0, At, B0); PG8_BAR; PG8_SCHED;
            PG8_LDB(B1, 1, 1); PG8_STAGE(PG8_SB(1, 0), b3, voffB);
            PG8_BAR; PG8_WAIT_L(0); PG8_MMA(0, 1, At, B1); PG8_BAR;
            PG8_LDA(At, 1, 1); PG8_STAGE(PG8_SA(1, 0), a3, voffA);
            PG8_BAR; PG8_WAIT_L(0); PG8_MMA(1, 0, At, B0); PG8_BAR; PG8_SCHED;
            PG8_STAGE(PG8_SB(1, 1), b3 + hstep, voffB);
            PG8_WAIT_V(6); PG8_BAR; PG8_MMA(1, 1, At, B1); PG8_BAR;
            }
        }
        if constexpr (ALIGN_EPI) { if (wr == 0) PG8_BAR; }
        if constexpr (!Epi::AFTER_DRAIN) { E(acc, cur, wr, wc, fr, fq); S.done(cur); }
        if (!has_next) break;
#pragma unroll
        for (int a = 0; a < 2; ++a)
#pragma unroll
            for (int b = 0; b < 2; ++b)
#pragma unroll
                for (int m = 0; m < 4; ++m)
#pragma unroll
                    for (int n = 0; n < 2; ++n) acc[a][b][m][n] = (f32x4){0.f, 0.f, 0.f, 0.f};
        cur = nxt; cA = nA; cB = nB; ++ui;
        if constexpr (ALIGN_EPI) { if (wr == 1) PG8_BAR; }
    }
    PG8_WAIT_V(0);
    if constexpr (!ALIGN_EPI) { if (wr == 0) PG8_BAR; }
    PG8_BAR;
    if constexpr (Epi::AFTER_DRAIN) { E.fused(acc, cur, wr, wc, fr, fq, lds, wid, lane); S.done(cur); }
#undef PG8_SA
#undef PG8_SB
#undef PG8_STAGE
#undef PG8_LDA
#undef PG8_LDB
#undef PG8_MMA
#undef PG8_WAIT_V
#undef PG8_WAIT_L
#undef PG8_BAR
#undef PG8_SCHED
}
}
#define GAS __attribute__((address_space(1)))
#define LAS __attribute__((address_space(3)))
typedef unsigned short bf16;
typedef unsigned v4u __attribute__((ext_vector_type(4)));
typedef float f32x4 __attribute__((ext_vector_type(4)));
typedef short bf16x8 __attribute__((ext_vector_type(8)));
typedef GAS unsigned gu32;
typedef GAS unsigned long long gu64;
#define RLX_AGENT __ATOMIC_RELAXED, __HIP_MEMORY_SCOPE_AGENT
#define LDS_WAIT() asm volatile("s_waitcnt lgkmcnt(0)" ::: "memory")
#define VM_WAIT() asm volatile("s_waitcnt vmcnt(0)" ::: "memory")
__device__ __forceinline__ unsigned long long rt() { return __builtin_amdgcn_s_memrealtime(); }
__device__ __forceinline__ unsigned f2bf(float f) { unsigned u = __builtin_bit_cast(unsigned, f); return (u + 0x7fffu + ((u >> 16) & 1u)) >> 16; }
__device__ __forceinline__ unsigned pk2(float lo, float hi) { return f2bf(lo) | (f2bf(hi) << 16); }

#define XB_TMO      128
#define XB_XCNT(j)  (256  + 64 * (j))
#define XB_XSUB(j)  (1280 + 64 * (j))
#define XB_XGEN(j)  (2304 + 64 * (j))
#define XB_TOP      3328
#define XB_TOPGEN   3392
#define XCD_BAR_WORDS 3456
#define XB_SPIN_CAP (1u << 18)

__device__ __forceinline__ unsigned xb_ld(unsigned* p)              { return __hip_atomic_load(p, __ATOMIC_RELAXED, __HIP_MEMORY_SCOPE_AGENT); }
__device__ __forceinline__ unsigned xb_add(unsigned* p, unsigned v) { return __hip_atomic_fetch_add(p, v, __ATOMIC_RELAXED, __HIP_MEMORY_SCOPE_AGENT); }
__device__ __forceinline__ unsigned xb_xcc_id() { return (unsigned)__builtin_amdgcn_s_getreg((3 << 11) | 20) & 0xFu; }
#define XB_SPIN(cond, bar) do { unsigned _sp = 0; while (cond) { __builtin_amdgcn_s_sleep(1); \
    if ((++_sp & 255u) == 0u) { if (xb_ld(&(bar)[XB_TMO])) break; if (_sp > XB_SPIN_CAP) { atomicAdd(&(bar)[XB_TMO], 1u); break; } } } } while (0)

struct XcdBarrier {
    unsigned* bar; unsigned x;
    volatile LAS unsigned* st;
};

__device__ __forceinline__ XcdBarrier xcd_barrier_post(unsigned* bar, volatile LAS unsigned* st) {
    XcdBarrier b; b.bar = bar; b.x = xb_xcc_id(); b.st = st;
    if (threadIdx.x == 0) (void)xb_add(&bar[XB_XCNT(b.x)], 1u);
    return b;
}
__device__ __forceinline__ void xcd_barrier_complete(unsigned* bar, unsigned x, unsigned& nloc, unsigned& nx) {
    const unsigned G = gridDim.x * gridDim.y * gridDim.z;
    unsigned sum, cnt, mine, sp = 0u;
    for (;;) {
        sum = 0u; cnt = 0u; mine = 0u;
#pragma unroll
        for (unsigned j = 0; j < 16; ++j) { const unsigned c = xb_ld(&bar[XB_XCNT(j)]); sum += c; cnt += (c > 0u) ? 1u : 0u; mine = (j == x) ? c : mine; }
        if (sum == G) break;
        __builtin_amdgcn_s_sleep(1);
        if ((++sp & 255u) == 0u) { if (xb_ld(&bar[XB_TMO])) break; if (sp > XB_SPIN_CAP) { atomicAdd(&bar[XB_TMO], 1u); break; } }
    }
    nloc = mine > 0u ? mine : 1u; nx = cnt > 0u ? cnt : 1u;
}

__device__ __forceinline__ void xcd_barrier(const XcdBarrier& b) {
    asm volatile("s_waitcnt vmcnt(0)" ::: "memory");
    __syncthreads();
    if (threadIdx.x == 0) {
        unsigned* bar = b.bar;
        __builtin_amdgcn_s_waitcnt(0);
        unsigned nloc = b.st[0], nx = b.st[1];
        if (nloc == 0u) { xcd_barrier_complete(bar, b.x, nloc, nx); b.st[0] = nloc; b.st[1] = nx; }
        const unsigned old = xb_add(&bar[XB_XSUB(b.x)], 1u);
        const unsigned gen = old / nloc;
        if (old + 1u == (gen + 1u) * nloc) {
            __builtin_amdgcn_fence(__ATOMIC_RELEASE, "agent");
            asm volatile("s_waitcnt vmcnt(0)" ::: "memory");
            const unsigned og = xb_add(&bar[XB_TOP], 1u);
            const unsigned tg = og / nx;
            if (og + 1u == (tg + 1u) * nx) xb_add(&bar[XB_TOPGEN], 1u);
            else XB_SPIN(xb_ld(&bar[XB_TOPGEN]) == tg, bar);
            __builtin_amdgcn_fence(__ATOMIC_ACQUIRE, "agent");
            xb_add(&bar[XB_XGEN(b.x)], 1u);
            asm volatile("s_waitcnt vmcnt(0)" ::: "memory");
        } else {
            XB_SPIN(xb_ld(&bar[XB_XGEN(b.x)]) == gen, bar);
            __builtin_amdgcn_fence(__ATOMIC_ACQUIRE, "agent");
            asm volatile("s_waitcnt vmcnt(0)" ::: "memory");
        }
    }
    __syncthreads();
}


#ifndef STAGE
#define STAGE 3
#endif
#ifndef N_LAUNCH_MODE
#define N_LAUNCH_MODE 1
#endif
#ifndef REP_TK
#define REP_TK 1
#endif
#ifndef REP_AT
#define REP_AT 1
#endif
#ifndef REP_PH
#define REP_PH -1
#endif
#ifndef TK_PREFETCH
#define TK_PREFETCH 1
#endif
#ifndef DBG_C
#define DBG_C 0.0f
#endif

typedef float f32x16 __attribute__((ext_vector_type(16)));
typedef __attribute__((ext_vector_type(2))) __bf16 bf16x2_t;
using pg8::bf16_t; using pg8::Unit;

constexpr int M = 16384, DM = 1024, NHEAD = 8, HD = 64, AW = 512, PW = 512, FF = 2816, FF2 = 5632, NIN = 4420, NINP = 4608, NMOD = 6144;
constexpr float EPS = 1e-6f;
constexpr int NWAVES = 8, NTHR = 512;

constexpr size_t MiB = 1u << 20;
constexpr size_t WS_CTL = 0, CTL_ZERO_BYTES = 64 * 1024;
constexpr size_t WS_WIN = 1 * MiB, WS_WATTN = 10 * MiB, WS_WGRP = 11 * MiB, WS_WPOOL = 11 * MiB + 512 * 1024, WS_WOUT = 12 * MiB + 512 * 1024,
                 WS_WUP = 14 * MiB + 512 * 1024, WS_WDOWN = 25 * MiB + 512 * 1024;
constexpr size_t WS_MODP = 31 * MiB, WS_MODF = 31 * MiB + 393216, WS_WI = 31 * MiB + 512 * 1024;
constexpr size_t WS_H = 32 * MiB;
constexpr size_t WS_Q = 64 * MiB, WS_K = 80 * MiB, WS_V = 96 * MiB;
constexpr size_t WS_SEL = 88 * MiB;
constexpr size_t WS_QI = 112 * MiB, WS_KI = 120 * MiB;
constexpr size_t WS_UPOOL = 128 * MiB, WS_POOLED = 144 * MiB, WS_POOLMIX = 160 * MiB, WS_ATTN = 176 * MiB;
constexpr size_t WS_GA = 192 * MiB, WS_GP = 224 * MiB;
constexpr size_t WS_ACT = 64 * MiB;
constexpr size_t WS_RAW = 152 * MiB;
constexpr size_t WS_END = 256 * MiB;
constexpr int CW_BAR = 1024, CW_QUEUE = 512;

constexpr int LDS_BYTES = 163840;
constexpr int HSTRIDE = 1025, MSTRIDE = 513;
constexpr int LIST_OFF = 135168, ST_OFF = 151552, MISC_OFF = 159744;

#define SYNC() __syncthreads()
__device__ __forceinline__ float wave_sum(float v) {
#pragma unroll
    for (int o = 1; o < 64; o <<= 1) v += __shfl_xor(v, o);
    return v;
}
__device__ __forceinline__ float bf_lo(unsigned w) { return __builtin_bit_cast(float, w << 16); }
__device__ __forceinline__ float bf_hi(unsigned w) { return __builtin_bit_cast(float, w & 0xffff0000u); }
__device__ __forceinline__ float sigmoidf_(float x) { return __builtin_amdgcn_rcpf(1.0f + __expf(-x)); }
__device__ __forceinline__ unsigned pkbf(float lo, float hi) { return pg8::cvt_pk_bf16(lo, hi); }
typedef unsigned u32x2 __attribute__((ext_vector_type(2)));
__device__ __forceinline__ u32x2 pk4(f32x4 v) { u32x2 r; r.x = pkbf(v[0], v[1]); r.y = pkbf(v[2], v[3]); return r; }
__device__ __forceinline__ unsigned pk4_fp8(f32x4 v) { int w = 0; w = __builtin_amdgcn_cvt_pk_fp8_f32(v[0], v[1], w, false); w = __builtin_amdgcn_cvt_pk_fp8_f32(v[2], v[3], w, true); return (unsigned)w; }

__device__ __forceinline__ void tr_item(const float* W, int ldw, int src_col, int nvalid, int k0, bf16_t* WT, int K, int dst_row, LAS float* scr, int lane) {
    f32x4 v[8];
#pragma unroll
    for (int i = 0; i < 8; ++i) { const int kk = 8 * i + (lane >> 3), n4 = 4 * (lane & 7);
        v[i] = (f32x4){0.f, 0.f, 0.f, 0.f}; if (W != nullptr && n4 < nvalid) v[i] = *(const f32x4*)(W + (size_t)(k0 + kk) * ldw + src_col + n4); }
#pragma unroll
    for (int i = 0; i < 8; ++i) { const int kk = 8 * i + (lane >> 3), n4 = 4 * (lane & 7); LAS float* p = scr + kk * 33 + n4; p[0] = v[i][0]; p[1] = v[i][1]; p[2] = v[i][2]; p[3] = v[i][3]; }
    LDS_WAIT(); asm volatile("" ::: "memory");
    const int c = lane & 7;
#pragma unroll
    for (int j = 0; j < 4; ++j) { const int n = (lane >> 3) + 8 * j; const LAS float* s = scr + (8 * c) * 33 + n;
        v4u o; o.x = pk2(s[0 * 33], s[1 * 33]); o.y = pk2(s[2 * 33], s[3 * 33]); o.z = pk2(s[4 * 33], s[5 * 33]); o.w = pk2(s[6 * 33], s[7 * 33]);
        *(GAS v4u*)(WT + (size_t)(dst_row + n) * K + k0 + 8 * c) = o; }
    LDS_WAIT(); asm volatile("" ::: "memory");
}

struct P0Ptrs { const float *c, *w_ada, *w_in, *w_attn, *w_grp, *w_pool, *w_out, *w_up, *w_down, *pscale; bf16_t *WIN, *WATTN, *WGRP, *WPOOL, *WOUT, *WUP, *WDOWN; float* MODP; };
__device__ __forceinline__ void p0_prologue(const P0Ptrs& P, LAS unsigned char* lds, int gw, int NGW, int wave, int lane) {
    LAS float* scr = (LAS float*)(lds + wave * 16384);
    LAS float* sil = (LAS float*)(lds + 131072);
    for (int i = threadIdx.x; i < 1024; i += NTHR) { const float cv = P.c[i]; sil[i] = cv / (1.0f + __expf(-cv)); }
    SYNC();
    constexpr int I_WIN = 144 * 16, I_WATTN = 32 * 8, I_WGRP = 128, I_WPOOL = 32 * 8, I_WOUT = 32 * 16, I_WUP = 176 * 16, I_WDOWN = 32 * 44, I_MOD = 96 * 16;
    constexpr int NITEMS = I_WIN + I_WATTN + I_WGRP + I_WPOOL + I_WOUT + I_WUP + I_WDOWN + I_MOD;
    for (int it = gw; it < NITEMS; it += NGW) {
        int r = it;
        if (r < I_MOD) {
            const int cb = r % 96, kc = r / 96, col = cb * 64 + lane; float acc = 0.f;
            float wa[64];
#pragma unroll
            for (int i = 0; i < 64; ++i) wa[i] = P.w_ada[(size_t)(kc * 64 + i) * NMOD + col];
#pragma unroll
            for (int i = 0; i < 64; ++i) acc = fmaf(sil[kc * 64 + i], wa[i], acc);
            P.MODP[kc * NMOD + col] = acc; continue; }
        r -= I_MOD;
        if (r < I_WIN) { const int g = r / 16, kb = r % 16, tile = g >> 3, gi = g & 7; int src = -1, nv = 32;
            const int permgi = gi < 4 ? 64 * gi : 64 * (gi - 4) + 32;
            if (tile < 2) src = tile * 256 + permgi;
            else if (tile < 4) src = 512 + (tile - 2) * 256 + permgi;
            else if (tile < 6) src = 1024 + (tile - 4) * 256 + 32 * gi;
            else if (tile == 6) src = 1536 + 32 * gi;
            else if (tile == 7) { if (gi < 2) src = 1792 + 32 * gi; else if (gi == 2) { src = 1856; nv = 4; } }
            else if (tile < 10) src = 1860 + (tile - 8) * 256 + 32 * gi;
            else if (tile < 14) src = 2372 + (tile - 10) * 256 + 32 * gi;
            else src = 3396 + (tile - 14) * 256 + 32 * gi;
            tr_item(src >= 0 ? P.w_in : nullptr, NIN, src >= 0 ? src : 0, nv, kb * 64, P.WIN, 1024, g * 32, scr, lane); continue; }
        r -= I_WIN;
        if (r < I_WATTN) { tr_item(P.w_attn, 1024, (r / 8) * 32, 32, (r % 8) * 64, P.WATTN, 512, (r / 8) * 32, scr, lane); continue; }
        r -= I_WATTN;
        if (r < I_WGRP) {
            const int row = 4 * r + (lane >> 4), g = row >> 7; const float* src = P.w_grp + (size_t)g * 16384 + (size_t)(row & 127) * 128;
#pragma unroll
            for (int q = 0; q < 4; ++q) { const int d0 = 32 * (lane & 15) + 8 * q; v4u o = (v4u){0u, 0u, 0u, 0u};
                if ((d0 >> 7) == g) { const f32x4 a = *(const f32x4*)(src + (d0 & 127)) * *(const f32x4*)(P.pscale + d0), b = *(const f32x4*)(src + (d0 & 127) + 4) * *(const f32x4*)(P.pscale + d0 + 4);
                    o.x = pk2(a[0], a[1]); o.y = pk2(a[2], a[3]); o.z = pk2(b[0], b[1]); o.w = pk2(b[2], b[3]); }
                *(GAS v4u*)(P.WGRP + (size_t)row * 512 + d0) = o; }
            continue; }
        r -= I_WGRP;
        if (r < I_WPOOL) { tr_item(P.w_pool, 1024, (r / 8) * 32, 32, (r % 8) * 64, P.WPOOL, 512, (r / 8) * 32, scr, lane); continue; }
        r -= I_WPOOL;
        if (r < I_WOUT) { tr_item(P.w_out, 1024, (r / 16) * 32, 32, (r % 16) * 64, P.WOUT, 1024, (r / 16) * 32, scr, lane); continue; }
        r -= I_WOUT;
        if (r < I_WUP) { const int g = r / 16, kb = r % 16, tile = g >> 3, gi = g & 7;
            const int src = gi < 4 ? 128 * tile + 32 * gi : FF + 128 * tile + 32 * (gi - 4);
            tr_item(P.w_up, FF2, src, 32, kb * 64, P.WUP, 1024, g * 32, scr, lane); continue; }
        r -= I_WUP;
        { tr_item(P.w_down, 1024, (r / 44) * 32, 32, (r % 44) * 64, P.WDOWN, FF, (r / 44) * 32, scr, lane); }
    }
}

__device__ __forceinline__ void modulate_rows(const float* X, bf16_t* O, const LAS float* mulv, const LAS float* addv, int gw, int NGW, int lane) {
    f32x4 mu[4], ad[4];
#pragma unroll
    for (int j = 0; j < 4; ++j) { mu[j] = *(const LAS f32x4*)(mulv + 4 * lane + 256 * j); ad[j] = *(const LAS f32x4*)(addv + 4 * lane + 256 * j); }
    for (int row = gw; row < M; row += NGW) {
        const GAS f32x4* xr = (const GAS f32x4*)(X + (size_t)row * DM) + lane;
        f32x4 v[4]; float s = 0.f;
#pragma unroll
        for (int j = 0; j < 4; ++j) { v[j] = xr[64 * j]; s += (v[j].x * v[j].x + v[j].y * v[j].y) + (v[j].z * v[j].z + v[j].w * v[j].w); }
        const float rstd = 1.0f / sqrtf(wave_sum(s) * (1.0f / DM) + EPS);
        GAS u32x2* o8 = (GAS u32x2*)(O + (size_t)row * DM) + lane;
#pragma unroll
        for (int j = 0; j < 4; ++j) { const f32x4 y = v[j] * rstd * mu[j] + ad[j]; o8[64 * j] = pk4(y); }
    }
}

struct EpiProj {
    static constexpr bool PERM = false, AFTER_DRAIN = false;
    bf16_t *Q; unsigned char *K8, *V8; bf16_t *QI, *KI, *UPOOL, *GA, *GP; float* WI; const float *qg, *kg;
    __device__ __forceinline__ void operator()(const pg8::f32x4 (&acc)[2][2][4][2], const Unit& u, int wr, int wc, int fr, int fq) const {
        const int pn = u.pn, row0 = u.pm * 256 + wr * 64 + fr;
        if (pn < 4) {
            const bool isq = pn < 2; const float* g = isq ? qg : kg; const int head = (pn & 1) * 4 + wc;
            f32x4 gv[2][2];
#pragma unroll
            for (int bj = 0; bj < 2; ++bj)
#pragma unroll
                for (int n = 0; n < 2; ++n) gv[bj][n] = *(const f32x4*)(g + 32 * bj + 16 * n + 4 * fq);
#pragma unroll
            for (int ai = 0; ai < 2; ++ai)
#pragma unroll
                for (int m = 0; m < 4; ++m) {
                    float ss = 0.f;
#pragma unroll
                    for (int bj = 0; bj < 2; ++bj)
#pragma unroll
                        for (int n = 0; n < 2; ++n) { const f32x4 x = acc[ai][bj][m][n]; ss += (x[0] * x[0] + x[1] * x[1]) + (x[2] * x[2] + x[3] * x[3]); }
                    ss += __shfl_xor(ss, 16); ss += __shfl_xor(ss, 32);
                    const float rstd = 1.0f / sqrtf(ss * (1.0f / 64.0f) + EPS);
                    const size_t ro = (size_t)(row0 + ai * 128 + m * 16) * AW + head * 64 + 4 * fq;
#pragma unroll
                    for (int bj = 0; bj < 2; ++bj)
#pragma unroll
                        for (int n = 0; n < 2; ++n) { const f32x4 y = acc[ai][bj][m][n] * rstd * gv[bj][n];
                            if (isq) *(u32x2*)(Q + ro + 32 * bj + 16 * n) = pk4(y); else *(unsigned*)(K8 + ((size_t)head * M + (row0 + ai * 128 + m * 16)) * 128 + 4 * fq + 32 * bj + 16 * n) = pk4_fp8(y); }
                }
            return;
        }
        const int colw = wc * 32 + 4 * fq;
        if (pn == 7) {
#pragma unroll
            for (int ai = 0; ai < 2; ++ai)
#pragma unroll
                for (int m = 0; m < 4; ++m) { const int row = row0 + ai * 128 + m * 16;
                    if (wc < 2) {
#pragma unroll
                        for (int n = 0; n < 2; ++n) { const int c = colw + 16 * n; *(u32x2*)(KI + (size_t)(row >> 5) * 2048 + (c >> 4) * 512 + ((((c >> 3) & 1) * 32 + (row & 31)) * 8) + (c & 7)) = pk4(acc[ai][0][m][n]); }
                    } else if (wc == 2 && fq == 0) { *(f32x4*)(WI + (size_t)row * 4) = acc[ai][0][m][0] * 0.5f; }
                }
            return;
        }
        if (pn < 6) {
#pragma unroll
            for (int ai = 0; ai < 2; ++ai)
#pragma unroll
                for (int m = 0; m < 4; ++m) { const int row = row0 + ai * 128 + m * 16;
#pragma unroll
                    for (int bj = 0; bj < 2; ++bj)
#pragma unroll
                        for (int n = 0; n < 2; ++n) { const int col = (pn - 4) * 256 + colw + 128 * bj + 16 * n;
                            *(unsigned*)(V8 + ((size_t)(col >> 6) * M + row) * 128 + 64 + (col & 63)) = pk4_fp8(acc[ai][bj][m][n]); } }
            return;
        }
        bf16_t* O; int ldo, ct; float sc = 1.0f; bool sig = false;
        if (pn == 6) { O = QI; ldo = 256; ct = 0; sc = 0.125f; }
        else if (pn < 10) { O = UPOOL; ldo = PW; ct = (pn - 8) * 256; }
        else if (pn < 14) { O = GA; ldo = DM; ct = (pn - 10) * 256; sig = true; }
        else { O = GP; ldo = DM; ct = (pn - 14) * 256; sig = true; }
#pragma unroll
        for (int ai = 0; ai < 2; ++ai)
#pragma unroll
            for (int m = 0; m < 4; ++m) { bf16_t* rowp = O + (size_t)(row0 + ai * 128 + m * 16) * ldo + ct + colw;
#pragma unroll
                for (int bj = 0; bj < 2; ++bj)
#pragma unroll
                    for (int n = 0; n < 2; ++n) { f32x4 y = acc[ai][bj][m][n] * sc;
                        if (sig) { y[0] = sigmoidf_(y[0]); y[1] = sigmoidf_(y[1]); y[2] = sigmoidf_(y[2]); y[3] = sigmoidf_(y[3]); }
                        *(u32x2*)(rowp + 128 * bj + 16 * n) = pk4(y); }
            }
    }
};

template <int MODE> struct EpiBf {
    static constexpr bool PERM = false, AFTER_DRAIN = false;
    bf16_t* O; int ldo; const float* colscale; const bf16_t* ADD;
    __device__ __forceinline__ void operator()(const pg8::f32x4 (&acc)[2][2][4][2], const Unit& u, int wr, int wc, int fr, int fq) const {
        const int row0 = u.pm * 256 + wr * 64 + fr, col0 = u.pn * 256 + wc * 32 + 4 * fq;
#pragma unroll
        for (int ai = 0; ai < 2; ++ai)
#pragma unroll
            for (int m = 0; m < 4; ++m) { const size_t ro = (size_t)(row0 + ai * 128 + m * 16) * ldo + col0;
#pragma unroll
                for (int bj = 0; bj < 2; ++bj)
#pragma unroll
                    for (int n = 0; n < 2; ++n) { f32x4 y = acc[ai][bj][m][n]; const size_t off = ro + 128 * bj + 16 * n;
                        if (MODE == 3) { }
                        else if (MODE == 0) { y = y * *(const f32x4*)(colscale + col0 + 128 * bj + 16 * n); }
                        else { const u32x2 gq = *(const u32x2*)(O + off); y[0] *= bf_lo(gq.x); y[1] *= bf_hi(gq.x); y[2] *= bf_lo(gq.y); y[3] *= bf_hi(gq.y);
                            if (MODE == 2) { const u32x2 a = *(const u32x2*)(ADD + off); y[0] += bf_lo(a.x); y[1] += bf_hi(a.x); y[2] += bf_lo(a.y); y[3] += bf_hi(a.y); } }
                        *(u32x2*)(O + off) = pk4(y); }
            }
    }
};

struct EpiRes {
    static constexpr bool PERM = false, AFTER_DRAIN = false;
    const float* BASE; float* OUT; const float* gate; float dbg;
    __device__ __forceinline__ void operator()(const pg8::f32x4 (&acc)[2][2][4][2], const Unit& u, int wr, int wc, int fr, int fq) const {
        const int row0 = u.pm * 256 + wr * 64 + fr, col0 = u.pn * 256 + wc * 32 + 4 * fq;
        f32x4 gv[2][2];
#pragma unroll
        for (int bj = 0; bj < 2; ++bj)
#pragma unroll
            for (int n = 0; n < 2; ++n) gv[bj][n] = *(const f32x4*)(gate + col0 + 128 * bj + 16 * n);
#pragma unroll
        for (int ai = 0; ai < 2; ++ai)
#pragma unroll
            for (int m = 0; m < 4; ++m) { const int row = row0 + ai * 128 + m * 16; const size_t ro = (size_t)row * DM + col0;
#pragma unroll
                for (int bj = 0; bj < 2; ++bj)
#pragma unroll
                    for (int n = 0; n < 2; ++n) { const size_t off = ro + 128 * bj + 16 * n; f32x4 y = *(const f32x4*)(BASE + off) + gv[bj][n] * acc[ai][bj][m][n];
                        if (dbg != 0.f) { const float sg = ((row * 7 + (int)(off >> 2)) & 1) ? dbg : -dbg; y[0] += sg; y[1] -= sg; y[2] += sg; y[3] -= sg; }
                        *(f32x4*)(OUT + off) = y; }
            }
    }
};

template <int CTRL> __device__ __forceinline__ float dppf(float x) { return __builtin_bit_cast(float, __builtin_amdgcn_update_dpp(0, __builtin_bit_cast(int, x), CTRL, 0xf, 0xf, false)); }
__device__ __forceinline__ f32x4 ror1(f32x4 v) { f32x4 r; r[0] = dppf<0x121>(v[0]); r[1] = dppf<0x121>(v[1]); r[2] = dppf<0x121>(v[2]); r[3] = dppf<0x121>(v[3]); return r; }
__device__ __forceinline__ f32x4 ror2(f32x4 v) { f32x4 r; r[0] = dppf<0x122>(v[0]); r[1] = dppf<0x122>(v[1]); r[2] = dppf<0x122>(v[2]); r[3] = dppf<0x122>(v[3]); return r; }
__device__ __forceinline__ f32x4 silu_mul(f32x4 a, f32x4 b) { f32x4 r;
#pragma unroll
    for (int e = 0; e < 4; ++e) r[e] = a[e] * __builtin_amdgcn_rcpf(1.0f + __expf(-a[e])) * b[e];
    return r; }
struct EpiUpAct {
    static constexpr bool PERM = false, AFTER_DRAIN = false;
    bf16_t* ACT; float* RAW; const float* cw; const float* cb;
    __device__ __forceinline__ void operator()(const pg8::f32x4 (&acc)[2][2][4][2], const Unit& u, int wr, int wc, int fr, int fq) const {
#pragma unroll
        for (int n = 0; n < 2; ++n) {
            const int ch = u.pn * 128 + wc * 32 + 4 * fq + 16 * n;
            const f32x4 w0a = *(const f32x4*)(cw + ch), w1a = *(const f32x4*)(cw + FF2 + ch), w2a = *(const f32x4*)(cw + 2 * FF2 + ch), ba = *(const f32x4*)(cb + ch);
            const f32x4 w0b = *(const f32x4*)(cw + FF + ch), w1b = *(const f32x4*)(cw + FF2 + FF + ch), w2b = *(const f32x4*)(cw + 2 * FF2 + FF + ch), bb = *(const f32x4*)(cb + FF + ch);
#pragma unroll
            for (int ai = 0; ai < 2; ++ai) {
                const int blk = u.pm * 4 + ai * 2 + wr;
                if (fr < 2) { *(f32x4*)(RAW + (size_t)(blk * 4 + fr) * FF2 + ch) = acc[ai][0][0][n]; *(f32x4*)(RAW + (size_t)(blk * 4 + fr) * FF2 + FF + ch) = acc[ai][1][0][n]; }
                if (fr >= 14) { *(f32x4*)(RAW + (size_t)(blk * 4 + fr - 12) * FF2 + ch) = acc[ai][0][3][n]; *(f32x4*)(RAW + (size_t)(blk * 4 + fr - 12) * FF2 + FF + ch) = acc[ai][1][3][n]; }
                f32x4 pa1 = {0.f, 0.f, 0.f, 0.f}, pa2 = pa1, pb1 = pa1, pb2 = pa1;
#pragma unroll
                for (int m = 0; m < 4; ++m) {
                    const f32x4 va = acc[ai][0][m][n], vb = acc[ai][1][m][n];
                    const f32x4 ra1 = ror1(va), ra2 = ror2(va), rb1 = ror1(vb), rb2 = ror2(vb);
                    const f32x4 xa1 = fr >= 1 ? ra1 : pa1, xa2 = fr >= 2 ? ra2 : pa2, xb1 = fr >= 1 ? rb1 : pb1, xb2 = fr >= 2 ? rb2 : pb2;
                    pa1 = ra1; pa2 = ra2; pb1 = rb1; pb2 = rb2;
                    const f32x4 ya = ba + w0a * xa2 + w1a * xa1 + w2a * va, yb = bb + w0b * xb2 + w1b * xb1 + w2b * vb;
                    const f32x4 o = silu_mul(ya, yb);
                    if (!(m == 0 && fr < 2)) *(u32x2*)(ACT + (size_t)(blk * 64 + 16 * m + fr) * FF + ch) = pk4(o);
                }
            }
        }
    }
};

__device__ __forceinline__ void fixup_phase(const float* RAW, bf16_t* ACT, const float* cw, const float* cb, int gtid, int nthr) {
    for (int it = gtid; it < 256 * 2 * 704; it += nthr) {
        const int c4 = it % 704, rr = (it / 704) & 1, blk = it / 1408, ch = 4 * c4;
        const float* cur = RAW + (size_t)(blk * 4 + rr) * FF2;
        const float* p1 = rr == 1 ? RAW + (size_t)(blk * 4) * FF2 : (blk > 0 ? RAW + (size_t)((blk - 1) * 4 + 3) * FF2 : nullptr);
        const float* p2 = rr == 1 ? (blk > 0 ? RAW + (size_t)((blk - 1) * 4 + 3) * FF2 : nullptr) : (blk > 0 ? RAW + (size_t)((blk - 1) * 4 + 2) * FF2 : nullptr);
        const f32x4 z = {0.f, 0.f, 0.f, 0.f};
        const f32x4 va = *(const f32x4*)(cur + ch), vb = *(const f32x4*)(cur + FF + ch);
        const f32x4 a1 = p1 ? *(const f32x4*)(p1 + ch) : z, b1 = p1 ? *(const f32x4*)(p1 + FF + ch) : z;
        const f32x4 a2 = p2 ? *(const f32x4*)(p2 + ch) : z, b2 = p2 ? *(const f32x4*)(p2 + FF + ch) : z;
        const f32x4 ya = *(const f32x4*)(cb + ch) + *(const f32x4*)(cw + ch) * a2 + *(const f32x4*)(cw + FF2 + ch) * a1 + *(const f32x4*)(cw + 2 * FF2 + ch) * va;
        const f32x4 yb = *(const f32x4*)(cb + FF + ch) + *(const f32x4*)(cw + FF + ch) * b2 + *(const f32x4*)(cw + FF2 + FF + ch) * b1 + *(const f32x4*)(cw + 2 * FF2 + FF + ch) * vb;
        *(u32x2*)(ACT + (size_t)(blk * 64 + rr) * FF + ch) = pk4(silu_mul(ya, yb));
    }
}

template <int W> __device__ __forceinline__ void pooled_item(const bf16_t* UPOOL, bf16_t* POOLED, int t, int c8) {
    v4u v[W];
#pragma unroll
    for (int j = 0; j < W; ++j) { const int tj = (t - j) >= 0 ? (t - j) : 0; v[j] = *(const v4u*)(UPOOL + (size_t)tj * PW + 8 * c8); }
    float s[8];
#pragma unroll
    for (int e = 0; e < 8; ++e) s[e] = 0.f;
#pragma unroll
    for (int j = 0; j < W; ++j) { const float m = (t - j) >= 0 ? 1.f : 0.f;
        s[0] = fmaf(m, bf_lo(v[j].x), s[0]); s[1] = fmaf(m, bf_hi(v[j].x), s[1]); s[2] = fmaf(m, bf_lo(v[j].y), s[2]); s[3] = fmaf(m, bf_hi(v[j].y), s[3]);
        s[4] = fmaf(m, bf_lo(v[j].z), s[4]); s[5] = fmaf(m, bf_hi(v[j].z), s[5]); s[6] = fmaf(m, bf_lo(v[j].w), s[6]); s[7] = fmaf(m, bf_hi(v[j].w), s[7]); }
    const int cntw = (t + 1) < W ? (t + 1) : W; const float inv = 1.0f / (float)cntw; v4u o;
    o.x = pkbf(s[0] * inv - bf_lo(v[0].x), s[1] * inv - bf_hi(v[0].x)); o.y = pkbf(s[2] * inv - bf_lo(v[0].y), s[3] * inv - bf_hi(v[0].y));
    o.z = pkbf(s[4] * inv - bf_lo(v[0].z), s[5] * inv - bf_hi(v[0].z)); o.w = pkbf(s[6] * inv - bf_lo(v[0].w), s[7] * inv - bf_hi(v[0].w));
    *(v4u*)(POOLED + (size_t)t * PW + 8 * c8) = o;
}
__device__ __forceinline__ void pooled_phase(const bf16_t* UPOOL, bf16_t* POOLED, int gtid, int nthr) {
    for (int it = gtid; it < M * 64; it += nthr) {
        const int wv = it >> 6, l = it & 63, g = wv & 3, t = (wv >> 2) * 4 + (l >> 4), c8 = g * 16 + (l & 15);
        if (g == 0) pooled_item<2>(UPOOL, POOLED, t, c8); else if (g == 1) pooled_item<4>(UPOOL, POOLED, t, c8); else if (g == 2) pooled_item<8>(UPOOL, POOLED, t, c8); else pooled_item<16>(UPOOL, POOLED, t, c8);
    }
}

#ifndef ATT_MFMA
#define ATT_MFMA 1
#endif
#ifndef SP_QB
#define SP_QB 64
#endif
#ifndef SP_Z
#define SP_Z 3.5f
#endif
#ifndef SP_DRY
#define SP_DRY 0
#endif
#define MFMA32(a, b, c) __builtin_amdgcn_mfma_f32_32x32x16_bf16((a), (b), (c), 0, 0, 0)
__device__ __forceinline__ unsigned lds_add(LAS unsigned* p, unsigned v) { return __hip_atomic_fetch_add(p, v, __ATOMIC_RELAXED, __HIP_MEMORY_SCOPE_WORKGROUP); }
__device__ __forceinline__ unsigned lds_and(LAS unsigned* p, unsigned v) { return __hip_atomic_fetch_and(p, v, __ATOMIC_RELAXED, __HIP_MEMORY_SCOPE_WORKGROUP); }
__device__ __forceinline__ unsigned lds_or(LAS unsigned* p, unsigned v) { return __hip_atomic_fetch_or(p, v, __ATOMIC_RELAXED, __HIP_MEMORY_SCOPE_WORKGROUP); }

__device__ __forceinline__ unsigned f2sort(float f) { unsigned uu = __float_as_uint(f); return uu ^ (((unsigned)((int)uu >> 31)) | 0x80000000u); }
__device__ __forceinline__ float u2f(unsigned u) { return __uint_as_float((u & 0x80000000u) ? (u & 0x7fffffffu) : ~u); }
constexpr unsigned SP_CAP = 48u, SP_PHYS = 64u;
template <bool EMIT>
__device__ __forceinline__ unsigned tk_pass(int qb, int wave, int lane, const bf16_t* KI, const LAS bf16_t* QF, const float (&wv)[4], LAS unsigned* H, LAS unsigned* SELM, LAS unsigned* TIEM,
                                        int sh, unsigned vlo, bool clampTop, unsigned bmax, int stage, unsigned vmin, float fsel, float ftie, unsigned vmax = 0xffffffffu,
                                        bool append = false, float ftie_a = 0.f, unsigned char* lst = nullptr, unsigned loff0 = 0u) {
    const int r = lane & 31, h = lane >> 5;
    unsigned loff = loff0, lovf = 0u;
    const unsigned long long appmask = __ballot(ftie_a == ftie);
    const bool appfast = __ballot(ftie_a != ftie && ftie_a != INFINITY) == 0ull;
    const int gstep = stage == 1 ? 8 : 1, g0 = stage == 1 ? wave : 0;
#define TK_NEXT_G(g) ({ int _g = (g) + gstep; if (stage == 2 && (_g & 7) == wave) ++_g; _g; })
    int gcur = g0; if (stage == 2 && (gcur & 7) == wave) ++gcur;
    pg8::bf16x8 kf[4];
    { const int T0 = (wave + 8 * gcur) <= qb ? (wave + 8 * gcur) : qb; const bf16_t* kp = KI + (size_t)T0 * 2048 + 8 * lane;
#pragma unroll
      for (int s = 0; s < 4; ++s) kf[s] = *(const pg8::bf16x8*)(kp + 512 * s); }
    LAS unsigned* Hq = H + r * HSTRIDE;
    pg8::bf16x8 qf[16];
#pragma unroll
    for (int f = 0; f < 16; ++f) qf[f] = *(const LAS pg8::bf16x8*)(QF + f * 512 + lane * 8);
#pragma unroll 1
    for (; wave + 8 * gcur <= qb; gcur = TK_NEXT_G(gcur)) {
        const int T = wave + 8 * gcur;
        float sc[16];
#pragma unroll
        for (int i = 0; i < 16; ++i) sc[i] = 0.f;
        f32x16 acur;
#pragma unroll
        for (int i = 0; i < 16; ++i) acur[i] = 0.f;
#pragma unroll
        for (int s = 0; s < 4; ++s) acur = MFMA32(kf[s], qf[s], acur);
#pragma unroll
        for (int hd = 0; hd < 4; ++hd) { f32x16 an;
#pragma unroll
            for (int i = 0; i < 16; ++i) an[i] = 0.f;
            if (hd < 3) {
#pragma unroll
                for (int s = 0; s < 4; ++s) an = MFMA32(kf[s], qf[(hd + 1) * 4 + s], an); }
#pragma unroll
            for (int i = 0; i < 16; ++i) { const float av = acur[i]; const int ab = __float_as_int(av); sc[i] = fmaf(wv[hd], __int_as_float(ab > 0 ? ab : 0), sc[i]); }
            acur = an; }
        { const int Tnn = wave + 8 * TK_NEXT_G(gcur); const int Tn = Tnn <= qb ? Tnn : T; const bf16_t* kp = KI + (size_t)Tn * 2048 + 8 * lane;
#pragma unroll
          for (int s = 0; s < 4; ++s) kf[s] = *(const pg8::bf16x8*)(kp + 512 * s); }
        const int rlim = (T == qb) ? r : 64;
        if (!EMIT) {
#pragma unroll
            for (int i = 0; i < 16; ++i) {
                const int kr = (i & 3) + 8 * (i >> 2) + 4 * h;
                unsigned uu = __float_as_uint(sc[i]); uu ^= ((unsigned)((int)uu >> 31)) | 0x80000000u;
                const unsigned v = uu >> sh; unsigned b = v - vlo;
                const bool ok = (kr <= rlim) && (v >= vmin) && (v <= vmax) && (clampTop || b <= bmax);
                b = b > 2047u ? 2047u : b;
                lds_add(Hq + (ok ? (b >> 1) : 1024u), 1u << ((b & 1u) * 16u));
            }
        } else {
            unsigned ms = 0u, mg = 0u;
            const bool fastapp = append && appfast && T != qb;
            if (fastapp) {
#pragma unroll
                for (int i = 15; i >= 0; --i) {
                    unsigned long long cs, ct;
                    asm("v_cmp_ge_f32_e64 %0, %1, %2" : "=s"(cs) : "v"(sc[i]), "v"(fsel));
                    asm("v_addc_co_u32_e64 %0, vcc, %0, %0, %1" : "+v"(ms) : "s"(cs) : "vcc");
                    asm("v_cmp_ge_f32_e64 %0, %1, %2" : "=s"(ct) : "v"(sc[i]), "v"(ftie));
                    asm("v_addc_co_u32_e64 %0, vcc, %0, %0, %1" : "+v"(mg) : "s"(ct) : "vcc");
                    if (__builtin_amdgcn_inverse_ballot_w64(ct & ~cs & appmask)) { *(u32x2*)(lst + loff) = (u32x2){__float_as_uint(sc[i]), (unsigned)(32 * T + (i & 3) + 8 * (i >> 2) + 4 * h)}; loff += 8u; }
                }
            } else {
#pragma unroll
            for (int i = 15; i >= 0; --i) {
                asm("v_cmp_ge_f32_e32 vcc, %1, %2\n\tv_addc_co_u32_e32 %0, vcc, %0, %0, vcc" : "+v"(ms) : "v"(sc[i]), "v"(fsel) : "vcc");
                asm("v_cmp_ge_f32_e32 vcc, %1, %2\n\tv_addc_co_u32_e32 %0, vcc, %0, %0, vcc" : "+v"(mg) : "v"(sc[i]), "v"(ftie) : "vcc");
            }
            }
            const unsigned vrow = rlim >= 31 ? 0xffffffffu : ((2u << rlim) - 1u);
            auto spread = [&](unsigned m) { return (((m & 0xfu) | ((m & 0xf0u) << 4) | ((m & 0xf00u) << 8) | ((m & 0xf000u) << 12)) << (4 * h)) & vrow; };
            const unsigned msel = spread(ms), mtie = spread(mg) & ~msel;
            const unsigned osel = __shfl_xor(msel, 32), otie = __shfl_xor(mtie, 32);
            if (h == 0) { SELM[r * MSTRIDE + T] = msel | osel; TIEM[r * MSTRIDE + T] = mtie | otie; }
            if (append && !fastapp) {
#pragma unroll
                for (int i = 0; i < 16; ++i) {
                    const int kr = (i & 3) + 8 * (i >> 2) + 4 * h;
                    if ((sc[i] >= ftie_a) && !(sc[i] >= fsel) && (kr <= rlim)) { *(u32x2*)(lst + loff) = (u32x2){__float_as_uint(sc[i]), (unsigned)(32 * T + kr)}; loff += 8u; }
                }
            }
            if (append && loff >= loff0 + (SP_PHYS - 16u) * 8u) { lovf = 1u; loff = loff0; }
        }
    }
#undef TK_NEXT_G
    return loff | lovf;
}

template <int CTRL> __device__ __forceinline__ float dppx(float x) { return __builtin_bit_cast(float, __builtin_amdgcn_mov_dpp(__builtin_bit_cast(int, x), CTRL, 0xf, 0xf, true)); }
__device__ __forceinline__ u32x2 tk_rescore_load(const bf16_t* KI, int key, int lane) {
    const int c = 4 * (lane & 15);
    return *(const u32x2*)(KI + (size_t)(key >> 5) * 2048 + (c >> 4) * 512 + ((((c >> 3) & 1) * 32 + (key & 31)) * 8) + (c & 7));
}
__device__ __forceinline__ float tk_rescore(const u32x2 q4, float wh, const u32x2 k4) {
    float d = bf_lo(q4.x) * bf_lo(k4.x); d = fmaf(bf_hi(q4.x), bf_hi(k4.x), d); d = fmaf(bf_lo(q4.y), bf_lo(k4.y), d); d = fmaf(bf_hi(q4.y), bf_hi(k4.y), d);
    d += dppx<0xB1>(d); d += dppx<0x4E>(d); d += dppx<0x141>(d); d += dppx<0x140>(d);
    float sc = wh * fmaxf(d, 0.f);
    sc += __shfl_xor(sc, 16); sc += __shfl_xor(sc, 32);
    return sc + 0.f;
}

__device__ __forceinline__ int wave_incl_scan(int v) {
    v += __builtin_amdgcn_update_dpp(0, v, 0x111, 0xf, 0xf, true); v += __builtin_amdgcn_update_dpp(0, v, 0x112, 0xf, 0xf, true);
    v += __builtin_amdgcn_update_dpp(0, v, 0x114, 0xf, 0xf, true); v += __builtin_amdgcn_update_dpp(0, v, 0x118, 0xf, 0xf, true);
    v += __builtin_amdgcn_update_dpp(0, v, 0x142, 0xa, 0xf, false); v += __builtin_amdgcn_update_dpp(0, v, 0x143, 0xc, 0xf, false);
    return v;
}
template <int WPL>
__device__ __forceinline__ void tk_scan_core(const LAS unsigned* Hq, int need, int lane, unsigned& Dsel, unsigned& nsel, unsigned& csel, int& total) {
    constexpr int BPL = 2 * WPL;
    asm volatile("" : "+v"(lane));
    int S = 0;
#pragma unroll
    for (int i = 0; i < WPL; ++i) { const unsigned w = Hq[WPL * lane + ((i + lane) & (WPL - 1))]; S += (int)((w & 0xffffu) + (w >> 16)); }
    const int incl = wave_incl_scan(S); total = __builtin_amdgcn_readlane(incl, 63); const int Tabove = total - incl;
    const bool hit = (Tabove < need) && (need <= Tabove + S);
    const unsigned long long mk = __ballot(hit);
    const int L = mk ? (int)__builtin_ctzll(mk) : 0;
    const int remL = need - __builtin_amdgcn_readlane(Tabove, L);
    const unsigned w2 = Hq[WPL * L + ((lane & (BPL - 1)) >> 1)];
    const int c = lane < BPL ? (int)((w2 >> (16 * (lane & 1))) & 0xffffu) : 0;
    const int incl2 = wave_incl_scan(c), tot2 = __builtin_amdgcn_readlane(incl2, 63), above2 = tot2 - incl2;
    const bool hit2 = (lane < BPL) && (above2 < remL) && (remL <= above2 + c);
    const unsigned long long mk2 = __ballot(hit2);
    const int J = mk2 ? (int)__builtin_ctzll(mk2) : 0;
    Dsel = mk ? (unsigned)(BPL * L + J) : 0xffffu; nsel = mk2 ? (unsigned)(remL - __builtin_amdgcn_readlane(above2, J)) : 1u; csel = (unsigned)__builtin_amdgcn_readlane(c, J);
}
__device__ __forceinline__ void tk_scan(const LAS unsigned* Hq, LAS unsigned* pref_p, LAS unsigned* need_p, LAS unsigned* cnt_p, int bits, int lane, LAS unsigned* tot_p = nullptr) {
    unsigned Dsel, nsel, csel; int total;
    tk_scan_core<16>(Hq, (int)*need_p, lane, Dsel, nsel, csel, total);
    if (lane == 0) { *pref_p = bits ? ((*pref_p << bits) | Dsel) : Dsel; *need_p = nsel; if (cnt_p) *cnt_p = csel; if (tot_p) *tot_p = (unsigned)total; }
}

typedef float f32x2_t __attribute__((ext_vector_type(2)));
__device__ __forceinline__ void unpack16(const v4u w, f32x2_t (&f)[8]) {
#pragma unroll
    for (int i = 0; i < 4; ++i) { f[2 * i] = __builtin_amdgcn_cvt_pk_f32_fp8((int)w[i], false); f[2 * i + 1] = __builtin_amdgcn_cvt_pk_f32_fp8((int)w[i], true); }
}
__device__ __forceinline__ void attn_item(int t, int hd, const unsigned short* SEL, const bf16_t* Q, const unsigned char* K8, const unsigned char* V8, bf16_t* ATTN, int lane) {
    constexpr float LOG2E = 1.4426950408889634f;
    const int kk = lane >> 2, part = lane & 3, cnt = (t + 1) < 256 ? (t + 1) : 256;
    const float slope2 = __uint_as_float((unsigned)(126 - hd) << 23) * LOG2E, sc2 = 0.125f * LOG2E;
#if ATT_MFMA
    const int g4 = lane >> 4, bp = 4 * (4 * (lane & 15) + g4), isel = kk & 3;
    long B1, B2;
    { const v4u qa = *(const v4u*)(Q + (size_t)t * AW + hd * 64 + g4 * 16), qb = *(const v4u*)(Q + (size_t)t * AW + hd * 64 + g4 * 16 + 8);
      int b0 = __builtin_amdgcn_cvt_pk_fp8_f32(bf_lo(qa.x), bf_hi(qa.x), 0, false); b0 = __builtin_amdgcn_cvt_pk_fp8_f32(bf_lo(qa.y), bf_hi(qa.y), b0, true);
      int b1 = __builtin_amdgcn_cvt_pk_fp8_f32(bf_lo(qa.z), bf_hi(qa.z), 0, false); b1 = __builtin_amdgcn_cvt_pk_fp8_f32(bf_lo(qa.w), bf_hi(qa.w), b1, true);
      int b2 = __builtin_amdgcn_cvt_pk_fp8_f32(bf_lo(qb.x), bf_hi(qb.x), 0, false); b2 = __builtin_amdgcn_cvt_pk_fp8_f32(bf_lo(qb.y), bf_hi(qb.y), b2, true);
      int b3 = __builtin_amdgcn_cvt_pk_fp8_f32(bf_lo(qb.z), bf_hi(qb.z), 0, false); b3 = __builtin_amdgcn_cvt_pk_fp8_f32(bf_lo(qb.w), bf_hi(qb.w), b3, true);
      B1 = (long)(((unsigned long long)(unsigned)b1 << 32) | (unsigned)b0); B2 = (long)(((unsigned long long)(unsigned)b3 << 32) | (unsigned)b2); }
#else
    f32x2_t q[8];
    { const v4u qa = *(const v4u*)(Q + (size_t)t * AW + hd * 64 + part * 16), qb = *(const v4u*)(Q + (size_t)t * AW + hd * 64 + part * 16 + 8);
#pragma unroll
      for (int i = 0; i < 4; ++i) { q[i] = (f32x2_t){bf_lo(qa[i]) * sc2, bf_hi(qa[i]) * sc2}; q[4 + i] = (f32x2_t){bf_lo(qb[i]) * sc2, bf_hi(qb[i]) * sc2}; } }
#endif
    const unsigned short* lp = SEL + (size_t)t * 256;
    const unsigned char* kb = K8 + (size_t)hd * M * 128 + part * 16; const unsigned char* vb = kb + 64; (void)V8;
    int key[16]; v4u kf[16], vf[16];
#pragma unroll
    for (int r = 0; r < 16; ++r) { const int j = 16 * r + kk; key[r] = (int)lp[j < cnt ? j : cnt - 1]; }
#pragma unroll
    for (int r = 0; r < 16; ++r) { kf[r] = *(const v4u*)(kb + (size_t)key[r] * 128); vf[r] = *(const v4u*)(vb + (size_t)key[r] * 128); }
    float sv[16]; float mx = -INFINITY;
#if ATT_MFMA
    const bool o1 = (isel & 1) != 0, o2 = (isel & 2) != 0;
#pragma unroll
    for (int r = 0; r < 16; ++r) {
        kf[r].x = (unsigned)__builtin_amdgcn_ds_bpermute(bp, (int)kf[r].x); kf[r].y = (unsigned)__builtin_amdgcn_ds_bpermute(bp, (int)kf[r].y);
        kf[r].z = (unsigned)__builtin_amdgcn_ds_bpermute(bp, (int)kf[r].z); kf[r].w = (unsigned)__builtin_amdgcn_ds_bpermute(bp, (int)kf[r].w); }
#pragma unroll
    for (int r = 0; r < 16; ++r) {
        const long A1 = (long)(((unsigned long long)kf[r].y << 32) | kf[r].x), A2 = (long)(((unsigned long long)kf[r].w << 32) | kf[r].z);
        f32x4 acc = {0.f, 0.f, 0.f, 0.f};
        acc = __builtin_amdgcn_mfma_f32_16x16x32_fp8_fp8(A1, B1, acc, 0, 0, 0); acc = __builtin_amdgcn_mfma_f32_16x16x32_fp8_fp8(A2, B2, acc, 0, 0, 0);
        const float a0 = acc[0], a1 = acc[1], a2 = acc[2], a3 = acc[3];
        const float s01 = o1 ? a1 : a0, s23 = o1 ? a3 : a2;
        sv[r] = o2 ? s23 : s01; }
#pragma unroll
    for (int r = 0; r < 16; ++r) { sv[r] = (16 * r + kk) < cnt ? fmaf(sv[r], sc2, -slope2 * (float)(t - key[r])) : -INFINITY; mx = fmaxf(mx, sv[r]); }
#else
#pragma unroll
    for (int r = 0; r < 16; ++r) { f32x2_t kx[8]; unpack16(kf[r], kx); f32x2_t d2 = q[0] * kx[0];
#pragma unroll
        for (int e = 1; e < 8; ++e) d2 = __builtin_elementwise_fma(q[e], kx[e], d2);
        sv[r] = d2.x + d2.y; }
#pragma unroll
    for (int r = 0; r < 16; ++r) sv[r] += dppx<0xB1>(sv[r]);
#pragma unroll
    for (int r = 0; r < 16; ++r) sv[r] += dppx<0x4E>(sv[r]);
#pragma unroll
    for (int r = 0; r < 16; ++r) { sv[r] = (16 * r + kk) < cnt ? sv[r] - slope2 * (float)(t - key[r]) : -INFINITY; mx = fmaxf(mx, sv[r]); }
#endif
    mx = fmaxf(mx, __shfl_xor(mx, 4)); mx = fmaxf(mx, __shfl_xor(mx, 8)); mx = fmaxf(mx, __shfl_xor(mx, 16)); mx = fmaxf(mx, __shfl_xor(mx, 32));
    f32x2_t o[8]; float lsum = 0.f;
#pragma unroll
    for (int e = 0; e < 8; ++e) o[e] = (f32x2_t){0.f, 0.f};
#pragma unroll
    for (int r = 0; r < 16; ++r) { const float p = __builtin_amdgcn_exp2f(sv[r] - mx); lsum += p; f32x2_t vx[8]; unpack16(vf[r], vx); const f32x2_t p2 = (f32x2_t){p, p};
#pragma unroll
        for (int e = 0; e < 8; ++e) o[e] = __builtin_elementwise_fma(p2, vx[e], o[e]); }
    lsum += dppx<0x124>(lsum); lsum += dppx<0x128>(lsum); lsum += __shfl_xor(lsum, 16); lsum += __shfl_xor(lsum, 32);
    float of[16];
#pragma unroll
    for (int e = 0; e < 8; ++e) { of[2 * e] = o[e].x; of[2 * e + 1] = o[e].y; }
#pragma unroll
    for (int e = 0; e < 16; ++e) of[e] += dppx<0x124>(of[e]);
#pragma unroll
    for (int e = 0; e < 16; ++e) of[e] += dppx<0x128>(of[e]);
#pragma unroll
    for (int e = 0; e < 16; ++e) of[e] += __shfl_xor(of[e], 16);
#pragma unroll
    for (int e = 0; e < 16; ++e) of[e] += __shfl_xor(of[e], 32);
    if (lane < 4) { const float inv = __builtin_amdgcn_rcpf(lsum); v4u a, b;
        a.x = pkbf(of[0] * inv, of[1] * inv); a.y = pkbf(of[2] * inv, of[3] * inv); a.z = pkbf(of[4] * inv, of[5] * inv); a.w = pkbf(of[6] * inv, of[7] * inv);
        b.x = pkbf(of[8] * inv, of[9] * inv); b.y = pkbf(of[10] * inv, of[11] * inv); b.z = pkbf(of[12] * inv, of[13] * inv); b.w = pkbf(of[14] * inv, of[15] * inv);
        *(v4u*)(ATTN + (size_t)t * AW + hd * 64 + part * 16) = a; *(v4u*)(ATTN + (size_t)t * AW + hd * 64 + part * 16 + 8) = b; }
}

struct TkPtrs { const bf16_t *QI, *KI; const float* WI; unsigned short* SEL; unsigned char* LST; };
__device__ __forceinline__ void topk_attn_block(int qb, const TkPtrs& P, LAS unsigned char* lds, int tid, int wave, int lane, bool do_attn) {
    LAS unsigned* H = (LAS unsigned*)lds;
    LAS unsigned* SELM = (LAS unsigned*)lds;
    LAS unsigned* TIEM = (LAS unsigned*)(lds + 32 * MSTRIDE * 4);
    LAS unsigned short* LIST = (LAS unsigned short*)(lds + LIST_OFF);
    LAS unsigned* STP = (LAS unsigned*)(lds + ST_OFF);
    LAS unsigned* STN = STP + 32;
    const int t0 = qb * 32, r = lane & 31, h = lane >> 5;
    SYNC();
    float wv[4];
    LAS bf16_t* QF = (LAS bf16_t*)(lds + LIST_OFF);
    { const bf16_t* qp = P.QI + (size_t)(t0 + r) * 256 + 8 * h;
#pragma unroll
      for (int k = 0; k < 2; ++k) { const int f = 2 * wave + k; *(LAS pg8::bf16x8*)(QF + f * 512 + lane * 8) = *(const pg8::bf16x8*)(qp + (f >> 2) * 64 + 16 * (f & 3)); }
      const f32x4 w4 = *(const f32x4*)(P.WI + (size_t)(t0 + r) * 4); wv[0] = w4[0]; wv[1] = w4[1]; wv[2] = w4[2]; wv[3] = w4[3]; }
    LAS unsigned* STC = STP + 64;
    LAS unsigned* STG = STP + 96;
    LAS unsigned* FB = STP + 160;
    LAS unsigned* STS = STP + 192;
    LAS float* FSEL = (LAS float*)(STP + 256);
    LAS float* FTIE = FSEL + 32;
    const bool negw = (wv[0] <= 0.f) && (wv[1] <= 0.f) && (wv[2] <= 0.f) && (wv[3] <= 0.f);
    const unsigned wbase = negw ? 7745u : 22976u;
    LAS unsigned* WINOK = STP + 161;
    LAS unsigned* PBN = STP + 320;
    LAS unsigned* FBS = STP + 162;
    LAS float* FTA = FSEL + 96;
    LAS unsigned* CNTL = STP + 512;
    if (wave == 0 && lane == 0) { *FB = 0u; *WINOK = 0u; *FBS = 0u; }
#pragma unroll 1
    for (int mode = (qb >= SP_QB && blockIdx.x < 256u) ? -1 : 0; mode < 2; ++mode) {
        if (mode == 1) { if ((*FB & 1u) == 0u) break; }
        if (wave == 0 && lane < 32) { STP[lane] = 0u; const int nv = t0 + lane + 1; STN[lane] = nv < 256 ? nv : 256; STG[lane] = negw ? 1u : 0u; }
        const int nstep = mode <= 0 ? 1 : 3;
#pragma unroll 1
        for (int step = 0; step < nstep; ++step) {
            for (int i = tid; i < 32 * HSTRIDE; i += NTHR) H[i] = 0u;
            SYNC();
            const int sh = mode <= 0 ? 17 : (step == 0 ? 21 : (step == 1 ? 10 : 0));
            const unsigned vlo = mode <= 0 ? wbase : (step == 0 ? 0u : (STP[r] << (step == 1 ? 11 : 10)));
            tk_pass<false>(qb, wave, lane, P.KI, QF, wv, H, SELM, TIEM, sh, vlo, mode <= 0, (mode == 1 && step == 2) ? 1023u : 2047u, mode < 0 ? 1 : 0, vlo, 0.f, 0.f);
            SYNC();
#pragma unroll 1
            for (int qq = 0; qq < 4; ++qq) { const int rq = 4 * wave + qq;
                if (mode < 0) {
                    int ns = 0;
#pragma unroll
                    for (int w = 0; w < 8; ++w) { const int first = 9 * w; if (first <= qb) { const int k = (qb - first) >> 6; ns += 32 * (k + 1); if (first + 64 * k == qb) ns -= 31 - rq; } }
                    const float phi = (float)ns / (float)(t0 + rq + 1), mu = 256.f * phi, sd = sqrtf(mu * (1.f - phi));
                    int rhi = (int)floorf(mu - SP_Z * sd); const int rlo = (int)ceilf(mu + SP_Z * sd); rhi = rhi < 1 ? 1 : rhi;
                    unsigned Dh, Dl, n1, c1; int tot1;
                    tk_scan_core<16>(H + rq * HSTRIDE, rhi, lane, Dh, n1, c1, tot1);
                    tk_scan_core<16>(H + rq * HSTRIDE, rlo, lane, Dl, n1, c1, tot1);
                    if (lane == 0) { const unsigned ng = STG[rq] & 1u;
                        if (Dl == 0xffffu) {
                            if (ng) *FBS = 1u;
                            else {
                                FSEL[rq] = (Dh == 0xffffu || Dh == 2047u) ? INFINITY : u2f((22976u + Dh + 1u) << 17); FTIE[rq] = 0.f; FTA[rq] = __uint_as_float(1u); STG[rq] = 8u | 16u; }
                        } else { const unsigned wb = ng ? 7745u : 22976u; const bool zb = ng && Dl == 2047u;
                            const float ft = u2f((wb + Dl) << 17);
                            FSEL[rq] = Dh == 2047u ? INFINITY : u2f((wb + Dh + 1u) << 17); FTIE[rq] = ft; FTA[rq] = zb ? INFINITY : ft;
                            STG[rq] = ng | (zb ? 0u : 8u); } }
                    continue;
                }
                tk_scan(H + rq * HSTRIDE, STP + rq, STN + rq, STC + rq, (mode == 1 && step == 2) ? 10 : 11, lane, PBN + rq);
                if (mode == 0 && lane == 0) { const unsigned D = STP[rq], nn = STN[rq], c = STC[rq], ng = STG[rq] & 1u;
                    if (D == 0xffffu) {
                        if (!ng) { const int nv = t0 + rq + 1; const unsigned need0 = nv < 256 ? nv : 256; PBN[rq] = need0 - PBN[rq]; STG[rq] = 4u; lds_or(FB, 2u); }
                        else lds_or(FB, 1u);
                    } else {
                        const bool zerobin = ng && D == 2047u, edge = (D == 0u) || (D == 2047u && !ng);
                        const bool wantc = (c > nn) && !zerobin;
                        if (edge || (wantc && c > 64u)) lds_or(FB, 1u);
                        STG[rq] = ng | (wantc ? 2u : 0u);
                        const unsigned wb = ng ? 7745u : 22976u;
                        FTIE[rq] = u2f((wb + D) << 17); FSEL[rq] = zerobin ? INFINITY : u2f((wb + D + 1u) << 17); } }
                if (mode == 1 && step == 2 && lane == 0) { const unsigned tau = STP[rq]; FTIE[rq] = u2f(tau); FSEL[rq] = tau == 0xffffffffu ? INFINITY : u2f(tau + 1u); } }
            SYNC();
        }
        if (mode < 0) {
            if (*FBS) continue;
            const unsigned tid8 = (unsigned)((r * 16 + 2 * wave + h) * 512);
            const unsigned lend = tk_pass<true>(qb, wave, lane, P.KI, QF, wv, H, SELM, TIEM, 0, 0u, false, 0u, 0, 0u, FSEL[r], FTIE[r], 0xffffffffu, true, FTA[r], P.LST, tid8);
            CNTL[tid] = (lend & 1u) ? 0xffffu : ((lend - tid8) >> 3);
            SYNC();
#pragma unroll 1
            for (int qq = 0; qq < 4; ++qq) { const int rq = 4 * wave + qq;
                int cs = 0, ct = 0;
#pragma unroll
                for (int i = 0; i < 8; ++i) { const int T = 8 * lane + i; if (T <= qb) { cs += __builtin_popcount(SELM[rq * MSTRIDE + T]); ct += __builtin_popcount(TIEM[rq * MSTRIDE + T]); } }
                cs = __builtin_amdgcn_readlane(wave_incl_scan(cs), 63); ct = __builtin_amdgcn_readlane(wave_incl_scan(ct), 63);
                const unsigned cn = CNTL[64 * ((lane & 15) >> 1) + 32 * (lane & 1) + rq];
                const bool bad = __ballot(cn > SP_CAP) != 0ull;
                if (lane == 0) { if (cs >= 256 || cs + ct < 256 || ((STG[rq] & 8u) && bad)) *FBS = 1u; STN[rq] = (unsigned)(256 - cs); }
            }
            SYNC();
            if (*FBS || SP_DRY) continue;
            break;
        }
        if (mode == 0 && (*FB & 1u)) continue;
        if (mode == 0 && (*FB & 2u)) {
            for (int i = tid; i < 32 * HSTRIDE; i += NTHR) H[i] = 0u;
            if (wave == 0 && lane < 32 && (STG[lane] & 4u)) { STP[lane] = 0u; STN[lane] = PBN[lane]; }
            SYNC();
            const bool isB = (STG[r] & 4u) != 0u;
            tk_pass<false>(qb, wave, lane, P.KI, QF, wv, H, SELM, TIEM, 17, 7745u, true, 2047u, 0, isB ? 7745u : 0xffffffffu, 0.f, 0.f, 22975u);
            SYNC();
#pragma unroll 1
            for (int qq = 0; qq < 4; ++qq) { const int rq = 4 * wave + qq;
                if (STG[rq] & 4u) { tk_scan(H + rq * HSTRIDE, STP + rq, STN + rq, STC + rq, 11, lane);
                    if (lane == 0) { const unsigned D = STP[rq], nn = STN[rq], c = STC[rq];
                        const bool zerobin = D == 2047u, wantc = (c > nn) && !zerobin;
                        if (D == 0xffffu || D == 0u || (wantc && c > 64u)) lds_or(FB, 1u);
                        STG[rq] = wantc ? 2u : 0u;
                        FTIE[rq] = u2f((7745u + D) << 17); FSEL[rq] = zerobin ? __uint_as_float(1u) : u2f((7745u + D + 1u) << 17); } } }
            SYNC();
            if (*FB & 1u) continue;
        }
        tk_pass<true>(qb, wave, lane, P.KI, QF, wv, H, SELM, TIEM, 0, 0u, false, 0u, 0, 0u, FSEL[r], FTIE[r]);
        if (mode == 0 && wave == 0 && lane == 0) *WINOK = 1u;
        SYNC();
        break;
    }
    if (!do_attn) return;
    asm volatile("" : "+v"(lane));
#pragma unroll 1
    for (int qq = 0; qq < 4; ++qq) {
        const int rq = 4 * wave + qq, t = t0 + rq; int mties = (int)STN[rq];
        if (STG[rq] & 8u) {
            const int sl = lane >> 2, cn = (int)CNTL[64 * (sl >> 1) + 32 * (sl & 1) + rq];
            const unsigned lo_u = f2sort(FTA[rq]), span = f2sort(FSEL[rq]) - lo_u;
            const int ptot = __builtin_amdgcn_readlane(wave_incl_scan((lane & 3) == 0 ? cn : 0), 63);
            const bool allc = (STG[rq] & 16u) && ptot < mties;
            unsigned eu[12], ek[12];
#pragma unroll
            for (int m = 0; m < 6; ++m) { const int j0 = 2 * (lane & 3) + 8 * m; const v4u e = *(const v4u*)(P.LST + (size_t)(((rq * 16 + sl) * 64 + j0) * 8));
                eu[2 * m] = j0 < cn ? f2sort(__uint_as_float(e.x)) - lo_u : 0xffffffffu; ek[2 * m] = e.y;
                eu[2 * m + 1] = (j0 + 1) < cn ? f2sort(__uint_as_float(e.z)) - lo_u : 0xffffffffu; ek[2 * m + 1] = e.w; }
            LAS unsigned* Hr = TIEM + rq * MSTRIDE; LAS unsigned* Sr = SELM + rq * MSTRIDE;
            unsigned lo = 0u, width = span; int sh = 22 - (int)__builtin_clz(span | 1u); sh = sh < 0 ? 0 : sh;
            int needc = mties; unsigned long long thr = 0ull; unsigned tieoff = 0xffffffffu; int mt = 0;
            if (allc) {
#pragma unroll
                for (int m = 0; m < 12; ++m) if (eu[m] != 0xffffffffu) { const unsigned bit = 1u << (ek[m] & 31u); lds_or(Sr + (ek[m] >> 5), bit); lds_and(Hr + (ek[m] >> 5), ~bit); }
                LDS_WAIT(); asm volatile("" ::: "memory");
                mties -= ptot;
            } else {
#pragma unroll 1
            for (int round = 0; round < 4; ++round) {
#pragma unroll
                for (int i = 0; i < 8; ++i) Hr[lane + 64 * i] = 0u;
                LDS_WAIT();
#pragma unroll
                for (int m = 0; m < 12; ++m) { const unsigned d = eu[m] - lo; if (d < width) { const unsigned b = d >> sh; lds_add(Hr + (b >> 1), 1u << ((b & 1u) * 16u)); } }
                LDS_WAIT();
                unsigned D, nn, c; int tot;
                tk_scan_core<8>(Hr, needc, lane, D, nn, c, tot);
                if (D == 0xffffu) break;
                if (c == nn) { thr = (unsigned long long)lo + ((unsigned long long)D << sh); break; }
                if (sh == 0) { thr = (unsigned long long)lo + D + 1ull; tieoff = lo + D; mt = (int)nn; break; }
                lo += D << sh; width = 1u << sh; sh = sh > 10 ? sh - 10 : 0; needc = (int)nn;
            }
#pragma unroll
            for (int i = 0; i < 8; ++i) Hr[lane + 64 * i] = 0u;
            LDS_WAIT();
#pragma unroll
            for (int m = 0; m < 12; ++m) { const unsigned bit = 1u << (ek[m] & 31u);
                if (eu[m] != 0xffffffffu && (unsigned long long)eu[m] >= thr) lds_or(Sr + (ek[m] >> 5), bit);
                else if (eu[m] == tieoff && eu[m] != 0xffffffffu) lds_or(Hr + (ek[m] >> 5), bit); }
            LDS_WAIT(); asm volatile("" ::: "memory");
            mties = mt;
            }
        }
        unsigned tw[8], fw[8]; int S = 0;
#pragma unroll
        for (int i = 0; i < 8; ++i) { const int T = 8 * lane + i; const bool v = T <= qb; fw[i] = v ? SELM[rq * MSTRIDE + T] : 0u; tw[i] = 0u; }
        const bool rerank = *WINOK != 0u && (STG[rq] & 2u);
        int incl = 0;
        if (mties > 0 || rerank) {
#pragma unroll
            for (int i = 0; i < 8; ++i) { const int T = 8 * lane + i; tw[i] = T <= qb ? TIEM[rq * MSTRIDE + T] : 0u; S += __builtin_popcount(tw[i]); }
            incl = wave_incl_scan(S); }
        if (rerank) {
            const int c = __builtin_amdgcn_readlane(incl, 63), nn = mties;
            LAS unsigned short* cl = LIST + rq * 256;
            { int pos = incl - S;
#pragma unroll
              for (int i = 0; i < 8; ++i) { unsigned w = tw[i]; while (w) { const int b = __builtin_ctz(w); if (pos < 64) cl[pos] = (unsigned short)(256 * lane + 32 * i + b); ++pos; w &= w - 1u; } } }
            LDS_WAIT(); asm volatile("" ::: "memory");
            const u32x2 q4 = *(const u32x2*)(P.QI + (size_t)t * 256 + 4 * lane); const float wh = P.WI[(size_t)t * 4 + (lane >> 4)];
            float mys = 0.f; const int cc = c < 64 ? c : 64;
#pragma unroll 1
            for (int j0 = 0; j0 < cc; j0 += 8) { u32x2 k4[8];
#pragma unroll
                for (int u = 0; u < 8; ++u) { const int jj = (j0 + u) < cc ? (j0 + u) : (cc - 1); k4[u] = tk_rescore_load(P.KI, __builtin_amdgcn_readfirstlane((int)cl[jj]), lane); }
#pragma unroll
                for (int u = 0; u < 8; ++u) { const float sj = tk_rescore(q4, wh, k4[u]); if (lane == j0 + u) mys = sj; } }
            int rank = 0;
            for (int j = 0; j < cc; ++j) { const float sj = __int_as_float(__builtin_amdgcn_readlane(__float_as_int(mys), j)); rank += (sj > mys || (sj == mys && j < lane)) ? 1 : 0; }
            const bool keepme = lane < cc && rank < nn; const int mykey = lane < cc ? (int)cl[lane] : 0;
#pragma unroll 1
            for (int j = 0; j < cc; ++j) { const int kj = __builtin_amdgcn_readlane(mykey, j); const int kp = __builtin_amdgcn_readlane((int)keepme, j);
                if (kp && (kj >> 8) == lane) {
#pragma unroll
                    for (int i = 0; i < 8; ++i) if (((kj >> 5) & 7) == i) fw[i] |= 1u << (kj & 31); } }
            mties = 0;
        }
        int cl2 = 0;
        if (mties > 0) {
            int take = mties - (incl - S); take = take < 0 ? 0 : (take > S ? S : take);
#pragma unroll
            for (int i = 0; i < 8; ++i) { unsigned w = tw[i]; const int c = __builtin_popcount(w); unsigned keep;
                if (take >= c) { keep = w; take -= c; } else { keep = 0u; for (int k = 0; k < take; ++k) { const unsigned low = w & (0u - w); keep |= low; w ^= low; } take = 0; }
                fw[i] |= keep; } }
#pragma unroll
        for (int i = 0; i < 8; ++i) cl2 += __builtin_popcount(fw[i]);
        const int inc2 = wave_incl_scan(cl2);
        int pos = inc2 - cl2; const int cnt = __builtin_amdgcn_readlane(inc2, 63);
        LAS unsigned short* lp = LIST + rq * 256;
#pragma unroll
        for (int i = 0; i < 8; ++i) { unsigned w = fw[i]; while (w) { const int b = __builtin_ctz(w); if (pos < 256) lp[pos] = (unsigned short)(256 * lane + 32 * i + b); ++pos; w &= w - 1u; } }
        LDS_WAIT(); asm volatile("" ::: "memory");
        (void)cnt;
        *(u32x2*)(P.SEL + (size_t)t * 256 + 4 * lane) = *(const LAS u32x2*)(lp + 4 * lane);
    }
}

struct OneUnit { int pm, pn;
    __device__ __forceinline__ bool next(int i, pg8::Unit& u) const { if (i != 0) return false; u.pm = pm; u.pn = pn; return true; }
    __device__ __forceinline__ void a_ready(const pg8::Unit&) const {}
    __device__ __forceinline__ void done(const pg8::Unit&) const {}
};
struct Args { const float* in[18]; float* out; unsigned char* ws; int ph_lo, ph_hi; };
constexpr int NPH = 13;

typedef const __attribute__((address_space(4))) unsigned long long* kargp_t;
#define KARGS() kargp_t kargs = (kargp_t)__builtin_amdgcn_kernarg_segment_ptr(); asm volatile("" : "+s"(kargs)); GAS unsigned char* const ws = (GAS unsigned char*)kargs[19]; (void)ws
#define KIN(i) ((const float*)(const GAS float*)kargs[(i)])
#define KOUT() ((float*)(GAS float*)kargs[18])
#define WSP(T, off) ((T*)(GAS T*)(ws + (off)))
__global__ void __launch_bounds__(NTHR, 2) fwd_kernel(Args a) {
    extern __shared__ __attribute__((aligned(16))) unsigned char lds_raw[];
    LAS unsigned char* lds = (LAS unsigned char*)lds_raw;
    const int lo = a.ph_lo, hi = a.ph_hi;
    { int tid0 = threadIdx.x; asm volatile("" : "+v"(tid0)); for (int u = tid0; u < (LDS_BYTES - MISC_OFF) / 4; u += NTHR) ((LAS unsigned*)(lds + MISC_OFF))[u] = 0u; }
    SYNC();
    XcdBarrier bar; bar.bar = nullptr; bar.x = 0; bar.st = nullptr;
    if (hi - lo > 1) { KARGS(); bar = xcd_barrier_post((unsigned*)(GAS unsigned*)(ws + WS_CTL) + CW_BAR, (volatile LAS unsigned*)(lds + MISC_OFF) + 8); }
#define IN(k) (lo <= (k) && (k) < hi)
#define SEAM(k) do { if (IN(k) && IN((k) + 1)) xcd_barrier(bar); } while (0)
#define IDS() const int tid = threadIdx.x, lane = tid & 63, wave = __builtin_amdgcn_readfirstlane(tid >> 6), G = gridDim.x, bid = blockIdx.x; (void)lane; (void)wave; (void)G; (void)bid

    for (int rep_ph = 0; rep_ph < ((REP_PH == 0) ? 2 : 1); ++rep_ph) if (IN(0)) { KARGS(); IDS();
        P0Ptrs P{KIN(1), KIN(2), KIN(5), KIN(8), KIN(9), KIN(11), KIN(12), KIN(14), KIN(17), KIN(10), WSP(bf16_t, WS_WIN), WSP(bf16_t, WS_WATTN), WSP(bf16_t, WS_WGRP), WSP(bf16_t, WS_WPOOL), WSP(bf16_t, WS_WOUT),
                 WSP(bf16_t, WS_WUP), WSP(bf16_t, WS_WDOWN), WSP(float, WS_MODP)};
        p0_prologue(P, lds, bid * NWAVES + wave, G * NWAVES, wave, lane);
    }
    SEAM(0);
    if (IN(1)) { KARGS(); IDS();
        const float *b_ada = KIN(3), *norm1_g = KIN(4); const float* MODP = WSP(float, WS_MODP); float* MODF = WSP(float, WS_MODF);
        LAS float* mulv = (LAS float*)lds; LAS float* addv = mulv + 1024;
        for (int i = tid; i < 1024; i += NTHR) { float sh = b_ada[i], scv = b_ada[1024 + i];
#pragma unroll
            for (int kc = 0; kc < 16; ++kc) { sh += MODP[kc * NMOD + i]; scv += MODP[kc * NMOD + 1024 + i]; }
            mulv[i] = norm1_g[i] * (1.0f + scv); addv[i] = sh; }
        if (bid < 24 && tid < 256) { const int i = bid * 256 + tid; float v = b_ada[i];
#pragma unroll
            for (int kc = 0; kc < 16; ++kc) v += MODP[kc * NMOD + i];
            MODF[i] = v; }
        SYNC();
        modulate_rows(KIN(0), WSP(bf16_t, WS_H), mulv, addv, bid * NWAVES + wave, G * NWAVES, lane);
        SYNC();
    }
    SEAM(1);
    for (int rep_ph = 0; rep_ph < ((REP_PH == 2) ? 2 : 1); ++rep_ph) if (IN(2)) { KARGS(); IDS();
        pg8::Gemm g{WSP(bf16_t, WS_H), WSP(bf16_t, WS_WIN), M, NINP, DM}; pg8::StaticOrder S; S.init(M, NINP, G, bid);
        EpiProj E{WSP(bf16_t, WS_Q), WSP(unsigned char, WS_K), WSP(unsigned char, WS_K), WSP(bf16_t, WS_QI), WSP(bf16_t, WS_KI), WSP(bf16_t, WS_UPOOL), WSP(bf16_t, WS_GA), WSP(bf16_t, WS_GP), WSP(float, WS_WI), KIN(6), KIN(7)};
        pg8::gemm_phase<EpiProj, pg8::StaticOrder, true, true>(lds, g, S, E);
    }
    SEAM(2);
    if (IN(3)) { KARGS(); IDS();
        if (bid < 8) {
            pg8::Gemm g{WSP(bf16_t, WS_WPOOL), WSP(bf16_t, WS_WGRP), 1024, PW, PW}; OneUnit S{bid >> 1, bid & 1};
            EpiBf<3> E{WSP(bf16_t, WS_POOLMIX), PW, nullptr, nullptr};
            pg8::gemm_phase<EpiBf<3>, OneUnit, true, true>(lds, g, S, E);
            SYNC();
        }
        pooled_phase(WSP(bf16_t, WS_UPOOL), WSP(bf16_t, WS_POOLED), bid * NTHR + tid, G * NTHR);
        const int lb = bid & 255; const size_t lsto = (lb < 128 ? WS_H : (lb < 192 ? WS_ATTN - 128u * 262144u : WS_V - 192u * 262144u)) + (size_t)lb * 262144u;
        TkPtrs T{WSP(bf16_t, WS_QI), WSP(bf16_t, WS_KI), WSP(float, WS_WI), (unsigned short*)KOUT(), WSP(unsigned char, lsto)};
        unsigned* qctr = (unsigned*)(GAS unsigned*)(ws + WS_CTL) + CW_QUEUE;
        LAS int* qslot = (LAS int*)(lds + ST_OFF + 2040);
#pragma unroll 1
        for (;;) {
            SYNC();
            if (tid == 0) *qslot = (int)__hip_atomic_fetch_add(qctr, 1u, __ATOMIC_RELAXED, __HIP_MEMORY_SCOPE_AGENT);
            SYNC();
            const int qi0 = *qslot;
            const int qi = qi0;
            if (qi >= 512 * (1 + REP_TKONLY)) break;
            topk_attn_block(511 - (qi & 511), T, lds, tid, wave, lane, qi >= 512 * REP_TKONLY);
        }
        SYNC();
    }
    SEAM(3);
    if (IN(4)) { KARGS(); IDS();
        {
        pg8::Gemm g{WSP(bf16_t, WS_POOLED), WSP(bf16_t, WS_POOLMIX), M, DM, PW}; pg8::StaticOrder S; S.init(M, DM, G, bid);
        EpiBf<1> E{WSP(bf16_t, WS_GP), DM, nullptr, nullptr};
        pg8::gemm_phase<EpiBf<1>, pg8::StaticOrder, true, true>(lds, g, S, E);
        }
        SYNC();
        const unsigned short* SEL = (const unsigned short*)KOUT(); const bf16_t* Qp = WSP(bf16_t, WS_Q); const unsigned char *K8 = WSP(unsigned char, WS_K), *V8 = WSP(unsigned char, WS_K); bf16_t* ATTN = WSP(bf16_t, WS_ATTN);
        const bool aff = (G & 7) == 0; const int nitem = 8 * M, step = aff ? (G >> 3) * NWAVES : G * NWAVES;
#pragma unroll 1
        for (int it = aff ? (bid >> 3) * NWAVES + wave : bid * NWAVES + wave; it < (aff ? M : nitem); it += step) attn_item(aff ? it : (it >> 3), aff ? (bid & 7) : (it & 7), SEL, Qp, K8, V8, ATTN, lane);
    }
    SEAM(4);
    if (IN(7)) { KARGS(); IDS();
        pg8::Gemm g{WSP(bf16_t, WS_ATTN), WSP(bf16_t, WS_WATTN), M, DM, AW}; pg8::StaticOrder S; S.init(M, DM, G, bid);
        EpiBf<2> E{WSP(bf16_t, WS_GA), DM, nullptr, WSP(bf16_t, WS_GP)};
        pg8::gemm_phase<EpiBf<2>, pg8::StaticOrder, true, true>(lds, g, S, E);
    }
    SEAM(7);
    for (int rep_ph = 0; rep_ph < ((REP_PH == 8) ? 2 : 1); ++rep_ph) if (IN(8)) { KARGS(); IDS();
        pg8::Gemm g{WSP(bf16_t, WS_GA), WSP(bf16_t, WS_WOUT), M, DM, DM}; pg8::StaticOrder S; S.init(M, DM, G, bid);
        EpiRes E{KIN(0), KOUT(), WSP(float, WS_MODF) + 2048, 0.f};
        pg8::gemm_phase<EpiRes, pg8::StaticOrder, true, true>(lds, g, S, E);
    }
    SEAM(8);
    if (IN(9)) { KARGS(); IDS();
        const float* norm2_g = KIN(13); const float* MODF = WSP(float, WS_MODF);
        LAS float* mulv = (LAS float*)lds; LAS float* addv = mulv + 1024;
        for (int i = tid; i < 1024; i += NTHR) { mulv[i] = norm2_g[i] * (1.0f + MODF[4096 + i]); addv[i] = MODF[3072 + i]; }
        SYNC();
        modulate_rows(KOUT(), WSP(bf16_t, WS_H), mulv, addv, bid * NWAVES + wave, G * NWAVES, lane);
        SYNC();
    }
    SEAM(9);
    for (int rep_ph = 0; rep_ph < ((REP_PH == 10) ? 2 : 1); ++rep_ph) if (IN(10)) { KARGS(); IDS();
        pg8::Gemm g{WSP(bf16_t, WS_H), WSP(bf16_t, WS_WUP), M, FF2, DM}; pg8::StaticOrder S; S.init(M, FF2, G, bid);
        EpiUpAct E{WSP(bf16_t, WS_ACT), WSP(float, WS_RAW), KIN(15), KIN(16)};
        pg8::gemm_phase<EpiUpAct, pg8::StaticOrder, true, true>(lds, g, S, E);
    }
    SEAM(10);
    if (IN(11)) { KARGS(); IDS(); fixup_phase(WSP(float, WS_RAW), WSP(bf16_t, WS_ACT), KIN(15), KIN(16), bid * NTHR + tid, G * NTHR); }
    SEAM(11);
    if (IN(12)) { KARGS(); IDS();
        pg8::Gemm g{WSP(bf16_t, WS_ACT), WSP(bf16_t, WS_WDOWN), M, DM, FF}; pg8::StaticOrder S; S.init(M, DM, G, bid);
        EpiRes E{KOUT(), KOUT(), WSP(float, WS_MODF) + 5120, DBG_C};
        pg8::gemm_phase<EpiRes, pg8::StaticOrder, true, true>(lds, g, S, E);
    }
#undef IN
#undef SEAM
}

extern "C" void kernel_launch(void* const* d_in, const int* in_sizes, int n_in, void* d_out, int out_size, void* d_ws, size_t ws_size, hipStream_t stream) {
    static int grid = 0;
    if (grid == 0) {
        if (n_in != 18 || in_sizes[0] != M * DM || out_size != M * DM || ws_size < WS_END) { fprintf(stderr, "kernel_launch: unexpected shapes (n_in %d, in0 %d, out %d, ws %zu)\n", n_in, n_in > 0 ? in_sizes[0] : -1, out_size, ws_size); grid = -1; return; }
        int dev = 0, cus = 0, per_cu = 0;
        if (hipGetDevice(&dev) != hipSuccess || hipDeviceGetAttribute(&cus, hipDeviceAttributeMultiprocessorCount, dev) != hipSuccess) { grid = -1; return; }
        if (hipFuncSetAttribute((const void*)fwd_kernel, hipFuncAttributeMaxDynamicSharedMemorySize, LDS_BYTES) != hipSuccess) { fprintf(stderr, "kernel_launch: hipFuncSetAttribute failed\n"); grid = -1; return; }
        if (hipOccupancyMaxActiveBlocksPerMultiprocessor(&per_cu, (const void*)fwd_kernel, NTHR, LDS_BYTES) != hipSuccess || per_cu < 1) fprintf(stderr, "kernel_launch: occupancy query says %d\n", per_cu);
        (void)hipGetLastError();
        grid = cus;
    }
    if (grid < 0) return;
    (void)hipMemsetAsync((char*)d_ws + WS_CTL, 0, CTL_ZERO_BYTES, stream);
    Args a{};
    for (int i = 0; i < 18; ++i) a.in[i] = (const float*)d_in[i];
    a.out = (float*)d_out; a.ws = (unsigned char*)d_ws;
#if N_LAUNCH_MODE == 1
    a.ph_lo = 0; a.ph_hi = NPH;
    hipLaunchKernelGGL(fwd_kernel, dim3(grid), dim3(NTHR), LDS_BYTES, stream, a);
#else
    for (int p = 0; p < NPH; ++p) { a.ph_lo = p; a.ph_hi = p + 1; hipLaunchKernelGGL(fwd_kernel, dim3(grid), dim3(NTHR), LDS_BYTES, stream, a); }
#endif
}
```

```cpp
#include <hip/hip_runtime.h>
#include <cstdio>
#include <cstdint>
#ifndef REP_TKONLY
#define REP_TKONLY 0
#endif
#ifndef REP_BLK
#define REP_BLK 1
#endif
__device__ __forceinline__ int hw_lane() { int l; asm volatile("v_mbcnt_lo_u32_b32 %0, -1, 0\n\tv_mbcnt_hi_u32_b32 %0, -1, %0" : "=v"(l)); return l; }
namespace pg8 {
#define PG8_LAS __attribute__((address_space(3)))
typedef unsigned short bf16_t;
typedef short bf16x8 __attribute__((ext_vector_type(8)));
typedef float f32x4 __attribute__((ext_vector_type(4)));
typedef unsigned u32x4 __attribute__((ext_vector_type(4)));
constexpr int BM = 256, BK = 64, HALF = 128, HTB = HALF * BK * 2  , STAGE_BYTES = 8 * HTB, NXCD = 8, WGM = 4;

__host__ __device__ __forceinline__ int lds_byte(int r, int c) { const int st = (r >> 4) * 2 + (c >> 5), rr = r & 15, cc = c & 31, ob = rr * 64 + cc * 2; return st * 1024 + (ob ^ (((ob >> 9) & 1) << 5)); }
__host__ __device__ __forceinline__ void stage_rc(int b, int& R, int& C) { const int st = b / 1024, sb = b % 1024, swz = sb ^ (((sb >> 9) & 1) << 5); R = (st >> 1) * 16 + swz / 64; C = (st & 1) * 32 + (swz % 64) / 2; }
__host__ __device__ __forceinline__ int perm32(int rho) { const int n = rho >> 4, i = rho & 15; return 8 * (i >> 2) + 4 * n + (i & 3); }

struct Unit { int pm, pn; };
struct Gemm { const bf16_t* A; const bf16_t* Bt; int M, N, K; };

struct StaticOrder {
    int nM, nN, nwg, G, c;
    __host__ __device__ void init(int M, int N, int G_, int c_) { nM = M / BM; nN = N / BM; nwg = nM * nN; G = G_; c = c_; }
    __host__ __device__ bool next(int i, Unit& u) const {
        const long L = (long)i * G + c; if (L >= nwg) return false;
        int wgid = (int)L; { const int q = nwg / NXCD, r = nwg % NXCD, xcd = wgid % NXCD, off = wgid / NXCD; wgid = (xcd < r ? xcd * (q + 1) : r * (q + 1) + (xcd - r) * q) + off; }
        const int nig = WGM * nN, gid = wgid / nig, fm = gid * WGM, gsz = (nM - fm) < WGM ? (nM - fm) : WGM;
        u.pm = fm + ((wgid % nig) % gsz); u.pn = (wgid % nig) / gsz; return true;
    }
    __device__ __forceinline__ bool next_fi(int i, int& pm, int& pn) const {
        const long L = (long)i * G + c; if (L >= nwg) return false;
        int wgid = (int)L; { const int q = nwg / NXCD, r = nwg % NXCD, xcd = wgid % NXCD, off = wgid / NXCD; wgid = (xcd < r ? xcd * (q + 1) : r * (q + 1) + (xcd - r) * q) + off; }
        const int nig = WGM * nN, gid = wgid / nig, fm = gid * WGM, gsz = (nM - fm) < WGM ? (nM - fm) : WGM;
        pm = fm + ((wgid % nig) % gsz); pn = (wgid % nig) / gsz; return true; }
    __device__ __forceinline__ void a_ready(const Unit&) const {}
    __device__ __forceinline__ void done(const Unit&) const {}
};

__device__ __forceinline__ unsigned cvt_pk_bf16(float lo, float hi) { unsigned r; asm volatile("v_cvt_pk_bf16_f32 %0, %1, %2" : "=v"(r) : "v"(lo), "v"(hi)); return r; }
typedef int i32x8 __attribute__((ext_vector_type(8)));
typedef int i32x4g __attribute__((ext_vector_type(4)));
template <class Epi, class Sched, bool ALIGN_EPI = false, bool SP2 = false, bool FP8 = false>
__device__ __forceinline__ void gemm_phase(PG8_LAS unsigned char* lds, const Gemm g, const Sched& S, const Epi& E, int wv) {
    int tid_ = wv * 64 + hw_lane(); asm volatile("" : "+v"(tid_));
    const int tid = tid_, wid = __builtin_amdgcn_readfirstlane(tid >> 6), lane = tid & 63, wr = wid >> 2, wc = wid & 3, fr = lane & 15, fq = lane >> 4;
    const int K = g.K, nt = K / BK;
    unsigned voffA, voffB;
    { int R, C; stage_rc(tid * 16, R, C); const int Rb = Epi::PERM ? ((R & ~31) + perm32(R & 31)) : R; voffA = (unsigned)(R * K + C) * 2u; voffB = (unsigned)(Rb * K + C) * 2u; }
    const size_t rskip = (size_t)64 * K * 2;
    const size_t kstep = (size_t)(BK * 2);
    const size_t hstep = (size_t)HALF * K * 2;
    const size_t tstep = 2 * hstep;
    const unsigned ldsw = (unsigned)wid * 1024u;
    const int aoff = lds_byte(wr * 64 + fr, fq * 8), boff = lds_byte(wc * 32 + fr, fq * 8);
#define PG8_SA(b, h) (((b) * 2 + (h)) * HTB)
#define PG8_SB(b, h) ((4 + (b) * 2 + (h)) * HTB)
#define PG8_STAGE(bufoff, gbase, voff) do { _Pragma("unroll") for (int _i = 0; _i < 2; ++_i) \
        __builtin_amdgcn_global_load_lds((const unsigned*)((const char*)(gbase) + (_i ? rskip : (size_t)0) + (voff)), (PG8_LAS unsigned*)(lds + (bufoff) + ldsw + _i * 8192), 16, 0, 0); } while (0)
#define PG8_LDA(dst, b, h) do { _Pragma("unroll") for (int m = 0; m < 4; ++m) { \
        if constexpr (FP8) { const i32x4g lo_ = *(const PG8_LAS i32x4g*)(lds + PG8_SA(b, h) + aoff + m * 2048), hi_ = *(const PG8_LAS i32x4g*)(lds + PG8_SA(b, h) + aoff + m * 2048 + 1024); \
            dst##8[m] = __builtin_shufflevector(lo_, hi_, 0, 1, 2, 3, 4, 5, 6, 7); } \
        else { _Pragma("unroll") for (int k = 0; k < 2; ++k) dst[m][k] = *(const PG8_LAS bf16x8*)(lds + PG8_SA(b, h) + aoff + m * 2048 + k * 1024); } } } while (0)
#define PG8_LDB(dst, b, h) do { _Pragma("unroll") for (int n = 0; n < 2; ++n) { \
        if constexpr (FP8) { const i32x4g lo_ = *(const PG8_LAS i32x4g*)(lds + PG8_SB(b, h) + boff + n * 2048), hi_ = *(const PG8_LAS i32x4g*)(lds + PG8_SB(b, h) + boff + n * 2048 + 1024); \
            dst##8[n] = __builtin_shufflevector(lo_, hi_, 0, 1, 2, 3, 4, 5, 6, 7); } \
        else { _Pragma("unroll") for (int k = 0; k < 2; ++k) dst[n][k] = *(const PG8_LAS bf16x8*)(lds + PG8_SB(b, h) + boff + n * 2048 + k * 1024); } } } while (0)
#define PG8_MMA(ai, bj, At, Bt) do { __builtin_amdgcn_s_setprio(1); _Pragma("unroll") for (int m = 0; m < 4; ++m) _Pragma("unroll") for (int n = 0; n < 2; ++n) { \
        if constexpr (FP8) acc[ai][bj][m][n] = __builtin_amdgcn_mfma_scale_f32_16x16x128_f8f6f4(Bt##8[n], At##8[m], acc[ai][bj][m][n], 0, 0, 0, 0x7f7f7f7f, 0, 0x7f7f7f7f); \
        else { _Pragma("unroll") for (int k = 0; k < 2; ++k) acc[ai][bj][m][n] = __builtin_amdgcn_mfma_f32_16x16x32_bf16(Bt[n][k], At[m][k], acc[ai][bj][m][n], 0, 0, 0); } } \
        __builtin_amdgcn_s_setprio(0); } while (0)
#define PG8_WAIT_V(n) asm volatile("s_waitcnt vmcnt(" #n ")" ::: "memory")
#define PG8_WAIT_L(n) asm volatile("s_waitcnt lgkmcnt(" #n ")" ::: "memory")
#define PG8_BAR __builtin_amdgcn_s_barrier()
#define PG8_SCHED __builtin_amdgcn_sched_barrier(0)
    Unit cur, nxt; int ui = 0;
    if (!S.next(0, cur)) return;
    f32x4 acc[2][2][4][2];
#pragma unroll
    for (int a = 0; a < 2; ++a)
#pragma unroll
        for (int b = 0; b < 2; ++b)
#pragma unroll
            for (int m = 0; m < 4; ++m)
#pragma unroll
                for (int n = 0; n < 2; ++n) acc[a][b][m][n] = (f32x4){0.f, 0.f, 0.f, 0.f};
    bf16x8 At[4][2], B0[2][2], B1[2][2]; i32x8 At8[4], B08[2], B18[2];
    const char* cA = (const char*)g.A + (size_t)cur.pm * tstep; const char* cB = (const char*)g.Bt + (size_t)cur.pn * tstep;
    S.a_ready(cur);
    if constexpr (SP2) {
        PG8_STAGE(PG8_SB(0, 0), cB, voffB); PG8_STAGE(PG8_SB(0, 1), cB + hstep, voffB); PG8_STAGE(PG8_SA(0, 0), cA, voffA); PG8_STAGE(PG8_SA(0, 1), cA + hstep, voffA);
        if (wr == 1) PG8_BAR;
        PG8_WAIT_V(2); PG8_BAR;
        PG8_STAGE(PG8_SB(1, 0), cB + kstep, voffB); PG8_STAGE(PG8_SA(1, 0), cA + kstep, voffA); PG8_STAGE(PG8_SB(1, 1), cB + hstep + kstep, voffB);
        PG8_WAIT_V(6); PG8_BAR;
    } else {
        PG8_STAGE(PG8_SB(0, 0), cB, voffB); PG8_STAGE(PG8_SA(0, 0), cA, voffA); PG8_STAGE(PG8_SB(0, 1), cB + hstep, voffB); PG8_STAGE(PG8_SA(0, 1), cA + hstep, voffA);
        if (wr == 1) PG8_BAR;
        PG8_WAIT_V(4); PG8_BAR;
        PG8_STAGE(PG8_SB(1, 0), cB + kstep, voffB); PG8_STAGE(PG8_SA(1, 0), cA + kstep, voffA); PG8_STAGE(PG8_SB(1, 1), cB + hstep + kstep, voffB);
        PG8_WAIT_V(6); PG8_BAR;
    }
    for (;;) {
        const bool has_next = S.next(ui + 1, nxt);
        const char* nA = has_next ? (const char*)g.A + (size_t)nxt.pm * tstep : cA; const char* nB = has_next ? (const char*)g.Bt + (size_t)nxt.pn * tstep : cB;
#pragma unroll 1
        for (int t = 0; t < nt; t += 2) {
            const bool last = (t == nt - 2);
            const char* a1 = cA + (size_t)(t + 1) * kstep;
            const char* a2 = last ? nA : cA + (size_t)(t + 2) * kstep; const char* b2 = last ? nB : cB + (size_t)(t + 2) * kstep;
            const char* a3 = a2 + kstep; const char* b3 = b2 + kstep;
            if (last && has_next) S.a_ready(nxt);
            if constexpr (SP2) {
            PG8_LDB(B0, 0, 0); PG8_LDB(B1, 0, 1); PG8_SCHED; PG8_LDA(At, 0, 0); PG8_STAGE(PG8_SA(1, 1), a1 + hstep, voffA);
            PG8_WAIT_V(8); PG8_WAIT_L(0); PG8_BAR; PG8_MMA(0, 0, At, B0); PG8_MMA(0, 1, At, B1); PG8_BAR; PG8_SCHED;
            PG8_LDA(At, 0, 1); PG8_STAGE(PG8_SB(0, 0), b2, voffB); PG8_STAGE(PG8_SB(0, 1), b2 + hstep, voffB); PG8_STAGE(PG8_SA(0, 0), a2, voffA);
            PG8_WAIT_V(8); PG8_WAIT_L(0); PG8_BAR; PG8_MMA(1, 0, At, B0); PG8_MMA(1, 1, At, B1); PG8_BAR; PG8_SCHED;
            PG8_LDB(B0, 1, 0); PG8_LDB(B1, 1, 1); PG8_SCHED; PG8_LDA(At, 1, 0); PG8_STAGE(PG8_SA(0, 1), a2 + hstep, voffA);
            PG8_WAIT_V(8); PG8_WAIT_L(0); PG8_BAR; PG8_MMA(0, 0, At, B0); PG8_MMA(0, 1, At, B1); PG8_BAR; PG8_SCHED;
            PG8_LDA(At, 1, 1); PG8_STAGE(PG8_SB(1, 0), b3, voffB); PG8_STAGE(PG8_SB(1, 1), b3 + hstep, voffB); PG8_STAGE(PG8_SA(1, 0), a3, voffA);
            PG8_WAIT_V(8); PG8_WAIT_L(0); PG8_BAR; PG8_MMA(1, 0, At, B0); PG8_MMA(1, 1, At, B1); PG8_BAR; PG8_SCHED;
            } else {
            PG8_LDB(B0, 0, 0); PG8_SCHED; PG8_LDA(At, 0, 0); PG8_STAGE(PG8_SA(1, 1), a1 + hstep, voffA);
            PG8_WAIT_L(8); PG8_BAR; PG8_WAIT_L(0); PG8_MMA(0, 0, At, B0); PG8_BAR; PG8_SCHED;
            PG8_LDB(B1, 0, 1); PG8_STAGE(PG8_SB(0, 0), b2, voffB);
            PG8_BAR; PG8_WAIT_L(0); PG8_MMA(0, 1, At, B1); PG8_BAR;
            PG8_LDA(At, 0, 1); PG8_STAGE(PG8_SA(0, 0), a2, voffA);
            PG8_BAR; PG8_WAIT_L(0); PG8_MMA(1, 0, At, B0); PG8_BAR; PG8_SCHED;
            PG8_STAGE(PG8_SB(0, 1), b2 + hstep, voffB);
            PG8_WAIT_V(6); PG8_BAR; PG8_MMA(1, 1, At, B1); PG8_BAR;
            PG8_LDB(B0, 1, 0); PG8_SCHED; PG8_LDA(At, 1, 0); PG8_STAGE(PG8_SA(0, 1), a2 + hstep, voffA);
            PG8_WAIT_L(8); PG8_BAR; PG8_WAIT_L(0); PG8_MMA(0, 0, At, B0); PG8_BAR; PG8_SCHED;
            PG8_LDB(B1, 1, 1); PG8_STAGE(PG8_SB(1, 0), b3, voffB);
            PG8_BAR; PG8_WAIT_L(0); PG8_MMA(0, 1, At, B1); PG8_BAR;
            PG8_LDA(At, 1, 1); PG8_STAGE(PG8_SA(1, 0), a3, voffA);
            PG8_BAR; PG8_WAIT_L(0); PG8_MMA(1, 0, At, B0); PG8_BAR; PG8_SCHED;
            PG8_STAGE(PG8_SB(1, 1), b3 + hstep, voffB);
            PG8_WAIT_V(6); PG8_BAR; PG8_MMA(1, 1, At, B1); PG8_BAR;
            }
        }
        if constexpr (ALIGN_EPI) { if (wr == 0) PG8_BAR; }
        if constexpr (!Epi::AFTER_DRAIN) { int fr_ = fr, fq_ = fq; if constexpr (FP8) { const int l_ = hw_lane(); fr_ = l_ & 15; fq_ = l_ >> 4; }
            E(acc, cur, wr, wc, fr_, fq_); S.done(cur); }
        if (!has_next) break;
#pragma unroll
        for (int a = 0; a < 2; ++a)
#pragma unroll
            for (int b = 0; b < 2; ++b)
#pragma unroll
                for (int m = 0; m < 4; ++m)
#pragma unroll
                    for (int n = 0; n < 2; ++n) acc[a][b][m][n] = (f32x4){0.f, 0.f, 0.f, 0.f};
        cur = nxt; cA = nA; cB = nB; ++ui;
        if constexpr (ALIGN_EPI) { if (wr == 1) PG8_BAR; }
    }
    PG8_WAIT_V(0);
    if constexpr (!ALIGN_EPI) { if (wr == 0) PG8_BAR; }
    PG8_BAR;
    if constexpr (Epi::AFTER_DRAIN) { E.fused(acc, cur, wr, wc, fr, fq, lds, wid, lane); S.done(cur); }
#undef PG8_SA
#undef PG8_SB
#undef PG8_STAGE
#undef PG8_LDA
#undef PG8_LDB
#undef PG8_MMA
#undef PG8_WAIT_V
#undef PG8_WAIT_L
#undef PG8_BAR
#undef PG8_SCHED
}
}
#define GAS __attribute__((address_space(1)))
#define LAS __attribute__((address_space(3)))
typedef unsigned short bf16;
typedef unsigned v4u __attribute__((ext_vector_type(4)));
typedef float f32x4 __attribute__((ext_vector_type(4)));
typedef short bf16x8 __attribute__((ext_vector_type(8)));
typedef GAS unsigned gu32;
typedef GAS unsigned long long gu64;
#define RLX_AGENT __ATOMIC_RELAXED, __HIP_MEMORY_SCOPE_AGENT
#define LDS_WAIT() asm volatile("s_waitcnt lgkmcnt(0)" ::: "memory")
#define VM_WAIT() asm volatile("s_waitcnt vmcnt(0)" ::: "memory")
__device__ __forceinline__ unsigned long long rt() { return __builtin_amdgcn_s_memrealtime(); }
__device__ __forceinline__ unsigned f2bf(float f) { unsigned u = __builtin_bit_cast(unsigned, f); return (u + 0x7fffu + ((u >> 16) & 1u)) >> 16; }
__device__ __forceinline__ unsigned pk2(float lo, float hi) { return f2bf(lo) | (f2bf(hi) << 16); }

#define XB_TMO      128
#define XB_XCNT(j)  (256  + 64 * (j))
#define XB_XSUB(j)  (1280 + 64 * (j))
#define XB_XGEN(j)  (2304 + 64 * (j))
#define XB_TOP      3328
#define XB_TOPGEN   3392
#define XCD_BAR_WORDS 3456
#define XB_SPIN_CAP (1u << 18)

__device__ __forceinline__ unsigned xb_ld(unsigned* p)              { return __hip_atomic_load(p, __ATOMIC_RELAXED, __HIP_MEMORY_SCOPE_AGENT); }
__device__ __forceinline__ unsigned xb_add(unsigned* p, unsigned v) { return __hip_atomic_fetch_add(p, v, __ATOMIC_RELAXED, __HIP_MEMORY_SCOPE_AGENT); }
__device__ __forceinline__ unsigned xb_xcc_id() { return (unsigned)__builtin_amdgcn_s_getreg((3 << 11) | 20) & 0xFu; }
#define XB_SPIN(cond, bar) do { unsigned _sp = 0; while (cond) { __builtin_amdgcn_s_sleep(1); \
    if ((++_sp & 255u) == 0u) { if (xb_ld(&(bar)[XB_TMO])) break; if (_sp > XB_SPIN_CAP) { atomicAdd(&(bar)[XB_TMO], 1u); break; } } } } while (0)

struct XcdBarrier {
    unsigned* bar; unsigned x;
    volatile LAS unsigned* st;
    bool lead;
};

__device__ __forceinline__ XcdBarrier xcd_barrier_post(unsigned* bar, volatile LAS unsigned* st, bool lead) {
    XcdBarrier b; b.bar = bar; b.x = xb_xcc_id(); b.st = st; b.lead = lead;
    if (lead && hw_lane() == 0) (void)xb_add(&bar[XB_XCNT(b.x)], 1u);
    return b;
}
__device__ __forceinline__ void xcd_barrier_complete(unsigned* bar, unsigned x, unsigned& nloc, unsigned& nx) {
    const unsigned G = gridDim.x * gridDim.y * gridDim.z;
    unsigned sum, cnt, mine, sp = 0u;
    for (;;) {
        sum = 0u; cnt = 0u; mine = 0u;
#pragma unroll
        for (unsigned j = 0; j < 16; ++j) { const unsigned c = xb_ld(&bar[XB_XCNT(j)]); sum += c; cnt += (c > 0u) ? 1u : 0u; mine = (j == x) ? c : mine; }
        if (sum == G) break;
        __builtin_amdgcn_s_sleep(1);
        if ((++sp & 255u) == 0u) { if (xb_ld(&bar[XB_TMO])) break; if (sp > XB_SPIN_CAP) { atomicAdd(&bar[XB_TMO], 1u); break; } }
    }
    nloc = mine > 0u ? mine : 1u; nx = cnt > 0u ? cnt : 1u;
}

__device__ __forceinline__ void xcd_barrier(const XcdBarrier& b) {
    asm volatile("s_waitcnt vmcnt(0)" ::: "memory");
    __syncthreads();
    if (b.lead && hw_lane() == 0) {
        unsigned* bar = b.bar;
        __builtin_amdgcn_s_waitcnt(0);
        unsigned nloc = b.st[0], nx = b.st[1];
        if (nloc == 0u) { xcd_barrier_complete(bar, b.x, nloc, nx); b.st[0] = nloc; b.st[1] = nx; }
        const unsigned old = xb_add(&bar[XB_XSUB(b.x)], 1u);
        const unsigned gen = old / nloc;
        if (old + 1u == (gen + 1u) * nloc) {
            __builtin_amdgcn_fence(__ATOMIC_RELEASE, "agent");
            asm volatile("s_waitcnt vmcnt(0)" ::: "memory");
            const unsigned og = xb_add(&bar[XB_TOP], 1u);
            const unsigned tg = og / nx;
            if (og + 1u == (tg + 1u) * nx) xb_add(&bar[XB_TOPGEN], 1u);
            else XB_SPIN(xb_ld(&bar[XB_TOPGEN]) == tg, bar);
            __builtin_amdgcn_fence(__ATOMIC_ACQUIRE, "agent");
            xb_add(&bar[XB_XGEN(b.x)], 1u);
            asm volatile("s_waitcnt vmcnt(0)" ::: "memory");
        } else {
            XB_SPIN(xb_ld(&bar[XB_XGEN(b.x)]) == gen, bar);
            __builtin_amdgcn_fence(__ATOMIC_ACQUIRE, "agent");
            asm volatile("s_waitcnt vmcnt(0)" ::: "memory");
        }
    }
    __syncthreads();
}


#ifndef STAGE
#define STAGE 3
#endif
#ifndef N_LAUNCH_MODE
#define N_LAUNCH_MODE 1
#endif
#ifndef REP_TK
#define REP_TK 1
#endif
#ifndef REP_AT
#define REP_AT 1
#endif
#ifndef REP_PH
#define REP_PH -1
#endif
#ifndef TK_PREFETCH
#define TK_PREFETCH 1
#endif
#ifndef DBG_C
#define DBG_C 0.0f
#endif

typedef float f32x16 __attribute__((ext_vector_type(16)));
typedef __attribute__((ext_vector_type(2))) __bf16 bf16x2_t;
using pg8::bf16_t; using pg8::Unit;

constexpr int M = 16384, DM = 1024, NHEAD = 8, HD = 64, AW = 512, PW = 512, FF = 2816, FF2 = 5632, NIN = 4420, NINP = 4608, NMOD = 6144;
constexpr float EPS = 1e-6f;
constexpr int NWAVES = 8, NTHR = 512;

constexpr size_t MiB = 1u << 20;
constexpr size_t WS_CTL = 0, CTL_ZERO_BYTES = 64 * 1024;
constexpr size_t WS_WIN = 1 * MiB, WS_WATTN = 10 * MiB, WS_WGRP = 11 * MiB, WS_WPOOL = 11 * MiB + 512 * 1024, WS_WOUT = 12 * MiB + 512 * 1024,
                 WS_WUP = 14 * MiB + 512 * 1024, WS_WDOWN = 25 * MiB + 512 * 1024;
constexpr size_t WS_MODP = 31 * MiB, WS_MODF = 31 * MiB + 393216, WS_WI = 31 * MiB + 512 * 1024;
constexpr size_t WS_H = 32 * MiB;
constexpr size_t WS_Q = 64 * MiB, WS_K = 80 * MiB, WS_V = 96 * MiB;
constexpr size_t WS_SEL = 88 * MiB;
constexpr size_t WS_QI = 112 * MiB, WS_KI = 120 * MiB;
constexpr size_t WS_UPOOL = 128 * MiB, WS_POOLED = 144 * MiB, WS_POOLMIX = 160 * MiB, WS_ATTN = 176 * MiB;
constexpr size_t WS_GA = 192 * MiB, WS_GP = 224 * MiB;
constexpr size_t WS_ACT = 64 * MiB;
constexpr size_t WS_RAW = 152 * MiB;
constexpr size_t WS_X1B = 108 * MiB;
constexpr size_t WS_END = 256 * MiB;
constexpr int CW_BAR = 1024, CW_QUEUE = 512;

constexpr int LDS_BYTES = 163840;
constexpr int HSTRIDE = 1025, MSTRIDE = 513;
constexpr int LIST_OFF = 135168, ST_OFF = 151552, MISC_OFF = 159744;

#define SYNC() __syncthreads()
__device__ __forceinline__ float wave_sum(float v) {
#pragma unroll
    for (int o = 1; o < 64; o <<= 1) v += __shfl_xor(v, o);
    return v;
}
__device__ __forceinline__ float bf_lo(unsigned w) { return __builtin_bit_cast(float, w << 16); }
__device__ __forceinline__ float bf_hi(unsigned w) { return __builtin_bit_cast(float, w & 0xffff0000u); }
__device__ __forceinline__ float sigmoidf_(float x) { return __builtin_amdgcn_rcpf(1.0f + __expf(-x)); }
__device__ __forceinline__ unsigned pkbf(float lo, float hi) { return pg8::cvt_pk_bf16(lo, hi); }
typedef unsigned u32x2 __attribute__((ext_vector_type(2)));
__device__ __forceinline__ unsigned pk4f8(f32x4 v) { const float a = v[0], b = v[1], c = v[2], d = v[3]; int r = __builtin_amdgcn_cvt_pk_fp8_f32(a, b, 0, false); r = __builtin_amdgcn_cvt_pk_fp8_f32(c, d, r, true); return (unsigned)r; }
__device__ __forceinline__ u32x2 pk4(f32x4 v) { u32x2 r; r.x = pkbf(v[0], v[1]); r.y = pkbf(v[2], v[3]); return r; }
__device__ __forceinline__ unsigned pk4_fp8(f32x4 v) { int w = 0; w = __builtin_amdgcn_cvt_pk_fp8_f32(v[0], v[1], w, false); w = __builtin_amdgcn_cvt_pk_fp8_f32(v[2], v[3], w, true); return (unsigned)w; }

__device__ __forceinline__ void tr_item(const float* W, int ldw, int src_col, int nvalid, int k0, bf16_t* WT, int K, int dst_row, LAS float* scr, int lane, bool f8 = false) {
    asm volatile("" : "+v"(lane));
    f32x4 v[16];
#pragma unroll
    for (int i = 0; i < 16; ++i) { const int kk = 8 * i + (lane >> 3), n4 = 4 * (lane & 7);
        v[i] = (f32x4){0.f, 0.f, 0.f, 0.f}; if (W != nullptr && n4 < nvalid) v[i] = *(const f32x4*)(W + (size_t)(k0 + kk) * ldw + src_col + n4); }
#pragma unroll
    for (int hf = 0; hf < 2; ++hf) {
#pragma unroll
        for (int i = 0; i < 8; ++i) { const int kk = 8 * i + (lane >> 3), n4 = 4 * (lane & 7); LAS float* p = scr + kk * 33 + n4; const f32x4 t = v[8 * hf + i]; p[0] = t[0]; p[1] = t[1]; p[2] = t[2]; p[3] = t[3]; }
        LDS_WAIT(); asm volatile("" ::: "memory");
        const int c = lane & 7, kq = k0 + 64 * hf;
#pragma unroll
        for (int j = 0; j < 4; ++j) { const int n = (lane >> 3) + 8 * j; const LAS float* s = scr + (8 * c) * 33 + n;
            if (f8) { int r0 = __builtin_amdgcn_cvt_pk_fp8_f32(64.f * s[0 * 33], 64.f * s[1 * 33], 0, false); r0 = __builtin_amdgcn_cvt_pk_fp8_f32(64.f * s[2 * 33], 64.f * s[3 * 33], r0, true);
                int r1 = __builtin_amdgcn_cvt_pk_fp8_f32(64.f * s[4 * 33], 64.f * s[5 * 33], 0, false); r1 = __builtin_amdgcn_cvt_pk_fp8_f32(64.f * s[6 * 33], 64.f * s[7 * 33], r1, true);
                *(GAS u32x2*)((GAS unsigned char*)WT + (size_t)(dst_row + n) * K + kq + 8 * c) = (u32x2){(unsigned)r0, (unsigned)r1}; continue; }
            v4u o; o.x = pk2(s[0 * 33], s[1 * 33]); o.y = pk2(s[2 * 33], s[3 * 33]); o.z = pk2(s[4 * 33], s[5 * 33]); o.w = pk2(s[6 * 33], s[7 * 33]);
            *(GAS v4u*)(WT + (size_t)(dst_row + n) * K + kq + 8 * c) = o; }
        LDS_WAIT(); asm volatile("" ::: "memory");
    }
}

struct P0Ptrs { const float *c, *w_ada, *w_in, *w_attn, *w_grp, *w_pool, *w_out, *w_up, *w_down, *pscale; bf16_t *WIN, *WATTN, *WGRP, *WPOOL, *WOUT, *WUP, *WDOWN; float* MODP; bf16_t* WIN8; };
__device__ __forceinline__ void p0_prologue(const P0Ptrs& P, LAS unsigned char* lds, int gw, int NGW, int wave, int lane) {
    LAS float* scr = (LAS float*)(lds + wave * 16384);
    LAS float* sil = (LAS float*)(lds + 131072);
    for (int i = wave * 64 + lane; i < 1024; i += NTHR) { const float cv = P.c[i]; sil[i] = cv / (1.0f + __expf(-cv)); }
    SYNC();
    constexpr int I_WIN = 144 * 8, I_WATTN = 32 * 4, I_WGRP = 128, I_WPOOL = 32 * 4, I_WOUT = 32 * 8, I_WUP = 176 * 8, I_WDOWN = 32 * 22, I_MOD = 96 * 16;
    constexpr int NITEMS = I_WIN + I_WATTN + I_WGRP + I_WPOOL + I_WOUT + I_WUP + I_WDOWN + I_MOD;
    for (int it = gw; it < NITEMS; it += NGW) {
        int r = it;
        if (r < I_MOD) {
            const int cb = r % 96, kc = r / 96, col = cb * 64 + lane; float acc = 0.f;
            float wa[64];
#pragma unroll
            for (int i = 0; i < 64; ++i) wa[i] = P.w_ada[(size_t)(kc * 64 + i) * NMOD + col];
#pragma unroll
            for (int i = 0; i < 64; ++i) acc = fmaf(sil[kc * 64 + i], wa[i], acc);
            P.MODP[kc * NMOD + col] = acc; continue; }
        r -= I_MOD;
        if (r < I_WIN) { const int g = r / 8, kb = r % 8, tile = g >> 3, gi = g & 7; int src = -1, nv = 32;
            const int permgi = gi < 4 ? 64 * gi : 64 * (gi - 4) + 32;
            if (tile < 2) src = tile * 256 + permgi;
            else if (tile < 4) src = 512 + (tile - 2) * 256 + permgi;
            else if (tile < 6) src = 1024 + (tile - 4) * 256 + 32 * gi;
            else if (tile == 6) src = 1536 + 32 * gi;
            else if (tile == 7) { if (gi < 2) src = 1792 + 32 * gi; else if (gi == 2) { src = 1856; nv = 4; } }
            else if (tile < 10) src = 1860 + (tile - 8) * 256 + 32 * gi;
            else if (tile < 14) src = 2372 + (tile - 10) * 256 + 32 * gi;
            else src = 3396 + (tile - 14) * 256 + 32 * gi;
            if (tile == 6 || tile == 7) tr_item(src >= 0 ? P.w_in : nullptr, NIN, src >= 0 ? src : 0, nv, kb * 128, P.WIN, 1024, g * 32, scr, lane);
            else tr_item(src >= 0 ? P.w_in : nullptr, NIN, src >= 0 ? src : 0, nv, kb * 128, P.WIN8, 1024, g * 32, scr, lane, true);
            continue; }
        r -= I_WIN;
        if (r < I_WATTN) { tr_item(P.w_attn, 1024, (r / 4) * 32, 32, (r % 4) * 128, P.WATTN, 512, (r / 4) * 32, scr, lane, true); continue; }
        r -= I_WATTN;
        if (r < I_WGRP) {
            const int row = 4 * r + (lane >> 4), g = row >> 7; const float* src = P.w_grp + (size_t)g * 16384 + (size_t)(row & 127) * 128;
#pragma unroll
            for (int q = 0; q < 4; ++q) { const int d0 = 32 * (lane & 15) + 8 * q; v4u o = (v4u){0u, 0u, 0u, 0u};
                if ((d0 >> 7) == g) { const f32x4 a = *(const f32x4*)(src + (d0 & 127)) * *(const f32x4*)(P.pscale + d0), b = *(const f32x4*)(src + (d0 & 127) + 4) * *(const f32x4*)(P.pscale + d0 + 4);
                    o.x = pk2(a[0], a[1]); o.y = pk2(a[2], a[3]); o.z = pk2(b[0], b[1]); o.w = pk2(b[2], b[3]); }
                *(GAS v4u*)(P.WGRP + (size_t)row * 512 + d0) = o; }
            continue; }
        r -= I_WGRP;
        if (r < I_WPOOL) { tr_item(P.w_pool, 1024, (r / 4) * 32, 32, (r % 4) * 128, P.WPOOL, 512, (r / 4) * 32, scr, lane); continue; }
        r -= I_WPOOL;
        if (r < I_WOUT) { tr_item(P.w_out, 1024, (r / 8) * 32, 32, (r % 8) * 128, P.WOUT, 1024, (r / 8) * 32, scr, lane, true); continue; }
        r -= I_WOUT;
        if (r < I_WUP) { const int g = r / 8, kb = r % 8, tile = g >> 3, gi = g & 7;
            const int src = gi < 4 ? 128 * tile + 32 * gi : FF + 128 * tile + 32 * (gi - 4);
            tr_item(P.w_up, FF2, src, 32, kb * 128, P.WUP, 1024, g * 32, scr, lane, true); continue; }
        r -= I_WUP;
        { tr_item(P.w_down, 1024, (r / 22) * 32, 32, (r % 22) * 128, P.WDOWN, FF, (r / 22) * 32, scr, lane, true); }
    }
}

__device__ __forceinline__ void modulate_rows(const float* X, bf16_t* O, const LAS float* mulv, const LAS float* addv, int gw, int NGW, int lane, bool f8 = false, unsigned char* O8 = nullptr, bool xbf = false) {
    f32x4 mu[4], ad[4];
#pragma unroll
    for (int j = 0; j < 4; ++j) { mu[j] = *(const LAS f32x4*)(mulv + 4 * lane + 256 * j); ad[j] = *(const LAS f32x4*)(addv + 4 * lane + 256 * j); }
    for (int row = gw; row < M; row += NGW) {
        const GAS f32x4* xr = (const GAS f32x4*)(X + (size_t)row * DM) + lane;
        f32x4 v[4]; float s = 0.f;
#pragma unroll
        for (int j = 0; j < 4; ++j) {
            if (xbf) { const u32x2 q = ((const GAS u32x2*)((const GAS bf16_t*)X + (size_t)row * DM))[lane + 64 * j]; v[j] = (f32x4){bf_lo(q.x), bf_hi(q.x), bf_lo(q.y), bf_hi(q.y)}; }
            else v[j] = xr[64 * j];
            s += (v[j].x * v[j].x + v[j].y * v[j].y) + (v[j].z * v[j].z + v[j].w * v[j].w); }
        const float rstd = 1.0f / sqrtf(wave_sum(s) * (1.0f / DM) + EPS);
        GAS u32x2* o8 = (GAS u32x2*)(O + (size_t)row * DM) + lane;
#pragma unroll
        for (int j = 0; j < 4; ++j) { const f32x4 y = v[j] * rstd * mu[j] + ad[j]; if (f8) ((GAS unsigned*)((GAS unsigned char*)O + (size_t)row * DM))[lane + 64 * j] = pk4f8(y); else o8[64 * j] = pk4(y);
            if (O8 != nullptr) ((GAS unsigned*)((GAS unsigned char*)O8 + (size_t)row * DM))[lane + 64 * j] = pk4f8(y); }
    }
}

template <bool F8> struct EpiProj {
    static constexpr bool PERM = false, AFTER_DRAIN = false; static constexpr float AS = F8 ? 0.015625f : 1.0f;
    bf16_t *Q; unsigned char *K8, *V8; bf16_t *QI, *KI, *UPOOL, *GA, *GP; float* WI; const float *qg, *kg;
    __device__ __forceinline__ void operator()(const pg8::f32x4 (&acc)[2][2][4][2], const Unit& u, int wr, int wc, int fr, int fq) const {
        const int pn = u.pn, row0 = u.pm * 256 + wr * 64 + fr;
        if (pn < 4) {
            const bool isq = pn < 2; const float* g = isq ? qg : kg; const int head = (pn & 1) * 4 + wc;
            f32x4 gv[2][2];
#pragma unroll
            for (int bj = 0; bj < 2; ++bj)
#pragma unroll
                for (int n = 0; n < 2; ++n) gv[bj][n] = *(const f32x4*)(g + 32 * bj + 16 * n + 4 * fq);
#pragma unroll
            for (int ai = 0; ai < 2; ++ai)
#pragma unroll
                for (int m = 0; m < 4; ++m) {
                    float ss = 0.f;
#pragma unroll
                    for (int bj = 0; bj < 2; ++bj)
#pragma unroll
                        for (int n = 0; n < 2; ++n) { const f32x4 x = acc[ai][bj][m][n] * AS; ss += (x[0] * x[0] + x[1] * x[1]) + (x[2] * x[2] + x[3] * x[3]); }
                    ss += __shfl_xor(ss, 16); ss += __shfl_xor(ss, 32);
                    const float rstd = 1.0f / sqrtf(ss * (1.0f / 64.0f) + EPS);
                    const size_t ro = (size_t)(row0 + ai * 128 + m * 16) * AW + head * 64 + 4 * fq;
#pragma unroll
                    for (int bj = 0; bj < 2; ++bj)
#pragma unroll
                        for (int n = 0; n < 2; ++n) { const f32x4 y = acc[ai][bj][m][n] * (AS * rstd) * gv[bj][n];
                            if (isq) *(u32x2*)(Q + ro + 32 * bj + 16 * n) = pk4(y); else *(unsigned*)(K8 + ((size_t)head * M + (row0 + ai * 128 + m * 16)) * 128 + 4 * fq + 32 * bj + 16 * n) = pk4_fp8(y); }
                }
            return;
        }
        const int colw = wc * 32 + 4 * fq;
        if (pn == 7) {
#pragma unroll
            for (int ai = 0; ai < 2; ++ai)
#pragma unroll
                for (int m = 0; m < 4; ++m) { const int row = row0 + ai * 128 + m * 16;
                    if (wc < 2) {
#pragma unroll
                        for (int n = 0; n < 2; ++n) { const int c = colw + 16 * n; *(u32x2*)(KI + (size_t)(row >> 5) * 2048 + (c >> 4) * 512 + ((((c >> 3) & 1) * 32 + (row & 31)) * 8) + (c & 7)) = pk4(acc[ai][0][m][n] * AS); }
                    } else if (wc == 2 && fq == 0) { *(f32x4*)(WI + (size_t)row * 4) = acc[ai][0][m][0] * (0.5f * AS); }
                }
            return;
        }
        if (pn < 6) {
#pragma unroll
            for (int ai = 0; ai < 2; ++ai)
#pragma unroll
                for (int m = 0; m < 4; ++m) { const int row = row0 + ai * 128 + m * 16;
#pragma unroll
                    for (int bj = 0; bj < 2; ++bj)
#pragma unroll
                        for (int n = 0; n < 2; ++n) { const int col = (pn - 4) * 256 + colw + 128 * bj + 16 * n;
                            *(unsigned*)(V8 + ((size_t)(col >> 6) * M + row) * 128 + 64 + (col & 63)) = pk4_fp8(acc[ai][bj][m][n] * AS); } }
            return;
        }
        bf16_t* O; int ldo, ct; float sc = 1.0f; bool sig = false;
        if (pn == 6) { O = QI; ldo = 256; ct = 0; sc = 0.125f; }
        else if (pn < 10) { O = UPOOL; ldo = PW; ct = (pn - 8) * 256; }
        else if (pn < 14) { O = GA; ldo = DM; ct = (pn - 10) * 256; sig = true; }
        else { O = GP; ldo = DM; ct = (pn - 14) * 256; sig = true; }
#pragma unroll
        for (int ai = 0; ai < 2; ++ai)
#pragma unroll
            for (int m = 0; m < 4; ++m) { bf16_t* rowp = O + (size_t)(row0 + ai * 128 + m * 16) * ldo + ct + colw;
#pragma unroll
                for (int bj = 0; bj < 2; ++bj)
#pragma unroll
                    for (int n = 0; n < 2; ++n) { f32x4 y = acc[ai][bj][m][n] * (sc * AS);
                        if (sig) { y[0] = sigmoidf_(y[0]); y[1] = sigmoidf_(y[1]); y[2] = sigmoidf_(y[2]); y[3] = sigmoidf_(y[3]); }
                        *(u32x2*)(rowp + 128 * bj + 16 * n) = pk4(y); }
            }
    }
};

template <int MODE> struct EpiBf {
    static constexpr bool PERM = false, AFTER_DRAIN = false;
    bf16_t* O; int ldo; const float* colscale; const bf16_t* ADD; unsigned char* O8 = nullptr; float as = 1.0f;
    __device__ __forceinline__ void operator()(const pg8::f32x4 (&acc)[2][2][4][2], const Unit& u, int wr, int wc, int fr, int fq) const {
        const int row0 = u.pm * 256 + wr * 64 + fr, col0 = u.pn * 256 + wc * 32 + 4 * fq;
#pragma unroll
        for (int ai = 0; ai < 2; ++ai)
#pragma unroll
            for (int m = 0; m < 4; ++m) { const size_t ro = (size_t)(row0 + ai * 128 + m * 16) * ldo + col0;
#pragma unroll
                for (int bj = 0; bj < 2; ++bj)
#pragma unroll
                    for (int n = 0; n < 2; ++n) { f32x4 y = acc[ai][bj][m][n] * as; const size_t off = ro + 128 * bj + 16 * n;
                        if (MODE == 3) { }
                        else if (MODE == 5) { *(unsigned*)((unsigned char*)O + off) = pk4f8(y * 64.0f); continue; }
                        else if (MODE == 0) { y = y * *(const f32x4*)(colscale + col0 + 128 * bj + 16 * n); }
                        else { const u32x2 gq = *(const u32x2*)(O + off); y[0] *= bf_lo(gq.x); y[1] *= bf_hi(gq.x); y[2] *= bf_lo(gq.y); y[3] *= bf_hi(gq.y);
                            if (MODE == 2 || MODE == 4) { const u32x2 a = *(const u32x2*)(ADD + off); y[0] += bf_lo(a.x); y[1] += bf_hi(a.x); y[2] += bf_lo(a.y); y[3] += bf_hi(a.y); } }
                        if (MODE == 4) *(unsigned*)(O8 + off) = pk4f8(y); else *(u32x2*)(O + off) = pk4(y); }
            }
    }
};

template <bool BIN, bool BOUT> struct EpiRes {
    static constexpr bool PERM = false, AFTER_DRAIN = false;
    const float* BASE; float* OUT; const float* gate; float dbg; float gs = 1.0f;
    __device__ __forceinline__ void operator()(const pg8::f32x4 (&acc)[2][2][4][2], const Unit& u, int wr, int wc, int fr, int fq) const {
        const int row0 = u.pm * 256 + wr * 64 + fr, col0 = u.pn * 256 + wc * 32 + 4 * fq;
        f32x4 gv[2][2];
#pragma unroll
        for (int bj = 0; bj < 2; ++bj)
#pragma unroll
            for (int n = 0; n < 2; ++n) gv[bj][n] = *(const f32x4*)(gate + col0 + 128 * bj + 16 * n) * gs;
#pragma unroll
        for (int ai = 0; ai < 2; ++ai)
#pragma unroll
            for (int m = 0; m < 4; ++m) { const int row = row0 + ai * 128 + m * 16; const size_t ro = (size_t)row * DM + col0;
#pragma unroll
                for (int bj = 0; bj < 2; ++bj)
#pragma unroll
                    for (int n = 0; n < 2; ++n) { const size_t off = ro + 128 * bj + 16 * n; f32x4 xb;
                        if (BIN) { const u32x2 q = *(const u32x2*)((const bf16_t*)BASE + off); xb = (f32x4){bf_lo(q.x), bf_hi(q.x), bf_lo(q.y), bf_hi(q.y)}; } else xb = *(const f32x4*)(BASE + off);
                        f32x4 y = xb + gv[bj][n] * acc[ai][bj][m][n];
                        if (dbg != 0.f) { const float sg = ((row * 7 + (int)(off >> 2)) & 1) ? dbg : -dbg; y[0] += sg; y[1] -= sg; y[2] += sg; y[3] -= sg; }
                        if (BOUT) *(u32x2*)((bf16_t*)OUT + off) = pk4(y); else *(f32x4*)(OUT + off) = y; }
            }
    }
};

template <int CTRL> __device__ __forceinline__ float dppf(float x) { return __builtin_bit_cast(float, __builtin_amdgcn_update_dpp(0, __builtin_bit_cast(int, x), CTRL, 0xf, 0xf, false)); }
__device__ __forceinline__ f32x4 ror1(f32x4 v) { f32x4 r; r[0] = dppf<0x121>(v[0]); r[1] = dppf<0x121>(v[1]); r[2] = dppf<0x121>(v[2]); r[3] = dppf<0x121>(v[3]); return r; }
__device__ __forceinline__ f32x4 ror2(f32x4 v) { f32x4 r; r[0] = dppf<0x122>(v[0]); r[1] = dppf<0x122>(v[1]); r[2] = dppf<0x122>(v[2]); r[3] = dppf<0x122>(v[3]); return r; }
__device__ __forceinline__ f32x4 silu_mul(f32x4 a, f32x4 b) { f32x4 r;
#pragma unroll
    for (int e = 0; e < 4; ++e) r[e] = a[e] * __builtin_amdgcn_rcpf(1.0f + __expf(-a[e])) * b[e];
    return r; }
struct EpiUpAct {
    static constexpr bool PERM = false, AFTER_DRAIN = false;
    bf16_t* ACT; float* RAW; const float* cw; const float* cb;
    static constexpr float US = 0.015625f;
    __device__ __forceinline__ void operator()(const pg8::f32x4 (&acc)[2][2][4][2], const Unit& u, int wr, int wc, int fr, int fq) const {
#pragma unroll
        for (int n = 0; n < 2; ++n) {
            const int ch = u.pn * 128 + wc * 32 + 4 * fq + 16 * n;
            const f32x4 w0a = *(const f32x4*)(cw + ch) * US, w1a = *(const f32x4*)(cw + FF2 + ch) * US, w2a = *(const f32x4*)(cw + 2 * FF2 + ch) * US, ba = *(const f32x4*)(cb + ch);
            const f32x4 w0b = *(const f32x4*)(cw + FF + ch) * US, w1b = *(const f32x4*)(cw + FF2 + FF + ch) * US, w2b = *(const f32x4*)(cw + 2 * FF2 + FF + ch) * US, bb = *(const f32x4*)(cb + FF + ch);
#pragma unroll
            for (int ai = 0; ai < 2; ++ai) {
                const int blk = u.pm * 4 + ai * 2 + wr;
                if (fr < 2) { *(f32x4*)(RAW + (size_t)(blk * 4 + fr) * FF2 + ch) = acc[ai][0][0][n] * US; *(f32x4*)(RAW + (size_t)(blk * 4 + fr) * FF2 + FF + ch) = acc[ai][1][0][n] * US; }
                if (fr >= 14) { *(f32x4*)(RAW + (size_t)(blk * 4 + fr - 12) * FF2 + ch) = acc[ai][0][3][n] * US; *(f32x4*)(RAW + (size_t)(blk * 4 + fr - 12) * FF2 + FF + ch) = acc[ai][1][3][n] * US; }
                f32x4 pa1 = {0.f, 0.f, 0.f, 0.f}, pa2 = pa1, pb1 = pa1, pb2 = pa1;
#pragma unroll
                for (int m = 0; m < 4; ++m) {
                    const f32x4 va = acc[ai][0][m][n], vb = acc[ai][1][m][n];
                    const f32x4 ra1 = ror1(va), ra2 = ror2(va), rb1 = ror1(vb), rb2 = ror2(vb);
                    const f32x4 xa1 = fr >= 1 ? ra1 : pa1, xa2 = fr >= 2 ? ra2 : pa2, xb1 = fr >= 1 ? rb1 : pb1, xb2 = fr >= 2 ? rb2 : pb2;
                    pa1 = ra1; pa2 = ra2; pb1 = rb1; pb2 = rb2;
                    const f32x4 ya = ba + w0a * xa2 + w1a * xa1 + w2a * va, yb = bb + w0b * xb2 + w1b * xb1 + w2b * vb;
                    const f32x4 o = silu_mul(ya, yb);
                    if (!(m == 0 && fr < 2)) *(unsigned*)((unsigned char*)ACT + (size_t)(blk * 64 + 16 * m + fr) * FF + ch) = pk4f8(o);
                }
            }
        }
    }
};

__device__ __forceinline__ void fixup_phase(const float* RAW, bf16_t* ACT, const float* cw, const float* cb, int gtid, int nthr, int it0 = 0, int it1 = 256 * 2 * 704) {
#pragma unroll 4
    for (int it = it0 + gtid; it < it1; it += nthr) {
        const int c4 = it % 704, rr = (it / 704) & 1, blk = it / 1408, ch = 4 * c4;
        const float* cur = RAW + (size_t)(blk * 4 + rr) * FF2;
        const float* p1 = rr == 1 ? RAW + (size_t)(blk * 4) * FF2 : (blk > 0 ? RAW + (size_t)((blk - 1) * 4 + 3) * FF2 : nullptr);
        const float* p2 = rr == 1 ? (blk > 0 ? RAW + (size_t)((blk - 1) * 4 + 3) * FF2 : nullptr) : (blk > 0 ? RAW + (size_t)((blk - 1) * 4 + 2) * FF2 : nullptr);
        const f32x4 z = {0.f, 0.f, 0.f, 0.f};
        const f32x4 va = *(const f32x4*)(cur + ch), vb = *(const f32x4*)(cur + FF + ch);
        const f32x4 a1 = p1 ? *(const f32x4*)(p1 + ch) : z, b1 = p1 ? *(const f32x4*)(p1 + FF + ch) : z;
        const f32x4 a2 = p2 ? *(const f32x4*)(p2 + ch) : z, b2 = p2 ? *(const f32x4*)(p2 + FF + ch) : z;
        const f32x4 ya = *(const f32x4*)(cb + ch) + *(const f32x4*)(cw + ch) * a2 + *(const f32x4*)(cw + FF2 + ch) * a1 + *(const f32x4*)(cw + 2 * FF2 + ch) * va;
        const f32x4 yb = *(const f32x4*)(cb + FF + ch) + *(const f32x4*)(cw + FF + ch) * b2 + *(const f32x4*)(cw + FF2 + FF + ch) * b1 + *(const f32x4*)(cw + 2 * FF2 + FF + ch) * vb;
        *(unsigned*)((unsigned char*)ACT + (size_t)(blk * 64 + rr) * FF + ch) = pk4f8(silu_mul(ya, yb));
    }
}

template <int W> __device__ __forceinline__ void pooled_item(const bf16_t* UPOOL, bf16_t* POOLED, int t, int c8) {
    v4u v[W];
#pragma unroll
    for (int j = 0; j < W; ++j) { const int tj = (t - j) >= 0 ? (t - j) : 0; v[j] = *(const v4u*)(UPOOL + (size_t)tj * PW + 8 * c8); }
    float s[8];
#pragma unroll
    for (int e = 0; e < 8; ++e) s[e] = 0.f;
#pragma unroll
    for (int j = 0; j < W; ++j) { const float m = (t - j) >= 0 ? 1.f : 0.f;
        s[0] = fmaf(m, bf_lo(v[j].x), s[0]); s[1] = fmaf(m, bf_hi(v[j].x), s[1]); s[2] = fmaf(m, bf_lo(v[j].y), s[2]); s[3] = fmaf(m, bf_hi(v[j].y), s[3]);
        s[4] = fmaf(m, bf_lo(v[j].z), s[4]); s[5] = fmaf(m, bf_hi(v[j].z), s[5]); s[6] = fmaf(m, bf_lo(v[j].w), s[6]); s[7] = fmaf(m, bf_hi(v[j].w), s[7]); }
    const int cntw = (t + 1) < W ? (t + 1) : W; const float inv = 1.0f / (float)cntw; v4u o;
    (void)o;
    const unsigned o0 = pk4f8((f32x4){s[0] * inv - bf_lo(v[0].x), s[1] * inv - bf_hi(v[0].x), s[2] * inv - bf_lo(v[0].y), s[3] * inv - bf_hi(v[0].y)});
    const unsigned o1 = pk4f8((f32x4){s[4] * inv - bf_lo(v[0].z), s[5] * inv - bf_hi(v[0].z), s[6] * inv - bf_lo(v[0].w), s[7] * inv - bf_hi(v[0].w)});
    *(u32x2*)((unsigned char*)POOLED + (size_t)t * PW + 8 * c8) = (u32x2){o0, o1};
}
template <int W> __device__ __forceinline__ void pooled_rows8(const bf16_t* UPOOL, bf16_t* POOLED, int t0, int c8) {
    constexpr int NR = W + 7;
    v4u v[NR];
#pragma unroll
    for (int j = 0; j < NR; ++j) { const int tj = t0 - (W - 1) + j; v[j] = *(const v4u*)(UPOOL + (size_t)(tj >= 0 ? tj : 0) * PW + 8 * c8); }
    float s[8];
#pragma unroll
    for (int e = 0; e < 8; ++e) s[e] = 0.f;
#define POOL_ACC(m, q) do { s[0] = fmaf((m), bf_lo((q).x), s[0]); s[1] = fmaf((m), bf_hi((q).x), s[1]); s[2] = fmaf((m), bf_lo((q).y), s[2]); s[3] = fmaf((m), bf_hi((q).y), s[3]); \
        s[4] = fmaf((m), bf_lo((q).z), s[4]); s[5] = fmaf((m), bf_hi((q).z), s[5]); s[6] = fmaf((m), bf_lo((q).w), s[6]); s[7] = fmaf((m), bf_hi((q).w), s[7]); } while (0)
#pragma unroll
    for (int j = 0; j < W - 1; ++j) { const float m = (t0 - (W - 1) + j) >= 0 ? 1.f : 0.f; POOL_ACC(m, v[j]); }
#pragma unroll
    for (int r = 0; r < 8; ++r) { const int t = t0 + r; const v4u cur = v[r + W - 1];
        POOL_ACC(1.f, cur);
        if (r > 0) { const float mo = (t - W) >= 0 ? -1.f : 0.f; POOL_ACC(mo, v[r - 1]); }
        const int cntw = (t + 1) < W ? (t + 1) : W; const float inv = 1.0f / (float)cntw;
        const unsigned o0 = pk4f8((f32x4){s[0] * inv - bf_lo(cur.x), s[1] * inv - bf_hi(cur.x), s[2] * inv - bf_lo(cur.y), s[3] * inv - bf_hi(cur.y)});
        const unsigned o1 = pk4f8((f32x4){s[4] * inv - bf_lo(cur.z), s[5] * inv - bf_hi(cur.z), s[6] * inv - bf_lo(cur.w), s[7] * inv - bf_hi(cur.w)});
        *(u32x2*)((unsigned char*)POOLED + (size_t)t * PW + 8 * c8) = (u32x2){o0, o1}; }
#undef POOL_ACC
}
__device__ __forceinline__ void pooled_phase(const bf16_t* UPOOL, bf16_t* POOLED, int gtid, int nthr) {
    for (int w = gtid >> 6; w < 2048; w += (nthr >> 6)) {
        const int l = gtid & 63, g = w & 3, t0 = ((w >> 2) * 4 + (l >> 4)) * 8, c8 = g * 16 + (l & 15);
        if (g == 0) pooled_rows8<2>(UPOOL, POOLED, t0, c8); else if (g == 1) pooled_rows8<4>(UPOOL, POOLED, t0, c8); else if (g == 2) pooled_rows8<8>(UPOOL, POOLED, t0, c8); else pooled_rows8<16>(UPOOL, POOLED, t0, c8);
    }
}

#ifndef ATT_MFMA
#define ATT_MFMA 1
#endif
#ifndef SP_QB
#define SP_QB 64
#endif
#ifndef SP_Z
#define SP_Z 3.75f
#endif
#ifndef SP_ZBIG
#define SP_ZBIG 4.5f
#endif
#ifndef SP_DRY
#define SP_DRY 0
#endif
#define MFMA32(a, b, c) __builtin_amdgcn_mfma_f32_32x32x16_bf16((a), (b), (c), 0, 0, 0)
__device__ __forceinline__ unsigned lds_add(LAS unsigned* p, unsigned v) { return __hip_atomic_fetch_add(p, v, __ATOMIC_RELAXED, __HIP_MEMORY_SCOPE_WORKGROUP); }
__device__ __forceinline__ unsigned lds_and(LAS unsigned* p, unsigned v) { return __hip_atomic_fetch_and(p, v, __ATOMIC_RELAXED, __HIP_MEMORY_SCOPE_WORKGROUP); }
__device__ __forceinline__ unsigned lds_or(LAS unsigned* p, unsigned v) { return __hip_atomic_fetch_or(p, v, __ATOMIC_RELAXED, __HIP_MEMORY_SCOPE_WORKGROUP); }

__device__ __forceinline__ unsigned f2sort(float f) { unsigned uu = __float_as_uint(f); return uu ^ (((unsigned)((int)uu >> 31)) | 0x80000000u); }
__device__ __forceinline__ float u2f(unsigned u) { return __uint_as_float((u & 0x80000000u) ? (u & 0x7fffffffu) : ~u); }
constexpr unsigned SP_CAP = 68u, SP_PHYS = 84u;
constexpr int SP_M = 18;
template <bool EMIT>
__device__ __forceinline__ unsigned tk_pass(int qb, int wave, int lane, const bf16_t* KI, const LAS bf16_t* QF, const float (&wv)[4], LAS unsigned* H, LAS unsigned* SELM, LAS unsigned* TIEM,
                                        int sh, unsigned vlo, bool clampTop, unsigned bmax, int stage, unsigned vmin, float fsel, float ftie, unsigned vmax = 0xffffffffu,
                                        bool append = false, float ftie_a = 0.f, unsigned char* lst = nullptr, unsigned loff0 = 0u,
                                        bool havepre = false, const pg8::bf16x8 pk0 = pg8::bf16x8{}, const pg8::bf16x8 pk1 = pg8::bf16x8{}, const pg8::bf16x8 pk2 = pg8::bf16x8{}, const pg8::bf16x8 pk3 = pg8::bf16x8{}) {
    const int r = lane & 31, h = lane >> 5;
    unsigned loff = loff0, lovf = 0u;
    const unsigned long long appmask = __ballot(ftie_a == ftie);
    const bool nosel = __ballot(fsel != INFINITY) == 0ull;
    const bool appfast = __ballot(ftie_a != ftie && ftie_a != INFINITY) == 0ull;
    const int gstep = stage == 1 ? 8 : 1, g0 = stage == 1 ? wave : 0;
#define TK_NEXT_G(g) ({ int _g = (g) + gstep; if (stage == 2 && (_g & 7) == wave) ++_g; _g; })
    int gcur = g0; if (stage == 2 && (gcur & 7) == wave) ++gcur;
    pg8::bf16x8 kf[4];
    if (havepre) { kf[0] = pk0; kf[1] = pk1; kf[2] = pk2; kf[3] = pk3; }
    else { const int T0 = (wave + 8 * gcur) <= qb ? (wave + 8 * gcur) : qb; const bf16_t* kp = KI + (size_t)T0 * 2048 + 8 * lane;
#pragma unroll
      for (int s = 0; s < 4; ++s) kf[s] = *(const pg8::bf16x8*)(kp + 512 * s); }
    LAS unsigned* Hq = H + r * HSTRIDE;
    pg8::bf16x8 qf[16];
#pragma unroll
    for (int f = 0; f < 16; ++f) qf[f] = *(const LAS pg8::bf16x8*)(QF + f * 512 + lane * 8);
#pragma unroll 1
    for (; wave + 8 * gcur <= qb; gcur = TK_NEXT_G(gcur)) {
        const int T = wave + 8 * gcur;
        float sc[16];
#pragma unroll
        for (int i = 0; i < 16; ++i) sc[i] = 0.f;
        f32x16 acur;
#pragma unroll
        for (int i = 0; i < 16; ++i) acur[i] = 0.f;
#pragma unroll
        for (int s = 0; s < 4; ++s) acur = MFMA32(kf[s], qf[s], acur);
#pragma unroll
        for (int hd = 0; hd < 4; ++hd) { f32x16 an;
#pragma unroll
            for (int i = 0; i < 16; ++i) an[i] = 0.f;
            if (hd < 3) {
#pragma unroll
                for (int s = 0; s < 4; ++s) an = MFMA32(kf[s], qf[(hd + 1) * 4 + s], an); }
#pragma unroll
            for (int i = 0; i < 16; ++i) { const float av = acur[i]; const int ab = __float_as_int(av); sc[i] = fmaf(wv[hd], __int_as_float(ab > 0 ? ab : 0), sc[i]); }
            acur = an; }
        { const int Tnn = wave + 8 * TK_NEXT_G(gcur); const int Tn = Tnn <= qb ? Tnn : T; const bf16_t* kp = KI + (size_t)Tn * 2048 + 8 * lane;
#pragma unroll
          for (int s = 0; s < 4; ++s) kf[s] = *(const pg8::bf16x8*)(kp + 512 * s); }
        const int rlim = (T == qb) ? r : 64;
        if (!EMIT) {
#pragma unroll
            for (int i = 0; i < 16; ++i) {
                const int kr = (i & 3) + 8 * (i >> 2) + 4 * h;
                unsigned uu = __float_as_uint(sc[i]); uu ^= ((unsigned)((int)uu >> 31)) | 0x80000000u;
                const unsigned v = uu >> sh; unsigned b = v - vlo;
                const bool ok = (kr <= rlim) && (v >= vmin) && (v <= vmax) && (clampTop || b <= bmax);
                b = b > 2047u ? 2047u : b;
                lds_add(Hq + (ok ? (b >> 1) : 1024u), 1u << ((b & 1u) * 16u));
            }
        } else {
            unsigned ms = 0u, mg = 0u;
            const bool fastapp = append && appfast && nosel && T != qb;
            if (fastapp) {
#pragma unroll
                for (int i = 15; i >= 0; --i) {
                    unsigned long long ct;
                    asm("v_cmp_ge_f32_e64 %0, %1, %2" : "=s"(ct) : "v"(sc[i]), "v"(ftie));
                    asm("v_addc_co_u32_e64 %0, vcc, %0, %0, %1" : "+v"(mg) : "s"(ct) : "vcc");
                    if (__builtin_amdgcn_inverse_ballot_w64(ct & appmask)) { *(u32x2*)(lst + loff) = (u32x2){__float_as_uint(sc[i]), (unsigned)(32 * T + (i & 3) + 8 * (i >> 2) + 4 * h)}; loff += 8u; }
                }
            } else {
#pragma unroll
            for (int i = 15; i >= 0; --i) {
                asm("v_cmp_ge_f32_e32 vcc, %1, %2\n\tv_addc_co_u32_e32 %0, vcc, %0, %0, vcc" : "+v"(ms) : "v"(sc[i]), "v"(fsel) : "vcc");
                asm("v_cmp_ge_f32_e32 vcc, %1, %2\n\tv_addc_co_u32_e32 %0, vcc, %0, %0, vcc" : "+v"(mg) : "v"(sc[i]), "v"(ftie) : "vcc");
            }
            }
            const unsigned vrow = rlim >= 31 ? 0xffffffffu : ((2u << rlim) - 1u);
            auto spread = [&](unsigned m) { return (((m & 0xfu) | ((m & 0xf0u) << 4) | ((m & 0xf00u) << 8) | ((m & 0xf000u) << 12)) << (4 * h)) & vrow; };
            const unsigned msel = spread(ms), mtie = spread(mg) & ~msel;
            const unsigned osel = __shfl_xor(msel, 32), otie = __shfl_xor(mtie, 32);
            if (h == 0) { SELM[r * MSTRIDE + T] = msel | osel; TIEM[r * MSTRIDE + T] = mtie | otie; }
            if (append && !fastapp) {
#pragma unroll
                for (int i = 0; i < 16; ++i) {
                    const int kr = (i & 3) + 8 * (i >> 2) + 4 * h;
                    if ((sc[i] >= ftie_a) && !(sc[i] >= fsel) && (kr <= rlim)) { *(u32x2*)(lst + loff) = (u32x2){__float_as_uint(sc[i]), (unsigned)(32 * T + kr)}; loff += 8u; }
                }
            }
            if (append && loff >= loff0 + (SP_PHYS - 16u) * 8u) { lovf = 1u; loff = loff0; }
        }
    }
#undef TK_NEXT_G
    return loff | lovf;
}

template <int CTRL> __device__ __forceinline__ float dppx(float x) { return __builtin_bit_cast(float, __builtin_amdgcn_mov_dpp(__builtin_bit_cast(int, x), CTRL, 0xf, 0xf, true)); }
__device__ __forceinline__ u32x2 tk_rescore_load(const bf16_t* KI, int key, int lane) {
    const int c = 4 * (lane & 15);
    return *(const u32x2*)(KI + (size_t)(key >> 5) * 2048 + (c >> 4) * 512 + ((((c >> 3) & 1) * 32 + (key & 31)) * 8) + (c & 7));
}
__device__ __forceinline__ float tk_rescore(const u32x2 q4, float wh, const u32x2 k4) {
    float d = bf_lo(q4.x) * bf_lo(k4.x); d = fmaf(bf_hi(q4.x), bf_hi(k4.x), d); d = fmaf(bf_lo(q4.y), bf_lo(k4.y), d); d = fmaf(bf_hi(q4.y), bf_hi(k4.y), d);
    d += dppx<0xB1>(d); d += dppx<0x4E>(d); d += dppx<0x141>(d); d += dppx<0x140>(d);
    float sc = wh * fmaxf(d, 0.f);
    sc += __shfl_xor(sc, 16); sc += __shfl_xor(sc, 32);
    return sc + 0.f;
}

__device__ __forceinline__ int wave_incl_scan(int v) {
    v += __builtin_amdgcn_update_dpp(0, v, 0x111, 0xf, 0xf, true); v += __builtin_amdgcn_update_dpp(0, v, 0x112, 0xf, 0xf, true);
    v += __builtin_amdgcn_update_dpp(0, v, 0x114, 0xf, 0xf, true); v += __builtin_amdgcn_update_dpp(0, v, 0x118, 0xf, 0xf, true);
    v += __builtin_amdgcn_update_dpp(0, v, 0x142, 0xa, 0xf, false); v += __builtin_amdgcn_update_dpp(0, v, 0x143, 0xc, 0xf, false);
    return v;
}
template <int WPL>
__device__ __forceinline__ void tk_scan_core(const LAS unsigned* Hq, int need, int lane, unsigned& Dsel, unsigned& nsel, unsigned& csel, int& total) {
    constexpr int BPL = 2 * WPL;
    asm volatile("" : "+v"(lane));
    int S = 0;
#pragma unroll
    for (int i = 0; i < WPL; ++i) { const unsigned w = Hq[WPL * lane + ((i + lane) & (WPL - 1))]; S += (int)((w & 0xffffu) + (w >> 16)); }
    const int incl = wave_incl_scan(S); total = __builtin_amdgcn_readlane(incl, 63); const int Tabove = total - incl;
    const bool hit = (Tabove < need) && (need <= Tabove + S);
    const unsigned long long mk = __ballot(hit);
    const int L = mk ? (int)__builtin_ctzll(mk) : 0;
    const int remL = need - __builtin_amdgcn_readlane(Tabove, L);
    const unsigned w2 = Hq[WPL * L + ((lane & (BPL - 1)) >> 1)];
    const int c = lane < BPL ? (int)((w2 >> (16 * (lane & 1))) & 0xffffu) : 0;
    const int incl2 = wave_incl_scan(c), tot2 = __builtin_amdgcn_readlane(incl2, 63), above2 = tot2 - incl2;
    const bool hit2 = (lane < BPL) && (above2 < remL) && (remL <= above2 + c);
    const unsigned long long mk2 = __ballot(hit2);
    const int J = mk2 ? (int)__builtin_ctzll(mk2) : 0;
    Dsel = mk ? (unsigned)(BPL * L + J) : 0xffffu; nsel = mk2 ? (unsigned)(remL - __builtin_amdgcn_readlane(above2, J)) : 1u; csel = (unsigned)__builtin_amdgcn_readlane(c, J);
}
__device__ __forceinline__ void tk_scan_two(const LAS unsigned* Hq, int needA, int needB, int lane, unsigned& DA, unsigned& DB) {
    int S = 0;
#pragma unroll
    for (int i = 0; i < 16; ++i) { const unsigned w = Hq[16 * lane + ((i + lane) & 15)]; S += (int)((w & 0xffffu) + (w >> 16)); }
    const int incl = wave_incl_scan(S), total = __builtin_amdgcn_readlane(incl, 63), Tabove = total - incl;
    const unsigned long long mkA = __ballot((Tabove < needA) && (needA <= Tabove + S)), mkB = __ballot((Tabove < needB) && (needB <= Tabove + S));
    const int LA = mkA ? (int)__builtin_ctzll(mkA) : 0, LB = mkB ? (int)__builtin_ctzll(mkB) : 0;
    const int remA = needA - __builtin_amdgcn_readlane(Tabove, LA), remB = needB - __builtin_amdgcn_readlane(Tabove, LB);
    const unsigned wA = Hq[16 * LA + ((lane & 31) >> 1)], wB = Hq[16 * LB + ((lane & 31) >> 1)];
    const int cA = lane < 32 ? (int)((wA >> (16 * (lane & 1))) & 0xffffu) : 0, cB = lane < 32 ? (int)((wB >> (16 * (lane & 1))) & 0xffffu) : 0;
    const int iA = wave_incl_scan(cA), iB = wave_incl_scan(cB);
    const int aA = __builtin_amdgcn_readlane(iA, 63) - iA, aB = __builtin_amdgcn_readlane(iB, 63) - iB;
    const unsigned long long m2A = __ballot((lane < 32) && (aA < remA) && (remA <= aA + cA)), m2B = __ballot((lane < 32) && (aB < remB) && (remB <= aB + cB));
    DA = mkA ? (unsigned)(32 * LA + (m2A ? (int)__builtin_ctzll(m2A) : 0)) : 0xffffu;
    DB = mkB ? (unsigned)(32 * LB + (m2B ? (int)__builtin_ctzll(m2B) : 0)) : 0xffffu;
}
__device__ __forceinline__ void tk_scan(const LAS unsigned* Hq, LAS unsigned* pref_p, LAS unsigned* need_p, LAS unsigned* cnt_p, int bits, int lane, LAS unsigned* tot_p = nullptr) {
    unsigned Dsel, nsel, csel; int total;
    tk_scan_core<16>(Hq, (int)*need_p, lane, Dsel, nsel, csel, total);
    if (lane == 0) { *pref_p = bits ? ((*pref_p << bits) | Dsel) : Dsel; *need_p = nsel; if (cnt_p) *cnt_p = csel; if (tot_p) *tot_p = (unsigned)total; }
}

typedef float f32x2_t __attribute__((ext_vector_type(2)));
__device__ __forceinline__ void unpack16(const v4u w, f32x2_t (&f)[8]) {
#pragma unroll
    for (int i = 0; i < 4; ++i) { f[2 * i] = __builtin_amdgcn_cvt_pk_f32_fp8((int)w[i], false); f[2 * i + 1] = __builtin_amdgcn_cvt_pk_f32_fp8((int)w[i], true); }
}
__device__ __forceinline__ void attn_item(int t, int hd, const unsigned short* SEL, const bf16_t* Q, const unsigned char* K8, const unsigned char* V8, bf16_t* ATTN, int lane) {
    constexpr float LOG2E = 1.4426950408889634f;
    const int kk = lane >> 2, part = lane & 3, cnt = (t + 1) < 256 ? (t + 1) : 256;
    const float slope2 = __uint_as_float((unsigned)(126 - hd) << 23) * LOG2E, sc2 = 0.125f * LOG2E;
#if ATT_MFMA
    const int g4 = lane >> 4, bp = 4 * (4 * (lane & 15) + g4), isel = kk & 3;
    long B1, B2;
    { const v4u qa = *(const v4u*)(Q + (size_t)t * AW + hd * 64 + g4 * 16), qb = *(const v4u*)(Q + (size_t)t * AW + hd * 64 + g4 * 16 + 8);
      int b0 = __builtin_amdgcn_cvt_pk_fp8_f32(bf_lo(qa.x), bf_hi(qa.x), 0, false); b0 = __builtin_amdgcn_cvt_pk_fp8_f32(bf_lo(qa.y), bf_hi(qa.y), b0, true);
      int b1 = __builtin_amdgcn_cvt_pk_fp8_f32(bf_lo(qa.z), bf_hi(qa.z), 0, false); b1 = __builtin_amdgcn_cvt_pk_fp8_f32(bf_lo(qa.w), bf_hi(qa.w), b1, true);
      int b2 = __builtin_amdgcn_cvt_pk_fp8_f32(bf_lo(qb.x), bf_hi(qb.x), 0, false); b2 = __builtin_amdgcn_cvt_pk_fp8_f32(bf_lo(qb.y), bf_hi(qb.y), b2, true);
      int b3 = __builtin_amdgcn_cvt_pk_fp8_f32(bf_lo(qb.z), bf_hi(qb.z), 0, false); b3 = __builtin_amdgcn_cvt_pk_fp8_f32(bf_lo(qb.w), bf_hi(qb.w), b3, true);
      B1 = (long)(((unsigned long long)(unsigned)b1 << 32) | (unsigned)b0); B2 = (long)(((unsigned long long)(unsigned)b3 << 32) | (unsigned)b2); }
#else
    f32x2_t q[8];
    { const v4u qa = *(const v4u*)(Q + (size_t)t * AW + hd * 64 + part * 16), qb = *(const v4u*)(Q + (size_t)t * AW + hd * 64 + part * 16 + 8);
#pragma unroll
      for (int i = 0; i < 4; ++i) { q[i] = (f32x2_t){bf_lo(qa[i]) * sc2, bf_hi(qa[i]) * sc2}; q[4 + i] = (f32x2_t){bf_lo(qb[i]) * sc2, bf_hi(qb[i]) * sc2}; } }
#endif
    const unsigned short* lp = SEL + (size_t)t * 256;
    const unsigned char* kb = K8 + (size_t)hd * M * 128 + part * 16; const unsigned char* vb = kb + 64; (void)V8;
    int key[16]; v4u kf[16], vf[16];
#pragma unroll
    for (int r = 0; r < 16; ++r) { const int j = 16 * r + kk; key[r] = (int)lp[j < cnt ? j : cnt - 1]; }
#pragma unroll
    for (int r = 0; r < 16; ++r) { kf[r] = *(const v4u*)(kb + (size_t)key[r] * 128); vf[r] = *(const v4u*)(vb + (size_t)key[r] * 128); }
    float sv[16]; float mx = -INFINITY;
#if ATT_MFMA
    const bool o1 = (isel & 1) != 0, o2 = (isel & 2) != 0;
#pragma unroll
    for (int r = 0; r < 16; ++r) {
        kf[r].x = (unsigned)__builtin_amdgcn_ds_bpermute(bp, (int)kf[r].x); kf[r].y = (unsigned)__builtin_amdgcn_ds_bpermute(bp, (int)kf[r].y);
        kf[r].z = (unsigned)__builtin_amdgcn_ds_bpermute(bp, (int)kf[r].z); kf[r].w = (unsigned)__builtin_amdgcn_ds_bpermute(bp, (int)kf[r].w); }
#pragma unroll
    for (int r = 0; r < 16; ++r) {
        const long A1 = (long)(((unsigned long long)kf[r].y << 32) | kf[r].x), A2 = (long)(((unsigned long long)kf[r].w << 32) | kf[r].z);
        f32x4 acc = {0.f, 0.f, 0.f, 0.f};
        acc = __builtin_amdgcn_mfma_f32_16x16x32_fp8_fp8(A1, B1, acc, 0, 0, 0); acc = __builtin_amdgcn_mfma_f32_16x16x32_fp8_fp8(A2, B2, acc, 0, 0, 0);
        const float a0 = acc[0], a1 = acc[1], a2 = acc[2], a3 = acc[3];
        const float s01 = o1 ? a1 : a0, s23 = o1 ? a3 : a2;
        sv[r] = o2 ? s23 : s01; }
#pragma unroll
    for (int r = 0; r < 16; ++r) { sv[r] = (16 * r + kk) < cnt ? fmaf(sv[r], sc2, -slope2 * (float)(t - key[r])) : -INFINITY; mx = fmaxf(mx, sv[r]); }
#else
#pragma unroll
    for (int r = 0; r < 16; ++r) { f32x2_t kx[8]; unpack16(kf[r], kx); f32x2_t d2 = q[0] * kx[0];
#pragma unroll
        for (int e = 1; e < 8; ++e) d2 = __builtin_elementwise_fma(q[e], kx[e], d2);
        sv[r] = d2.x + d2.y; }
#pragma unroll
    for (int r = 0; r < 16; ++r) sv[r] += dppx<0xB1>(sv[r]);
#pragma unroll
    for (int r = 0; r < 16; ++r) sv[r] += dppx<0x4E>(sv[r]);
#pragma unroll
    for (int r = 0; r < 16; ++r) { sv[r] = (16 * r + kk) < cnt ? sv[r] - slope2 * (float)(t - key[r]) : -INFINITY; mx = fmaxf(mx, sv[r]); }
#endif
    mx = fmaxf(mx, __shfl_xor(mx, 4)); mx = fmaxf(mx, __shfl_xor(mx, 8)); mx = fmaxf(mx, __shfl_xor(mx, 16)); mx = fmaxf(mx, __shfl_xor(mx, 32));
    f32x2_t o[8]; float lsum = 0.f;
#pragma unroll
    for (int e = 0; e < 8; ++e) o[e] = (f32x2_t){0.f, 0.f};
#pragma unroll
    for (int r = 0; r < 16; ++r) { const float p = __builtin_amdgcn_exp2f(sv[r] - mx); lsum += p; f32x2_t vx[8]; unpack16(vf[r], vx); const f32x2_t p2 = (f32x2_t){p, p};
#pragma unroll
        for (int e = 0; e < 8; ++e) o[e] = __builtin_elementwise_fma(p2, vx[e], o[e]); }
    lsum += dppx<0x124>(lsum); lsum += dppx<0x128>(lsum); lsum += __shfl_xor(lsum, 16); lsum += __shfl_xor(lsum, 32);
    float of[16];
#pragma unroll
    for (int e = 0; e < 8; ++e) { of[2 * e] = o[e].x; of[2 * e + 1] = o[e].y; }
#pragma unroll
    for (int e = 0; e < 16; ++e) of[e] += dppx<0x124>(of[e]);
#pragma unroll
    for (int e = 0; e < 16; ++e) of[e] += dppx<0x128>(of[e]);
#pragma unroll
    for (int e = 0; e < 16; ++e) of[e] += __shfl_xor(of[e], 16);
#pragma unroll
    for (int e = 0; e < 16; ++e) of[e] += __shfl_xor(of[e], 32);
    if (lane < 4) { const float inv = __builtin_amdgcn_rcpf(lsum); v4u a, b;
        a.x = pk4f8((f32x4){of[0] * inv, of[1] * inv, of[2] * inv, of[3] * inv}); a.y = pk4f8((f32x4){of[4] * inv, of[5] * inv, of[6] * inv, of[7] * inv});
        a.z = pk4f8((f32x4){of[8] * inv, of[9] * inv, of[10] * inv, of[11] * inv}); a.w = pk4f8((f32x4){of[12] * inv, of[13] * inv, of[14] * inv, of[15] * inv}); (void)b;
        *(v4u*)((unsigned char*)ATTN + (size_t)t * AW + hd * 64 + part * 16) = a; }
}

struct TkPtrs { const bf16_t *QI, *KI; const float* WI; unsigned short* SEL; unsigned char* LST; };
__device__ __forceinline__ unsigned wave_max_u32(unsigned v) {
    v = max(v, (unsigned)__builtin_amdgcn_update_dpp(0, (int)v, 0x111, 0xf, 0xf, true)); v = max(v, (unsigned)__builtin_amdgcn_update_dpp(0, (int)v, 0x112, 0xf, 0xf, true));
    v = max(v, (unsigned)__builtin_amdgcn_update_dpp(0, (int)v, 0x114, 0xf, 0xf, true)); v = max(v, (unsigned)__builtin_amdgcn_update_dpp(0, (int)v, 0x118, 0xf, 0xf, true));
    v = max(v, (unsigned)__builtin_amdgcn_update_dpp(0, (int)v, 0x142, 0xa, 0xf, false)); v = max(v, (unsigned)__builtin_amdgcn_update_dpp(0, (int)v, 0x143, 0xc, 0xf, false));
    return (unsigned)__builtin_amdgcn_readlane((int)v, 63);
}
struct TkPre { pg8::bf16x8 f0, f1; f32x4 w4; int qi; };
__device__ __forceinline__ TkPre tk_prefetch(int qi, const TkPtrs& P, int wave, int lane) {
    TkPre N; const int t0 = (511 - (qi & 511)) * 32, r = lane & 31, h = lane >> 5; const bf16_t* qp = P.QI + (size_t)(t0 + r) * 256 + 8 * h;
    { const int f = 2 * wave; N.f0 = *(const pg8::bf16x8*)(qp + (f >> 2) * 64 + 16 * (f & 3)); }
    { const int f = 2 * wave + 1; N.f1 = *(const pg8::bf16x8*)(qp + (f >> 2) * 64 + 16 * (f & 3)); }
    N.w4 = *(const f32x4*)(P.WI + (size_t)(t0 + r) * 4); N.qi = qi; return N;
}
__device__ __forceinline__ void topk_passes(int qb, const TkPtrs& P, LAS unsigned char* lds, int tid, int wave, int lane, const pg8::bf16x8 pf0, const pg8::bf16x8 pf1, const f32x4 w4) {
    LAS unsigned* H = (LAS unsigned*)lds;
    LAS unsigned* SELM = (LAS unsigned*)lds;
    LAS unsigned* TIEM = (LAS unsigned*)(lds + 32 * MSTRIDE * 4);
    LAS unsigned short* LIST = (LAS unsigned short*)(lds + LIST_OFF);
    LAS unsigned* STP = (LAS unsigned*)(lds + ST_OFF);
    LAS unsigned* STN = STP + 32;
    const int t0 = qb * 32, r = lane & 31, h = lane >> 5;
    SYNC();
    float wv[4];
    LAS bf16_t* QF = (LAS bf16_t*)(lds + LIST_OFF);
    *(LAS pg8::bf16x8*)(QF + (2 * wave) * 512 + lane * 8) = pf0; *(LAS pg8::bf16x8*)(QF + (2 * wave + 1) * 512 + lane * 8) = pf1;
    wv[0] = w4[0]; wv[1] = w4[1]; wv[2] = w4[2]; wv[3] = w4[3];
    LAS unsigned* STC = STP + 64;
    LAS unsigned* STG = STP + 96;
    LAS unsigned* FB = STP + 160;
    LAS unsigned* STS = STP + 192;
    LAS float* FSEL = (LAS float*)(STP + 256);
    LAS float* FTIE = FSEL + 32;
    const bool negw = (wv[0] <= 0.f) && (wv[1] <= 0.f) && (wv[2] <= 0.f) && (wv[3] <= 0.f);
    const unsigned wbase = negw ? 7745u : 22976u;
    LAS unsigned* WINOK = STP + 161;
    LAS unsigned* PBN = STP + 320;
    LAS unsigned* FBS = STP + 162;
    LAS float* FTA = FSEL + 96;
    LAS unsigned* CNTL = STP + 512;
    if (wave == 0 && lane == 0) { *FB = 0u; *WINOK = 0u; *FBS = 0u; }
#pragma unroll 1
    for (int mode = (qb >= SP_QB && blockIdx.x < 256u) ? -1 : 0; mode < 2; ++mode) {
        if (mode == 1) { if ((*FB & 1u) == 0u) break; }
        if (wave == 0 && lane < 32) { STP[lane] = 0u; const int nv = t0 + lane + 1; STN[lane] = nv < 256 ? nv : 256; STG[lane] = negw ? 1u : 0u; }
        const int nstep = mode <= 0 ? 1 : 3;
#pragma unroll 1
        for (int step = 0; step < nstep; ++step) {
            pg8::bf16x8 pk[4] = {pg8::bf16x8{}, pg8::bf16x8{}, pg8::bf16x8{}, pg8::bf16x8{}};
            if (mode < 0) { const int T0 = 9 * wave <= qb ? 9 * wave : qb; const bf16_t* kp = P.KI + (size_t)T0 * 2048 + 8 * lane;
#pragma unroll
                for (int s4 = 0; s4 < 4; ++s4) pk[s4] = *(const pg8::bf16x8*)(kp + 512 * s4); }
            for (int i = tid; i < 32 * HSTRIDE; i += NTHR) H[i] = 0u;
            SYNC();
            const int sh = mode <= 0 ? 17 : (step == 0 ? 21 : (step == 1 ? 10 : 0));
            const unsigned vlo = mode <= 0 ? wbase : (step == 0 ? 0u : (STP[r] << (step == 1 ? 11 : 10)));
            tk_pass<false>(qb, wave, lane, P.KI, QF, wv, H, SELM, TIEM, sh, vlo, mode <= 0, (mode == 1 && step == 2) ? 1023u : 2047u, mode < 0 ? 1 : 0, vlo, 0.f, 0.f, 0xffffffffu, false, 0.f, nullptr, 0u, mode < 0, pk[0], pk[1], pk[2], pk[3]);
            SYNC();
            if (mode < 0) {
                int lane_s = lane; asm volatile("" : "+v"(lane_s));
#pragma unroll
                for (int qq = 0; qq < 4; ++qq) { const int rq = 4 * wave + qq;
                    int ns = 0;
#pragma unroll
                    for (int w = 0; w < 8; ++w) { const int first = 9 * w; if (first <= qb) { const int k = (qb - first) >> 6; ns += 32 * (k + 1); if (first + 64 * k == qb) ns -= 31 - rq; } }
                    const float phi = (float)ns / (float)(t0 + rq + 1), mu = 256.f * phi, sd = sqrtf(mu * (1.f - phi));
                    const float zz = qb >= 384 ? SP_ZBIG : SP_Z;
                    int rhi = (int)floorf(mu - zz * sd); const int rlo = (int)ceilf(mu + zz * sd); rhi = rhi < 1 ? 1 : rhi;
                    unsigned Dh, Dl;
                    tk_scan_two(H + rq * HSTRIDE, rhi, rlo, lane_s, Dh, Dl);
                    if (lane_s == 0) { const unsigned ng = STG[rq] & 1u;
                        if (Dl == 0xffffu) {
                            if (ng) *FBS = 1u;
                            else {
                                FSEL[rq] = (Dh == 0xffffu || Dh == 2047u) ? INFINITY : u2f((22976u + Dh + 1u) << 17); FTIE[rq] = 0.f; FTA[rq] = __uint_as_float(1u); STG[rq] = 8u | 16u; }
                        } else {
                            const unsigned wb = ng ? 7745u : 22976u; const bool zb = ng && Dl == 2047u;
                            const float ft = u2f((wb + Dl) << 17);
                            FSEL[rq] = INFINITY; FTIE[rq] = ft; FTA[rq] = zb ? INFINITY : ft;
                            STG[rq] = ng | (zb ? 0u : 8u); } }
                }
            } else
#pragma unroll 1
            for (int qq = 0; qq < 4; ++qq) { const int rq = 4 * wave + qq;
                tk_scan(H + rq * HSTRIDE, STP + rq, STN + rq, STC + rq, (mode == 1 && step == 2) ? 10 : 11, lane, PBN + rq);
                if (mode == 0 && lane == 0) { const unsigned D = STP[rq], nn = STN[rq], c = STC[rq], ng = STG[rq] & 1u;
                    if (D == 0xffffu) {
                        if (!ng) { const int nv = t0 + rq + 1; const unsigned need0 = nv < 256 ? nv : 256; PBN[rq] = need0 - PBN[rq]; STG[rq] = 4u; lds_or(FB, 2u); }
                        else lds_or(FB, 1u);
                    } else {
                        const bool zerobin = ng && D == 2047u, edge = (D == 0u) || (D == 2047u && !ng);
                        const bool wantc = (c > nn) && !zerobin;
                        if (edge || (wantc && c > 64u)) lds_or(FB, 1u);
                        STG[rq] = ng | (wantc ? 2u : 0u);
                        const unsigned wb = ng ? 7745u : 22976u;
                        FTIE[rq] = u2f((wb + D) << 17); FSEL[rq] = zerobin ? INFINITY : u2f((wb + D + 1u) << 17); } }
                if (mode == 1 && step == 2 && lane == 0) { const unsigned tau = STP[rq]; FTIE[rq] = u2f(tau); FSEL[rq] = tau == 0xffffffffu ? INFINITY : u2f(tau + 1u); } }
            SYNC();
        }
        if (mode < 0) {
            if (*FBS) continue;
            const unsigned tid8 = (unsigned)((r * 16 + 2 * wave + h) * (int)(SP_PHYS * 8u));
            const unsigned lend = tk_pass<true>(qb, wave, lane, P.KI, QF, wv, H, SELM, TIEM, 0, 0u, false, 0u, 0, 0u, FSEL[r], FTIE[r], 0xffffffffu, true, FTA[r], P.LST, tid8);
            CNTL[tid] = (lend & 1u) ? 0xffffu : ((lend - tid8) >> 3);
            SYNC();
#pragma unroll 1
            for (int qq = 0; qq < 4; ++qq) { const int rq = 4 * wave + qq;
                int cs = 0, ct = 0;
#pragma unroll
                for (int i = 0; i < 8; ++i) { const int T = 8 * lane + i; if (T <= qb) { cs += __builtin_popcount(SELM[rq * MSTRIDE + T]); ct += __builtin_popcount(TIEM[rq * MSTRIDE + T]); } }
                cs = __builtin_amdgcn_readlane(wave_incl_scan(cs), 63); ct = __builtin_amdgcn_readlane(wave_incl_scan(ct), 63);
                const unsigned cn = CNTL[64 * ((lane & 15) >> 1) + 32 * (lane & 1) + rq];
                const bool bad = __ballot(cn > SP_CAP) != 0ull;
                if (lane == 0) { if (cs >= 256 || cs + ct < 256 || ((STG[rq] & 8u) && bad)) *FBS = 1u; STN[rq] = (unsigned)(256 - cs); }
            }
            SYNC();
            if (*FBS || SP_DRY) continue;
            break;
        }
        if (mode == 0 && (*FB & 1u)) continue;
        if (mode == 0 && (*FB & 2u)) {
            for (int i = tid; i < 32 * HSTRIDE; i += NTHR) H[i] = 0u;
            if (wave == 0 && lane < 32 && (STG[lane] & 4u)) { STP[lane] = 0u; STN[lane] = PBN[lane]; }
            SYNC();
            const bool isB = (STG[r] & 4u) != 0u;
            tk_pass<false>(qb, wave, lane, P.KI, QF, wv, H, SELM, TIEM, 17, 7745u, true, 2047u, 0, isB ? 7745u : 0xffffffffu, 0.f, 0.f, 22975u);
            SYNC();
#pragma unroll 1
            for (int qq = 0; qq < 4; ++qq) { const int rq = 4 * wave + qq;
                if (STG[rq] & 4u) { tk_scan(H + rq * HSTRIDE, STP + rq, STN + rq, STC + rq, 11, lane);
                    if (lane == 0) { const unsigned D = STP[rq], nn = STN[rq], c = STC[rq];
                        const bool zerobin = D == 2047u, wantc = (c > nn) && !zerobin;
                        if (D == 0xffffu || D == 0u || (wantc && c > 64u)) lds_or(FB, 1u);
                        STG[rq] = wantc ? 2u : 0u;
                        FTIE[rq] = u2f((7745u + D) << 17); FSEL[rq] = zerobin ? __uint_as_float(1u) : u2f((7745u + D + 1u) << 17); } } }
            SYNC();
            if (*FB & 1u) continue;
        }
        tk_pass<true>(qb, wave, lane, P.KI, QF, wv, H, SELM, TIEM, 0, 0u, false, 0u, 0, 0u, FSEL[r], FTIE[r]);
        if (mode == 0 && wave == 0 && lane == 0) *WINOK = 1u;
        SYNC();
        break;
    }
}
__device__ __forceinline__ void topk_tail(int qb, const TkPtrs& P, LAS unsigned char* lds, int tid, int wave, int lane) {
    LAS unsigned* SELM = (LAS unsigned*)lds; LAS unsigned* TIEM = (LAS unsigned*)(lds + 32 * MSTRIDE * 4);
    LAS unsigned short* LIST = (LAS unsigned short*)(lds + LIST_OFF);
    LAS unsigned* STP = (LAS unsigned*)(lds + ST_OFF); LAS unsigned* STN = STP + 32; LAS unsigned* STG = STP + 96; LAS unsigned* WINOK = STP + 161;
    LAS float* FSEL = (LAS float*)(STP + 256); LAS float* FTA = FSEL + 96; LAS unsigned* CNTL = STP + 512;
    const int t0 = qb * 32; (void)tid;
    asm volatile("" : "+v"(lane));
#pragma unroll 1
    for (int qq = 0; qq < 4; ++qq) {
        const int rq = 4 * wave + qq, t = t0 + rq; int mties = (int)STN[rq];
        if (STG[rq] & 8u) {
            const int sl = lane >> 2, cn = (int)CNTL[64 * (sl >> 1) + 32 * (sl & 1) + rq];
            const unsigned lo_u = f2sort(FTA[rq]);
            const int ptot = __builtin_amdgcn_readlane(wave_incl_scan((lane & 3) == 0 ? cn : 0), 63);
            const bool allc = (STG[rq] & 16u) && ptot < mties;
            unsigned eu[SP_M], ek[SP_M];
#pragma unroll
            for (int m = 0; m < SP_M / 2; ++m) { const int j0 = 2 * (lane & 3) + 8 * m; const v4u e = *(const v4u*)(P.LST + (size_t)(((rq * 16 + sl) * (int)SP_PHYS + j0) * 8));
                eu[2 * m] = j0 < cn ? f2sort(__uint_as_float(e.x)) - lo_u : 0xffffffffu; ek[2 * m] = e.y;
                eu[2 * m + 1] = (j0 + 1) < cn ? f2sort(__uint_as_float(e.z)) - lo_u : 0xffffffffu; ek[2 * m + 1] = e.w; }
            LAS unsigned* Hr = TIEM + rq * MSTRIDE; LAS unsigned* Sr = SELM + rq * MSTRIDE;
            unsigned span = 0u;
#pragma unroll
            for (int m = 0; m < SP_M; ++m) { const unsigned e1 = eu[m] + 1u; span = e1 > span ? e1 : span; }
            span = wave_max_u32(span);
            unsigned lo = 0u, width = span; int sh = 22 - (int)__builtin_clz(span | 1u); sh = sh < 0 ? 0 : sh;
            int needc = mties; unsigned long long thr = 0ull; unsigned tieoff = 0xffffffffu; int mt = 0;
            LAS unsigned short* lpw = LIST + rq * 256;
            if (allc) {
                int wpos = 256 - ptot;
#pragma unroll
                for (int m = 0; m < SP_M; ++m) { const bool v = eu[m] != 0xffffffffu; const unsigned long long bm = __ballot(v);
                    if (v) { lds_and(Hr + (ek[m] >> 5), ~(1u << (ek[m] & 31u))); lpw[wpos + (int)__builtin_amdgcn_mbcnt_hi((unsigned)(bm >> 32), __builtin_amdgcn_mbcnt_lo((unsigned)bm, 0u))] = (unsigned short)ek[m]; }
                    wpos += (int)__builtin_popcountll(bm); }
                LDS_WAIT(); asm volatile("" ::: "memory");
                mties -= ptot;
            } else {
#pragma unroll 1
            for (int round = 0; round < 4; ++round) {
#pragma unroll
                for (int i = 0; i < 8; ++i) Hr[lane + 64 * i] = 0u;
                LDS_WAIT();
#pragma unroll
                for (int m = 0; m < SP_M; ++m) { const unsigned d = eu[m] - lo; if (d < width) { const unsigned b = d >> sh; lds_add(Hr + (b >> 1), 1u << ((b & 1u) * 16u)); } }
                LDS_WAIT();
                unsigned D, nn, c; int tot;
                tk_scan_core<8>(Hr, needc, lane, D, nn, c, tot);
                if (D == 0xffffu) break;
                if (c == nn) { thr = (unsigned long long)lo + ((unsigned long long)D << sh); break; }
                if (sh == 0) { thr = (unsigned long long)lo + D + 1ull; tieoff = lo + D; mt = (int)nn; break; }
                lo += D << sh; width = 1u << sh; sh = sh > 10 ? sh - 10 : 0; needc = (int)nn;
            }
            int wpos = 256 - mties + mt;
#pragma unroll
            for (int m = 0; m < SP_M; ++m) { const bool win = eu[m] != 0xffffffffu && (unsigned long long)eu[m] >= thr; const unsigned long long bm = __ballot(win);
                { const int wp = wpos + (int)__builtin_amdgcn_mbcnt_hi((unsigned)(bm >> 32), __builtin_amdgcn_mbcnt_lo((unsigned)bm, 0u)); if (win && wp < 256) lpw[wp] = (unsigned short)ek[m]; }
                wpos += (int)__builtin_popcountll(bm); }
            if (mt > 0) {
#pragma unroll
                for (int i = 0; i < 8; ++i) Hr[lane + 64 * i] = 0u;
                LDS_WAIT();
#pragma unroll
                for (int m = 0; m < SP_M; ++m) if (eu[m] == tieoff && eu[m] != 0xffffffffu) lds_or(Hr + (ek[m] >> 5), 1u << (ek[m] & 31u)); }
            LDS_WAIT(); asm volatile("" ::: "memory");
            mties = mt;
            }
        }
        if ((STG[rq] & 8u) && mties == 0 && STN[rq] == 256u) {
            LAS unsigned short* lp0 = LIST + rq * 256; LDS_WAIT(); asm volatile("" ::: "memory");
            *(u32x2*)(P.SEL + (size_t)t * 256 + 4 * lane) = *(const LAS u32x2*)(lp0 + 4 * lane); continue; }
        unsigned tw[8], fw[8]; int S = 0;
#pragma unroll
        for (int i = 0; i < 8; ++i) { const int T = 8 * lane + i; const bool v = T <= qb; fw[i] = v ? SELM[rq * MSTRIDE + T] : 0u; tw[i] = 0u; }
        const bool rerank = *WINOK != 0u && (STG[rq] & 2u);
        int incl = 0;
        if (mties > 0 || rerank) {
#pragma unroll
            for (int i = 0; i < 8; ++i) { const int T = 8 * lane + i; tw[i] = T <= qb ? TIEM[rq * MSTRIDE + T] : 0u; S += __builtin_popcount(tw[i]); }
            incl = wave_incl_scan(S); }
        if (rerank) {
            const int c = __builtin_amdgcn_readlane(incl, 63), nn = mties;
            LAS unsigned short* cl = LIST + rq * 256;
            { int pos = incl - S;
#pragma unroll
              for (int i = 0; i < 8; ++i) { unsigned w = tw[i]; while (w) { const int b = __builtin_ctz(w); if (pos < 64) cl[pos] = (unsigned short)(256 * lane + 32 * i + b); ++pos; w &= w - 1u; } } }
            LDS_WAIT(); asm volatile("" ::: "memory");
            const u32x2 q4 = *(const u32x2*)(P.QI + (size_t)t * 256 + 4 * lane); const float wh = P.WI[(size_t)t * 4 + (lane >> 4)];
            float mys = 0.f; const int cc = c < 64 ? c : 64;
#pragma unroll 1
            for (int j0 = 0; j0 < cc; j0 += 8) { u32x2 k4[8];
#pragma unroll
                for (int u = 0; u < 8; ++u) { const int jj = (j0 + u) < cc ? (j0 + u) : (cc - 1); k4[u] = tk_rescore_load(P.KI, __builtin_amdgcn_readfirstlane((int)cl[jj]), lane); }
#pragma unroll
                for (int u = 0; u < 8; ++u) { const float sj = tk_rescore(q4, wh, k4[u]); if (lane == j0 + u) mys = sj; } }
            int rank = 0;
            for (int j = 0; j < cc; ++j) { const float sj = __int_as_float(__builtin_amdgcn_readlane(__float_as_int(mys), j)); rank += (sj > mys || (sj == mys && j < lane)) ? 1 : 0; }
            const bool keepme = lane < cc && rank < nn; const int mykey = lane < cc ? (int)cl[lane] : 0;
#pragma unroll 1
            for (int j = 0; j < cc; ++j) { const int kj = __builtin_amdgcn_readlane(mykey, j); const int kp = __builtin_amdgcn_readlane((int)keepme, j);
                if (kp && (kj >> 8) == lane) {
#pragma unroll
                    for (int i = 0; i < 8; ++i) if (((kj >> 5) & 7) == i) fw[i] |= 1u << (kj & 31); } }
            mties = 0;
        }
        int cl2 = 0;
        if (mties > 0) {
            int take = mties - (incl - S); take = take < 0 ? 0 : (take > S ? S : take);
#pragma unroll
            for (int i = 0; i < 8; ++i) { unsigned w = tw[i]; const int c = __builtin_popcount(w); unsigned keep;
                if (take >= c) { keep = w; take -= c; } else { keep = 0u; for (int k = 0; k < take; ++k) { const unsigned low = w & (0u - w); keep |= low; w ^= low; } take = 0; }
                fw[i] |= keep; } }
#pragma unroll
        for (int i = 0; i < 8; ++i) cl2 += __builtin_popcount(fw[i]);
        const int inc2 = wave_incl_scan(cl2);
        int pos = inc2 - cl2; const int cnt = __builtin_amdgcn_readlane(inc2, 63);
        LAS unsigned short* lp = LIST + rq * 256;
#pragma unroll
        for (int i = 0; i < 8; ++i) { unsigned w = fw[i]; while (w) { const int b = __builtin_ctz(w); if (pos < 256) lp[pos] = (unsigned short)(256 * lane + 32 * i + b); ++pos; w &= w - 1u; } }
        LDS_WAIT(); asm volatile("" ::: "memory");
        (void)cnt;
        *(u32x2*)(P.SEL + (size_t)t * 256 + 4 * lane) = *(const LAS u32x2*)(lp + 4 * lane);
    }
}

struct ProjOrderB { int c, G;
    __device__ __forceinline__ bool next(int i, pg8::Unit& u) const { const int L = i * G + c; if (L >= 128) return false; u.pm = L >> 1; u.pn = 6 + (L & 1); return true; }
    __device__ __forceinline__ void a_ready(const pg8::Unit&) const {}
    __device__ __forceinline__ void done(const pg8::Unit&) const {}
};
struct ProjOrderF { int c, G;
    __device__ __forceinline__ bool next(int i, pg8::Unit& u) const { int L;
        if (G == 256) { if (c < 128) { if (i >= 3) return false; L = c + 128 * i; } else { if (i >= 5) return false; L = 384 + (c - 128) + 128 * i; } }
        else { L = i * G + c; if (L >= 1024) return false; }
        const int pi = L & 15; u.pn = pi < 6 ? pi : pi + 2; u.pm = L >> 4; return true; }
    __device__ __forceinline__ void a_ready(const pg8::Unit&) const {}
    __device__ __forceinline__ void done(const pg8::Unit&) const {}
};
struct OneUnit { int pm, pn;
    __device__ __forceinline__ bool next(int i, pg8::Unit& u) const { if (i != 0) return false; u.pm = pm; u.pn = pn; return true; }
    __device__ __forceinline__ void a_ready(const pg8::Unit&) const {}
    __device__ __forceinline__ void done(const pg8::Unit&) const {}
};
struct Args { const float* in[18]; float* out; unsigned char* ws; int ph_lo, ph_hi; };
constexpr int NPH = 13;

typedef const __attribute__((address_space(4))) unsigned long long* kargp_t;
#define KARGS() kargp_t kargs = (kargp_t)__builtin_amdgcn_kernarg_segment_ptr(); asm volatile("" : "+s"(kargs)); GAS unsigned char* const ws = (GAS unsigned char*)kargs[19]; (void)ws
#define KIN(i) ((const float*)(const GAS float*)kargs[(i)])
#define KOUT() ((float*)(GAS float*)kargs[18])
#define WSP(T, off) ((T*)(GAS T*)(ws + (off)))
__global__ void __launch_bounds__(NTHR, 2) fwd_kernel(Args a) {
    extern __shared__ __attribute__((aligned(16))) unsigned char lds_raw[];
    LAS unsigned char* lds = (LAS unsigned char*)lds_raw;
    const int lo = a.ph_lo, hi = a.ph_hi;
    const int wave_s = __builtin_amdgcn_readfirstlane((int)(threadIdx.x >> 6));
    { int tid0 = wave_s * 64 + hw_lane(); asm volatile("" : "+v"(tid0)); for (int u = tid0; u < (LDS_BYTES - MISC_OFF) / 4; u += NTHR) ((LAS unsigned*)(lds + MISC_OFF))[u] = 0u; }
    SYNC();
    XcdBarrier bar; bar.bar = nullptr; bar.x = 0; bar.st = nullptr;
    if (hi - lo > 1) { KARGS(); bar = xcd_barrier_post((unsigned*)(GAS unsigned*)(ws + WS_CTL) + CW_BAR, (volatile LAS unsigned*)(lds + MISC_OFF) + 8, wave_s == 0); }
#define IN(k) (lo <= (k) && (k) < hi)
#define SEAM(k) do { if (IN(k) && IN((k) + 1)) xcd_barrier(bar); } while (0)
#define IDS() const int tid = threadIdx.x, lane = tid & 63, wave = __builtin_amdgcn_readfirstlane(tid >> 6), G = gridDim.x, bid = blockIdx.x; (void)lane; (void)wave; (void)G; (void)bid
#define IDSW() const int lane = hw_lane(), wave = wave_s, tid = wave * 64 + lane, G = gridDim.x, bid = blockIdx.x; (void)lane; (void)wave; (void)G; (void)bid; (void)tid

    for (int rep_ph = 0; rep_ph < ((REP_PH == 0) ? 2 : 1); ++rep_ph) if (IN(0)) { KARGS(); IDS();
        P0Ptrs P{KIN(1), KIN(2), KIN(5), KIN(8), KIN(9), KIN(11), KIN(12), KIN(14), KIN(17), KIN(10), WSP(bf16_t, WS_WIN), WSP(bf16_t, WS_WATTN), WSP(bf16_t, WS_WGRP), WSP(bf16_t, WS_WPOOL), WSP(bf16_t, WS_WOUT),
                 WSP(bf16_t, WS_WUP), WSP(bf16_t, WS_WDOWN), WSP(float, WS_MODP), WSP(bf16_t, WS_V)};
        p0_prologue(P, lds, bid * NWAVES + wave, G * NWAVES, wave, lane);
    }
    SEAM(0);
    if (IN(1)) { KARGS(); IDS();
        const float *b_ada = KIN(3), *norm1_g = KIN(4); const float* MODP = WSP(float, WS_MODP); float* MODF = WSP(float, WS_MODF);
        LAS float* mulv = (LAS float*)lds; LAS float* addv = mulv + 1024;
        for (int i = tid; i < 1024; i += NTHR) { float sh = b_ada[i], scv = b_ada[1024 + i];
#pragma unroll
            for (int kc = 0; kc < 16; ++kc) { sh += MODP[kc * NMOD + i]; scv += MODP[kc * NMOD + 1024 + i]; }
            mulv[i] = norm1_g[i] * (1.0f + scv); addv[i] = sh; }
        if (bid < 24 && tid < 256) { const int i = bid * 256 + tid; float v = b_ada[i];
#pragma unroll
            for (int kc = 0; kc < 16; ++kc) v += MODP[kc * NMOD + i];
            MODF[i] = v; }
        SYNC();
        modulate_rows(KIN(0), WSP(bf16_t, WS_H), mulv, addv, bid * NWAVES + wave, G * NWAVES, lane, false, WSP(unsigned char, WS_ATTN));
        SYNC();
    }
    SEAM(1);
    for (int rep_ph = 0; rep_ph < ((REP_PH == 2) ? 2 : 1); ++rep_ph) if (IN(2)) { KARGS(); IDSW();
        {
        pg8::Gemm g{WSP(bf16_t, WS_H), WSP(bf16_t, WS_WIN), M, NINP, DM}; ProjOrderB S{bid, G};
        EpiProj<false> E{WSP(bf16_t, WS_Q), WSP(unsigned char, WS_K), WSP(unsigned char, WS_K), WSP(bf16_t, WS_QI), WSP(bf16_t, WS_KI), WSP(bf16_t, WS_UPOOL), WSP(bf16_t, WS_GA), WSP(bf16_t, WS_GP), WSP(float, WS_WI), KIN(6), KIN(7)};
        pg8::gemm_phase<EpiProj<false>, ProjOrderB, true, true>(lds, g, S, E, wave);
        }
        SYNC();
        {
        pg8::Gemm g{WSP(bf16_t, WS_ATTN), WSP(bf16_t, WS_V), M, NINP, DM / 2}; ProjOrderF S{bid, G};
        EpiProj<true> E{WSP(bf16_t, WS_Q), WSP(unsigned char, WS_K), WSP(unsigned char, WS_K), WSP(bf16_t, WS_QI), WSP(bf16_t, WS_KI), WSP(bf16_t, WS_UPOOL), WSP(bf16_t, WS_GA), WSP(bf16_t, WS_GP), WSP(float, WS_WI), KIN(6), KIN(7)};
#pragma unroll 1
        for (int ui = 0; ; ++ui) { pg8::Unit uu; if (!S.next(ui, uu)) break;
            OneUnit S1{uu.pm, uu.pn}; pg8::gemm_phase<EpiProj<true>, OneUnit, true, true, true>(lds, g, S1, E, wave); SYNC(); }
        }
    }
    SEAM(2);
    if (IN(3)) { KARGS(); IDSW();
        if (bid < 8) {
            pg8::Gemm g{WSP(bf16_t, WS_WPOOL), WSP(bf16_t, WS_WGRP), 1024, PW, PW}; OneUnit S{bid >> 1, bid & 1};
            EpiBf<5> E{WSP(bf16_t, WS_POOLMIX), PW, nullptr, nullptr};
            pg8::gemm_phase<EpiBf<5>, OneUnit, true, true>(lds, g, S, E, wave);
            SYNC();
        }
        pooled_phase(WSP(bf16_t, WS_UPOOL), WSP(bf16_t, WS_POOLED), bid * NTHR + tid, G * NTHR);
        const int lb = bid & 255; constexpr size_t LSZ = 32u * 16u * SP_PHYS * 8u;
        const size_t lsto = (lb < 97 ? WS_H : (lb < 145 ? WS_ATTN - 97u * LSZ : (lb < 193 ? WS_V - 145u * LSZ : (lb < 238 ? WS_POOLMIX + MiB - 193u * LSZ : WS_WIN - 238u * LSZ)))) + (size_t)lb * LSZ;
        TkPtrs T{WSP(bf16_t, WS_QI), WSP(bf16_t, WS_KI), WSP(float, WS_WI), (unsigned short*)KOUT(), WSP(unsigned char, lsto)};
        unsigned* qctr = (unsigned*)(GAS unsigned*)(ws + WS_CTL) + CW_QUEUE;
        LAS int* qslot = (LAS int*)(lds + ST_OFF + 2040);
        SYNC();
        if (tid == 0) *qslot = (int)__hip_atomic_fetch_add(qctr, 1u, __ATOMIC_RELAXED, __HIP_MEMORY_SCOPE_AGENT);
        SYNC();
        TkPre cur = tk_prefetch(*qslot, T, wave, lane);
#pragma unroll 1
        for (;;) {
            if (cur.qi >= 512 * (1 + REP_TKONLY)) break;
            const int qb = 511 - (cur.qi & 511);
            int nq = 0; if (tid == 0) nq = (int)__hip_atomic_fetch_add(qctr, 1u, __ATOMIC_RELAXED, __HIP_MEMORY_SCOPE_AGENT);
            topk_passes(qb, T, lds, tid, wave, lane, cur.f0, cur.f1, cur.w4);
            if (tid == 0) *qslot = nq;
            SYNC();
            const TkPre nx = tk_prefetch(*qslot, T, wave, lane);
            if (cur.qi >= 512 * REP_TKONLY) topk_tail(qb, T, lds, tid, wave, lane);
            cur = nx;
        }
        SYNC();
    }
    SEAM(3);
    if (IN(4)) { KARGS(); IDSW();
        {
        pg8::Gemm g{WSP(bf16_t, WS_POOLED), WSP(bf16_t, WS_POOLMIX), M, DM, PW / 2}; pg8::StaticOrder S; S.init(M, DM, G, bid);
        EpiBf<1> E{WSP(bf16_t, WS_GP), DM, nullptr, nullptr, nullptr, 0.015625f};
        pg8::gemm_phase<EpiBf<1>, pg8::StaticOrder, true, true, true>(lds, g, S, E, wave);
        }
        SYNC();
        const unsigned short* SEL = (const unsigned short*)KOUT(); const bf16_t* Qp = WSP(bf16_t, WS_Q); const unsigned char *K8 = WSP(unsigned char, WS_K), *V8 = WSP(unsigned char, WS_K); bf16_t* ATTN = WSP(bf16_t, WS_ATTN);
        const bool aff = (G & 7) == 0; const int nitem = 8 * M, step = aff ? (G >> 3) * NWAVES : G * NWAVES;
#pragma unroll 1
        for (int it = aff ? (bid >> 3) * NWAVES + wave : bid * NWAVES + wave; it < (aff ? M : nitem); it += step) attn_item(aff ? it : (it >> 3), aff ? (bid & 7) : (it & 7), SEL, Qp, K8, V8, ATTN, lane);
    }
    SEAM(4);
    if (IN(7)) { KARGS(); IDSW();
        pg8::Gemm g{WSP(bf16_t, WS_ATTN), WSP(bf16_t, WS_WATTN), M, DM, AW / 2}; pg8::StaticOrder S; S.init(M, DM, G, bid);
        EpiBf<4> E{WSP(bf16_t, WS_GA), DM, nullptr, WSP(bf16_t, WS_GP), WSP(unsigned char, WS_H), 0.015625f};
        pg8::gemm_phase<EpiBf<4>, pg8::StaticOrder, true, true, true>(lds, g, S, E, wave);
    }
    SEAM(7);
    for (int rep_ph = 0; rep_ph < ((REP_PH == 8) ? 2 : 1); ++rep_ph) if (IN(8)) { KARGS(); IDSW();
        pg8::Gemm g{WSP(bf16_t, WS_H), WSP(bf16_t, WS_WOUT), M, DM, DM / 2}; pg8::StaticOrder S; S.init(M, DM, G, bid);
        EpiRes<false, true> E{KIN(0), WSP(float, WS_X1B), WSP(float, WS_MODF) + 2048, 0.f, 0.015625f};
        pg8::gemm_phase<EpiRes<false, true>, pg8::StaticOrder, true, true, true>(lds, g, S, E, wave);
    }
    SEAM(8);
    if (IN(9)) { KARGS(); IDSW();
        const float* norm2_g = KIN(13); const float* MODF = WSP(float, WS_MODF);
        LAS float* mulv = (LAS float*)lds; LAS float* addv = mulv + 1024;
        for (int i = tid; i < 1024; i += NTHR) { mulv[i] = norm2_g[i] * (1.0f + MODF[4096 + i]); addv[i] = MODF[3072 + i]; }
        SYNC();
        modulate_rows(WSP(float, WS_X1B), WSP(bf16_t, WS_H), mulv, addv, bid * NWAVES + wave, G * NWAVES, lane, true, nullptr, true);
        SYNC();
    }
    SEAM(9);
    for (int rep_ph = 0; rep_ph < ((REP_PH == 10) ? 2 : 1); ++rep_ph) if (IN(10)) { KARGS(); IDSW();
        pg8::Gemm g{WSP(bf16_t, WS_H), WSP(bf16_t, WS_WUP), M, FF2, DM / 2}; pg8::StaticOrder S; S.init(M, FF2, G, bid);
        EpiUpAct E{WSP(bf16_t, WS_ACT), WSP(float, WS_RAW), KIN(15), KIN(16)};
        pg8::gemm_phase<EpiUpAct, pg8::StaticOrder, true, true, true>(lds, g, S, E, wave);
    }
    SEAM(10);
    if (IN(12)) { KARGS(); IDSW();
        pg8::Gemm g{WSP(bf16_t, WS_ACT), WSP(bf16_t, WS_WDOWN), M, DM, FF / 2}; pg8::StaticOrder S; S.init(M, DM, G, bid);
#pragma unroll 1
        for (int ui = 0; ; ++ui) { int pm_, pn_; if (!S.next_fi(ui, pm_, pn_)) break;
            fixup_phase(WSP(float, WS_RAW), WSP(bf16_t, WS_ACT), KIN(15), KIN(16), tid, NTHR, pm_ * 4 * 1408, (pm_ * 4 + 4) * 1408); }
        asm volatile("s_waitcnt vmcnt(0)" ::: "memory"); SYNC();
        EpiRes<true, false> E{WSP(float, WS_X1B), KOUT(), WSP(float, WS_MODF) + 5120, DBG_C, 0.015625f};
        pg8::gemm_phase<EpiRes<true, false>, pg8::StaticOrder, true, true, true>(lds, g, S, E, wave);
    }
#undef IN
#undef SEAM
}

extern "C" void kernel_launch(void* const* d_in, const int* in_sizes, int n_in, void* d_out, int out_size, void* d_ws, size_t ws_size, hipStream_t stream) {
    static int grid = 0;
    if (grid == 0) {
        if (n_in != 18 || in_sizes[0] != M * DM || out_size != M * DM || ws_size < WS_END) { fprintf(stderr, "kernel_launch: unexpected shapes (n_in %d, in0 %d, out %d, ws %zu)\n", n_in, n_in > 0 ? in_sizes[0] : -1, out_size, ws_size); grid = -1; return; }
        int dev = 0, cus = 0, per_cu = 0;
        if (hipGetDevice(&dev) != hipSuccess || hipDeviceGetAttribute(&cus, hipDeviceAttributeMultiprocessorCount, dev) != hipSuccess) { grid = -1; return; }
        if (hipFuncSetAttribute((const void*)fwd_kernel, hipFuncAttributeMaxDynamicSharedMemorySize, LDS_BYTES) != hipSuccess) { fprintf(stderr, "kernel_launch: hipFuncSetAttribute failed\n"); grid = -1; return; }
        if (hipOccupancyMaxActiveBlocksPerMultiprocessor(&per_cu, (const void*)fwd_kernel, NTHR, LDS_BYTES) != hipSuccess || per_cu < 1) fprintf(stderr, "kernel_launch: occupancy query says %d\n", per_cu);
        (void)hipGetLastError();
        grid = cus;
    }
    if (grid < 0) return;
    (void)hipMemsetAsync((char*)d_ws + WS_CTL, 0, CTL_ZERO_BYTES, stream);
    Args a{};
    for (int i = 0; i < 18; ++i) a.in[i] = (const float*)d_in[i];
    a.out = (float*)d_out; a.ws = (unsigned char*)d_ws;
#if N_LAUNCH_MODE == 1
    a.ph_lo = 0; a.ph_hi = NPH;
    hipLaunchKernelGGL(fwd_kernel, dim3(grid), dim3(NTHR), LDS_BYTES, stream, a);
#else
    for (int p = 0; p < NPH; ++p) { a.ph_lo = p; a.ph_hi = p + 1; hipLaunchKernelGGL(fwd_kernel, dim3(grid), dim3(NTHR), LDS_BYTES, stream, a); }
#endif
}
```
